# Optimizing an MI355X kernel written in HIP

```python
import math
import jax, jax.numpy as jnp
from jax import lax
import numpy as np

D_MODEL = 1024
BATCH = 2
SEQ = 8192
DEPTH = 4

GRID_W = 64
CTX_LEN = 256
N_EVEN = (DEPTH + 1) // 2
N_ODD = DEPTH // 2
D_FF = 4 * D_MODEL
NORM_EPS = 1e-6
NEG_INF = -1e30

FNET_GROUPS = 8
FNET_GROUP_W = 64
FNET_W = FNET_GROUPS * FNET_GROUP_W
SSD_HEAD_DIM = 64
SSD_HEADS = 24
SSD_GROUPS = 4
SSD_HPG = SSD_HEADS // SSD_GROUPS
SSD_STATE = 128
SSD_INNER = SSD_HEADS * SSD_HEAD_DIM
SSD_CONV_DIM = SSD_INNER + 2 * SSD_GROUPS * SSD_STATE
SSD_CONV_W = 5
SSD_CHUNK = 128
EVEN_IN = FNET_W + SSD_INNER + SSD_CONV_DIM + 2 * SSD_HEADS
EVEN_MIX = FNET_W + SSD_INNER
HEAD_DIM = 64
WIN_Q_HEADS = 8
WIN_KV_HEADS = 2
WIN_GQA = WIN_Q_HEADS // WIN_KV_HEADS
WIN_RADIUS = 128
WIN_BLOCK = 128
NA_HEADS = 8
NA_ROWS = 8
NA_COLS = 16
ODD_IN = (WIN_Q_HEADS + 2 * WIN_KV_HEADS) * HEAD_DIM + 3 * NA_HEADS * HEAD_DIM
ODD_MIX = (WIN_Q_HEADS + NA_HEADS) * HEAD_DIM
ROPE_THETA = 10000.0

kernel_name = "hybrid_fourier_ssd_window_na_prefix_trunk"


def rms_norm(x, g):
    xf = x.astype(jnp.float32)
    y = xf * lax.rsqrt(jnp.mean(xf * xf, axis=-1, keepdims=True) + NORM_EPS)
    return (y * g.astype(jnp.float32)).astype(x.dtype)


def modulate(x, shift, scale):
    return x * (1 + scale) + shift


def sq_relu_mlp(x, w1, w2):
    return jnp.square(jax.nn.relu(x @ w1)) @ w2


def axial_rope_tables(n_tokens):
    pos = jnp.arange(n_tokens)
    row = (pos // GRID_W).astype(jnp.float32)
    col = (pos % GRID_W).astype(jnp.float32)
    n_freq = HEAD_DIM // 4
    inv = ROPE_THETA ** (-jnp.arange(n_freq, dtype=jnp.float32) / n_freq)
    ang = jnp.stack([row[:, None] * inv, col[:, None] * inv], axis=1)
    return jnp.cos(ang), jnp.sin(ang)


def apply_axial_rope(x, cos, sin):
    b, l, h, dh = x.shape
    xr = x.astype(jnp.float32).reshape(b, l, h, 2, 2, dh // 4)
    x1, x2 = xr[..., 0, :], xr[..., 1, :]
    cs, sn = cos[:, None], sin[:, None]
    out = jnp.stack([x1 * cs - x2 * sn, x2 * cs + x1 * sn], axis=-2)
    return out.reshape(b, l, h, dh).astype(x.dtype)


def centred_depthwise_conv(x, w, bias):
    k = w.shape[0]
    y = lax.conv_general_dilated(x, w[:, None, :].astype(x.dtype), window_strides=(1,),
                                 padding=[(k // 2, k // 2)], dimension_numbers=("NWC", "WIO", "NWC"),
                                 feature_group_count=x.shape[-1])
    return y + bias.astype(x.dtype)


def fourier_mix(u):
    b, l, _ = u.shape
    ug = u.astype(jnp.float32).reshape(b, l, FNET_GROUPS, FNET_GROUP_W)
    f = jnp.fft.fft2(ug, axes=(1, 3), norm="ortho")
    return jnp.real(f).reshape(b, l, FNET_W).astype(u.dtype)


def ssd_inputs(u_xbc, u_dt, conv_w, conv_b, dt_bias):
    b, l = u_xbc.shape[:2]
    xbc = jax.nn.silu(centred_depthwise_conv(u_xbc, conv_w, conv_b)).astype(jnp.float32)
    gn = SSD_GROUPS * SSD_STATE
    xs = xbc[..., :SSD_INNER].reshape(b, l, SSD_GROUPS, SSD_HPG, SSD_HEAD_DIM)
    bm = xbc[..., SSD_INNER:SSD_INNER + gn].reshape(b, l, SSD_GROUPS, SSD_STATE)
    cm = xbc[..., SSD_INNER + gn:].reshape(b, l, SSD_GROUPS, SSD_STATE)
    dt = jax.nn.softplus(u_dt.astype(jnp.float32).reshape(b, l, 2, SSD_GROUPS, SSD_HPG) + dt_bias)
    return xs, bm, cm, dt


def ssd_scan(xs, dt, a, bm, cm, h0):
    b, l = xs.shape[:2]
    nc, q = l // SSD_CHUNK, SSD_CHUNK
    xdt = (xs * dt[..., None]).reshape(b, nc, q, SSD_GROUPS, SSD_HPG, SSD_HEAD_DIM)
    a_cum = jnp.cumsum((dt * a).reshape(b, nc, q, SSD_GROUPS, SSD_HPG), axis=2)
    bc = bm.reshape(b, nc, q, SSD_GROUPS, SSD_STATE)
    cc = cm.reshape(b, nc, q, SSD_GROUPS, SSD_STATE)
    lower = jnp.tril(jnp.ones((q, q), dtype=bool))
    seg = a_cum[:, :, :, None] - a_cum[:, :, None, :]
    decay = jnp.exp(jnp.where(lower[:, :, None, None], seg, NEG_INF))
    cb = jnp.einsum("bclgn,bcsgn->bclsg", cc, bc)
    y_diag = jnp.einsum("bclsgr,bcsgrp->bclgrp", cb[..., None] * decay, xdt)
    decay_to_end = jnp.exp(a_cum[:, :, -1:] - a_cum)
    states = jnp.einsum("bcsgn,bcsgrp->bcgrpn", bc, xdt * decay_to_end[..., None])
    chunk_decay = jnp.exp(a_cum[:, :, -1])

    def carry_state(h, inp):
        s_c, d_c = inp
        return h * d_c[..., None, None] + s_c, h

    h_last, h_enter = lax.scan(carry_state, h0, (jnp.moveaxis(states, 1, 0), jnp.moveaxis(chunk_decay, 1, 0)))
    h_enter = jnp.moveaxis(h_enter, 0, 1)
    y_off = jnp.einsum("bclgn,bcgrpn->bclgrp", cc, h_enter) * jnp.exp(a_cum)[..., None]
    return (y_diag + y_off).reshape(b, l, SSD_GROUPS, SSD_HPG, SSD_HEAD_DIM), h_last


def bidir_ssd(xs, bm, cm, dt, a, h0_fwd, h0_bwd):
    y_f, h_f = ssd_scan(xs, dt[:, :, 0], a[0], bm, cm, h0_fwd)
    flip = lambda t: jnp.flip(t, axis=1)
    y_b, h_b = ssd_scan(flip(xs), flip(dt[:, :, 1]), a[1], flip(bm), flip(cm), h0_bwd)
    return y_f + flip(y_b), h_f, h_b


def ssd_output(y, xs, z, d_skip, norm_g):
    b, l = y.shape[:2]
    y = (y + d_skip[..., None] * xs).reshape(b, l, SSD_INNER) * jax.nn.silu(z.astype(jnp.float32))
    yg = y.reshape(b, l, SSD_GROUPS, SSD_INNER // SSD_GROUPS)
    yg = yg * lax.rsqrt(jnp.mean(yg * yg, axis=-1, keepdims=True) + NORM_EPS)
    return (yg.reshape(b, l, SSD_INNER) * norm_g.astype(jnp.float32)).astype(z.dtype)


def even_mixer(uc, ul, w_in, conv_w, conv_b, dt_bias, a_log, d_skip, ssd_norm_g, w_out, need_ctx):
    s1 = FNET_W
    s2 = s1 + SSD_INNER
    s3 = s2 + SSD_CONV_DIM
    fc, zc, xbcc, dtc = jnp.split(uc @ w_in, [s1, s2, s3], axis=-1)
    fl, zl, xbcl, dtl = jnp.split(ul @ w_in, [s1, s2, s3], axis=-1)
    a = -jnp.exp(a_log.astype(jnp.float32)).reshape(2, SSD_GROUPS, SSD_HPG)
    dtb = dt_bias.astype(jnp.float32).reshape(2, SSD_GROUPS, SSD_HPG)
    dsk = d_skip.astype(jnp.float32).reshape(SSD_GROUPS, SSD_HPG)
    xs_c, b_c, c_c, dt_c = ssd_inputs(xbcc, dtc, conv_w, conv_b, dtb)
    xs_l, b_l, c_l, dt_l = ssd_inputs(xbcl, dtl, conv_w, conv_b, dtb)
    h0 = jnp.zeros((uc.shape[0], SSD_GROUPS, SSD_HPG, SSD_HEAD_DIM, SSD_STATE), jnp.float32)
    y_c, h_f, h_b = bidir_ssd(xs_c, b_c, c_c, dt_c, a, h0, h0)
    y_l, _, _ = bidir_ssd(xs_l, b_l, c_l, dt_l, a, h_f, h_b)
    ol = jnp.concatenate([fourier_mix(fl), ssd_output(y_l, xs_l, zl, dsk, ssd_norm_g)], axis=-1) @ w_out
    oc = None
    if need_ctx:
        oc = jnp.concatenate([fourier_mix(fc), ssd_output(y_c, xs_c, zc, dsk, ssd_norm_g)], axis=-1) @ w_out
    return oc, ol


def context_attention(qc, kc, vc, sink):
    b, n = qc.shape[:2]
    s = jnp.einsum("bqhgd,bkhd->bhgqk", qc, kc).astype(jnp.float32) * (HEAD_DIM ** -0.5)
    if sink is not None:
        s_sink = jnp.broadcast_to(sink.astype(jnp.float32)[None, :, :, None, None], s.shape[:-1] + (1,))
        s = jnp.concatenate([s, s_sink], axis=-1)
    p = jax.nn.softmax(s, axis=-1)[..., :kc.shape[1]]
    o = jnp.einsum("bhgqk,bkhd->bqhgd", p.astype(vc.dtype), vc)
    return o.reshape(b, n, -1)


def window_attention(q, k, v, kc, vc, sink):
    b, l = q.shape[:2]
    nb = l // WIN_BLOCK
    n_ctx = kc.shape[1]
    qb = q.reshape(b, nb, WIN_BLOCK, WIN_KV_HEADS, WIN_GQA, HEAD_DIM)

    def band(t):
        tb = jnp.pad(t.reshape(b, nb, WIN_BLOCK, WIN_KV_HEADS, HEAD_DIM), ((0, 0), (1, 1), (0, 0), (0, 0), (0, 0)))
        return jnp.concatenate([tb[:, :-2], tb[:, 1:-1], tb[:, 2:]], axis=2)

    kb, vb = band(k), band(v)
    scale = HEAD_DIM ** -0.5
    s_loc = jnp.einsum("bnqhgd,bnshd->bnhgqs", qb, kb).astype(jnp.float32) * scale
    qpos = jnp.arange(nb)[:, None] * WIN_BLOCK + jnp.arange(WIN_BLOCK)[None]
    kpos = (jnp.arange(nb)[:, None] - 1) * WIN_BLOCK + jnp.arange(3 * WIN_BLOCK)[None]
    valid = ((jnp.abs(qpos[:, :, None] - kpos[:, None, :]) <= WIN_RADIUS)
             & (kpos[:, None, :] >= 0) & (kpos[:, None, :] < l))
    s_loc = jnp.where(valid[None, :, None, None], s_loc, NEG_INF)
    s_ctx = jnp.einsum("bnqhgd,bchd->bnhgqc", qb, kc).astype(jnp.float32) * scale
    s_sink = jnp.broadcast_to(sink.astype(jnp.float32).reshape(WIN_KV_HEADS, WIN_GQA)[None, None, :, :, None, None],
                              s_loc.shape[:-1] + (1,))
    p = jax.nn.softmax(jnp.concatenate([s_loc, s_ctx, s_sink], axis=-1), axis=-1)
    p_loc = p[..., :3 * WIN_BLOCK].astype(v.dtype)
    p_ctx = p[..., 3 * WIN_BLOCK:3 * WIN_BLOCK + n_ctx].astype(v.dtype)
    o = jnp.einsum("bnhgqs,bnshd->bnqhgd", p_loc, vb) + jnp.einsum("bnhgqc,bchd->bnqhgd", p_ctx, vc)
    return o.reshape(b, l, WIN_Q_HEADS * HEAD_DIM)


def neighbourhood_attention(q, k, v, kc, vc, rpb):
    b, l, h, dh = q.shape
    rows = l // GRID_W
    kr = min(NA_ROWS, rows)
    r = jnp.arange(rows)
    row_idx = jnp.clip(r - kr // 2, 0, rows - kr)[:, None] + jnp.arange(kr)[None]
    cols = jnp.arange(GRID_W)
    col_start = jnp.clip(cols - NA_COLS // 2, 0, GRID_W - NA_COLS)
    col_ok = (cols[None] >= col_start[:, None]) & (cols[None] < col_start[:, None] + NA_COLS)
    qg = q.reshape(b, rows, GRID_W, h, dh)
    kg = k.reshape(b, rows, GRID_W, h, dh)[:, row_idx]
    vg = v.reshape(b, rows, GRID_W, h, dh)[:, row_idx]
    scale = HEAD_DIM ** -0.5
    s_loc = jnp.einsum("brwhd,brkuhd->bhrwku", qg, kg).astype(jnp.float32) * scale
    row_off = row_idx - r[:, None] + (NA_ROWS - 1)
    col_off = jnp.clip(cols[None] - cols[:, None] + (NA_COLS - 1), 0, 2 * NA_COLS - 2)
    bias = rpb.astype(jnp.float32)[:, row_off[:, None, :, None], col_off[None, :, None, :]]
    s_loc = jnp.where(col_ok[:, None, :], s_loc + bias[None], NEG_INF)
    s_ctx = jnp.einsum("brwhd,bchd->bhrwc", qg, kc).astype(jnp.float32) * scale
    n_loc = kr * GRID_W
    p = jax.nn.softmax(jnp.concatenate([s_loc.reshape(b, h, rows, GRID_W, n_loc), s_ctx], axis=-1), axis=-1)
    p_loc = p[..., :n_loc].reshape(b, h, rows, GRID_W, kr, GRID_W).astype(v.dtype)
    p_ctx = p[..., n_loc:].astype(v.dtype)
    o = jnp.einsum("bhrwku,brkuhd->brwhd", p_loc, vg) + jnp.einsum("bhrwc,bchd->brwhd", p_ctx, vc)
    return o.reshape(b, l, h * dh)


def odd_mixer(uc, ul, w_in, q_norm_win, k_norm_win, sink_win, q_norm_na, k_norm_na, rpb_na, w_out, cos, sin, need_ctx):
    wq = WIN_Q_HEADS * HEAD_DIM
    wk = WIN_KV_HEADS * HEAD_DIM
    nh = NA_HEADS * HEAD_DIM
    splits = [wq, wq + wk, wq + 2 * wk, wq + 2 * wk + nh, wq + 2 * wk + 2 * nh]

    def heads(p):
        b, l = p.shape[:2]
        qw, kw, vw, qn, kn, vn = jnp.split(p, splits, axis=-1)
        qw = rms_norm(qw.reshape(b, l, WIN_Q_HEADS, HEAD_DIM), q_norm_win)
        kw = rms_norm(kw.reshape(b, l, WIN_KV_HEADS, HEAD_DIM), k_norm_win)
        vw = vw.reshape(b, l, WIN_KV_HEADS, HEAD_DIM)
        qn = rms_norm(qn.reshape(b, l, NA_HEADS, HEAD_DIM), q_norm_na)
        kn = rms_norm(kn.reshape(b, l, NA_HEADS, HEAD_DIM), k_norm_na)
        vn = vn.reshape(b, l, NA_HEADS, HEAD_DIM)
        return qw, kw, vw, qn, kn, vn

    qwc, kwc, vwc, qnc, knc, vnc = heads(uc @ w_in)
    qwl, kwl, vwl, qnl, knl, vnl = heads(ul @ w_in)
    qwl = apply_axial_rope(qwl, cos, sin)
    kwl = apply_axial_rope(kwl, cos, sin)
    ol = jnp.concatenate([window_attention(qwl, kwl, vwl, kwc, vwc, sink_win),
                          neighbourhood_attention(qnl, knl, vnl, knc, vnc, rpb_na)], axis=-1) @ w_out
    oc = None
    if need_ctx:
        b, n = uc.shape[:2]
        oc = jnp.concatenate([
            context_attention(qwc.reshape(b, n, WIN_KV_HEADS, WIN_GQA, HEAD_DIM), kwc, vwc,
                              sink_win.reshape(WIN_KV_HEADS, WIN_GQA)),
            context_attention(qnc.reshape(b, n, NA_HEADS, 1, HEAD_DIM), knc, vnc, None)], axis=-1) @ w_out
    return oc, ol


def setup_inputs(seed: int = 0) -> dict:
    key = jax.random.key(seed)
    ks = jax.random.split(key, 32)
    f32 = jnp.float32
    D = D_MODEL

    def nrm(k, shape, s):
        return jax.random.normal(k, shape, f32) * s

    dt0 = jnp.exp(jax.random.uniform(ks[14], (N_EVEN, 2, SSD_HEADS), f32, math.log(1e-3), math.log(1e-1)))
    return {
        "x": nrm(ks[0], (BATCH, SEQ, D), 1.0),
        "c": nrm(ks[1], (BATCH, D), 1.0),
        "ctx": nrm(ks[2], (BATCH, CTX_LEN, D), 1.0),
        "c_ctx": nrm(ks[3], (D,), 1.0),
        "w_mod": nrm(ks[4], (DEPTH, D, 6 * D), 0.5 * D ** -0.5),
        "b_mod": nrm(ks[5], (DEPTH, 6 * D), 0.01),
        "norm_mix_g": 1.0 + nrm(ks[6], (DEPTH, D), 0.02),
        "norm_ff_g": 1.0 + nrm(ks[7], (DEPTH, D), 0.02),
        "w_ff1": nrm(ks[8], (DEPTH, D, D_FF), D ** -0.5),
        "w_ff2": nrm(ks[9], (DEPTH, D_FF, D), D_FF ** -0.5),
        "w_in_even": nrm(ks[10], (N_EVEN, D, EVEN_IN), D ** -0.5),
        "conv_w": nrm(ks[11], (N_EVEN, SSD_CONV_W, SSD_CONV_DIM), SSD_CONV_W ** -0.5),
        "conv_b": nrm(ks[12], (N_EVEN, SSD_CONV_DIM), 0.01),
        "dt_bias": dt0 + jnp.log(-jnp.expm1(-dt0)),
        "a_log": jnp.log(jax.random.uniform(ks[15], (N_EVEN, 2, SSD_HEADS), f32, 1.0, 16.0)),
        "d_skip": 1.0 + nrm(ks[16], (N_EVEN, SSD_HEADS), 0.02),
        "ssd_norm_g": 1.0 + nrm(ks[17], (N_EVEN, SSD_INNER), 0.02),
        "w_out_even": nrm(ks[18], (N_EVEN, EVEN_MIX, D), EVEN_MIX ** -0.5),
        "w_in_odd": nrm(ks[19], (N_ODD, D, ODD_IN), D ** -0.5),
        "q_norm_win": 1.0 + nrm(ks[20], (N_ODD, HEAD_DIM), 0.02),
        "k_norm_win": 1.0 + nrm(ks[21], (N_ODD, HEAD_DIM), 0.02),
        "sink_win": nrm(ks[22], (N_ODD, WIN_Q_HEADS), 0.5),
        "q_norm_na": 1.0 + nrm(ks[23], (N_ODD, HEAD_DIM), 0.02),
        "k_norm_na": 1.0 + nrm(ks[24], (N_ODD, HEAD_DIM), 0.02),
        "rpb_na": nrm(ks[25], (N_ODD, NA_HEADS, 2 * NA_ROWS - 1, 2 * NA_COLS - 1), 0.02),
        "w_out_odd": nrm(ks[26], (N_ODD, ODD_MIX, D), ODD_MIX ** -0.5),
    }


def reference(x, c, ctx, c_ctx, w_mod, b_mod, norm_mix_g, norm_ff_g, w_ff1, w_ff2,
              w_in_even, conv_w, conv_b, dt_bias, a_log, d_skip, ssd_norm_g, w_out_even,
              w_in_odd, q_norm_win, k_norm_win, sink_win, q_norm_na, k_norm_na, rpb_na, w_out_odd):
    hl, hc = x, ctx
    cos, sin = axial_rope_tables(x.shape[1])
    silu_c = jax.nn.silu(c)
    silu_cc = jax.nn.silu(c_ctx)
    for i in range(DEPTH):
        need_ctx = i < DEPTH - 1
        mod_l = (silu_c @ w_mod[i] + b_mod[i])[:, None, :]
        mod_c = (silu_cc @ w_mod[i] + b_mod[i])[None, None, :]
        sh1_l, sc1_l, g1_l, sh2_l, sc2_l, g2_l = jnp.split(mod_l, 6, axis=-1)
        sh1_c, sc1_c, g1_c, sh2_c, sc2_c, g2_c = jnp.split(mod_c, 6, axis=-1)
        ul = modulate(rms_norm(hl, norm_mix_g[i]), sh1_l, sc1_l)
        uc = modulate(rms_norm(hc, norm_mix_g[i]), sh1_c, sc1_c)
        if i % 2 == 0:
            j = i // 2
            oc, ol = even_mixer(uc, ul, w_in_even[j], conv_w[j], conv_b[j], dt_bias[j], a_log[j],
                                d_skip[j], ssd_norm_g[j], w_out_even[j], need_ctx)
        else:
            j = i // 2
            oc, ol = odd_mixer(uc, ul, w_in_odd[j], q_norm_win[j], k_norm_win[j], sink_win[j],
                               q_norm_na[j], k_norm_na[j], rpb_na[j], w_out_odd[j], cos, sin, need_ctx)
        hl = hl + g1_l * ol
        hl = hl + g2_l * sq_relu_mlp(modulate(rms_norm(hl, norm_ff_g[i]), sh2_l, sc2_l), w_ff1[i], w_ff2[i])
        if need_ctx:
            hc = hc + g1_c * oc
            hc = hc + g2_c * sq_relu_mlp(modulate(rms_norm(hc, norm_ff_g[i]), sh2_c, sc2_c), w_ff1[i], w_ff2[i])
    return hl
```

```cpp
#include <hip/hip_runtime.h>
#include <hip/hip_cooperative_groups.h>
#include <cstdio>
namespace cg = cooperative_groups;

typedef unsigned short bfr;
typedef __attribute__((ext_vector_type(8))) short bf16x8;
typedef __attribute__((ext_vector_type(4))) short bf16x4;
typedef __attribute__((ext_vector_type(16))) float f32x16;
#define DI __device__ __forceinline__
#define MFMA(a, b, c) __builtin_amdgcn_mfma_f32_32x32x16_bf16((a), (b), (c), 0, 0, 0)

#ifndef MULTI_LAUNCH
#define MULTI_LAUNCH 0
#endif

constexpr int RL = 16384, R = 16896, SEQ = 8192, CTX = 256;
constexpr int NCH = 33, CL = 256;
constexpr int NPHASE = 37;

constexpr size_t al(size_t x) { return (x + 255) & ~size_t(255); }
constexpr size_t OFF_HC = 0;
constexpr size_t OFF_MOD = OFF_HC + al(512 * 1024 * 4);
constexpr size_t OFF_TW = OFF_MOD + al(4 * 3 * 6144 * 4);
constexpr size_t OFF_C128 = OFF_TW + al(8192 * 8);
constexpr size_t OFF_S128 = OFF_C128 + al(128 * 128 * 2);
constexpr size_t OFF_C64 = OFF_S128 + al(128 * 128 * 2);
constexpr size_t OFF_S64 = OFF_C64 + al(64 * 64 * 2);
constexpr size_t OFF_C256 = OFF_S64 + al(64 * 64 * 2);
constexpr size_t OFF_S256 = OFF_C256 + al(256 * 256 * 2);
constexpr size_t OFF_ROPE = OFF_S256 + al(256 * 256 * 2);
constexpr size_t OFF_DTV = OFF_ROPE + al(2 * 2 * 128 * 16 * 4);
constexpr size_t DT_BYTES = (size_t)2 * 2 * NCH * 24 * 256 * 4;
constexpr size_t OFF_ACUM = OFF_DTV + al(DT_BYTES);
constexpr size_t OFF_WIN = OFF_ACUM + al(DT_BYTES);
constexpr size_t OFF_WOUT = OFF_WIN + al((size_t)5248 * 1024 * 2);
constexpr size_t OFF_WFF1 = OFF_WOUT + al((size_t)1024 * 2048 * 2);
constexpr size_t OFF_WFF2 = OFF_WFF1 + al((size_t)4096 * 1024 * 2);
constexpr size_t OFF_MIX = OFF_WFF2 + al((size_t)4096 * 1024 * 2);
constexpr size_t OFF_BIG = OFF_MIX + al((size_t)R * 2048 * 2);
constexpr size_t OFF_Z = OFF_BIG;
constexpr size_t OFF_ZRT = OFF_Z + (size_t)R * 1536 * 2;
constexpr size_t OFF_ZIT = OFF_ZRT + (size_t)512 * R * 2;
constexpr size_t OFF_XBC = OFF_ZIT + (size_t)512 * R * 2;
constexpr size_t OFF_DTRAW = OFF_XBC + (size_t)R * 2560 * 2;
constexpr size_t BIG_END = OFF_DTRAW + (size_t)R * 48 * 4;
constexpr size_t OFF_HS = OFF_XBC;
constexpr size_t HS_BYTES = (size_t)2 * 2 * NCH * 24 * 8192 * 2;
constexpr size_t OFF_YR = OFF_HS + HS_BYTES;
constexpr size_t OFF_YI = OFF_YR + (size_t)2 * 512 * 128 * 64 * 2;
static_assert(OFF_YI + (size_t)2 * 512 * 128 * 64 * 2 <= OFF_DTRAW, "fft scratch overflows");
constexpr size_t OFF_ACT = OFF_BIG;
static_assert((size_t)R * 4096 * 2 <= BIG_END - OFF_BIG, "act overflows");
constexpr size_t OFF_P = OFF_BIG;
constexpr size_t OFF_VT = OFF_P + (size_t)R * 2304 * 2;
constexpr size_t OFF_QK = OFF_VT + (size_t)640 * R * 2;
static_assert(OFF_QK + (size_t)R * 1664 * 2 <= BIG_END, "odd overflows");
constexpr size_t OFF_XT = al(BIG_END);
constexpr size_t OFF_BN = OFF_XT + (size_t)1536 * R * 2;
constexpr size_t OFF_BT = OFF_BN + (size_t)R * 512 * 2;
constexpr size_t OFF_CN = OFF_BT + (size_t)512 * R * 2;
constexpr size_t WS_TOTAL = OFF_CN + (size_t)R * 512 * 2;
static_assert(WS_TOTAL <= 402653184ull, "workspace too large");

struct Params {
  const float *x, *c, *ctx, *c_ctx, *w_mod, *b_mod, *norm_mix_g, *norm_ff_g, *w_ff1, *w_ff2;
  const float *w_in_even, *conv_w, *conv_b, *dt_bias, *a_log, *d_skip, *ssd_norm_g, *w_out_even;
  const float *w_in_odd, *q_norm_win, *k_norm_win, *sink_win, *q_norm_na, *k_norm_na, *rpb_na, *w_out_odd;
  float* out;
  unsigned char* ws;
};

struct DP : Params { int tidl, bidl; };

__shared__ __attribute__((aligned(16))) unsigned char smem[73728];

DI bfr f2bf(float x) { unsigned u = __float_as_uint(x); u += 0x7fffu + ((u >> 16) & 1u); return (bfr)(u >> 16); }
DI float bf2f(bfr b) { return __uint_as_float(((unsigned)b) << 16); }
DI float bfs(short s) { return __uint_as_float(((unsigned)(unsigned short)s) << 16); }
DI int crow(int i, int h) { return (i & 3) + 8 * (i >> 2) + 4 * h; }
DI f32x16 zero16() { f32x16 z; for (int i = 0; i < 16; ++i) z[i] = 0.f; return z; }
DI bf16x8 pack8(float a0, float a1, float a2, float a3, float a4, float a5, float a6, float a7) {
  bf16x8 v;
  v[0] = (short)f2bf(a0); v[1] = (short)f2bf(a1); v[2] = (short)f2bf(a2); v[3] = (short)f2bf(a3);
  v[4] = (short)f2bf(a4); v[5] = (short)f2bf(a5); v[6] = (short)f2bf(a6); v[7] = (short)f2bf(a7);
  return v;
}
DI bf16x4 pack4(float a0, float a1, float a2, float a3) {
  bf16x4 v; v[0] = (short)f2bf(a0); v[1] = (short)f2bf(a1); v[2] = (short)f2bf(a2); v[3] = (short)f2bf(a3); return v;
}
#define PACK_HALF(s, s2) pack8(s[8 * (s2)], s[8 * (s2) + 1], s[8 * (s2) + 2], s[8 * (s2) + 3], s[8 * (s2) + 4], s[8 * (s2) + 5], s[8 * (s2) + 6], s[8 * (s2) + 7])
DI bf16x8 join44(bf16x4 lo, bf16x4 hi) { return __builtin_shufflevector(lo, hi, 0, 1, 2, 3, 4, 5, 6, 7); }
DI int chunk_row0(int b, int c) { return c == 0 ? RL + b * CTX : b * SEQ + (c - 1) * CL; }

DI void sincos_turn(double f, float& s, float& c) {
  f -= rint(f);
  double x = f * 6.283185307179586476925;
  double x2 = x * x, ss = 1.0, cc = 1.0;
#pragma unroll
  for (int k = 13; k >= 1; --k) {
    ss = 1.0 - x2 / (double)((2 * k) * (2 * k + 1)) * ss;
    cc = 1.0 - x2 / (double)((2 * k - 1) * (2 * k)) * cc;
  }
  s = (float)(x * ss); c = (float)cc;
}

template <class T> DI T* wsp(const DP& p, size_t off) { return (T*)(p.ws + off); }

DI void phase0(const DP& p) {
  const int tid = p.tidl, bid = p.bidl, G = gridDim.x;
  float* lds = (float*)smem;
  float* MOD = wsp<float>(p, OFF_MOD);
  for (int u = bid; u < 384; u += G) {
    int layer = u / 96, cb = u % 96;
    for (int i = tid; i < 3072; i += 256) {
      int v = i >> 10, k = i & 1023;
      float c = v < 2 ? p.c[v * 1024 + k] : p.c_ctx[k];
      lds[i] = c / (1.f + expf(-c));
    }
    __syncthreads();
    int kq = tid >> 6, cc = tid & 63, col = cb * 64 + cc;
    const float* w = p.w_mod + (size_t)layer * 1024 * 6144 + col;
    float a0 = 0, a1 = 0, a2 = 0;
    for (int k = kq * 256; k < kq * 256 + 256; ++k) {
      float wv = w[(size_t)k * 6144];
      a0 += lds[k] * wv; a1 += lds[1024 + k] * wv; a2 += lds[2048 + k] * wv;
    }
    float* red = lds + 3072;
    red[(kq * 3 + 0) * 64 + cc] = a0; red[(kq * 3 + 1) * 64 + cc] = a1; red[(kq * 3 + 2) * 64 + cc] = a2;
    __syncthreads();
    if (tid < 192) {
      int v = tid >> 6;
      float s = red[(0 * 3 + v) * 64 + cc] + red[(1 * 3 + v) * 64 + cc] + red[(2 * 3 + v) * 64 + cc] + red[(3 * 3 + v) * 64 + cc];
      MOD[(layer * 3 + v) * 6144 + col] = s + p.b_mod[layer * 6144 + col];
    }
    __syncthreads();
  }
  const int gt = bid * 256 + tid, nt = G * 256;
  {
    const float4* xs = (const float4*)p.x; float4* od = (float4*)p.out;
    for (int i = gt; i < RL * 256; i += nt) od[i] = xs[i];
    const float4* cs = (const float4*)p.ctx; float4* hd = wsp<float4>(p, OFF_HC);
    for (int i = gt; i < 512 * 256; i += nt) hd[i] = cs[i];
  }
  float2* TW = wsp<float2>(p, OFF_TW);
  for (int i = gt; i < 8192; i += nt) { float s, c; sincos_turn((double)i / 8192.0, s, c); TW[i] = make_float2(c, s); }
  bfr* C128 = wsp<bfr>(p, OFF_C128); bfr* S128 = wsp<bfr>(p, OFF_S128);
  for (int i = gt; i < 128 * 128; i += nt) { int a = i >> 7, b = i & 127; float s, c; sincos_turn((double)((a * b) & 127) / 128.0, s, c); C128[i] = f2bf(c); S128[i] = f2bf(s); }
  bfr* C64 = wsp<bfr>(p, OFF_C64); bfr* S64 = wsp<bfr>(p, OFF_S64);
  for (int i = gt; i < 64 * 64; i += nt) { int a = i >> 6, b = i & 63; float s, c; sincos_turn((double)((a * b) & 63) / 64.0, s, c); C64[i] = f2bf(c); S64[i] = f2bf(s); }
  bfr* C256 = wsp<bfr>(p, OFF_C256); bfr* S256 = wsp<bfr>(p, OFF_S256);
  for (int i = gt; i < 256 * 256; i += nt) { int a = i >> 8, b = i & 255; float s, c; sincos_turn((double)((a * b) & 255) / 256.0, s, c); C256[i] = f2bf(c); S256[i] = f2bf(s); }
  float* ROPE = wsp<float>(p, OFF_ROPE);
  for (int i = gt; i < 2 * 128 * 16; i += nt) {
    int f = i & 15, idx = (i >> 4) & 127;
    float ang = (float)idx * (float)exp(-(double)f * 0.5756462732485115);
    float s, c; sincos_turn((double)ang / 6.283185307179586476925, s, c);
    ROPE[i] = c; ROPE[4096 + i] = s;
  }
}

DI void tcvt_unit(const float* __restrict__ src, int ld, int c0, int ncols, int K, bfr* __restrict__ dst, int dr0, int u, int tid) {
  const int ntk = K >> 6;
  const int tn = u / ntk, tk = u % ntk, k0 = tk * 64, nb = tn * 64;
  bfr* T = (bfr*)smem;
#pragma unroll
  for (int i = 0; i < 4; ++i) {
    int kk = (tid >> 4) + 16 * i, n4 = (tid & 15) * 4;
    float4 v = make_float4(0.f, 0.f, 0.f, 0.f);
    if (nb + n4 < ncols) v = *(const float4*)(src + (size_t)(k0 + kk) * ld + c0 + nb + n4);
    T[(n4 + 0) * 72 + kk] = f2bf(v.x); T[(n4 + 1) * 72 + kk] = f2bf(v.y);
    T[(n4 + 2) * 72 + kk] = f2bf(v.z); T[(n4 + 3) * 72 + kk] = f2bf(v.w);
  }
  __syncthreads();
  {
    int n = tid >> 2, kseg = (tid & 3) * 16;
    if (nb + n < ncols) {
      bfr* d = dst + (size_t)(dr0 + nb + n) * K + k0 + kseg;
      *(bf16x8*)d = *(const bf16x8*)(T + n * 72 + kseg);
      *(bf16x8*)(d + 8) = *(const bf16x8*)(T + n * 72 + kseg + 8);
    }
  }
  __syncthreads();
}

DI void wconv_phase(const DP& p, int layer) {
  const int tid = p.tidl;
  const int j = layer >> 1;
  bfr* WIN = wsp<bfr>(p, OFF_WIN); bfr* WOUT = wsp<bfr>(p, OFF_WOUT);
  bfr* WFF1 = wsp<bfr>(p, OFF_WFF1); bfr* WFF2 = wsp<bfr>(p, OFF_WFF2);
  const float* ff1 = p.w_ff1 + (size_t)layer * 1024 * 4096;
  const float* ff2 = p.w_ff2 + (size_t)layer * 4096 * 1024;
  float* cst = (float*)(smem + 12288);
  if (tid < 64) { float s, c; sincos_turn((double)tid / 64.0, s, c); cst[tid] = c; cst[64 + tid] = s; }
  __syncthreads();
  if ((layer & 1) == 0) {
    const float* win = p.w_in_even + (size_t)j * 1024 * 4656;
    const float* wout = p.w_out_even + (size_t)j * 2048 * 1024;
    const int n_in = 65 * 16, n_out = 16 * 32, n_f1 = 64 * 16, n_f2 = 16 * 64, n_fold = 2048;
    const int total = n_in + n_out + n_f1 + n_f2 + n_fold;
    for (int u = p.bidl; u < total; u += gridDim.x) {
      int v = u;
      if (v < n_in) { tcvt_unit(win, 4656, 512, 4144, 1024, WIN, 1024, v, tid); continue; }
      v -= n_in;
      if (v < n_out) { tcvt_unit(wout, 1024, 0, 1024, 2048, WOUT, 0, v, tid); continue; }
      v -= n_out;
      if (v < n_f1) { tcvt_unit(ff1, 4096, 0, 4096, 1024, WFF1, 0, v, tid); continue; }
      v -= n_f1;
      if (v < n_f2) { tcvt_unit(ff2, 1024, 0, 1024, 4096, WFF2, 0, v, tid); continue; }
      v -= n_f2;
      {
        int ch = v >> 2, kb = v & 3, k = kb * 256 + tid, g = ch >> 6, m = ch & 63;
        const float* wr = win + (size_t)k * 4656 + g * 64;
        float sc = 0.f, ss = 0.f;
        for (int jj = 0; jj < 64; ++jj) { float w = wr[jj]; int idx = (m * jj) & 63; sc += w * cst[idx]; ss += w * cst[64 + idx]; }
        WIN[(size_t)ch * 1024 + k] = f2bf(sc);
        WIN[(size_t)(512 + ch) * 1024 + k] = f2bf(-ss);
      }
    }
  } else {
    const float* win = p.w_in_odd + (size_t)j * 1024 * 2304;
    const float* wout = p.w_out_odd + (size_t)j * 1024 * 1024;
    const int n_in = 36 * 16, n_out = 16 * 16, n_f1 = 64 * 16, n_f2 = 16 * 64;
    const int total = n_in + n_out + n_f1 + n_f2;
    for (int u = p.bidl; u < total; u += gridDim.x) {
      int v = u;
      if (v < n_in) { tcvt_unit(win, 2304, 0, 2304, 1024, WIN, 0, v, tid); continue; }
      v -= n_in;
      if (v < n_out) { tcvt_unit(wout, 1024, 0, 1024, 1024, WOUT, 0, v, tid); continue; }
      v -= n_out;
      if (v < n_f1) { tcvt_unit(ff1, 4096, 0, 4096, 1024, WFF1, 0, v, tid); continue; }
      v -= n_f1;
      tcvt_unit(ff2, 1024, 0, 1024, 4096, WFF2, 0, v, tid);
    }
  }
}

DI void norm_phase(const DP& p, int layer, const float* __restrict__ gvec, int shc, int scc) {
  const int lane = p.tidl & 63;
  const int wg = p.bidl * 4 + (p.tidl >> 6), nw = gridDim.x * 4;
  const float* MOD = wsp<float>(p, OFF_MOD);
  const float* HC = wsp<float>(p, OFF_HC);
  bfr* U = wsp<bfr>(p, OFF_MIX);
  for (int row = wg; row < R; row += nw) {
    const float* hp = row < RL ? p.out + (size_t)row * 1024 : HC + (size_t)(row - RL) * 1024;
    const int ms = row < RL ? (row >> 13) : 2;
    const float* md = MOD + (layer * 3 + ms) * 6144;
    float4 v[4]; float ss = 0.f;
#pragma unroll
    for (int i = 0; i < 4; ++i) {
      v[i] = *(const float4*)(hp + i * 256 + lane * 4);
      ss += v[i].x * v[i].x + v[i].y * v[i].y + v[i].z * v[i].z + v[i].w * v[i].w;
    }
#pragma unroll
    for (int o = 32; o >= 1; o >>= 1) ss += __shfl_xor(ss, o);
    const float rs = rsqrtf(ss * (1.f / 1024.f) + 1e-6f);
#pragma unroll
    for (int i = 0; i < 4; ++i) {
      int col = i * 256 + lane * 4;
      float4 g = *(const float4*)(gvec + col);
      float4 sc = *(const float4*)(md + scc * 1024 + col);
      float4 sh = *(const float4*)(md + shc * 1024 + col);
      bf16x4 o = pack4(v[i].x * rs * g.x * (1.f + sc.x) + sh.x, v[i].y * rs * g.y * (1.f + sc.y) + sh.y,
                       v[i].z * rs * g.z * (1.f + sc.z) + sh.z, v[i].w * rs * g.w * (1.f + sc.w) + sh.w);
      *(bf16x4*)(U + (size_t)row * 1024 + col) = o;
    }
  }
}

enum { EPI_EVEN_IN = 0, EPI_ODD_IN = 1, EPI_RELU2 = 2, EPI_RESID = 3 };

DI void gemm_phase(const DP& p, int mode, const bfr* __restrict__ A, int lda, const bfr* __restrict__ Bt,
                   int N, int K, int S, int layer, int gchunk) {
  const int tid = p.tidl, lane = tid & 63, wid = tid >> 6, r = lane & 31, h = lane >> 5;
  const int wm = wid >> 1, wn = wid & 1;
  const int nN = (N + 127) >> 7, nM = R / 128;
  const int Ks = K / S, nk = Ks >> 6;
  const int units = nM * nN * S;
  bfr* sm = (bfr*)smem;
  const int lrow = tid >> 3, lc = (tid & 7) * 8;
  for (int u = p.bidl; u < units; u += gridDim.x) {
    const int ks = u % S; const int t = u / S; const int tn = t % nN, tm = t / nN;
    const int m0 = tm * 128, n0 = tn * 128, kbase = ks * Ks;
    f32x16 acc[2][2];
    acc[0][0] = zero16(); acc[0][1] = zero16(); acc[1][0] = zero16(); acc[1][1] = zero16();
    const bfr* Ag = A + (size_t)(m0 + lrow) * lda + kbase + lc;
    const bfr* Bg = Bt + (size_t)(n0 + lrow) * K + kbase + lc;
    bf16x8 ra[4], rb[4];
#pragma unroll
    for (int i = 0; i < 4; ++i) {
      ra[i] = *(const bf16x8*)(Ag + (size_t)(32 * i) * lda);
      rb[i] = *(const bf16x8*)(Bg + (size_t)(32 * i) * K);
    }
#pragma unroll
    for (int i = 0; i < 4; ++i) {
      *(bf16x8*)(sm + (lrow + 32 * i) * 72 + lc) = ra[i];
      *(bf16x8*)(sm + 9216 + (lrow + 32 * i) * 72 + lc) = rb[i];
    }
    __syncthreads();
    for (int kt = 0; kt < nk; ++kt) {
      if (kt + 1 < nk) {
#pragma unroll
        for (int i = 0; i < 4; ++i) {
          ra[i] = *(const bf16x8*)(Ag + (size_t)(32 * i) * lda + (kt + 1) * 64);
          rb[i] = *(const bf16x8*)(Bg + (size_t)(32 * i) * K + (kt + 1) * 64);
        }
      }
      const bfr* As = sm + (kt & 1) * 18432;
      const bfr* Bs = As + 9216;
#pragma unroll
      for (int kk = 0; kk < 4; ++kk) {
        bf16x8 a0 = *(const bf16x8*)(As + (wm * 64 + r) * 72 + kk * 16 + h * 8);
        bf16x8 a1 = *(const bf16x8*)(As + (wm * 64 + 32 + r) * 72 + kk * 16 + h * 8);
        bf16x8 b0 = *(const bf16x8*)(Bs + (wn * 64 + r) * 72 + kk * 16 + h * 8);
        bf16x8 b1 = *(const bf16x8*)(Bs + (wn * 64 + 32 + r) * 72 + kk * 16 + h * 8);
        acc[0][0] = MFMA(a0, b0, acc[0][0]);
        acc[0][1] = MFMA(a0, b1, acc[0][1]);
        acc[1][0] = MFMA(a1, b0, acc[1][0]);
        acc[1][1] = MFMA(a1, b1, acc[1][1]);
      }
      if (kt + 1 < nk) {
        bfr* Ad = sm + ((kt + 1) & 1) * 18432;
#pragma unroll
        for (int i = 0; i < 4; ++i) {
          *(bf16x8*)(Ad + (lrow + 32 * i) * 72 + lc) = ra[i];
          *(bf16x8*)(Ad + 9216 + (lrow + 32 * i) * 72 + lc) = rb[i];
        }
      }
      __syncthreads();
    }
#pragma unroll
    for (int mi = 0; mi < 2; ++mi)
#pragma unroll
      for (int ni = 0; ni < 2; ++ni)
#pragma unroll
        for (int g4 = 0; g4 < 4; ++g4) {
          const int row = m0 + wm * 64 + mi * 32 + 8 * g4 + 4 * h;
          const int col = n0 + wn * 64 + ni * 32 + r;
          const float v0 = acc[mi][ni][4 * g4], v1 = acc[mi][ni][4 * g4 + 1], v2 = acc[mi][ni][4 * g4 + 2], v3 = acc[mi][ni][4 * g4 + 3];
          if (mode == EPI_EVEN_IN) {
            if (col < 1024) {
              bfr* dst = wsp<bfr>(p, col < 512 ? OFF_ZRT : OFF_ZIT) + (size_t)(col & 511) * R + row;
              *(bf16x4*)dst = pack4(v0, v1, v2, v3);
            } else if (col < 2560) {
              bfr* dst = wsp<bfr>(p, OFF_Z) + (size_t)row * 1536 + (col - 1024);
              dst[0] = f2bf(v0); dst[1536] = f2bf(v1); dst[2 * 1536] = f2bf(v2); dst[3 * 1536] = f2bf(v3);
            } else if (col < 5120) {
              bfr* dst = wsp<bfr>(p, OFF_XBC) + (size_t)row * 2560 + (col - 2560);
              dst[0] = f2bf(v0); dst[2560] = f2bf(v1); dst[2 * 2560] = f2bf(v2); dst[3 * 2560] = f2bf(v3);
            } else if (col < 5168) {
              float* dst = wsp<float>(p, OFF_DTRAW) + (size_t)row * 48 + (col - 5120);
              dst[0] = v0; dst[48] = v1; dst[96] = v2; dst[144] = v3;
            }
          } else if (mode == EPI_ODD_IN) {
            if (col >= 640 && col < 768) {
              *(bf16x4*)(wsp<bfr>(p, OFF_VT) + (size_t)(col - 640) * R + row) = pack4(v0, v1, v2, v3);
            } else if (col >= 1792) {
              *(bf16x4*)(wsp<bfr>(p, OFF_VT) + (size_t)(128 + col - 1792) * R + row) = pack4(v0, v1, v2, v3);
            } else {
              bfr* dst = wsp<bfr>(p, OFF_P) + (size_t)row * 2304 + col;
              dst[0] = f2bf(v0); dst[2304] = f2bf(v1); dst[2 * 2304] = f2bf(v2); dst[3 * 2304] = f2bf(v3);
            }
          } else if (mode == EPI_RELU2) {
            bfr* dst = wsp<bfr>(p, OFF_ACT) + (size_t)row * 4096 + col;
            float t0 = fmaxf(v0, 0.f), t1 = fmaxf(v1, 0.f), t2 = fmaxf(v2, 0.f), t3 = fmaxf(v3, 0.f);
            dst[0] = f2bf(t0 * t0); dst[4096] = f2bf(t1 * t1); dst[2 * 4096] = f2bf(t2 * t2); dst[3 * 4096] = f2bf(t3 * t3);
          } else {
            const int ms = row < RL ? (row >> 13) : 2;
            const float gate = wsp<float>(p, OFF_MOD)[(layer * 3 + ms) * 6144 + gchunk * 1024 + col];
            float* hp = row < RL ? p.out + (size_t)row * 1024 + col : wsp<float>(p, OFF_HC) + (size_t)(row - RL) * 1024 + col;
            if (S > 1) {
              unsafeAtomicAdd(hp, gate * v0); unsafeAtomicAdd(hp + 1024, gate * v1);
              unsafeAtomicAdd(hp + 2048, gate * v2); unsafeAtomicAdd(hp + 3072, gate * v3);
            } else {
              hp[0] += gate * v0; hp[1024] += gate * v1; hp[2048] += gate * v2; hp[3072] += gate * v3;
            }
          }
        }
  }
}

DI float softplus_f(float x) { return x > 0.f ? x + log1pf(expf(-x)) : log1pf(expf(x)); }

DI void conv_dt_phase(const DP& p, int j) {
  const int tid = p.tidl, lane = tid & 63, wid = tid >> 6;
  const bfr* XBC = wsp<bfr>(p, OFF_XBC);
  bfr* XT = wsp<bfr>(p, OFF_XT); bfr* BN = wsp<bfr>(p, OFF_BN); bfr* BTt = wsp<bfr>(p, OFF_BT); bfr* CN = wsp<bfr>(p, OFF_CN);
  bfr* TT = (bfr*)smem;
  const float* cw = p.conv_w + (size_t)j * 5 * 2560;
  const float* cb = p.conv_b + (size_t)j * 2560;
  const int n_conv = 264 * 40, n_dt = 792;
  for (int u = p.bidl; u < n_conv + n_dt; u += gridDim.x) {
    if (u < n_conv) {
      const int tb = u / 40, cbk = u % 40, row0 = tb * 64, ch0 = cbk * 64;
      int pos0, len;
      if (row0 < RL) { pos0 = row0 & 8191; len = SEQ; } else { pos0 = (row0 - RL) & 255; len = CTX; }
      const int c8 = tid & 7, ch = ch0 + c8 * 8;
      float w[5][8], bias[8];
#pragma unroll
      for (int k = 0; k < 5; ++k) {
        float4 wa = *(const float4*)(cw + k * 2560 + ch), wb = *(const float4*)(cw + k * 2560 + ch + 4);
        w[k][0] = wa.x; w[k][1] = wa.y; w[k][2] = wa.z; w[k][3] = wa.w; w[k][4] = wb.x; w[k][5] = wb.y; w[k][6] = wb.z; w[k][7] = wb.w;
      }
      {
        float4 wa = *(const float4*)(cb + ch), wb = *(const float4*)(cb + ch + 4);
        bias[0] = wa.x; bias[1] = wa.y; bias[2] = wa.z; bias[3] = wa.w; bias[4] = wb.x; bias[5] = wb.y; bias[6] = wb.z; bias[7] = wb.w;
      }
#pragma unroll
      for (int ps = 0; ps < 2; ++ps) {
        const int tl = (tid >> 3) + 32 * ps, pos = pos0 + tl, row = row0 + tl;
        float a[8];
#pragma unroll
        for (int e = 0; e < 8; ++e) a[e] = bias[e];
#pragma unroll
        for (int k = 0; k < 5; ++k) {
          int pp = pos + k - 2;
          if (pp >= 0 && pp < len) {
            bf16x8 xv = *(const bf16x8*)(XBC + (size_t)(row + k - 2) * 2560 + ch);
#pragma unroll
            for (int e = 0; e < 8; ++e) a[e] += w[k][e] * bfs(xv[e]);
          }
        }
        bf16x8 o;
#pragma unroll
        for (int e = 0; e < 8; ++e) { float s = a[e] / (1.f + __expf(-a[e])); o[e] = (short)f2bf(s); }
        if (ch0 >= 2048) *(bf16x8*)(CN + (size_t)row * 512 + (ch - 2048)) = o;
        else if (ch0 >= 1536) *(bf16x8*)(BN + (size_t)row * 512 + (ch - 1536)) = o;
        if (ch0 < 2048) {
#pragma unroll
          for (int e = 0; e < 8; ++e) TT[(c8 * 8 + e) * 72 + tl] = (bfr)o[e];
        }
      }
      if (ch0 < 2048) {
        __syncthreads();
        const int chl = tid >> 2, tseg = (tid & 3) * 16;
        bfr* dst = (ch0 < 1536 ? XT + (size_t)(ch0 + chl) * R : BTt + (size_t)(ch0 - 1536 + chl) * R) + row0 + tseg;
        *(bf16x8*)dst = *(const bf16x8*)(TT + chl * 72 + tseg);
        *(bf16x8*)(dst + 8) = *(const bf16x8*)(TT + chl * 72 + tseg + 8);
        __syncthreads();
      }
    } else {
      const int item = (u - n_conv) * 4 + wid;
      const int head = item % 24; int rest = item / 24; const int dir = rest & 1; rest >>= 1; const int c = rest % NCH, b = rest / NCH;
      const int row0 = chunk_row0(b, c), col = dir * 24 + head;
      const float bias = p.dt_bias[j * 48 + col];
      const float a = -expf(p.a_log[j * 48 + col]);
      const float* DTRAW = wsp<float>(p, OFF_DTRAW);
      float dt[4], cs[4];
      float run = 0.f;
#pragma unroll
      for (int q = 0; q < 4; ++q) {
        dt[q] = softplus_f(DTRAW[(size_t)(row0 + lane * 4 + q) * 48 + col] + bias);
        run += dt[q] * a; cs[q] = run;
      }
      float x = run;
#pragma unroll
      for (int o = 1; o < 64; o <<= 1) { float t2 = __shfl_up(x, o); if (lane >= o) x += t2; }
      const float excl = x - run;
      const float total = __shfl(x, 63);
      float ac[4];
#pragma unroll
      for (int q = 0; q < 4; ++q) {
        float inc = excl + cs[q];
        ac[q] = dir == 0 ? inc : total - inc + dt[q] * a;
      }
      const size_t base = ((size_t)(((dir * 2 + b) * NCH + c) * 24 + head)) * 256 + lane * 4;
      *(float4*)(wsp<float>(p, OFF_DTV) + base) = make_float4(dt[0], dt[1], dt[2], dt[3]);
      *(float4*)(wsp<float>(p, OFF_ACUM) + base) = make_float4(ac[0], ac[1], ac[2], ac[3]);
    }
  }
}

DI bf16x8 scale8(bf16x8 a, const float* w) {
  return pack8(bfs(a[0]) * w[0], bfs(a[1]) * w[1], bfs(a[2]) * w[2], bfs(a[3]) * w[3],
               bfs(a[4]) * w[4], bfs(a[5]) * w[5], bfs(a[6]) * w[6], bfs(a[7]) * w[7]);
}

DI void s1_item(const DP& p, int item, int lane) {
  const int r = lane & 31, h = lane >> 5;
  const int head = item % 24; int rest = item / 24; const int dir = rest & 1; rest >>= 1; const int c = rest % NCH, b = rest / NCH;
  const int g = head / 6;
  const int row0 = chunk_row0(b, c);
  const size_t dbase = ((size_t)(((dir * 2 + b) * NCH + c) * 24 + head)) * 256;
  const float* dtv = wsp<float>(p, OFF_DTV) + dbase;
  const float* acm = wsp<float>(p, OFF_ACUM) + dbase;
  const float acend = dir == 0 ? acm[255] : acm[0];
  const bfr* XT = wsp<bfr>(p, OFF_XT); const bfr* BTt = wsp<bfr>(p, OFF_BT);
  bfr* HS = wsp<bfr>(p, OFF_HS) + ((size_t)(((dir * 2 + b) * NCH + c) * 24 + head)) * 8192;
#pragma unroll 1
  for (int pt = 0; pt < 2; ++pt) {
    f32x16 acc[4];
#pragma unroll
    for (int n = 0; n < 4; ++n) acc[n] = zero16();
#pragma unroll 1
    for (int kk = 0; kk < 16; ++kk) {
      const int s0 = kk * 16 + 8 * h;
      float4 d0 = *(const float4*)(dtv + s0), d1 = *(const float4*)(dtv + s0 + 4);
      float4 a0 = *(const float4*)(acm + s0), a1 = *(const float4*)(acm + s0 + 4);
      float w[8];
      w[0] = d0.x * __expf(acend - a0.x); w[1] = d0.y * __expf(acend - a0.y); w[2] = d0.z * __expf(acend - a0.z); w[3] = d0.w * __expf(acend - a0.w);
      w[4] = d1.x * __expf(acend - a1.x); w[5] = d1.y * __expf(acend - a1.y); w[6] = d1.z * __expf(acend - a1.z); w[7] = d1.w * __expf(acend - a1.w);
      bf16x8 af = scale8(*(const bf16x8*)(XT + (size_t)(head * 64 + pt * 32 + r) * R + row0 + s0), w);
#pragma unroll
      for (int nt = 0; nt < 4; ++nt) {
        bf16x8 bfv = *(const bf16x8*)(BTt + (size_t)(g * 128 + nt * 32 + r) * R + row0 + s0);
        acc[nt] = MFMA(af, bfv, acc[nt]);
      }
    }
#pragma unroll
    for (int nt = 0; nt < 4; ++nt)
#pragma unroll
      for (int i = 0; i < 16; ++i) HS[(pt * 32 + crow(i, h)) * 128 + nt * 32 + r] = f2bf(acc[nt][i]);
  }
}

DI void f1_item(const DP& p, int item, int lane) {
  const int r = lane & 31, h = lane >> 5;
  const int l2t = item & 1, m = (item >> 1) & 511, b = item >> 10;
  const bfr* ZRT = wsp<bfr>(p, OFF_ZRT) + (size_t)m * R + b * SEQ + l2t * 32 + r;
  const bfr* ZIT = wsp<bfr>(p, OFF_ZIT) + (size_t)m * R + b * SEQ + l2t * 32 + r;
  const bfr* C128 = wsp<bfr>(p, OFF_C128); const bfr* S128 = wsp<bfr>(p, OFF_S128);
  const float2* TW = wsp<float2>(p, OFF_TW);
  bfr* YR = wsp<bfr>(p, OFF_YR); bfr* YI = wsp<bfr>(p, OFF_YI);
  const int l2 = l2t * 32 + r;
#pragma unroll 1
  for (int mh = 0; mh < 2; ++mh) {
    f32x16 yr[2], yi[2];
#pragma unroll
    for (int i = 0; i < 2; ++i) { yr[i] = zero16(); yi[i] = zero16(); }
#pragma unroll 1
    for (int kk = 0; kk < 8; ++kk) {
      bf16x8 zr, zi, nzr;
#pragma unroll
      for (int jj = 0; jj < 8; ++jj) {
        int l1 = kk * 16 + 8 * h + jj;
        zr[jj] = (short)ZRT[l1 * 64]; zi[jj] = (short)ZIT[l1 * 64];
        nzr[jj] = (short)(zr[jj] ^ (short)0x8000);
      }
#pragma unroll
      for (int m2 = 0; m2 < 2; ++m2) {
        const int mt = mh * 2 + m2;
        bf16x8 ca = *(const bf16x8*)(C128 + (mt * 32 + r) * 128 + kk * 16 + 8 * h);
        bf16x8 sa = *(const bf16x8*)(S128 + (mt * 32 + r) * 128 + kk * 16 + 8 * h);
        yr[m2] = MFMA(ca, zr, yr[m2]); yr[m2] = MFMA(sa, zi, yr[m2]);
        yi[m2] = MFMA(ca, zi, yi[m2]); yi[m2] = MFMA(sa, nzr, yi[m2]);
      }
    }
#pragma unroll
    for (int m2 = 0; m2 < 2; ++m2)
#pragma unroll
      for (int i = 0; i < 16; ++i) {
        int k1 = (mh * 2 + m2) * 32 + crow(i, h);
        float2 t = TW[k1 * l2];
        float a = yr[m2][i], bb = yi[m2][i];
        size_t o = ((size_t)(b * 512 + m) * 128 + k1) * 64 + l2;
        YR[o] = f2bf(a * t.x + bb * t.y);
        YI[o] = f2bf(bb * t.x - a * t.y);
      }
  }
}

DI void f1c_item(const DP& p, int item, int lane) {
  const int r = lane & 31, h = lane >> 5;
  const int mt = item & 15, kt = (item >> 4) & 7, b = item >> 7;
  const int m = mt * 32 + r;
  const bfr* ZRT = wsp<bfr>(p, OFF_ZRT) + (size_t)m * R + RL + b * CTX;
  const bfr* ZIT = wsp<bfr>(p, OFF_ZIT) + (size_t)m * R + RL + b * CTX;
  const bfr* C256 = wsp<bfr>(p, OFF_C256) + (kt * 32 + r) * 256;
  const bfr* S256 = wsp<bfr>(p, OFF_S256) + (kt * 32 + r) * 256;
  f32x16 acc = zero16();
  for (int kk = 0; kk < 16; ++kk) {
    int o = kk * 16 + 8 * h;
    acc = MFMA(*(const bf16x8*)(C256 + o), *(const bf16x8*)(ZRT + o), acc);
    acc = MFMA(*(const bf16x8*)(S256 + o), *(const bf16x8*)(ZIT + o), acc);
  }
  bfr* MIX = wsp<bfr>(p, OFF_MIX);
#pragma unroll
  for (int i = 0; i < 16; ++i)
    MIX[(size_t)(RL + b * CTX + kt * 32 + crow(i, h)) * 2048 + m] = f2bf(acc[i] * (1.f / 128.f));
}

DI void s1f1_phase(const DP& p) {
  const int lane = p.tidl & 63;
  const int wg = p.bidl * 4 + (p.tidl >> 6), nw = gridDim.x * 4;
  const int n_s1 = 2 * NCH * 2 * 24, n_f1 = 2048, n_f1c = 256;
#pragma unroll 1
  for (int it = wg; it < n_s1 + n_f1 + n_f1c; it += nw) {
    if (it < n_s1) s1_item(p, it, lane);
    else if (it < n_s1 + n_f1) f1_item(p, it - n_s1, lane);
    else f1c_item(p, it - n_s1 - n_f1, lane);
  }
}

DI void f2_item(const DP& p, int item, int lane) {
  const int r = lane & 31, h = lane >> 5;
  const int mt16 = item & 15, k1 = (item >> 4) & 127, b = item >> 11;
  const int m = mt16 * 32 + r;
  const bfr* YR = wsp<bfr>(p, OFF_YR) + ((size_t)(b * 512 + m) * 128 + k1) * 64;
  const bfr* YI = wsp<bfr>(p, OFF_YI) + ((size_t)(b * 512 + m) * 128 + k1) * 64;
  const bfr* C64 = wsp<bfr>(p, OFF_C64); const bfr* S64 = wsp<bfr>(p, OFF_S64);
  f32x16 acc[2]; acc[0] = zero16(); acc[1] = zero16();
#pragma unroll
  for (int kk = 0; kk < 4; ++kk) {
    bf16x8 yr = *(const bf16x8*)(YR + kk * 16 + 8 * h), yi = *(const bf16x8*)(YI + kk * 16 + 8 * h);
#pragma unroll
    for (int t = 0; t < 2; ++t) {
      bf16x8 ca = *(const bf16x8*)(C64 + (t * 32 + r) * 64 + kk * 16 + 8 * h);
      bf16x8 sa = *(const bf16x8*)(S64 + (t * 32 + r) * 64 + kk * 16 + 8 * h);
      acc[t] = MFMA(ca, yr, acc[t]); acc[t] = MFMA(sa, yi, acc[t]);
    }
  }
  bfr* MIX = wsp<bfr>(p, OFF_MIX);
  const float scale = 0.001381067932f;
#pragma unroll
  for (int t = 0; t < 2; ++t)
#pragma unroll
    for (int i = 0; i < 16; ++i) {
      int k2 = t * 32 + crow(i, h);
      MIX[(size_t)(b * SEQ + k1 + 128 * k2) * 2048 + m] = f2bf(acc[t][i] * scale);
    }
}

DI void s2f2_phase(const DP& p) {
  const int gt = p.bidl * 256 + p.tidl, nt = gridDim.x * 256;
  bfr* HSb = wsp<bfr>(p, OFF_HS);
  const float* ACUM = wsp<float>(p, OFF_ACUM);
  for (int it = gt; it < 2 * 2 * 24 * 2048; it += nt) {
    const int e4 = it & 2047; const int rest = it >> 11; const int head = rest % 24, db = rest / 24, dir = db >> 1;
    float h0 = 0.f, h1 = 0.f, h2 = 0.f, h3 = 0.f;
    for (int step = 0; step < NCH; ++step) {
      const int c = dir == 0 ? step : (step == 0 ? 0 : NCH - step);
      const size_t ci = (size_t)((db * NCH + c) * 24 + head);
      bfr* hp = HSb + ci * 8192 + e4 * 4;
      bf16x4 sv = *(const bf16x4*)hp;
      const float cd = __expf(ACUM[ci * 256 + (dir == 0 ? 255 : 0)]);
      *(bf16x4*)hp = pack4(h0, h1, h2, h3);
      h0 = h0 * cd + bfs(sv[0]); h1 = h1 * cd + bfs(sv[1]); h2 = h2 * cd + bfs(sv[2]); h3 = h3 * cd + bfs(sv[3]);
    }
  }
  const int lane = p.tidl & 63;
  const int wg = p.bidl * 4 + (p.tidl >> 6), nw = gridDim.x * 4;
#pragma unroll 1
  for (int it = wg; it < 4096; it += nw) f2_item(p, it, lane);
}

DI void s3_item(const DP& p, int j, int item, int lane) {
  const int r = lane & 31, h = lane >> 5;
  const int g = item & 3, lt = (item >> 2) & 7; const int bc = item >> 5; const int c = bc % NCH, b = bc / NCH;
  const int row0 = chunk_row0(b, c);
  const int rowl = row0 + lt * 32 + r;
  const bfr* CN = wsp<bfr>(p, OFF_CN); const bfr* BN = wsp<bfr>(p, OFF_BN); const bfr* XT = wsp<bfr>(p, OFF_XT);
  const bfr* Z = wsp<bfr>(p, OFF_Z); bfr* MIX = wsp<bfr>(p, OFF_MIX);
  bf16x8 cf[8];
#pragma unroll
  for (int kk = 0; kk < 8; ++kk) cf[kk] = *(const bf16x8*)(CN + (size_t)rowl * 512 + g * 128 + kk * 16 + 8 * h);
  float sumsq = 0.f;
#pragma unroll 1
  for (int hh = 0; hh < 6; ++hh) {
    const int head = g * 6 + hh;
    const size_t cif = (size_t)(((0 * 2 + b) * NCH + c) * 24 + head), cib = (size_t)(((1 * 2 + b) * NCH + c) * 24 + head);
    const float* acf = wsp<float>(p, OFF_ACUM) + cif * 256; const float* acb = wsp<float>(p, OFF_ACUM) + cib * 256;
    const float* dtf = wsp<float>(p, OFF_DTV) + cif * 256; const float* dtb = wsp<float>(p, OFF_DTV) + cib * 256;
    const bfr* HSf = wsp<bfr>(p, OFF_HS) + cif * 8192; const bfr* HSbk = wsp<bfr>(p, OFF_HS) + cib * 8192;
    const float al_f = acf[lt * 32 + r], al_b = acb[lt * 32 + r];
    f32x16 acc[2];
    {
      f32x16 t0 = zero16(), t1 = zero16();
#pragma unroll
      for (int kk = 0; kk < 8; ++kk) {
        t0 = MFMA(*(const bf16x8*)(HSf + (r) * 128 + kk * 16 + 8 * h), cf[kk], t0);
        t1 = MFMA(*(const bf16x8*)(HSf + (32 + r) * 128 + kk * 16 + 8 * h), cf[kk], t1);
      }
      const float ef = __expf(al_f);
#pragma unroll
      for (int i = 0; i < 16; ++i) { acc[0][i] = t0[i] * ef; acc[1][i] = t1[i] * ef; }
      t0 = zero16(); t1 = zero16();
#pragma unroll
      for (int kk = 0; kk < 8; ++kk) {
        t0 = MFMA(*(const bf16x8*)(HSbk + (r) * 128 + kk * 16 + 8 * h), cf[kk], t0);
        t1 = MFMA(*(const bf16x8*)(HSbk + (32 + r) * 128 + kk * 16 + 8 * h), cf[kk], t1);
      }
      const float eb = __expf(al_b);
#pragma unroll
      for (int i = 0; i < 16; ++i) { acc[0][i] += t0[i] * eb; acc[1][i] += t1[i] * eb; }
    }
#pragma unroll 1
    for (int st = 0; st < 8; ++st) {
      f32x16 gt = zero16();
#pragma unroll
      for (int kk = 0; kk < 8; ++kk)
        gt = MFMA(*(const bf16x8*)(BN + (size_t)(row0 + st * 32 + r) * 512 + g * 128 + kk * 16 + 8 * h), cf[kk], gt);
#pragma unroll
      for (int dir = 0; dir < 2; ++dir) {
        if (dir == 0 ? (st > lt) : (st < lt)) continue;
        const float* acd = dir == 0 ? acf : acb; const float* dtd = dir == 0 ? dtf : dtb;
        const float al = dir == 0 ? al_f : al_b;
        f32x16 mm;
#pragma unroll
        for (int g4 = 0; g4 < 4; ++g4) {
          const int sb = st * 32 + 8 * g4 + 4 * h;
          float4 a4 = *(const float4*)(acd + sb), d4 = *(const float4*)(dtd + sb);
          const float av[4] = {a4.x, a4.y, a4.z, a4.w}, dv[4] = {d4.x, d4.y, d4.z, d4.w};
#pragma unroll
          for (int q = 0; q < 4; ++q) {
            const int sidx = sb + q, lidx = lt * 32 + r;
            const bool valid = dir == 0 ? (sidx <= lidx) : (sidx >= lidx);
            const float e = __expf(fminf(al - av[q], 0.f));
            mm[4 * g4 + q] = valid ? gt[4 * g4 + q] * dv[q] * e : 0.f;
          }
        }
#pragma unroll
        for (int s2 = 0; s2 < 2; ++s2) {
          bf16x8 pf = PACK_HALF(mm, s2);
#pragma unroll
          for (int pt = 0; pt < 2; ++pt) {
            const bfr* xp = XT + (size_t)(head * 64 + pt * 32 + r) * R + row0 + st * 32 + 16 * s2 + 4 * h;
            bf16x8 xf = join44(*(const bf16x4*)xp, *(const bf16x4*)(xp + 8));
            acc[pt] = MFMA(xf, pf, acc[pt]);
          }
        }
      }
    }
    const float dsk = p.d_skip[j * 24 + head];
#pragma unroll
    for (int pt = 0; pt < 2; ++pt)
#pragma unroll
      for (int g4 = 0; g4 < 4; ++g4) {
        const int pb = pt * 32 + 8 * g4 + 4 * h;
        bf16x4 zv = *(const bf16x4*)(Z + (size_t)rowl * 1536 + head * 64 + pb);
        float y[4];
#pragma unroll
        for (int q = 0; q < 4; ++q) {
          float xv = bf2f(XT[(size_t)(head * 64 + pb + q) * R + rowl]);
          float zz = bfs(zv[q]);
          float v = (acc[pt][4 * g4 + q] + dsk * xv) * (zz / (1.f + __expf(-zz)));
          sumsq += v * v; y[q] = v;
        }
        *(bf16x4*)(MIX + (size_t)rowl * 2048 + 512 + head * 64 + pb) = pack4(y[0], y[1], y[2], y[3]);
      }
  }
  const float tot = sumsq + __shfl_xor(sumsq, 32);
  const float sc = rsqrtf(tot * (1.f / 384.f) + 1e-6f);
  const float* ng = p.ssd_norm_g + (size_t)j * 1536;
#pragma unroll 1
  for (int hh = 0; hh < 6; ++hh) {
    const int head = g * 6 + hh;
#pragma unroll
    for (int pt = 0; pt < 2; ++pt)
#pragma unroll
      for (int g4 = 0; g4 < 4; ++g4) {
        const int pb = pt * 32 + 8 * g4 + 4 * h;
        bfr* mp = MIX + (size_t)rowl * 2048 + 512 + head * 64 + pb;
        bf16x4 yv = *(const bf16x4*)mp;
        float4 gg = *(const float4*)(ng + head * 64 + pb);
        *(bf16x4*)mp = pack4(bfs(yv[0]) * sc * gg.x, bfs(yv[1]) * sc * gg.y, bfs(yv[2]) * sc * gg.z, bfs(yv[3]) * sc * gg.w);
      }
  }
}

DI void s3_phase(const DP& p, int j) {
  const int lane = p.tidl & 63;
  const int wg = p.bidl * 4 + (p.tidl >> 6), nw = gridDim.x * 4;
#pragma unroll 1
  for (int it = wg; it < 2 * NCH * 8 * 4; it += nw) s3_item(p, j, it, lane);
}

DI void qkprep_phase(const DP& p, int j) {
  const int lane = p.tidl & 63;
  const int wg = p.bidl * 4 + (p.tidl >> 6), nw = gridDim.x * 4;
  const bfr* P = wsp<bfr>(p, OFF_P); bfr* QK = wsp<bfr>(p, OFF_QK);
  const float* ROPE = wsp<float>(p, OFF_ROPE);
  const int sub = lane >> 3, d0 = (lane & 7) * 8;
  for (int row = wg; row < R; row += nw) {
#pragma unroll
    for (int ps = 0; ps < 4; ++ps) {
      const int hs = ps * 8 + sub;
      const bool act = hs < 26;
      const int hsc = act ? hs : 25;
      const int col = hsc < 10 ? hsc * 64 : 768 + (hsc - 10) * 64;
      bf16x8 xv = *(const bf16x8*)(P + (size_t)row * 2304 + col + d0);
      float x[8]; float ss = 0.f;
#pragma unroll
      for (int e = 0; e < 8; ++e) { x[e] = bfs(xv[e]); ss += x[e] * x[e]; }
      ss += __shfl_xor(ss, 1); ss += __shfl_xor(ss, 2); ss += __shfl_xor(ss, 4);
      const float rs = rsqrtf(ss * (1.f / 64.f) + 1e-6f);
      const float* gv = hsc < 8 ? p.q_norm_win + j * 64 : hsc < 10 ? p.k_norm_win + j * 64 : hsc < 18 ? p.q_norm_na + j * 64 : p.k_norm_na + j * 64;
#pragma unroll
      for (int e = 0; e < 8; ++e) x[e] = x[e] * rs * gv[d0 + e];
      float pr[8];
#pragma unroll
      for (int e = 0; e < 8; ++e) pr[e] = __shfl_xor(x[e], 2);
      if (hsc < 10 && row < RL) {
        const int pos = row & 8191;
        const int axis = d0 >> 5;
        const int idx = axis == 0 ? (pos >> 6) : (pos & 63);
        const int f0 = d0 & 15;
        const bool second = (d0 & 16) != 0;
        const float* cp = ROPE + (axis * 128 + idx) * 16 + f0;
        const float* sp = cp + 4096;
#pragma unroll
        for (int e = 0; e < 8; ++e) {
          float cs = cp[e], sn = sp[e];
          x[e] = second ? (x[e] * cs + pr[e] * sn) : (x[e] * cs - pr[e] * sn);
        }
      }
      const bool isq = hsc < 8 || (hsc >= 10 && hsc < 18);
      const float qs = isq ? 0.125f : 1.f;
      if (act) *(bf16x8*)(QK + (size_t)row * 1664 + hsc * 64 + d0) = pack8(x[0] * qs, x[1] * qs, x[2] * qs, x[3] * qs, x[4] * qs, x[5] * qs, x[6] * qs, x[7] * qs);
    }
  }
}

template <class MF>
DI void attn_tile(f32x16 (&o)[2], float& m, float& l, const bf16x8 (&q)[4], const bfr* __restrict__ Kt, const bfr* __restrict__ Vt,
                  int r, int h, MF mf) {
  f32x16 s = zero16();
#pragma unroll
  for (int kk = 0; kk < 4; ++kk) s = MFMA(*(const bf16x8*)(Kt + (size_t)r * 1664 + kk * 16 + 8 * h), q[kk], s);
  float tmax = -3.0e38f;
#pragma unroll
  for (int i = 0; i < 16; ++i) { s[i] = mf(s[i], crow(i, h)); tmax = fmaxf(tmax, s[i]); }
  tmax = fmaxf(tmax, __shfl_xor(tmax, 32));
  const float mn = fmaxf(m, tmax);
  const float alpha = __expf(m - mn);
  float ps = 0.f;
#pragma unroll
  for (int i = 0; i < 16; ++i) { s[i] = __expf(s[i] - mn); ps += s[i]; }
  l = l * alpha + ps; m = mn;
#pragma unroll
  for (int i = 0; i < 16; ++i) { o[0][i] *= alpha; o[1][i] *= alpha; }
#pragma unroll
  for (int s2 = 0; s2 < 2; ++s2) {
    bf16x8 pf = PACK_HALF(s, s2);
#pragma unroll
    for (int dt = 0; dt < 2; ++dt) {
      const bfr* vp = Vt + (size_t)(dt * 32 + r) * R + 16 * s2 + 4 * h;
      bf16x8 vf = join44(*(const bf16x4*)vp, *(const bf16x4*)(vp + 8));
      o[dt] = MFMA(vf, pf, o[dt]);
    }
  }
}

DI void attn_item(const DP& p, int j, int item, int lane) {
  const int r = lane & 31, h = lane >> 5;
  const bfr* QK = wsp<bfr>(p, OFF_QK); const bfr* VT = wsp<bfr>(p, OFF_VT); bfr* MIX = wsp<bfr>(p, OFF_MIX);
  int kind, b, hd, qt;
  if (item < 4096) { kind = 0; qt = item & 255; hd = (item >> 8) & 7; b = item >> 11; }
  else if (item < 8192) { int v = item - 4096; kind = 1; qt = v & 255; hd = (v >> 8) & 7; b = v >> 11; }
  else if (item < 8320) { int v = item - 8192; kind = 2; qt = v & 7; hd = (v >> 3) & 7; b = v >> 6; }
  else { int v = item - 8320; kind = 3; qt = v & 7; hd = (v >> 3) & 7; b = v >> 6; }
  const bool win = (kind == 0 || kind == 2);
  const bool lat = kind < 2;
  const int q_row0 = lat ? b * SEQ + qt * 32 : RL + b * CTX + qt * 32;
  const int qcol = win ? hd * 64 : (10 + hd) * 64;
  const int kcol = win ? (8 + (hd >> 2)) * 64 : (18 + hd) * 64;
  const bfr* Vb = win ? VT + (size_t)((hd >> 2) * 64) * R : VT + (size_t)(128 + hd * 64) * R;
  bf16x8 q[4];
#pragma unroll
  for (int kk = 0; kk < 4; ++kk) q[kk] = *(const bf16x8*)(QK + (size_t)(q_row0 + r) * 1664 + qcol + kk * 16 + 8 * h);
  f32x16 o[2]; o[0] = zero16(); o[1] = zero16();
  float m = -1.0e30f, l = 0.f;
  if (win) { m = p.sink_win[j * 8 + hd]; l = h == 0 ? 1.f : 0.f; }
#pragma unroll 1
  for (int t = 0; t < 8; ++t) {
    const int k0 = RL + b * CTX + t * 32;
    attn_tile(o, m, l, q, QK + (size_t)k0 * 1664 + kcol, Vb + k0, r, h, [](float s, int) { return s; });
  }
  if (kind == 0) {
    const int lo = qt - 4 < 0 ? 0 : qt - 4, hi = qt + 4 > 255 ? 255 : qt + 4;
    const int qpos = qt * 32 + r;
#pragma unroll 1
    for (int kt = lo; kt <= hi; ++kt) {
      const int k0 = b * SEQ + kt * 32;
      const int kp0 = kt * 32;
      attn_tile(o, m, l, q, QK + (size_t)k0 * 1664 + kcol, Vb + k0, r, h, [=](float s, int key) {
        int dd = qpos - (kp0 + key); dd = dd < 0 ? -dd : dd;
        return dd <= 128 ? s : -1.0e30f;
      });
    }
  } else if (kind == 1) {
    const int gr = qt >> 1, half = qt & 1;
    const int w = half * 32 + r;
    int cs = w - 8; cs = cs < 0 ? 0 : (cs > 48 ? 48 : cs);
    int kr0 = gr - 4; kr0 = kr0 < 0 ? 0 : (kr0 > 120 ? 120 : kr0);
    const float* rpb = p.rpb_na + (size_t)j * 8 * 15 * 31 + hd * 15 * 31;
#pragma unroll 1
    for (int kk = 0; kk < 8; ++kk) {
      const int krow = kr0 + kk;
      const float* rp = rpb + (krow - gr + 7) * 31;
#pragma unroll 1
      for (int ch = 0; ch < 2; ++ch) {
        const int k0 = b * SEQ + krow * 64 + ch * 32;
        attn_tile(o, m, l, q, QK + (size_t)k0 * 1664 + kcol, Vb + k0, r, h, [=](float s, int key) {
          int u = ch * 32 + key;
          int co = u - w + 15; co = co < 0 ? 0 : (co > 30 ? 30 : co);
          bool valid = (u >= cs) && (u < cs + 16);
          return valid ? s + rp[co] : -1.0e30f;
        });
      }
    }
  }
  const float lt = l + __shfl_xor(l, 32);
  const float inv = 1.f / lt;
  const int ocol = win ? hd * 64 : 512 + hd * 64;
#pragma unroll
  for (int dt = 0; dt < 2; ++dt)
#pragma unroll
    for (int g4 = 0; g4 < 4; ++g4) {
      const int d = dt * 32 + 8 * g4 + 4 * h;
      *(bf16x4*)(MIX + (size_t)(q_row0 + r) * 1024 + ocol + d) =
          pack4(o[dt][4 * g4] * inv, o[dt][4 * g4 + 1] * inv, o[dt][4 * g4 + 2] * inv, o[dt][4 * g4 + 3] * inv);
    }
}

DI void attn_phase(const DP& p, int j) {
  const int lane = p.tidl & 63;
  const int wg = p.bidl * 4 + (p.tidl >> 6), nw = gridDim.x * 4;
#pragma unroll 1
  for (int it = wg; it < 8448; it += nw) attn_item(p, j, it, lane);
}

DI void run_phase(const DP& p, int ph) {
  if (ph == 0) { phase0(p); return; }
  int q = ph - 1, layer, lp;
  if (q < 10) { layer = 0; lp = q; } else if (q < 18) { layer = 1; lp = q - 10; } else if (q < 28) { layer = 2; lp = q - 18; } else { layer = 3; lp = q - 28; }
  const int j = layer >> 1;
  const bool even = (layer & 1) == 0;
  int op, gsel = 0;
  if (even) {
    op = (int)((0x2272654321ull >> (4 * lp)) & 15ull); gsel = (int)((0x3201000000ull >> (4 * lp)) & 15ull);
  } else {
    op = (int)((0x22729821ull >> (4 * lp)) & 15ull); gsel = (int)((0x32010000ull >> (4 * lp)) & 15ull);
  }
  if (op == 1) wconv_phase(p, layer);
  if (op == 1 || op == 7) {
    const bool first = op == 1;
    norm_phase(p, layer, (first ? p.norm_mix_g : p.norm_ff_g) + layer * 1024, first ? 0 : 3, first ? 1 : 4);
  } else if (op == 2) {
    int mode, lda, N, K, S, gch; size_t offA, offB;
    if (gsel == 0) { mode = even ? EPI_EVEN_IN : EPI_ODD_IN; offA = OFF_MIX; lda = 1024; offB = OFF_WIN; N = even ? 5168 : 2304; K = 1024; S = 1; gch = 0; }
    else if (gsel == 1) { mode = EPI_RESID; offA = OFF_MIX; lda = even ? 2048 : 1024; offB = OFF_WOUT; N = 1024; K = even ? 2048 : 1024; S = 2; gch = 2; }
    else if (gsel == 2) { mode = EPI_RELU2; offA = OFF_MIX; lda = 1024; offB = OFF_WFF1; N = 4096; K = 1024; S = 1; gch = 0; }
    else { mode = EPI_RESID; offA = OFF_ACT; lda = 4096; offB = OFF_WFF2; N = 1024; K = 4096; S = 4; gch = 5; }
    gemm_phase(p, mode, wsp<bfr>(p, offA), lda, wsp<bfr>(p, offB), N, K, S, layer, gch);
  } else if (op == 3) conv_dt_phase(p, j);
  else if (op == 4) s1f1_phase(p);
  else if (op == 5) s2f2_phase(p);
  else if (op == 6) s3_phase(p, j);
  else if (op == 8) qkprep_phase(p, j);
  else if (op == 9) attn_phase(p, j);
}

__global__ void __launch_bounds__(256, 2) mega(Params p, int ph0, int ph1) {
  cg::grid_group grid = cg::this_grid();
#pragma unroll 1
  for (int ph = ph0; ph < ph1; ++ph) {
    DP q;
    (Params&)q = p;
    int t = threadIdx.x, bb = blockIdx.x;
    asm volatile("" : "+v"(t));
    asm volatile("" : "+s"(bb));
    int z0;
    asm volatile("s_mov_b32 %0, 0" : "=s"(z0));
    q.ws = p.ws + z0;
    q.out = p.out + z0;
    q.tidl = t; q.bidl = bb;
    run_phase(q, ph);
    if (ph + 1 < ph1) grid.sync();
  }
}

extern "C" void kernel_launch(void* const* d_in, const int* in_sizes, int n_in, void* d_out, int out_size, void* d_ws,
                              size_t ws_size, hipStream_t stream) {
  static int grid_blocks = 0;
  if (!grid_blocks) {
    int dev = 0, cus = 0, per_cu = 0;
    hipGetDevice(&dev);
    hipDeviceGetAttribute(&cus, hipDeviceAttributeMultiprocessorCount, dev);
    hipOccupancyMaxActiveBlocksPerMultiprocessor(&per_cu, mega, 256, 0);
    if (per_cu > 2) per_cu = 2;
    if (per_cu < 1) per_cu = 1;
    grid_blocks = cus * per_cu;
  }
  Params p{};
  const float** pp = (const float**)&p;
  for (int i = 0; i < 26; ++i) pp[i] = (const float*)d_in[i];
  p.out = (float*)d_out;
  p.ws = (unsigned char*)d_ws;
  if (ws_size < WS_TOTAL) fprintf(stderr, "workspace too small: %zu < %zu\n", ws_size, (size_t)WS_TOTAL);
#if MULTI_LAUNCH
  for (int ph = 0; ph < NPHASE; ++ph) {
    int a = ph, b = ph + 1;
    void* args[] = {&p, &a, &b};
    hipLaunchCooperativeKernel((void*)mega, dim3(grid_blocks), dim3(256), args, 0, stream);
  }
#else
  int a = 0, b = NPHASE;
  void* args[] = {&p, &a, &b};
  hipError_t e = hipLaunchCooperativeKernel((void*)mega, dim3(grid_blocks), dim3(256), args, 0, stream);
  if (e != hipSuccess) fprintf(stderr, "cooperative launch failed: %s (grid %d)\n", hipGetErrorString(e), grid_blocks);
#endif
}
```

```cpp
#include <hip/hip_runtime.h>
#include <hip/hip_cooperative_groups.h>
#include <cstdio>
namespace cg = cooperative_groups;

typedef unsigned short bfr;
typedef __attribute__((ext_vector_type(8))) short bf16x8;
typedef __attribute__((ext_vector_type(4))) short bf16x4;
typedef __attribute__((ext_vector_type(16))) float f32x16;
#define DI __device__ __forceinline__
#define MFMA(a, b, c) __builtin_amdgcn_mfma_f32_32x32x16_bf16((a), (b), (c), 0, 0, 0)

#ifndef MULTI_LAUNCH
#define MULTI_LAUNCH 0
#endif

constexpr int RL = 16384, R = 16896, SEQ = 8192, CTX = 256;
constexpr int NCH = 33, CL = 256;
constexpr int NPHASE = 37;

constexpr size_t al(size_t x) { return (x + 255) & ~size_t(255); }
constexpr size_t OFF_HC = 0;
constexpr size_t OFF_MOD = OFF_HC + al(512 * 1024 * 4);
constexpr size_t OFF_TW = OFF_MOD + al(4 * 3 * 6144 * 4);
constexpr size_t OFF_C128 = OFF_TW + al(8192 * 8);
constexpr size_t OFF_S128 = OFF_C128 + al(128 * 128 * 2);
constexpr size_t OFF_C64 = OFF_S128 + al(128 * 128 * 2);
constexpr size_t OFF_S64 = OFF_C64 + al(64 * 64 * 2);
constexpr size_t OFF_C256 = OFF_S64 + al(64 * 64 * 2);
constexpr size_t OFF_S256 = OFF_C256 + al(256 * 256 * 2);
constexpr size_t OFF_ROPE = OFF_S256 + al(256 * 256 * 2);
constexpr size_t OFF_DTV = OFF_ROPE + al(2 * 2 * 128 * 16 * 4);
constexpr size_t DT_BYTES = (size_t)2 * 2 * NCH * 24 * 256 * 4;
constexpr size_t OFF_ACUM = OFF_DTV + al(DT_BYTES);
constexpr size_t OFF_WIN = OFF_ACUM + al(DT_BYTES);
constexpr size_t OFF_WOUT = OFF_WIN + al((size_t)5248 * 1024 * 2);
constexpr size_t OFF_WFF1 = OFF_WOUT + al((size_t)1024 * 2048 * 2);
constexpr size_t OFF_WFF2 = OFF_WFF1 + al((size_t)4096 * 1024 * 2);
constexpr size_t OFF_MIX = OFF_WFF2 + al((size_t)4096 * 1024 * 2);
constexpr size_t OFF_BIG = OFF_MIX + al((size_t)R * 2048 * 2);
constexpr size_t OFF_Z = OFF_BIG;
constexpr size_t OFF_ZRT = OFF_Z + (size_t)R * 1536 * 2;
constexpr size_t OFF_ZIT = OFF_ZRT + (size_t)512 * R * 2;
constexpr size_t OFF_XBC = OFF_ZIT + (size_t)512 * R * 2;
constexpr size_t OFF_DTRAW = OFF_XBC + (size_t)R * 2560 * 2;
constexpr size_t BIG_END = OFF_DTRAW + (size_t)R * 48 * 4;
constexpr size_t OFF_HS = OFF_XBC;
constexpr size_t HS_BYTES = (size_t)2 * 2 * NCH * 24 * 8192 * 2;
constexpr size_t OFF_YR = OFF_HS + HS_BYTES;
constexpr size_t OFF_YI = OFF_YR + (size_t)2 * 512 * 128 * 64 * 2;
static_assert(OFF_YI + (size_t)2 * 512 * 128 * 64 * 2 <= OFF_DTRAW, "fft scratch overflows");
constexpr size_t OFF_ACT = OFF_BIG;
static_assert((size_t)R * 4096 * 2 <= BIG_END - OFF_BIG, "act overflows");
constexpr size_t OFF_P = OFF_BIG;
constexpr size_t OFF_VT = OFF_P + (size_t)R * 2304 * 2;
constexpr size_t OFF_QK = OFF_VT + (size_t)640 * R * 2;
static_assert(OFF_QK + (size_t)R * 1664 * 2 <= BIG_END, "odd overflows");
constexpr size_t OFF_XT = al(BIG_END);
constexpr size_t OFF_BN = OFF_XT + (size_t)1536 * R * 2;
constexpr size_t OFF_BT = OFF_BN + (size_t)R * 512 * 2;
constexpr size_t OFF_CN = OFF_BT + (size_t)512 * R * 2;
constexpr size_t OFF_BAR = al(OFF_CN + (size_t)R * 512 * 2);
constexpr size_t WS_TOTAL = OFF_BAR + 16384;
static_assert(WS_TOTAL <= 402653184ull, "workspace too large");

struct Params {
  const float *x, *c, *ctx, *c_ctx, *w_mod, *b_mod, *norm_mix_g, *norm_ff_g, *w_ff1, *w_ff2;
  const float *w_in_even, *conv_w, *conv_b, *dt_bias, *a_log, *d_skip, *ssd_norm_g, *w_out_even;
  const float *w_in_odd, *q_norm_win, *k_norm_win, *sink_win, *q_norm_na, *k_norm_na, *rpb_na, *w_out_odd;
  float* out;
  unsigned char* ws;
};

struct DP : Params { int tidl, bidl; };

__shared__ __attribute__((aligned(16))) unsigned char smem[73728];

DI bfr f2bf(float x) { unsigned u = __float_as_uint(x); u += 0x7fffu + ((u >> 16) & 1u); return (bfr)(u >> 16); }
DI float bf2f(bfr b) { return __uint_as_float(((unsigned)b) << 16); }
DI float bfs(short s) { return __uint_as_float(((unsigned)(unsigned short)s) << 16); }
DI int crow(int i, int h) { return (i & 3) + 8 * (i >> 2) + 4 * h; }
DI f32x16 zero16() { f32x16 z; for (int i = 0; i < 16; ++i) z[i] = 0.f; return z; }
DI bf16x8 pack8(float a0, float a1, float a2, float a3, float a4, float a5, float a6, float a7) {
  bf16x8 v;
  v[0] = (short)f2bf(a0); v[1] = (short)f2bf(a1); v[2] = (short)f2bf(a2); v[3] = (short)f2bf(a3);
  v[4] = (short)f2bf(a4); v[5] = (short)f2bf(a5); v[6] = (short)f2bf(a6); v[7] = (short)f2bf(a7);
  return v;
}
DI bf16x4 pack4(float a0, float a1, float a2, float a3) {
  bf16x4 v; v[0] = (short)f2bf(a0); v[1] = (short)f2bf(a1); v[2] = (short)f2bf(a2); v[3] = (short)f2bf(a3); return v;
}
#define PACK_HALF(s, s2) pack8(s[8 * (s2)], s[8 * (s2) + 1], s[8 * (s2) + 2], s[8 * (s2) + 3], s[8 * (s2) + 4], s[8 * (s2) + 5], s[8 * (s2) + 6], s[8 * (s2) + 7])
DI bf16x8 join44(bf16x4 lo, bf16x4 hi) { return __builtin_shufflevector(lo, hi, 0, 1, 2, 3, 4, 5, 6, 7); }
DI int chunk_row0(int b, int c) { return c == 0 ? RL + b * CTX : b * SEQ + (c - 1) * CL; }

DI void sincos_turn(double f, float& s, float& c) {
  f -= rint(f);
  double x = f * 6.283185307179586476925;
  double x2 = x * x, ss = 1.0, cc = 1.0;
#pragma unroll
  for (int k = 13; k >= 1; --k) {
    ss = 1.0 - x2 / (double)((2 * k) * (2 * k + 1)) * ss;
    cc = 1.0 - x2 / (double)((2 * k - 1) * (2 * k)) * cc;
  }
  s = (float)(x * ss); c = (float)cc;
}

template <class T> DI T* wsp(const DP& p, size_t off) { return (T*)(p.ws + off); }

DI void phase0(const DP& p) {
  const int tid = p.tidl, bid = p.bidl, G = gridDim.x;
  float* lds = (float*)smem;
  float* MOD = wsp<float>(p, OFF_MOD);
  for (int u = bid; u < 384; u += G) {
    int layer = u / 96, cb = u % 96;
    for (int i = tid; i < 3072; i += 256) {
      int v = i >> 10, k = i & 1023;
      float c = v < 2 ? p.c[v * 1024 + k] : p.c_ctx[k];
      lds[i] = c / (1.f + expf(-c));
    }
    __syncthreads();
    int kq = tid >> 6, cc = tid & 63, col = cb * 64 + cc;
    const float* w = p.w_mod + (size_t)layer * 1024 * 6144 + col;
    float a0 = 0, a1 = 0, a2 = 0;
    for (int k = kq * 256; k < kq * 256 + 256; ++k) {
      float wv = w[(size_t)k * 6144];
      a0 += lds[k] * wv; a1 += lds[1024 + k] * wv; a2 += lds[2048 + k] * wv;
    }
    float* red = lds + 3072;
    red[(kq * 3 + 0) * 64 + cc] = a0; red[(kq * 3 + 1) * 64 + cc] = a1; red[(kq * 3 + 2) * 64 + cc] = a2;
    __syncthreads();
    if (tid < 192) {
      int v = tid >> 6;
      float s = red[(0 * 3 + v) * 64 + cc] + red[(1 * 3 + v) * 64 + cc] + red[(2 * 3 + v) * 64 + cc] + red[(3 * 3 + v) * 64 + cc];
      MOD[(layer * 3 + v) * 6144 + col] = s + p.b_mod[layer * 6144 + col];
    }
    __syncthreads();
  }
  const int gt = bid * 256 + tid, nt = G * 256;
  {
    const float4* xs = (const float4*)p.x; float4* od = (float4*)p.out;
    for (int i = gt; i < RL * 256; i += nt) od[i] = xs[i];
    const float4* cs = (const float4*)p.ctx; float4* hd = wsp<float4>(p, OFF_HC);
    for (int i = gt; i < 512 * 256; i += nt) hd[i] = cs[i];
  }
  float2* TW = wsp<float2>(p, OFF_TW);
  for (int i = gt; i < 8192; i += nt) { float s, c; sincos_turn((double)i / 8192.0, s, c); TW[i] = make_float2(c, s); }
  bfr* C128 = wsp<bfr>(p, OFF_C128); bfr* S128 = wsp<bfr>(p, OFF_S128);
  for (int i = gt; i < 128 * 128; i += nt) { int a = i >> 7, b = i & 127; float s, c; sincos_turn((double)((a * b) & 127) / 128.0, s, c); C128[i] = f2bf(c); S128[i] = f2bf(s); }
  bfr* C64 = wsp<bfr>(p, OFF_C64); bfr* S64 = wsp<bfr>(p, OFF_S64);
  for (int i = gt; i < 64 * 64; i += nt) { int a = i >> 6, b = i & 63; float s, c; sincos_turn((double)((a * b) & 63) / 64.0, s, c); C64[i] = f2bf(c); S64[i] = f2bf(s); }
  bfr* C256 = wsp<bfr>(p, OFF_C256); bfr* S256 = wsp<bfr>(p, OFF_S256);
  for (int i = gt; i < 256 * 256; i += nt) { int a = i >> 8, b = i & 255; float s, c; sincos_turn((double)((a * b) & 255) / 256.0, s, c); C256[i] = f2bf(c); S256[i] = f2bf(s); }
  float* ROPE = wsp<float>(p, OFF_ROPE);
  for (int i = gt; i < 2 * 128 * 16; i += nt) {
    int f = i & 15, idx = (i >> 4) & 127;
    float ang = (float)idx * (float)exp(-(double)f * 0.5756462732485115);
    float s, c; sincos_turn((double)ang / 6.283185307179586476925, s, c);
    ROPE[i] = c; ROPE[4096 + i] = s;
  }
}

DI void tcvt_unit(const float* __restrict__ src, int ld, int c0, int ncols, int K, bfr* __restrict__ dst, int dr0, int u, int tid) {
  const int ntk = K >> 6;
  const int tn = u / ntk, tk = u % ntk, k0 = tk * 64, nb = tn * 64;
  bfr* T = (bfr*)smem;
#pragma unroll
  for (int i = 0; i < 4; ++i) {
    int kk = (tid >> 4) + 16 * i, n4 = (tid & 15) * 4;
    float4 v = make_float4(0.f, 0.f, 0.f, 0.f);
    if (nb + n4 < ncols) v = *(const float4*)(src + (size_t)(k0 + kk) * ld + c0 + nb + n4);
    T[(n4 + 0) * 72 + kk] = f2bf(v.x); T[(n4 + 1) * 72 + kk] = f2bf(v.y);
    T[(n4 + 2) * 72 + kk] = f2bf(v.z); T[(n4 + 3) * 72 + kk] = f2bf(v.w);
  }
  __syncthreads();
  {
    int n = tid >> 2, kseg = (tid & 3) * 16;
    if (nb + n < ncols) {
      bfr* d = dst + (size_t)(dr0 + nb + n) * K + k0 + kseg;
      *(bf16x8*)d = *(const bf16x8*)(T + n * 72 + kseg);
      *(bf16x8*)(d + 8) = *(const bf16x8*)(T + n * 72 + kseg + 8);
    }
  }
  __syncthreads();
}

DI void wconv_phase(const DP& p, int layer) {
  const int tid = p.tidl;
  const int j = layer >> 1;
  bfr* WIN = wsp<bfr>(p, OFF_WIN); bfr* WOUT = wsp<bfr>(p, OFF_WOUT);
  bfr* WFF1 = wsp<bfr>(p, OFF_WFF1); bfr* WFF2 = wsp<bfr>(p, OFF_WFF2);
  const float* ff1 = p.w_ff1 + (size_t)layer * 1024 * 4096;
  const float* ff2 = p.w_ff2 + (size_t)layer * 4096 * 1024;
  float* cst = (float*)(smem + 12288);
  if (tid < 64) { float s, c; sincos_turn((double)tid / 64.0, s, c); cst[tid] = c; cst[64 + tid] = s; }
  __syncthreads();
  if ((layer & 1) == 0) {
    const float* win = p.w_in_even + (size_t)j * 1024 * 4656;
    const float* wout = p.w_out_even + (size_t)j * 2048 * 1024;
    const int n_in = 65 * 16, n_out = 16 * 32, n_f1 = 64 * 16, n_f2 = 16 * 64, n_fold = 2048;
    const int total = n_in + n_out + n_f1 + n_f2 + n_fold;
    for (int u = p.bidl; u < total; u += gridDim.x) {
      int v = u;
      if (v < n_in) { tcvt_unit(win, 4656, 512, 4144, 1024, WIN, 1024, v, tid); continue; }
      v -= n_in;
      if (v < n_out) { tcvt_unit(wout, 1024, 0, 1024, 2048, WOUT, 0, v, tid); continue; }
      v -= n_out;
      if (v < n_f1) { tcvt_unit(ff1, 4096, 0, 4096, 1024, WFF1, 0, v, tid); continue; }
      v -= n_f1;
      if (v < n_f2) { tcvt_unit(ff2, 1024, 0, 1024, 4096, WFF2, 0, v, tid); continue; }
      v -= n_f2;
      {
        int ch = v >> 2, kb = v & 3, k = kb * 256 + tid, g = ch >> 6, m = ch & 63;
        const float* wr = win + (size_t)k * 4656 + g * 64;
        float sc = 0.f, ss = 0.f;
        for (int jj = 0; jj < 64; ++jj) { float w = wr[jj]; int idx = (m * jj) & 63; sc += w * cst[idx]; ss += w * cst[64 + idx]; }
        WIN[(size_t)ch * 1024 + k] = f2bf(sc);
        WIN[(size_t)(512 + ch) * 1024 + k] = f2bf(-ss);
      }
    }
  } else {
    const float* win = p.w_in_odd + (size_t)j * 1024 * 2304;
    const float* wout = p.w_out_odd + (size_t)j * 1024 * 1024;
    const int n_in = 36 * 16, n_out = 16 * 16, n_f1 = 64 * 16, n_f2 = 16 * 64;
    const int total = n_in + n_out + n_f1 + n_f2;
    for (int u = p.bidl; u < total; u += gridDim.x) {
      int v = u;
      if (v < n_in) { tcvt_unit(win, 2304, 0, 2304, 1024, WIN, 0, v, tid); continue; }
      v -= n_in;
      if (v < n_out) { tcvt_unit(wout, 1024, 0, 1024, 1024, WOUT, 0, v, tid); continue; }
      v -= n_out;
      if (v < n_f1) { tcvt_unit(ff1, 4096, 0, 4096, 1024, WFF1, 0, v, tid); continue; }
      v -= n_f1;
      tcvt_unit(ff2, 1024, 0, 1024, 4096, WFF2, 0, v, tid);
    }
  }
}

DI void norm_phase(const DP& p, int layer, const float* __restrict__ gvec, int shc, int scc) {
  const int lane = p.tidl & 63;
  const int wg = p.bidl * 4 + (p.tidl >> 6), nw = gridDim.x * 4;
  const float* MOD = wsp<float>(p, OFF_MOD);
  const float* HC = wsp<float>(p, OFF_HC);
  bfr* U = wsp<bfr>(p, OFF_MIX);
  for (int row = wg; row < R; row += nw) {
    const float* hp = row < RL ? p.out + (size_t)row * 1024 : HC + (size_t)(row - RL) * 1024;
    const int ms = row < RL ? (row >> 13) : 2;
    const float* md = MOD + (layer * 3 + ms) * 6144;
    float4 v[4]; float ss = 0.f;
#pragma unroll
    for (int i = 0; i < 4; ++i) {
      v[i] = *(const float4*)(hp + i * 256 + lane * 4);
      ss += v[i].x * v[i].x + v[i].y * v[i].y + v[i].z * v[i].z + v[i].w * v[i].w;
    }
#pragma unroll
    for (int o = 32; o >= 1; o >>= 1) ss += __shfl_xor(ss, o);
    const float rs = rsqrtf(ss * (1.f / 1024.f) + 1e-6f);
#pragma unroll
    for (int i = 0; i < 4; ++i) {
      int col = i * 256 + lane * 4;
      float4 g = *(const float4*)(gvec + col);
      float4 sc = *(const float4*)(md + scc * 1024 + col);
      float4 sh = *(const float4*)(md + shc * 1024 + col);
      bf16x4 o = pack4(v[i].x * rs * g.x * (1.f + sc.x) + sh.x, v[i].y * rs * g.y * (1.f + sc.y) + sh.y,
                       v[i].z * rs * g.z * (1.f + sc.z) + sh.z, v[i].w * rs * g.w * (1.f + sc.w) + sh.w);
      *(bf16x4*)(U + (size_t)row * 1024 + col) = o;
    }
  }
}

enum { EPI_EVEN_IN = 0, EPI_ODD_IN = 1, EPI_RELU2 = 2, EPI_RESID = 3 };

DI void gemm_phase(const DP& p, int mode, const bfr* __restrict__ A, int lda, const bfr* __restrict__ Bt,
                   int N, int K, int S, int layer, int gchunk) {
  const int tid = p.tidl, lane = tid & 63, wid = tid >> 6, r = lane & 31, h = lane >> 5;
  const int wm = wid >> 1, wn = wid & 1;
  const int nN = (N + 127) >> 7, nM = R / 128;
  const int Ks = K / S, nk = Ks >> 6;
  const int units = nM * nN * S;
  bfr* sm = (bfr*)smem;
  const int lrow = tid >> 3, lc = (tid & 7) * 8;
  for (int u = p.bidl; u < units; u += gridDim.x) {
    const int ks = u % S; const int t = u / S; const int tn = t % nN, tm = t / nN;
    const int m0 = tm * 128, n0 = tn * 128, kbase = ks * Ks;
    f32x16 acc[2][2];
    acc[0][0] = zero16(); acc[0][1] = zero16(); acc[1][0] = zero16(); acc[1][1] = zero16();
    const bfr* Ag = A + (size_t)(m0 + lrow) * lda + kbase + lc;
    const bfr* Bg = Bt + (size_t)(n0 + lrow) * K + kbase + lc;
    bf16x8 ra[4], rb[4];
#pragma unroll
    for (int i = 0; i < 4; ++i) {
      ra[i] = *(const bf16x8*)(Ag + (size_t)(32 * i) * lda);
      rb[i] = *(const bf16x8*)(Bg + (size_t)(32 * i) * K);
    }
#pragma unroll
    for (int i = 0; i < 4; ++i) {
      *(bf16x8*)(sm + (lrow + 32 * i) * 72 + lc) = ra[i];
      *(bf16x8*)(sm + 9216 + (lrow + 32 * i) * 72 + lc) = rb[i];
    }
    __syncthreads();
    for (int kt = 0; kt < nk; ++kt) {
      if (kt + 1 < nk) {
#pragma unroll
        for (int i = 0; i < 4; ++i) {
          ra[i] = *(const bf16x8*)(Ag + (size_t)(32 * i) * lda + (kt + 1) * 64);
          rb[i] = *(const bf16x8*)(Bg + (size_t)(32 * i) * K + (kt + 1) * 64);
        }
      }
      const bfr* As = sm + (kt & 1) * 18432;
      const bfr* Bs = As + 9216;
#pragma unroll
      for (int kk = 0; kk < 4; ++kk) {
        bf16x8 a0 = *(const bf16x8*)(As + (wm * 64 + r) * 72 + kk * 16 + h * 8);
        bf16x8 a1 = *(const bf16x8*)(As + (wm * 64 + 32 + r) * 72 + kk * 16 + h * 8);
        bf16x8 b0 = *(const bf16x8*)(Bs + (wn * 64 + r) * 72 + kk * 16 + h * 8);
        bf16x8 b1 = *(const bf16x8*)(Bs + (wn * 64 + 32 + r) * 72 + kk * 16 + h * 8);
        acc[0][0] = MFMA(a0, b0, acc[0][0]);
        acc[0][1] = MFMA(a0, b1, acc[0][1]);
        acc[1][0] = MFMA(a1, b0, acc[1][0]);
        acc[1][1] = MFMA(a1, b1, acc[1][1]);
      }
      if (kt + 1 < nk) {
        bfr* Ad = sm + ((kt + 1) & 1) * 18432;
#pragma unroll
        for (int i = 0; i < 4; ++i) {
          *(bf16x8*)(Ad + (lrow + 32 * i) * 72 + lc) = ra[i];
          *(bf16x8*)(Ad + 9216 + (lrow + 32 * i) * 72 + lc) = rb[i];
        }
      }
      __syncthreads();
    }
#pragma unroll
    for (int mi = 0; mi < 2; ++mi)
#pragma unroll
      for (int ni = 0; ni < 2; ++ni)
#pragma unroll
        for (int g4 = 0; g4 < 4; ++g4) {
          const int row = m0 + wm * 64 + mi * 32 + 8 * g4 + 4 * h;
          const int col = n0 + wn * 64 + ni * 32 + r;
          const float v0 = acc[mi][ni][4 * g4], v1 = acc[mi][ni][4 * g4 + 1], v2 = acc[mi][ni][4 * g4 + 2], v3 = acc[mi][ni][4 * g4 + 3];
          if (mode == EPI_EVEN_IN) {
            if (col < 1024) {
              bfr* dst = wsp<bfr>(p, col < 512 ? OFF_ZRT : OFF_ZIT) + (size_t)(col & 511) * R + row;
              *(bf16x4*)dst = pack4(v0, v1, v2, v3);
            } else if (col < 2560) {
              bfr* dst = wsp<bfr>(p, OFF_Z) + (size_t)row * 1536 + (col - 1024);
              dst[0] = f2bf(v0); dst[1536] = f2bf(v1); dst[2 * 1536] = f2bf(v2); dst[3 * 1536] = f2bf(v3);
            } else if (col < 5120) {
              bfr* dst = wsp<bfr>(p, OFF_XBC) + (size_t)row * 2560 + (col - 2560);
              dst[0] = f2bf(v0); dst[2560] = f2bf(v1); dst[2 * 2560] = f2bf(v2); dst[3 * 2560] = f2bf(v3);
            } else if (col < 5168) {
              float* dst = wsp<float>(p, OFF_DTRAW) + (size_t)row * 48 + (col - 5120);
              dst[0] = v0; dst[48] = v1; dst[96] = v2; dst[144] = v3;
            }
          } else if (mode == EPI_ODD_IN) {
            if (col >= 640 && col < 768) {
              *(bf16x4*)(wsp<bfr>(p, OFF_VT) + (size_t)(col - 640) * R + row) = pack4(v0, v1, v2, v3);
            } else if (col >= 1792) {
              *(bf16x4*)(wsp<bfr>(p, OFF_VT) + (size_t)(128 + col - 1792) * R + row) = pack4(v0, v1, v2, v3);
            } else {
              bfr* dst = wsp<bfr>(p, OFF_P) + (size_t)row * 2304 + col;
              dst[0] = f2bf(v0); dst[2304] = f2bf(v1); dst[2 * 2304] = f2bf(v2); dst[3 * 2304] = f2bf(v3);
            }
          } else if (mode == EPI_RELU2) {
            bfr* dst = wsp<bfr>(p, OFF_ACT) + (size_t)row * 4096 + col;
            float t0 = fmaxf(v0, 0.f), t1 = fmaxf(v1, 0.f), t2 = fmaxf(v2, 0.f), t3 = fmaxf(v3, 0.f);
            dst[0] = f2bf(t0 * t0); dst[4096] = f2bf(t1 * t1); dst[2 * 4096] = f2bf(t2 * t2); dst[3 * 4096] = f2bf(t3 * t3);
          } else {
            const int ms = row < RL ? (row >> 13) : 2;
            const float gate = wsp<float>(p, OFF_MOD)[(layer * 3 + ms) * 6144 + gchunk * 1024 + col];
            float* hp = row < RL ? p.out + (size_t)row * 1024 + col : wsp<float>(p, OFF_HC) + (size_t)(row - RL) * 1024 + col;
            if (S > 1) {
              unsafeAtomicAdd(hp, gate * v0); unsafeAtomicAdd(hp + 1024, gate * v1);
              unsafeAtomicAdd(hp + 2048, gate * v2); unsafeAtomicAdd(hp + 3072, gate * v3);
            } else {
              hp[0] += gate * v0; hp[1024] += gate * v1; hp[2048] += gate * v2; hp[3072] += gate * v3;
            }
          }
        }
  }
}

DI float softplus_f(float x) { return x > 0.f ? x + log1pf(expf(-x)) : log1pf(expf(x)); }

DI void conv_dt_phase(const DP& p, int j) {
  const int tid = p.tidl, lane = tid & 63, wid = tid >> 6;
  const bfr* XBC = wsp<bfr>(p, OFF_XBC);
  bfr* XT = wsp<bfr>(p, OFF_XT); bfr* BN = wsp<bfr>(p, OFF_BN); bfr* BTt = wsp<bfr>(p, OFF_BT); bfr* CN = wsp<bfr>(p, OFF_CN);
  bfr* TT = (bfr*)smem;
  const float* cw = p.conv_w + (size_t)j * 5 * 2560;
  const float* cb = p.conv_b + (size_t)j * 2560;
  const int n_conv = 264 * 40, n_dt = 792;
  for (int u = p.bidl; u < n_conv + n_dt; u += gridDim.x) {
    if (u < n_conv) {
      const int tb = u / 40, cbk = u % 40, row0 = tb * 64, ch0 = cbk * 64;
      int pos0, len;
      if (row0 < RL) { pos0 = row0 & 8191; len = SEQ; } else { pos0 = (row0 - RL) & 255; len = CTX; }
      const int c8 = tid & 7, ch = ch0 + c8 * 8;
      float w[5][8], bias[8];
#pragma unroll
      for (int k = 0; k < 5; ++k) {
        float4 wa = *(const float4*)(cw + k * 2560 + ch), wb = *(const float4*)(cw + k * 2560 + ch + 4);
        w[k][0] = wa.x; w[k][1] = wa.y; w[k][2] = wa.z; w[k][3] = wa.w; w[k][4] = wb.x; w[k][5] = wb.y; w[k][6] = wb.z; w[k][7] = wb.w;
      }
      {
        float4 wa = *(const float4*)(cb + ch), wb = *(const float4*)(cb + ch + 4);
        bias[0] = wa.x; bias[1] = wa.y; bias[2] = wa.z; bias[3] = wa.w; bias[4] = wb.x; bias[5] = wb.y; bias[6] = wb.z; bias[7] = wb.w;
      }
#pragma unroll
      for (int ps = 0; ps < 2; ++ps) {
        const int tl = (tid >> 3) + 32 * ps, pos = pos0 + tl, row = row0 + tl;
        float a[8];
#pragma unroll
        for (int e = 0; e < 8; ++e) a[e] = bias[e];
#pragma unroll
        for (int k = 0; k < 5; ++k) {
          int pp = pos + k - 2;
          if (pp >= 0 && pp < len) {
            bf16x8 xv = *(const bf16x8*)(XBC + (size_t)(row + k - 2) * 2560 + ch);
#pragma unroll
            for (int e = 0; e < 8; ++e) a[e] += w[k][e] * bfs(xv[e]);
          }
        }
        bf16x8 o;
#pragma unroll
        for (int e = 0; e < 8; ++e) { float s = a[e] / (1.f + __expf(-a[e])); o[e] = (short)f2bf(s); }
        if (ch0 >= 2048) *(bf16x8*)(CN + (size_t)row * 512 + (ch - 2048)) = o;
        else if (ch0 >= 1536) *(bf16x8*)(BN + (size_t)row * 512 + (ch - 1536)) = o;
        if (ch0 < 2048) {
#pragma unroll
          for (int e = 0; e < 8; ++e) TT[(c8 * 8 + e) * 72 + tl] = (bfr)o[e];
        }
      }
      if (ch0 < 2048) {
        __syncthreads();
        const int chl = tid >> 2, tseg = (tid & 3) * 16;
        bfr* dst = (ch0 < 1536 ? XT + (size_t)(ch0 + chl) * R : BTt + (size_t)(ch0 - 1536 + chl) * R) + row0 + tseg;
        *(bf16x8*)dst = *(const bf16x8*)(TT + chl * 72 + tseg);
        *(bf16x8*)(dst + 8) = *(const bf16x8*)(TT + chl * 72 + tseg + 8);
        __syncthreads();
      }
    } else {
      const int item = (u - n_conv) * 4 + wid;
      const int head = item % 24; int rest = item / 24; const int dir = rest & 1; rest >>= 1; const int c = rest % NCH, b = rest / NCH;
      const int row0 = chunk_row0(b, c), col = dir * 24 + head;
      const float bias = p.dt_bias[j * 48 + col];
      const float a = -expf(p.a_log[j * 48 + col]);
      const float* DTRAW = wsp<float>(p, OFF_DTRAW);
      float dt[4], cs[4];
      float run = 0.f;
#pragma unroll
      for (int q = 0; q < 4; ++q) {
        dt[q] = softplus_f(DTRAW[(size_t)(row0 + lane * 4 + q) * 48 + col] + bias);
        run += dt[q] * a; cs[q] = run;
      }
      float x = run;
#pragma unroll
      for (int o = 1; o < 64; o <<= 1) { float t2 = __shfl_up(x, o); if (lane >= o) x += t2; }
      const float excl = x - run;
      const float total = __shfl(x, 63);
      float ac[4];
#pragma unroll
      for (int q = 0; q < 4; ++q) {
        float inc = excl + cs[q];
        ac[q] = dir == 0 ? inc : total - inc + dt[q] * a;
      }
      const size_t base = ((size_t)(((dir * 2 + b) * NCH + c) * 24 + head)) * 256 + lane * 4;
      *(float4*)(wsp<float>(p, OFF_DTV) + base) = make_float4(dt[0], dt[1], dt[2], dt[3]);
      *(float4*)(wsp<float>(p, OFF_ACUM) + base) = make_float4(ac[0], ac[1], ac[2], ac[3]);
    }
  }
}

DI bf16x8 scale8(bf16x8 a, const float* w) {
  return pack8(bfs(a[0]) * w[0], bfs(a[1]) * w[1], bfs(a[2]) * w[2], bfs(a[3]) * w[3],
               bfs(a[4]) * w[4], bfs(a[5]) * w[5], bfs(a[6]) * w[6], bfs(a[7]) * w[7]);
}

DI void s1_item(const DP& p, int item, int lane) {
  const int r = lane & 31, h = lane >> 5;
  const int head = item % 24; int rest = item / 24; const int dir = rest & 1; rest >>= 1; const int c = rest % NCH, b = rest / NCH;
  const int g = head / 6;
  const int row0 = chunk_row0(b, c);
  const size_t dbase = ((size_t)(((dir * 2 + b) * NCH + c) * 24 + head)) * 256;
  const float* dtv = wsp<float>(p, OFF_DTV) + dbase;
  const float* acm = wsp<float>(p, OFF_ACUM) + dbase;
  const float acend = dir == 0 ? acm[255] : acm[0];
  const bfr* XT = wsp<bfr>(p, OFF_XT); const bfr* BTt = wsp<bfr>(p, OFF_BT);
  bfr* HS = wsp<bfr>(p, OFF_HS) + ((size_t)(((dir * 2 + b) * NCH + c) * 24 + head)) * 8192;
#pragma unroll 1
  for (int pt = 0; pt < 2; ++pt) {
    f32x16 acc[4];
#pragma unroll
    for (int n = 0; n < 4; ++n) acc[n] = zero16();
#pragma unroll 1
    for (int kk = 0; kk < 16; ++kk) {
      const int s0 = kk * 16 + 8 * h;
      float4 d0 = *(const float4*)(dtv + s0), d1 = *(const float4*)(dtv + s0 + 4);
      float4 a0 = *(const float4*)(acm + s0), a1 = *(const float4*)(acm + s0 + 4);
      float w[8];
      w[0] = d0.x * __expf(acend - a0.x); w[1] = d0.y * __expf(acend - a0.y); w[2] = d0.z * __expf(acend - a0.z); w[3] = d0.w * __expf(acend - a0.w);
      w[4] = d1.x * __expf(acend - a1.x); w[5] = d1.y * __expf(acend - a1.y); w[6] = d1.z * __expf(acend - a1.z); w[7] = d1.w * __expf(acend - a1.w);
      bf16x8 af = scale8(*(const bf16x8*)(XT + (size_t)(head * 64 + pt * 32 + r) * R + row0 + s0), w);
#pragma unroll
      for (int nt = 0; nt < 4; ++nt) {
        bf16x8 bfv = *(const bf16x8*)(BTt + (size_t)(g * 128 + nt * 32 + r) * R + row0 + s0);
        acc[nt] = MFMA(af, bfv, acc[nt]);
      }
    }
#pragma unroll
    for (int nt = 0; nt < 4; ++nt)
#pragma unroll
      for (int i = 0; i < 16; ++i) HS[(pt * 32 + crow(i, h)) * 128 + nt * 32 + r] = f2bf(acc[nt][i]);
  }
}

DI void f1_item(const DP& p, int item, int lane) {
  const int r = lane & 31, h = lane >> 5;
  const int l2t = item & 1, m = (item >> 1) & 511, b = item >> 10;
  const bfr* ZRT = wsp<bfr>(p, OFF_ZRT) + (size_t)m * R + b * SEQ + l2t * 32 + r;
  const bfr* ZIT = wsp<bfr>(p, OFF_ZIT) + (size_t)m * R + b * SEQ + l2t * 32 + r;
  const bfr* C128 = wsp<bfr>(p, OFF_C128); const bfr* S128 = wsp<bfr>(p, OFF_S128);
  const float2* TW = wsp<float2>(p, OFF_TW);
  bfr* YR = wsp<bfr>(p, OFF_YR); bfr* YI = wsp<bfr>(p, OFF_YI);
  const int l2 = l2t * 32 + r;
#pragma unroll 1
  for (int mh = 0; mh < 2; ++mh) {
    f32x16 yr[2], yi[2];
#pragma unroll
    for (int i = 0; i < 2; ++i) { yr[i] = zero16(); yi[i] = zero16(); }
#pragma unroll 1
    for (int kk = 0; kk < 8; ++kk) {
      bf16x8 zr, zi, nzr;
#pragma unroll
      for (int jj = 0; jj < 8; ++jj) {
        int l1 = kk * 16 + 8 * h + jj;
        zr[jj] = (short)ZRT[l1 * 64]; zi[jj] = (short)ZIT[l1 * 64];
        nzr[jj] = (short)(zr[jj] ^ (short)0x8000);
      }
#pragma unroll
      for (int m2 = 0; m2 < 2; ++m2) {
        const int mt = mh * 2 + m2;
        bf16x8 ca = *(const bf16x8*)(C128 + (mt * 32 + r) * 128 + kk * 16 + 8 * h);
        bf16x8 sa = *(const bf16x8*)(S128 + (mt * 32 + r) * 128 + kk * 16 + 8 * h);
        yr[m2] = MFMA(ca, zr, yr[m2]); yr[m2] = MFMA(sa, zi, yr[m2]);
        yi[m2] = MFMA(ca, zi, yi[m2]); yi[m2] = MFMA(sa, nzr, yi[m2]);
      }
    }
#pragma unroll
    for (int m2 = 0; m2 < 2; ++m2)
#pragma unroll
      for (int i = 0; i < 16; ++i) {
        int k1 = (mh * 2 + m2) * 32 + crow(i, h);
        float2 t = TW[k1 * l2];
        float a = yr[m2][i], bb = yi[m2][i];
        size_t o = ((size_t)(b * 512 + m) * 128 + k1) * 64 + l2;
        YR[o] = f2bf(a * t.x + bb * t.y);
        YI[o] = f2bf(bb * t.x - a * t.y);
      }
  }
}

DI void f1c_item(const DP& p, int item, int lane) {
  const int r = lane & 31, h = lane >> 5;
  const int mt = item & 15, kt = (item >> 4) & 7, b = item >> 7;
  const int m = mt * 32 + r;
  const bfr* ZRT = wsp<bfr>(p, OFF_ZRT) + (size_t)m * R + RL + b * CTX;
  const bfr* ZIT = wsp<bfr>(p, OFF_ZIT) + (size_t)m * R + RL + b * CTX;
  const bfr* C256 = wsp<bfr>(p, OFF_C256) + (kt * 32 + r) * 256;
  const bfr* S256 = wsp<bfr>(p, OFF_S256) + (kt * 32 + r) * 256;
  f32x16 acc = zero16();
  for (int kk = 0; kk < 16; ++kk) {
    int o = kk * 16 + 8 * h;
    acc = MFMA(*(const bf16x8*)(C256 + o), *(const bf16x8*)(ZRT + o), acc);
    acc = MFMA(*(const bf16x8*)(S256 + o), *(const bf16x8*)(ZIT + o), acc);
  }
  bfr* MIX = wsp<bfr>(p, OFF_MIX);
#pragma unroll
  for (int i = 0; i < 16; ++i)
    MIX[(size_t)(RL + b * CTX + kt * 32 + crow(i, h)) * 2048 + m] = f2bf(acc[i] * (1.f / 128.f));
}

DI void s1f1_phase(const DP& p) {
  const int lane = p.tidl & 63;
  const int wg = p.bidl * 4 + (p.tidl >> 6), nw = gridDim.x * 4;
  const int n_s1 = 2 * NCH * 2 * 24, n_f1 = 2048, n_f1c = 256;
#pragma unroll 1
  for (int it = wg; it < n_s1 + n_f1 + n_f1c; it += nw) {
    if (it < n_s1) s1_item(p, it, lane);
    else if (it < n_s1 + n_f1) f1_item(p, it - n_s1, lane);
    else f1c_item(p, it - n_s1 - n_f1, lane);
  }
}

DI void f2_item(const DP& p, int item, int lane) {
  const int r = lane & 31, h = lane >> 5;
  const int mt16 = item & 15, k1 = (item >> 4) & 127, b = item >> 11;
  const int m = mt16 * 32 + r;
  const bfr* YR = wsp<bfr>(p, OFF_YR) + ((size_t)(b * 512 + m) * 128 + k1) * 64;
  const bfr* YI = wsp<bfr>(p, OFF_YI) + ((size_t)(b * 512 + m) * 128 + k1) * 64;
  const bfr* C64 = wsp<bfr>(p, OFF_C64); const bfr* S64 = wsp<bfr>(p, OFF_S64);
  f32x16 acc[2]; acc[0] = zero16(); acc[1] = zero16();
#pragma unroll
  for (int kk = 0; kk < 4; ++kk) {
    bf16x8 yr = *(const bf16x8*)(YR + kk * 16 + 8 * h), yi = *(const bf16x8*)(YI + kk * 16 + 8 * h);
#pragma unroll
    for (int t = 0; t < 2; ++t) {
      bf16x8 ca = *(const bf16x8*)(C64 + (t * 32 + r) * 64 + kk * 16 + 8 * h);
      bf16x8 sa = *(const bf16x8*)(S64 + (t * 32 + r) * 64 + kk * 16 + 8 * h);
      acc[t] = MFMA(ca, yr, acc[t]); acc[t] = MFMA(sa, yi, acc[t]);
    }
  }
  bfr* MIX = wsp<bfr>(p, OFF_MIX);
  const float scale = 0.001381067932f;
#pragma unroll
  for (int t = 0; t < 2; ++t)
#pragma unroll
    for (int i = 0; i < 16; ++i) {
      int k2 = t * 32 + crow(i, h);
      MIX[(size_t)(b * SEQ + k1 + 128 * k2) * 2048 + m] = f2bf(acc[t][i] * scale);
    }
}

DI void s2f2_phase(const DP& p) {
  const int gt = p.bidl * 256 + p.tidl, nt = gridDim.x * 256;
  bfr* HSb = wsp<bfr>(p, OFF_HS);
  const float* ACUM = wsp<float>(p, OFF_ACUM);
  for (int it = gt; it < 2 * 2 * 24 * 2048; it += nt) {
    const int e4 = it & 2047; const int rest = it >> 11; const int head = rest % 24, db = rest / 24, dir = db >> 1;
    float h0 = 0.f, h1 = 0.f, h2 = 0.f, h3 = 0.f;
    for (int step = 0; step < NCH; ++step) {
      const int c = dir == 0 ? step : (step == 0 ? 0 : NCH - step);
      const size_t ci = (size_t)((db * NCH + c) * 24 + head);
      bfr* hp = HSb + ci * 8192 + e4 * 4;
      bf16x4 sv = *(const bf16x4*)hp;
      const float cd = __expf(ACUM[ci * 256 + (dir == 0 ? 255 : 0)]);
      *(bf16x4*)hp = pack4(h0, h1, h2, h3);
      h0 = h0 * cd + bfs(sv[0]); h1 = h1 * cd + bfs(sv[1]); h2 = h2 * cd + bfs(sv[2]); h3 = h3 * cd + bfs(sv[3]);
    }
  }
  const int lane = p.tidl & 63;
  const int wg = p.bidl * 4 + (p.tidl >> 6), nw = gridDim.x * 4;
#pragma unroll 1
  for (int it = wg; it < 4096; it += nw) f2_item(p, it, lane);
}

DI void s3_item(const DP& p, int j, int item, int lane) {
  const int r = lane & 31, h = lane >> 5;
  const int g = item & 3, lt = (item >> 2) & 7; const int bc = item >> 5; const int c = bc % NCH, b = bc / NCH;
  const int row0 = chunk_row0(b, c);
  const int rowl = row0 + lt * 32 + r;
  const bfr* CN = wsp<bfr>(p, OFF_CN); const bfr* BN = wsp<bfr>(p, OFF_BN); const bfr* XT = wsp<bfr>(p, OFF_XT);
  const bfr* Z = wsp<bfr>(p, OFF_Z); bfr* MIX = wsp<bfr>(p, OFF_MIX);
  bf16x8 cf[8];
#pragma unroll
  for (int kk = 0; kk < 8; ++kk) cf[kk] = *(const bf16x8*)(CN + (size_t)rowl * 512 + g * 128 + kk * 16 + 8 * h);
  float sumsq = 0.f;
#pragma unroll 1
  for (int hh = 0; hh < 6; ++hh) {
    const int head = g * 6 + hh;
    const size_t cif = (size_t)(((0 * 2 + b) * NCH + c) * 24 + head), cib = (size_t)(((1 * 2 + b) * NCH + c) * 24 + head);
    const float* acf = wsp<float>(p, OFF_ACUM) + cif * 256; const float* acb = wsp<float>(p, OFF_ACUM) + cib * 256;
    const float* dtf = wsp<float>(p, OFF_DTV) + cif * 256; const float* dtb = wsp<float>(p, OFF_DTV) + cib * 256;
    const bfr* HSf = wsp<bfr>(p, OFF_HS) + cif * 8192; const bfr* HSbk = wsp<bfr>(p, OFF_HS) + cib * 8192;
    const float al_f = acf[lt * 32 + r], al_b = acb[lt * 32 + r];
    f32x16 acc[2];
    {
      f32x16 t0 = zero16(), t1 = zero16();
#pragma unroll
      for (int kk = 0; kk < 8; ++kk) {
        t0 = MFMA(*(const bf16x8*)(HSf + (r) * 128 + kk * 16 + 8 * h), cf[kk], t0);
        t1 = MFMA(*(const bf16x8*)(HSf + (32 + r) * 128 + kk * 16 + 8 * h), cf[kk], t1);
      }
      const float ef = __expf(al_f);
#pragma unroll
      for (int i = 0; i < 16; ++i) { acc[0][i] = t0[i] * ef; acc[1][i] = t1[i] * ef; }
      t0 = zero16(); t1 = zero16();
#pragma unroll
      for (int kk = 0; kk < 8; ++kk) {
        t0 = MFMA(*(const bf16x8*)(HSbk + (r) * 128 + kk * 16 + 8 * h), cf[kk], t0);
        t1 = MFMA(*(const bf16x8*)(HSbk + (32 + r) * 128 + kk * 16 + 8 * h), cf[kk], t1);
      }
      const float eb = __expf(al_b);
#pragma unroll
      for (int i = 0; i < 16; ++i) { acc[0][i] += t0[i] * eb; acc[1][i] += t1[i] * eb; }
    }
#pragma unroll 1
    for (int st = 0; st < 8; ++st) {
      f32x16 gt = zero16();
#pragma unroll
      for (int kk = 0; kk < 8; ++kk)
        gt = MFMA(*(const bf16x8*)(BN + (size_t)(row0 + st * 32 + r) * 512 + g * 128 + kk * 16 + 8 * h), cf[kk], gt);
#pragma unroll
      for (int dir = 0; dir < 2; ++dir) {
        if (dir == 0 ? (st > lt) : (st < lt)) continue;
        const float* acd = dir == 0 ? acf : acb; const float* dtd = dir == 0 ? dtf : dtb;
        const float al = dir == 0 ? al_f : al_b;
        f32x16 mm;
#pragma unroll
        for (int g4 = 0; g4 < 4; ++g4) {
          const int sb = st * 32 + 8 * g4 + 4 * h;
          float4 a4 = *(const float4*)(acd + sb), d4 = *(const float4*)(dtd + sb);
          const float av[4] = {a4.x, a4.y, a4.z, a4.w}, dv[4] = {d4.x, d4.y, d4.z, d4.w};
#pragma unroll
          for (int q = 0; q < 4; ++q) {
            const int sidx = sb + q, lidx = lt * 32 + r;
            const bool valid = dir == 0 ? (sidx <= lidx) : (sidx >= lidx);
            const float e = __expf(fminf(al - av[q], 0.f));
            mm[4 * g4 + q] = valid ? gt[4 * g4 + q] * dv[q] * e : 0.f;
          }
        }
#pragma unroll
        for (int s2 = 0; s2 < 2; ++s2) {
          bf16x8 pf = PACK_HALF(mm, s2);
#pragma unroll
          for (int pt = 0; pt < 2; ++pt) {
            const bfr* xp = XT + (size_t)(head * 64 + pt * 32 + r) * R + row0 + st * 32 + 16 * s2 + 4 * h;
            bf16x8 xf = join44(*(const bf16x4*)xp, *(const bf16x4*)(xp + 8));
            acc[pt] = MFMA(xf, pf, acc[pt]);
          }
        }
      }
    }
    const float dsk = p.d_skip[j * 24 + head];
#pragma unroll
    for (int pt = 0; pt < 2; ++pt)
#pragma unroll
      for (int g4 = 0; g4 < 4; ++g4) {
        const int pb = pt * 32 + 8 * g4 + 4 * h;
        bf16x4 zv = *(const bf16x4*)(Z + (size_t)rowl * 1536 + head * 64 + pb);
        float y[4];
#pragma unroll
        for (int q = 0; q < 4; ++q) {
          float xv = bf2f(XT[(size_t)(head * 64 + pb + q) * R + rowl]);
          float zz = bfs(zv[q]);
          float v = (acc[pt][4 * g4 + q] + dsk * xv) * (zz / (1.f + __expf(-zz)));
          sumsq += v * v; y[q] = v;
        }
        *(bf16x4*)(MIX + (size_t)rowl * 2048 + 512 + head * 64 + pb) = pack4(y[0], y[1], y[2], y[3]);
      }
  }
  const float tot = sumsq + __shfl_xor(sumsq, 32);
  const float sc = rsqrtf(tot * (1.f / 384.f) + 1e-6f);
  const float* ng = p.ssd_norm_g + (size_t)j * 1536;
#pragma unroll 1
  for (int hh = 0; hh < 6; ++hh) {
    const int head = g * 6 + hh;
#pragma unroll
    for (int pt = 0; pt < 2; ++pt)
#pragma unroll
      for (int g4 = 0; g4 < 4; ++g4) {
        const int pb = pt * 32 + 8 * g4 + 4 * h;
        bfr* mp = MIX + (size_t)rowl * 2048 + 512 + head * 64 + pb;
        bf16x4 yv = *(const bf16x4*)mp;
        float4 gg = *(const float4*)(ng + head * 64 + pb);
        *(bf16x4*)mp = pack4(bfs(yv[0]) * sc * gg.x, bfs(yv[1]) * sc * gg.y, bfs(yv[2]) * sc * gg.z, bfs(yv[3]) * sc * gg.w);
      }
  }
}

DI void s3_phase(const DP& p, int j) {
  const int lane = p.tidl & 63;
  const int wg = p.bidl * 4 + (p.tidl >> 6), nw = gridDim.x * 4;
#pragma unroll 1
  for (int it = wg; it < 2 * NCH * 8 * 4; it += nw) s3_item(p, j, it, lane);
}

DI void qkprep_phase(const DP& p, int j) {
  const int lane = p.tidl & 63;
  const int wg = p.bidl * 4 + (p.tidl >> 6), nw = gridDim.x * 4;
  const bfr* P = wsp<bfr>(p, OFF_P); bfr* QK = wsp<bfr>(p, OFF_QK);
  const float* ROPE = wsp<float>(p, OFF_ROPE);
  const int sub = lane >> 3, d0 = (lane & 7) * 8;
  for (int row = wg; row < R; row += nw) {
#pragma unroll
    for (int ps = 0; ps < 4; ++ps) {
      const int hs = ps * 8 + sub;
      const bool act = hs < 26;
      const int hsc = act ? hs : 25;
      const int col = hsc < 10 ? hsc * 64 : 768 + (hsc - 10) * 64;
      bf16x8 xv = *(const bf16x8*)(P + (size_t)row * 2304 + col + d0);
      float x[8]; float ss = 0.f;
#pragma unroll
      for (int e = 0; e < 8; ++e) { x[e] = bfs(xv[e]); ss += x[e] * x[e]; }
      ss += __shfl_xor(ss, 1); ss += __shfl_xor(ss, 2); ss += __shfl_xor(ss, 4);
      const float rs = rsqrtf(ss * (1.f / 64.f) + 1e-6f);
      const float* gv = hsc < 8 ? p.q_norm_win + j * 64 : hsc < 10 ? p.k_norm_win + j * 64 : hsc < 18 ? p.q_norm_na + j * 64 : p.k_norm_na + j * 64;
#pragma unroll
      for (int e = 0; e < 8; ++e) x[e] = x[e] * rs * gv[d0 + e];
      float pr[8];
#pragma unroll
      for (int e = 0; e < 8; ++e) pr[e] = __shfl_xor(x[e], 2);
      if (hsc < 10 && row < RL) {
        const int pos = row & 8191;
        const int axis = d0 >> 5;
        const int idx = axis == 0 ? (pos >> 6) : (pos & 63);
        const int f0 = d0 & 15;
        const bool second = (d0 & 16) != 0;
        const float* cp = ROPE + (axis * 128 + idx) * 16 + f0;
        const float* sp = cp + 4096;
#pragma unroll
        for (int e = 0; e < 8; ++e) {
          float cs = cp[e], sn = sp[e];
          x[e] = second ? (x[e] * cs + pr[e] * sn) : (x[e] * cs - pr[e] * sn);
        }
      }
      const bool isq = hsc < 8 || (hsc >= 10 && hsc < 18);
      const float qs = isq ? 0.125f : 1.f;
      if (act) *(bf16x8*)(QK + (size_t)row * 1664 + hsc * 64 + d0) = pack8(x[0] * qs, x[1] * qs, x[2] * qs, x[3] * qs, x[4] * qs, x[5] * qs, x[6] * qs, x[7] * qs);
    }
  }
}

template <class MF>
DI void attn_tile(f32x16 (&o)[2], float& m, float& l, const bf16x8 (&q)[4], const bfr* __restrict__ Kt, const bfr* __restrict__ Vt,
                  int r, int h, MF mf) {
  f32x16 s = zero16();
#pragma unroll
  for (int kk = 0; kk < 4; ++kk) s = MFMA(*(const bf16x8*)(Kt + (size_t)r * 1664 + kk * 16 + 8 * h), q[kk], s);
  float tmax = -3.0e38f;
#pragma unroll
  for (int i = 0; i < 16; ++i) { s[i] = mf(s[i], crow(i, h)); tmax = fmaxf(tmax, s[i]); }
  tmax = fmaxf(tmax, __shfl_xor(tmax, 32));
  const float mn = fmaxf(m, tmax);
  const float alpha = __expf(m - mn);
  float ps = 0.f;
#pragma unroll
  for (int i = 0; i < 16; ++i) { s[i] = __expf(s[i] - mn); ps += s[i]; }
  l = l * alpha + ps; m = mn;
#pragma unroll
  for (int i = 0; i < 16; ++i) { o[0][i] *= alpha; o[1][i] *= alpha; }
#pragma unroll
  for (int s2 = 0; s2 < 2; ++s2) {
    bf16x8 pf = PACK_HALF(s, s2);
#pragma unroll
    for (int dt = 0; dt < 2; ++dt) {
      const bfr* vp = Vt + (size_t)(dt * 32 + r) * R + 16 * s2 + 4 * h;
      bf16x8 vf = join44(*(const bf16x4*)vp, *(const bf16x4*)(vp + 8));
      o[dt] = MFMA(vf, pf, o[dt]);
    }
  }
}

DI void attn_item(const DP& p, int j, int item, int lane) {
  const int r = lane & 31, h = lane >> 5;
  const bfr* QK = wsp<bfr>(p, OFF_QK); const bfr* VT = wsp<bfr>(p, OFF_VT); bfr* MIX = wsp<bfr>(p, OFF_MIX);
  int kind, b, hd, qt;
  if (item < 4096) { kind = 0; qt = item & 255; hd = (item >> 8) & 7; b = item >> 11; }
  else if (item < 8192) { int v = item - 4096; kind = 1; qt = v & 255; hd = (v >> 8) & 7; b = v >> 11; }
  else if (item < 8320) { int v = item - 8192; kind = 2; qt = v & 7; hd = (v >> 3) & 7; b = v >> 6; }
  else { int v = item - 8320; kind = 3; qt = v & 7; hd = (v >> 3) & 7; b = v >> 6; }
  const bool win = (kind == 0 || kind == 2);
  const bool lat = kind < 2;
  const int q_row0 = lat ? b * SEQ + qt * 32 : RL + b * CTX + qt * 32;
  const int qcol = win ? hd * 64 : (10 + hd) * 64;
  const int kcol = win ? (8 + (hd >> 2)) * 64 : (18 + hd) * 64;
  const bfr* Vb = win ? VT + (size_t)((hd >> 2) * 64) * R : VT + (size_t)(128 + hd * 64) * R;
  bf16x8 q[4];
#pragma unroll
  for (int kk = 0; kk < 4; ++kk) q[kk] = *(const bf16x8*)(QK + (size_t)(q_row0 + r) * 1664 + qcol + kk * 16 + 8 * h);
  f32x16 o[2]; o[0] = zero16(); o[1] = zero16();
  float m = -1.0e30f, l = 0.f;
  if (win) { m = p.sink_win[j * 8 + hd]; l = h == 0 ? 1.f : 0.f; }
#pragma unroll 1
  for (int t = 0; t < 8; ++t) {
    const int k0 = RL + b * CTX + t * 32;
    attn_tile(o, m, l, q, QK + (size_t)k0 * 1664 + kcol, Vb + k0, r, h, [](float s, int) { return s; });
  }
  if (kind == 0) {
    const int lo = qt - 4 < 0 ? 0 : qt - 4, hi = qt + 4 > 255 ? 255 : qt + 4;
    const int qpos = qt * 32 + r;
#pragma unroll 1
    for (int kt = lo; kt <= hi; ++kt) {
      const int k0 = b * SEQ + kt * 32;
      const int kp0 = kt * 32;
      attn_tile(o, m, l, q, QK + (size_t)k0 * 1664 + kcol, Vb + k0, r, h, [=](float s, int key) {
        int dd = qpos - (kp0 + key); dd = dd < 0 ? -dd : dd;
        return dd <= 128 ? s : -1.0e30f;
      });
    }
  } else if (kind == 1) {
    const int gr = qt >> 1, half = qt & 1;
    const int w = half * 32 + r;
    int cs = w - 8; cs = cs < 0 ? 0 : (cs > 48 ? 48 : cs);
    int kr0 = gr - 4; kr0 = kr0 < 0 ? 0 : (kr0 > 120 ? 120 : kr0);
    const float* rpb = p.rpb_na + (size_t)j * 8 * 15 * 31 + hd * 15 * 31;
#pragma unroll 1
    for (int kk = 0; kk < 8; ++kk) {
      const int krow = kr0 + kk;
      const float* rp = rpb + (krow - gr + 7) * 31;
#pragma unroll 1
      for (int ch = 0; ch < 2; ++ch) {
        const int k0 = b * SEQ + krow * 64 + ch * 32;
        attn_tile(o, m, l, q, QK + (size_t)k0 * 1664 + kcol, Vb + k0, r, h, [=](float s, int key) {
          int u = ch * 32 + key;
          int co = u - w + 15; co = co < 0 ? 0 : (co > 30 ? 30 : co);
          bool valid = (u >= cs) && (u < cs + 16);
          return valid ? s + rp[co] : -1.0e30f;
        });
      }
    }
  }
  const float lt = l + __shfl_xor(l, 32);
  const float inv = 1.f / lt;
  const int ocol = win ? hd * 64 : 512 + hd * 64;
#pragma unroll
  for (int dt = 0; dt < 2; ++dt)
#pragma unroll
    for (int g4 = 0; g4 < 4; ++g4) {
      const int d = dt * 32 + 8 * g4 + 4 * h;
      *(bf16x4*)(MIX + (size_t)(q_row0 + r) * 1024 + ocol + d) =
          pack4(o[dt][4 * g4] * inv, o[dt][4 * g4 + 1] * inv, o[dt][4 * g4 + 2] * inv, o[dt][4 * g4 + 3] * inv);
    }
}

DI void attn_phase(const DP& p, int j) {
  const int lane = p.tidl & 63;
  const int wg = p.bidl * 4 + (p.tidl >> 6), nw = gridDim.x * 4;
#pragma unroll 1
  for (int it = wg; it < 8448; it += nw) attn_item(p, j, it, lane);
}

#define XB_TMO      128
#define XB_XCNT(j)  (256  + 64 * (j))
#define XB_XSUB(j)  (1280 + 64 * (j))
#define XB_XGEN(j)  (2304 + 64 * (j))
#define XB_TOP      3328
#define XB_TOPGEN   3392
#define XCD_BAR_WORDS 3456
#define XB_SPIN_CAP (1u << 18)
#define LAS __attribute__((address_space(3)))

__device__ __forceinline__ unsigned xb_ld(unsigned* p)              { return __hip_atomic_load(p, __ATOMIC_RELAXED, __HIP_MEMORY_SCOPE_AGENT); }
__device__ __forceinline__ unsigned xb_add(unsigned* p, unsigned v) { return __hip_atomic_fetch_add(p, v, __ATOMIC_RELAXED, __HIP_MEMORY_SCOPE_AGENT); }
__device__ __forceinline__ unsigned xb_xcc_id() { return (unsigned)__builtin_amdgcn_s_getreg((3 << 11) | 20) & 0xFu; }
#define XB_SPIN(cond, bar) do { unsigned _sp = 0; while (cond) { __builtin_amdgcn_s_sleep(1); \
    if ((++_sp & 255u) == 0u) { if (xb_ld(&(bar)[XB_TMO])) break; if (_sp > XB_SPIN_CAP) { atomicAdd(&(bar)[XB_TMO], 1u); break; } } } } while (0)

struct XcdBarrier {
    unsigned* bar; unsigned x;
    volatile LAS unsigned* st;
};

__device__ __forceinline__ XcdBarrier xcd_barrier_post(unsigned* bar, volatile LAS unsigned* st) {
    XcdBarrier b; b.bar = bar; b.x = xb_xcc_id(); b.st = st;
    if (threadIdx.x == 0) (void)xb_add(&bar[XB_XCNT(b.x)], 1u);
    return b;
}
__device__ __forceinline__ void xcd_barrier_complete(unsigned* bar, unsigned x, unsigned& nloc, unsigned& nx) {
    const unsigned G = gridDim.x * gridDim.y * gridDim.z;
    unsigned sum, cnt, mine, sp = 0u;
    for (;;) {
        sum = 0u; cnt = 0u; mine = 0u;
#pragma unroll
        for (unsigned j = 0; j < 16; ++j) { const unsigned c = xb_ld(&bar[XB_XCNT(j)]); sum += c; cnt += (c > 0u) ? 1u : 0u; mine = (j == x) ? c : mine; }
        if (sum == G) break;
        __builtin_amdgcn_s_sleep(1);
        if ((++sp & 255u) == 0u) { if (xb_ld(&bar[XB_TMO])) break; if (sp > XB_SPIN_CAP) { atomicAdd(&bar[XB_TMO], 1u); break; } }
    }
    nloc = mine > 0u ? mine : 1u; nx = cnt > 0u ? cnt : 1u;
}

__device__ __forceinline__ void xcd_barrier(const XcdBarrier& b) {
    asm volatile("s_waitcnt vmcnt(0)" ::: "memory");
    __syncthreads();
    if (threadIdx.x == 0) {
        unsigned* bar = b.bar;
        __builtin_amdgcn_s_waitcnt(0);
        unsigned nloc = b.st[0], nx = b.st[1];
        if (nloc == 0u) { xcd_barrier_complete(bar, b.x, nloc, nx); b.st[0] = nloc; b.st[1] = nx; }
        const unsigned old = xb_add(&bar[XB_XSUB(b.x)], 1u);
        const unsigned gen = old / nloc;
        if (old + 1u == (gen + 1u) * nloc) {
            __builtin_amdgcn_fence(__ATOMIC_RELEASE, "agent");
            asm volatile("s_waitcnt vmcnt(0)" ::: "memory");
            const unsigned og = xb_add(&bar[XB_TOP], 1u);
            const unsigned tg = og / nx;
            if (og + 1u == (tg + 1u) * nx) xb_add(&bar[XB_TOPGEN], 1u);
            else XB_SPIN(xb_ld(&bar[XB_TOPGEN]) == tg, bar);
            __builtin_amdgcn_fence(__ATOMIC_ACQUIRE, "agent");
            xb_add(&bar[XB_XGEN(b.x)], 1u);
            asm volatile("s_waitcnt vmcnt(0)" ::: "memory");
        } else {
            XB_SPIN(xb_ld(&bar[XB_XGEN(b.x)]) == gen, bar);
            __builtin_amdgcn_fence(__ATOMIC_ACQUIRE, "agent");
            asm volatile("s_waitcnt vmcnt(0)" ::: "memory");
        }
    }
    __syncthreads();
}


DI void run_phase(const DP& p, int ph) {
  if (ph == 0) { phase0(p); return; }
  int q = ph - 1, layer, lp;
  if (q < 10) { layer = 0; lp = q; } else if (q < 18) { layer = 1; lp = q - 10; } else if (q < 28) { layer = 2; lp = q - 18; } else { layer = 3; lp = q - 28; }
  const int j = layer >> 1;
  const bool even = (layer & 1) == 0;
  int op, gsel = 0;
  if (even) {
    op = (int)((0x2272654321ull >> (4 * lp)) & 15ull); gsel = (int)((0x3201000000ull >> (4 * lp)) & 15ull);
  } else {
    op = (int)((0x22729821ull >> (4 * lp)) & 15ull); gsel = (int)((0x32010000ull >> (4 * lp)) & 15ull);
  }
  if (op == 1) wconv_phase(p, layer);
  if (op == 1 || op == 7) {
    const bool first = op == 1;
    norm_phase(p, layer, (first ? p.norm_mix_g : p.norm_ff_g) + layer * 1024, first ? 0 : 3, first ? 1 : 4);
  } else if (op == 2) {
    int mode, lda, N, K, S, gch; size_t offA, offB;
    if (gsel == 0) { mode = even ? EPI_EVEN_IN : EPI_ODD_IN; offA = OFF_MIX; lda = 1024; offB = OFF_WIN; N = even ? 5168 : 2304; K = 1024; S = 1; gch = 0; }
    else if (gsel == 1) { mode = EPI_RESID; offA = OFF_MIX; lda = even ? 2048 : 1024; offB = OFF_WOUT; N = 1024; K = even ? 2048 : 1024; S = 2; gch = 2; }
    else if (gsel == 2) { mode = EPI_RELU2; offA = OFF_MIX; lda = 1024; offB = OFF_WFF1; N = 4096; K = 1024; S = 1; gch = 0; }
    else { mode = EPI_RESID; offA = OFF_ACT; lda = 4096; offB = OFF_WFF2; N = 1024; K = 4096; S = 4; gch = 5; }
    gemm_phase(p, mode, wsp<bfr>(p, offA), lda, wsp<bfr>(p, offB), N, K, S, layer, gch);
  } else if (op == 3) conv_dt_phase(p, j);
  else if (op == 4) s1f1_phase(p);
  else if (op == 5) s2f2_phase(p);
  else if (op == 6) s3_phase(p, j);
  else if (op == 8) qkprep_phase(p, j);
  else if (op == 9) attn_phase(p, j);
}

DI int probe_reps(int ph) {
#ifdef PROBE_MASK
  if (ph == 0) return (PROBE_MASK & 1) ? 2 : 1;
  int q = ph - 1, layer, lp;
  if (q < 10) { layer = 0; lp = q; } else if (q < 18) { layer = 1; lp = q - 10; } else if (q < 28) { layer = 2; lp = q - 18; } else { layer = 3; lp = q - 28; }
  const bool even = (layer & 1) == 0;
  int op, gsel;
  if (even) { op = (int)((0x2272654321ull >> (4 * lp)) & 15ull); gsel = (int)((0x3201000000ull >> (4 * lp)) & 15ull); }
  else { op = (int)((0x22729821ull >> (4 * lp)) & 15ull); gsel = (int)((0x32010000ull >> (4 * lp)) & 15ull); }
  if (op == 5) return 1;
  if (op == 2 && (gsel == 1 || gsel == 3)) return 1;
  return ((PROBE_MASK >> op) & 1) ? 2 : 1;
#else
  return 1;
#endif
}

__shared__ uint4 xb_words;

__global__ void __launch_bounds__(256, 2) mega(Params p, int ph0, int ph1) {
  cg::grid_group grid = cg::this_grid();
  if (threadIdx.x == 0) xb_words = make_uint4(0u, 0u, 0u, 0u);
  __syncthreads();
  XcdBarrier xb = xcd_barrier_post((unsigned*)(p.ws + OFF_BAR), (volatile LAS unsigned*)&xb_words);
#pragma unroll 1
  for (int ph = ph0; ph < ph1; ++ph) {
    const int nrep = probe_reps(ph);
#pragma unroll 1
    for (int rep = 0; rep < nrep; ++rep) {
      DP q;
      (Params&)q = p;
      int t = threadIdx.x, bb = blockIdx.x;
      asm volatile("" : "+v"(t));
      asm volatile("" : "+s"(bb));
      int z0;
      asm volatile("s_mov_b32 %0, 0" : "=s"(z0));
      q.ws = p.ws + z0;
      q.out = p.out + z0;
      q.tidl = t; q.bidl = bb;
      run_phase(q, ph);
    }
    if (ph + 1 < ph1) {
      if (ph == ph0) grid.sync();
      else xcd_barrier(xb);
    }
  }
}

extern "C" void kernel_launch(void* const* d_in, const int* in_sizes, int n_in, void* d_out, int out_size, void* d_ws,
                              size_t ws_size, hipStream_t stream) {
  static int grid_blocks = 0;
  if (!grid_blocks) {
    int dev = 0, cus = 0, per_cu = 0;
    hipGetDevice(&dev);
    hipDeviceGetAttribute(&cus, hipDeviceAttributeMultiprocessorCount, dev);
    hipOccupancyMaxActiveBlocksPerMultiprocessor(&per_cu, mega, 256, 0);
    if (per_cu > 2) per_cu = 2;
    if (per_cu < 1) per_cu = 1;
    grid_blocks = cus * per_cu;
  }
  Params p{};
  const float** pp = (const float**)&p;
  for (int i = 0; i < 26; ++i) pp[i] = (const float*)d_in[i];
  p.out = (float*)d_out;
  p.ws = (unsigned char*)d_ws;
  if (ws_size < WS_TOTAL) fprintf(stderr, "workspace too small: %zu < %zu\n", ws_size, (size_t)WS_TOTAL);
  hipMemsetAsync((unsigned char*)d_ws + OFF_BAR, 0, XCD_BAR_WORDS * 4, stream);
#if MULTI_LAUNCH
  for (int ph = 0; ph < NPHASE; ++ph) {
    int a = ph, b = ph + 1;
    void* args[] = {&p, &a, &b};
    hipLaunchCooperativeKernel((void*)mega, dim3(grid_blocks), dim3(256), args, 0, stream);
  }
#else
  int a = 0, b = NPHASE;
  void* args[] = {&p, &a, &b};
  hipError_t e = hipLaunchCooperativeKernel((void*)mega, dim3(grid_blocks), dim3(256), args, 0, stream);
  if (e != hipSuccess) fprintf(stderr, "cooperative launch failed: %s (grid %d)\n", hipGetErrorString(e), grid_blocks);
#endif
}
```

```cpp
#include <hip/hip_runtime.h>
#include <hip/hip_cooperative_groups.h>
#include <cstdio>
namespace cg = cooperative_groups;

typedef unsigned short bfr;
typedef __attribute__((ext_vector_type(8))) short bf16x8;
typedef __attribute__((ext_vector_type(4))) short bf16x4;
typedef __attribute__((ext_vector_type(16))) float f32x16;
#define DI __device__ __forceinline__
#define MFMA(a, b, c) __builtin_amdgcn_mfma_f32_32x32x16_bf16((a), (b), (c), 0, 0, 0)

#ifndef MULTI_LAUNCH
#define MULTI_LAUNCH 0
#endif

constexpr int RL = 16384, R = 16896, SEQ = 8192, CTX = 256;
constexpr int NCH = 33, CL = 256;
constexpr int NPHASE = 37;

constexpr size_t al(size_t x) { return (x + 255) & ~size_t(255); }
constexpr size_t OFF_HC = 0;
constexpr size_t OFF_MOD = OFF_HC + al(512 * 1024 * 4);
constexpr size_t OFF_TW = OFF_MOD + al(4 * 3 * 6144 * 4);
constexpr size_t OFF_C128 = OFF_TW + al(8192 * 8);
constexpr size_t OFF_S128 = OFF_C128 + al(128 * 128 * 2);
constexpr size_t OFF_C64 = OFF_S128 + al(128 * 128 * 2);
constexpr size_t OFF_S64 = OFF_C64 + al(64 * 64 * 2);
constexpr size_t OFF_C256 = OFF_S64 + al(64 * 64 * 2);
constexpr size_t OFF_S256 = OFF_C256 + al(256 * 256 * 2);
constexpr size_t OFF_ROPE = OFF_S256 + al(256 * 256 * 2);
constexpr size_t OFF_DTV = OFF_ROPE + al(2 * 2 * 128 * 16 * 4);
constexpr size_t DT_BYTES = (size_t)2 * 2 * NCH * 24 * 256 * 4;
constexpr size_t OFF_ACUM = OFF_DTV + al(DT_BYTES);
constexpr size_t OFF_WIN = OFF_ACUM + al(DT_BYTES);
constexpr size_t OFF_WOUT = OFF_WIN + al((size_t)5248 * 1024 * 2);
constexpr size_t OFF_WFF1 = OFF_WOUT + al((size_t)1024 * 2048 * 2);
constexpr size_t OFF_WFF2 = OFF_WFF1 + al((size_t)4096 * 1024 * 2);
constexpr size_t OFF_MIX = OFF_WFF2 + al((size_t)4096 * 1024 * 2);
constexpr size_t OFF_BIG = OFF_MIX + al((size_t)R * 2048 * 2);
constexpr size_t OFF_Z = OFF_BIG;
constexpr size_t OFF_ZRT = OFF_Z + (size_t)R * 1536 * 2;
constexpr size_t OFF_ZIT = OFF_ZRT + (size_t)512 * R * 2;
constexpr size_t OFF_XBC = OFF_ZIT + (size_t)512 * R * 2;
constexpr size_t OFF_DTRAW = OFF_XBC + (size_t)R * 2560 * 2;
constexpr size_t BIG_END = OFF_DTRAW + (size_t)R * 48 * 4;
constexpr size_t OFF_HS = OFF_XBC;
constexpr size_t HS_BYTES = (size_t)2 * 2 * NCH * 24 * 8192 * 2;
constexpr size_t OFF_YR = OFF_HS + HS_BYTES;
constexpr size_t OFF_YI = OFF_YR + (size_t)2 * 512 * 128 * 64 * 2;
static_assert(OFF_YI + (size_t)2 * 512 * 128 * 64 * 2 <= OFF_DTRAW, "fft scratch overflows");
constexpr size_t OFF_ACT = OFF_BIG;
static_assert((size_t)R * 4096 * 2 <= BIG_END - OFF_BIG, "act overflows");
constexpr size_t OFF_P = OFF_BIG;
constexpr size_t OFF_VT = OFF_P + (size_t)R * 2304 * 2;
constexpr size_t OFF_QK = OFF_VT + (size_t)640 * R * 2;
static_assert(OFF_QK + (size_t)R * 1664 * 2 <= BIG_END, "odd overflows");
constexpr size_t OFF_XT = al(BIG_END);
constexpr size_t OFF_BN = OFF_XT + (size_t)1536 * R * 2;
constexpr size_t OFF_BT = OFF_BN + (size_t)R * 512 * 2;
constexpr size_t OFF_CN = OFF_BT + (size_t)512 * R * 2;
constexpr size_t OFF_BAR = al(OFF_CN + (size_t)R * 512 * 2);
constexpr size_t WS_TOTAL = OFF_BAR + 16384;
static_assert(WS_TOTAL <= 402653184ull, "workspace too large");

struct Params {
  const float *x, *c, *ctx, *c_ctx, *w_mod, *b_mod, *norm_mix_g, *norm_ff_g, *w_ff1, *w_ff2;
  const float *w_in_even, *conv_w, *conv_b, *dt_bias, *a_log, *d_skip, *ssd_norm_g, *w_out_even;
  const float *w_in_odd, *q_norm_win, *k_norm_win, *sink_win, *q_norm_na, *k_norm_na, *rpb_na, *w_out_odd;
  float* out;
  unsigned char* ws;
};

struct DP : Params { int tidl, bidl; };

__shared__ __attribute__((aligned(16))) unsigned char smem[73728];

DI bfr f2bf(float x) { unsigned u = __float_as_uint(x); u += 0x7fffu + ((u >> 16) & 1u); return (bfr)(u >> 16); }
DI float bf2f(bfr b) { return __uint_as_float(((unsigned)b) << 16); }
DI float bfs(short s) { return __uint_as_float(((unsigned)(unsigned short)s) << 16); }
DI int crow(int i, int h) { return (i & 3) + 8 * (i >> 2) + 4 * h; }
DI f32x16 zero16() { f32x16 z; for (int i = 0; i < 16; ++i) z[i] = 0.f; return z; }
DI bf16x8 pack8(float a0, float a1, float a2, float a3, float a4, float a5, float a6, float a7) {
  bf16x8 v;
  v[0] = (short)f2bf(a0); v[1] = (short)f2bf(a1); v[2] = (short)f2bf(a2); v[3] = (short)f2bf(a3);
  v[4] = (short)f2bf(a4); v[5] = (short)f2bf(a5); v[6] = (short)f2bf(a6); v[7] = (short)f2bf(a7);
  return v;
}
DI bf16x4 pack4(float a0, float a1, float a2, float a3) {
  bf16x4 v; v[0] = (short)f2bf(a0); v[1] = (short)f2bf(a1); v[2] = (short)f2bf(a2); v[3] = (short)f2bf(a3); return v;
}
#define PACK_HALF(s, s2) pack8(s[8 * (s2)], s[8 * (s2) + 1], s[8 * (s2) + 2], s[8 * (s2) + 3], s[8 * (s2) + 4], s[8 * (s2) + 5], s[8 * (s2) + 6], s[8 * (s2) + 7])
DI bf16x8 join44(bf16x4 lo, bf16x4 hi) { return __builtin_shufflevector(lo, hi, 0, 1, 2, 3, 4, 5, 6, 7); }
DI int chunk_row0(int b, int c) { return c == 0 ? RL + b * CTX : b * SEQ + (c - 1) * CL; }

DI void sincos_turn(double f, float& s, float& c) {
  f -= rint(f);
  double x = f * 6.283185307179586476925;
  double x2 = x * x, ss = 1.0, cc = 1.0;
#pragma unroll
  for (int k = 13; k >= 1; --k) {
    ss = 1.0 - x2 / (double)((2 * k) * (2 * k + 1)) * ss;
    cc = 1.0 - x2 / (double)((2 * k - 1) * (2 * k)) * cc;
  }
  s = (float)(x * ss); c = (float)cc;
}

template <class T> DI T* wsp(const DP& p, size_t off) { return (T*)(p.ws + off); }

DI void phase0(const DP& p) {
  const int tid = p.tidl, bid = p.bidl, G = gridDim.x;
  float* lds = (float*)smem;
  float* MOD = wsp<float>(p, OFF_MOD);
  for (int u = bid; u < 384; u += G) {
    int layer = u / 96, cb = u % 96;
    for (int i = tid; i < 3072; i += 256) {
      int v = i >> 10, k = i & 1023;
      float c = v < 2 ? p.c[v * 1024 + k] : p.c_ctx[k];
      lds[i] = c / (1.f + expf(-c));
    }
    __syncthreads();
    int kq = tid >> 6, cc = tid & 63, col = cb * 64 + cc;
    const float* w = p.w_mod + (size_t)layer * 1024 * 6144 + col;
    float a0 = 0, a1 = 0, a2 = 0;
    for (int k = kq * 256; k < kq * 256 + 256; ++k) {
      float wv = w[(size_t)k * 6144];
      a0 += lds[k] * wv; a1 += lds[1024 + k] * wv; a2 += lds[2048 + k] * wv;
    }
    float* red = lds + 3072;
    red[(kq * 3 + 0) * 64 + cc] = a0; red[(kq * 3 + 1) * 64 + cc] = a1; red[(kq * 3 + 2) * 64 + cc] = a2;
    __syncthreads();
    if (tid < 192) {
      int v = tid >> 6;
      float s = red[(0 * 3 + v) * 64 + cc] + red[(1 * 3 + v) * 64 + cc] + red[(2 * 3 + v) * 64 + cc] + red[(3 * 3 + v) * 64 + cc];
      MOD[(layer * 3 + v) * 6144 + col] = s + p.b_mod[layer * 6144 + col];
    }
    __syncthreads();
  }
  const int gt = bid * 256 + tid, nt = G * 256;
  {
    const float4* xs = (const float4*)p.x; float4* od = (float4*)p.out;
    for (int i = gt; i < RL * 256; i += nt) od[i] = xs[i];
    const float4* cs = (const float4*)p.ctx; float4* hd = wsp<float4>(p, OFF_HC);
    for (int i = gt; i < 512 * 256; i += nt) hd[i] = cs[i];
  }
  float2* TW = wsp<float2>(p, OFF_TW);
  for (int i = gt; i < 8192; i += nt) { float s, c; sincos_turn((double)i / 8192.0, s, c); TW[i] = make_float2(c, s); }
  bfr* C128 = wsp<bfr>(p, OFF_C128); bfr* S128 = wsp<bfr>(p, OFF_S128);
  for (int i = gt; i < 128 * 128; i += nt) { int a = i >> 7, b = i & 127; float s, c; sincos_turn((double)((a * b) & 127) / 128.0, s, c); C128[i] = f2bf(c); S128[i] = f2bf(s); }
  bfr* C64 = wsp<bfr>(p, OFF_C64); bfr* S64 = wsp<bfr>(p, OFF_S64);
  for (int i = gt; i < 64 * 64; i += nt) { int a = i >> 6, b = i & 63; float s, c; sincos_turn((double)((a * b) & 63) / 64.0, s, c); C64[i] = f2bf(c); S64[i] = f2bf(s); }
  bfr* C256 = wsp<bfr>(p, OFF_C256); bfr* S256 = wsp<bfr>(p, OFF_S256);
  for (int i = gt; i < 256 * 256; i += nt) { int a = i >> 8, b = i & 255; float s, c; sincos_turn((double)((a * b) & 255) / 256.0, s, c); C256[i] = f2bf(c); S256[i] = f2bf(s); }
  float* ROPE = wsp<float>(p, OFF_ROPE);
  for (int i = gt; i < 2 * 128 * 16; i += nt) {
    int f = i & 15, idx = (i >> 4) & 127;
    float ang = (float)idx * (float)exp(-(double)f * 0.5756462732485115);
    float s, c; sincos_turn((double)ang / 6.283185307179586476925, s, c);
    ROPE[i] = c; ROPE[4096 + i] = s;
  }
}

DI void tcvt_unit(const float* __restrict__ src, int ld, int c0, int ncols, int K, bfr* __restrict__ dst, int dr0, int u, int tid) {
  const int ntk = K >> 6;
  const int tn = u / ntk, tk = u % ntk, k0 = tk * 64, nb = tn * 64;
  bfr* T = (bfr*)smem;
#pragma unroll
  for (int i = 0; i < 4; ++i) {
    int kk = (tid >> 4) + 16 * i, n4 = (tid & 15) * 4;
    float4 v = make_float4(0.f, 0.f, 0.f, 0.f);
    if (nb + n4 < ncols) v = *(const float4*)(src + (size_t)(k0 + kk) * ld + c0 + nb + n4);
    T[(n4 + 0) * 72 + kk] = f2bf(v.x); T[(n4 + 1) * 72 + kk] = f2bf(v.y);
    T[(n4 + 2) * 72 + kk] = f2bf(v.z); T[(n4 + 3) * 72 + kk] = f2bf(v.w);
  }
  __syncthreads();
  {
    int n = tid >> 2, kseg = (tid & 3) * 16;
    if (nb + n < ncols) {
      bfr* d = dst + (size_t)(dr0 + nb + n) * K + k0 + kseg;
      *(bf16x8*)d = *(const bf16x8*)(T + n * 72 + kseg);
      *(bf16x8*)(d + 8) = *(const bf16x8*)(T + n * 72 + kseg + 8);
    }
  }
  __syncthreads();
}

DI void wconv_phase(const DP& p, int layer) {
  const int tid = p.tidl;
  const int j = layer >> 1;
  bfr* WIN = wsp<bfr>(p, OFF_WIN); bfr* WOUT = wsp<bfr>(p, OFF_WOUT);
  bfr* WFF1 = wsp<bfr>(p, OFF_WFF1); bfr* WFF2 = wsp<bfr>(p, OFF_WFF2);
  const float* ff1 = p.w_ff1 + (size_t)layer * 1024 * 4096;
  const float* ff2 = p.w_ff2 + (size_t)layer * 4096 * 1024;
  float* cst = (float*)(smem + 12288);
  if (tid < 64) { float s, c; sincos_turn((double)tid / 64.0, s, c); cst[tid] = c; cst[64 + tid] = s; }
  __syncthreads();
  if ((layer & 1) == 0) {
    const float* win = p.w_in_even + (size_t)j * 1024 * 4656;
    const float* wout = p.w_out_even + (size_t)j * 2048 * 1024;
    const int n_in = 65 * 16, n_out = 16 * 32, n_f1 = 64 * 16, n_f2 = 16 * 64, n_fold = 2048;
    const int total = n_in + n_out + n_f1 + n_f2 + n_fold;
    for (int u = p.bidl; u < total; u += gridDim.x) {
      int v = u;
      if (v < n_in) { tcvt_unit(win, 4656, 512, 4144, 1024, WIN, 1024, v, tid); continue; }
      v -= n_in;
      if (v < n_out) { tcvt_unit(wout, 1024, 0, 1024, 2048, WOUT, 0, v, tid); continue; }
      v -= n_out;
      if (v < n_f1) { tcvt_unit(ff1, 4096, 0, 4096, 1024, WFF1, 0, v, tid); continue; }
      v -= n_f1;
      if (v < n_f2) { tcvt_unit(ff2, 1024, 0, 1024, 4096, WFF2, 0, v, tid); continue; }
      v -= n_f2;
      {
        int ch = v >> 2, kb = v & 3, k = kb * 256 + tid, g = ch >> 6, m = ch & 63;
        const float* wr = win + (size_t)k * 4656 + g * 64;
        float sc = 0.f, ss = 0.f;
        for (int jj = 0; jj < 64; ++jj) { float w = wr[jj]; int idx = (m * jj) & 63; sc += w * cst[idx]; ss += w * cst[64 + idx]; }
        WIN[(size_t)ch * 1024 + k] = f2bf(sc);
        WIN[(size_t)(512 + ch) * 1024 + k] = f2bf(-ss);
      }
    }
  } else {
    const float* win = p.w_in_odd + (size_t)j * 1024 * 2304;
    const float* wout = p.w_out_odd + (size_t)j * 1024 * 1024;
    const int n_in = 36 * 16, n_out = 16 * 16, n_f1 = 64 * 16, n_f2 = 16 * 64;
    const int total = n_in + n_out + n_f1 + n_f2;
    for (int u = p.bidl; u < total; u += gridDim.x) {
      int v = u;
      if (v < n_in) { tcvt_unit(win, 2304, 0, 2304, 1024, WIN, 0, v, tid); continue; }
      v -= n_in;
      if (v < n_out) { tcvt_unit(wout, 1024, 0, 1024, 1024, WOUT, 0, v, tid); continue; }
      v -= n_out;
      if (v < n_f1) { tcvt_unit(ff1, 4096, 0, 4096, 1024, WFF1, 0, v, tid); continue; }
      v -= n_f1;
      tcvt_unit(ff2, 1024, 0, 1024, 4096, WFF2, 0, v, tid);
    }
  }
}

DI void norm_phase(const DP& p, int layer, const float* __restrict__ gvec, int shc, int scc) {
  const int lane = p.tidl & 63;
  const int wg = p.bidl * 4 + (p.tidl >> 6), nw = gridDim.x * 4;
  const float* MOD = wsp<float>(p, OFF_MOD);
  const float* HC = wsp<float>(p, OFF_HC);
  bfr* U = wsp<bfr>(p, OFF_MIX);
  for (int row = wg; row < R; row += nw) {
    const float* hp = row < RL ? p.out + (size_t)row * 1024 : HC + (size_t)(row - RL) * 1024;
    const int ms = row < RL ? (row >> 13) : 2;
    const float* md = MOD + (layer * 3 + ms) * 6144;
    float4 v[4]; float ss = 0.f;
#pragma unroll
    for (int i = 0; i < 4; ++i) {
      v[i] = *(const float4*)(hp + i * 256 + lane * 4);
      ss += v[i].x * v[i].x + v[i].y * v[i].y + v[i].z * v[i].z + v[i].w * v[i].w;
    }
#pragma unroll
    for (int o = 32; o >= 1; o >>= 1) ss += __shfl_xor(ss, o);
    const float rs = rsqrtf(ss * (1.f / 1024.f) + 1e-6f);
#pragma unroll
    for (int i = 0; i < 4; ++i) {
      int col = i * 256 + lane * 4;
      float4 g = *(const float4*)(gvec + col);
      float4 sc = *(const float4*)(md + scc * 1024 + col);
      float4 sh = *(const float4*)(md + shc * 1024 + col);
      bf16x4 o = pack4(v[i].x * rs * g.x * (1.f + sc.x) + sh.x, v[i].y * rs * g.y * (1.f + sc.y) + sh.y,
                       v[i].z * rs * g.z * (1.f + sc.z) + sh.z, v[i].w * rs * g.w * (1.f + sc.w) + sh.w);
      *(bf16x4*)(U + (size_t)row * 1024 + col) = o;
    }
  }
}

enum { EPI_EVEN_IN = 0, EPI_ODD_IN = 1, EPI_RELU2 = 2, EPI_RESID = 3 };

DI void gemm_phase(const DP& p, int mode, const bfr* __restrict__ A, int lda, const bfr* __restrict__ Bt,
                   int N, int K, int layer, int gchunk) {
  const int tid = p.tidl, lane = tid & 63, wid = tid >> 6, r = lane & 31, h = lane >> 5;
  const int wm = wid >> 1, wn = wid & 1;
  const int nN = (N + 127) >> 7, nM = R / 128;
  const int tiles = nM * nN, G = (int)gridDim.x;
  int full = tiles, tail = 0, St = 1;
  if (mode == EPI_RESID) {
    full = (tiles / G) * G; tail = tiles - full;
    if (tail > 0) { int c = G / tail; int kmax = K >> 7; St = 1; while (St * 2 <= c && St * 2 <= 16 && St * 2 <= kmax) St *= 2; }
  }
  const int chunk = (full + 7) >> 3;
  const int units = chunk * 8 + tail * St;
  bfr* sm = (bfr*)smem;
  const int lrow = tid >> 3, lc = (tid & 7) * 8;
#pragma unroll 1
  for (int u = p.bidl; u < units; u += G) {
    int t, ks, Ks; bool atom;
    if (u < chunk * 8) {
      t = (u & 7) * chunk + (u >> 3);
      if (t >= full) continue;
      ks = 0; Ks = K; atom = false;
    } else { const int v = u - chunk * 8; t = full + v / St; ks = v % St; Ks = K / St; atom = St > 1; }
    const int nk = Ks >> 6;
    const int panel = t / (nM * 8); const int rem = t - panel * nM * 8;
    const int pw = (nN - panel * 8) < 8 ? (nN - panel * 8) : 8;
    const int tm = rem / pw, tn = panel * 8 + rem % pw;
    const int m0 = tm * 128, n0 = tn * 128, kbase = ks * Ks;
    f32x16 acc[2][2];
    acc[0][0] = zero16(); acc[0][1] = zero16(); acc[1][0] = zero16(); acc[1][1] = zero16();
    const bfr* Ag = A + (size_t)(m0 + lrow) * lda + kbase + lc;
    const bfr* Bg = Bt + (size_t)(n0 + lrow) * K + kbase + lc;
    bf16x8 ra[4], rb[4];
#pragma unroll
    for (int i = 0; i < 4; ++i) {
      ra[i] = *(const bf16x8*)(Ag + (size_t)(32 * i) * lda);
      rb[i] = *(const bf16x8*)(Bg + (size_t)(32 * i) * K);
    }
#pragma unroll
    for (int i = 0; i < 4; ++i) {
      *(bf16x8*)(sm + (lrow + 32 * i) * 72 + lc) = ra[i];
      *(bf16x8*)(sm + 9216 + (lrow + 32 * i) * 72 + lc) = rb[i];
    }
    __syncthreads();
    for (int kt = 0; kt < nk; ++kt) {
      if (kt + 1 < nk) {
#pragma unroll
        for (int i = 0; i < 4; ++i) {
          ra[i] = *(const bf16x8*)(Ag + (size_t)(32 * i) * lda + (kt + 1) * 64);
          rb[i] = *(const bf16x8*)(Bg + (size_t)(32 * i) * K + (kt + 1) * 64);
        }
      }
      const bfr* As = sm + (kt & 1) * 18432;
      const bfr* Bs = As + 9216;
#pragma unroll
      for (int kk = 0; kk < 4; ++kk) {
        bf16x8 a0 = *(const bf16x8*)(As + (wm * 64 + r) * 72 + kk * 16 + h * 8);
        bf16x8 a1 = *(const bf16x8*)(As + (wm * 64 + 32 + r) * 72 + kk * 16 + h * 8);
        bf16x8 b0 = *(const bf16x8*)(Bs + (wn * 64 + r) * 72 + kk * 16 + h * 8);
        bf16x8 b1 = *(const bf16x8*)(Bs + (wn * 64 + 32 + r) * 72 + kk * 16 + h * 8);
        acc[0][0] = MFMA(a0, b0, acc[0][0]);
        acc[0][1] = MFMA(a0, b1, acc[0][1]);
        acc[1][0] = MFMA(a1, b0, acc[1][0]);
        acc[1][1] = MFMA(a1, b1, acc[1][1]);
      }
      if (kt + 1 < nk) {
        bfr* Ad = sm + ((kt + 1) & 1) * 18432;
#pragma unroll
        for (int i = 0; i < 4; ++i) {
          *(bf16x8*)(Ad + (lrow + 32 * i) * 72 + lc) = ra[i];
          *(bf16x8*)(Ad + 9216 + (lrow + 32 * i) * 72 + lc) = rb[i];
        }
      }
      __syncthreads();
    }
#pragma unroll
    for (int mi = 0; mi < 2; ++mi)
#pragma unroll
      for (int ni = 0; ni < 2; ++ni)
#pragma unroll
        for (int g4 = 0; g4 < 4; ++g4) {
          const int row = m0 + wm * 64 + mi * 32 + 8 * g4 + 4 * h;
          const int col = n0 + wn * 64 + ni * 32 + r;
          const float v0 = acc[mi][ni][4 * g4], v1 = acc[mi][ni][4 * g4 + 1], v2 = acc[mi][ni][4 * g4 + 2], v3 = acc[mi][ni][4 * g4 + 3];
          if (mode == EPI_EVEN_IN) {
            if (col < 1024) {
              bfr* dst = wsp<bfr>(p, col < 512 ? OFF_ZRT : OFF_ZIT) + (size_t)(col & 511) * R + row;
              *(bf16x4*)dst = pack4(v0, v1, v2, v3);
            } else if (col < 2560) {
              bfr* dst = wsp<bfr>(p, OFF_Z) + (size_t)row * 1536 + (col - 1024);
              dst[0] = f2bf(v0); dst[1536] = f2bf(v1); dst[2 * 1536] = f2bf(v2); dst[3 * 1536] = f2bf(v3);
            } else if (col < 5120) {
              bfr* dst = wsp<bfr>(p, OFF_XBC) + (size_t)row * 2560 + (col - 2560);
              dst[0] = f2bf(v0); dst[2560] = f2bf(v1); dst[2 * 2560] = f2bf(v2); dst[3 * 2560] = f2bf(v3);
            } else if (col < 5168) {
              float* dst = wsp<float>(p, OFF_DTRAW) + (size_t)row * 48 + (col - 5120);
              dst[0] = v0; dst[48] = v1; dst[96] = v2; dst[144] = v3;
            }
          } else if (mode == EPI_ODD_IN) {
            if (col >= 640 && col < 768) {
              *(bf16x4*)(wsp<bfr>(p, OFF_VT) + (size_t)(col - 640) * R + row) = pack4(v0, v1, v2, v3);
            } else if (col >= 1792) {
              *(bf16x4*)(wsp<bfr>(p, OFF_VT) + (size_t)(128 + col - 1792) * R + row) = pack4(v0, v1, v2, v3);
            } else {
              bfr* dst = wsp<bfr>(p, OFF_P) + (size_t)row * 2304 + col;
              dst[0] = f2bf(v0); dst[2304] = f2bf(v1); dst[2 * 2304] = f2bf(v2); dst[3 * 2304] = f2bf(v3);
            }
          } else if (mode == EPI_RELU2) {
            bfr* dst = wsp<bfr>(p, OFF_ACT) + (size_t)row * 4096 + col;
            float t0 = fmaxf(v0, 0.f), t1 = fmaxf(v1, 0.f), t2 = fmaxf(v2, 0.f), t3 = fmaxf(v3, 0.f);
            dst[0] = f2bf(t0 * t0); dst[4096] = f2bf(t1 * t1); dst[2 * 4096] = f2bf(t2 * t2); dst[3 * 4096] = f2bf(t3 * t3);
          } else {
            const int ms = row < RL ? (row >> 13) : 2;
            const float gate = wsp<float>(p, OFF_MOD)[(layer * 3 + ms) * 6144 + gchunk * 1024 + col];
            float* hp = row < RL ? p.out + (size_t)row * 1024 + col : wsp<float>(p, OFF_HC) + (size_t)(row - RL) * 1024 + col;
            if (atom) {
              unsafeAtomicAdd(hp, gate * v0); unsafeAtomicAdd(hp + 1024, gate * v1);
              unsafeAtomicAdd(hp + 2048, gate * v2); unsafeAtomicAdd(hp + 3072, gate * v3);
            } else {
              hp[0] += gate * v0; hp[1024] += gate * v1; hp[2048] += gate * v2; hp[3072] += gate * v3;
            }
          }
        }
  }
}

DI float softplus_f(float x) { return x > 0.f ? x + log1pf(expf(-x)) : log1pf(expf(x)); }

DI void conv_dt_phase(const DP& p, int j) {
  const int tid = p.tidl, lane = tid & 63, wid = tid >> 6;
  const bfr* XBC = wsp<bfr>(p, OFF_XBC);
  bfr* XT = wsp<bfr>(p, OFF_XT); bfr* BN = wsp<bfr>(p, OFF_BN); bfr* BTt = wsp<bfr>(p, OFF_BT); bfr* CN = wsp<bfr>(p, OFF_CN);
  bfr* TT = (bfr*)smem;
  const float* cw = p.conv_w + (size_t)j * 5 * 2560;
  const float* cb = p.conv_b + (size_t)j * 2560;
  const int n_conv = 264 * 40, n_dt = 792;
  for (int u = p.bidl; u < n_conv + n_dt; u += gridDim.x) {
    if (u < n_conv) {
      const int tb = u / 40, cbk = u % 40, row0 = tb * 64, ch0 = cbk * 64;
      int pos0, len;
      if (row0 < RL) { pos0 = row0 & 8191; len = SEQ; } else { pos0 = (row0 - RL) & 255; len = CTX; }
      const int c8 = tid & 7, ch = ch0 + c8 * 8;
      float w[5][8], bias[8];
#pragma unroll
      for (int k = 0; k < 5; ++k) {
        float4 wa = *(const float4*)(cw + k * 2560 + ch), wb = *(const float4*)(cw + k * 2560 + ch + 4);
        w[k][0] = wa.x; w[k][1] = wa.y; w[k][2] = wa.z; w[k][3] = wa.w; w[k][4] = wb.x; w[k][5] = wb.y; w[k][6] = wb.z; w[k][7] = wb.w;
      }
      {
        float4 wa = *(const float4*)(cb + ch), wb = *(const float4*)(cb + ch + 4);
        bias[0] = wa.x; bias[1] = wa.y; bias[2] = wa.z; bias[3] = wa.w; bias[4] = wb.x; bias[5] = wb.y; bias[6] = wb.z; bias[7] = wb.w;
      }
#pragma unroll
      for (int ps = 0; ps < 2; ++ps) {
        const int tl = (tid >> 3) + 32 * ps, pos = pos0 + tl, row = row0 + tl;
        float a[8];
#pragma unroll
        for (int e = 0; e < 8; ++e) a[e] = bias[e];
#pragma unroll
        for (int k = 0; k < 5; ++k) {
          int pp = pos + k - 2;
          if (pp >= 0 && pp < len) {
            bf16x8 xv = *(const bf16x8*)(XBC + (size_t)(row + k - 2) * 2560 + ch);
#pragma unroll
            for (int e = 0; e < 8; ++e) a[e] += w[k][e] * bfs(xv[e]);
          }
        }
        bf16x8 o;
#pragma unroll
        for (int e = 0; e < 8; ++e) { float s = a[e] / (1.f + __expf(-a[e])); o[e] = (short)f2bf(s); }
        if (ch0 >= 2048) *(bf16x8*)(CN + (size_t)row * 512 + (ch - 2048)) = o;
        else if (ch0 >= 1536) *(bf16x8*)(BN + (size_t)row * 512 + (ch - 1536)) = o;
        if (ch0 < 2048) {
#pragma unroll
          for (int e = 0; e < 8; ++e) TT[(c8 * 8 + e) * 72 + tl] = (bfr)o[e];
        }
      }
      if (ch0 < 2048) {
        __syncthreads();
        const int chl = tid >> 2, tseg = (tid & 3) * 16;
        bfr* dst = (ch0 < 1536 ? XT + (size_t)(ch0 + chl) * R : BTt + (size_t)(ch0 - 1536 + chl) * R) + row0 + tseg;
        *(bf16x8*)dst = *(const bf16x8*)(TT + chl * 72 + tseg);
        *(bf16x8*)(dst + 8) = *(const bf16x8*)(TT + chl * 72 + tseg + 8);
        __syncthreads();
      }
    } else {
      const int item = (u - n_conv) * 4 + wid;
      const int head = item % 24; int rest = item / 24; const int dir = rest & 1; rest >>= 1; const int c = rest % NCH, b = rest / NCH;
      const int row0 = chunk_row0(b, c), col = dir * 24 + head;
      const float bias = p.dt_bias[j * 48 + col];
      const float a = -expf(p.a_log[j * 48 + col]);
      const float* DTRAW = wsp<float>(p, OFF_DTRAW);
      float dt[4], cs[4];
      float run = 0.f;
#pragma unroll
      for (int q = 0; q < 4; ++q) {
        dt[q] = softplus_f(DTRAW[(size_t)(row0 + lane * 4 + q) * 48 + col] + bias);
        run += dt[q] * a; cs[q] = run;
      }
      float x = run;
#pragma unroll
      for (int o = 1; o < 64; o <<= 1) { float t2 = __shfl_up(x, o); if (lane >= o) x += t2; }
      const float excl = x - run;
      const float total = __shfl(x, 63);
      float ac[4];
#pragma unroll
      for (int q = 0; q < 4; ++q) {
        float inc = excl + cs[q];
        ac[q] = dir == 0 ? inc : total - inc + dt[q] * a;
      }
      const size_t base = ((size_t)(((dir * 2 + b) * NCH + c) * 24 + head)) * 256 + lane * 4;
      *(float4*)(wsp<float>(p, OFF_DTV) + base) = make_float4(dt[0], dt[1], dt[2], dt[3]);
      *(float4*)(wsp<float>(p, OFF_ACUM) + base) = make_float4(ac[0], ac[1], ac[2], ac[3]);
    }
  }
}

DI bf16x8 scale8(bf16x8 a, const float* w) {
  return pack8(bfs(a[0]) * w[0], bfs(a[1]) * w[1], bfs(a[2]) * w[2], bfs(a[3]) * w[3],
               bfs(a[4]) * w[4], bfs(a[5]) * w[5], bfs(a[6]) * w[6], bfs(a[7]) * w[7]);
}

DI void s1_item(const DP& p, int item, int lane) {
  const int r = lane & 31, h = lane >> 5;
  const int head = item % 24; int rest = item / 24; const int dir = rest & 1; rest >>= 1; const int c = rest % NCH, b = rest / NCH;
  const int g = head / 6;
  const int row0 = chunk_row0(b, c);
  const size_t dbase = ((size_t)(((dir * 2 + b) * NCH + c) * 24 + head)) * 256;
  const float* dtv = wsp<float>(p, OFF_DTV) + dbase;
  const float* acm = wsp<float>(p, OFF_ACUM) + dbase;
  const float acend = dir == 0 ? acm[255] : acm[0];
  const bfr* XT = wsp<bfr>(p, OFF_XT); const bfr* BTt = wsp<bfr>(p, OFF_BT);
  bfr* HS = wsp<bfr>(p, OFF_HS) + ((size_t)(((dir * 2 + b) * NCH + c) * 24 + head)) * 8192;
#pragma unroll 1
  for (int pt = 0; pt < 2; ++pt) {
    f32x16 acc[4];
#pragma unroll
    for (int n = 0; n < 4; ++n) acc[n] = zero16();
#pragma unroll 1
    for (int kk = 0; kk < 16; ++kk) {
      const int s0 = kk * 16 + 8 * h;
      float4 d0 = *(const float4*)(dtv + s0), d1 = *(const float4*)(dtv + s0 + 4);
      float4 a0 = *(const float4*)(acm + s0), a1 = *(const float4*)(acm + s0 + 4);
      float w[8];
      w[0] = d0.x * __expf(acend - a0.x); w[1] = d0.y * __expf(acend - a0.y); w[2] = d0.z * __expf(acend - a0.z); w[3] = d0.w * __expf(acend - a0.w);
      w[4] = d1.x * __expf(acend - a1.x); w[5] = d1.y * __expf(acend - a1.y); w[6] = d1.z * __expf(acend - a1.z); w[7] = d1.w * __expf(acend - a1.w);
      bf16x8 af = scale8(*(const bf16x8*)(XT + (size_t)(head * 64 + pt * 32 + r) * R + row0 + s0), w);
#pragma unroll
      for (int nt = 0; nt < 4; ++nt) {
        bf16x8 bfv = *(const bf16x8*)(BTt + (size_t)(g * 128 + nt * 32 + r) * R + row0 + s0);
        acc[nt] = MFMA(af, bfv, acc[nt]);
      }
    }
#pragma unroll
    for (int nt = 0; nt < 4; ++nt)
#pragma unroll
      for (int i = 0; i < 16; ++i) HS[(pt * 32 + crow(i, h)) * 128 + nt * 32 + r] = f2bf(acc[nt][i]);
  }
}

DI void f1_item(const DP& p, int item, int lane) {
  const int r = lane & 31, h = lane >> 5;
  const int l2t = item & 1, m = (item >> 1) & 511, b = item >> 10;
  const bfr* ZRT = wsp<bfr>(p, OFF_ZRT) + (size_t)m * R + b * SEQ + l2t * 32 + r;
  const bfr* ZIT = wsp<bfr>(p, OFF_ZIT) + (size_t)m * R + b * SEQ + l2t * 32 + r;
  const bfr* C128 = wsp<bfr>(p, OFF_C128); const bfr* S128 = wsp<bfr>(p, OFF_S128);
  const float2* TW = wsp<float2>(p, OFF_TW);
  bfr* YR = wsp<bfr>(p, OFF_YR); bfr* YI = wsp<bfr>(p, OFF_YI);
  const int l2 = l2t * 32 + r;
#pragma unroll 1
  for (int mh = 0; mh < 2; ++mh) {
    f32x16 yr[2], yi[2];
#pragma unroll
    for (int i = 0; i < 2; ++i) { yr[i] = zero16(); yi[i] = zero16(); }
#pragma unroll 1
    for (int kk = 0; kk < 8; ++kk) {
      bf16x8 zr, zi, nzr;
#pragma unroll
      for (int jj = 0; jj < 8; ++jj) {
        int l1 = kk * 16 + 8 * h + jj;
        zr[jj] = (short)ZRT[l1 * 64]; zi[jj] = (short)ZIT[l1 * 64];
        nzr[jj] = (short)(zr[jj] ^ (short)0x8000);
      }
#pragma unroll
      for (int m2 = 0; m2 < 2; ++m2) {
        const int mt = mh * 2 + m2;
        bf16x8 ca = *(const bf16x8*)(C128 + (mt * 32 + r) * 128 + kk * 16 + 8 * h);
        bf16x8 sa = *(const bf16x8*)(S128 + (mt * 32 + r) * 128 + kk * 16 + 8 * h);
        yr[m2] = MFMA(ca, zr, yr[m2]); yr[m2] = MFMA(sa, zi, yr[m2]);
        yi[m2] = MFMA(ca, zi, yi[m2]); yi[m2] = MFMA(sa, nzr, yi[m2]);
      }
    }
#pragma unroll
    for (int m2 = 0; m2 < 2; ++m2)
#pragma unroll
      for (int i = 0; i < 16; ++i) {
        int k1 = (mh * 2 + m2) * 32 + crow(i, h);
        float2 t = TW[k1 * l2];
        float a = yr[m2][i], bb = yi[m2][i];
        size_t o = ((size_t)(b * 512 + m) * 128 + k1) * 64 + l2;
        YR[o] = f2bf(a * t.x + bb * t.y);
        YI[o] = f2bf(bb * t.x - a * t.y);
      }
  }
}

DI void f1c_item(const DP& p, int item, int lane) {
  const int r = lane & 31, h = lane >> 5;
  const int mt = item & 15, kt = (item >> 4) & 7, b = item >> 7;
  const int m = mt * 32 + r;
  const bfr* ZRT = wsp<bfr>(p, OFF_ZRT) + (size_t)m * R + RL + b * CTX;
  const bfr* ZIT = wsp<bfr>(p, OFF_ZIT) + (size_t)m * R + RL + b * CTX;
  const bfr* C256 = wsp<bfr>(p, OFF_C256) + (kt * 32 + r) * 256;
  const bfr* S256 = wsp<bfr>(p, OFF_S256) + (kt * 32 + r) * 256;
  f32x16 acc = zero16();
  for (int kk = 0; kk < 16; ++kk) {
    int o = kk * 16 + 8 * h;
    acc = MFMA(*(const bf16x8*)(C256 + o), *(const bf16x8*)(ZRT + o), acc);
    acc = MFMA(*(const bf16x8*)(S256 + o), *(const bf16x8*)(ZIT + o), acc);
  }
  bfr* MIX = wsp<bfr>(p, OFF_MIX);
#pragma unroll
  for (int i = 0; i < 16; ++i)
    MIX[(size_t)(RL + b * CTX + kt * 32 + crow(i, h)) * 2048 + m] = f2bf(acc[i] * (1.f / 128.f));
}

DI void s1f1_phase(const DP& p) {
  const int lane = p.tidl & 63;
  const int wg = p.bidl * 4 + (p.tidl >> 6), nw = gridDim.x * 4;
  const int n_s1 = 2 * NCH * 2 * 24, n_f1 = 2048, n_f1c = 256;
#pragma unroll 1
  for (int it = wg; it < n_s1 + n_f1 + n_f1c; it += nw) {
    if (it < n_s1) s1_item(p, it, lane);
    else if (it < n_s1 + n_f1) f1_item(p, it - n_s1, lane);
    else f1c_item(p, it - n_s1 - n_f1, lane);
  }
}

DI void f2_item(const DP& p, int item, int lane) {
  const int r = lane & 31, h = lane >> 5;
  const int mt16 = item & 15, k1 = (item >> 4) & 127, b = item >> 11;
  const int m = mt16 * 32 + r;
  const bfr* YR = wsp<bfr>(p, OFF_YR) + ((size_t)(b * 512 + m) * 128 + k1) * 64;
  const bfr* YI = wsp<bfr>(p, OFF_YI) + ((size_t)(b * 512 + m) * 128 + k1) * 64;
  const bfr* C64 = wsp<bfr>(p, OFF_C64); const bfr* S64 = wsp<bfr>(p, OFF_S64);
  f32x16 acc[2]; acc[0] = zero16(); acc[1] = zero16();
#pragma unroll
  for (int kk = 0; kk < 4; ++kk) {
    bf16x8 yr = *(const bf16x8*)(YR + kk * 16 + 8 * h), yi = *(const bf16x8*)(YI + kk * 16 + 8 * h);
#pragma unroll
    for (int t = 0; t < 2; ++t) {
      bf16x8 ca = *(const bf16x8*)(C64 + (t * 32 + r) * 64 + kk * 16 + 8 * h);
      bf16x8 sa = *(const bf16x8*)(S64 + (t * 32 + r) * 64 + kk * 16 + 8 * h);
      acc[t] = MFMA(ca, yr, acc[t]); acc[t] = MFMA(sa, yi, acc[t]);
    }
  }
  bfr* MIX = wsp<bfr>(p, OFF_MIX);
  const float scale = 0.001381067932f;
#pragma unroll
  for (int t = 0; t < 2; ++t)
#pragma unroll
    for (int i = 0; i < 16; ++i) {
      int k2 = t * 32 + crow(i, h);
      MIX[(size_t)(b * SEQ + k1 + 128 * k2) * 2048 + m] = f2bf(acc[t][i] * scale);
    }
}

DI void s2f2_phase(const DP& p) {
  const int gt = p.bidl * 256 + p.tidl, nt = gridDim.x * 256;
  bfr* HSb = wsp<bfr>(p, OFF_HS);
  const float* ACUM = wsp<float>(p, OFF_ACUM);
#pragma unroll 1
  for (int it = gt; it < 2 * 2 * 24 * 2048; it += nt) {
    const int e4 = it & 2047; const int rest = it >> 11; const int head = rest % 24, db = rest / 24, dir = db >> 1;
    bf16x4 sv[NCH]; float cd[NCH];
#pragma unroll
    for (int step = 0; step < NCH; ++step) {
      const int c = dir == 0 ? step : (step == 0 ? 0 : NCH - step);
      const size_t ci = (size_t)((db * NCH + c) * 24 + head);
      sv[step] = *(const bf16x4*)(HSb + ci * 8192 + e4 * 4);
      cd[step] = ACUM[ci * 256 + (dir == 0 ? 255 : 0)];
    }
    float h0 = 0.f, h1 = 0.f, h2 = 0.f, h3 = 0.f;
#pragma unroll
    for (int step = 0; step < NCH; ++step) {
      const int c = dir == 0 ? step : (step == 0 ? 0 : NCH - step);
      const size_t ci = (size_t)((db * NCH + c) * 24 + head);
      *(bf16x4*)(HSb + ci * 8192 + e4 * 4) = pack4(h0, h1, h2, h3);
      const float e = __expf(cd[step]);
      h0 = h0 * e + bfs(sv[step][0]); h1 = h1 * e + bfs(sv[step][1]); h2 = h2 * e + bfs(sv[step][2]); h3 = h3 * e + bfs(sv[step][3]);
    }
  }
  const int lane = p.tidl & 63;
  const int wg = p.bidl * 4 + (p.tidl >> 6), nw = gridDim.x * 4;
#pragma unroll 1
  for (int it = wg; it < 4096; it += nw) f2_item(p, it, lane);
}

DI void s3_phase(const DP& p, int j) {
  const int tid = p.tidl, lane = tid & 63, wid = tid >> 6, r = lane & 31, h = lane >> 5;
  const bfr* CN = wsp<bfr>(p, OFF_CN); const bfr* BN = wsp<bfr>(p, OFF_BN); const bfr* XT = wsp<bfr>(p, OFF_XT);
  const bfr* Z = wsp<bfr>(p, OFF_Z); bfr* MIX = wsp<bfr>(p, OFF_MIX);
  bfr* XTs = (bfr*)smem;
  bfr* HSF = (bfr*)(smem + 33792);
  bfr* HSB = (bfr*)(smem + 51200);
  float* LWF = (float*)(smem + 68608);
  float* LWB = LWF + 256;
#pragma unroll 1
  for (int item = p.bidl; item < 2 * NCH * 4 * 2; item += (int)gridDim.x) {
    const int half = item & 1, g = (item >> 1) & 3; const int bc = item >> 3; const int c = bc % NCH, b = bc / NCH;
    const int row0 = chunk_row0(b, c);
    const int lt = half * 4 + wid;
    const int rowl = row0 + lt * 32 + r;
    const bfr* cfp = CN + (size_t)rowl * 512 + g * 128 + 8 * h;
    bf16x8 gtp[8][2];
    {
      bf16x8 cf[8];
#pragma unroll
      for (int kk = 0; kk < 8; ++kk) cf[kk] = *(const bf16x8*)(cfp + kk * 16);
#pragma unroll
      for (int k = 0; k < 8; ++k) { gtp[k][0] = cf[0]; gtp[k][1] = cf[0]; }
#pragma unroll 1
      for (int st = 0; st < 8; ++st) {
        f32x16 gt = zero16();
#pragma unroll
        for (int kk = 0; kk < 8; ++kk)
          gt = MFMA(*(const bf16x8*)(BN + (size_t)(row0 + st * 32 + r) * 512 + g * 128 + kk * 16 + 8 * h), cf[kk], gt);
#pragma unroll
        for (int k = 0; k < 7; ++k) { gtp[k][0] = gtp[k + 1][0]; gtp[k][1] = gtp[k + 1][1]; }
        gtp[7][0] = PACK_HALF(gt, 0); gtp[7][1] = PACK_HALF(gt, 1);
      }
    }
    float sumsq = 0.f;
#pragma unroll 1
    for (int hh = 0; hh < 6; ++hh) {
      const int head = g * 6 + hh;
      const size_t cif = (size_t)(((0 * 2 + b) * NCH + c) * 24 + head), cib = (size_t)(((1 * 2 + b) * NCH + c) * 24 + head);
      const float* acf = wsp<float>(p, OFF_ACUM) + cif * 256; const float* acb = wsp<float>(p, OFF_ACUM) + cib * 256;
      const float* dtf = wsp<float>(p, OFF_DTV) + cif * 256; const float* dtb = wsp<float>(p, OFF_DTV) + cib * 256;
      const bfr* HSf = wsp<bfr>(p, OFF_HS) + cif * 8192; const bfr* HSbk = wsp<bfr>(p, OFF_HS) + cib * 8192;
      __syncthreads();
#pragma unroll 4
      for (int i = 0; i < 8; ++i) {
        const int idx = tid + 256 * i, row = idx >> 5, c16 = idx & 31;
        *(bf16x8*)(XTs + row * 264 + c16 * 8) = *(const bf16x8*)(XT + (size_t)(head * 64 + row) * R + row0 + c16 * 8);
      }
#pragma unroll 2
      for (int i = 0; i < 4; ++i) {
        const int idx = tid + 256 * i, row = idx >> 4, c16 = idx & 15;
        *(bf16x8*)(HSF + row * 136 + c16 * 8) = *(const bf16x8*)(HSf + row * 128 + c16 * 8);
        *(bf16x8*)(HSB + row * 136 + c16 * 8) = *(const bf16x8*)(HSbk + row * 128 + c16 * 8);
      }
      LWF[tid] = __logf(dtf[tid]) - acf[tid];
      LWB[tid] = __logf(dtb[tid]) - acb[tid];
      const float al_f = acf[lt * 32 + r], al_b = acb[lt * 32 + r];
      __syncthreads();
      f32x16 acc[2];
      {
        f32x16 t0 = zero16(), t1 = zero16();
#pragma unroll
        for (int kk = 0; kk < 8; ++kk) {
          const bf16x8 cfk = *(const bf16x8*)(cfp + kk * 16);
          t0 = MFMA(*(const bf16x8*)(HSF + (r) * 136 + kk * 16 + 8 * h), cfk, t0);
          t1 = MFMA(*(const bf16x8*)(HSF + (32 + r) * 136 + kk * 16 + 8 * h), cfk, t1);
        }
        const float ef = __expf(al_f);
#pragma unroll
        for (int i = 0; i < 16; ++i) { acc[0][i] = t0[i] * ef; acc[1][i] = t1[i] * ef; }
        t0 = zero16(); t1 = zero16();
#pragma unroll
        for (int kk = 0; kk < 8; ++kk) {
          const bf16x8 cfk = *(const bf16x8*)(cfp + kk * 16);
          t0 = MFMA(*(const bf16x8*)(HSB + (r) * 136 + kk * 16 + 8 * h), cfk, t0);
          t1 = MFMA(*(const bf16x8*)(HSB + (32 + r) * 136 + kk * 16 + 8 * h), cfk, t1);
        }
        const float eb = __expf(al_b);
#pragma unroll
        for (int i = 0; i < 16; ++i) { acc[0][i] += t0[i] * eb; acc[1][i] += t1[i] * eb; }
      }
#pragma unroll 1
      for (int st = 0; st < 8; ++st) {
        const bf16x8 g0 = gtp[0][0], g1 = gtp[0][1];
#pragma unroll
        for (int k = 0; k < 7; ++k) { gtp[k][0] = gtp[k + 1][0]; gtp[k][1] = gtp[k + 1][1]; }
        gtp[7][0] = g0; gtp[7][1] = g1;
#pragma unroll 1
        for (int dir = 0; dir < 2; ++dir) {
          if (dir == 0 ? (st > lt) : (st < lt)) continue;
          const float* lwd = dir == 0 ? LWF : LWB;
          const float al = dir == 0 ? al_f : al_b;
          f32x16 mm;
#pragma unroll
          for (int g4 = 0; g4 < 4; ++g4) {
            const int sb = st * 32 + 8 * g4 + 4 * h;
            const float4 l4 = *(const float4*)(lwd + sb);
            const float lv[4] = {l4.x, l4.y, l4.z, l4.w};
#pragma unroll
            for (int q = 0; q < 4; ++q) {
              const int i = 4 * g4 + q;
              const int sidx = sb + q, lidx = lt * 32 + r;
              const bool valid = dir == 0 ? (sidx <= lidx) : (sidx >= lidx);
              const float gv = bfs((i >> 3) ? g1[i & 7] : g0[i & 7]);
              const float e = __expf(fminf(al + lv[q], 30.f));
              mm[i] = valid ? gv * e : 0.f;
            }
          }
#pragma unroll
          for (int s2 = 0; s2 < 2; ++s2) {
            bf16x8 pf = PACK_HALF(mm, s2);
#pragma unroll
            for (int pt = 0; pt < 2; ++pt) {
              const bfr* xp = XTs + (pt * 32 + r) * 264 + st * 32 + 16 * s2 + 4 * h;
              bf16x8 xf = join44(*(const bf16x4*)xp, *(const bf16x4*)(xp + 8));
              acc[pt] = MFMA(xf, pf, acc[pt]);
            }
          }
        }
      }
      const float dsk = p.d_skip[j * 24 + head];
#pragma unroll
      for (int pt = 0; pt < 2; ++pt)
#pragma unroll
        for (int g4 = 0; g4 < 4; ++g4) {
          const int pb = pt * 32 + 8 * g4 + 4 * h;
          bf16x4 zv = *(const bf16x4*)(Z + (size_t)rowl * 1536 + head * 64 + pb);
          float y[4];
#pragma unroll
          for (int q = 0; q < 4; ++q) {
            float xv = bf2f(XTs[(pb + q) * 264 + lt * 32 + r]);
            float zz = bfs(zv[q]);
            float v = (acc[pt][4 * g4 + q] + dsk * xv) * (zz / (1.f + __expf(-zz)));
            sumsq += v * v; y[q] = v;
          }
          *(bf16x4*)(MIX + (size_t)rowl * 2048 + 512 + head * 64 + pb) = pack4(y[0], y[1], y[2], y[3]);
        }
    }
    const float tot = sumsq + __shfl_xor(sumsq, 32);
    const float sc = rsqrtf(tot * (1.f / 384.f) + 1e-6f);
    const float* ng = p.ssd_norm_g + (size_t)j * 1536;
#pragma unroll 1
    for (int hh = 0; hh < 6; ++hh) {
      const int head = g * 6 + hh;
#pragma unroll
      for (int pt = 0; pt < 2; ++pt)
#pragma unroll
        for (int g4 = 0; g4 < 4; ++g4) {
          const int pb = pt * 32 + 8 * g4 + 4 * h;
          bfr* mp = MIX + (size_t)rowl * 2048 + 512 + head * 64 + pb;
          bf16x4 yv = *(const bf16x4*)mp;
          float4 gg = *(const float4*)(ng + head * 64 + pb);
          *(bf16x4*)mp = pack4(bfs(yv[0]) * sc * gg.x, bfs(yv[1]) * sc * gg.y, bfs(yv[2]) * sc * gg.z, bfs(yv[3]) * sc * gg.w);
        }
    }
  }
}

DI void qkprep_phase(const DP& p, int j) {
  const int lane = p.tidl & 63;
  const int wg = p.bidl * 4 + (p.tidl >> 6), nw = gridDim.x * 4;
  const bfr* P = wsp<bfr>(p, OFF_P); bfr* QK = wsp<bfr>(p, OFF_QK);
  const float* ROPE = wsp<float>(p, OFF_ROPE);
  const int sub = lane >> 3, d0 = (lane & 7) * 8;
  for (int row = wg; row < R; row += nw) {
#pragma unroll
    for (int ps = 0; ps < 4; ++ps) {
      const int hs = ps * 8 + sub;
      const bool act = hs < 26;
      const int hsc = act ? hs : 25;
      const int col = hsc < 10 ? hsc * 64 : 768 + (hsc - 10) * 64;
      bf16x8 xv = *(const bf16x8*)(P + (size_t)row * 2304 + col + d0);
      float x[8]; float ss = 0.f;
#pragma unroll
      for (int e = 0; e < 8; ++e) { x[e] = bfs(xv[e]); ss += x[e] * x[e]; }
      ss += __shfl_xor(ss, 1); ss += __shfl_xor(ss, 2); ss += __shfl_xor(ss, 4);
      const float rs = rsqrtf(ss * (1.f / 64.f) + 1e-6f);
      const float* gv = hsc < 8 ? p.q_norm_win + j * 64 : hsc < 10 ? p.k_norm_win + j * 64 : hsc < 18 ? p.q_norm_na + j * 64 : p.k_norm_na + j * 64;
#pragma unroll
      for (int e = 0; e < 8; ++e) x[e] = x[e] * rs * gv[d0 + e];
      float pr[8];
#pragma unroll
      for (int e = 0; e < 8; ++e) pr[e] = __shfl_xor(x[e], 2);
      if (hsc < 10 && row < RL) {
        const int pos = row & 8191;
        const int axis = d0 >> 5;
        const int idx = axis == 0 ? (pos >> 6) : (pos & 63);
        const int f0 = d0 & 15;
        const bool second = (d0 & 16) != 0;
        const float* cp = ROPE + (axis * 128 + idx) * 16 + f0;
        const float* sp = cp + 4096;
#pragma unroll
        for (int e = 0; e < 8; ++e) {
          float cs = cp[e], sn = sp[e];
          x[e] = second ? (x[e] * cs + pr[e] * sn) : (x[e] * cs - pr[e] * sn);
        }
      }
      const bool isq = hsc < 8 || (hsc >= 10 && hsc < 18);
      const float qs = isq ? 0.125f : 1.f;
      if (act) *(bf16x8*)(QK + (size_t)row * 1664 + hsc * 64 + d0) = pack8(x[0] * qs, x[1] * qs, x[2] * qs, x[3] * qs, x[4] * qs, x[5] * qs, x[6] * qs, x[7] * qs);
    }
  }
}

template <class MF>
DI void attn_tile(f32x16 (&o)[2], float& m, float& l, const bf16x8 (&q)[4], const bfr* __restrict__ Kt, const bfr* __restrict__ Vt,
                  int r, int h, MF mf) {
  f32x16 s = zero16();
#pragma unroll
  for (int kk = 0; kk < 4; ++kk) s = MFMA(*(const bf16x8*)(Kt + (size_t)r * 1664 + kk * 16 + 8 * h), q[kk], s);
  float tmax = -3.0e38f;
#pragma unroll
  for (int i = 0; i < 16; ++i) { s[i] = mf(s[i], crow(i, h)); tmax = fmaxf(tmax, s[i]); }
  tmax = fmaxf(tmax, __shfl_xor(tmax, 32));
  const float mn = fmaxf(m, tmax);
  const float alpha = __expf(m - mn);
  float ps = 0.f;
#pragma unroll
  for (int i = 0; i < 16; ++i) { s[i] = __expf(s[i] - mn); ps += s[i]; }
  l = l * alpha + ps; m = mn;
#pragma unroll
  for (int i = 0; i < 16; ++i) { o[0][i] *= alpha; o[1][i] *= alpha; }
#pragma unroll
  for (int s2 = 0; s2 < 2; ++s2) {
    bf16x8 pf = PACK_HALF(s, s2);
#pragma unroll
    for (int dt = 0; dt < 2; ++dt) {
      const bfr* vp = Vt + (size_t)(dt * 32 + r) * R + 16 * s2 + 4 * h;
      bf16x8 vf = join44(*(const bf16x4*)vp, *(const bf16x4*)(vp + 8));
      o[dt] = MFMA(vf, pf, o[dt]);
    }
  }
}

DI void attn_item(const DP& p, int j, int item, int lane) {
  const int r = lane & 31, h = lane >> 5;
  const bfr* QK = wsp<bfr>(p, OFF_QK); const bfr* VT = wsp<bfr>(p, OFF_VT); bfr* MIX = wsp<bfr>(p, OFF_MIX);
  int kind, b, hd, qt;
  if (item < 4096) { kind = 0; qt = item & 255; hd = (item >> 8) & 7; b = item >> 11; }
  else if (item < 8192) { int v = item - 4096; kind = 1; qt = v & 255; hd = (v >> 8) & 7; b = v >> 11; }
  else if (item < 8320) { int v = item - 8192; kind = 2; qt = v & 7; hd = (v >> 3) & 7; b = v >> 6; }
  else { int v = item - 8320; kind = 3; qt = v & 7; hd = (v >> 3) & 7; b = v >> 6; }
  const bool win = (kind == 0 || kind == 2);
  const bool lat = kind < 2;
  const int q_row0 = lat ? b * SEQ + qt * 32 : RL + b * CTX + qt * 32;
  const int qcol = win ? hd * 64 : (10 + hd) * 64;
  const int kcol = win ? (8 + (hd >> 2)) * 64 : (18 + hd) * 64;
  const bfr* Vb = win ? VT + (size_t)((hd >> 2) * 64) * R : VT + (size_t)(128 + hd * 64) * R;
  bf16x8 q[4];
#pragma unroll
  for (int kk = 0; kk < 4; ++kk) q[kk] = *(const bf16x8*)(QK + (size_t)(q_row0 + r) * 1664 + qcol + kk * 16 + 8 * h);
  f32x16 o[2]; o[0] = zero16(); o[1] = zero16();
  float m = -1.0e30f, l = 0.f;
  if (win) { m = p.sink_win[j * 8 + hd]; l = h == 0 ? 1.f : 0.f; }
#pragma unroll 1
  for (int t = 0; t < 8; ++t) {
    const int k0 = RL + b * CTX + t * 32;
    attn_tile(o, m, l, q, QK + (size_t)k0 * 1664 + kcol, Vb + k0, r, h, [](float s, int) { return s; });
  }
  if (kind == 0) {
    const int lo = qt - 4 < 0 ? 0 : qt - 4, hi = qt + 4 > 255 ? 255 : qt + 4;
    const int qpos = qt * 32 + r;
#pragma unroll 1
    for (int kt = lo; kt <= hi; ++kt) {
      const int k0 = b * SEQ + kt * 32;
      const int kp0 = kt * 32;
      attn_tile(o, m, l, q, QK + (size_t)k0 * 1664 + kcol, Vb + k0, r, h, [=](float s, int key) {
        int dd = qpos - (kp0 + key); dd = dd < 0 ? -dd : dd;
        return dd <= 128 ? s : -1.0e30f;
      });
    }
  } else if (kind == 1) {
    const int gr = qt >> 1, half = qt & 1;
    const int w = half * 32 + r;
    int cs = w - 8; cs = cs < 0 ? 0 : (cs > 48 ? 48 : cs);
    int kr0 = gr - 4; kr0 = kr0 < 0 ? 0 : (kr0 > 120 ? 120 : kr0);
    const float* rpb = p.rpb_na + (size_t)j * 8 * 15 * 31 + hd * 15 * 31;
#pragma unroll 1
    for (int kk = 0; kk < 8; ++kk) {
      const int krow = kr0 + kk;
      const float* rp = rpb + (krow - gr + 7) * 31;
#pragma unroll 1
      for (int ch = 0; ch < 2; ++ch) {
        const int k0 = b * SEQ + krow * 64 + ch * 32;
        attn_tile(o, m, l, q, QK + (size_t)k0 * 1664 + kcol, Vb + k0, r, h, [=](float s, int key) {
          int u = ch * 32 + key;
          int co = u - w + 15; co = co < 0 ? 0 : (co > 30 ? 30 : co);
          bool valid = (u >= cs) && (u < cs + 16);
          return valid ? s + rp[co] : -1.0e30f;
        });
      }
    }
  }
  const float lt = l + __shfl_xor(l, 32);
  const float inv = 1.f / lt;
  const int ocol = win ? hd * 64 : 512 + hd * 64;
#pragma unroll
  for (int dt = 0; dt < 2; ++dt)
#pragma unroll
    for (int g4 = 0; g4 < 4; ++g4) {
      const int d = dt * 32 + 8 * g4 + 4 * h;
      *(bf16x4*)(MIX + (size_t)(q_row0 + r) * 1024 + ocol + d) =
          pack4(o[dt][4 * g4] * inv, o[dt][4 * g4 + 1] * inv, o[dt][4 * g4 + 2] * inv, o[dt][4 * g4 + 3] * inv);
    }
}

DI void attn_phase(const DP& p, int j) {
  const int lane = p.tidl & 63;
  const int wg = p.bidl * 4 + (p.tidl >> 6), nw = gridDim.x * 4;
#pragma unroll 1
  for (int it = wg; it < 8448; it += nw) attn_item(p, j, it, lane);
}

#define XB_TMO      128
#define XB_XCNT(j)  (256  + 64 * (j))
#define XB_XSUB(j)  (1280 + 64 * (j))
#define XB_XGEN(j)  (2304 + 64 * (j))
#define XB_TOP      3328
#define XB_TOPGEN   3392
#define XCD_BAR_WORDS 3456
#define XB_SPIN_CAP (1u << 18)
#define LAS __attribute__((address_space(3)))

__device__ __forceinline__ unsigned xb_ld(unsigned* p)              { return __hip_atomic_load(p, __ATOMIC_RELAXED, __HIP_MEMORY_SCOPE_AGENT); }
__device__ __forceinline__ unsigned xb_add(unsigned* p, unsigned v) { return __hip_atomic_fetch_add(p, v, __ATOMIC_RELAXED, __HIP_MEMORY_SCOPE_AGENT); }
__device__ __forceinline__ unsigned xb_xcc_id() { return (unsigned)__builtin_amdgcn_s_getreg((3 << 11) | 20) & 0xFu; }
#define XB_SPIN(cond, bar) do { unsigned _sp = 0; while (cond) { __builtin_amdgcn_s_sleep(1); \
    if ((++_sp & 255u) == 0u) { if (xb_ld(&(bar)[XB_TMO])) break; if (_sp > XB_SPIN_CAP) { atomicAdd(&(bar)[XB_TMO], 1u); break; } } } } while (0)

struct XcdBarrier {
    unsigned* bar; unsigned x;
    volatile LAS unsigned* st;
};

__device__ __forceinline__ XcdBarrier xcd_barrier_post(unsigned* bar, volatile LAS unsigned* st) {
    XcdBarrier b; b.bar = bar; b.x = xb_xcc_id(); b.st = st;
    if (threadIdx.x == 0) (void)xb_add(&bar[XB_XCNT(b.x)], 1u);
    return b;
}
__device__ __forceinline__ void xcd_barrier_complete(unsigned* bar, unsigned x, unsigned& nloc, unsigned& nx) {
    const unsigned G = gridDim.x * gridDim.y * gridDim.z;
    unsigned sum, cnt, mine, sp = 0u;
    for (;;) {
        sum = 0u; cnt = 0u; mine = 0u;
#pragma unroll
        for (unsigned j = 0; j < 16; ++j) { const unsigned c = xb_ld(&bar[XB_XCNT(j)]); sum += c; cnt += (c > 0u) ? 1u : 0u; mine = (j == x) ? c : mine; }
        if (sum == G) break;
        __builtin_amdgcn_s_sleep(1);
        if ((++sp & 255u) == 0u) { if (xb_ld(&bar[XB_TMO])) break; if (sp > XB_SPIN_CAP) { atomicAdd(&bar[XB_TMO], 1u); break; } }
    }
    nloc = mine > 0u ? mine : 1u; nx = cnt > 0u ? cnt : 1u;
}

__device__ __forceinline__ void xcd_barrier(const XcdBarrier& b) {
    asm volatile("s_waitcnt vmcnt(0)" ::: "memory");
    __syncthreads();
    if (threadIdx.x == 0) {
        unsigned* bar = b.bar;
        __builtin_amdgcn_s_waitcnt(0);
        unsigned nloc = b.st[0], nx = b.st[1];
        if (nloc == 0u) { xcd_barrier_complete(bar, b.x, nloc, nx); b.st[0] = nloc; b.st[1] = nx; }
        const unsigned old = xb_add(&bar[XB_XSUB(b.x)], 1u);
        const unsigned gen = old / nloc;
        if (old + 1u == (gen + 1u) * nloc) {
            __builtin_amdgcn_fence(__ATOMIC_RELEASE, "agent");
            asm volatile("s_waitcnt vmcnt(0)" ::: "memory");
            const unsigned og = xb_add(&bar[XB_TOP], 1u);
            const unsigned tg = og / nx;
            if (og + 1u == (tg + 1u) * nx) xb_add(&bar[XB_TOPGEN], 1u);
            else XB_SPIN(xb_ld(&bar[XB_TOPGEN]) == tg, bar);
            __builtin_amdgcn_fence(__ATOMIC_ACQUIRE, "agent");
            xb_add(&bar[XB_XGEN(b.x)], 1u);
            asm volatile("s_waitcnt vmcnt(0)" ::: "memory");
        } else {
            XB_SPIN(xb_ld(&bar[XB_XGEN(b.x)]) == gen, bar);
            __builtin_amdgcn_fence(__ATOMIC_ACQUIRE, "agent");
            asm volatile("s_waitcnt vmcnt(0)" ::: "memory");
        }
    }
    __syncthreads();
}


DI void run_phase(const DP& p, int ph) {
  if (ph == 0) { phase0(p); return; }
  int q = ph - 1, layer, lp;
  if (q < 10) { layer = 0; lp = q; } else if (q < 18) { layer = 1; lp = q - 10; } else if (q < 28) { layer = 2; lp = q - 18; } else { layer = 3; lp = q - 28; }
  const int j = layer >> 1;
  const bool even = (layer & 1) == 0;
  int op, gsel = 0;
  if (even) {
    op = (int)((0x2272654321ull >> (4 * lp)) & 15ull); gsel = (int)((0x3201000000ull >> (4 * lp)) & 15ull);
  } else {
    op = (int)((0x22729821ull >> (4 * lp)) & 15ull); gsel = (int)((0x32010000ull >> (4 * lp)) & 15ull);
  }
  if (op == 1) wconv_phase(p, layer);
  if (op == 1 || op == 7) {
    const bool first = op == 1;
    norm_phase(p, layer, (first ? p.norm_mix_g : p.norm_ff_g) + layer * 1024, first ? 0 : 3, first ? 1 : 4);
  } else if (op == 2) {
    int mode, lda, N, K, gch; size_t offA, offB;
    if (gsel == 0) { mode = even ? EPI_EVEN_IN : EPI_ODD_IN; offA = OFF_MIX; lda = 1024; offB = OFF_WIN; N = even ? 5168 : 2304; K = 1024; gch = 0; }
    else if (gsel == 1) { mode = EPI_RESID; offA = OFF_MIX; lda = even ? 2048 : 1024; offB = OFF_WOUT; N = 1024; K = even ? 2048 : 1024; gch = 2; }
    else if (gsel == 2) { mode = EPI_RELU2; offA = OFF_MIX; lda = 1024; offB = OFF_WFF1; N = 4096; K = 1024; gch = 0; }
    else { mode = EPI_RESID; offA = OFF_ACT; lda = 4096; offB = OFF_WFF2; N = 1024; K = 4096; gch = 5; }
    gemm_phase(p, mode, wsp<bfr>(p, offA), lda, wsp<bfr>(p, offB), N, K, layer, gch);
  } else if (op == 3) conv_dt_phase(p, j);
  else if (op == 4) s1f1_phase(p);
  else if (op == 5) s2f2_phase(p);
  else if (op == 6) s3_phase(p, j);
  else if (op == 8) qkprep_phase(p, j);
  else if (op == 9) attn_phase(p, j);
}

DI int probe_reps(int ph) {
#ifdef PROBE_MASK
  if (ph == 0) return (PROBE_MASK & 1) ? 2 : 1;
  int q = ph - 1, layer, lp;
  if (q < 10) { layer = 0; lp = q; } else if (q < 18) { layer = 1; lp = q - 10; } else if (q < 28) { layer = 2; lp = q - 18; } else { layer = 3; lp = q - 28; }
  const bool even = (layer & 1) == 0;
  int op, gsel;
  if (even) { op = (int)((0x2272654321ull >> (4 * lp)) & 15ull); gsel = (int)((0x3201000000ull >> (4 * lp)) & 15ull); }
  else { op = (int)((0x22729821ull >> (4 * lp)) & 15ull); gsel = (int)((0x32010000ull >> (4 * lp)) & 15ull); }
  if (op == 5) return 1;
  if (op == 2 && (gsel == 1 || gsel == 3)) return 1;
  return ((PROBE_MASK >> op) & 1) ? 2 : 1;
#else
  return 1;
#endif
}

__shared__ uint4 xb_words;

__global__ void __launch_bounds__(256, 2) mega(Params p, int ph0, int ph1) {
  cg::grid_group grid = cg::this_grid();
  if (threadIdx.x == 0) xb_words = make_uint4(0u, 0u, 0u, 0u);
  __syncthreads();
  XcdBarrier xb = xcd_barrier_post((unsigned*)(p.ws + OFF_BAR), (volatile LAS unsigned*)&xb_words);
#pragma unroll 1
  for (int ph = ph0; ph < ph1; ++ph) {
    const int nrep = probe_reps(ph);
#pragma unroll 1
    for (int rep = 0; rep < nrep; ++rep) {
      DP q;
      (Params&)q = p;
      int t = threadIdx.x, bb = blockIdx.x;
      asm volatile("" : "+v"(t));
      asm volatile("" : "+s"(bb));
      int z0;
      asm volatile("s_mov_b32 %0, 0" : "=s"(z0));
      q.ws = p.ws + z0;
      q.out = p.out + z0;
      q.tidl = t; q.bidl = bb;
      run_phase(q, ph);
    }
    if (ph + 1 < ph1) {
      if (ph == ph0) grid.sync();
      else xcd_barrier(xb);
    }
  }
}

extern "C" void kernel_launch(void* const* d_in, const int* in_sizes, int n_in, void* d_out, int out_size, void* d_ws,
                              size_t ws_size, hipStream_t stream) {
  static int grid_blocks = 0;
  if (!grid_blocks) {
    int dev = 0, cus = 0, per_cu = 0;
    hipGetDevice(&dev);
    hipDeviceGetAttribute(&cus, hipDeviceAttributeMultiprocessorCount, dev);
    hipOccupancyMaxActiveBlocksPerMultiprocessor(&per_cu, mega, 256, 0);
    if (per_cu > 2) per_cu = 2;
    if (per_cu < 1) per_cu = 1;
    grid_blocks = cus * per_cu;
  }
  Params p{};
  const float** pp = (const float**)&p;
  for (int i = 0; i < 26; ++i) pp[i] = (const float*)d_in[i];
  p.out = (float*)d_out;
  p.ws = (unsigned char*)d_ws;
  if (ws_size < WS_TOTAL) fprintf(stderr, "workspace too small: %zu < %zu\n", ws_size, (size_t)WS_TOTAL);
  hipMemsetAsync((unsigned char*)d_ws + OFF_BAR, 0, XCD_BAR_WORDS * 4, stream);
#if MULTI_LAUNCH
  for (int ph = 0; ph < NPHASE; ++ph) {
    int a = ph, b = ph + 1;
    void* args[] = {&p, &a, &b};
    hipLaunchCooperativeKernel((void*)mega, dim3(grid_blocks), dim3(256), args, 0, stream);
  }
#else
  int a = 0, b = NPHASE;
  void* args[] = {&p, &a, &b};
  hipError_t e = hipLaunchCooperativeKernel((void*)mega, dim3(grid_blocks), dim3(256), args, 0, stream);
  if (e != hipSuccess) fprintf(stderr, "cooperative launch failed: %s (grid %d)\n", hipGetErrorString(e), grid_blocks);
#endif
}
```

```cpp
#include <hip/hip_runtime.h>
#include <hip/hip_cooperative_groups.h>
#include <cstdio>
namespace cg = cooperative_groups;

typedef unsigned short bfr;
typedef __attribute__((ext_vector_type(8))) short bf16x8;
typedef __attribute__((ext_vector_type(4))) short bf16x4;
typedef __attribute__((ext_vector_type(16))) float f32x16;
#define DI __device__ __forceinline__
#define MFMA(a, b, c) __builtin_amdgcn_mfma_f32_32x32x16_bf16((a), (b), (c), 0, 0, 0)

#ifndef MULTI_LAUNCH
#define MULTI_LAUNCH 0
#endif

constexpr int RL = 16384, R = 16896, SEQ = 8192, CTX = 256;
constexpr int NCH = 33, CL = 256;
constexpr int NPHASE = 37;

constexpr size_t al(size_t x) { return (x + 255) & ~size_t(255); }
constexpr size_t OFF_HC = 0;
constexpr size_t OFF_MOD = OFF_HC + al(512 * 1024 * 4);
constexpr size_t OFF_TW = OFF_MOD + al(4 * 3 * 6144 * 4);
constexpr size_t OFF_C128 = OFF_TW + al(8192 * 8);
constexpr size_t OFF_S128 = OFF_C128 + al(128 * 128 * 2);
constexpr size_t OFF_C64 = OFF_S128 + al(128 * 128 * 2);
constexpr size_t OFF_S64 = OFF_C64 + al(64 * 64 * 2);
constexpr size_t OFF_C256 = OFF_S64 + al(64 * 64 * 2);
constexpr size_t OFF_S256 = OFF_C256 + al(256 * 256 * 2);
constexpr size_t OFF_ROPE = OFF_S256 + al(256 * 256 * 2);
constexpr size_t OFF_DTV = OFF_ROPE + al(2 * 2 * 128 * 16 * 4);
constexpr size_t DT_BYTES = (size_t)2 * 2 * NCH * 24 * 256 * 4;
constexpr size_t OFF_ACUM = OFF_DTV + al(DT_BYTES);
constexpr size_t OFF_WIN = OFF_ACUM + al(DT_BYTES);
constexpr size_t OFF_WOUT = OFF_WIN + al((size_t)5248 * 1024 * 2);
constexpr size_t OFF_WFF1 = OFF_WOUT + al((size_t)1024 * 2048 * 2);
constexpr size_t OFF_WFF2 = OFF_WFF1 + al((size_t)4096 * 1024 * 2);
constexpr size_t OFF_MIX = OFF_WFF2 + al((size_t)4096 * 1024 * 2);
constexpr size_t OFF_BIG = OFF_MIX + al((size_t)R * 2048 * 2);
constexpr size_t OFF_Z = OFF_BIG;
constexpr size_t OFF_ZRT = OFF_Z + (size_t)R * 1536 * 2;
constexpr size_t OFF_ZIT = OFF_ZRT + (size_t)512 * R * 2;
constexpr size_t OFF_XBC = OFF_ZIT + (size_t)512 * R * 2;
constexpr size_t OFF_DTRAW = OFF_XBC + (size_t)R * 2560 * 2;
constexpr size_t BIG_END = OFF_DTRAW + (size_t)R * 48 * 4;
constexpr size_t OFF_HS = OFF_XBC;
constexpr size_t HS_BYTES = (size_t)2 * 2 * NCH * 24 * 8192 * 2;
constexpr size_t OFF_YR = OFF_HS + HS_BYTES;
constexpr size_t OFF_YI = OFF_YR + (size_t)2 * 512 * 128 * 64 * 2;
static_assert(OFF_YI + (size_t)2 * 512 * 128 * 64 * 2 <= OFF_DTRAW, "fft scratch overflows");
constexpr size_t OFF_ACT = OFF_BIG;
static_assert((size_t)R * 4096 * 2 <= BIG_END - OFF_BIG, "act overflows");
constexpr size_t OFF_P = OFF_BIG;
constexpr size_t OFF_VT = OFF_P + (size_t)R * 2304 * 2;
constexpr size_t OFF_QK = OFF_VT + (size_t)640 * R * 2;
static_assert(OFF_QK + (size_t)R * 1664 * 2 <= BIG_END, "odd overflows");
constexpr size_t OFF_XT = al(BIG_END);
constexpr size_t OFF_BN = OFF_XT + (size_t)1536 * R * 2;
constexpr size_t OFF_BT = OFF_BN + (size_t)R * 512 * 2;
constexpr size_t OFF_CN = OFF_BT + (size_t)512 * R * 2;
constexpr size_t OFF_BAR = al(OFF_CN + (size_t)R * 512 * 2);
constexpr size_t WS_TOTAL = OFF_BAR + 16384;
static_assert(WS_TOTAL <= 402653184ull, "workspace too large");

struct Params {
  const float *x, *c, *ctx, *c_ctx, *w_mod, *b_mod, *norm_mix_g, *norm_ff_g, *w_ff1, *w_ff2;
  const float *w_in_even, *conv_w, *conv_b, *dt_bias, *a_log, *d_skip, *ssd_norm_g, *w_out_even;
  const float *w_in_odd, *q_norm_win, *k_norm_win, *sink_win, *q_norm_na, *k_norm_na, *rpb_na, *w_out_odd;
  float* out;
  unsigned char* ws;
};

struct DP : Params { int tidl, bidl; };

__shared__ __attribute__((aligned(16))) unsigned char smem[73728];

DI bfr f2bf(float x) { unsigned u = __float_as_uint(x); u += 0x7fffu + ((u >> 16) & 1u); return (bfr)(u >> 16); }
DI float bf2f(bfr b) { return __uint_as_float(((unsigned)b) << 16); }
DI float bfs(short s) { return __uint_as_float(((unsigned)(unsigned short)s) << 16); }
DI int crow(int i, int h) { return (i & 3) + 8 * (i >> 2) + 4 * h; }
DI f32x16 zero16() { f32x16 z; for (int i = 0; i < 16; ++i) z[i] = 0.f; return z; }
DI bf16x8 pack8(float a0, float a1, float a2, float a3, float a4, float a5, float a6, float a7) {
  bf16x8 v;
  v[0] = (short)f2bf(a0); v[1] = (short)f2bf(a1); v[2] = (short)f2bf(a2); v[3] = (short)f2bf(a3);
  v[4] = (short)f2bf(a4); v[5] = (short)f2bf(a5); v[6] = (short)f2bf(a6); v[7] = (short)f2bf(a7);
  return v;
}
DI bf16x4 pack4(float a0, float a1, float a2, float a3) {
  bf16x4 v; v[0] = (short)f2bf(a0); v[1] = (short)f2bf(a1); v[2] = (short)f2bf(a2); v[3] = (short)f2bf(a3); return v;
}
#define PACK_HALF(s, s2) pack8(s[8 * (s2)], s[8 * (s2) + 1], s[8 * (s2) + 2], s[8 * (s2) + 3], s[8 * (s2) + 4], s[8 * (s2) + 5], s[8 * (s2) + 6], s[8 * (s2) + 7])
DI bf16x8 join44(bf16x4 lo, bf16x4 hi) { return __builtin_shufflevector(lo, hi, 0, 1, 2, 3, 4, 5, 6, 7); }
DI int chunk_row0(int b, int c) { return c == 0 ? RL + b * CTX : b * SEQ + (c - 1) * CL; }

DI void sincos_turn(double f, float& s, float& c) {
  f -= rint(f);
  double x = f * 6.283185307179586476925;
  double x2 = x * x, ss = 1.0, cc = 1.0;
#pragma unroll
  for (int k = 13; k >= 1; --k) {
    ss = 1.0 - x2 / (double)((2 * k) * (2 * k + 1)) * ss;
    cc = 1.0 - x2 / (double)((2 * k - 1) * (2 * k)) * cc;
  }
  s = (float)(x * ss); c = (float)cc;
}

template <class T> DI T* wsp(const DP& p, size_t off) { return (T*)(p.ws + off); }

DI void phase0(const DP& p) {
  const int tid = p.tidl, bid = p.bidl, G = gridDim.x;
  float* lds = (float*)smem;
  float* MOD = wsp<float>(p, OFF_MOD);
  for (int u = bid; u < 384; u += G) {
    int layer = u / 96, cb = u % 96;
    for (int i = tid; i < 3072; i += 256) {
      int v = i >> 10, k = i & 1023;
      float c = v < 2 ? p.c[v * 1024 + k] : p.c_ctx[k];
      lds[i] = c / (1.f + expf(-c));
    }
    __syncthreads();
    int kq = tid >> 6, cc = tid & 63, col = cb * 64 + cc;
    const float* w = p.w_mod + (size_t)layer * 1024 * 6144 + col;
    float a0 = 0, a1 = 0, a2 = 0;
    for (int k = kq * 256; k < kq * 256 + 256; ++k) {
      float wv = w[(size_t)k * 6144];
      a0 += lds[k] * wv; a1 += lds[1024 + k] * wv; a2 += lds[2048 + k] * wv;
    }
    float* red = lds + 3072;
    red[(kq * 3 + 0) * 64 + cc] = a0; red[(kq * 3 + 1) * 64 + cc] = a1; red[(kq * 3 + 2) * 64 + cc] = a2;
    __syncthreads();
    if (tid < 192) {
      int v = tid >> 6;
      float s = red[(0 * 3 + v) * 64 + cc] + red[(1 * 3 + v) * 64 + cc] + red[(2 * 3 + v) * 64 + cc] + red[(3 * 3 + v) * 64 + cc];
      MOD[(layer * 3 + v) * 6144 + col] = s + p.b_mod[layer * 6144 + col];
    }
    __syncthreads();
  }
  const int gt = bid * 256 + tid, nt = G * 256;
  {
    const float4* xs = (const float4*)p.x; float4* od = (float4*)p.out;
    for (int i = gt; i < RL * 256; i += nt) od[i] = xs[i];
    const float4* cs = (const float4*)p.ctx; float4* hd = wsp<float4>(p, OFF_HC);
    for (int i = gt; i < 512 * 256; i += nt) hd[i] = cs[i];
  }
  float2* TW = wsp<float2>(p, OFF_TW);
  for (int i = gt; i < 8192; i += nt) { float s, c; sincos_turn((double)i / 8192.0, s, c); TW[i] = make_float2(c, s); }
  bfr* C128 = wsp<bfr>(p, OFF_C128); bfr* S128 = wsp<bfr>(p, OFF_S128);
  for (int i = gt; i < 128 * 128; i += nt) { int a = i >> 7, b = i & 127; float s, c; sincos_turn((double)((a * b) & 127) / 128.0, s, c); C128[i] = f2bf(c); S128[i] = f2bf(s); }
  bfr* C64 = wsp<bfr>(p, OFF_C64); bfr* S64 = wsp<bfr>(p, OFF_S64);
  for (int i = gt; i < 64 * 64; i += nt) { int a = i >> 6, b = i & 63; float s, c; sincos_turn((double)((a * b) & 63) / 64.0, s, c); C64[i] = f2bf(c); S64[i] = f2bf(s); }
  bfr* C256 = wsp<bfr>(p, OFF_C256); bfr* S256 = wsp<bfr>(p, OFF_S256);
  for (int i = gt; i < 256 * 256; i += nt) { int a = i >> 8, b = i & 255; float s, c; sincos_turn((double)((a * b) & 255) / 256.0, s, c); C256[i] = f2bf(c); S256[i] = f2bf(s); }
  float* ROPE = wsp<float>(p, OFF_ROPE);
  for (int i = gt; i < 2 * 128 * 16; i += nt) {
    int f = i & 15, idx = (i >> 4) & 127;
    float ang = (float)idx * (float)exp(-(double)f * 0.5756462732485115);
    float s, c; sincos_turn((double)ang / 6.283185307179586476925, s, c);
    ROPE[i] = c; ROPE[4096 + i] = s;
  }
}

DI void tcvt_unit(const float* __restrict__ src, int ld, int c0, int ncols, int K, bfr* __restrict__ dst, int dr0, int u, int tid) {
  const int ntk = K >> 6;
  const int tn = u / ntk, tk = u % ntk, k0 = tk * 64, nb = tn * 64;
  bfr* T = (bfr*)smem;
#pragma unroll
  for (int i = 0; i < 4; ++i) {
    int kk = (tid >> 4) + 16 * i, n4 = (tid & 15) * 4;
    float4 v = make_float4(0.f, 0.f, 0.f, 0.f);
    if (nb + n4 < ncols) v = *(const float4*)(src + (size_t)(k0 + kk) * ld + c0 + nb + n4);
    T[(n4 + 0) * 72 + kk] = f2bf(v.x); T[(n4 + 1) * 72 + kk] = f2bf(v.y);
    T[(n4 + 2) * 72 + kk] = f2bf(v.z); T[(n4 + 3) * 72 + kk] = f2bf(v.w);
  }
  __syncthreads();
  {
    int n = tid >> 2, kseg = (tid & 3) * 16;
    if (nb + n < ncols) {
      bfr* d = dst + (size_t)(dr0 + nb + n) * K + k0 + kseg;
      *(bf16x8*)d = *(const bf16x8*)(T + n * 72 + kseg);
      *(bf16x8*)(d + 8) = *(const bf16x8*)(T + n * 72 + kseg + 8);
    }
  }
  __syncthreads();
}

DI void wconv_phase(const DP& p, int layer) {
  const int tid = p.tidl;
  const int j = layer >> 1;
  bfr* WIN = wsp<bfr>(p, OFF_WIN); bfr* WOUT = wsp<bfr>(p, OFF_WOUT);
  bfr* WFF1 = wsp<bfr>(p, OFF_WFF1); bfr* WFF2 = wsp<bfr>(p, OFF_WFF2);
  const float* ff1 = p.w_ff1 + (size_t)layer * 1024 * 4096;
  const float* ff2 = p.w_ff2 + (size_t)layer * 4096 * 1024;
  float* cst = (float*)(smem + 12288);
  if (tid < 64) { float s, c; sincos_turn((double)tid / 64.0, s, c); cst[tid] = c; cst[64 + tid] = s; }
  __syncthreads();
  if ((layer & 1) == 0) {
    const float* win = p.w_in_even + (size_t)j * 1024 * 4656;
    const float* wout = p.w_out_even + (size_t)j * 2048 * 1024;
    const int n_in = 65 * 16, n_out = 16 * 32, n_f1 = 64 * 16, n_f2 = 16 * 64, n_fold = 2048;
    const int total = n_in + n_out + n_f1 + n_f2 + n_fold;
    for (int u = p.bidl; u < total; u += gridDim.x) {
      int v = u;
      if (v < n_in) { tcvt_unit(win, 4656, 512, 4144, 1024, WIN, 1024, v, tid); continue; }
      v -= n_in;
      if (v < n_out) { tcvt_unit(wout, 1024, 0, 1024, 2048, WOUT, 0, v, tid); continue; }
      v -= n_out;
      if (v < n_f1) { tcvt_unit(ff1, 4096, 0, 4096, 1024, WFF1, 0, v, tid); continue; }
      v -= n_f1;
      if (v < n_f2) { tcvt_unit(ff2, 1024, 0, 1024, 4096, WFF2, 0, v, tid); continue; }
      v -= n_f2;
      {
        int ch = v >> 2, kb = v & 3, k = kb * 256 + tid, g = ch >> 6, m = ch & 63;
        const float* wr = win + (size_t)k * 4656 + g * 64;
        float sc = 0.f, ss = 0.f;
        for (int jj = 0; jj < 64; ++jj) { float w = wr[jj]; int idx = (m * jj) & 63; sc += w * cst[idx]; ss += w * cst[64 + idx]; }
        WIN[(size_t)ch * 1024 + k] = f2bf(sc);
        WIN[(size_t)(512 + ch) * 1024 + k] = f2bf(-ss);
      }
    }
  } else {
    const float* win = p.w_in_odd + (size_t)j * 1024 * 2304;
    const float* wout = p.w_out_odd + (size_t)j * 1024 * 1024;
    const int n_in = 36 * 16, n_out = 16 * 16, n_f1 = 64 * 16, n_f2 = 16 * 64;
    const int total = n_in + n_out + n_f1 + n_f2;
    for (int u = p.bidl; u < total; u += gridDim.x) {
      int v = u;
      if (v < n_in) { tcvt_unit(win, 2304, 0, 2304, 1024, WIN, 0, v, tid); continue; }
      v -= n_in;
      if (v < n_out) { tcvt_unit(wout, 1024, 0, 1024, 1024, WOUT, 0, v, tid); continue; }
      v -= n_out;
      if (v < n_f1) { tcvt_unit(ff1, 4096, 0, 4096, 1024, WFF1, 0, v, tid); continue; }
      v -= n_f1;
      tcvt_unit(ff2, 1024, 0, 1024, 4096, WFF2, 0, v, tid);
    }
  }
}

DI void norm_phase(const DP& p, int layer, const float* __restrict__ gvec, int shc, int scc) {
  const int lane = p.tidl & 63;
  const int wg = p.bidl * 4 + (p.tidl >> 6), nw = gridDim.x * 4;
  const float* MOD = wsp<float>(p, OFF_MOD);
  const float* HC = wsp<float>(p, OFF_HC);
  bfr* U = wsp<bfr>(p, OFF_MIX);
  for (int row = wg; row < R; row += nw) {
    const float* hp = row < RL ? p.out + (size_t)row * 1024 : HC + (size_t)(row - RL) * 1024;
    const int ms = row < RL ? (row >> 13) : 2;
    const float* md = MOD + (layer * 3 + ms) * 6144;
    float4 v[4]; float ss = 0.f;
#pragma unroll
    for (int i = 0; i < 4; ++i) {
      v[i] = *(const float4*)(hp + i * 256 + lane * 4);
      ss += v[i].x * v[i].x + v[i].y * v[i].y + v[i].z * v[i].z + v[i].w * v[i].w;
    }
#pragma unroll
    for (int o = 32; o >= 1; o >>= 1) ss += __shfl_xor(ss, o);
    const float rs = rsqrtf(ss * (1.f / 1024.f) + 1e-6f);
#pragma unroll
    for (int i = 0; i < 4; ++i) {
      int col = i * 256 + lane * 4;
      float4 g = *(const float4*)(gvec + col);
      float4 sc = *(const float4*)(md + scc * 1024 + col);
      float4 sh = *(const float4*)(md + shc * 1024 + col);
      bf16x4 o = pack4(v[i].x * rs * g.x * (1.f + sc.x) + sh.x, v[i].y * rs * g.y * (1.f + sc.y) + sh.y,
                       v[i].z * rs * g.z * (1.f + sc.z) + sh.z, v[i].w * rs * g.w * (1.f + sc.w) + sh.w);
      *(bf16x4*)(U + (size_t)row * 1024 + col) = o;
    }
  }
}

enum { EPI_EVEN_IN = 0, EPI_ODD_IN = 1, EPI_RELU2 = 2, EPI_RESID = 3 };

DI void gemm_phase(const DP& p, int mode, const bfr* __restrict__ A, int lda, const bfr* __restrict__ Bt,
                   int N, int K, int layer, int gchunk) {
  const int tid = p.tidl, lane = tid & 63, wid = tid >> 6, r = lane & 31, h = lane >> 5;
  const int wm = wid >> 1, wn = wid & 1;
  const int nN = (N + 127) >> 7, nM = R / 128;
  const int tiles = nM * nN, G = (int)gridDim.x;
  int full = tiles, tail = 0, St = 1;
  if (mode == EPI_RESID) {
    full = (tiles / G) * G; tail = tiles - full;
    if (tail > 0) { int c = G / tail; int kmax = K >> 7; St = 1; while (St * 2 <= c && St * 2 <= 16 && St * 2 <= kmax) St *= 2; }
  }
  const int chunk = (full + 7) >> 3;
  const int units = chunk * 8 + tail * St;
  bfr* sm = (bfr*)smem;
  const int lrow = tid >> 3, lc = (tid & 7) * 8;
#pragma unroll 1
  for (int u = p.bidl; u < units; u += G) {
    int t, ks, Ks; bool atom;
    if (u < chunk * 8) {
      t = (u & 7) * chunk + (u >> 3);
      if (t >= full) continue;
      ks = 0; Ks = K; atom = false;
    } else { const int v = u - chunk * 8; t = full + v / St; ks = v % St; Ks = K / St; atom = St > 1; }
    const int nk = Ks >> 6;
    const int panel = t / (nM * 8); const int rem = t - panel * nM * 8;
    const int pw = (nN - panel * 8) < 8 ? (nN - panel * 8) : 8;
    const int tm = rem / pw, tn = panel * 8 + rem % pw;
    const int m0 = tm * 128, n0 = tn * 128, kbase = ks * Ks;
    f32x16 acc[2][2];
    acc[0][0] = zero16(); acc[0][1] = zero16(); acc[1][0] = zero16(); acc[1][1] = zero16();
    const bfr* Ag = A + (size_t)(m0 + lrow) * lda + kbase + lc;
    const bfr* Bg = Bt + (size_t)(n0 + lrow) * K + kbase + lc;
    bf16x8 ra[4], rb[4];
#pragma unroll
    for (int i = 0; i < 4; ++i) {
      ra[i] = *(const bf16x8*)(Ag + (size_t)(32 * i) * lda);
      rb[i] = *(const bf16x8*)(Bg + (size_t)(32 * i) * K);
    }
#pragma unroll
    for (int i = 0; i < 4; ++i) {
      *(bf16x8*)(sm + (lrow + 32 * i) * 72 + lc) = ra[i];
      *(bf16x8*)(sm + 9216 + (lrow + 32 * i) * 72 + lc) = rb[i];
    }
    __syncthreads();
    for (int kt = 0; kt < nk; ++kt) {
      if (kt + 1 < nk) {
#pragma unroll
        for (int i = 0; i < 4; ++i) {
          ra[i] = *(const bf16x8*)(Ag + (size_t)(32 * i) * lda + (kt + 1) * 64);
          rb[i] = *(const bf16x8*)(Bg + (size_t)(32 * i) * K + (kt + 1) * 64);
        }
      }
      const bfr* As = sm + (kt & 1) * 18432;
      const bfr* Bs = As + 9216;
#pragma unroll
      for (int kk = 0; kk < 4; ++kk) {
        bf16x8 a0 = *(const bf16x8*)(As + (wm * 64 + r) * 72 + kk * 16 + h * 8);
        bf16x8 a1 = *(const bf16x8*)(As + (wm * 64 + 32 + r) * 72 + kk * 16 + h * 8);
        bf16x8 b0 = *(const bf16x8*)(Bs + (wn * 64 + r) * 72 + kk * 16 + h * 8);
        bf16x8 b1 = *(const bf16x8*)(Bs + (wn * 64 + 32 + r) * 72 + kk * 16 + h * 8);
        acc[0][0] = MFMA(a0, b0, acc[0][0]);
        acc[0][1] = MFMA(a0, b1, acc[0][1]);
        acc[1][0] = MFMA(a1, b0, acc[1][0]);
        acc[1][1] = MFMA(a1, b1, acc[1][1]);
      }
      if (kt + 1 < nk) {
        bfr* Ad = sm + ((kt + 1) & 1) * 18432;
#pragma unroll
        for (int i = 0; i < 4; ++i) {
          *(bf16x8*)(Ad + (lrow + 32 * i) * 72 + lc) = ra[i];
          *(bf16x8*)(Ad + 9216 + (lrow + 32 * i) * 72 + lc) = rb[i];
        }
      }
      __syncthreads();
    }
#pragma unroll
    for (int mi = 0; mi < 2; ++mi)
#pragma unroll
      for (int ni = 0; ni < 2; ++ni)
#pragma unroll
        for (int g4 = 0; g4 < 4; ++g4) {
          const int row = m0 + wm * 64 + mi * 32 + 8 * g4 + 4 * h;
          const int col = n0 + wn * 64 + ni * 32 + r;
          const float v0 = acc[mi][ni][4 * g4], v1 = acc[mi][ni][4 * g4 + 1], v2 = acc[mi][ni][4 * g4 + 2], v3 = acc[mi][ni][4 * g4 + 3];
          if (mode == EPI_EVEN_IN) {
            if (col < 1024) {
              bfr* dst = wsp<bfr>(p, col < 512 ? OFF_ZRT : OFF_ZIT) + (size_t)(col & 511) * R + row;
              *(bf16x4*)dst = pack4(v0, v1, v2, v3);
            } else if (col < 2560) {
              bfr* dst = wsp<bfr>(p, OFF_Z) + (size_t)row * 1536 + (col - 1024);
              dst[0] = f2bf(v0); dst[1536] = f2bf(v1); dst[2 * 1536] = f2bf(v2); dst[3 * 1536] = f2bf(v3);
            } else if (col < 5120) {
              bfr* dst = wsp<bfr>(p, OFF_XBC) + (size_t)row * 2560 + (col - 2560);
              dst[0] = f2bf(v0); dst[2560] = f2bf(v1); dst[2 * 2560] = f2bf(v2); dst[3 * 2560] = f2bf(v3);
            } else if (col < 5168) {
              float* dst = wsp<float>(p, OFF_DTRAW) + (size_t)row * 48 + (col - 5120);
              dst[0] = v0; dst[48] = v1; dst[96] = v2; dst[144] = v3;
            }
          } else if (mode == EPI_ODD_IN) {
            if (col >= 640 && col < 768) {
              *(bf16x4*)(wsp<bfr>(p, OFF_VT) + (size_t)(col - 640) * R + row) = pack4(v0, v1, v2, v3);
            } else if (col >= 1792) {
              *(bf16x4*)(wsp<bfr>(p, OFF_VT) + (size_t)(128 + col - 1792) * R + row) = pack4(v0, v1, v2, v3);
            } else {
              bfr* dst = wsp<bfr>(p, OFF_P) + (size_t)row * 2304 + col;
              dst[0] = f2bf(v0); dst[2304] = f2bf(v1); dst[2 * 2304] = f2bf(v2); dst[3 * 2304] = f2bf(v3);
            }
          } else if (mode == EPI_RELU2) {
            bfr* dst = wsp<bfr>(p, OFF_ACT) + (size_t)row * 4096 + col;
            float t0 = fmaxf(v0, 0.f), t1 = fmaxf(v1, 0.f), t2 = fmaxf(v2, 0.f), t3 = fmaxf(v3, 0.f);
            dst[0] = f2bf(t0 * t0); dst[4096] = f2bf(t1 * t1); dst[2 * 4096] = f2bf(t2 * t2); dst[3 * 4096] = f2bf(t3 * t3);
          } else if (mode == EPI_RESID) {
            const int ms = row < RL ? (row >> 13) : 2;
            const float gate = wsp<float>(p, OFF_MOD)[(layer * 3 + ms) * 6144 + gchunk * 1024 + col];
            float* hp = row < RL ? p.out + (size_t)row * 1024 + col : wsp<float>(p, OFF_HC) + (size_t)(row - RL) * 1024 + col;
            if (atom) {
              unsafeAtomicAdd(hp, gate * v0); unsafeAtomicAdd(hp + 1024, gate * v1);
              unsafeAtomicAdd(hp + 2048, gate * v2); unsafeAtomicAdd(hp + 3072, gate * v3);
            } else {
              hp[0] += gate * v0; hp[1024] += gate * v1; hp[2048] += gate * v2; hp[3072] += gate * v3;
            }
          }
        }
  }
}

DI float softplus_f(float x) { return x > 0.f ? x + log1pf(expf(-x)) : log1pf(expf(x)); }

DI void conv_dt_phase(const DP& p, int j) {
  const int tid = p.tidl, lane = tid & 63, wid = tid >> 6;
  const bfr* XBC = wsp<bfr>(p, OFF_XBC);
  bfr* XT = wsp<bfr>(p, OFF_XT); bfr* BN = wsp<bfr>(p, OFF_BN); bfr* BTt = wsp<bfr>(p, OFF_BT); bfr* CN = wsp<bfr>(p, OFF_CN);
  bfr* TT = (bfr*)smem;
  const float* cw = p.conv_w + (size_t)j * 5 * 2560;
  const float* cb = p.conv_b + (size_t)j * 2560;
  const int n_conv = 264 * 40, n_dt = 792;
  for (int u = p.bidl; u < n_conv + n_dt; u += gridDim.x) {
    if (u < n_conv) {
      const int tb = u / 40, cbk = u % 40, row0 = tb * 64, ch0 = cbk * 64;
      int pos0, len;
      if (row0 < RL) { pos0 = row0 & 8191; len = SEQ; } else { pos0 = (row0 - RL) & 255; len = CTX; }
      const int c8 = tid & 7, ch = ch0 + c8 * 8;
      float w[5][8], bias[8];
#pragma unroll
      for (int k = 0; k < 5; ++k) {
        float4 wa = *(const float4*)(cw + k * 2560 + ch), wb = *(const float4*)(cw + k * 2560 + ch + 4);
        w[k][0] = wa.x; w[k][1] = wa.y; w[k][2] = wa.z; w[k][3] = wa.w; w[k][4] = wb.x; w[k][5] = wb.y; w[k][6] = wb.z; w[k][7] = wb.w;
      }
      {
        float4 wa = *(const float4*)(cb + ch), wb = *(const float4*)(cb + ch + 4);
        bias[0] = wa.x; bias[1] = wa.y; bias[2] = wa.z; bias[3] = wa.w; bias[4] = wb.x; bias[5] = wb.y; bias[6] = wb.z; bias[7] = wb.w;
      }
#pragma unroll
      for (int ps = 0; ps < 2; ++ps) {
        const int tl = (tid >> 3) + 32 * ps, pos = pos0 + tl, row = row0 + tl;
        float a[8];
#pragma unroll
        for (int e = 0; e < 8; ++e) a[e] = bias[e];
#pragma unroll
        for (int k = 0; k < 5; ++k) {
          int pp = pos + k - 2;
          if (pp >= 0 && pp < len) {
            bf16x8 xv = *(const bf16x8*)(XBC + (size_t)(row + k - 2) * 2560 + ch);
#pragma unroll
            for (int e = 0; e < 8; ++e) a[e] += w[k][e] * bfs(xv[e]);
          }
        }
        bf16x8 o;
#pragma unroll
        for (int e = 0; e < 8; ++e) { float s = a[e] / (1.f + __expf(-a[e])); o[e] = (short)f2bf(s); }
        if (ch0 >= 2048) *(bf16x8*)(CN + (size_t)row * 512 + (ch - 2048)) = o;
        else if (ch0 >= 1536) *(bf16x8*)(BN + (size_t)row * 512 + (ch - 1536)) = o;
        if (ch0 < 2048) {
#pragma unroll
          for (int e = 0; e < 8; ++e) TT[(c8 * 8 + e) * 72 + tl] = (bfr)o[e];
        }
      }
      if (ch0 < 2048) {
        __syncthreads();
        const int chl = tid >> 2, tseg = (tid & 3) * 16;
        bfr* dst = (ch0 < 1536 ? XT + (size_t)(ch0 + chl) * R : BTt + (size_t)(ch0 - 1536 + chl) * R) + row0 + tseg;
        *(bf16x8*)dst = *(const bf16x8*)(TT + chl * 72 + tseg);
        *(bf16x8*)(dst + 8) = *(const bf16x8*)(TT + chl * 72 + tseg + 8);
        __syncthreads();
      }
    } else {
      const int item = (u - n_conv) * 4 + wid;
      const int head = item % 24; int rest = item / 24; const int dir = rest & 1; rest >>= 1; const int c = rest % NCH, b = rest / NCH;
      const int row0 = chunk_row0(b, c), col = dir * 24 + head;
      const float bias = p.dt_bias[j * 48 + col];
      const float a = -expf(p.a_log[j * 48 + col]);
      const float* DTRAW = wsp<float>(p, OFF_DTRAW);
      float dt[4], cs[4];
      float run = 0.f;
#pragma unroll
      for (int q = 0; q < 4; ++q) {
        dt[q] = softplus_f(DTRAW[(size_t)(row0 + lane * 4 + q) * 48 + col] + bias);
        run += dt[q] * a; cs[q] = run;
      }
      float x = run;
#pragma unroll
      for (int o = 1; o < 64; o <<= 1) { float t2 = __shfl_up(x, o); if (lane >= o) x += t2; }
      const float excl = x - run;
      const float total = __shfl(x, 63);
      float ac[4];
#pragma unroll
      for (int q = 0; q < 4; ++q) {
        float inc = excl + cs[q];
        ac[q] = dir == 0 ? inc : total - inc + dt[q] * a;
      }
      const size_t base = ((size_t)(((dir * 2 + b) * NCH + c) * 24 + head)) * 256 + lane * 4;
      *(float4*)(wsp<float>(p, OFF_DTV) + base) = make_float4(dt[0], dt[1], dt[2], dt[3]);
      *(float4*)(wsp<float>(p, OFF_ACUM) + base) = make_float4(ac[0], ac[1], ac[2], ac[3]);
    }
  }
}

DI bf16x8 scale8(bf16x8 a, const float* w) {
  return pack8(bfs(a[0]) * w[0], bfs(a[1]) * w[1], bfs(a[2]) * w[2], bfs(a[3]) * w[3],
               bfs(a[4]) * w[4], bfs(a[5]) * w[5], bfs(a[6]) * w[6], bfs(a[7]) * w[7]);
}

DI void s1_item(const DP& p, int item, int lane) {
  const int r = lane & 31, h = lane >> 5;
  const int head = item % 24; int rest = item / 24; const int dir = rest & 1; rest >>= 1; const int c = rest % NCH, b = rest / NCH;
  const int g = head / 6;
  const int row0 = chunk_row0(b, c);
  const size_t dbase = ((size_t)(((dir * 2 + b) * NCH + c) * 24 + head)) * 256;
  const float* dtv = wsp<float>(p, OFF_DTV) + dbase;
  const float* acm = wsp<float>(p, OFF_ACUM) + dbase;
  const float acend = dir == 0 ? acm[255] : acm[0];
  const bfr* XT = wsp<bfr>(p, OFF_XT); const bfr* BTt = wsp<bfr>(p, OFF_BT);
  bfr* HS = wsp<bfr>(p, OFF_HS) + ((size_t)(((dir * 2 + b) * NCH + c) * 24 + head)) * 8192;
#pragma unroll 1
  for (int pt = 0; pt < 2; ++pt) {
    f32x16 acc[4];
#pragma unroll
    for (int n = 0; n < 4; ++n) acc[n] = zero16();
#pragma unroll 1
    for (int kk = 0; kk < 16; ++kk) {
      const int s0 = kk * 16 + 8 * h;
      float4 d0 = *(const float4*)(dtv + s0), d1 = *(const float4*)(dtv + s0 + 4);
      float4 a0 = *(const float4*)(acm + s0), a1 = *(const float4*)(acm + s0 + 4);
      float w[8];
      w[0] = d0.x * __expf(acend - a0.x); w[1] = d0.y * __expf(acend - a0.y); w[2] = d0.z * __expf(acend - a0.z); w[3] = d0.w * __expf(acend - a0.w);
      w[4] = d1.x * __expf(acend - a1.x); w[5] = d1.y * __expf(acend - a1.y); w[6] = d1.z * __expf(acend - a1.z); w[7] = d1.w * __expf(acend - a1.w);
      bf16x8 af = scale8(*(const bf16x8*)(XT + (size_t)(head * 64 + pt * 32 + r) * R + row0 + s0), w);
#pragma unroll
      for (int nt = 0; nt < 4; ++nt) {
        bf16x8 bfv = *(const bf16x8*)(BTt + (size_t)(g * 128 + nt * 32 + r) * R + row0 + s0);
        acc[nt] = MFMA(af, bfv, acc[nt]);
      }
    }
#pragma unroll
    for (int nt = 0; nt < 4; ++nt)
#pragma unroll
      for (int i = 0; i < 16; ++i) HS[(pt * 32 + crow(i, h)) * 128 + nt * 32 + r] = f2bf(acc[nt][i]);
  }
}

DI void f1_item(const DP& p, int item, int lane) {
  const int r = lane & 31, h = lane >> 5;
  const int l2t = item & 1, m = (item >> 1) & 511, b = item >> 10;
  const bfr* ZRT = wsp<bfr>(p, OFF_ZRT) + (size_t)m * R + b * SEQ + l2t * 32 + r;
  const bfr* ZIT = wsp<bfr>(p, OFF_ZIT) + (size_t)m * R + b * SEQ + l2t * 32 + r;
  const bfr* C128 = wsp<bfr>(p, OFF_C128); const bfr* S128 = wsp<bfr>(p, OFF_S128);
  const float2* TW = wsp<float2>(p, OFF_TW);
  bfr* YR = wsp<bfr>(p, OFF_YR); bfr* YI = wsp<bfr>(p, OFF_YI);
  const int l2 = l2t * 32 + r;
#pragma unroll 1
  for (int mh = 0; mh < 2; ++mh) {
    f32x16 yr[2], yi[2];
#pragma unroll
    for (int i = 0; i < 2; ++i) { yr[i] = zero16(); yi[i] = zero16(); }
#pragma unroll 1
    for (int kk = 0; kk < 8; ++kk) {
      bf16x8 zr, zi, nzr;
#pragma unroll
      for (int jj = 0; jj < 8; ++jj) {
        int l1 = kk * 16 + 8 * h + jj;
        zr[jj] = (short)ZRT[l1 * 64]; zi[jj] = (short)ZIT[l1 * 64];
        nzr[jj] = (short)(zr[jj] ^ (short)0x8000);
      }
#pragma unroll
      for (int m2 = 0; m2 < 2; ++m2) {
        const int mt = mh * 2 + m2;
        bf16x8 ca = *(const bf16x8*)(C128 + (mt * 32 + r) * 128 + kk * 16 + 8 * h);
        bf16x8 sa = *(const bf16x8*)(S128 + (mt * 32 + r) * 128 + kk * 16 + 8 * h);
        yr[m2] = MFMA(ca, zr, yr[m2]); yr[m2] = MFMA(sa, zi, yr[m2]);
        yi[m2] = MFMA(ca, zi, yi[m2]); yi[m2] = MFMA(sa, nzr, yi[m2]);
      }
    }
#pragma unroll
    for (int m2 = 0; m2 < 2; ++m2)
#pragma unroll
      for (int i = 0; i < 16; ++i) {
        int k1 = (mh * 2 + m2) * 32 + crow(i, h);
        float2 t = TW[k1 * l2];
        float a = yr[m2][i], bb = yi[m2][i];
        size_t o = ((size_t)(b * 512 + m) * 128 + k1) * 64 + l2;
        YR[o] = f2bf(a * t.x + bb * t.y);
        YI[o] = f2bf(bb * t.x - a * t.y);
      }
  }
}

DI void f1c_item(const DP& p, int item, int lane) {
  const int r = lane & 31, h = lane >> 5;
  const int mt = item & 15, kt = (item >> 4) & 7, b = item >> 7;
  const int m = mt * 32 + r;
  const bfr* ZRT = wsp<bfr>(p, OFF_ZRT) + (size_t)m * R + RL + b * CTX;
  const bfr* ZIT = wsp<bfr>(p, OFF_ZIT) + (size_t)m * R + RL + b * CTX;
  const bfr* C256 = wsp<bfr>(p, OFF_C256) + (kt * 32 + r) * 256;
  const bfr* S256 = wsp<bfr>(p, OFF_S256) + (kt * 32 + r) * 256;
  f32x16 acc = zero16();
  for (int kk = 0; kk < 16; ++kk) {
    int o = kk * 16 + 8 * h;
    acc = MFMA(*(const bf16x8*)(C256 + o), *(const bf16x8*)(ZRT + o), acc);
    acc = MFMA(*(const bf16x8*)(S256 + o), *(const bf16x8*)(ZIT + o), acc);
  }
  bfr* MIX = wsp<bfr>(p, OFF_MIX);
#pragma unroll
  for (int i = 0; i < 16; ++i)
    MIX[(size_t)(RL + b * CTX + kt * 32 + crow(i, h)) * 2048 + m] = f2bf(acc[i] * (1.f / 128.f));
}

DI void s1f1_phase(const DP& p) {
  const int lane = p.tidl & 63;
  const int wg = p.bidl * 4 + (p.tidl >> 6), nw = gridDim.x * 4;
  const int n_s1 = 2 * NCH * 2 * 24, n_f1 = 2048, n_f1c = 256;
#pragma unroll 1
  for (int it = wg; it < n_s1 + n_f1 + n_f1c; it += nw) {
    if (it < n_s1) s1_item(p, it, lane);
    else if (it < n_s1 + n_f1) f1_item(p, it - n_s1, lane);
    else f1c_item(p, it - n_s1 - n_f1, lane);
  }
}

DI void f2_item(const DP& p, int item, int lane) {
  const int r = lane & 31, h = lane >> 5;
  const int mt16 = item & 15, k1 = (item >> 4) & 127, b = item >> 11;
  const int m = mt16 * 32 + r;
  const bfr* YR = wsp<bfr>(p, OFF_YR) + ((size_t)(b * 512 + m) * 128 + k1) * 64;
  const bfr* YI = wsp<bfr>(p, OFF_YI) + ((size_t)(b * 512 + m) * 128 + k1) * 64;
  const bfr* C64 = wsp<bfr>(p, OFF_C64); const bfr* S64 = wsp<bfr>(p, OFF_S64);
  f32x16 acc[2]; acc[0] = zero16(); acc[1] = zero16();
#pragma unroll
  for (int kk = 0; kk < 4; ++kk) {
    bf16x8 yr = *(const bf16x8*)(YR + kk * 16 + 8 * h), yi = *(const bf16x8*)(YI + kk * 16 + 8 * h);
#pragma unroll
    for (int t = 0; t < 2; ++t) {
      bf16x8 ca = *(const bf16x8*)(C64 + (t * 32 + r) * 64 + kk * 16 + 8 * h);
      bf16x8 sa = *(const bf16x8*)(S64 + (t * 32 + r) * 64 + kk * 16 + 8 * h);
      acc[t] = MFMA(ca, yr, acc[t]); acc[t] = MFMA(sa, yi, acc[t]);
    }
  }
  bfr* MIX = wsp<bfr>(p, OFF_MIX);
  const float scale = 0.001381067932f;
#pragma unroll
  for (int t = 0; t < 2; ++t)
#pragma unroll
    for (int i = 0; i < 16; ++i) {
      int k2 = t * 32 + crow(i, h);
      MIX[(size_t)(b * SEQ + k1 + 128 * k2) * 2048 + m] = f2bf(acc[t][i] * scale);
    }
}

DI void s2f2_phase(const DP& p) {
  const int gt = p.bidl * 256 + p.tidl, nt = gridDim.x * 256;
  bfr* HSb = wsp<bfr>(p, OFF_HS);
  const float* ACUM = wsp<float>(p, OFF_ACUM);
#pragma unroll 1
  for (int it = gt; it < 2 * 2 * 24 * 2048; it += nt) {
    const int e4 = it & 2047; const int rest = it >> 11; const int head = rest % 24, db = rest / 24, dir = db >> 1;
    bf16x4 sv[NCH]; float cd[NCH];
#pragma unroll
    for (int step = 0; step < NCH; ++step) {
      const int c = dir == 0 ? step : (step == 0 ? 0 : NCH - step);
      const size_t ci = (size_t)((db * NCH + c) * 24 + head);
      sv[step] = *(const bf16x4*)(HSb + ci * 8192 + e4 * 4);
      cd[step] = ACUM[ci * 256 + (dir == 0 ? 255 : 0)];
    }
    float h0 = 0.f, h1 = 0.f, h2 = 0.f, h3 = 0.f;
#pragma unroll
    for (int step = 0; step < NCH; ++step) {
      const int c = dir == 0 ? step : (step == 0 ? 0 : NCH - step);
      const size_t ci = (size_t)((db * NCH + c) * 24 + head);
      *(bf16x4*)(HSb + ci * 8192 + e4 * 4) = pack4(h0, h1, h2, h3);
      const float e = __expf(cd[step]);
      h0 = h0 * e + bfs(sv[step][0]); h1 = h1 * e + bfs(sv[step][1]); h2 = h2 * e + bfs(sv[step][2]); h3 = h3 * e + bfs(sv[step][3]);
    }
  }
  const int lane = p.tidl & 63;
  const int wg = p.bidl * 4 + (p.tidl >> 6), nw = gridDim.x * 4;
#pragma unroll 1
  for (int it = wg; it < 4096; it += nw) f2_item(p, it, lane);
}

DI void s3_phase(const DP& p, int j) {
  const int tid = p.tidl, lane = tid & 63, wid = tid >> 6, r = lane & 31, h = lane >> 5;
  const bfr* CN = wsp<bfr>(p, OFF_CN); const bfr* BN = wsp<bfr>(p, OFF_BN); const bfr* XT = wsp<bfr>(p, OFF_XT);
  const bfr* Z = wsp<bfr>(p, OFF_Z); bfr* MIX = wsp<bfr>(p, OFF_MIX);
  bfr* XTs = (bfr*)smem;
  bfr* HSF = (bfr*)(smem + 33792);
  bfr* HSB = (bfr*)(smem + 51200);
  float* LWF = (float*)(smem + 68608);
  float* LWB = LWF + 256;
#pragma unroll 1
  for (int item = p.bidl; item < 2 * NCH * 4 * 2; item += (int)gridDim.x) {
    const int half = item & 1, g = (item >> 1) & 3; const int bc = item >> 3; const int c = bc % NCH, b = bc / NCH;
    const int row0 = chunk_row0(b, c);
    const int lt = half * 4 + wid;
    const int rowl = row0 + lt * 32 + r;
    const bfr* cfp = CN + (size_t)rowl * 512 + g * 128 + 8 * h;
    bf16x8 gtp[8][2];
    {
      bf16x8 cf[8];
#pragma unroll
      for (int kk = 0; kk < 8; ++kk) cf[kk] = *(const bf16x8*)(cfp + kk * 16);
#pragma unroll
      for (int k = 0; k < 8; ++k) { gtp[k][0] = cf[0]; gtp[k][1] = cf[0]; }
#pragma unroll 1
      for (int st = 0; st < 8; ++st) {
        f32x16 gt = zero16();
#pragma unroll
        for (int kk = 0; kk < 8; ++kk)
          gt = MFMA(*(const bf16x8*)(BN + (size_t)(row0 + st * 32 + r) * 512 + g * 128 + kk * 16 + 8 * h), cf[kk], gt);
#pragma unroll
        for (int k = 0; k < 7; ++k) { gtp[k][0] = gtp[k + 1][0]; gtp[k][1] = gtp[k + 1][1]; }
        gtp[7][0] = PACK_HALF(gt, 0); gtp[7][1] = PACK_HALF(gt, 1);
      }
    }
    float sumsq = 0.f;
#pragma unroll 1
    for (int hh = 0; hh < 6; ++hh) {
      const int head = g * 6 + hh;
      const size_t cif = (size_t)(((0 * 2 + b) * NCH + c) * 24 + head), cib = (size_t)(((1 * 2 + b) * NCH + c) * 24 + head);
      const float* acf = wsp<float>(p, OFF_ACUM) + cif * 256; const float* acb = wsp<float>(p, OFF_ACUM) + cib * 256;
      const float* dtf = wsp<float>(p, OFF_DTV) + cif * 256; const float* dtb = wsp<float>(p, OFF_DTV) + cib * 256;
      const bfr* HSf = wsp<bfr>(p, OFF_HS) + cif * 8192; const bfr* HSbk = wsp<bfr>(p, OFF_HS) + cib * 8192;
      __syncthreads();
#pragma unroll 4
      for (int i = 0; i < 8; ++i) {
        const int idx = tid + 256 * i, row = idx >> 5, c16 = idx & 31;
        *(bf16x8*)(XTs + row * 264 + c16 * 8) = *(const bf16x8*)(XT + (size_t)(head * 64 + row) * R + row0 + c16 * 8);
      }
#pragma unroll 2
      for (int i = 0; i < 4; ++i) {
        const int idx = tid + 256 * i, row = idx >> 4, c16 = idx & 15;
        *(bf16x8*)(HSF + row * 136 + c16 * 8) = *(const bf16x8*)(HSf + row * 128 + c16 * 8);
        *(bf16x8*)(HSB + row * 136 + c16 * 8) = *(const bf16x8*)(HSbk + row * 128 + c16 * 8);
      }
      LWF[tid] = __logf(dtf[tid]) - acf[tid];
      LWB[tid] = __logf(dtb[tid]) - acb[tid];
      const float al_f = acf[lt * 32 + r], al_b = acb[lt * 32 + r];
      __syncthreads();
      f32x16 acc[2];
      {
        f32x16 t0 = zero16(), t1 = zero16();
#pragma unroll
        for (int kk = 0; kk < 8; ++kk) {
          const bf16x8 cfk = *(const bf16x8*)(cfp + kk * 16);
          t0 = MFMA(*(const bf16x8*)(HSF + (r) * 136 + kk * 16 + 8 * h), cfk, t0);
          t1 = MFMA(*(const bf16x8*)(HSF + (32 + r) * 136 + kk * 16 + 8 * h), cfk, t1);
        }
        const float ef = __expf(al_f);
#pragma unroll
        for (int i = 0; i < 16; ++i) { acc[0][i] = t0[i] * ef; acc[1][i] = t1[i] * ef; }
        t0 = zero16(); t1 = zero16();
#pragma unroll
        for (int kk = 0; kk < 8; ++kk) {
          const bf16x8 cfk = *(const bf16x8*)(cfp + kk * 16);
          t0 = MFMA(*(const bf16x8*)(HSB + (r) * 136 + kk * 16 + 8 * h), cfk, t0);
          t1 = MFMA(*(const bf16x8*)(HSB + (32 + r) * 136 + kk * 16 + 8 * h), cfk, t1);
        }
        const float eb = __expf(al_b);
#pragma unroll
        for (int i = 0; i < 16; ++i) { acc[0][i] += t0[i] * eb; acc[1][i] += t1[i] * eb; }
      }
#pragma unroll 1
      for (int st = 0; st < 8; ++st) {
        const bf16x8 g0 = gtp[0][0], g1 = gtp[0][1];
#pragma unroll
        for (int k = 0; k < 7; ++k) { gtp[k][0] = gtp[k + 1][0]; gtp[k][1] = gtp[k + 1][1]; }
        gtp[7][0] = g0; gtp[7][1] = g1;
#pragma unroll 1
        for (int dir = 0; dir < 2; ++dir) {
          if (dir == 0 ? (st > lt) : (st < lt)) continue;
          const float* lwd = dir == 0 ? LWF : LWB;
          const float al = dir == 0 ? al_f : al_b;
          f32x16 mm;
#pragma unroll
          for (int g4 = 0; g4 < 4; ++g4) {
            const int sb = st * 32 + 8 * g4 + 4 * h;
            const float4 l4 = *(const float4*)(lwd + sb);
            const float lv[4] = {l4.x, l4.y, l4.z, l4.w};
#pragma unroll
            for (int q = 0; q < 4; ++q) {
              const int i = 4 * g4 + q;
              const int sidx = sb + q, lidx = lt * 32 + r;
              const bool valid = dir == 0 ? (sidx <= lidx) : (sidx >= lidx);
              const float gv = bfs((i >> 3) ? g1[i & 7] : g0[i & 7]);
              const float e = __expf(fminf(al + lv[q], 30.f));
              mm[i] = valid ? gv * e : 0.f;
            }
          }
#pragma unroll
          for (int s2 = 0; s2 < 2; ++s2) {
            bf16x8 pf = PACK_HALF(mm, s2);
#pragma unroll
            for (int pt = 0; pt < 2; ++pt) {
              const bfr* xp = XTs + (pt * 32 + r) * 264 + st * 32 + 16 * s2 + 4 * h;
              bf16x8 xf = join44(*(const bf16x4*)xp, *(const bf16x4*)(xp + 8));
              acc[pt] = MFMA(xf, pf, acc[pt]);
            }
          }
        }
      }
      const float dsk = p.d_skip[j * 24 + head];
#pragma unroll
      for (int pt = 0; pt < 2; ++pt)
#pragma unroll
        for (int g4 = 0; g4 < 4; ++g4) {
          const int pb = pt * 32 + 8 * g4 + 4 * h;
          bf16x4 zv = *(const bf16x4*)(Z + (size_t)rowl * 1536 + head * 64 + pb);
          float y[4];
#pragma unroll
          for (int q = 0; q < 4; ++q) {
            float xv = bf2f(XTs[(pb + q) * 264 + lt * 32 + r]);
            float zz = bfs(zv[q]);
            float v = (acc[pt][4 * g4 + q] + dsk * xv) * (zz / (1.f + __expf(-zz)));
            sumsq += v * v; y[q] = v;
          }
          *(bf16x4*)(MIX + (size_t)rowl * 2048 + 512 + head * 64 + pb) = pack4(y[0], y[1], y[2], y[3]);
        }
    }
    const float tot = sumsq + __shfl_xor(sumsq, 32);
    const float sc = rsqrtf(tot * (1.f / 384.f) + 1e-6f);
    const float* ng = p.ssd_norm_g + (size_t)j * 1536;
#pragma unroll 1
    for (int hh = 0; hh < 6; ++hh) {
      const int head = g * 6 + hh;
#pragma unroll
      for (int pt = 0; pt < 2; ++pt)
#pragma unroll
        for (int g4 = 0; g4 < 4; ++g4) {
          const int pb = pt * 32 + 8 * g4 + 4 * h;
          bfr* mp = MIX + (size_t)rowl * 2048 + 512 + head * 64 + pb;
          bf16x4 yv = *(const bf16x4*)mp;
          float4 gg = *(const float4*)(ng + head * 64 + pb);
          *(bf16x4*)mp = pack4(bfs(yv[0]) * sc * gg.x, bfs(yv[1]) * sc * gg.y, bfs(yv[2]) * sc * gg.z, bfs(yv[3]) * sc * gg.w);
        }
    }
  }
}

DI void qkprep_phase(const DP& p, int j) {
  const int lane = p.tidl & 63;
  const int wg = p.bidl * 4 + (p.tidl >> 6), nw = gridDim.x * 4;
  const bfr* P = wsp<bfr>(p, OFF_P); bfr* QK = wsp<bfr>(p, OFF_QK);
  const float* ROPE = wsp<float>(p, OFF_ROPE);
  const int sub = lane >> 3, d0 = (lane & 7) * 8;
  for (int row = wg; row < R; row += nw) {
#pragma unroll
    for (int ps = 0; ps < 4; ++ps) {
      const int hs = ps * 8 + sub;
      const bool act = hs < 26;
      const int hsc = act ? hs : 25;
      const int col = hsc < 10 ? hsc * 64 : 768 + (hsc - 10) * 64;
      bf16x8 xv = *(const bf16x8*)(P + (size_t)row * 2304 + col + d0);
      float x[8]; float ss = 0.f;
#pragma unroll
      for (int e = 0; e < 8; ++e) { x[e] = bfs(xv[e]); ss += x[e] * x[e]; }
      ss += __shfl_xor(ss, 1); ss += __shfl_xor(ss, 2); ss += __shfl_xor(ss, 4);
      const float rs = rsqrtf(ss * (1.f / 64.f) + 1e-6f);
      const float* gv = hsc < 8 ? p.q_norm_win + j * 64 : hsc < 10 ? p.k_norm_win + j * 64 : hsc < 18 ? p.q_norm_na + j * 64 : p.k_norm_na + j * 64;
#pragma unroll
      for (int e = 0; e < 8; ++e) x[e] = x[e] * rs * gv[d0 + e];
      float pr[8];
#pragma unroll
      for (int e = 0; e < 8; ++e) pr[e] = __shfl_xor(x[e], 2);
      if (hsc < 10 && row < RL) {
        const int pos = row & 8191;
        const int axis = d0 >> 5;
        const int idx = axis == 0 ? (pos >> 6) : (pos & 63);
        const int f0 = d0 & 15;
        const bool second = (d0 & 16) != 0;
        const float* cp = ROPE + (axis * 128 + idx) * 16 + f0;
        const float* sp = cp + 4096;
#pragma unroll
        for (int e = 0; e < 8; ++e) {
          float cs = cp[e], sn = sp[e];
          x[e] = second ? (x[e] * cs + pr[e] * sn) : (x[e] * cs - pr[e] * sn);
        }
      }
      const bool isq = hsc < 8 || (hsc >= 10 && hsc < 18);
      const float qs = isq ? 0.125f : 1.f;
      if (act) *(bf16x8*)(QK + (size_t)row * 1664 + hsc * 64 + d0) = pack8(x[0] * qs, x[1] * qs, x[2] * qs, x[3] * qs, x[4] * qs, x[5] * qs, x[6] * qs, x[7] * qs);
    }
  }
}

struct KVF { bf16x8 k[4]; bf16x8 v[2][2]; };
struct KVS { bf16x8 k[4]; bf16x8 v[4]; };

DI void kv_gload(KVS& g, const bfr* __restrict__ Kt, const bfr* __restrict__ Vt, int lane) {
#pragma unroll
  for (int i = 0; i < 4; ++i) {
    const int idx = lane + 64 * i;
    g.k[i] = *(const bf16x8*)(Kt + (size_t)(idx >> 3) * 1664 + (idx & 7) * 8);
    g.v[i] = *(const bf16x8*)(Vt + (size_t)(idx >> 2) * R + (idx & 3) * 8);
  }
}
DI void kv_sstore(const KVS& g, unsigned char* base, int lane) {
#pragma unroll
  for (int i = 0; i < 4; ++i) {
    const int idx = lane + 64 * i;
    { const int row = idx >> 3, c = idx & 7; *(bf16x8*)(base + row * 128 + ((c ^ (row & 7)) << 4)) = g.k[i]; }
    {
      const int d = idx >> 2, c16 = idx & 3, sw = (d >> 2) & 7;
      bf16x4 lo = __builtin_shufflevector(g.v[i], g.v[i], 0, 1, 2, 3), hi = __builtin_shufflevector(g.v[i], g.v[i], 4, 5, 6, 7);
      *(bf16x4*)(base + 4096 + d * 64 + (((2 * c16) ^ sw) << 3)) = lo;
      *(bf16x4*)(base + 4096 + d * 64 + (((2 * c16 + 1) ^ sw) << 3)) = hi;
    }
  }
}
DI void kv_sload(KVF& f, const unsigned char* base, int r, int h) {
#pragma unroll
  for (int kk = 0; kk < 4; ++kk) f.k[kk] = *(const bf16x8*)(base + r * 128 + (((2 * kk + h) ^ (r & 7)) << 4));
#pragma unroll
  for (int s2 = 0; s2 < 2; ++s2)
#pragma unroll
    for (int dt = 0; dt < 2; ++dt) {
      const int d = dt * 32 + r, sw = (d >> 2) & 7, c8 = 4 * s2 + h;
      const unsigned char* vb = base + 4096 + d * 64;
      f.v[s2][dt] = join44(*(const bf16x4*)(vb + ((c8 ^ sw) << 3)), *(const bf16x4*)(vb + (((c8 + 2) ^ sw) << 3)));
    }
}

DI void attn_compute(f32x16 (&o)[2], float& m, float& l, const unsigned char* qb, const unsigned char* base, int r, int h,
                     int mode, int a0, int a1, const float* __restrict__ rp) {
  f32x16 s = zero16();
#pragma unroll
  for (int kk = 0; kk < 4; ++kk) {
    const int off = r * 128 + (((2 * kk + h) ^ (r & 7)) << 4);
    s = MFMA(*(const bf16x8*)(base + off), *(const bf16x8*)(qb + off), s);
  }
  float tmax = -3.0e38f;
  if (mode == 1) {
#pragma unroll
    for (int i = 0; i < 16; ++i) { int dd = a0 - crow(i, h); dd = dd < 0 ? -dd : dd; s[i] = dd <= 128 ? s[i] : -1.0e30f; }
  } else if (mode == 2) {
#pragma unroll
    for (int i = 0; i < 16; ++i) {
      const int key = crow(i, h);
      const int rel = a0 + key;
      int co = a1 + key; co = co < 0 ? 0 : (co > 30 ? 30 : co);
      s[i] = (rel >= 0 && rel < 16) ? s[i] + rp[co] : -1.0e30f;
    }
  }
#pragma unroll
  for (int i = 0; i < 16; ++i) tmax = fmaxf(tmax, s[i]);
  tmax = fmaxf(tmax, __shfl_xor(tmax, 32));
  const float mn = fmaxf(m, tmax);
  const float alpha = __expf(m - mn);
  float ps = 0.f;
#pragma unroll
  for (int i = 0; i < 16; ++i) { s[i] = __expf(s[i] - mn); ps += s[i]; }
  l = l * alpha + ps; m = mn;
#pragma unroll
  for (int i = 0; i < 16; ++i) { o[0][i] *= alpha; o[1][i] *= alpha; }
#pragma unroll
  for (int s2 = 0; s2 < 2; ++s2) {
    bf16x8 pf = PACK_HALF(s, s2);
#pragma unroll
    for (int dt = 0; dt < 2; ++dt) {
      const int d = dt * 32 + r, sw = (d >> 2) & 7, c8 = 4 * s2 + h;
      const unsigned char* vb = base + 4096 + d * 64;
      bf16x8 vf = join44(*(const bf16x4*)(vb + ((c8 ^ sw) << 3)), *(const bf16x4*)(vb + (((c8 + 2) ^ sw) << 3)));
      o[dt] = MFMA(vf, pf, o[dt]);
    }
  }
}

DI void attn_item(const DP& p, int j, int item, int lane) {
  const int r = lane & 31, h = lane >> 5;
  const bfr* QK = wsp<bfr>(p, OFF_QK); const bfr* VT = wsp<bfr>(p, OFF_VT); bfr* MIX = wsp<bfr>(p, OFF_MIX);
  int kind, b, hd, qt;
  if (item < 4096) { kind = 0; qt = item & 255; hd = (item >> 8) & 7; b = item >> 11; }
  else if (item < 8192) { int v = item - 4096; kind = 1; qt = v & 255; hd = (v >> 8) & 7; b = v >> 11; }
  else if (item < 8320) { int v = item - 8192; kind = 2; qt = v & 7; hd = (v >> 3) & 7; b = v >> 6; }
  else { int v = item - 8320; kind = 3; qt = v & 7; hd = (v >> 3) & 7; b = v >> 6; }
  const bool win = (kind == 0 || kind == 2);
  const bool lat = kind < 2;
  const int q_row0 = lat ? b * SEQ + qt * 32 : RL + b * CTX + qt * 32;
  const int qcol = win ? hd * 64 : (10 + hd) * 64;
  const int kcol = win ? (8 + (hd >> 2)) * 64 : (18 + hd) * 64;
  const bfr* Vb = win ? VT + (size_t)((hd >> 2) * 64) * R : VT + (size_t)(128 + hd * 64) * R;
  const bfr* Kb = QK + kcol;
  f32x16 o[2]; o[0] = zero16(); o[1] = zero16();
  float m = -1.0e30f, l = 0.f;
  if (win) { m = p.sink_win[j * 8 + hd]; l = h == 0 ? 1.f : 0.f; }
  int nloc = 0, lo = 0, gr = 0, kr0 = 0, w = 0, cs = 0;
  const int qpos = qt * 32 + r;
  if (kind == 0) { lo = qt - 4 < 0 ? 0 : qt - 4; const int hi = qt + 4 > 255 ? 255 : qt + 4; nloc = hi - lo + 1; }
  else if (kind == 1) {
    gr = qt >> 1; w = (qt & 1) * 32 + r;
    cs = w - 8; cs = cs < 0 ? 0 : (cs > 48 ? 48 : cs);
    kr0 = gr - 4; kr0 = kr0 < 0 ? 0 : (kr0 > 120 ? 120 : kr0);
    nloc = 16;
  }
  const int ntile = 8 + nloc;
  const float* rpb = p.rpb_na + (size_t)j * 8 * 15 * 31 + hd * 15 * 31;
  auto tile_row = [&](int i) -> int {
    if (i < 8) return RL + b * CTX + i * 32;
    const int li = i - 8;
    if (kind == 0) return b * SEQ + (lo + li) * 32;
    return b * SEQ + (kr0 + (li >> 1)) * 64 + (li & 1) * 32;
  };
  unsigned char* lbase = smem + (p.tidl >> 6) * 12288;
  asm volatile("" ::: "memory");
#pragma unroll
  for (int i = 0; i < 4; ++i) {
    const int idx = lane + 64 * i, row = idx >> 3, c = idx & 7;
    *(bf16x8*)(lbase + 8192 + row * 128 + ((c ^ (row & 7)) << 4)) = *(const bf16x8*)(QK + (size_t)(q_row0 + row) * 1664 + qcol + c * 8);
  }
  KVS g;
  { const int k0 = tile_row(0); kv_gload(g, Kb + (size_t)k0 * 1664, Vb + k0, lane); }
  kv_sstore(g, lbase, lane);
#pragma unroll 1
  for (int i = 0; i < ntile; ++i) {
    { const int in = i + 1 < ntile ? i + 1 : i; const int k0 = tile_row(in); kv_gload(g, Kb + (size_t)k0 * 1664, Vb + k0, lane); }
    int mode = 0, a0 = 0, a1 = 0; const float* rp = rpb;
    if (i >= 8) {
      const int li = i - 8;
      if (kind == 0) { mode = 1; a0 = qpos - (lo + li) * 32; }
      else { mode = 2; const int krow = kr0 + (li >> 1); const int ub = (li & 1) * 32; a0 = ub - cs; a1 = ub - w + 15; rp = rpb + (krow - gr + 7) * 31; }
    }
    asm volatile("" ::: "memory");
    attn_compute(o, m, l, lbase + 8192, lbase, r, h, mode, a0, a1, rp);
    asm volatile("" ::: "memory");
    kv_sstore(g, lbase, lane);
  }
  asm volatile("" ::: "memory");
  const float lt = l + __shfl_xor(l, 32);
  const float inv = 1.f / lt;
  const int ocol = win ? hd * 64 : 512 + hd * 64;
#pragma unroll
  for (int dt = 0; dt < 2; ++dt)
#pragma unroll
    for (int g4 = 0; g4 < 4; ++g4) {
      const int d = dt * 32 + 8 * g4 + 4 * h;
      *(bf16x4*)(MIX + (size_t)(q_row0 + r) * 1024 + ocol + d) =
          pack4(o[dt][4 * g4] * inv, o[dt][4 * g4 + 1] * inv, o[dt][4 * g4 + 2] * inv, o[dt][4 * g4 + 3] * inv);
    }
}

DI void attn_phase(const DP& p, int j) {
  const int lane = p.tidl & 63;
  const int wg = p.bidl * 4 + (p.tidl >> 6), nw = gridDim.x * 4;
#pragma unroll 1
  for (int it = wg; it < 8448; it += nw) attn_item(p, j, it, lane);
}

#define XB_TMO      128
#define XB_XCNT(j)  (256  + 64 * (j))
#define XB_XSUB(j)  (1280 + 64 * (j))
#define XB_XGEN(j)  (2304 + 64 * (j))
#define XB_TOP      3328
#define XB_TOPGEN   3392
#define XCD_BAR_WORDS 3456
#define XB_SPIN_CAP (1u << 18)
#define LAS __attribute__((address_space(3)))

__device__ __forceinline__ unsigned xb_ld(unsigned* p)              { return __hip_atomic_load(p, __ATOMIC_RELAXED, __HIP_MEMORY_SCOPE_AGENT); }
__device__ __forceinline__ unsigned xb_add(unsigned* p, unsigned v) { return __hip_atomic_fetch_add(p, v, __ATOMIC_RELAXED, __HIP_MEMORY_SCOPE_AGENT); }
__device__ __forceinline__ unsigned xb_xcc_id() { return (unsigned)__builtin_amdgcn_s_getreg((3 << 11) | 20) & 0xFu; }
#define XB_SPIN(cond, bar) do { unsigned _sp = 0; while (cond) { __builtin_amdgcn_s_sleep(1); \
    if ((++_sp & 255u) == 0u) { if (xb_ld(&(bar)[XB_TMO])) break; if (_sp > XB_SPIN_CAP) { atomicAdd(&(bar)[XB_TMO], 1u); break; } } } } while (0)

struct XcdBarrier {
    unsigned* bar; unsigned x;
    volatile LAS unsigned* st;
};

__device__ __forceinline__ XcdBarrier xcd_barrier_post(unsigned* bar, volatile LAS unsigned* st) {
    XcdBarrier b; b.bar = bar; b.x = xb_xcc_id(); b.st = st;
    if (threadIdx.x == 0) (void)xb_add(&bar[XB_XCNT(b.x)], 1u);
    return b;
}
__device__ __forceinline__ void xcd_barrier_complete(unsigned* bar, unsigned x, unsigned& nloc, unsigned& nx) {
    const unsigned G = gridDim.x * gridDim.y * gridDim.z;
    unsigned sum, cnt, mine, sp = 0u;
    for (;;) {
        sum = 0u; cnt = 0u; mine = 0u;
#pragma unroll
        for (unsigned j = 0; j < 16; ++j) { const unsigned c = xb_ld(&bar[XB_XCNT(j)]); sum += c; cnt += (c > 0u) ? 1u : 0u; mine = (j == x) ? c : mine; }
        if (sum == G) break;
        __builtin_amdgcn_s_sleep(1);
        if ((++sp & 255u) == 0u) { if (xb_ld(&bar[XB_TMO])) break; if (sp > XB_SPIN_CAP) { atomicAdd(&bar[XB_TMO], 1u); break; } }
    }
    nloc = mine > 0u ? mine : 1u; nx = cnt > 0u ? cnt : 1u;
}

__device__ __forceinline__ void xcd_barrier(const XcdBarrier& b) {
    asm volatile("s_waitcnt vmcnt(0)" ::: "memory");
    __syncthreads();
    if (threadIdx.x == 0) {
        unsigned* bar = b.bar;
        __builtin_amdgcn_s_waitcnt(0);
        unsigned nloc = b.st[0], nx = b.st[1];
        if (nloc == 0u) { xcd_barrier_complete(bar, b.x, nloc, nx); b.st[0] = nloc; b.st[1] = nx; }
        const unsigned old = xb_add(&bar[XB_XSUB(b.x)], 1u);
        const unsigned gen = old / nloc;
        if (old + 1u == (gen + 1u) * nloc) {
            __builtin_amdgcn_fence(__ATOMIC_RELEASE, "agent");
            asm volatile("s_waitcnt vmcnt(0)" ::: "memory");
            const unsigned og = xb_add(&bar[XB_TOP], 1u);
            const unsigned tg = og / nx;
            if (og + 1u == (tg + 1u) * nx) xb_add(&bar[XB_TOPGEN], 1u);
            else XB_SPIN(xb_ld(&bar[XB_TOPGEN]) == tg, bar);
            __builtin_amdgcn_fence(__ATOMIC_ACQUIRE, "agent");
            xb_add(&bar[XB_XGEN(b.x)], 1u);
            asm volatile("s_waitcnt vmcnt(0)" ::: "memory");
        } else {
            XB_SPIN(xb_ld(&bar[XB_XGEN(b.x)]) == gen, bar);
            __builtin_amdgcn_fence(__ATOMIC_ACQUIRE, "agent");
            asm volatile("s_waitcnt vmcnt(0)" ::: "memory");
        }
    }
    __syncthreads();
}


DI void run_phase(const DP& p, int ph, int dry) {
  if (ph == 0) { phase0(p); return; }
  int q = ph - 1, layer, lp;
  if (q < 10) { layer = 0; lp = q; } else if (q < 18) { layer = 1; lp = q - 10; } else if (q < 28) { layer = 2; lp = q - 18; } else { layer = 3; lp = q - 28; }
  const int j = layer >> 1;
  const bool even = (layer & 1) == 0;
  int op, gsel = 0;
  if (even) {
    op = (int)((0x2272654321ull >> (4 * lp)) & 15ull); gsel = (int)((0x3201000000ull >> (4 * lp)) & 15ull);
  } else {
    op = (int)((0x22729821ull >> (4 * lp)) & 15ull); gsel = (int)((0x32010000ull >> (4 * lp)) & 15ull);
  }
  if (op == 1) wconv_phase(p, layer);
  if (op == 1 || op == 7) {
    const bool first = op == 1;
    norm_phase(p, layer, (first ? p.norm_mix_g : p.norm_ff_g) + layer * 1024, first ? 0 : 3, first ? 1 : 4);
  } else if (op == 2) {
    int mode, lda, N, K, gch; size_t offA, offB;
    if (gsel == 0) { mode = even ? EPI_EVEN_IN : EPI_ODD_IN; offA = OFF_MIX; lda = 1024; offB = OFF_WIN; N = even ? 5168 : 2304; K = 1024; gch = 0; }
    else if (gsel == 1) { mode = EPI_RESID; offA = OFF_MIX; lda = even ? 2048 : 1024; offB = OFF_WOUT; N = 1024; K = even ? 2048 : 1024; gch = 2; }
    else if (gsel == 2) { mode = EPI_RELU2; offA = OFF_MIX; lda = 1024; offB = OFF_WFF1; N = 4096; K = 1024; gch = 0; }
    else { mode = EPI_RESID; offA = OFF_ACT; lda = 4096; offB = OFF_WFF2; N = 1024; K = 4096; gch = 5; }
    if (dry && mode == EPI_RESID) mode = 4;
    gemm_phase(p, mode, wsp<bfr>(p, offA), lda, wsp<bfr>(p, offB), N, K, layer, gch);
  } else if (op == 3) conv_dt_phase(p, j);
  else if (op == 4) s1f1_phase(p);
  else if (op == 5) s2f2_phase(p);
  else if (op == 6) s3_phase(p, j);
  else if (op == 8) qkprep_phase(p, j);
  else if (op == 9) attn_phase(p, j);
}

DI int probe_reps(int ph) {
#ifdef PROBE_MASK
  if (ph == 0) return (PROBE_MASK & 1) ? 2 : 1;
  int q = ph - 1, layer, lp;
  if (q < 10) { layer = 0; lp = q; } else if (q < 18) { layer = 1; lp = q - 10; } else if (q < 28) { layer = 2; lp = q - 18; } else { layer = 3; lp = q - 28; }
  const bool even = (layer & 1) == 0;
  int op, gsel;
  if (even) { op = (int)((0x2272654321ull >> (4 * lp)) & 15ull); gsel = (int)((0x3201000000ull >> (4 * lp)) & 15ull); }
  else { op = (int)((0x22729821ull >> (4 * lp)) & 15ull); gsel = (int)((0x32010000ull >> (4 * lp)) & 15ull); }
  if (op == 5) return 1;
  if (op == 2 && (gsel == 1 || gsel == 3)) return ((PROBE_MASK >> 10) & 1) ? 2 : 1;
  return ((PROBE_MASK >> op) & 1) ? 2 : 1;
#else
  return 1;
#endif
}

__shared__ uint4 xb_words;

__global__ void __launch_bounds__(256, 2) mega(Params p, int ph0, int ph1) {
  cg::grid_group grid = cg::this_grid();
  if (threadIdx.x == 0) xb_words = make_uint4(0u, 0u, 0u, 0u);
  __syncthreads();
  XcdBarrier xb = xcd_barrier_post((unsigned*)(p.ws + OFF_BAR), (volatile LAS unsigned*)&xb_words);
#pragma unroll 1
  for (int ph = ph0; ph < ph1; ++ph) {
    const int nrep = probe_reps(ph);
#pragma unroll 1
    for (int rep = 0; rep < nrep; ++rep) {
      DP q;
      (Params&)q = p;
      int t = threadIdx.x, bb = blockIdx.x;
      asm volatile("" : "+v"(t));
      asm volatile("" : "+s"(bb));
      int z0;
      asm volatile("s_mov_b32 %0, 0" : "=s"(z0));
      q.ws = p.ws + z0;
      q.out = p.out + z0;
      q.tidl = t; q.bidl = bb;
      run_phase(q, ph, rep + 1 < nrep);
    }
    if (ph + 1 < ph1) {
      if (ph == ph0) grid.sync();
      else xcd_barrier(xb);
    }
  }
}

extern "C" void kernel_launch(void* const* d_in, const int* in_sizes, int n_in, void* d_out, int out_size, void* d_ws,
                              size_t ws_size, hipStream_t stream) {
  static int grid_blocks = 0;
  if (!grid_blocks) {
    int dev = 0, cus = 0, per_cu = 0;
    hipGetDevice(&dev);
    hipDeviceGetAttribute(&cus, hipDeviceAttributeMultiprocessorCount, dev);
    hipOccupancyMaxActiveBlocksPerMultiprocessor(&per_cu, mega, 256, 0);
    if (per_cu > 2) per_cu = 2;
    if (per_cu < 1) per_cu = 1;
    grid_blocks = cus * per_cu;
  }
  Params p{};
  const float** pp = (const float**)&p;
  for (int i = 0; i < 26; ++i) pp[i] = (const float*)d_in[i];
  p.out = (float*)d_out;
  p.ws = (unsigned char*)d_ws;
  if (ws_size < WS_TOTAL) fprintf(stderr, "workspace too small: %zu < %zu\n", ws_size, (size_t)WS_TOTAL);
  hipMemsetAsync((unsigned char*)d_ws + OFF_BAR, 0, XCD_BAR_WORDS * 4, stream);
#if MULTI_LAUNCH
  for (int ph = 0; ph < NPHASE; ++ph) {
    int a = ph, b = ph + 1;
    void* args[] = {&p, &a, &b};
    hipLaunchCooperativeKernel((void*)mega, dim3(grid_blocks), dim3(256), args, 0, stream);
  }
#else
  int a = 0, b = NPHASE;
  void* args[] = {&p, &a, &b};
  hipError_t e = hipLaunchCooperativeKernel((void*)mega, dim3(grid_blocks), dim3(256), args, 0, stream);
  if (e != hipSuccess) fprintf(stderr, "cooperative launch failed: %s (grid %d)\n", hipGetErrorString(e), grid_blocks);
#endif
}
```

```cpp
#include <hip/hip_runtime.h>
#include <hip/hip_cooperative_groups.h>
#include <cstdio>
namespace cg = cooperative_groups;

typedef unsigned short bfr;
typedef __attribute__((ext_vector_type(8))) short bf16x8;
typedef __attribute__((ext_vector_type(4))) short bf16x4;
typedef __attribute__((ext_vector_type(16))) float f32x16;
#define DI __device__ __forceinline__
#define MFMA(a, b, c) __builtin_amdgcn_mfma_f32_32x32x16_bf16((a), (b), (c), 0, 0, 0)

#ifndef MULTI_LAUNCH
#define MULTI_LAUNCH 0
#endif

constexpr int RL = 16384, R = 16896, SEQ = 8192, CTX = 256;
constexpr int NCH = 33, CL = 256;
constexpr int NPHASE = 37;

constexpr size_t al(size_t x) { return (x + 255) & ~size_t(255); }
constexpr size_t OFF_HC = 0;
constexpr size_t OFF_MOD = OFF_HC + al(512 * 1024 * 4);
constexpr size_t OFF_TW = OFF_MOD + al(4 * 3 * 6144 * 4);
constexpr size_t OFF_C128 = OFF_TW + al(8192 * 8);
constexpr size_t OFF_S128 = OFF_C128 + al(128 * 128 * 2);
constexpr size_t OFF_C64 = OFF_S128 + al(128 * 128 * 2);
constexpr size_t OFF_S64 = OFF_C64 + al(64 * 64 * 2);
constexpr size_t OFF_C256 = OFF_S64 + al(64 * 64 * 2);
constexpr size_t OFF_S256 = OFF_C256 + al(256 * 256 * 2);
constexpr size_t OFF_ROPE = OFF_S256 + al(256 * 256 * 2);
constexpr size_t OFF_DTV = OFF_ROPE + al(2 * 2 * 128 * 16 * 4);
constexpr size_t DT_BYTES = (size_t)2 * 2 * NCH * 24 * 256 * 4;
constexpr size_t OFF_ACUM = OFF_DTV + al(DT_BYTES);
constexpr size_t OFF_WIN = OFF_ACUM + al(DT_BYTES);
constexpr size_t OFF_WOUT = OFF_WIN + al((size_t)5248 * 1024 * 2);
constexpr size_t OFF_WFF1 = OFF_WOUT + al((size_t)1024 * 2048 * 2);
constexpr size_t OFF_WFF2 = OFF_WFF1 + al((size_t)4096 * 1024 * 2);
constexpr size_t OFF_MIX = OFF_WFF2 + al((size_t)4096 * 1024 * 2);
constexpr size_t OFF_BIG = OFF_MIX + al((size_t)R * 2048 * 2);
constexpr size_t OFF_Z = OFF_BIG;
constexpr size_t OFF_ZRT = OFF_Z + (size_t)R * 1536 * 2;
constexpr size_t OFF_ZIT = OFF_ZRT + (size_t)512 * R * 2;
constexpr size_t OFF_XBC = OFF_ZIT + (size_t)512 * R * 2;
constexpr size_t OFF_DTRAW = OFF_XBC + (size_t)R * 2560 * 2;
constexpr size_t BIG_END = OFF_DTRAW + (size_t)R * 48 * 4;
constexpr size_t OFF_HS = OFF_XBC;
constexpr size_t HS_BYTES = (size_t)2 * 2 * NCH * 24 * 8192 * 2;
constexpr size_t OFF_YR = OFF_HS + HS_BYTES;
constexpr size_t OFF_YI = OFF_YR + (size_t)2 * 512 * 128 * 64 * 2;
static_assert(OFF_YI + (size_t)2 * 512 * 128 * 64 * 2 <= OFF_DTRAW, "fft scratch overflows");
constexpr size_t OFF_ACT = OFF_BIG;
static_assert((size_t)R * 4096 * 2 <= BIG_END - OFF_BIG, "act overflows");
constexpr size_t OFF_P = OFF_BIG;
constexpr size_t OFF_VT = OFF_P + (size_t)R * 2304 * 2;
constexpr size_t OFF_QK = OFF_VT + (size_t)640 * R * 2;
static_assert(OFF_QK + (size_t)R * 1664 * 2 <= BIG_END, "odd overflows");
constexpr size_t OFF_XT = al(BIG_END);
constexpr size_t OFF_BN = OFF_XT + (size_t)1536 * R * 2;
constexpr size_t OFF_BT = OFF_BN + (size_t)R * 512 * 2;
constexpr size_t OFF_CN = OFF_BT + (size_t)512 * R * 2;
constexpr size_t OFF_BAR = al(OFF_CN + (size_t)R * 512 * 2);
constexpr size_t WS_TOTAL = OFF_BAR + 16384;
static_assert(WS_TOTAL <= 402653184ull, "workspace too large");

struct Params {
  const float *x, *c, *ctx, *c_ctx, *w_mod, *b_mod, *norm_mix_g, *norm_ff_g, *w_ff1, *w_ff2;
  const float *w_in_even, *conv_w, *conv_b, *dt_bias, *a_log, *d_skip, *ssd_norm_g, *w_out_even;
  const float *w_in_odd, *q_norm_win, *k_norm_win, *sink_win, *q_norm_na, *k_norm_na, *rpb_na, *w_out_odd;
  float* out;
  unsigned char* ws;
};

struct DP : Params { int tidl, bidl; };

__shared__ __attribute__((aligned(16))) unsigned char smem[73728];

DI bfr f2bf(float x) { unsigned u = __float_as_uint(x); u += 0x7fffu + ((u >> 16) & 1u); return (bfr)(u >> 16); }
DI float bf2f(bfr b) { return __uint_as_float(((unsigned)b) << 16); }
DI float bfs(short s) { return __uint_as_float(((unsigned)(unsigned short)s) << 16); }
DI int crow(int i, int h) { return (i & 3) + 8 * (i >> 2) + 4 * h; }
DI f32x16 zero16() { f32x16 z; for (int i = 0; i < 16; ++i) z[i] = 0.f; return z; }
DI bf16x8 pack8(float a0, float a1, float a2, float a3, float a4, float a5, float a6, float a7) {
  bf16x8 v;
  v[0] = (short)f2bf(a0); v[1] = (short)f2bf(a1); v[2] = (short)f2bf(a2); v[3] = (short)f2bf(a3);
  v[4] = (short)f2bf(a4); v[5] = (short)f2bf(a5); v[6] = (short)f2bf(a6); v[7] = (short)f2bf(a7);
  return v;
}
DI bf16x4 pack4(float a0, float a1, float a2, float a3) {
  bf16x4 v; v[0] = (short)f2bf(a0); v[1] = (short)f2bf(a1); v[2] = (short)f2bf(a2); v[3] = (short)f2bf(a3); return v;
}
#define PACK_HALF(s, s2) pack8(s[8 * (s2)], s[8 * (s2) + 1], s[8 * (s2) + 2], s[8 * (s2) + 3], s[8 * (s2) + 4], s[8 * (s2) + 5], s[8 * (s2) + 6], s[8 * (s2) + 7])
DI bf16x8 join44(bf16x4 lo, bf16x4 hi) { return __builtin_shufflevector(lo, hi, 0, 1, 2, 3, 4, 5, 6, 7); }
DI int chunk_row0(int b, int c) { return c == 0 ? RL + b * CTX : b * SEQ + (c - 1) * CL; }

DI void sincos_turn(double f, float& s, float& c) {
  f -= rint(f);
  double x = f * 6.283185307179586476925;
  double x2 = x * x, ss = 1.0, cc = 1.0;
#pragma unroll
  for (int k = 13; k >= 1; --k) {
    ss = 1.0 - x2 / (double)((2 * k) * (2 * k + 1)) * ss;
    cc = 1.0 - x2 / (double)((2 * k - 1) * (2 * k)) * cc;
  }
  s = (float)(x * ss); c = (float)cc;
}

template <class T> DI T* wsp(const DP& p, size_t off) { return (T*)(p.ws + off); }

DI void phase0(const DP& p) {
  const int tid = p.tidl, bid = p.bidl, G = gridDim.x;
  float* lds = (float*)smem;
  float* MOD = wsp<float>(p, OFF_MOD);
  for (int u = bid; u < 384; u += G) {
    int layer = u / 96, cb = u % 96;
    for (int i = tid; i < 3072; i += 256) {
      int v = i >> 10, k = i & 1023;
      float c = v < 2 ? p.c[v * 1024 + k] : p.c_ctx[k];
      lds[i] = c / (1.f + expf(-c));
    }
    __syncthreads();
    int kq = tid >> 6, cc = tid & 63, col = cb * 64 + cc;
    const float* w = p.w_mod + (size_t)layer * 1024 * 6144 + col;
    float a0 = 0, a1 = 0, a2 = 0;
    for (int k = kq * 256; k < kq * 256 + 256; ++k) {
      float wv = w[(size_t)k * 6144];
      a0 += lds[k] * wv; a1 += lds[1024 + k] * wv; a2 += lds[2048 + k] * wv;
    }
    float* red = lds + 3072;
    red[(kq * 3 + 0) * 64 + cc] = a0; red[(kq * 3 + 1) * 64 + cc] = a1; red[(kq * 3 + 2) * 64 + cc] = a2;
    __syncthreads();
    if (tid < 192) {
      int v = tid >> 6;
      float s = red[(0 * 3 + v) * 64 + cc] + red[(1 * 3 + v) * 64 + cc] + red[(2 * 3 + v) * 64 + cc] + red[(3 * 3 + v) * 64 + cc];
      MOD[(layer * 3 + v) * 6144 + col] = s + p.b_mod[layer * 6144 + col];
    }
    __syncthreads();
  }
  const int gt = bid * 256 + tid, nt = G * 256;
  {
    const float4* xs = (const float4*)p.x; float4* od = (float4*)p.out;
    for (int i = gt; i < RL * 256; i += nt) od[i] = xs[i];
    const float4* cs = (const float4*)p.ctx; float4* hd = wsp<float4>(p, OFF_HC);
    for (int i = gt; i < 512 * 256; i += nt) hd[i] = cs[i];
  }
  float2* TW = wsp<float2>(p, OFF_TW);
  for (int i = gt; i < 8192; i += nt) { float s, c; sincos_turn((double)i / 8192.0, s, c); TW[i] = make_float2(c, s); }
  bfr* C128 = wsp<bfr>(p, OFF_C128); bfr* S128 = wsp<bfr>(p, OFF_S128);
  for (int i = gt; i < 128 * 128; i += nt) { int a = i >> 7, b = i & 127; float s, c; sincos_turn((double)((a * b) & 127) / 128.0, s, c); C128[i] = f2bf(c); S128[i] = f2bf(s); }
  bfr* C64 = wsp<bfr>(p, OFF_C64); bfr* S64 = wsp<bfr>(p, OFF_S64);
  for (int i = gt; i < 64 * 64; i += nt) { int a = i >> 6, b = i & 63; float s, c; sincos_turn((double)((a * b) & 63) / 64.0, s, c); C64[i] = f2bf(c); S64[i] = f2bf(s); }
  bfr* C256 = wsp<bfr>(p, OFF_C256); bfr* S256 = wsp<bfr>(p, OFF_S256);
  for (int i = gt; i < 256 * 256; i += nt) { int a = i >> 8, b = i & 255; float s, c; sincos_turn((double)((a * b) & 255) / 256.0, s, c); C256[i] = f2bf(c); S256[i] = f2bf(s); }
  float* ROPE = wsp<float>(p, OFF_ROPE);
  for (int i = gt; i < 2 * 128 * 16; i += nt) {
    int f = i & 15, idx = (i >> 4) & 127;
    float ang = (float)idx * (float)exp(-(double)f * 0.5756462732485115);
    float s, c; sincos_turn((double)ang / 6.283185307179586476925, s, c);
    ROPE[i] = c; ROPE[4096 + i] = s;
  }
}

DI void tcvt_unit(const float* __restrict__ src, int ld, int c0, int ncols, int K, bfr* __restrict__ dst, int dr0, int u, int tid) {
  const int ntk = K >> 6;
  const int tn = u / ntk, tk = u % ntk, k0 = tk * 64, nb = tn * 64;
  bfr* T = (bfr*)smem;
  float4 v[4];
  const int n4 = (tid & 15) * 4;
#pragma unroll
  for (int i = 0; i < 4; ++i) {
    const int kk = (tid >> 4) + 16 * i;
    v[i] = make_float4(0.f, 0.f, 0.f, 0.f);
    if (nb + n4 < ncols) v[i] = *(const float4*)(src + (size_t)(k0 + kk) * ld + c0 + nb + n4);
  }
#pragma unroll
  for (int i = 0; i < 4; ++i) {
    const int kk = (tid >> 4) + 16 * i;
    T[(n4 + 0) * 72 + kk] = f2bf(v[i].x); T[(n4 + 1) * 72 + kk] = f2bf(v[i].y);
    T[(n4 + 2) * 72 + kk] = f2bf(v[i].z); T[(n4 + 3) * 72 + kk] = f2bf(v[i].w);
  }
  __syncthreads();
  {
    int n = tid >> 2, kseg = (tid & 3) * 16;
    if (nb + n < ncols) {
      bfr* d = dst + (size_t)(dr0 + nb + n) * K + k0 + kseg;
      *(bf16x8*)d = *(const bf16x8*)(T + n * 72 + kseg);
      *(bf16x8*)(d + 8) = *(const bf16x8*)(T + n * 72 + kseg + 8);
    }
  }
  __syncthreads();
}

DI void wconv_phase(const DP& p, int layer) {
  const int tid = p.tidl;
  const int j = layer >> 1;
  bfr* WIN = wsp<bfr>(p, OFF_WIN); bfr* WOUT = wsp<bfr>(p, OFF_WOUT);
  bfr* WFF1 = wsp<bfr>(p, OFF_WFF1); bfr* WFF2 = wsp<bfr>(p, OFF_WFF2);
  const float* ff1 = p.w_ff1 + (size_t)layer * 1024 * 4096;
  const float* ff2 = p.w_ff2 + (size_t)layer * 4096 * 1024;
  float* cst = (float*)(smem + 20480);
  if (tid < 64) { float s, c; sincos_turn((double)tid / 64.0, s, c); cst[tid] = c; cst[64 + tid] = s; }
  __syncthreads();
  if ((layer & 1) == 0) {
    const float* win = p.w_in_even + (size_t)j * 1024 * 4656;
    const float* wout = p.w_out_even + (size_t)j * 2048 * 1024;
    const int n_in = 65 * 16, n_out = 16 * 32, n_f1 = 64 * 16, n_f2 = 16 * 64, n_fold = 128;
    const int total = n_in + n_out + n_f1 + n_f2 + n_fold;
    for (int u = p.bidl; u < total; u += gridDim.x) {
      int v = u;
      if (v < n_in) { tcvt_unit(win, 4656, 512, 4144, 1024, WIN, 1024, v, tid); continue; }
      v -= n_in;
      if (v < n_out) { tcvt_unit(wout, 1024, 0, 1024, 2048, WOUT, 0, v, tid); continue; }
      v -= n_out;
      if (v < n_f1) { tcvt_unit(ff1, 4096, 0, 4096, 1024, WFF1, 0, v, tid); continue; }
      v -= n_f1;
      if (v < n_f2) { tcvt_unit(ff2, 1024, 0, 1024, 4096, WFF2, 0, v, tid); continue; }
      v -= n_f2;
      {
        const int g = v >> 4, kb = v & 15;
        float* wt = (float*)smem;
#pragma unroll
        for (int i = 0; i < 4; ++i) {
          const int idx = tid + 256 * i, kk = idx >> 4, j4 = (idx & 15) * 4;
          const float4 wv = *(const float4*)(win + (size_t)(kb * 64 + kk) * 4656 + g * 64 + j4);
          wt[kk * 65 + j4] = wv.x; wt[kk * 65 + j4 + 1] = wv.y; wt[kk * 65 + j4 + 2] = wv.z; wt[kk * 65 + j4 + 3] = wv.w;
        }
        __syncthreads();
        const int kl = tid & 63, mg = tid >> 6;
#pragma unroll 1
        for (int mi = 0; mi < 16; ++mi) {
          const int m = mg * 16 + mi;
          float sc = 0.f, ss = 0.f;
#pragma unroll 8
          for (int jj = 0; jj < 64; ++jj) { const float w = wt[kl * 65 + jj]; const int idx = (m * jj) & 63; sc += w * cst[idx]; ss += w * cst[64 + idx]; }
          const int ch = g * 64 + m, k = kb * 64 + kl;
          WIN[(size_t)ch * 1024 + k] = f2bf(sc);
          WIN[(size_t)(512 + ch) * 1024 + k] = f2bf(-ss);
        }
        __syncthreads();
      }
    }
  } else {
    const float* win = p.w_in_odd + (size_t)j * 1024 * 2304;
    const float* wout = p.w_out_odd + (size_t)j * 1024 * 1024;
    const int n_in = 36 * 16, n_out = 16 * 16, n_f1 = 64 * 16, n_f2 = 16 * 64;
    const int total = n_in + n_out + n_f1 + n_f2;
    for (int u = p.bidl; u < total; u += gridDim.x) {
      int v = u;
      if (v < n_in) { tcvt_unit(win, 2304, 0, 2304, 1024, WIN, 0, v, tid); continue; }
      v -= n_in;
      if (v < n_out) { tcvt_unit(wout, 1024, 0, 1024, 1024, WOUT, 0, v, tid); continue; }
      v -= n_out;
      if (v < n_f1) { tcvt_unit(ff1, 4096, 0, 4096, 1024, WFF1, 0, v, tid); continue; }
      v -= n_f1;
      tcvt_unit(ff2, 1024, 0, 1024, 4096, WFF2, 0, v, tid);
    }
  }
}

DI void norm_phase(const DP& p, int layer, const float* __restrict__ gvec, int shc, int scc) {
  const int lane = p.tidl & 63;
  const int wg = p.bidl * 4 + (p.tidl >> 6), nw = gridDim.x * 4;
  const float* MOD = wsp<float>(p, OFF_MOD);
  const float* HC = wsp<float>(p, OFF_HC);
  bfr* U = wsp<bfr>(p, OFF_MIX);
  for (int row = wg; row < R; row += nw) {
    const float* hp = row < RL ? p.out + (size_t)row * 1024 : HC + (size_t)(row - RL) * 1024;
    const int ms = row < RL ? (row >> 13) : 2;
    const float* md = MOD + (layer * 3 + ms) * 6144;
    float4 v[4]; float ss = 0.f;
#pragma unroll
    for (int i = 0; i < 4; ++i) {
      v[i] = *(const float4*)(hp + i * 256 + lane * 4);
      ss += v[i].x * v[i].x + v[i].y * v[i].y + v[i].z * v[i].z + v[i].w * v[i].w;
    }
#pragma unroll
    for (int o = 32; o >= 1; o >>= 1) ss += __shfl_xor(ss, o);
    const float rs = rsqrtf(ss * (1.f / 1024.f) + 1e-6f);
#pragma unroll
    for (int i = 0; i < 4; ++i) {
      int col = i * 256 + lane * 4;
      float4 g = *(const float4*)(gvec + col);
      float4 sc = *(const float4*)(md + scc * 1024 + col);
      float4 sh = *(const float4*)(md + shc * 1024 + col);
      bf16x4 o = pack4(v[i].x * rs * g.x * (1.f + sc.x) + sh.x, v[i].y * rs * g.y * (1.f + sc.y) + sh.y,
                       v[i].z * rs * g.z * (1.f + sc.z) + sh.z, v[i].w * rs * g.w * (1.f + sc.w) + sh.w);
      *(bf16x4*)(U + (size_t)row * 1024 + col) = o;
    }
  }
}

enum { EPI_EVEN_IN = 0, EPI_ODD_IN = 1, EPI_RELU2 = 2, EPI_RESID = 3 };

DI void gemm_phase(const DP& p, int mode, const bfr* __restrict__ A, int lda, const bfr* __restrict__ Bt,
                   int N, int K, int layer, int gchunk) {
  const int tid = p.tidl, lane = tid & 63, wid = tid >> 6, r = lane & 31, h = lane >> 5;
  const int wm = wid >> 1, wn = wid & 1;
  const int nN = (N + 127) >> 7, nM = R / 128;
  const int tiles = nM * nN, G = (int)gridDim.x;
  int full = tiles, tail = 0, St = 1;
  if (mode == EPI_RESID) {
    full = (tiles / G) * G; tail = tiles - full;
    if (tail > 0) { int c = G / tail; int kmax = K >> 7; St = 1; while (St * 2 <= c && St * 2 <= 16 && St * 2 <= kmax) St *= 2; }
  }
  const int chunk = (full + 7) >> 3;
  const int units = chunk * 8 + tail * St;
  bfr* sm = (bfr*)smem;
  const int lrow = tid >> 3, lc = (tid & 7) * 8;
#pragma unroll 1
  for (int u = p.bidl; u < units; u += G) {
    int t, ks, Ks; bool atom;
    if (u < chunk * 8) {
      t = (u & 7) * chunk + (u >> 3);
      if (t >= full) continue;
      ks = 0; Ks = K; atom = false;
    } else { const int v = u - chunk * 8; t = full + v / St; ks = v % St; Ks = K / St; atom = St > 1; }
    const int nk = Ks >> 6;
    const int panel = t / (nM * 8); const int rem = t - panel * nM * 8;
    const int pw = (nN - panel * 8) < 8 ? (nN - panel * 8) : 8;
    const int tm = rem / pw, tn = panel * 8 + rem % pw;
    const int m0 = tm * 128, n0 = tn * 128, kbase = ks * Ks;
    f32x16 acc[2][2];
    acc[0][0] = zero16(); acc[0][1] = zero16(); acc[1][0] = zero16(); acc[1][1] = zero16();
    const bfr* Ag = A + (size_t)(m0 + lrow) * lda + kbase + lc;
    const bfr* Bg = Bt + (size_t)(n0 + lrow) * K + kbase + lc;
    bf16x8 ra[4], rb[4];
#pragma unroll
    for (int i = 0; i < 4; ++i) {
      ra[i] = *(const bf16x8*)(Ag + (size_t)(32 * i) * lda);
      rb[i] = *(const bf16x8*)(Bg + (size_t)(32 * i) * K);
    }
#pragma unroll
    for (int i = 0; i < 4; ++i) {
      *(bf16x8*)(sm + (lrow + 32 * i) * 72 + lc) = ra[i];
      *(bf16x8*)(sm + 9216 + (lrow + 32 * i) * 72 + lc) = rb[i];
    }
    if (nk > 1) {
#pragma unroll
      for (int i = 0; i < 4; ++i) {
        ra[i] = *(const bf16x8*)(Ag + (size_t)(32 * i) * lda + 64);
        rb[i] = *(const bf16x8*)(Bg + (size_t)(32 * i) * K + 64);
      }
    }
    __syncthreads();
#pragma unroll 1
    for (int kt = 0; kt < nk; ++kt) {
      if (kt + 1 < nk) {
        bfr* Ad = sm + ((kt + 1) & 1) * 18432;
#pragma unroll
        for (int i = 0; i < 4; ++i) {
          *(bf16x8*)(Ad + (lrow + 32 * i) * 72 + lc) = ra[i];
          *(bf16x8*)(Ad + 9216 + (lrow + 32 * i) * 72 + lc) = rb[i];
        }
      }
      if (kt + 2 < nk) {
#pragma unroll
        for (int i = 0; i < 4; ++i) {
          ra[i] = *(const bf16x8*)(Ag + (size_t)(32 * i) * lda + (kt + 2) * 64);
          rb[i] = *(const bf16x8*)(Bg + (size_t)(32 * i) * K + (kt + 2) * 64);
        }
      }
      const bfr* As = sm + (kt & 1) * 18432;
      const bfr* Bs = As + 9216;
      __builtin_amdgcn_s_setprio(1);
#pragma unroll
      for (int kk = 0; kk < 4; ++kk) {
        bf16x8 a0 = *(const bf16x8*)(As + (wm * 64 + r) * 72 + kk * 16 + h * 8);
        bf16x8 a1 = *(const bf16x8*)(As + (wm * 64 + 32 + r) * 72 + kk * 16 + h * 8);
        bf16x8 b0 = *(const bf16x8*)(Bs + (wn * 64 + r) * 72 + kk * 16 + h * 8);
        bf16x8 b1 = *(const bf16x8*)(Bs + (wn * 64 + 32 + r) * 72 + kk * 16 + h * 8);
        acc[0][0] = MFMA(a0, b0, acc[0][0]);
        acc[0][1] = MFMA(a0, b1, acc[0][1]);
        acc[1][0] = MFMA(a1, b0, acc[1][0]);
        acc[1][1] = MFMA(a1, b1, acc[1][1]);
      }
      __builtin_amdgcn_s_setprio(0);
      __syncthreads();
    }
#pragma unroll
    for (int mi = 0; mi < 2; ++mi)
#pragma unroll
      for (int ni = 0; ni < 2; ++ni)
#pragma unroll
        for (int g4 = 0; g4 < 4; ++g4) {
          const int row = m0 + wm * 64 + mi * 32 + 8 * g4 + 4 * h;
          const int col = n0 + wn * 64 + ni * 32 + r;
          const float v0 = acc[mi][ni][4 * g4], v1 = acc[mi][ni][4 * g4 + 1], v2 = acc[mi][ni][4 * g4 + 2], v3 = acc[mi][ni][4 * g4 + 3];
          if (mode == EPI_EVEN_IN) {
            if (col < 1024) {
              bfr* dst = wsp<bfr>(p, col < 512 ? OFF_ZRT : OFF_ZIT) + (size_t)(col & 511) * R + row;
              *(bf16x4*)dst = pack4(v0, v1, v2, v3);
            } else if (col < 2560) {
              bfr* dst = wsp<bfr>(p, OFF_Z) + (size_t)row * 1536 + (col - 1024);
              dst[0] = f2bf(v0); dst[1536] = f2bf(v1); dst[2 * 1536] = f2bf(v2); dst[3 * 1536] = f2bf(v3);
            } else if (col < 5120) {
              bfr* dst = wsp<bfr>(p, OFF_XBC) + (size_t)row * 2560 + (col - 2560);
              dst[0] = f2bf(v0); dst[2560] = f2bf(v1); dst[2 * 2560] = f2bf(v2); dst[3 * 2560] = f2bf(v3);
            } else if (col < 5168) {
              float* dst = wsp<float>(p, OFF_DTRAW) + (size_t)row * 48 + (col - 5120);
              dst[0] = v0; dst[48] = v1; dst[96] = v2; dst[144] = v3;
            }
          } else if (mode == EPI_ODD_IN) {
            if (col >= 640 && col < 768) {
              *(bf16x4*)(wsp<bfr>(p, OFF_VT) + (size_t)(col - 640) * R + row) = pack4(v0, v1, v2, v3);
            } else if (col >= 1792) {
              *(bf16x4*)(wsp<bfr>(p, OFF_VT) + (size_t)(128 + col - 1792) * R + row) = pack4(v0, v1, v2, v3);
            } else {
              bfr* dst = wsp<bfr>(p, OFF_P) + (size_t)row * 2304 + col;
              dst[0] = f2bf(v0); dst[2304] = f2bf(v1); dst[2 * 2304] = f2bf(v2); dst[3 * 2304] = f2bf(v3);
            }
          } else if (mode == EPI_RELU2) {
            bfr* dst = wsp<bfr>(p, OFF_ACT) + (size_t)row * 4096 + col;
            float t0 = fmaxf(v0, 0.f), t1 = fmaxf(v1, 0.f), t2 = fmaxf(v2, 0.f), t3 = fmaxf(v3, 0.f);
            dst[0] = f2bf(t0 * t0); dst[4096] = f2bf(t1 * t1); dst[2 * 4096] = f2bf(t2 * t2); dst[3 * 4096] = f2bf(t3 * t3);
          } else if (mode == EPI_RESID) {
            const int ms = row < RL ? (row >> 13) : 2;
            const float gate = wsp<float>(p, OFF_MOD)[(layer * 3 + ms) * 6144 + gchunk * 1024 + col];
            float* hp = row < RL ? p.out + (size_t)row * 1024 + col : wsp<float>(p, OFF_HC) + (size_t)(row - RL) * 1024 + col;
            if (atom) {
              unsafeAtomicAdd(hp, gate * v0); unsafeAtomicAdd(hp + 1024, gate * v1);
              unsafeAtomicAdd(hp + 2048, gate * v2); unsafeAtomicAdd(hp + 3072, gate * v3);
            } else {
              hp[0] += gate * v0; hp[1024] += gate * v1; hp[2048] += gate * v2; hp[3072] += gate * v3;
            }
          }
        }
  }
}

DI float softplus_f(float x) { return x > 0.f ? x + log1pf(expf(-x)) : log1pf(expf(x)); }

DI void conv_dt_phase(const DP& p, int j) {
  const int tid = p.tidl, lane = tid & 63, wid = tid >> 6;
  const bfr* XBC = wsp<bfr>(p, OFF_XBC);
  bfr* XT = wsp<bfr>(p, OFF_XT); bfr* BN = wsp<bfr>(p, OFF_BN); bfr* BTt = wsp<bfr>(p, OFF_BT); bfr* CN = wsp<bfr>(p, OFF_CN);
  bfr* TT = (bfr*)smem;
  const float* cw = p.conv_w + (size_t)j * 5 * 2560;
  const float* cb = p.conv_b + (size_t)j * 2560;
  const int n_conv = 264 * 40, n_dt = 792;
  for (int u = p.bidl; u < n_conv + n_dt; u += gridDim.x) {
    if (u < n_conv) {
      const int tb = u / 40, cbk = u % 40, row0 = tb * 64, ch0 = cbk * 64;
      int pos0, len;
      if (row0 < RL) { pos0 = row0 & 8191; len = SEQ; } else { pos0 = (row0 - RL) & 255; len = CTX; }
      const int c8 = tid & 7, ch = ch0 + c8 * 8;
      float w[5][8], bias[8];
#pragma unroll
      for (int k = 0; k < 5; ++k) {
        float4 wa = *(const float4*)(cw + k * 2560 + ch), wb = *(const float4*)(cw + k * 2560 + ch + 4);
        w[k][0] = wa.x; w[k][1] = wa.y; w[k][2] = wa.z; w[k][3] = wa.w; w[k][4] = wb.x; w[k][5] = wb.y; w[k][6] = wb.z; w[k][7] = wb.w;
      }
      {
        float4 wa = *(const float4*)(cb + ch), wb = *(const float4*)(cb + ch + 4);
        bias[0] = wa.x; bias[1] = wa.y; bias[2] = wa.z; bias[3] = wa.w; bias[4] = wb.x; bias[5] = wb.y; bias[6] = wb.z; bias[7] = wb.w;
      }
#pragma unroll
      for (int ps = 0; ps < 2; ++ps) {
        const int tl = (tid >> 3) + 32 * ps, pos = pos0 + tl, row = row0 + tl;
        float a[8];
#pragma unroll
        for (int e = 0; e < 8; ++e) a[e] = bias[e];
        bf16x8 xr[5];
#pragma unroll
        for (int k = 0; k < 5; ++k) {
          const int pp = pos + k - 2;
          const bool ok = pp >= 0 && pp < len;
          const bfr* xp = XBC + (size_t)(ok ? row + k - 2 : row) * 2560 + ch;
          xr[k] = *(const bf16x8*)xp;
          if (!ok) { for (int e = 0; e < 8; ++e) xr[k][e] = 0; }
        }
#pragma unroll
        for (int k = 0; k < 5; ++k)
#pragma unroll
          for (int e = 0; e < 8; ++e) a[e] += w[k][e] * bfs(xr[k][e]);
        bf16x8 o;
#pragma unroll
        for (int e = 0; e < 8; ++e) { float s = a[e] / (1.f + __expf(-a[e])); o[e] = (short)f2bf(s); }
        if (ch0 >= 2048) *(bf16x8*)(CN + (size_t)row * 512 + (ch - 2048)) = o;
        else if (ch0 >= 1536) *(bf16x8*)(BN + (size_t)row * 512 + (ch - 1536)) = o;
        if (ch0 < 2048) {
#pragma unroll
          for (int e = 0; e < 8; ++e) TT[(c8 * 8 + e) * 72 + tl] = (bfr)o[e];
        }
      }
      if (ch0 < 2048) {
        __syncthreads();
        const int chl = tid >> 2, tseg = (tid & 3) * 16;
        bfr* dst = (ch0 < 1536 ? XT + (size_t)(ch0 + chl) * R : BTt + (size_t)(ch0 - 1536 + chl) * R) + row0 + tseg;
        *(bf16x8*)dst = *(const bf16x8*)(TT + chl * 72 + tseg);
        *(bf16x8*)(dst + 8) = *(const bf16x8*)(TT + chl * 72 + tseg + 8);
        __syncthreads();
      }
    } else {
      const int item = (u - n_conv) * 4 + wid;
      const int head = item % 24; int rest = item / 24; const int dir = rest & 1; rest >>= 1; const int c = rest % NCH, b = rest / NCH;
      const int row0 = chunk_row0(b, c), col = dir * 24 + head;
      const float bias = p.dt_bias[j * 48 + col];
      const float a = -expf(p.a_log[j * 48 + col]);
      const float* DTRAW = wsp<float>(p, OFF_DTRAW);
      float dt[4], cs[4];
      float run = 0.f;
#pragma unroll
      for (int q = 0; q < 4; ++q) {
        dt[q] = softplus_f(DTRAW[(size_t)(row0 + lane * 4 + q) * 48 + col] + bias);
        run += dt[q] * a; cs[q] = run;
      }
      float x = run;
#pragma unroll
      for (int o = 1; o < 64; o <<= 1) { float t2 = __shfl_up(x, o); if (lane >= o) x += t2; }
      const float excl = x - run;
      const float total = __shfl(x, 63);
      float ac[4];
#pragma unroll
      for (int q = 0; q < 4; ++q) {
        float inc = excl + cs[q];
        ac[q] = dir == 0 ? inc : total - inc + dt[q] * a;
      }
      const size_t base = ((size_t)(((dir * 2 + b) * NCH + c) * 24 + head)) * 256 + lane * 4;
      *(float4*)(wsp<float>(p, OFF_DTV) + base) = make_float4(dt[0], dt[1], dt[2], dt[3]);
      *(float4*)(wsp<float>(p, OFF_ACUM) + base) = make_float4(ac[0], ac[1], ac[2], ac[3]);
    }
  }
}

DI bf16x8 scale8(bf16x8 a, const float* w) {
  return pack8(bfs(a[0]) * w[0], bfs(a[1]) * w[1], bfs(a[2]) * w[2], bfs(a[3]) * w[3],
               bfs(a[4]) * w[4], bfs(a[5]) * w[5], bfs(a[6]) * w[6], bfs(a[7]) * w[7]);
}

DI void s1_item(const DP& p, int item, int lane) {
  const int r = lane & 31, h = lane >> 5;
  const int head = item % 24; int rest = item / 24; const int dir = rest & 1; rest >>= 1; const int c = rest % NCH, b = rest / NCH;
  const int g = head / 6;
  const int row0 = chunk_row0(b, c);
  const size_t dbase = ((size_t)(((dir * 2 + b) * NCH + c) * 24 + head)) * 256;
  const float* dtv = wsp<float>(p, OFF_DTV) + dbase;
  const float* acm = wsp<float>(p, OFF_ACUM) + dbase;
  const float acend = dir == 0 ? acm[255] : acm[0];
  const bfr* XT = wsp<bfr>(p, OFF_XT); const bfr* BTt = wsp<bfr>(p, OFF_BT);
  bfr* HS = wsp<bfr>(p, OFF_HS) + ((size_t)(((dir * 2 + b) * NCH + c) * 24 + head)) * 8192;
#pragma unroll 1
  for (int pt = 0; pt < 2; ++pt) {
    f32x16 acc[4];
#pragma unroll
    for (int n = 0; n < 4; ++n) acc[n] = zero16();
#pragma unroll 1
    for (int kk = 0; kk < 16; ++kk) {
      const int s0 = kk * 16 + 8 * h;
      float4 d0 = *(const float4*)(dtv + s0), d1 = *(const float4*)(dtv + s0 + 4);
      float4 a0 = *(const float4*)(acm + s0), a1 = *(const float4*)(acm + s0 + 4);
      float w[8];
      w[0] = d0.x * __expf(acend - a0.x); w[1] = d0.y * __expf(acend - a0.y); w[2] = d0.z * __expf(acend - a0.z); w[3] = d0.w * __expf(acend - a0.w);
      w[4] = d1.x * __expf(acend - a1.x); w[5] = d1.y * __expf(acend - a1.y); w[6] = d1.z * __expf(acend - a1.z); w[7] = d1.w * __expf(acend - a1.w);
      bf16x8 af = scale8(*(const bf16x8*)(XT + (size_t)(head * 64 + pt * 32 + r) * R + row0 + s0), w);
#pragma unroll
      for (int nt = 0; nt < 4; ++nt) {
        bf16x8 bfv = *(const bf16x8*)(BTt + (size_t)(g * 128 + nt * 32 + r) * R + row0 + s0);
        acc[nt] = MFMA(af, bfv, acc[nt]);
      }
    }
#pragma unroll
    for (int nt = 0; nt < 4; ++nt)
#pragma unroll
      for (int i = 0; i < 16; ++i) HS[(pt * 32 + crow(i, h)) * 128 + nt * 32 + r] = f2bf(acc[nt][i]);
  }
}

DI void f1_item(const DP& p, int item, int lane) {
  const int r = lane & 31, h = lane >> 5;
  const int l2t = item & 1, m = (item >> 1) & 511, b = item >> 10;
  const bfr* ZRT = wsp<bfr>(p, OFF_ZRT) + (size_t)m * R + b * SEQ + l2t * 32 + r;
  const bfr* ZIT = wsp<bfr>(p, OFF_ZIT) + (size_t)m * R + b * SEQ + l2t * 32 + r;
  const bfr* C128 = wsp<bfr>(p, OFF_C128); const bfr* S128 = wsp<bfr>(p, OFF_S128);
  const float2* TW = wsp<float2>(p, OFF_TW);
  bfr* YR = wsp<bfr>(p, OFF_YR); bfr* YI = wsp<bfr>(p, OFF_YI);
  const int l2 = l2t * 32 + r;
#pragma unroll 1
  for (int mh = 0; mh < 2; ++mh) {
    f32x16 yr[2], yi[2];
#pragma unroll
    for (int i = 0; i < 2; ++i) { yr[i] = zero16(); yi[i] = zero16(); }
#pragma unroll 1
    for (int kk = 0; kk < 8; ++kk) {
      bf16x8 zr, zi, nzr;
#pragma unroll
      for (int jj = 0; jj < 8; ++jj) {
        int l1 = kk * 16 + 8 * h + jj;
        zr[jj] = (short)ZRT[l1 * 64]; zi[jj] = (short)ZIT[l1 * 64];
        nzr[jj] = (short)(zr[jj] ^ (short)0x8000);
      }
#pragma unroll
      for (int m2 = 0; m2 < 2; ++m2) {
        const int mt = mh * 2 + m2;
        bf16x8 ca = *(const bf16x8*)(C128 + (mt * 32 + r) * 128 + kk * 16 + 8 * h);
        bf16x8 sa = *(const bf16x8*)(S128 + (mt * 32 + r) * 128 + kk * 16 + 8 * h);
        yr[m2] = MFMA(ca, zr, yr[m2]); yr[m2] = MFMA(sa, zi, yr[m2]);
        yi[m2] = MFMA(ca, zi, yi[m2]); yi[m2] = MFMA(sa, nzr, yi[m2]);
      }
    }
#pragma unroll
    for (int m2 = 0; m2 < 2; ++m2)
#pragma unroll
      for (int i = 0; i < 16; ++i) {
        int k1 = (mh * 2 + m2) * 32 + crow(i, h);
        float2 t = TW[k1 * l2];
        float a = yr[m2][i], bb = yi[m2][i];
        size_t o = ((size_t)(b * 512 + m) * 128 + k1) * 64 + l2;
        YR[o] = f2bf(a * t.x + bb * t.y);
        YI[o] = f2bf(bb * t.x - a * t.y);
      }
  }
}

DI void f1c_item(const DP& p, int item, int lane) {
  const int r = lane & 31, h = lane >> 5;
  const int mt = item & 15, kt = (item >> 4) & 7, b = item >> 7;
  const int m = mt * 32 + r;
  const bfr* ZRT = wsp<bfr>(p, OFF_ZRT) + (size_t)m * R + RL + b * CTX;
  const bfr* ZIT = wsp<bfr>(p, OFF_ZIT) + (size_t)m * R + RL + b * CTX;
  const bfr* C256 = wsp<bfr>(p, OFF_C256) + (kt * 32 + r) * 256;
  const bfr* S256 = wsp<bfr>(p, OFF_S256) + (kt * 32 + r) * 256;
  f32x16 acc = zero16();
  for (int kk = 0; kk < 16; ++kk) {
    int o = kk * 16 + 8 * h;
    acc = MFMA(*(const bf16x8*)(C256 + o), *(const bf16x8*)(ZRT + o), acc);
    acc = MFMA(*(const bf16x8*)(S256 + o), *(const bf16x8*)(ZIT + o), acc);
  }
  bfr* MIX = wsp<bfr>(p, OFF_MIX);
#pragma unroll
  for (int i = 0; i < 16; ++i)
    MIX[(size_t)(RL + b * CTX + kt * 32 + crow(i, h)) * 2048 + m] = f2bf(acc[i] * (1.f / 128.f));
}

DI void s1f1_phase(const DP& p) {
  const int lane = p.tidl & 63;
  const int wg = p.bidl * 4 + (p.tidl >> 6), nw = gridDim.x * 4;
  const int n_s1 = 2 * NCH * 2 * 24, n_f1 = 2048, n_f1c = 256;
#pragma unroll 1
  for (int it = wg; it < n_s1 + n_f1 + n_f1c; it += nw) {
    if (it < n_s1) s1_item(p, it, lane);
    else if (it < n_s1 + n_f1) f1_item(p, it - n_s1, lane);
    else f1c_item(p, it - n_s1 - n_f1, lane);
  }
}

DI void f2_item(const DP& p, int item, int lane) {
  const int r = lane & 31, h = lane >> 5;
  const int mt16 = item & 15, k1 = (item >> 4) & 127, b = item >> 11;
  const int m = mt16 * 32 + r;
  const bfr* YR = wsp<bfr>(p, OFF_YR) + ((size_t)(b * 512 + m) * 128 + k1) * 64;
  const bfr* YI = wsp<bfr>(p, OFF_YI) + ((size_t)(b * 512 + m) * 128 + k1) * 64;
  const bfr* C64 = wsp<bfr>(p, OFF_C64); const bfr* S64 = wsp<bfr>(p, OFF_S64);
  f32x16 acc[2]; acc[0] = zero16(); acc[1] = zero16();
#pragma unroll
  for (int kk = 0; kk < 4; ++kk) {
    bf16x8 yr = *(const bf16x8*)(YR + kk * 16 + 8 * h), yi = *(const bf16x8*)(YI + kk * 16 + 8 * h);
#pragma unroll
    for (int t = 0; t < 2; ++t) {
      bf16x8 ca = *(const bf16x8*)(C64 + (t * 32 + r) * 64 + kk * 16 + 8 * h);
      bf16x8 sa = *(const bf16x8*)(S64 + (t * 32 + r) * 64 + kk * 16 + 8 * h);
      acc[t] = MFMA(ca, yr, acc[t]); acc[t] = MFMA(sa, yi, acc[t]);
    }
  }
  bfr* MIX = wsp<bfr>(p, OFF_MIX);
  const float scale = 0.001381067932f;
#pragma unroll
  for (int t = 0; t < 2; ++t)
#pragma unroll
    for (int i = 0; i < 16; ++i) {
      int k2 = t * 32 + crow(i, h);
      MIX[(size_t)(b * SEQ + k1 + 128 * k2) * 2048 + m] = f2bf(acc[t][i] * scale);
    }
}

DI void s2f2_phase(const DP& p) {
  const int gt = p.bidl * 256 + p.tidl, nt = gridDim.x * 256;
  bfr* HSb = wsp<bfr>(p, OFF_HS);
  const float* ACUM = wsp<float>(p, OFF_ACUM);
#pragma unroll 1
  for (int it = gt; it < 2 * 2 * 24 * 2048; it += nt) {
    const int e4 = it & 2047; const int rest = it >> 11; const int head = rest % 24, db = rest / 24, dir = db >> 1;
    bf16x4 sv[NCH]; float cd[NCH];
#pragma unroll
    for (int step = 0; step < NCH; ++step) {
      const int c = dir == 0 ? step : (step == 0 ? 0 : NCH - step);
      const size_t ci = (size_t)((db * NCH + c) * 24 + head);
      sv[step] = *(const bf16x4*)(HSb + ci * 8192 + e4 * 4);
      cd[step] = ACUM[ci * 256 + (dir == 0 ? 255 : 0)];
    }
    float h0 = 0.f, h1 = 0.f, h2 = 0.f, h3 = 0.f;
#pragma unroll
    for (int step = 0; step < NCH; ++step) {
      const int c = dir == 0 ? step : (step == 0 ? 0 : NCH - step);
      const size_t ci = (size_t)((db * NCH + c) * 24 + head);
      *(bf16x4*)(HSb + ci * 8192 + e4 * 4) = pack4(h0, h1, h2, h3);
      const float e = __expf(cd[step]);
      h0 = h0 * e + bfs(sv[step][0]); h1 = h1 * e + bfs(sv[step][1]); h2 = h2 * e + bfs(sv[step][2]); h3 = h3 * e + bfs(sv[step][3]);
    }
  }
  const int lane = p.tidl & 63;
  const int wg = p.bidl * 4 + (p.tidl >> 6), nw = gridDim.x * 4;
#pragma unroll 1
  for (int it = wg; it < 4096; it += nw) f2_item(p, it, lane);
}

DI void s3_phase(const DP& p, int j) {
  const int tid = p.tidl, lane = tid & 63, wid = tid >> 6, r = lane & 31, h = lane >> 5;
  const bfr* CN = wsp<bfr>(p, OFF_CN); const bfr* BN = wsp<bfr>(p, OFF_BN); const bfr* XT = wsp<bfr>(p, OFF_XT);
  const bfr* Z = wsp<bfr>(p, OFF_Z); bfr* MIX = wsp<bfr>(p, OFF_MIX);
  bfr* XTs = (bfr*)smem;
  bfr* HSF = (bfr*)(smem + 33792);
  bfr* HSB = (bfr*)(smem + 51200);
  float* LWF = (float*)(smem + 68608);
  float* LWB = LWF + 256;
#pragma unroll 1
  for (int item = p.bidl; item < 2 * NCH * 4 * 2; item += (int)gridDim.x) {
    const int half = item & 1, g = (item >> 1) & 3; const int bc = item >> 3; const int c = bc % NCH, b = bc / NCH;
    const int row0 = chunk_row0(b, c);
    const int lt = half * 4 + wid;
    const int rowl = row0 + lt * 32 + r;
    const bfr* cfp = CN + (size_t)rowl * 512 + g * 128 + 8 * h;
    bf16x8 gtp[8][2];
    {
      bf16x8 cf[8];
#pragma unroll
      for (int kk = 0; kk < 8; ++kk) cf[kk] = *(const bf16x8*)(cfp + kk * 16);
#pragma unroll
      for (int k = 0; k < 8; ++k) { gtp[k][0] = cf[0]; gtp[k][1] = cf[0]; }
#pragma unroll 1
      for (int st = 0; st < 8; ++st) {
        f32x16 gt = zero16();
#pragma unroll
        for (int kk = 0; kk < 8; ++kk)
          gt = MFMA(*(const bf16x8*)(BN + (size_t)(row0 + st * 32 + r) * 512 + g * 128 + kk * 16 + 8 * h), cf[kk], gt);
#pragma unroll
        for (int k = 0; k < 7; ++k) { gtp[k][0] = gtp[k + 1][0]; gtp[k][1] = gtp[k + 1][1]; }
        gtp[7][0] = PACK_HALF(gt, 0); gtp[7][1] = PACK_HALF(gt, 1);
      }
    }
    float sumsq = 0.f;
#pragma unroll 1
    for (int hh = 0; hh < 6; ++hh) {
      const int head = g * 6 + hh;
      const size_t cif = (size_t)(((0 * 2 + b) * NCH + c) * 24 + head), cib = (size_t)(((1 * 2 + b) * NCH + c) * 24 + head);
      const float* acf = wsp<float>(p, OFF_ACUM) + cif * 256; const float* acb = wsp<float>(p, OFF_ACUM) + cib * 256;
      const float* dtf = wsp<float>(p, OFF_DTV) + cif * 256; const float* dtb = wsp<float>(p, OFF_DTV) + cib * 256;
      const bfr* HSf = wsp<bfr>(p, OFF_HS) + cif * 8192; const bfr* HSbk = wsp<bfr>(p, OFF_HS) + cib * 8192;
      __syncthreads();
#pragma unroll 4
      for (int i = 0; i < 8; ++i) {
        const int idx = tid + 256 * i, row = idx >> 5, c16 = idx & 31;
        *(bf16x8*)(XTs + row * 264 + c16 * 8) = *(const bf16x8*)(XT + (size_t)(head * 64 + row) * R + row0 + c16 * 8);
      }
#pragma unroll 2
      for (int i = 0; i < 4; ++i) {
        const int idx = tid + 256 * i, row = idx >> 4, c16 = idx & 15;
        *(bf16x8*)(HSF + row * 136 + c16 * 8) = *(const bf16x8*)(HSf + row * 128 + c16 * 8);
        *(bf16x8*)(HSB + row * 136 + c16 * 8) = *(const bf16x8*)(HSbk + row * 128 + c16 * 8);
      }
      LWF[tid] = __logf(dtf[tid]) - acf[tid];
      LWB[tid] = __logf(dtb[tid]) - acb[tid];
      const float al_f = acf[lt * 32 + r], al_b = acb[lt * 32 + r];
      __syncthreads();
      f32x16 acc[2];
      {
        f32x16 t0 = zero16(), t1 = zero16();
#pragma unroll
        for (int kk = 0; kk < 8; ++kk) {
          const bf16x8 cfk = *(const bf16x8*)(cfp + kk * 16);
          t0 = MFMA(*(const bf16x8*)(HSF + (r) * 136 + kk * 16 + 8 * h), cfk, t0);
          t1 = MFMA(*(const bf16x8*)(HSF + (32 + r) * 136 + kk * 16 + 8 * h), cfk, t1);
        }
        const float ef = __expf(al_f);
#pragma unroll
        for (int i = 0; i < 16; ++i) { acc[0][i] = t0[i] * ef; acc[1][i] = t1[i] * ef; }
        t0 = zero16(); t1 = zero16();
#pragma unroll
        for (int kk = 0; kk < 8; ++kk) {
          const bf16x8 cfk = *(const bf16x8*)(cfp + kk * 16);
          t0 = MFMA(*(const bf16x8*)(HSB + (r) * 136 + kk * 16 + 8 * h), cfk, t0);
          t1 = MFMA(*(const bf16x8*)(HSB + (32 + r) * 136 + kk * 16 + 8 * h), cfk, t1);
        }
        const float eb = __expf(al_b);
#pragma unroll
        for (int i = 0; i < 16; ++i) { acc[0][i] += t0[i] * eb; acc[1][i] += t1[i] * eb; }
      }
#pragma unroll 1
      for (int st = 0; st < 8; ++st) {
        const bf16x8 g0 = gtp[0][0], g1 = gtp[0][1];
#pragma unroll
        for (int k = 0; k < 7; ++k) { gtp[k][0] = gtp[k + 1][0]; gtp[k][1] = gtp[k + 1][1]; }
        gtp[7][0] = g0; gtp[7][1] = g1;
#pragma unroll 1
        for (int dir = 0; dir < 2; ++dir) {
          if (dir == 0 ? (st > lt) : (st < lt)) continue;
          const float* lwd = dir == 0 ? LWF : LWB;
          const float al = dir == 0 ? al_f : al_b;
          f32x16 mm;
#pragma unroll
          for (int g4 = 0; g4 < 4; ++g4) {
            const int sb = st * 32 + 8 * g4 + 4 * h;
            const float4 l4 = *(const float4*)(lwd + sb);
            const float lv[4] = {l4.x, l4.y, l4.z, l4.w};
#pragma unroll
            for (int q = 0; q < 4; ++q) {
              const int i = 4 * g4 + q;
              const int sidx = sb + q, lidx = lt * 32 + r;
              const bool valid = dir == 0 ? (sidx <= lidx) : (sidx >= lidx);
              const float gv = bfs((i >> 3) ? g1[i & 7] : g0[i & 7]);
              const float e = __expf(fminf(al + lv[q], 30.f));
              mm[i] = valid ? gv * e : 0.f;
            }
          }
#pragma unroll
          for (int s2 = 0; s2 < 2; ++s2) {
            bf16x8 pf = PACK_HALF(mm, s2);
#pragma unroll
            for (int pt = 0; pt < 2; ++pt) {
              const bfr* xp = XTs + (pt * 32 + r) * 264 + st * 32 + 16 * s2 + 4 * h;
              bf16x8 xf = join44(*(const bf16x4*)xp, *(const bf16x4*)(xp + 8));
              acc[pt] = MFMA(xf, pf, acc[pt]);
            }
          }
        }
      }
      const float dsk = p.d_skip[j * 24 + head];
#pragma unroll
      for (int pt = 0; pt < 2; ++pt)
#pragma unroll
        for (int g4 = 0; g4 < 4; ++g4) {
          const int pb = pt * 32 + 8 * g4 + 4 * h;
          bf16x4 zv = *(const bf16x4*)(Z + (size_t)rowl * 1536 + head * 64 + pb);
          float y[4];
#pragma unroll
          for (int q = 0; q < 4; ++q) {
            float xv = bf2f(XTs[(pb + q) * 264 + lt * 32 + r]);
            float zz = bfs(zv[q]);
            float v = (acc[pt][4 * g4 + q] + dsk * xv) * (zz / (1.f + __expf(-zz)));
            sumsq += v * v; y[q] = v;
          }
          *(bf16x4*)(MIX + (size_t)rowl * 2048 + 512 + head * 64 + pb) = pack4(y[0], y[1], y[2], y[3]);
        }
    }
    const float tot = sumsq + __shfl_xor(sumsq, 32);
    const float sc = rsqrtf(tot * (1.f / 384.f) + 1e-6f);
    const float* ng = p.ssd_norm_g + (size_t)j * 1536;
#pragma unroll 1
    for (int hh = 0; hh < 6; ++hh) {
      const int head = g * 6 + hh;
#pragma unroll
      for (int pt = 0; pt < 2; ++pt)
#pragma unroll
        for (int g4 = 0; g4 < 4; ++g4) {
          const int pb = pt * 32 + 8 * g4 + 4 * h;
          bfr* mp = MIX + (size_t)rowl * 2048 + 512 + head * 64 + pb;
          bf16x4 yv = *(const bf16x4*)mp;
          float4 gg = *(const float4*)(ng + head * 64 + pb);
          *(bf16x4*)mp = pack4(bfs(yv[0]) * sc * gg.x, bfs(yv[1]) * sc * gg.y, bfs(yv[2]) * sc * gg.z, bfs(yv[3]) * sc * gg.w);
        }
    }
  }
}

DI void qkprep_phase(const DP& p, int j) {
  const int lane = p.tidl & 63;
  const int wg = p.bidl * 4 + (p.tidl >> 6), nw = gridDim.x * 4;
  const bfr* P = wsp<bfr>(p, OFF_P); bfr* QK = wsp<bfr>(p, OFF_QK);
  const float* ROPE = wsp<float>(p, OFF_ROPE);
  const int sub = lane >> 3, d0 = (lane & 7) * 8;
  for (int row = wg; row < R; row += nw) {
#pragma unroll
    for (int ps = 0; ps < 4; ++ps) {
      const int hs = ps * 8 + sub;
      const bool act = hs < 26;
      const int hsc = act ? hs : 25;
      const int col = hsc < 10 ? hsc * 64 : 768 + (hsc - 10) * 64;
      bf16x8 xv = *(const bf16x8*)(P + (size_t)row * 2304 + col + d0);
      float x[8]; float ss = 0.f;
#pragma unroll
      for (int e = 0; e < 8; ++e) { x[e] = bfs(xv[e]); ss += x[e] * x[e]; }
      ss += __shfl_xor(ss, 1); ss += __shfl_xor(ss, 2); ss += __shfl_xor(ss, 4);
      const float rs = rsqrtf(ss * (1.f / 64.f) + 1e-6f);
      const float* gv = hsc < 8 ? p.q_norm_win + j * 64 : hsc < 10 ? p.k_norm_win + j * 64 : hsc < 18 ? p.q_norm_na + j * 64 : p.k_norm_na + j * 64;
#pragma unroll
      for (int e = 0; e < 8; ++e) x[e] = x[e] * rs * gv[d0 + e];
      float pr[8];
#pragma unroll
      for (int e = 0; e < 8; ++e) pr[e] = __shfl_xor(x[e], 2);
      if (hsc < 10 && row < RL) {
        const int pos = row & 8191;
        const int axis = d0 >> 5;
        const int idx = axis == 0 ? (pos >> 6) : (pos & 63);
        const int f0 = d0 & 15;
        const bool second = (d0 & 16) != 0;
        const float* cp = ROPE + (axis * 128 + idx) * 16 + f0;
        const float* sp = cp + 4096;
#pragma unroll
        for (int e = 0; e < 8; ++e) {
          float cs = cp[e], sn = sp[e];
          x[e] = second ? (x[e] * cs + pr[e] * sn) : (x[e] * cs - pr[e] * sn);
        }
      }
      const bool isq = hsc < 8 || (hsc >= 10 && hsc < 18);
      const float qs = isq ? 0.125f : 1.f;
      if (act) *(bf16x8*)(QK + (size_t)row * 1664 + hsc * 64 + d0) = pack8(x[0] * qs, x[1] * qs, x[2] * qs, x[3] * qs, x[4] * qs, x[5] * qs, x[6] * qs, x[7] * qs);
    }
  }
}

struct KVF { bf16x8 k[4]; bf16x8 v[2][2]; };
struct KVS { bf16x8 k[4]; bf16x8 v[4]; };

DI void kv_gload(KVS& g, const bfr* __restrict__ Kt, const bfr* __restrict__ Vt, int lane) {
#pragma unroll
  for (int i = 0; i < 4; ++i) {
    const int idx = lane + 64 * i;
    g.k[i] = *(const bf16x8*)(Kt + (size_t)(idx >> 3) * 1664 + (idx & 7) * 8);
    g.v[i] = *(const bf16x8*)(Vt + (size_t)(idx >> 2) * R + (idx & 3) * 8);
  }
}
DI void kv_sstore(const KVS& g, unsigned char* base, int lane) {
#pragma unroll
  for (int i = 0; i < 4; ++i) {
    const int idx = lane + 64 * i;
    { const int row = idx >> 3, c = idx & 7; *(bf16x8*)(base + row * 128 + ((c ^ (row & 7)) << 4)) = g.k[i]; }
    {
      const int d = idx >> 2, c16 = idx & 3, sw = (d >> 2) & 7;
      bf16x4 lo = __builtin_shufflevector(g.v[i], g.v[i], 0, 1, 2, 3), hi = __builtin_shufflevector(g.v[i], g.v[i], 4, 5, 6, 7);
      *(bf16x4*)(base + 4096 + d * 64 + (((2 * c16) ^ sw) << 3)) = lo;
      *(bf16x4*)(base + 4096 + d * 64 + (((2 * c16 + 1) ^ sw) << 3)) = hi;
    }
  }
}
DI void kv_sload(KVF& f, const unsigned char* base, int r, int h) {
#pragma unroll
  for (int kk = 0; kk < 4; ++kk) f.k[kk] = *(const bf16x8*)(base + r * 128 + (((2 * kk + h) ^ (r & 7)) << 4));
#pragma unroll
  for (int s2 = 0; s2 < 2; ++s2)
#pragma unroll
    for (int dt = 0; dt < 2; ++dt) {
      const int d = dt * 32 + r, sw = (d >> 2) & 7, c8 = 4 * s2 + h;
      const unsigned char* vb = base + 4096 + d * 64;
      f.v[s2][dt] = join44(*(const bf16x4*)(vb + ((c8 ^ sw) << 3)), *(const bf16x4*)(vb + (((c8 + 2) ^ sw) << 3)));
    }
}

DI void attn_compute(f32x16 (&o)[2], float& m, float& l, const unsigned char* qb, const unsigned char* base, int r, int h,
                     int mode, int a0, int a1, const float* __restrict__ rp) {
  f32x16 s = zero16();
#pragma unroll
  for (int kk = 0; kk < 4; ++kk) {
    const int off = r * 128 + (((2 * kk + h) ^ (r & 7)) << 4);
    s = MFMA(*(const bf16x8*)(base + off), *(const bf16x8*)(qb + off), s);
  }
  float tmax = -3.0e38f;
  if (mode == 1) {
#pragma unroll
    for (int i = 0; i < 16; ++i) { int dd = a0 - crow(i, h); dd = dd < 0 ? -dd : dd; s[i] = dd <= 128 ? s[i] : -1.0e30f; }
  } else if (mode == 2) {
#pragma unroll
    for (int i = 0; i < 16; ++i) {
      const int key = crow(i, h);
      const int rel = a0 + key;
      int co = a1 + key; co = co < 0 ? 0 : (co > 30 ? 30 : co);
      s[i] = (rel >= 0 && rel < 16) ? s[i] + rp[co] : -1.0e30f;
    }
  }
#pragma unroll
  for (int i = 0; i < 16; ++i) tmax = fmaxf(tmax, s[i]);
  tmax = fmaxf(tmax, __shfl_xor(tmax, 32));
  const float mn = fmaxf(m, tmax);
  const float alpha = __expf(m - mn);
  float ps = 0.f;
#pragma unroll
  for (int i = 0; i < 16; ++i) { s[i] = __expf(s[i] - mn); ps += s[i]; }
  l = l * alpha + ps; m = mn;
#pragma unroll
  for (int i = 0; i < 16; ++i) { o[0][i] *= alpha; o[1][i] *= alpha; }
#pragma unroll
  for (int s2 = 0; s2 < 2; ++s2) {
    bf16x8 pf = PACK_HALF(s, s2);
#pragma unroll
    for (int dt = 0; dt < 2; ++dt) {
      const int d = dt * 32 + r, sw = (d >> 2) & 7, c8 = 4 * s2 + h;
      const unsigned char* vb = base + 4096 + d * 64;
      bf16x8 vf = join44(*(const bf16x4*)(vb + ((c8 ^ sw) << 3)), *(const bf16x4*)(vb + (((c8 + 2) ^ sw) << 3)));
      o[dt] = MFMA(vf, pf, o[dt]);
    }
  }
}

DI void attn_item(const DP& p, int j, int item, int lane) {
  const int r = lane & 31, h = lane >> 5;
  const bfr* QK = wsp<bfr>(p, OFF_QK); const bfr* VT = wsp<bfr>(p, OFF_VT); bfr* MIX = wsp<bfr>(p, OFF_MIX);
  int kind, b, hd, qt;
  if (item < 4096) { kind = 0; qt = item & 255; hd = (item >> 8) & 7; b = item >> 11; }
  else if (item < 8192) { int v = item - 4096; kind = 1; qt = v & 255; hd = (v >> 8) & 7; b = v >> 11; }
  else if (item < 8320) { int v = item - 8192; kind = 2; qt = v & 7; hd = (v >> 3) & 7; b = v >> 6; }
  else { int v = item - 8320; kind = 3; qt = v & 7; hd = (v >> 3) & 7; b = v >> 6; }
  const bool win = (kind == 0 || kind == 2);
  const bool lat = kind < 2;
  const int q_row0 = lat ? b * SEQ + qt * 32 : RL + b * CTX + qt * 32;
  const int qcol = win ? hd * 64 : (10 + hd) * 64;
  const int kcol = win ? (8 + (hd >> 2)) * 64 : (18 + hd) * 64;
  const bfr* Vb = win ? VT + (size_t)((hd >> 2) * 64) * R : VT + (size_t)(128 + hd * 64) * R;
  const bfr* Kb = QK + kcol;
  f32x16 o[2]; o[0] = zero16(); o[1] = zero16();
  float m = -1.0e30f, l = 0.f;
  if (win) { m = p.sink_win[j * 8 + hd]; l = h == 0 ? 1.f : 0.f; }
  int nloc = 0, lo = 0, gr = 0, kr0 = 0, w = 0, cs = 0;
  const int qpos = qt * 32 + r;
  if (kind == 0) { lo = qt - 4 < 0 ? 0 : qt - 4; const int hi = qt + 4 > 255 ? 255 : qt + 4; nloc = hi - lo + 1; }
  else if (kind == 1) {
    gr = qt >> 1; w = (qt & 1) * 32 + r;
    cs = w - 8; cs = cs < 0 ? 0 : (cs > 48 ? 48 : cs);
    kr0 = gr - 4; kr0 = kr0 < 0 ? 0 : (kr0 > 120 ? 120 : kr0);
    nloc = 16;
  }
  const int ntile = 8 + nloc;
  const float* rpb = p.rpb_na + (size_t)j * 8 * 15 * 31 + hd * 15 * 31;
  auto tile_row = [&](int i) -> int {
    if (i < 8) return RL + b * CTX + i * 32;
    const int li = i - 8;
    if (kind == 0) return b * SEQ + (lo + li) * 32;
    return b * SEQ + (kr0 + (li >> 1)) * 64 + (li & 1) * 32;
  };
  unsigned char* lbase = smem + (p.tidl >> 6) * 12288;
  asm volatile("" ::: "memory");
#pragma unroll
  for (int i = 0; i < 4; ++i) {
    const int idx = lane + 64 * i, row = idx >> 3, c = idx & 7;
    *(bf16x8*)(lbase + 8192 + row * 128 + ((c ^ (row & 7)) << 4)) = *(const bf16x8*)(QK + (size_t)(q_row0 + row) * 1664 + qcol + c * 8);
  }
  KVS g;
  { const int k0 = tile_row(0); kv_gload(g, Kb + (size_t)k0 * 1664, Vb + k0, lane); }
  kv_sstore(g, lbase, lane);
#pragma unroll 1
  for (int i = 0; i < ntile; ++i) {
    { const int in = i + 1 < ntile ? i + 1 : i; const int k0 = tile_row(in); kv_gload(g, Kb + (size_t)k0 * 1664, Vb + k0, lane); }
    int mode = 0, a0 = 0, a1 = 0; const float* rp = rpb;
    if (i >= 8) {
      const int li = i - 8;
      if (kind == 0) { mode = 1; a0 = qpos - (lo + li) * 32; }
      else { mode = 2; const int krow = kr0 + (li >> 1); const int ub = (li & 1) * 32; a0 = ub - cs; a1 = ub - w + 15; rp = rpb + (krow - gr + 7) * 31; }
    }
    asm volatile("" ::: "memory");
    attn_compute(o, m, l, lbase + 8192, lbase, r, h, mode, a0, a1, rp);
    asm volatile("" ::: "memory");
    kv_sstore(g, lbase, lane);
  }
  asm volatile("" ::: "memory");
  const float lt = l + __shfl_xor(l, 32);
  const float inv = 1.f / lt;
  const int ocol = win ? hd * 64 : 512 + hd * 64;
#pragma unroll
  for (int dt = 0; dt < 2; ++dt)
#pragma unroll
    for (int g4 = 0; g4 < 4; ++g4) {
      const int d = dt * 32 + 8 * g4 + 4 * h;
      *(bf16x4*)(MIX + (size_t)(q_row0 + r) * 1024 + ocol + d) =
          pack4(o[dt][4 * g4] * inv, o[dt][4 * g4 + 1] * inv, o[dt][4 * g4 + 2] * inv, o[dt][4 * g4 + 3] * inv);
    }
}

DI void attn_phase(const DP& p, int j) {
  const int lane = p.tidl & 63;
  const int wg = p.bidl * 4 + (p.tidl >> 6), nw = gridDim.x * 4;
#pragma unroll 1
  for (int it = wg; it < 8448; it += nw) attn_item(p, j, it, lane);
}

#define XB_TMO      128
#define XB_XCNT(j)  (256  + 64 * (j))
#define XB_XSUB(j)  (1280 + 64 * (j))
#define XB_XGEN(j)  (2304 + 64 * (j))
#define XB_TOP      3328
#define XB_TOPGEN   3392
#define XCD_BAR_WORDS 3456
#define XB_SPIN_CAP (1u << 18)
#define LAS __attribute__((address_space(3)))

__device__ __forceinline__ unsigned xb_ld(unsigned* p)              { return __hip_atomic_load(p, __ATOMIC_RELAXED, __HIP_MEMORY_SCOPE_AGENT); }
__device__ __forceinline__ unsigned xb_add(unsigned* p, unsigned v) { return __hip_atomic_fetch_add(p, v, __ATOMIC_RELAXED, __HIP_MEMORY_SCOPE_AGENT); }
__device__ __forceinline__ unsigned xb_xcc_id() { return (unsigned)__builtin_amdgcn_s_getreg((3 << 11) | 20) & 0xFu; }
#define XB_SPIN(cond, bar) do { unsigned _sp = 0; while (cond) { __builtin_amdgcn_s_sleep(1); \
    if ((++_sp & 255u) == 0u) { if (xb_ld(&(bar)[XB_TMO])) break; if (_sp > XB_SPIN_CAP) { atomicAdd(&(bar)[XB_TMO], 1u); break; } } } } while (0)

struct XcdBarrier {
    unsigned* bar; unsigned x;
    volatile LAS unsigned* st;
};

__device__ __forceinline__ XcdBarrier xcd_barrier_post(unsigned* bar, volatile LAS unsigned* st) {
    XcdBarrier b; b.bar = bar; b.x = xb_xcc_id(); b.st = st;
    if (threadIdx.x == 0) (void)xb_add(&bar[XB_XCNT(b.x)], 1u);
    return b;
}
__device__ __forceinline__ void xcd_barrier_complete(unsigned* bar, unsigned x, unsigned& nloc, unsigned& nx) {
    const unsigned G = gridDim.x * gridDim.y * gridDim.z;
    unsigned sum, cnt, mine, sp = 0u;
    for (;;) {
        sum = 0u; cnt = 0u; mine = 0u;
#pragma unroll
        for (unsigned j = 0; j < 16; ++j) { const unsigned c = xb_ld(&bar[XB_XCNT(j)]); sum += c; cnt += (c > 0u) ? 1u : 0u; mine = (j == x) ? c : mine; }
        if (sum == G) break;
        __builtin_amdgcn_s_sleep(1);
        if ((++sp & 255u) == 0u) { if (xb_ld(&bar[XB_TMO])) break; if (sp > XB_SPIN_CAP) { atomicAdd(&bar[XB_TMO], 1u); break; } }
    }
    nloc = mine > 0u ? mine : 1u; nx = cnt > 0u ? cnt : 1u;
}

__device__ __forceinline__ void xcd_barrier(const XcdBarrier& b) {
    asm volatile("s_waitcnt vmcnt(0)" ::: "memory");
    __syncthreads();
    if (threadIdx.x == 0) {
        unsigned* bar = b.bar;
        __builtin_amdgcn_s_waitcnt(0);
        unsigned nloc = b.st[0], nx = b.st[1];
        if (nloc == 0u) { xcd_barrier_complete(bar, b.x, nloc, nx); b.st[0] = nloc; b.st[1] = nx; }
        const unsigned old = xb_add(&bar[XB_XSUB(b.x)], 1u);
        const unsigned gen = old / nloc;
        if (old + 1u == (gen + 1u) * nloc) {
            __builtin_amdgcn_fence(__ATOMIC_RELEASE, "agent");
            asm volatile("s_waitcnt vmcnt(0)" ::: "memory");
            const unsigned og = xb_add(&bar[XB_TOP], 1u);
            const unsigned tg = og / nx;
            if (og + 1u == (tg + 1u) * nx) xb_add(&bar[XB_TOPGEN], 1u);
            else XB_SPIN(xb_ld(&bar[XB_TOPGEN]) == tg, bar);
            __builtin_amdgcn_fence(__ATOMIC_ACQUIRE, "agent");
            xb_add(&bar[XB_XGEN(b.x)], 1u);
            asm volatile("s_waitcnt vmcnt(0)" ::: "memory");
        } else {
            XB_SPIN(xb_ld(&bar[XB_XGEN(b.x)]) == gen, bar);
            __builtin_amdgcn_fence(__ATOMIC_ACQUIRE, "agent");
            asm volatile("s_waitcnt vmcnt(0)" ::: "memory");
        }
    }
    __syncthreads();
}


DI void run_phase(const DP& p, int ph, int dry) {
  if (ph == 0) { phase0(p); return; }
  int q = ph - 1, layer, lp;
  if (q < 10) { layer = 0; lp = q; } else if (q < 18) { layer = 1; lp = q - 10; } else if (q < 28) { layer = 2; lp = q - 18; } else { layer = 3; lp = q - 28; }
  const int j = layer >> 1;
  const bool even = (layer & 1) == 0;
  int op, gsel = 0;
  if (even) {
    op = (int)((0x2272654321ull >> (4 * lp)) & 15ull); gsel = (int)((0x3201000000ull >> (4 * lp)) & 15ull);
  } else {
    op = (int)((0x22729821ull >> (4 * lp)) & 15ull); gsel = (int)((0x32010000ull >> (4 * lp)) & 15ull);
  }
  if (op == 1) wconv_phase(p, layer);
  if (op == 1 || op == 7) {
    const bool first = op == 1;
    norm_phase(p, layer, (first ? p.norm_mix_g : p.norm_ff_g) + layer * 1024, first ? 0 : 3, first ? 1 : 4);
  } else if (op == 2) {
    int mode, lda, N, K, gch; size_t offA, offB;
    if (gsel == 0) { mode = even ? EPI_EVEN_IN : EPI_ODD_IN; offA = OFF_MIX; lda = 1024; offB = OFF_WIN; N = even ? 5168 : 2304; K = 1024; gch = 0; }
    else if (gsel == 1) { mode = EPI_RESID; offA = OFF_MIX; lda = even ? 2048 : 1024; offB = OFF_WOUT; N = 1024; K = even ? 2048 : 1024; gch = 2; }
    else if (gsel == 2) { mode = EPI_RELU2; offA = OFF_MIX; lda = 1024; offB = OFF_WFF1; N = 4096; K = 1024; gch = 0; }
    else { mode = EPI_RESID; offA = OFF_ACT; lda = 4096; offB = OFF_WFF2; N = 1024; K = 4096; gch = 5; }
    if (dry && mode == EPI_RESID) mode = 4;
    gemm_phase(p, mode, wsp<bfr>(p, offA), lda, wsp<bfr>(p, offB), N, K, layer, gch);
  } else if (op == 3) conv_dt_phase(p, j);
  else if (op == 4) s1f1_phase(p);
  else if (op == 5) s2f2_phase(p);
  else if (op == 6) s3_phase(p, j);
  else if (op == 8) qkprep_phase(p, j);
  else if (op == 9) attn_phase(p, j);
}

DI int probe_reps(int ph) {
#ifdef PROBE_MASK
  if (ph == 0) return (PROBE_MASK & 1) ? 2 : 1;
  int q = ph - 1, layer, lp;
  if (q < 10) { layer = 0; lp = q; } else if (q < 18) { layer = 1; lp = q - 10; } else if (q < 28) { layer = 2; lp = q - 18; } else { layer = 3; lp = q - 28; }
  const bool even = (layer & 1) == 0;
  int op, gsel;
  if (even) { op = (int)((0x2272654321ull >> (4 * lp)) & 15ull); gsel = (int)((0x3201000000ull >> (4 * lp)) & 15ull); }
  else { op = (int)((0x22729821ull >> (4 * lp)) & 15ull); gsel = (int)((0x32010000ull >> (4 * lp)) & 15ull); }
  if (op == 5) return 1;
  if (op == 2 && (gsel == 1 || gsel == 3)) return ((PROBE_MASK >> 10) & 1) ? 2 : 1;
  return ((PROBE_MASK >> op) & 1) ? 2 : 1;
#else
  return 1;
#endif
}

__shared__ uint4 xb_words;

__global__ void __launch_bounds__(256, 2) mega(Params p, int ph0, int ph1) {
  cg::grid_group grid = cg::this_grid();
  if (threadIdx.x == 0) xb_words = make_uint4(0u, 0u, 0u, 0u);
  __syncthreads();
  XcdBarrier xb = xcd_barrier_post((unsigned*)(p.ws + OFF_BAR), (volatile LAS unsigned*)&xb_words);
#pragma unroll 1
  for (int ph = ph0; ph < ph1; ++ph) {
    const int nrep = probe_reps(ph);
#pragma unroll 1
    for (int rep = 0; rep < nrep; ++rep) {
      DP q;
      (Params&)q = p;
      int t = threadIdx.x, bb = blockIdx.x;
      asm volatile("" : "+v"(t));
      asm volatile("" : "+s"(bb));
      int z0;
      asm volatile("s_mov_b32 %0, 0" : "=s"(z0));
      q.ws = p.ws + z0;
      q.out = p.out + z0;
      q.tidl = t; q.bidl = bb;
      run_phase(q, ph, rep + 1 < nrep);
    }
    if (ph + 1 < ph1) {
      if (ph == ph0) grid.sync();
      else xcd_barrier(xb);
    }
  }
}

extern "C" void kernel_launch(void* const* d_in, const int* in_sizes, int n_in, void* d_out, int out_size, void* d_ws,
                              size_t ws_size, hipStream_t stream) {
  static int grid_blocks = 0;
  if (!grid_blocks) {
    int dev = 0, cus = 0, per_cu = 0;
    hipGetDevice(&dev);
    hipDeviceGetAttribute(&cus, hipDeviceAttributeMultiprocessorCount, dev);
    hipOccupancyMaxActiveBlocksPerMultiprocessor(&per_cu, mega, 256, 0);
    if (per_cu > 2) per_cu = 2;
    if (per_cu < 1) per_cu = 1;
    grid_blocks = cus * per_cu;
  }
  Params p{};
  const float** pp = (const float**)&p;
  for (int i = 0; i < 26; ++i) pp[i] = (const float*)d_in[i];
  p.out = (float*)d_out;
  p.ws = (unsigned char*)d_ws;
  if (ws_size < WS_TOTAL) fprintf(stderr, "workspace too small: %zu < %zu\n", ws_size, (size_t)WS_TOTAL);
  hipMemsetAsync((unsigned char*)d_ws + OFF_BAR, 0, XCD_BAR_WORDS * 4, stream);
#if MULTI_LAUNCH
  for (int ph = 0; ph < NPHASE; ++ph) {
    int a = ph, b = ph + 1;
    void* args[] = {&p, &a, &b};
    hipLaunchCooperativeKernel((void*)mega, dim3(grid_blocks), dim3(256), args, 0, stream);
  }
#else
  int a = 0, b = NPHASE;
  void* args[] = {&p, &a, &b};
  hipError_t e = hipLaunchCooperativeKernel((void*)mega, dim3(grid_blocks), dim3(256), args, 0, stream);
  if (e != hipSuccess) fprintf(stderr, "cooperative launch failed: %s (grid %d)\n", hipGetErrorString(e), grid_blocks);
#endif
}
```

```cpp
#include <hip/hip_runtime.h>
#include <hip/hip_cooperative_groups.h>
#include <cstdio>
namespace cg = cooperative_groups;

typedef unsigned short bfr;
typedef __attribute__((ext_vector_type(8))) short bf16x8;
typedef __attribute__((ext_vector_type(4))) short bf16x4;
typedef __attribute__((ext_vector_type(16))) float f32x16;
#define DI __device__ __forceinline__
#define MFMA(a, b, c) __builtin_amdgcn_mfma_f32_32x32x16_bf16((a), (b), (c), 0, 0, 0)

#ifndef MULTI_LAUNCH
#define MULTI_LAUNCH 0
#endif

constexpr int RL = 16384, R = 16896, SEQ = 8192, CTX = 256;
constexpr int NCH = 33, CL = 256;
constexpr int NPHASE = 37;

constexpr size_t al(size_t x) { return (x + 255) & ~size_t(255); }
constexpr size_t OFF_HC = 0;
constexpr size_t OFF_MOD = OFF_HC + al(512 * 1024 * 4);
constexpr size_t OFF_TW = OFF_MOD + al(4 * 3 * 6144 * 4);
constexpr size_t OFF_C128 = OFF_TW + al(8192 * 8);
constexpr size_t OFF_S128 = OFF_C128 + al(128 * 128 * 2);
constexpr size_t OFF_C64 = OFF_S128 + al(128 * 128 * 2);
constexpr size_t OFF_S64 = OFF_C64 + al(64 * 64 * 2);
constexpr size_t OFF_C256 = OFF_S64 + al(64 * 64 * 2);
constexpr size_t OFF_S256 = OFF_C256 + al(256 * 256 * 2);
constexpr size_t OFF_ROPE = OFF_S256 + al(256 * 256 * 2);
constexpr size_t OFF_DTV = OFF_ROPE + al(2 * 2 * 128 * 16 * 4);
constexpr size_t DT_BYTES = (size_t)2 * 2 * NCH * 24 * 256 * 4;
constexpr size_t OFF_ACUM = OFF_DTV + al(DT_BYTES);
constexpr size_t OFF_WIN = OFF_ACUM + al(DT_BYTES);
constexpr size_t OFF_WOUT = OFF_WIN + al((size_t)5248 * 1024 * 2);
constexpr size_t OFF_WFF1 = OFF_WOUT + al((size_t)1024 * 2048 * 2);
constexpr size_t OFF_WFF2 = OFF_WFF1 + al((size_t)4096 * 1024 * 2);
constexpr size_t OFF_MIX = OFF_WFF2 + al((size_t)4096 * 1024 * 2);
constexpr size_t OFF_BIG = OFF_MIX + al((size_t)R * 2048 * 2);
constexpr size_t OFF_Z = OFF_BIG;
constexpr size_t OFF_ZRT = OFF_Z + (size_t)R * 1536 * 2;
constexpr size_t OFF_ZIT = OFF_ZRT + (size_t)512 * R * 2;
constexpr size_t OFF_XBC = OFF_ZIT + (size_t)512 * R * 2;
constexpr size_t OFF_DTRAW = OFF_XBC + (size_t)R * 2560 * 2;
constexpr size_t BIG_END = OFF_DTRAW + (size_t)R * 48 * 4;
constexpr size_t OFF_HS = OFF_XBC;
constexpr size_t HS_BYTES = (size_t)2 * 2 * NCH * 24 * 8192 * 2;
constexpr size_t OFF_YR = OFF_HS + HS_BYTES;
constexpr size_t OFF_YI = OFF_YR + (size_t)2 * 512 * 128 * 64 * 2;
static_assert(OFF_YI + (size_t)2 * 512 * 128 * 64 * 2 <= OFF_DTRAW, "fft scratch overflows");
constexpr size_t OFF_ACT = OFF_BIG;
static_assert((size_t)R * 4096 * 2 <= BIG_END - OFF_BIG, "act overflows");
constexpr size_t OFF_P = OFF_BIG;
constexpr size_t OFF_VT = OFF_P + (size_t)R * 2304 * 2;
constexpr size_t OFF_QK = OFF_VT + (size_t)640 * R * 2;
static_assert(OFF_QK + (size_t)R * 1664 * 2 <= BIG_END, "odd overflows");
constexpr size_t OFF_XT = al(BIG_END);
constexpr size_t OFF_BN = OFF_XT + (size_t)1536 * R * 2;
constexpr size_t OFF_BT = OFF_BN + (size_t)R * 512 * 2;
constexpr size_t OFF_CN = OFF_BT + (size_t)512 * R * 2;
constexpr size_t OFF_BAR = al(OFF_CN + (size_t)R * 512 * 2);
constexpr size_t WS_TOTAL = OFF_BAR + 16384;
static_assert(WS_TOTAL <= 402653184ull, "workspace too large");

struct Params {
  const float *x, *c, *ctx, *c_ctx, *w_mod, *b_mod, *norm_mix_g, *norm_ff_g, *w_ff1, *w_ff2;
  const float *w_in_even, *conv_w, *conv_b, *dt_bias, *a_log, *d_skip, *ssd_norm_g, *w_out_even;
  const float *w_in_odd, *q_norm_win, *k_norm_win, *sink_win, *q_norm_na, *k_norm_na, *rpb_na, *w_out_odd;
  float* out;
  unsigned char* ws;
};

struct DP : Params { int tidl, bidl; };

__shared__ __attribute__((aligned(16))) unsigned char smem[73728];

DI bfr f2bf(float x) { unsigned u = __float_as_uint(x); u += 0x7fffu + ((u >> 16) & 1u); return (bfr)(u >> 16); }
DI float bf2f(bfr b) { return __uint_as_float(((unsigned)b) << 16); }
DI float bfs(short s) { return __uint_as_float(((unsigned)(unsigned short)s) << 16); }
DI int crow(int i, int h) { return (i & 3) + 8 * (i >> 2) + 4 * h; }
DI f32x16 zero16() { f32x16 z; for (int i = 0; i < 16; ++i) z[i] = 0.f; return z; }
DI bf16x8 pack8(float a0, float a1, float a2, float a3, float a4, float a5, float a6, float a7) {
  bf16x8 v;
  v[0] = (short)f2bf(a0); v[1] = (short)f2bf(a1); v[2] = (short)f2bf(a2); v[3] = (short)f2bf(a3);
  v[4] = (short)f2bf(a4); v[5] = (short)f2bf(a5); v[6] = (short)f2bf(a6); v[7] = (short)f2bf(a7);
  return v;
}
DI bf16x4 pack4(float a0, float a1, float a2, float a3) {
  bf16x4 v; v[0] = (short)f2bf(a0); v[1] = (short)f2bf(a1); v[2] = (short)f2bf(a2); v[3] = (short)f2bf(a3); return v;
}
#define PACK_HALF(s, s2) pack8(s[8 * (s2)], s[8 * (s2) + 1], s[8 * (s2) + 2], s[8 * (s2) + 3], s[8 * (s2) + 4], s[8 * (s2) + 5], s[8 * (s2) + 6], s[8 * (s2) + 7])
DI bf16x8 join44(bf16x4 lo, bf16x4 hi) { return __builtin_shufflevector(lo, hi, 0, 1, 2, 3, 4, 5, 6, 7); }
DI int chunk_row0(int b, int c) { return c == 0 ? RL + b * CTX : b * SEQ + (c - 1) * CL; }

DI void sincos_turn(double f, float& s, float& c) {
  f -= rint(f);
  double x = f * 6.283185307179586476925;
  double x2 = x * x, ss = 1.0, cc = 1.0;
#pragma unroll
  for (int k = 13; k >= 1; --k) {
    ss = 1.0 - x2 / (double)((2 * k) * (2 * k + 1)) * ss;
    cc = 1.0 - x2 / (double)((2 * k - 1) * (2 * k)) * cc;
  }
  s = (float)(x * ss); c = (float)cc;
}

template <class T> DI T* wsp(const DP& p, size_t off) { return (T*)(p.ws + off); }

DI void phase0(const DP& p) {
  const int tid = p.tidl, bid = p.bidl, G = gridDim.x;
  float* lds = (float*)smem;
  float* MOD = wsp<float>(p, OFF_MOD);
  for (int u = bid; u < 384; u += G) {
    int layer = u / 96, cb = u % 96;
    for (int i = tid; i < 3072; i += 256) {
      int v = i >> 10, k = i & 1023;
      float c = v < 2 ? p.c[v * 1024 + k] : p.c_ctx[k];
      lds[i] = c / (1.f + expf(-c));
    }
    __syncthreads();
    int kq = tid >> 6, cc = tid & 63, col = cb * 64 + cc;
    const float* w = p.w_mod + (size_t)layer * 1024 * 6144 + col;
    float a0 = 0, a1 = 0, a2 = 0;
    for (int k = kq * 256; k < kq * 256 + 256; ++k) {
      float wv = w[(size_t)k * 6144];
      a0 += lds[k] * wv; a1 += lds[1024 + k] * wv; a2 += lds[2048 + k] * wv;
    }
    float* red = lds + 3072;
    red[(kq * 3 + 0) * 64 + cc] = a0; red[(kq * 3 + 1) * 64 + cc] = a1; red[(kq * 3 + 2) * 64 + cc] = a2;
    __syncthreads();
    if (tid < 192) {
      int v = tid >> 6;
      float s = red[(0 * 3 + v) * 64 + cc] + red[(1 * 3 + v) * 64 + cc] + red[(2 * 3 + v) * 64 + cc] + red[(3 * 3 + v) * 64 + cc];
      MOD[(layer * 3 + v) * 6144 + col] = s + p.b_mod[layer * 6144 + col];
    }
    __syncthreads();
  }
  const int gt = bid * 256 + tid, nt = G * 256;
  {
    const float4* xs = (const float4*)p.x; float4* od = (float4*)p.out;
    for (int i = gt; i < RL * 256; i += nt) od[i] = xs[i];
    const float4* cs = (const float4*)p.ctx; float4* hd = wsp<float4>(p, OFF_HC);
    for (int i = gt; i < 512 * 256; i += nt) hd[i] = cs[i];
  }
  float2* TW = wsp<float2>(p, OFF_TW);
  for (int i = gt; i < 8192; i += nt) { float s, c; sincos_turn((double)i / 8192.0, s, c); TW[i] = make_float2(c, s); }
  bfr* C128 = wsp<bfr>(p, OFF_C128); bfr* S128 = wsp<bfr>(p, OFF_S128);
  for (int i = gt; i < 128 * 128; i += nt) { int a = i >> 7, b = i & 127; float s, c; sincos_turn((double)((a * b) & 127) / 128.0, s, c); C128[i] = f2bf(c); S128[i] = f2bf(s); }
  bfr* C64 = wsp<bfr>(p, OFF_C64); bfr* S64 = wsp<bfr>(p, OFF_S64);
  for (int i = gt; i < 64 * 64; i += nt) { int a = i >> 6, b = i & 63; float s, c; sincos_turn((double)((a * b) & 63) / 64.0, s, c); C64[i] = f2bf(c); S64[i] = f2bf(s); }
  bfr* C256 = wsp<bfr>(p, OFF_C256); bfr* S256 = wsp<bfr>(p, OFF_S256);
  for (int i = gt; i < 256 * 256; i += nt) { int a = i >> 8, b = i & 255; float s, c; sincos_turn((double)((a * b) & 255) / 256.0, s, c); C256[i] = f2bf(c); S256[i] = f2bf(s); }
  float* ROPE = wsp<float>(p, OFF_ROPE);
  for (int i = gt; i < 2 * 128 * 16; i += nt) {
    int f = i & 15, idx = (i >> 4) & 127;
    float ang = (float)idx * (float)exp(-(double)f * 0.5756462732485115);
    float s, c; sincos_turn((double)ang / 6.283185307179586476925, s, c);
    ROPE[i] = c; ROPE[4096 + i] = s;
  }
}

DI void tcvt_unit(const float* __restrict__ src, int ld, int c0, int ncols, int K, bfr* __restrict__ dst, int dr0, int u, int tid) {
  const int ntk = K >> 6;
  const int tn = u / ntk, tk = u % ntk, k0 = tk * 64, nb = tn * 64;
  bfr* T = (bfr*)smem;
  float4 v[4];
  const int n4 = (tid & 15) * 4;
#pragma unroll
  for (int i = 0; i < 4; ++i) {
    const int kk = (tid >> 4) + 16 * i;
    v[i] = make_float4(0.f, 0.f, 0.f, 0.f);
    if (nb + n4 < ncols) v[i] = *(const float4*)(src + (size_t)(k0 + kk) * ld + c0 + nb + n4);
  }
#pragma unroll
  for (int i = 0; i < 4; ++i) {
    const int kk = (tid >> 4) + 16 * i;
    T[(n4 + 0) * 72 + kk] = f2bf(v[i].x); T[(n4 + 1) * 72 + kk] = f2bf(v[i].y);
    T[(n4 + 2) * 72 + kk] = f2bf(v[i].z); T[(n4 + 3) * 72 + kk] = f2bf(v[i].w);
  }
  __syncthreads();
  {
    int n = tid >> 2, kseg = (tid & 3) * 16;
    if (nb + n < ncols) {
      bfr* d = dst + (size_t)(dr0 + nb + n) * K + k0 + kseg;
      *(bf16x8*)d = *(const bf16x8*)(T + n * 72 + kseg);
      *(bf16x8*)(d + 8) = *(const bf16x8*)(T + n * 72 + kseg + 8);
    }
  }
  __syncthreads();
}

DI void wconv_phase(const DP& p, int layer) {
  const int tid = p.tidl;
  const int j = layer >> 1;
  bfr* WIN = wsp<bfr>(p, OFF_WIN); bfr* WOUT = wsp<bfr>(p, OFF_WOUT);
  bfr* WFF1 = wsp<bfr>(p, OFF_WFF1); bfr* WFF2 = wsp<bfr>(p, OFF_WFF2);
  const float* ff1 = p.w_ff1 + (size_t)layer * 1024 * 4096;
  const float* ff2 = p.w_ff2 + (size_t)layer * 4096 * 1024;
  float* cst = (float*)(smem + 20480);
  if (tid < 64) { float s, c; sincos_turn((double)tid / 64.0, s, c); cst[tid] = c; cst[64 + tid] = s; }
  __syncthreads();
  if ((layer & 1) == 0) {
    const float* win = p.w_in_even + (size_t)j * 1024 * 4656;
    const float* wout = p.w_out_even + (size_t)j * 2048 * 1024;
    const int n_in = 65 * 16, n_out = 16 * 32, n_f1 = 64 * 16, n_f2 = 16 * 64, n_fold = 128;
    const int total = n_in + n_out + n_f1 + n_f2 + n_fold;
    for (int u = p.bidl; u < total; u += gridDim.x) {
      int v = u;
      if (v < n_in) { tcvt_unit(win, 4656, 512, 4144, 1024, WIN, 1024, v, tid); continue; }
      v -= n_in;
      if (v < n_out) { tcvt_unit(wout, 1024, 0, 1024, 2048, WOUT, 0, v, tid); continue; }
      v -= n_out;
      if (v < n_f1) { tcvt_unit(ff1, 4096, 0, 4096, 1024, WFF1, 0, v, tid); continue; }
      v -= n_f1;
      if (v < n_f2) { tcvt_unit(ff2, 1024, 0, 1024, 4096, WFF2, 0, v, tid); continue; }
      v -= n_f2;
      {
        const int g = v >> 4, kb = v & 15;
        float* wt = (float*)smem;
#pragma unroll
        for (int i = 0; i < 4; ++i) {
          const int idx = tid + 256 * i, kk = idx >> 4, j4 = (idx & 15) * 4;
          const float4 wv = *(const float4*)(win + (size_t)(kb * 64 + kk) * 4656 + g * 64 + j4);
          wt[kk * 65 + j4] = wv.x; wt[kk * 65 + j4 + 1] = wv.y; wt[kk * 65 + j4 + 2] = wv.z; wt[kk * 65 + j4 + 3] = wv.w;
        }
        __syncthreads();
        const int kl = tid & 63, mg = tid >> 6;
#pragma unroll 1
        for (int mi = 0; mi < 16; ++mi) {
          const int m = mg * 16 + mi;
          float sc = 0.f, ss = 0.f;
#pragma unroll 8
          for (int jj = 0; jj < 64; ++jj) { const float w = wt[kl * 65 + jj]; const int idx = (m * jj) & 63; sc += w * cst[idx]; ss += w * cst[64 + idx]; }
          const int ch = g * 64 + m, k = kb * 64 + kl;
          WIN[(size_t)ch * 1024 + k] = f2bf(sc);
          WIN[(size_t)(512 + ch) * 1024 + k] = f2bf(-ss);
        }
        __syncthreads();
      }
    }
  } else {
    const float* win = p.w_in_odd + (size_t)j * 1024 * 2304;
    const float* wout = p.w_out_odd + (size_t)j * 1024 * 1024;
    const int n_in = 36 * 16, n_out = 16 * 16, n_f1 = 64 * 16, n_f2 = 16 * 64;
    const int total = n_in + n_out + n_f1 + n_f2;
    for (int u = p.bidl; u < total; u += gridDim.x) {
      int v = u;
      if (v < n_in) { tcvt_unit(win, 2304, 0, 2304, 1024, WIN, 0, v, tid); continue; }
      v -= n_in;
      if (v < n_out) { tcvt_unit(wout, 1024, 0, 1024, 1024, WOUT, 0, v, tid); continue; }
      v -= n_out;
      if (v < n_f1) { tcvt_unit(ff1, 4096, 0, 4096, 1024, WFF1, 0, v, tid); continue; }
      v -= n_f1;
      tcvt_unit(ff2, 1024, 0, 1024, 4096, WFF2, 0, v, tid);
    }
  }
}

DI void norm_phase(const DP& p, int layer, const float* __restrict__ gvec, int shc, int scc) {
  const int lane = p.tidl & 63;
  const int wg = p.bidl * 4 + (p.tidl >> 6), nw = gridDim.x * 4;
  const float* MOD = wsp<float>(p, OFF_MOD);
  const float* HC = wsp<float>(p, OFF_HC);
  bfr* U = wsp<bfr>(p, OFF_MIX);
  for (int row = wg; row < R; row += nw) {
    const float* hp = row < RL ? p.out + (size_t)row * 1024 : HC + (size_t)(row - RL) * 1024;
    const int ms = row < RL ? (row >> 13) : 2;
    const float* md = MOD + (layer * 3 + ms) * 6144;
    float4 v[4]; float ss = 0.f;
#pragma unroll
    for (int i = 0; i < 4; ++i) {
      v[i] = *(const float4*)(hp + i * 256 + lane * 4);
      ss += v[i].x * v[i].x + v[i].y * v[i].y + v[i].z * v[i].z + v[i].w * v[i].w;
    }
#pragma unroll
    for (int o = 32; o >= 1; o >>= 1) ss += __shfl_xor(ss, o);
    const float rs = rsqrtf(ss * (1.f / 1024.f) + 1e-6f);
#pragma unroll
    for (int i = 0; i < 4; ++i) {
      int col = i * 256 + lane * 4;
      float4 g = *(const float4*)(gvec + col);
      float4 sc = *(const float4*)(md + scc * 1024 + col);
      float4 sh = *(const float4*)(md + shc * 1024 + col);
      bf16x4 o = pack4(v[i].x * rs * g.x * (1.f + sc.x) + sh.x, v[i].y * rs * g.y * (1.f + sc.y) + sh.y,
                       v[i].z * rs * g.z * (1.f + sc.z) + sh.z, v[i].w * rs * g.w * (1.f + sc.w) + sh.w);
      *(bf16x4*)(U + (size_t)row * 1024 + col) = o;
    }
  }
}

enum { EPI_EVEN_IN = 0, EPI_ODD_IN = 1, EPI_RELU2 = 2, EPI_RESID = 3 };

DI void gemm_phase(const DP& p, int mode, const bfr* __restrict__ A, int lda, const bfr* __restrict__ Bt,
                   int N, int K, int layer, int gchunk) {
  const int tid = p.tidl, lane = tid & 63, wid = tid >> 6, r = lane & 31, h = lane >> 5;
  const int wm = wid >> 1, wn = wid & 1;
  const int nN = (N + 127) >> 7, nM = R / 128;
  const int tiles = nM * nN, G = (int)gridDim.x;
  int full = tiles, tail = 0, St = 1;
  if (mode == EPI_RESID) {
    full = (tiles / G) * G; tail = tiles - full;
    if (tail > 0) { int c = G / tail; int kmax = K >> 7; St = 1; while (St * 2 <= c && St * 2 <= 16 && St * 2 <= kmax) St *= 2; }
  }
  const int chunk = (full + 7) >> 3;
  const int units = chunk * 8 + tail * St;
  bfr* sm = (bfr*)smem;
  const int lrow = tid >> 3, lc = (tid & 7) * 8;
#pragma unroll 1
  for (int u = p.bidl; u < units; u += G) {
    int t, ks, Ks; bool atom;
    if (u < chunk * 8) {
      t = (u & 7) * chunk + (u >> 3);
      if (t >= full) continue;
      ks = 0; Ks = K; atom = false;
    } else { const int v = u - chunk * 8; t = full + v / St; ks = v % St; Ks = K / St; atom = St > 1; }
    const int nk = Ks >> 6;
    const int panel = t / (nM * 8); const int rem = t - panel * nM * 8;
    const int pw = (nN - panel * 8) < 8 ? (nN - panel * 8) : 8;
    const int tm = rem / pw, tn = panel * 8 + rem % pw;
    const int m0 = tm * 128, n0 = tn * 128, kbase = ks * Ks;
    f32x16 acc[2][2];
    acc[0][0] = zero16(); acc[0][1] = zero16(); acc[1][0] = zero16(); acc[1][1] = zero16();
    const bfr* Ag = A + (size_t)(m0 + lrow) * lda + kbase + lc;
    const bfr* Bg = Bt + (size_t)(n0 + lrow) * K + kbase + lc;
    bf16x8 ra[4], rb[4];
#pragma unroll
    for (int i = 0; i < 4; ++i) {
      ra[i] = *(const bf16x8*)(Ag + (size_t)(32 * i) * lda);
      rb[i] = *(const bf16x8*)(Bg + (size_t)(32 * i) * K);
    }
#pragma unroll
    for (int i = 0; i < 4; ++i) {
      *(bf16x8*)(sm + (lrow + 32 * i) * 72 + lc) = ra[i];
      *(bf16x8*)(sm + 9216 + (lrow + 32 * i) * 72 + lc) = rb[i];
    }
    if (nk > 1) {
#pragma unroll
      for (int i = 0; i < 4; ++i) {
        ra[i] = *(const bf16x8*)(Ag + (size_t)(32 * i) * lda + 64);
        rb[i] = *(const bf16x8*)(Bg + (size_t)(32 * i) * K + 64);
      }
    }
    __syncthreads();
#pragma unroll 1
    for (int kt = 0; kt < nk; ++kt) {
      if (kt + 1 < nk) {
        bfr* Ad = sm + ((kt + 1) & 1) * 18432;
#pragma unroll
        for (int i = 0; i < 4; ++i) {
          *(bf16x8*)(Ad + (lrow + 32 * i) * 72 + lc) = ra[i];
          *(bf16x8*)(Ad + 9216 + (lrow + 32 * i) * 72 + lc) = rb[i];
        }
      }
      if (kt + 2 < nk) {
#pragma unroll
        for (int i = 0; i < 4; ++i) {
          ra[i] = *(const bf16x8*)(Ag + (size_t)(32 * i) * lda + (kt + 2) * 64);
          rb[i] = *(const bf16x8*)(Bg + (size_t)(32 * i) * K + (kt + 2) * 64);
        }
      }
      const bfr* As = sm + (kt & 1) * 18432;
      const bfr* Bs = As + 9216;
      __builtin_amdgcn_s_setprio(1);
#pragma unroll
      for (int kk = 0; kk < 4; ++kk) {
        bf16x8 a0 = *(const bf16x8*)(As + (wm * 64 + r) * 72 + kk * 16 + h * 8);
        bf16x8 a1 = *(const bf16x8*)(As + (wm * 64 + 32 + r) * 72 + kk * 16 + h * 8);
        bf16x8 b0 = *(const bf16x8*)(Bs + (wn * 64 + r) * 72 + kk * 16 + h * 8);
        bf16x8 b1 = *(const bf16x8*)(Bs + (wn * 64 + 32 + r) * 72 + kk * 16 + h * 8);
        acc[0][0] = MFMA(a0, b0, acc[0][0]);
        acc[0][1] = MFMA(a0, b1, acc[0][1]);
        acc[1][0] = MFMA(a1, b0, acc[1][0]);
        acc[1][1] = MFMA(a1, b1, acc[1][1]);
      }
      __builtin_amdgcn_s_setprio(0);
      __syncthreads();
    }
#pragma unroll
    for (int mi = 0; mi < 2; ++mi)
#pragma unroll
      for (int ni = 0; ni < 2; ++ni)
#pragma unroll
        for (int g4 = 0; g4 < 4; ++g4) {
          const int row = m0 + wm * 64 + mi * 32 + 8 * g4 + 4 * h;
          const int col = n0 + wn * 64 + ni * 32 + r;
          const float v0 = acc[mi][ni][4 * g4], v1 = acc[mi][ni][4 * g4 + 1], v2 = acc[mi][ni][4 * g4 + 2], v3 = acc[mi][ni][4 * g4 + 3];
          if (mode == EPI_EVEN_IN) {
            if (col < 1024) {
              bfr* dst = wsp<bfr>(p, col < 512 ? OFF_ZRT : OFF_ZIT) + (size_t)(col & 511) * R + row;
              *(bf16x4*)dst = pack4(v0, v1, v2, v3);
            } else if (col < 2560) {
              bfr* dst = wsp<bfr>(p, OFF_Z) + (size_t)row * 1536 + (col - 1024);
              dst[0] = f2bf(v0); dst[1536] = f2bf(v1); dst[2 * 1536] = f2bf(v2); dst[3 * 1536] = f2bf(v3);
            } else if (col < 5120) {
              bfr* dst = wsp<bfr>(p, OFF_XBC) + (size_t)row * 2560 + (col - 2560);
              dst[0] = f2bf(v0); dst[2560] = f2bf(v1); dst[2 * 2560] = f2bf(v2); dst[3 * 2560] = f2bf(v3);
            } else if (col < 5168) {
              float* dst = wsp<float>(p, OFF_DTRAW) + (size_t)row * 48 + (col - 5120);
              dst[0] = v0; dst[48] = v1; dst[96] = v2; dst[144] = v3;
            }
          } else if (mode == EPI_ODD_IN) {
            if (col >= 640 && col < 768) {
              *(bf16x4*)(wsp<bfr>(p, OFF_VT) + (size_t)(col - 640) * R + row) = pack4(v0, v1, v2, v3);
            } else if (col >= 1792) {
              *(bf16x4*)(wsp<bfr>(p, OFF_VT) + (size_t)(128 + col - 1792) * R + row) = pack4(v0, v1, v2, v3);
            } else {
              bfr* dst = wsp<bfr>(p, OFF_P) + (size_t)row * 2304 + col;
              dst[0] = f2bf(v0); dst[2304] = f2bf(v1); dst[2 * 2304] = f2bf(v2); dst[3 * 2304] = f2bf(v3);
            }
          } else if (mode == EPI_RELU2) {
            bfr* dst = wsp<bfr>(p, OFF_ACT) + (size_t)row * 4096 + col;
            float t0 = fmaxf(v0, 0.f), t1 = fmaxf(v1, 0.f), t2 = fmaxf(v2, 0.f), t3 = fmaxf(v3, 0.f);
            dst[0] = f2bf(t0 * t0); dst[4096] = f2bf(t1 * t1); dst[2 * 4096] = f2bf(t2 * t2); dst[3 * 4096] = f2bf(t3 * t3);
          } else if (mode == EPI_RESID) {
            const int ms = row < RL ? (row >> 13) : 2;
            const float gate = wsp<float>(p, OFF_MOD)[(layer * 3 + ms) * 6144 + gchunk * 1024 + col];
            float* hp = row < RL ? p.out + (size_t)row * 1024 + col : wsp<float>(p, OFF_HC) + (size_t)(row - RL) * 1024 + col;
            if (atom) {
              unsafeAtomicAdd(hp, gate * v0); unsafeAtomicAdd(hp + 1024, gate * v1);
              unsafeAtomicAdd(hp + 2048, gate * v2); unsafeAtomicAdd(hp + 3072, gate * v3);
            } else {
              hp[0] += gate * v0; hp[1024] += gate * v1; hp[2048] += gate * v2; hp[3072] += gate * v3;
            }
          }
        }
  }
}

DI float softplus_f(float x) { return x > 0.f ? x + log1pf(expf(-x)) : log1pf(expf(x)); }

DI void conv_dt_phase(const DP& p, int j) {
  const int tid = p.tidl, lane = tid & 63, wid = tid >> 6;
  const bfr* XBC = wsp<bfr>(p, OFF_XBC);
  bfr* XT = wsp<bfr>(p, OFF_XT); bfr* BN = wsp<bfr>(p, OFF_BN); bfr* BTt = wsp<bfr>(p, OFF_BT); bfr* CN = wsp<bfr>(p, OFF_CN);
  bfr* TT = (bfr*)smem;
  const float* cw = p.conv_w + (size_t)j * 5 * 2560;
  const float* cb = p.conv_b + (size_t)j * 2560;
  const int n_conv = 264 * 40, n_dt = 792;
  for (int u = p.bidl; u < n_conv + n_dt; u += gridDim.x) {
    if (u < n_conv) {
      const int tb = u / 40, cbk = u % 40, row0 = tb * 64, ch0 = cbk * 64;
      int pos0, len;
      if (row0 < RL) { pos0 = row0 & 8191; len = SEQ; } else { pos0 = (row0 - RL) & 255; len = CTX; }
      const int c8 = tid & 7, ch = ch0 + c8 * 8;
      float w[5][8], bias[8];
#pragma unroll
      for (int k = 0; k < 5; ++k) {
        float4 wa = *(const float4*)(cw + k * 2560 + ch), wb = *(const float4*)(cw + k * 2560 + ch + 4);
        w[k][0] = wa.x; w[k][1] = wa.y; w[k][2] = wa.z; w[k][3] = wa.w; w[k][4] = wb.x; w[k][5] = wb.y; w[k][6] = wb.z; w[k][7] = wb.w;
      }
      {
        float4 wa = *(const float4*)(cb + ch), wb = *(const float4*)(cb + ch + 4);
        bias[0] = wa.x; bias[1] = wa.y; bias[2] = wa.z; bias[3] = wa.w; bias[4] = wb.x; bias[5] = wb.y; bias[6] = wb.z; bias[7] = wb.w;
      }
#pragma unroll
      for (int ps = 0; ps < 2; ++ps) {
        const int tl = (tid >> 3) + 32 * ps, pos = pos0 + tl, row = row0 + tl;
        float a[8];
#pragma unroll
        for (int e = 0; e < 8; ++e) a[e] = bias[e];
        bf16x8 xr[5];
#pragma unroll
        for (int k = 0; k < 5; ++k) {
          const int pp = pos + k - 2;
          const bool ok = pp >= 0 && pp < len;
          const bfr* xp = XBC + (size_t)(ok ? row + k - 2 : row) * 2560 + ch;
          xr[k] = *(const bf16x8*)xp;
          if (!ok) { for (int e = 0; e < 8; ++e) xr[k][e] = 0; }
        }
#pragma unroll
        for (int k = 0; k < 5; ++k)
#pragma unroll
          for (int e = 0; e < 8; ++e) a[e] += w[k][e] * bfs(xr[k][e]);
        bf16x8 o;
#pragma unroll
        for (int e = 0; e < 8; ++e) { float s = a[e] / (1.f + __expf(-a[e])); o[e] = (short)f2bf(s); }
        if (ch0 >= 2048) *(bf16x8*)(CN + (size_t)row * 512 + (ch - 2048)) = o;
        else if (ch0 >= 1536) *(bf16x8*)(BN + (size_t)row * 512 + (ch - 1536)) = o;
        if (ch0 < 2048) {
#pragma unroll
          for (int e = 0; e < 8; ++e) TT[(c8 * 8 + e) * 72 + tl] = (bfr)o[e];
        }
      }
      if (ch0 < 2048) {
        __syncthreads();
        const int chl = tid >> 2, tseg = (tid & 3) * 16;
        bfr* dst = (ch0 < 1536 ? XT + (size_t)(ch0 + chl) * R : BTt + (size_t)(ch0 - 1536 + chl) * R) + row0 + tseg;
        *(bf16x8*)dst = *(const bf16x8*)(TT + chl * 72 + tseg);
        *(bf16x8*)(dst + 8) = *(const bf16x8*)(TT + chl * 72 + tseg + 8);
        __syncthreads();
      }
    } else {
      const int item = (u - n_conv) * 4 + wid;
      const int head = item % 24; int rest = item / 24; const int dir = rest & 1; rest >>= 1; const int c = rest % NCH, b = rest / NCH;
      const int row0 = chunk_row0(b, c), col = dir * 24 + head;
      const float bias = p.dt_bias[j * 48 + col];
      const float a = -expf(p.a_log[j * 48 + col]);
      const float* DTRAW = wsp<float>(p, OFF_DTRAW);
      float dt[4], cs[4];
      float run = 0.f;
#pragma unroll
      for (int q = 0; q < 4; ++q) {
        dt[q] = softplus_f(DTRAW[(size_t)(row0 + lane * 4 + q) * 48 + col] + bias);
        run += dt[q] * a; cs[q] = run;
      }
      float x = run;
#pragma unroll
      for (int o = 1; o < 64; o <<= 1) { float t2 = __shfl_up(x, o); if (lane >= o) x += t2; }
      const float excl = x - run;
      const float total = __shfl(x, 63);
      float ac[4];
#pragma unroll
      for (int q = 0; q < 4; ++q) {
        float inc = excl + cs[q];
        ac[q] = dir == 0 ? inc : total - inc + dt[q] * a;
      }
      const size_t base = ((size_t)(((dir * 2 + b) * NCH + c) * 24 + head)) * 256 + lane * 4;
      *(float4*)(wsp<float>(p, OFF_DTV) + base) = make_float4(dt[0], dt[1], dt[2], dt[3]);
      *(float4*)(wsp<float>(p, OFF_ACUM) + base) = make_float4(ac[0], ac[1], ac[2], ac[3]);
    }
  }
}

DI bf16x8 scale8(bf16x8 a, const float* w) {
  return pack8(bfs(a[0]) * w[0], bfs(a[1]) * w[1], bfs(a[2]) * w[2], bfs(a[3]) * w[3],
               bfs(a[4]) * w[4], bfs(a[5]) * w[5], bfs(a[6]) * w[6], bfs(a[7]) * w[7]);
}

DI void s1_item(const DP& p, int item, int lane) {
  const int r = lane & 31, h = lane >> 5;
  const int head = item % 24; int rest = item / 24; const int dir = rest & 1; rest >>= 1; const int c = rest % NCH, b = rest / NCH;
  const int g = head / 6;
  const int row0 = chunk_row0(b, c);
  const size_t dbase = ((size_t)(((dir * 2 + b) * NCH + c) * 24 + head)) * 256;
  const float* dtv = wsp<float>(p, OFF_DTV) + dbase;
  const float* acm = wsp<float>(p, OFF_ACUM) + dbase;
  const float acend = dir == 0 ? acm[255] : acm[0];
  const bfr* XT = wsp<bfr>(p, OFF_XT); const bfr* BTt = wsp<bfr>(p, OFF_BT);
  bfr* HS = wsp<bfr>(p, OFF_HS) + ((size_t)(((dir * 2 + b) * NCH + c) * 24 + head)) * 8192;
#pragma unroll 1
  for (int pt = 0; pt < 2; ++pt) {
    f32x16 acc[4];
#pragma unroll
    for (int n = 0; n < 4; ++n) acc[n] = zero16();
#pragma unroll 4
    for (int kk = 0; kk < 16; ++kk) {
      const int s0 = kk * 16 + 8 * h;
      float4 d0 = *(const float4*)(dtv + s0), d1 = *(const float4*)(dtv + s0 + 4);
      float4 a0 = *(const float4*)(acm + s0), a1 = *(const float4*)(acm + s0 + 4);
      float w[8];
      w[0] = d0.x * __expf(acend - a0.x); w[1] = d0.y * __expf(acend - a0.y); w[2] = d0.z * __expf(acend - a0.z); w[3] = d0.w * __expf(acend - a0.w);
      w[4] = d1.x * __expf(acend - a1.x); w[5] = d1.y * __expf(acend - a1.y); w[6] = d1.z * __expf(acend - a1.z); w[7] = d1.w * __expf(acend - a1.w);
      bf16x8 af = scale8(*(const bf16x8*)(XT + (size_t)(head * 64 + pt * 32 + r) * R + row0 + s0), w);
#pragma unroll
      for (int nt = 0; nt < 4; ++nt) {
        bf16x8 bfv = *(const bf16x8*)(BTt + (size_t)(g * 128 + nt * 32 + r) * R + row0 + s0);
        acc[nt] = MFMA(af, bfv, acc[nt]);
      }
    }
#pragma unroll
    for (int nt = 0; nt < 4; ++nt)
#pragma unroll
      for (int i = 0; i < 16; ++i) HS[(pt * 32 + crow(i, h)) * 128 + nt * 32 + r] = f2bf(acc[nt][i]);
  }
}

DI void f1_item(const DP& p, int item, int lane) {
  const int r = lane & 31, h = lane >> 5;
  const int l2t = item & 1, m = (item >> 1) & 511, b = item >> 10;
  const bfr* ZRT = wsp<bfr>(p, OFF_ZRT) + (size_t)m * R + b * SEQ + l2t * 32 + r;
  const bfr* ZIT = wsp<bfr>(p, OFF_ZIT) + (size_t)m * R + b * SEQ + l2t * 32 + r;
  const bfr* C128 = wsp<bfr>(p, OFF_C128); const bfr* S128 = wsp<bfr>(p, OFF_S128);
  const float2* TW = wsp<float2>(p, OFF_TW);
  bfr* YR = wsp<bfr>(p, OFF_YR); bfr* YI = wsp<bfr>(p, OFF_YI);
  const int l2 = l2t * 32 + r;
#pragma unroll 1
  for (int mh = 0; mh < 2; ++mh) {
    f32x16 yr[2], yi[2];
#pragma unroll
    for (int i = 0; i < 2; ++i) { yr[i] = zero16(); yi[i] = zero16(); }
#pragma unroll 2
    for (int kk = 0; kk < 8; ++kk) {
      bf16x8 zr, zi, nzr;
#pragma unroll
      for (int jj = 0; jj < 8; ++jj) {
        int l1 = kk * 16 + 8 * h + jj;
        zr[jj] = (short)ZRT[l1 * 64]; zi[jj] = (short)ZIT[l1 * 64];
        nzr[jj] = (short)(zr[jj] ^ (short)0x8000);
      }
#pragma unroll
      for (int m2 = 0; m2 < 2; ++m2) {
        const int mt = mh * 2 + m2;
        bf16x8 ca = *(const bf16x8*)(C128 + (mt * 32 + r) * 128 + kk * 16 + 8 * h);
        bf16x8 sa = *(const bf16x8*)(S128 + (mt * 32 + r) * 128 + kk * 16 + 8 * h);
        yr[m2] = MFMA(ca, zr, yr[m2]); yr[m2] = MFMA(sa, zi, yr[m2]);
        yi[m2] = MFMA(ca, zi, yi[m2]); yi[m2] = MFMA(sa, nzr, yi[m2]);
      }
    }
#pragma unroll
    for (int m2 = 0; m2 < 2; ++m2)
#pragma unroll
      for (int i = 0; i < 16; ++i) {
        int k1 = (mh * 2 + m2) * 32 + crow(i, h);
        float2 t = TW[k1 * l2];
        float a = yr[m2][i], bb = yi[m2][i];
        size_t o = ((size_t)(b * 512 + m) * 128 + k1) * 64 + l2;
        YR[o] = f2bf(a * t.x + bb * t.y);
        YI[o] = f2bf(bb * t.x - a * t.y);
      }
  }
}

DI void f1c_item(const DP& p, int item, int lane) {
  const int r = lane & 31, h = lane >> 5;
  const int mt = item & 15, kt = (item >> 4) & 7, b = item >> 7;
  const int m = mt * 32 + r;
  const bfr* ZRT = wsp<bfr>(p, OFF_ZRT) + (size_t)m * R + RL + b * CTX;
  const bfr* ZIT = wsp<bfr>(p, OFF_ZIT) + (size_t)m * R + RL + b * CTX;
  const bfr* C256 = wsp<bfr>(p, OFF_C256) + (kt * 32 + r) * 256;
  const bfr* S256 = wsp<bfr>(p, OFF_S256) + (kt * 32 + r) * 256;
  f32x16 acc = zero16();
#pragma unroll 4
  for (int kk = 0; kk < 16; ++kk) {
    int o = kk * 16 + 8 * h;
    acc = MFMA(*(const bf16x8*)(C256 + o), *(const bf16x8*)(ZRT + o), acc);
    acc = MFMA(*(const bf16x8*)(S256 + o), *(const bf16x8*)(ZIT + o), acc);
  }
  bfr* MIX = wsp<bfr>(p, OFF_MIX);
#pragma unroll
  for (int i = 0; i < 16; ++i)
    MIX[(size_t)(RL + b * CTX + kt * 32 + crow(i, h)) * 2048 + m] = f2bf(acc[i] * (1.f / 128.f));
}

DI void s1f1_phase(const DP& p) {
  const int lane = p.tidl & 63;
  const int wg = p.bidl * 4 + (p.tidl >> 6), nw = gridDim.x * 4;
  const int n_s1 = 2 * NCH * 2 * 24, n_f1 = 2048, n_f1c = 256;
#pragma unroll 1
  for (int it = wg; it < n_s1 + n_f1 + n_f1c; it += nw) {
    if (it < n_s1) s1_item(p, it, lane);
    else if (it < n_s1 + n_f1) f1_item(p, it - n_s1, lane);
    else f1c_item(p, it - n_s1 - n_f1, lane);
  }
}

DI void f2_item(const DP& p, int item, int lane) {
  const int r = lane & 31, h = lane >> 5;
  const int mt16 = item & 15, k1 = (item >> 4) & 127, b = item >> 11;
  const int m = mt16 * 32 + r;
  const bfr* YR = wsp<bfr>(p, OFF_YR) + ((size_t)(b * 512 + m) * 128 + k1) * 64;
  const bfr* YI = wsp<bfr>(p, OFF_YI) + ((size_t)(b * 512 + m) * 128 + k1) * 64;
  const bfr* C64 = wsp<bfr>(p, OFF_C64); const bfr* S64 = wsp<bfr>(p, OFF_S64);
  f32x16 acc[2]; acc[0] = zero16(); acc[1] = zero16();
#pragma unroll
  for (int kk = 0; kk < 4; ++kk) {
    bf16x8 yr = *(const bf16x8*)(YR + kk * 16 + 8 * h), yi = *(const bf16x8*)(YI + kk * 16 + 8 * h);
#pragma unroll
    for (int t = 0; t < 2; ++t) {
      bf16x8 ca = *(const bf16x8*)(C64 + (t * 32 + r) * 64 + kk * 16 + 8 * h);
      bf16x8 sa = *(const bf16x8*)(S64 + (t * 32 + r) * 64 + kk * 16 + 8 * h);
      acc[t] = MFMA(ca, yr, acc[t]); acc[t] = MFMA(sa, yi, acc[t]);
    }
  }
  bfr* MIX = wsp<bfr>(p, OFF_MIX);
  const float scale = 0.001381067932f;
#pragma unroll
  for (int t = 0; t < 2; ++t)
#pragma unroll
    for (int i = 0; i < 16; ++i) {
      int k2 = t * 32 + crow(i, h);
      MIX[(size_t)(b * SEQ + k1 + 128 * k2) * 2048 + m] = f2bf(acc[t][i] * scale);
    }
}

DI void s2f2_phase(const DP& p) {
  const int gt = p.bidl * 256 + p.tidl, nt = gridDim.x * 256;
  bfr* HSb = wsp<bfr>(p, OFF_HS);
  const float* ACUM = wsp<float>(p, OFF_ACUM);
#pragma unroll 1
  for (int it = gt; it < 2 * 2 * 24 * 2048; it += nt) {
    const int e4 = it & 2047; const int rest = it >> 11; const int head = rest % 24, db = rest / 24, dir = db >> 1;
    bf16x4 sv[NCH]; float cd[NCH];
#pragma unroll
    for (int step = 0; step < NCH; ++step) {
      const int c = dir == 0 ? step : (step == 0 ? 0 : NCH - step);
      const size_t ci = (size_t)((db * NCH + c) * 24 + head);
      sv[step] = *(const bf16x4*)(HSb + ci * 8192 + e4 * 4);
      cd[step] = ACUM[ci * 256 + (dir == 0 ? 255 : 0)];
    }
    float h0 = 0.f, h1 = 0.f, h2 = 0.f, h3 = 0.f;
#pragma unroll
    for (int step = 0; step < NCH; ++step) {
      const int c = dir == 0 ? step : (step == 0 ? 0 : NCH - step);
      const size_t ci = (size_t)((db * NCH + c) * 24 + head);
      *(bf16x4*)(HSb + ci * 8192 + e4 * 4) = pack4(h0, h1, h2, h3);
      const float e = __expf(cd[step]);
      h0 = h0 * e + bfs(sv[step][0]); h1 = h1 * e + bfs(sv[step][1]); h2 = h2 * e + bfs(sv[step][2]); h3 = h3 * e + bfs(sv[step][3]);
    }
  }
  const int lane = p.tidl & 63;
  const int wg = p.bidl * 4 + (p.tidl >> 6), nw = gridDim.x * 4;
#pragma unroll 1
  for (int it = wg; it < 4096; it += nw) f2_item(p, it, lane);
}

DI void s3_phase(const DP& p, int j) {
  const int tid = p.tidl, lane = tid & 63, wid = tid >> 6, r = lane & 31, h = lane >> 5;
  const bfr* CN = wsp<bfr>(p, OFF_CN); const bfr* BN = wsp<bfr>(p, OFF_BN); const bfr* XT = wsp<bfr>(p, OFF_XT);
  const bfr* Z = wsp<bfr>(p, OFF_Z); bfr* MIX = wsp<bfr>(p, OFF_MIX);
  bfr* XTs = (bfr*)smem;
  bfr* HSF = (bfr*)(smem + 33792);
  bfr* HSB = (bfr*)(smem + 51200);
  float* LWF = (float*)(smem + 68608);
  float* LWB = LWF + 256;
#pragma unroll 1
  for (int item = p.bidl; item < 2 * NCH * 4 * 2; item += (int)gridDim.x) {
    const int half = item & 1, g = (item >> 1) & 3; const int bc = item >> 3; const int c = bc % NCH, b = bc / NCH;
    const int row0 = chunk_row0(b, c);
    const int lt = half * 4 + wid;
    const int rowl = row0 + lt * 32 + r;
    const bfr* cfp = CN + (size_t)rowl * 512 + g * 128 + 8 * h;
    bf16x8 gtp[8][2];
    {
      bf16x8 cf[8];
#pragma unroll
      for (int kk = 0; kk < 8; ++kk) cf[kk] = *(const bf16x8*)(cfp + kk * 16);
#pragma unroll
      for (int k = 0; k < 8; ++k) { gtp[k][0] = cf[0]; gtp[k][1] = cf[0]; }
#pragma unroll 1
      for (int st = 0; st < 8; ++st) {
        f32x16 gt = zero16();
#pragma unroll
        for (int kk = 0; kk < 8; ++kk)
          gt = MFMA(*(const bf16x8*)(BN + (size_t)(row0 + st * 32 + r) * 512 + g * 128 + kk * 16 + 8 * h), cf[kk], gt);
#pragma unroll
        for (int k = 0; k < 7; ++k) { gtp[k][0] = gtp[k + 1][0]; gtp[k][1] = gtp[k + 1][1]; }
        gtp[7][0] = PACK_HALF(gt, 0); gtp[7][1] = PACK_HALF(gt, 1);
      }
    }
    float sumsq = 0.f;
#pragma unroll 1
    for (int hh = 0; hh < 6; ++hh) {
      const int head = g * 6 + hh;
      const size_t cif = (size_t)(((0 * 2 + b) * NCH + c) * 24 + head), cib = (size_t)(((1 * 2 + b) * NCH + c) * 24 + head);
      const float* acf = wsp<float>(p, OFF_ACUM) + cif * 256; const float* acb = wsp<float>(p, OFF_ACUM) + cib * 256;
      const float* dtf = wsp<float>(p, OFF_DTV) + cif * 256; const float* dtb = wsp<float>(p, OFF_DTV) + cib * 256;
      const bfr* HSf = wsp<bfr>(p, OFF_HS) + cif * 8192; const bfr* HSbk = wsp<bfr>(p, OFF_HS) + cib * 8192;
      __syncthreads();
#pragma unroll 4
      for (int i = 0; i < 8; ++i) {
        const int idx = tid + 256 * i, row = idx >> 5, c16 = idx & 31;
        *(bf16x8*)(XTs + row * 264 + c16 * 8) = *(const bf16x8*)(XT + (size_t)(head * 64 + row) * R + row0 + c16 * 8);
      }
#pragma unroll 2
      for (int i = 0; i < 4; ++i) {
        const int idx = tid + 256 * i, row = idx >> 4, c16 = idx & 15;
        *(bf16x8*)(HSF + row * 136 + c16 * 8) = *(const bf16x8*)(HSf + row * 128 + c16 * 8);
        *(bf16x8*)(HSB + row * 136 + c16 * 8) = *(const bf16x8*)(HSbk + row * 128 + c16 * 8);
      }
      LWF[tid] = __logf(dtf[tid]) - acf[tid];
      LWB[tid] = __logf(dtb[tid]) - acb[tid];
      const float al_f = acf[lt * 32 + r], al_b = acb[lt * 32 + r];
      __syncthreads();
      f32x16 acc[2];
      {
        f32x16 t0 = zero16(), t1 = zero16();
#pragma unroll
        for (int kk = 0; kk < 8; ++kk) {
          const bf16x8 cfk = *(const bf16x8*)(cfp + kk * 16);
          t0 = MFMA(*(const bf16x8*)(HSF + (r) * 136 + kk * 16 + 8 * h), cfk, t0);
          t1 = MFMA(*(const bf16x8*)(HSF + (32 + r) * 136 + kk * 16 + 8 * h), cfk, t1);
        }
        const float ef = __expf(al_f);
#pragma unroll
        for (int i = 0; i < 16; ++i) { acc[0][i] = t0[i] * ef; acc[1][i] = t1[i] * ef; }
        t0 = zero16(); t1 = zero16();
#pragma unroll
        for (int kk = 0; kk < 8; ++kk) {
          const bf16x8 cfk = *(const bf16x8*)(cfp + kk * 16);
          t0 = MFMA(*(const bf16x8*)(HSB + (r) * 136 + kk * 16 + 8 * h), cfk, t0);
          t1 = MFMA(*(const bf16x8*)(HSB + (32 + r) * 136 + kk * 16 + 8 * h), cfk, t1);
        }
        const float eb = __expf(al_b);
#pragma unroll
        for (int i = 0; i < 16; ++i) { acc[0][i] += t0[i] * eb; acc[1][i] += t1[i] * eb; }
      }
#pragma unroll 1
      for (int st = 0; st < 8; ++st) {
        const bf16x8 g0 = gtp[0][0], g1 = gtp[0][1];
#pragma unroll
        for (int k = 0; k < 7; ++k) { gtp[k][0] = gtp[k + 1][0]; gtp[k][1] = gtp[k + 1][1]; }
        gtp[7][0] = g0; gtp[7][1] = g1;
#pragma unroll 1
        for (int dir = 0; dir < 2; ++dir) {
          if (dir == 0 ? (st > lt) : (st < lt)) continue;
          const float* lwd = dir == 0 ? LWF : LWB;
          const float al = dir == 0 ? al_f : al_b;
          f32x16 mm;
#pragma unroll
          for (int g4 = 0; g4 < 4; ++g4) {
            const int sb = st * 32 + 8 * g4 + 4 * h;
            const float4 l4 = *(const float4*)(lwd + sb);
            const float lv[4] = {l4.x, l4.y, l4.z, l4.w};
#pragma unroll
            for (int q = 0; q < 4; ++q) {
              const int i = 4 * g4 + q;
              const int sidx = sb + q, lidx = lt * 32 + r;
              const bool valid = dir == 0 ? (sidx <= lidx) : (sidx >= lidx);
              const float gv = bfs((i >> 3) ? g1[i & 7] : g0[i & 7]);
              const float e = __expf(fminf(al + lv[q], 30.f));
              mm[i] = valid ? gv * e : 0.f;
            }
          }
#pragma unroll
          for (int s2 = 0; s2 < 2; ++s2) {
            bf16x8 pf = PACK_HALF(mm, s2);
#pragma unroll
            for (int pt = 0; pt < 2; ++pt) {
              const bfr* xp = XTs + (pt * 32 + r) * 264 + st * 32 + 16 * s2 + 4 * h;
              bf16x8 xf = join44(*(const bf16x4*)xp, *(const bf16x4*)(xp + 8));
              acc[pt] = MFMA(xf, pf, acc[pt]);
            }
          }
        }
      }
      const float dsk = p.d_skip[j * 24 + head];
#pragma unroll
      for (int pt = 0; pt < 2; ++pt)
#pragma unroll
        for (int g4 = 0; g4 < 4; ++g4) {
          const int pb = pt * 32 + 8 * g4 + 4 * h;
          bf16x4 zv = *(const bf16x4*)(Z + (size_t)rowl * 1536 + head * 64 + pb);
          float y[4];
#pragma unroll
          for (int q = 0; q < 4; ++q) {
            float xv = bf2f(XTs[(pb + q) * 264 + lt * 32 + r]);
            float zz = bfs(zv[q]);
            float v = (acc[pt][4 * g4 + q] + dsk * xv) * (zz / (1.f + __expf(-zz)));
            sumsq += v * v; y[q] = v;
          }
          *(bf16x4*)(MIX + (size_t)rowl * 2048 + 512 + head * 64 + pb) = pack4(y[0], y[1], y[2], y[3]);
        }
    }
    const float tot = sumsq + __shfl_xor(sumsq, 32);
    const float sc = rsqrtf(tot * (1.f / 384.f) + 1e-6f);
    const float* ng = p.ssd_norm_g + (size_t)j * 1536;
#pragma unroll 1
    for (int hh = 0; hh < 6; ++hh) {
      const int head = g * 6 + hh;
#pragma unroll
      for (int pt = 0; pt < 2; ++pt)
#pragma unroll
        for (int g4 = 0; g4 < 4; ++g4) {
          const int pb = pt * 32 + 8 * g4 + 4 * h;
          bfr* mp = MIX + (size_t)rowl * 2048 + 512 + head * 64 + pb;
          bf16x4 yv = *(const bf16x4*)mp;
          float4 gg = *(const float4*)(ng + head * 64 + pb);
          *(bf16x4*)mp = pack4(bfs(yv[0]) * sc * gg.x, bfs(yv[1]) * sc * gg.y, bfs(yv[2]) * sc * gg.z, bfs(yv[3]) * sc * gg.w);
        }
    }
  }
}

DI void qkprep_phase(const DP& p, int j) {
  const int lane = p.tidl & 63;
  const int wg = p.bidl * 4 + (p.tidl >> 6), nw = gridDim.x * 4;
  const bfr* P = wsp<bfr>(p, OFF_P); bfr* QK = wsp<bfr>(p, OFF_QK);
  const float* ROPE = wsp<float>(p, OFF_ROPE);
  const int sub = lane >> 3, d0 = (lane & 7) * 8;
  for (int row = wg; row < R; row += nw) {
#pragma unroll
    for (int ps = 0; ps < 4; ++ps) {
      const int hs = ps * 8 + sub;
      const bool act = hs < 26;
      const int hsc = act ? hs : 25;
      const int col = hsc < 10 ? hsc * 64 : 768 + (hsc - 10) * 64;
      bf16x8 xv = *(const bf16x8*)(P + (size_t)row * 2304 + col + d0);
      float x[8]; float ss = 0.f;
#pragma unroll
      for (int e = 0; e < 8; ++e) { x[e] = bfs(xv[e]); ss += x[e] * x[e]; }
      ss += __shfl_xor(ss, 1); ss += __shfl_xor(ss, 2); ss += __shfl_xor(ss, 4);
      const float rs = rsqrtf(ss * (1.f / 64.f) + 1e-6f);
      const float* gv = hsc < 8 ? p.q_norm_win + j * 64 : hsc < 10 ? p.k_norm_win + j * 64 : hsc < 18 ? p.q_norm_na + j * 64 : p.k_norm_na + j * 64;
#pragma unroll
      for (int e = 0; e < 8; ++e) x[e] = x[e] * rs * gv[d0 + e];
      float pr[8];
#pragma unroll
      for (int e = 0; e < 8; ++e) pr[e] = __shfl_xor(x[e], 2);
      if (hsc < 10 && row < RL) {
        const int pos = row & 8191;
        const int axis = d0 >> 5;
        const int idx = axis == 0 ? (pos >> 6) : (pos & 63);
        const int f0 = d0 & 15;
        const bool second = (d0 & 16) != 0;
        const float* cp = ROPE + (axis * 128 + idx) * 16 + f0;
        const float* sp = cp + 4096;
#pragma unroll
        for (int e = 0; e < 8; ++e) {
          float cs = cp[e], sn = sp[e];
          x[e] = second ? (x[e] * cs + pr[e] * sn) : (x[e] * cs - pr[e] * sn);
        }
      }
      const bool isq = hsc < 8 || (hsc >= 10 && hsc < 18);
      const float qs = isq ? 0.125f : 1.f;
      if (act) *(bf16x8*)(QK + (size_t)row * 1664 + hsc * 64 + d0) = pack8(x[0] * qs, x[1] * qs, x[2] * qs, x[3] * qs, x[4] * qs, x[5] * qs, x[6] * qs, x[7] * qs);
    }
  }
}

struct KVF { bf16x8 k[4]; bf16x8 v[2][2]; };
struct KVS { bf16x8 k[4]; bf16x8 v[4]; };

DI void kv_gload(KVS& g, const bfr* __restrict__ Kt, const bfr* __restrict__ Vt, int lane) {
#pragma unroll
  for (int i = 0; i < 4; ++i) {
    const int idx = lane + 64 * i;
    g.k[i] = *(const bf16x8*)(Kt + (size_t)(idx >> 3) * 1664 + (idx & 7) * 8);
    g.v[i] = *(const bf16x8*)(Vt + (size_t)(idx >> 2) * R + (idx & 3) * 8);
  }
}
DI void kv_sstore(const KVS& g, unsigned char* base, int lane) {
#pragma unroll
  for (int i = 0; i < 4; ++i) {
    const int idx = lane + 64 * i;
    { const int row = idx >> 3, c = idx & 7; *(bf16x8*)(base + row * 128 + ((c ^ (row & 7)) << 4)) = g.k[i]; }
    {
      const int d = idx >> 2, c16 = idx & 3, sw = (d >> 2) & 7;
      bf16x4 lo = __builtin_shufflevector(g.v[i], g.v[i], 0, 1, 2, 3), hi = __builtin_shufflevector(g.v[i], g.v[i], 4, 5, 6, 7);
      *(bf16x4*)(base + 4096 + d * 64 + (((2 * c16) ^ sw) << 3)) = lo;
      *(bf16x4*)(base + 4096 + d * 64 + (((2 * c16 + 1) ^ sw) << 3)) = hi;
    }
  }
}
DI void kv_sload(KVF& f, const unsigned char* base, int r, int h) {
#pragma unroll
  for (int kk = 0; kk < 4; ++kk) f.k[kk] = *(const bf16x8*)(base + r * 128 + (((2 * kk + h) ^ (r & 7)) << 4));
#pragma unroll
  for (int s2 = 0; s2 < 2; ++s2)
#pragma unroll
    for (int dt = 0; dt < 2; ++dt) {
      const int d = dt * 32 + r, sw = (d >> 2) & 7, c8 = 4 * s2 + h;
      const unsigned char* vb = base + 4096 + d * 64;
      f.v[s2][dt] = join44(*(const bf16x4*)(vb + ((c8 ^ sw) << 3)), *(const bf16x4*)(vb + (((c8 + 2) ^ sw) << 3)));
    }
}

DI void attn_compute(f32x16 (&o)[2], float& m, float& l, const unsigned char* qb, const unsigned char* base, int r, int h,
                     int mode, int a0, int a1, const float* __restrict__ rp) {
  f32x16 s = zero16();
#pragma unroll
  for (int kk = 0; kk < 4; ++kk) {
    const int off = r * 128 + (((2 * kk + h) ^ (r & 7)) << 4);
    s = MFMA(*(const bf16x8*)(base + off), *(const bf16x8*)(qb + off), s);
  }
  float tmax = -3.0e38f;
  if (mode == 1) {
#pragma unroll
    for (int i = 0; i < 16; ++i) { int dd = a0 - crow(i, h); dd = dd < 0 ? -dd : dd; s[i] = dd <= 128 ? s[i] : -1.0e30f; }
  } else if (mode == 2) {
#pragma unroll
    for (int i = 0; i < 16; ++i) {
      const int key = crow(i, h);
      const int rel = a0 + key;
      int co = a1 + key; co = co < 0 ? 0 : (co > 30 ? 30 : co);
      s[i] = (rel >= 0 && rel < 16) ? s[i] + rp[co] : -1.0e30f;
    }
  }
#pragma unroll
  for (int i = 0; i < 16; ++i) tmax = fmaxf(tmax, s[i]);
  tmax = fmaxf(tmax, __shfl_xor(tmax, 32));
  const float mn = fmaxf(m, tmax);
  const float alpha = __expf(m - mn);
  float ps = 0.f;
#pragma unroll
  for (int i = 0; i < 16; ++i) { s[i] = __expf(s[i] - mn); ps += s[i]; }
  l = l * alpha + ps; m = mn;
#pragma unroll
  for (int i = 0; i < 16; ++i) { o[0][i] *= alpha; o[1][i] *= alpha; }
#pragma unroll
  for (int s2 = 0; s2 < 2; ++s2) {
    bf16x8 pf = PACK_HALF(s, s2);
#pragma unroll
    for (int dt = 0; dt < 2; ++dt) {
      const int d = dt * 32 + r, sw = (d >> 2) & 7, c8 = 4 * s2 + h;
      const unsigned char* vb = base + 4096 + d * 64;
      bf16x8 vf = join44(*(const bf16x4*)(vb + ((c8 ^ sw) << 3)), *(const bf16x4*)(vb + (((c8 + 2) ^ sw) << 3)));
      o[dt] = MFMA(vf, pf, o[dt]);
    }
  }
}

DI void attn_item(const DP& p, int j, int item, int lane) {
  const int r = lane & 31, h = lane >> 5;
  const bfr* QK = wsp<bfr>(p, OFF_QK); const bfr* VT = wsp<bfr>(p, OFF_VT); bfr* MIX = wsp<bfr>(p, OFF_MIX);
  int kind, b, hd, qt;
  if (item < 4096) { kind = 0; qt = item & 255; hd = (item >> 8) & 7; b = item >> 11; }
  else if (item < 8192) { int v = item - 4096; kind = 1; qt = v & 255; hd = (v >> 8) & 7; b = v >> 11; }
  else if (item < 8320) { int v = item - 8192; kind = 2; qt = v & 7; hd = (v >> 3) & 7; b = v >> 6; }
  else { int v = item - 8320; kind = 3; qt = v & 7; hd = (v >> 3) & 7; b = v >> 6; }
  const bool win = (kind == 0 || kind == 2);
  const bool lat = kind < 2;
  const int q_row0 = lat ? b * SEQ + qt * 32 : RL + b * CTX + qt * 32;
  const int qcol = win ? hd * 64 : (10 + hd) * 64;
  const int kcol = win ? (8 + (hd >> 2)) * 64 : (18 + hd) * 64;
  const bfr* Vb = win ? VT + (size_t)((hd >> 2) * 64) * R : VT + (size_t)(128 + hd * 64) * R;
  const bfr* Kb = QK + kcol;
  f32x16 o[2]; o[0] = zero16(); o[1] = zero16();
  float m = -1.0e30f, l = 0.f;
  if (win) { m = p.sink_win[j * 8 + hd]; l = h == 0 ? 1.f : 0.f; }
  int nloc = 0, lo = 0, gr = 0, kr0 = 0, w = 0, cs = 0;
  const int qpos = qt * 32 + r;
  if (kind == 0) { lo = qt - 4 < 0 ? 0 : qt - 4; const int hi = qt + 4 > 255 ? 255 : qt + 4; nloc = hi - lo + 1; }
  else if (kind == 1) {
    gr = qt >> 1; w = (qt & 1) * 32 + r;
    cs = w - 8; cs = cs < 0 ? 0 : (cs > 48 ? 48 : cs);
    kr0 = gr - 4; kr0 = kr0 < 0 ? 0 : (kr0 > 120 ? 120 : kr0);
    nloc = 16;
  }
  const int ntile = 8 + nloc;
  const float* rpb = p.rpb_na + (size_t)j * 8 * 15 * 31 + hd * 15 * 31;
  auto tile_row = [&](int i) -> int {
    if (i < 8) return RL + b * CTX + i * 32;
    const int li = i - 8;
    if (kind == 0) return b * SEQ + (lo + li) * 32;
    return b * SEQ + (kr0 + (li >> 1)) * 64 + (li & 1) * 32;
  };
  unsigned char* lbase = smem + (p.tidl >> 6) * 12288;
  asm volatile("" ::: "memory");
#pragma unroll
  for (int i = 0; i < 4; ++i) {
    const int idx = lane + 64 * i, row = idx >> 3, c = idx & 7;
    *(bf16x8*)(lbase + 8192 + row * 128 + ((c ^ (row & 7)) << 4)) = *(const bf16x8*)(QK + (size_t)(q_row0 + row) * 1664 + qcol + c * 8);
  }
  KVS g;
  { const int k0 = tile_row(0); kv_gload(g, Kb + (size_t)k0 * 1664, Vb + k0, lane); }
  kv_sstore(g, lbase, lane);
#pragma unroll 1
  for (int i = 0; i < ntile; ++i) {
    { const int in = i + 1 < ntile ? i + 1 : i; const int k0 = tile_row(in); kv_gload(g, Kb + (size_t)k0 * 1664, Vb + k0, lane); }
    int mode = 0, a0 = 0, a1 = 0; const float* rp = rpb;
    if (i >= 8) {
      const int li = i - 8;
      if (kind == 0) { mode = 1; a0 = qpos - (lo + li) * 32; }
      else { mode = 2; const int krow = kr0 + (li >> 1); const int ub = (li & 1) * 32; a0 = ub - cs; a1 = ub - w + 15; rp = rpb + (krow - gr + 7) * 31; }
    }
    asm volatile("" ::: "memory");
    attn_compute(o, m, l, lbase + 8192, lbase, r, h, mode, a0, a1, rp);
    asm volatile("" ::: "memory");
    kv_sstore(g, lbase, lane);
  }
  asm volatile("" ::: "memory");
  const float lt = l + __shfl_xor(l, 32);
  const float inv = 1.f / lt;
  const int ocol = win ? hd * 64 : 512 + hd * 64;
#pragma unroll
  for (int dt = 0; dt < 2; ++dt)
#pragma unroll
    for (int g4 = 0; g4 < 4; ++g4) {
      const int d = dt * 32 + 8 * g4 + 4 * h;
      *(bf16x4*)(MIX + (size_t)(q_row0 + r) * 1024 + ocol + d) =
          pack4(o[dt][4 * g4] * inv, o[dt][4 * g4 + 1] * inv, o[dt][4 * g4 + 2] * inv, o[dt][4 * g4 + 3] * inv);
    }
}

DI void attn_phase(const DP& p, int j) {
  const int lane = p.tidl & 63;
  const int wg = p.bidl * 4 + (p.tidl >> 6), nw = gridDim.x * 4;
#pragma unroll 1
  for (int it = wg; it < 8448; it += nw) attn_item(p, j, it, lane);
}

#define XB_TMO      128
#define XB_XCNT(j)  (256  + 64 * (j))
#define XB_XSUB(j)  (1280 + 64 * (j))
#define XB_XGEN(j)  (2304 + 64 * (j))
#define XB_TOP      3328
#define XB_TOPGEN   3392
#define XCD_BAR_WORDS 3456
#define XB_SPIN_CAP (1u << 18)
#define LAS __attribute__((address_space(3)))

__device__ __forceinline__ unsigned xb_ld(unsigned* p)              { return __hip_atomic_load(p, __ATOMIC_RELAXED, __HIP_MEMORY_SCOPE_AGENT); }
__device__ __forceinline__ unsigned xb_add(unsigned* p, unsigned v) { return __hip_atomic_fetch_add(p, v, __ATOMIC_RELAXED, __HIP_MEMORY_SCOPE_AGENT); }
__device__ __forceinline__ unsigned xb_xcc_id() { return (unsigned)__builtin_amdgcn_s_getreg((3 << 11) | 20) & 0xFu; }
#define XB_SPIN(cond, bar) do { unsigned _sp = 0; while (cond) { __builtin_amdgcn_s_sleep(1); \
    if ((++_sp & 255u) == 0u) { if (xb_ld(&(bar)[XB_TMO])) break; if (_sp > XB_SPIN_CAP) { atomicAdd(&(bar)[XB_TMO], 1u); break; } } } } while (0)

struct XcdBarrier {
    unsigned* bar; unsigned x;
    volatile LAS unsigned* st;
};

__device__ __forceinline__ XcdBarrier xcd_barrier_post(unsigned* bar, volatile LAS unsigned* st) {
    XcdBarrier b; b.bar = bar; b.x = xb_xcc_id(); b.st = st;
    if (threadIdx.x == 0) (void)xb_add(&bar[XB_XCNT(b.x)], 1u);
    return b;
}
__device__ __forceinline__ void xcd_barrier_complete(unsigned* bar, unsigned x, unsigned& nloc, unsigned& nx) {
    const unsigned G = gridDim.x * gridDim.y * gridDim.z;
    unsigned sum, cnt, mine, sp = 0u;
    for (;;) {
        sum = 0u; cnt = 0u; mine = 0u;
#pragma unroll
        for (unsigned j = 0; j < 16; ++j) { const unsigned c = xb_ld(&bar[XB_XCNT(j)]); sum += c; cnt += (c > 0u) ? 1u : 0u; mine = (j == x) ? c : mine; }
        if (sum == G) break;
        __builtin_amdgcn_s_sleep(1);
        if ((++sp & 255u) == 0u) { if (xb_ld(&bar[XB_TMO])) break; if (sp > XB_SPIN_CAP) { atomicAdd(&bar[XB_TMO], 1u); break; } }
    }
    nloc = mine > 0u ? mine : 1u; nx = cnt > 0u ? cnt : 1u;
}

__device__ __forceinline__ void xcd_barrier(const XcdBarrier& b) {
    asm volatile("s_waitcnt vmcnt(0)" ::: "memory");
    __syncthreads();
    if (threadIdx.x == 0) {
        unsigned* bar = b.bar;
        __builtin_amdgcn_s_waitcnt(0);
        unsigned nloc = b.st[0], nx = b.st[1];
        if (nloc == 0u) { xcd_barrier_complete(bar, b.x, nloc, nx); b.st[0] = nloc; b.st[1] = nx; }
        const unsigned old = xb_add(&bar[XB_XSUB(b.x)], 1u);
        const unsigned gen = old / nloc;
        if (old + 1u == (gen + 1u) * nloc) {
            __builtin_amdgcn_fence(__ATOMIC_RELEASE, "agent");
            asm volatile("s_waitcnt vmcnt(0)" ::: "memory");
            const unsigned og = xb_add(&bar[XB_TOP], 1u);
            const unsigned tg = og / nx;
            if (og + 1u == (tg + 1u) * nx) xb_add(&bar[XB_TOPGEN], 1u);
            else XB_SPIN(xb_ld(&bar[XB_TOPGEN]) == tg, bar);
            __builtin_amdgcn_fence(__ATOMIC_ACQUIRE, "agent");
            xb_add(&bar[XB_XGEN(b.x)], 1u);
            asm volatile("s_waitcnt vmcnt(0)" ::: "memory");
        } else {
            XB_SPIN(xb_ld(&bar[XB_XGEN(b.x)]) == gen, bar);
            __builtin_amdgcn_fence(__ATOMIC_ACQUIRE, "agent");
            asm volatile("s_waitcnt vmcnt(0)" ::: "memory");
        }
    }
    __syncthreads();
}


DI void run_phase(const DP& p, int ph, int dry) {
  if (ph == 0) { phase0(p); return; }
  int q = ph - 1, layer, lp;
  if (q < 10) { layer = 0; lp = q; } else if (q < 18) { layer = 1; lp = q - 10; } else if (q < 28) { layer = 2; lp = q - 18; } else { layer = 3; lp = q - 28; }
  const int j = layer >> 1;
  const bool even = (layer & 1) == 0;
  int op, gsel = 0;
  if (even) {
    op = (int)((0x2272654321ull >> (4 * lp)) & 15ull); gsel = (int)((0x3201000000ull >> (4 * lp)) & 15ull);
  } else {
    op = (int)((0x22729821ull >> (4 * lp)) & 15ull); gsel = (int)((0x32010000ull >> (4 * lp)) & 15ull);
  }
  if (op == 1) wconv_phase(p, layer);
  if (op == 1 || op == 7) {
    const bool first = op == 1;
    norm_phase(p, layer, (first ? p.norm_mix_g : p.norm_ff_g) + layer * 1024, first ? 0 : 3, first ? 1 : 4);
  } else if (op == 2) {
    int mode, lda, N, K, gch; size_t offA, offB;
    if (gsel == 0) { mode = even ? EPI_EVEN_IN : EPI_ODD_IN; offA = OFF_MIX; lda = 1024; offB = OFF_WIN; N = even ? 5168 : 2304; K = 1024; gch = 0; }
    else if (gsel == 1) { mode = EPI_RESID; offA = OFF_MIX; lda = even ? 2048 : 1024; offB = OFF_WOUT; N = 1024; K = even ? 2048 : 1024; gch = 2; }
    else if (gsel == 2) { mode = EPI_RELU2; offA = OFF_MIX; lda = 1024; offB = OFF_WFF1; N = 4096; K = 1024; gch = 0; }
    else { mode = EPI_RESID; offA = OFF_ACT; lda = 4096; offB = OFF_WFF2; N = 1024; K = 4096; gch = 5; }
    if (dry && mode == EPI_RESID) mode = 4;
    gemm_phase(p, mode, wsp<bfr>(p, offA), lda, wsp<bfr>(p, offB), N, K, layer, gch);
  } else if (op == 3) conv_dt_phase(p, j);
  else if (op == 4) s1f1_phase(p);
  else if (op == 5) s2f2_phase(p);
  else if (op == 6) s3_phase(p, j);
  else if (op == 8) qkprep_phase(p, j);
  else if (op == 9) attn_phase(p, j);
}

DI int probe_reps(int ph) {
#ifdef PROBE_MASK
  if (ph == 0) return (PROBE_MASK & 1) ? 2 : 1;
  int q = ph - 1, layer, lp;
  if (q < 10) { layer = 0; lp = q; } else if (q < 18) { layer = 1; lp = q - 10; } else if (q < 28) { layer = 2; lp = q - 18; } else { layer = 3; lp = q - 28; }
  const bool even = (layer & 1) == 0;
  int op, gsel;
  if (even) { op = (int)((0x2272654321ull >> (4 * lp)) & 15ull); gsel = (int)((0x3201000000ull >> (4 * lp)) & 15ull); }
  else { op = (int)((0x22729821ull >> (4 * lp)) & 15ull); gsel = (int)((0x32010000ull >> (4 * lp)) & 15ull); }
  if (op == 5) return 1;
  if (op == 2 && (gsel == 1 || gsel == 3)) return ((PROBE_MASK >> 10) & 1) ? 2 : 1;
  return ((PROBE_MASK >> op) & 1) ? 2 : 1;
#else
  return 1;
#endif
}

__shared__ uint4 xb_words;

__global__ void __launch_bounds__(256, 2) mega(Params p, int ph0, int ph1) {
  cg::grid_group grid = cg::this_grid();
  if (threadIdx.x == 0) xb_words = make_uint4(0u, 0u, 0u, 0u);
  __syncthreads();
  XcdBarrier xb = xcd_barrier_post((unsigned*)(p.ws + OFF_BAR), (volatile LAS unsigned*)&xb_words);
#pragma unroll 1
  for (int ph = ph0; ph < ph1; ++ph) {
    const int nrep = probe_reps(ph);
#pragma unroll 1
    for (int rep = 0; rep < nrep; ++rep) {
      DP q;
      (Params&)q = p;
      int t = threadIdx.x, bb = blockIdx.x;
      asm volatile("" : "+v"(t));
      asm volatile("" : "+s"(bb));
      int z0;
      asm volatile("s_mov_b32 %0, 0" : "=s"(z0));
      q.ws = p.ws + z0;
      q.out = p.out + z0;
      q.tidl = t; q.bidl = bb;
      run_phase(q, ph, rep + 1 < nrep);
    }
    if (ph + 1 < ph1) {
      if (ph == ph0) grid.sync();
      else xcd_barrier(xb);
    }
  }
}

extern "C" void kernel_launch(void* const* d_in, const int* in_sizes, int n_in, void* d_out, int out_size, void* d_ws,
                              size_t ws_size, hipStream_t stream) {
  static int grid_blocks = 0;
  if (!grid_blocks) {
    int dev = 0, cus = 0, per_cu = 0;
    hipGetDevice(&dev);
    hipDeviceGetAttribute(&cus, hipDeviceAttributeMultiprocessorCount, dev);
    hipOccupancyMaxActiveBlocksPerMultiprocessor(&per_cu, mega, 256, 0);
    if (per_cu > 2) per_cu = 2;
    if (per_cu < 1) per_cu = 1;
    grid_blocks = cus * per_cu;
  }
  Params p{};
  const float** pp = (const float**)&p;
  for (int i = 0; i < 26; ++i) pp[i] = (const float*)d_in[i];
  p.out = (float*)d_out;
  p.ws = (unsigned char*)d_ws;
  if (ws_size < WS_TOTAL) fprintf(stderr, "workspace too small: %zu < %zu\n", ws_size, (size_t)WS_TOTAL);
  hipMemsetAsync((unsigned char*)d_ws + OFF_BAR, 0, XCD_BAR_WORDS * 4, stream);
#if MULTI_LAUNCH
  for (int ph = 0; ph < NPHASE; ++ph) {
    int a = ph, b = ph + 1;
    void* args[] = {&p, &a, &b};
    hipLaunchCooperativeKernel((void*)mega, dim3(grid_blocks), dim3(256), args, 0, stream);
  }
#else
  int a = 0, b = NPHASE;
  void* args[] = {&p, &a, &b};
  hipError_t e = hipLaunchCooperativeKernel((void*)mega, dim3(grid_blocks), dim3(256), args, 0, stream);
  if (e != hipSuccess) fprintf(stderr, "cooperative launch failed: %s (grid %d)\n", hipGetErrorString(e), grid_blocks);
#endif
}
```

```cpp
#include <hip/hip_runtime.h>
#include <hip/hip_cooperative_groups.h>
#include <cstdio>
namespace cg = cooperative_groups;

typedef unsigned short bfr;
typedef __attribute__((ext_vector_type(8))) short bf16x8;
typedef __attribute__((ext_vector_type(4))) short bf16x4;
typedef __attribute__((ext_vector_type(16))) float f32x16;
#define DI __device__ __forceinline__
#define MFMA(a, b, c) __builtin_amdgcn_mfma_f32_32x32x16_bf16((a), (b), (c), 0, 0, 0)

#ifndef MULTI_LAUNCH
#define MULTI_LAUNCH 0
#endif

constexpr int RL = 16384, R = 16896, SEQ = 8192, CTX = 256;
constexpr int NCH = 33, CL = 256;
constexpr int NPHASE = 37;

constexpr size_t al(size_t x) { return (x + 255) & ~size_t(255); }
constexpr size_t OFF_HC = 0;
constexpr size_t OFF_MOD = OFF_HC + al(512 * 1024 * 4);
constexpr size_t OFF_TW = OFF_MOD + al(4 * 3 * 6144 * 4);
constexpr size_t OFF_C128 = OFF_TW + al(8192 * 8);
constexpr size_t OFF_S128 = OFF_C128 + al(128 * 128 * 2);
constexpr size_t OFF_C64 = OFF_S128 + al(128 * 128 * 2);
constexpr size_t OFF_S64 = OFF_C64 + al(64 * 64 * 2);
constexpr size_t OFF_C256 = OFF_S64 + al(64 * 64 * 2);
constexpr size_t OFF_S256 = OFF_C256 + al(256 * 256 * 2);
constexpr size_t OFF_ROPE = OFF_S256 + al(256 * 256 * 2);
constexpr size_t OFF_DTV = OFF_ROPE + al(2 * 2 * 128 * 16 * 4);
constexpr size_t DT_BYTES = (size_t)2 * 2 * NCH * 24 * 256 * 4;
constexpr size_t OFF_ACUM = OFF_DTV + al(DT_BYTES);
constexpr size_t OFF_WIN = OFF_ACUM + al(DT_BYTES);
constexpr size_t OFF_WOUT = OFF_WIN + al((size_t)5248 * 1024 * 2);
constexpr size_t OFF_WFF1 = OFF_WOUT + al((size_t)1024 * 2048 * 2);
constexpr size_t OFF_WFF2 = OFF_WFF1 + al((size_t)4096 * 1024 * 2);
constexpr size_t OFF_MIX = OFF_WFF2 + al((size_t)4096 * 1024 * 2);
constexpr size_t OFF_BIG = OFF_MIX + al((size_t)R * 2048 * 2);
constexpr size_t OFF_Z = OFF_BIG;
constexpr size_t OFF_ZRT = OFF_Z + (size_t)R * 1536 * 2;
constexpr size_t OFF_ZIT = OFF_ZRT + (size_t)512 * R * 2;
constexpr size_t OFF_XBC = OFF_ZIT + (size_t)512 * R * 2;
constexpr size_t OFF_DTRAW = OFF_XBC + (size_t)R * 2560 * 2;
constexpr size_t BIG_END = OFF_DTRAW + (size_t)R * 48 * 4;
constexpr size_t OFF_HS = OFF_XBC;
constexpr size_t HS_BYTES = (size_t)2 * 2 * NCH * 24 * 8192 * 2;
constexpr size_t OFF_YR = OFF_HS + HS_BYTES;
constexpr size_t OFF_YI = OFF_YR + (size_t)2 * 512 * 128 * 64 * 2;
static_assert(OFF_YI + (size_t)2 * 512 * 128 * 64 * 2 <= OFF_DTRAW, "fft scratch overflows");
constexpr size_t OFF_ACT = OFF_BIG;
static_assert((size_t)R * 4096 * 2 <= BIG_END - OFF_BIG, "act overflows");
constexpr size_t OFF_P = OFF_BIG;
constexpr size_t OFF_VT = OFF_P + (size_t)R * 2304 * 2;
constexpr size_t OFF_QK = OFF_VT + (size_t)640 * R * 2;
static_assert(OFF_QK + (size_t)R * 1664 * 2 <= BIG_END, "odd overflows");
constexpr size_t OFF_XT = al(BIG_END);
constexpr size_t OFF_BN = OFF_XT + (size_t)1536 * R * 2;
constexpr size_t OFF_BT = OFF_BN + (size_t)R * 512 * 2;
constexpr size_t OFF_CN = OFF_BT + (size_t)512 * R * 2;
constexpr size_t OFF_BAR = al(OFF_CN + (size_t)R * 512 * 2);
constexpr size_t WS_TOTAL = OFF_BAR + 16384;
static_assert(WS_TOTAL <= 402653184ull, "workspace too large");

struct Params {
  const float *x, *c, *ctx, *c_ctx, *w_mod, *b_mod, *norm_mix_g, *norm_ff_g, *w_ff1, *w_ff2;
  const float *w_in_even, *conv_w, *conv_b, *dt_bias, *a_log, *d_skip, *ssd_norm_g, *w_out_even;
  const float *w_in_odd, *q_norm_win, *k_norm_win, *sink_win, *q_norm_na, *k_norm_na, *rpb_na, *w_out_odd;
  float* out;
  unsigned char* ws;
};

struct DP : Params { int tidl, bidl; };

__shared__ __attribute__((aligned(16))) unsigned char smem[73728];

DI bfr f2bf(float x) { unsigned u = __float_as_uint(x); u += 0x7fffu + ((u >> 16) & 1u); return (bfr)(u >> 16); }
DI float bf2f(bfr b) { return __uint_as_float(((unsigned)b) << 16); }
DI float bfs(short s) { return __uint_as_float(((unsigned)(unsigned short)s) << 16); }
DI int crow(int i, int h) { return (i & 3) + 8 * (i >> 2) + 4 * h; }
DI f32x16 zero16() { f32x16 z; for (int i = 0; i < 16; ++i) z[i] = 0.f; return z; }
DI bf16x8 pack8(float a0, float a1, float a2, float a3, float a4, float a5, float a6, float a7) {
  bf16x8 v;
  v[0] = (short)f2bf(a0); v[1] = (short)f2bf(a1); v[2] = (short)f2bf(a2); v[3] = (short)f2bf(a3);
  v[4] = (short)f2bf(a4); v[5] = (short)f2bf(a5); v[6] = (short)f2bf(a6); v[7] = (short)f2bf(a7);
  return v;
}
DI bf16x4 pack4(float a0, float a1, float a2, float a3) {
  bf16x4 v; v[0] = (short)f2bf(a0); v[1] = (short)f2bf(a1); v[2] = (short)f2bf(a2); v[3] = (short)f2bf(a3); return v;
}
#define PACK_HALF(s, s2) pack8(s[8 * (s2)], s[8 * (s2) + 1], s[8 * (s2) + 2], s[8 * (s2) + 3], s[8 * (s2) + 4], s[8 * (s2) + 5], s[8 * (s2) + 6], s[8 * (s2) + 7])
DI bf16x8 join44(bf16x4 lo, bf16x4 hi) { return __builtin_shufflevector(lo, hi, 0, 1, 2, 3, 4, 5, 6, 7); }
DI int chunk_row0(int b, int c) { return c == 0 ? RL + b * CTX : b * SEQ + (c - 1) * CL; }

DI void sincos_turn(double f, float& s, float& c) {
  f -= rint(f);
  double x = f * 6.283185307179586476925;
  double x2 = x * x, ss = 1.0, cc = 1.0;
#pragma unroll
  for (int k = 13; k >= 1; --k) {
    ss = 1.0 - x2 / (double)((2 * k) * (2 * k + 1)) * ss;
    cc = 1.0 - x2 / (double)((2 * k - 1) * (2 * k)) * cc;
  }
  s = (float)(x * ss); c = (float)cc;
}

template <class T> DI T* wsp(const DP& p, size_t off) { return (T*)(p.ws + off); }

DI void phase0(const DP& p) {
  const int tid = p.tidl, bid = p.bidl, G = gridDim.x;
  float* lds = (float*)smem;
  float* MOD = wsp<float>(p, OFF_MOD);
  for (int u = bid; u < 384; u += G) {
    int layer = u / 96, cb = u % 96;
    for (int i = tid; i < 3072; i += 256) {
      int v = i >> 10, k = i & 1023;
      float c = v < 2 ? p.c[v * 1024 + k] : p.c_ctx[k];
      lds[i] = c / (1.f + expf(-c));
    }
    __syncthreads();
    int kq = tid >> 6, cc = tid & 63, col = cb * 64 + cc;
    const float* w = p.w_mod + (size_t)layer * 1024 * 6144 + col;
    float a0 = 0, a1 = 0, a2 = 0;
    for (int k = kq * 256; k < kq * 256 + 256; ++k) {
      float wv = w[(size_t)k * 6144];
      a0 += lds[k] * wv; a1 += lds[1024 + k] * wv; a2 += lds[2048 + k] * wv;
    }
    float* red = lds + 3072;
    red[(kq * 3 + 0) * 64 + cc] = a0; red[(kq * 3 + 1) * 64 + cc] = a1; red[(kq * 3 + 2) * 64 + cc] = a2;
    __syncthreads();
    if (tid < 192) {
      int v = tid >> 6;
      float s = red[(0 * 3 + v) * 64 + cc] + red[(1 * 3 + v) * 64 + cc] + red[(2 * 3 + v) * 64 + cc] + red[(3 * 3 + v) * 64 + cc];
      MOD[(layer * 3 + v) * 6144 + col] = s + p.b_mod[layer * 6144 + col];
    }
    __syncthreads();
  }
  const int gt = bid * 256 + tid, nt = G * 256;
  {
    const float4* xs = (const float4*)p.x; float4* od = (float4*)p.out;
    for (int i = gt; i < RL * 256; i += nt) od[i] = xs[i];
    const float4* cs = (const float4*)p.ctx; float4* hd = wsp<float4>(p, OFF_HC);
    for (int i = gt; i < 512 * 256; i += nt) hd[i] = cs[i];
  }
  float2* TW = wsp<float2>(p, OFF_TW);
  for (int i = gt; i < 8192; i += nt) { float s, c; sincos_turn((double)i / 8192.0, s, c); TW[i] = make_float2(c, s); }
  bfr* C128 = wsp<bfr>(p, OFF_C128); bfr* S128 = wsp<bfr>(p, OFF_S128);
  for (int i = gt; i < 128 * 128; i += nt) { int a = i >> 7, b = i & 127; float s, c; sincos_turn((double)((a * b) & 127) / 128.0, s, c); C128[i] = f2bf(c); S128[i] = f2bf(s); }
  bfr* C64 = wsp<bfr>(p, OFF_C64); bfr* S64 = wsp<bfr>(p, OFF_S64);
  for (int i = gt; i < 64 * 64; i += nt) { int a = i >> 6, b = i & 63; float s, c; sincos_turn((double)((a * b) & 63) / 64.0, s, c); C64[i] = f2bf(c); S64[i] = f2bf(s); }
  bfr* C256 = wsp<bfr>(p, OFF_C256); bfr* S256 = wsp<bfr>(p, OFF_S256);
  for (int i = gt; i < 256 * 256; i += nt) { int a = i >> 8, b = i & 255; float s, c; sincos_turn((double)((a * b) & 255) / 256.0, s, c); C256[i] = f2bf(c); S256[i] = f2bf(s); }
  float* ROPE = wsp<float>(p, OFF_ROPE);
  for (int i = gt; i < 2 * 128 * 16; i += nt) {
    int f = i & 15, idx = (i >> 4) & 127;
    float ang = (float)idx * (float)exp(-(double)f * 0.5756462732485115);
    float s, c; sincos_turn((double)ang / 6.283185307179586476925, s, c);
    ROPE[i] = c; ROPE[4096 + i] = s;
  }
}

DI void tcvt_unit(const float* __restrict__ src, int ld, int c0, int ncols, int K, bfr* __restrict__ dst, int dr0, int u, int tid) {
  const int ntk = K >> 6;
  const int tn = u / ntk, tk = u % ntk, k0 = tk * 64, nb = tn * 64;
  bfr* T = (bfr*)smem;
  float4 v[4];
  const int n4 = (tid & 15) * 4;
#pragma unroll
  for (int i = 0; i < 4; ++i) {
    const int kk = (tid >> 4) + 16 * i;
    v[i] = make_float4(0.f, 0.f, 0.f, 0.f);
    if (nb + n4 < ncols) v[i] = *(const float4*)(src + (size_t)(k0 + kk) * ld + c0 + nb + n4);
  }
#pragma unroll
  for (int i = 0; i < 4; ++i) {
    const int kk = (tid >> 4) + 16 * i;
    T[(n4 + 0) * 72 + kk] = f2bf(v[i].x); T[(n4 + 1) * 72 + kk] = f2bf(v[i].y);
    T[(n4 + 2) * 72 + kk] = f2bf(v[i].z); T[(n4 + 3) * 72 + kk] = f2bf(v[i].w);
  }
  __syncthreads();
  {
    int n = tid >> 2, kseg = (tid & 3) * 16;
    if (nb + n < ncols) {
      bfr* d = dst + (size_t)(dr0 + nb + n) * K + k0 + kseg;
      *(bf16x8*)d = *(const bf16x8*)(T + n * 72 + kseg);
      *(bf16x8*)(d + 8) = *(const bf16x8*)(T + n * 72 + kseg + 8);
    }
  }
  __syncthreads();
}

DI void wconv_phase(const DP& p, int layer) {
  const int tid = p.tidl;
  const int j = layer >> 1;
  bfr* WIN = wsp<bfr>(p, OFF_WIN); bfr* WOUT = wsp<bfr>(p, OFF_WOUT);
  bfr* WFF1 = wsp<bfr>(p, OFF_WFF1); bfr* WFF2 = wsp<bfr>(p, OFF_WFF2);
  const float* ff1 = p.w_ff1 + (size_t)layer * 1024 * 4096;
  const float* ff2 = p.w_ff2 + (size_t)layer * 4096 * 1024;
  float* cst = (float*)(smem + 20480);
  if (tid < 64) { float s, c; sincos_turn((double)tid / 64.0, s, c); cst[tid] = c; cst[64 + tid] = s; }
  __syncthreads();
  if ((layer & 1) == 0) {
    const float* win = p.w_in_even + (size_t)j * 1024 * 4656;
    const float* wout = p.w_out_even + (size_t)j * 2048 * 1024;
    const int n_in = 65 * 16, n_out = 16 * 32, n_f1 = 64 * 16, n_f2 = 16 * 64, n_fold = 128;
    const int total = n_in + n_out + n_f1 + n_f2 + n_fold;
    for (int u = p.bidl; u < total; u += gridDim.x) {
      int v = u;
      if (v < n_in) { tcvt_unit(win, 4656, 512, 4144, 1024, WIN, 1024, v, tid); continue; }
      v -= n_in;
      if (v < n_out) { tcvt_unit(wout, 1024, 0, 1024, 2048, WOUT, 0, v, tid); continue; }
      v -= n_out;
      if (v < n_f1) { tcvt_unit(ff1, 4096, 0, 4096, 1024, WFF1, 0, v, tid); continue; }
      v -= n_f1;
      if (v < n_f2) { tcvt_unit(ff2, 1024, 0, 1024, 4096, WFF2, 0, v, tid); continue; }
      v -= n_f2;
      {
        const int g = v >> 4, kb = v & 15;
        float* wt = (float*)smem;
#pragma unroll
        for (int i = 0; i < 4; ++i) {
          const int idx = tid + 256 * i, kk = idx >> 4, j4 = (idx & 15) * 4;
          const float4 wv = *(const float4*)(win + (size_t)(kb * 64 + kk) * 4656 + g * 64 + j4);
          wt[kk * 65 + j4] = wv.x; wt[kk * 65 + j4 + 1] = wv.y; wt[kk * 65 + j4 + 2] = wv.z; wt[kk * 65 + j4 + 3] = wv.w;
        }
        __syncthreads();
        const int kl = tid & 63, mg = tid >> 6;
#pragma unroll 1
        for (int mi = 0; mi < 16; ++mi) {
          const int m = mg * 16 + mi;
          float sc = 0.f, ss = 0.f;
#pragma unroll 8
          for (int jj = 0; jj < 64; ++jj) { const float w = wt[kl * 65 + jj]; const int idx = (m * jj) & 63; sc += w * cst[idx]; ss += w * cst[64 + idx]; }
          const int ch = g * 64 + m, k = kb * 64 + kl;
          WIN[(size_t)ch * 1024 + k] = f2bf(sc);
          WIN[(size_t)(512 + ch) * 1024 + k] = f2bf(-ss);
        }
        __syncthreads();
      }
    }
  } else {
    const float* win = p.w_in_odd + (size_t)j * 1024 * 2304;
    const float* wout = p.w_out_odd + (size_t)j * 1024 * 1024;
    const int n_in = 36 * 16, n_out = 16 * 16, n_f1 = 64 * 16, n_f2 = 16 * 64;
    const int total = n_in + n_out + n_f1 + n_f2;
    for (int u = p.bidl; u < total; u += gridDim.x) {
      int v = u;
      if (v < n_in) { tcvt_unit(win, 2304, 0, 2304, 1024, WIN, 0, v, tid); continue; }
      v -= n_in;
      if (v < n_out) { tcvt_unit(wout, 1024, 0, 1024, 1024, WOUT, 0, v, tid); continue; }
      v -= n_out;
      if (v < n_f1) { tcvt_unit(ff1, 4096, 0, 4096, 1024, WFF1, 0, v, tid); continue; }
      v -= n_f1;
      tcvt_unit(ff2, 1024, 0, 1024, 4096, WFF2, 0, v, tid);
    }
  }
}

DI void norm_phase(const DP& p, int layer, const float* __restrict__ gvec, int shc, int scc) {
  const int lane = p.tidl & 63;
  const int wg = p.bidl * 4 + (p.tidl >> 6), nw = gridDim.x * 4;
  const float* MOD = wsp<float>(p, OFF_MOD);
  const float* HC = wsp<float>(p, OFF_HC);
  bfr* U = wsp<bfr>(p, OFF_MIX);
  for (int row = wg; row < R; row += nw) {
    const float* hp = row < RL ? p.out + (size_t)row * 1024 : HC + (size_t)(row - RL) * 1024;
    const int ms = row < RL ? (row >> 13) : 2;
    const float* md = MOD + (layer * 3 + ms) * 6144;
    float4 v[4]; float ss = 0.f;
#pragma unroll
    for (int i = 0; i < 4; ++i) {
      v[i] = *(const float4*)(hp + i * 256 + lane * 4);
      ss += v[i].x * v[i].x + v[i].y * v[i].y + v[i].z * v[i].z + v[i].w * v[i].w;
    }
#pragma unroll
    for (int o = 32; o >= 1; o >>= 1) ss += __shfl_xor(ss, o);
    const float rs = rsqrtf(ss * (1.f / 1024.f) + 1e-6f);
#pragma unroll
    for (int i = 0; i < 4; ++i) {
      int col = i * 256 + lane * 4;
      float4 g = *(const float4*)(gvec + col);
      float4 sc = *(const float4*)(md + scc * 1024 + col);
      float4 sh = *(const float4*)(md + shc * 1024 + col);
      bf16x4 o = pack4(v[i].x * rs * g.x * (1.f + sc.x) + sh.x, v[i].y * rs * g.y * (1.f + sc.y) + sh.y,
                       v[i].z * rs * g.z * (1.f + sc.z) + sh.z, v[i].w * rs * g.w * (1.f + sc.w) + sh.w);
      *(bf16x4*)(U + (size_t)row * 1024 + col) = o;
    }
  }
}

enum { EPI_EVEN_IN = 0, EPI_ODD_IN = 1, EPI_RELU2 = 2, EPI_RESID = 3 };

DI void gemm_phase(const DP& p, int mode, const bfr* __restrict__ A, int lda, const bfr* __restrict__ Bt,
                   int N, int K, int layer, int gchunk) {
  const int tid = p.tidl, lane = tid & 63, wid = tid >> 6, r = lane & 31, h = lane >> 5;
  const int wm = wid >> 1, wn = wid & 1;
  const int nN = (N + 127) >> 7, nM = R / 128;
  const int tiles = nM * nN, G = (int)gridDim.x;
  int full = tiles, tail = 0, St = 1;
  if (mode == EPI_RESID) {
    full = (tiles / G) * G; tail = tiles - full;
    if (tail > 0) { int c = G / tail; int kmax = K >> 7; St = 1; while (St * 2 <= c && St * 2 <= 16 && St * 2 <= kmax) St *= 2; }
  }
  const int chunk = (full + 7) >> 3;
  const int units = chunk * 8 + tail * St;
  bfr* sm = (bfr*)smem;
  const int lrow = tid >> 3, lc = (tid & 7) * 8;
#pragma unroll 1
  for (int u = p.bidl; u < units; u += G) {
    int t, ks, Ks; bool atom;
    if (u < chunk * 8) {
      t = (u & 7) * chunk + (u >> 3);
      if (t >= full) continue;
      ks = 0; Ks = K; atom = false;
    } else { const int v = u - chunk * 8; t = full + v / St; ks = v % St; Ks = K / St; atom = St > 1; }
    const int nk = Ks >> 6;
    const int panel = t / (nM * 8); const int rem = t - panel * nM * 8;
    const int pw = (nN - panel * 8) < 8 ? (nN - panel * 8) : 8;
    const int tm = rem / pw, tn = panel * 8 + rem % pw;
    const int m0 = tm * 128, n0 = tn * 128, kbase = ks * Ks;
    f32x16 acc[2][2];
    acc[0][0] = zero16(); acc[0][1] = zero16(); acc[1][0] = zero16(); acc[1][1] = zero16();
    const bfr* Ag = A + (size_t)(m0 + lrow) * lda + kbase + lc;
    const bfr* Bg = Bt + (size_t)(n0 + lrow) * K + kbase + lc;
    bf16x8 ra[4], rb[4];
#pragma unroll
    for (int i = 0; i < 4; ++i) {
      ra[i] = *(const bf16x8*)(Ag + (size_t)(32 * i) * lda);
      rb[i] = *(const bf16x8*)(Bg + (size_t)(32 * i) * K);
    }
#pragma unroll
    for (int i = 0; i < 4; ++i) {
      *(bf16x8*)(sm + (lrow + 32 * i) * 72 + lc) = ra[i];
      *(bf16x8*)(sm + 9216 + (lrow + 32 * i) * 72 + lc) = rb[i];
    }
    if (nk > 1) {
#pragma unroll
      for (int i = 0; i < 4; ++i) {
        ra[i] = *(const bf16x8*)(Ag + (size_t)(32 * i) * lda + 64);
        rb[i] = *(const bf16x8*)(Bg + (size_t)(32 * i) * K + 64);
      }
    }
    __syncthreads();
#pragma unroll 1
    for (int kt = 0; kt < nk; ++kt) {
      if (kt + 1 < nk) {
        bfr* Ad = sm + ((kt + 1) & 1) * 18432;
#pragma unroll
        for (int i = 0; i < 4; ++i) {
          *(bf16x8*)(Ad + (lrow + 32 * i) * 72 + lc) = ra[i];
          *(bf16x8*)(Ad + 9216 + (lrow + 32 * i) * 72 + lc) = rb[i];
        }
      }
      if (kt + 2 < nk) {
#pragma unroll
        for (int i = 0; i < 4; ++i) {
          ra[i] = *(const bf16x8*)(Ag + (size_t)(32 * i) * lda + (kt + 2) * 64);
          rb[i] = *(const bf16x8*)(Bg + (size_t)(32 * i) * K + (kt + 2) * 64);
        }
      }
      const bfr* As = sm + (kt & 1) * 18432;
      const bfr* Bs = As + 9216;
      __builtin_amdgcn_s_setprio(1);
#pragma unroll
      for (int kk = 0; kk < 4; ++kk) {
        bf16x8 a0 = *(const bf16x8*)(As + (wm * 64 + r) * 72 + kk * 16 + h * 8);
        bf16x8 a1 = *(const bf16x8*)(As + (wm * 64 + 32 + r) * 72 + kk * 16 + h * 8);
        bf16x8 b0 = *(const bf16x8*)(Bs + (wn * 64 + r) * 72 + kk * 16 + h * 8);
        bf16x8 b1 = *(const bf16x8*)(Bs + (wn * 64 + 32 + r) * 72 + kk * 16 + h * 8);
        acc[0][0] = MFMA(a0, b0, acc[0][0]);
        acc[0][1] = MFMA(a0, b1, acc[0][1]);
        acc[1][0] = MFMA(a1, b0, acc[1][0]);
        acc[1][1] = MFMA(a1, b1, acc[1][1]);
      }
      __builtin_amdgcn_s_setprio(0);
      __syncthreads();
    }
#pragma unroll
    for (int mi = 0; mi < 2; ++mi)
#pragma unroll
      for (int ni = 0; ni < 2; ++ni)
#pragma unroll
        for (int g4 = 0; g4 < 4; ++g4) {
          const int row = m0 + wm * 64 + mi * 32 + 8 * g4 + 4 * h;
          const int col = n0 + wn * 64 + ni * 32 + r;
          const float v0 = acc[mi][ni][4 * g4], v1 = acc[mi][ni][4 * g4 + 1], v2 = acc[mi][ni][4 * g4 + 2], v3 = acc[mi][ni][4 * g4 + 3];
          if (mode == EPI_EVEN_IN) {
            if (col < 1024) {
              bfr* dst = wsp<bfr>(p, col < 512 ? OFF_ZRT : OFF_ZIT) + (size_t)(col & 511) * R + row;
              *(bf16x4*)dst = pack4(v0, v1, v2, v3);
            } else if (col < 2560) {
              bfr* dst = wsp<bfr>(p, OFF_Z) + (size_t)row * 1536 + (col - 1024);
              dst[0] = f2bf(v0); dst[1536] = f2bf(v1); dst[2 * 1536] = f2bf(v2); dst[3 * 1536] = f2bf(v3);
            } else if (col < 5120) {
              bfr* dst = wsp<bfr>(p, OFF_XBC) + (size_t)row * 2560 + (col - 2560);
              dst[0] = f2bf(v0); dst[2560] = f2bf(v1); dst[2 * 2560] = f2bf(v2); dst[3 * 2560] = f2bf(v3);
            } else if (col < 5168) {
              float* dst = wsp<float>(p, OFF_DTRAW) + (size_t)row * 48 + (col - 5120);
              dst[0] = v0; dst[48] = v1; dst[96] = v2; dst[144] = v3;
            }
          } else if (mode == EPI_ODD_IN) {
            if (col >= 640 && col < 768) {
              *(bf16x4*)(wsp<bfr>(p, OFF_VT) + (size_t)(col - 640) * R + row) = pack4(v0, v1, v2, v3);
            } else if (col >= 1792) {
              *(bf16x4*)(wsp<bfr>(p, OFF_VT) + (size_t)(128 + col - 1792) * R + row) = pack4(v0, v1, v2, v3);
            } else {
              bfr* dst = wsp<bfr>(p, OFF_P) + (size_t)row * 2304 + col;
              dst[0] = f2bf(v0); dst[2304] = f2bf(v1); dst[2 * 2304] = f2bf(v2); dst[3 * 2304] = f2bf(v3);
            }
          } else if (mode == EPI_RELU2) {
            bfr* dst = wsp<bfr>(p, OFF_ACT) + (size_t)row * 4096 + col;
            float t0 = fmaxf(v0, 0.f), t1 = fmaxf(v1, 0.f), t2 = fmaxf(v2, 0.f), t3 = fmaxf(v3, 0.f);
            dst[0] = f2bf(t0 * t0); dst[4096] = f2bf(t1 * t1); dst[2 * 4096] = f2bf(t2 * t2); dst[3 * 4096] = f2bf(t3 * t3);
          } else if (mode == EPI_RESID) {
            const int ms = row < RL ? (row >> 13) : 2;
            const float gate = wsp<float>(p, OFF_MOD)[(layer * 3 + ms) * 6144 + gchunk * 1024 + col];
            float* hp = row < RL ? p.out + (size_t)row * 1024 + col : wsp<float>(p, OFF_HC) + (size_t)(row - RL) * 1024 + col;
            if (atom) {
              unsafeAtomicAdd(hp, gate * v0); unsafeAtomicAdd(hp + 1024, gate * v1);
              unsafeAtomicAdd(hp + 2048, gate * v2); unsafeAtomicAdd(hp + 3072, gate * v3);
            } else {
              hp[0] += gate * v0; hp[1024] += gate * v1; hp[2048] += gate * v2; hp[3072] += gate * v3;
            }
          }
        }
  }
}

DI float softplus_f(float x) { return x > 0.f ? x + log1pf(expf(-x)) : log1pf(expf(x)); }

DI void conv_dt_phase(const DP& p, int j) {
  const int tid = p.tidl, lane = tid & 63, wid = tid >> 6;
  const bfr* XBC = wsp<bfr>(p, OFF_XBC);
  bfr* XT = wsp<bfr>(p, OFF_XT); bfr* BN = wsp<bfr>(p, OFF_BN); bfr* BTt = wsp<bfr>(p, OFF_BT); bfr* CN = wsp<bfr>(p, OFF_CN);
  bfr* TT = (bfr*)smem;
  const float* cw = p.conv_w + (size_t)j * 5 * 2560;
  const float* cb = p.conv_b + (size_t)j * 2560;
  const int n_conv = 264 * 40, n_dt = 792;
  for (int u = p.bidl; u < n_conv + n_dt; u += gridDim.x) {
    if (u < n_conv) {
      const int tb = u / 40, cbk = u % 40, row0 = tb * 64, ch0 = cbk * 64;
      int pos0, len;
      if (row0 < RL) { pos0 = row0 & 8191; len = SEQ; } else { pos0 = (row0 - RL) & 255; len = CTX; }
      const int c8 = tid & 7, ch = ch0 + c8 * 8;
      float w[5][8], bias[8];
#pragma unroll
      for (int k = 0; k < 5; ++k) {
        float4 wa = *(const float4*)(cw + k * 2560 + ch), wb = *(const float4*)(cw + k * 2560 + ch + 4);
        w[k][0] = wa.x; w[k][1] = wa.y; w[k][2] = wa.z; w[k][3] = wa.w; w[k][4] = wb.x; w[k][5] = wb.y; w[k][6] = wb.z; w[k][7] = wb.w;
      }
      {
        float4 wa = *(const float4*)(cb + ch), wb = *(const float4*)(cb + ch + 4);
        bias[0] = wa.x; bias[1] = wa.y; bias[2] = wa.z; bias[3] = wa.w; bias[4] = wb.x; bias[5] = wb.y; bias[6] = wb.z; bias[7] = wb.w;
      }
#pragma unroll
      for (int ps = 0; ps < 2; ++ps) {
        const int tl = (tid >> 3) + 32 * ps, pos = pos0 + tl, row = row0 + tl;
        float a[8];
#pragma unroll
        for (int e = 0; e < 8; ++e) a[e] = bias[e];
        bf16x8 xr[5];
#pragma unroll
        for (int k = 0; k < 5; ++k) {
          const int pp = pos + k - 2;
          const bool ok = pp >= 0 && pp < len;
          const bfr* xp = XBC + (size_t)(ok ? row + k - 2 : row) * 2560 + ch;
          xr[k] = *(const bf16x8*)xp;
          if (!ok) { for (int e = 0; e < 8; ++e) xr[k][e] = 0; }
        }
#pragma unroll
        for (int k = 0; k < 5; ++k)
#pragma unroll
          for (int e = 0; e < 8; ++e) a[e] += w[k][e] * bfs(xr[k][e]);
        bf16x8 o;
#pragma unroll
        for (int e = 0; e < 8; ++e) { float s = a[e] / (1.f + __expf(-a[e])); o[e] = (short)f2bf(s); }
        if (ch0 >= 2048) *(bf16x8*)(CN + (size_t)row * 512 + (ch - 2048)) = o;
        else if (ch0 >= 1536) *(bf16x8*)(BN + (size_t)row * 512 + (ch - 1536)) = o;
        if (ch0 < 2048) {
#pragma unroll
          for (int e = 0; e < 8; ++e) TT[(c8 * 8 + e) * 72 + tl] = (bfr)o[e];
        }
      }
      if (ch0 < 2048) {
        __syncthreads();
        const int chl = tid >> 2, tseg = (tid & 3) * 16;
        bfr* dst = (ch0 < 1536 ? XT + (size_t)(ch0 + chl) * R : BTt + (size_t)(ch0 - 1536 + chl) * R) + row0 + tseg;
        *(bf16x8*)dst = *(const bf16x8*)(TT + chl * 72 + tseg);
        *(bf16x8*)(dst + 8) = *(const bf16x8*)(TT + chl * 72 + tseg + 8);
        __syncthreads();
      }
    } else {
      const int item = (u - n_conv) * 4 + wid;
      const int head = item % 24; int rest = item / 24; const int dir = rest & 1; rest >>= 1; const int c = rest % NCH, b = rest / NCH;
      const int row0 = chunk_row0(b, c), col = dir * 24 + head;
      const float bias = p.dt_bias[j * 48 + col];
      const float a = -expf(p.a_log[j * 48 + col]);
      const float* DTRAW = wsp<float>(p, OFF_DTRAW);
      float dt[4], cs[4];
      float run = 0.f;
#pragma unroll
      for (int q = 0; q < 4; ++q) {
        dt[q] = softplus_f(DTRAW[(size_t)(row0 + lane * 4 + q) * 48 + col] + bias);
        run += dt[q] * a; cs[q] = run;
      }
      float x = run;
#pragma unroll
      for (int o = 1; o < 64; o <<= 1) { float t2 = __shfl_up(x, o); if (lane >= o) x += t2; }
      const float excl = x - run;
      const float total = __shfl(x, 63);
      float ac[4];
#pragma unroll
      for (int q = 0; q < 4; ++q) {
        float inc = excl + cs[q];
        ac[q] = dir == 0 ? inc : total - inc + dt[q] * a;
      }
      const size_t base = ((size_t)(((dir * 2 + b) * NCH + c) * 24 + head)) * 256 + lane * 4;
      *(float4*)(wsp<float>(p, OFF_DTV) + base) = make_float4(dt[0], dt[1], dt[2], dt[3]);
      *(float4*)(wsp<float>(p, OFF_ACUM) + base) = make_float4(ac[0], ac[1], ac[2], ac[3]);
    }
  }
}

DI bf16x8 scale8(bf16x8 a, const float* w) {
  return pack8(bfs(a[0]) * w[0], bfs(a[1]) * w[1], bfs(a[2]) * w[2], bfs(a[3]) * w[3],
               bfs(a[4]) * w[4], bfs(a[5]) * w[5], bfs(a[6]) * w[6], bfs(a[7]) * w[7]);
}

DI void s1_item(const DP& p, int item, int lane) {
  const int r = lane & 31, h = lane >> 5;
  const int head = item % 24; int rest = item / 24; const int dir = rest & 1; rest >>= 1; const int c = rest % NCH, b = rest / NCH;
  const int g = head / 6;
  const int row0 = chunk_row0(b, c);
  const size_t dbase = ((size_t)(((dir * 2 + b) * NCH + c) * 24 + head)) * 256;
  const float* dtv = wsp<float>(p, OFF_DTV) + dbase;
  const float* acm = wsp<float>(p, OFF_ACUM) + dbase;
  const float acend = dir == 0 ? acm[255] : acm[0];
  const bfr* XT = wsp<bfr>(p, OFF_XT); const bfr* BTt = wsp<bfr>(p, OFF_BT);
  bfr* HS = wsp<bfr>(p, OFF_HS) + ((size_t)(((dir * 2 + b) * NCH + c) * 24 + head)) * 8192;
#pragma unroll 1
  for (int pt = 0; pt < 2; ++pt) {
    f32x16 acc[4];
#pragma unroll
    for (int n = 0; n < 4; ++n) acc[n] = zero16();
#pragma unroll 4
    for (int kk = 0; kk < 16; ++kk) {
      const int s0 = kk * 16 + 8 * h;
      float4 d0 = *(const float4*)(dtv + s0), d1 = *(const float4*)(dtv + s0 + 4);
      float4 a0 = *(const float4*)(acm + s0), a1 = *(const float4*)(acm + s0 + 4);
      float w[8];
      w[0] = d0.x * __expf(acend - a0.x); w[1] = d0.y * __expf(acend - a0.y); w[2] = d0.z * __expf(acend - a0.z); w[3] = d0.w * __expf(acend - a0.w);
      w[4] = d1.x * __expf(acend - a1.x); w[5] = d1.y * __expf(acend - a1.y); w[6] = d1.z * __expf(acend - a1.z); w[7] = d1.w * __expf(acend - a1.w);
      bf16x8 af = scale8(*(const bf16x8*)(XT + (size_t)(head * 64 + pt * 32 + r) * R + row0 + s0), w);
#pragma unroll
      for (int nt = 0; nt < 4; ++nt) {
        bf16x8 bfv = *(const bf16x8*)(BTt + (size_t)(g * 128 + nt * 32 + r) * R + row0 + s0);
        acc[nt] = MFMA(af, bfv, acc[nt]);
      }
    }
#pragma unroll
    for (int nt = 0; nt < 4; ++nt)
#pragma unroll
      for (int i = 0; i < 16; ++i) HS[(pt * 32 + crow(i, h)) * 128 + nt * 32 + r] = f2bf(acc[nt][i]);
  }
}

DI void f1_item(const DP& p, int item, int lane) {
  const int r = lane & 31, h = lane >> 5;
  const int l2t = item & 1, m = (item >> 1) & 511, b = item >> 10;
  const bfr* ZRT = wsp<bfr>(p, OFF_ZRT) + (size_t)m * R + b * SEQ + l2t * 32 + r;
  const bfr* ZIT = wsp<bfr>(p, OFF_ZIT) + (size_t)m * R + b * SEQ + l2t * 32 + r;
  const bfr* C128 = wsp<bfr>(p, OFF_C128); const bfr* S128 = wsp<bfr>(p, OFF_S128);
  const float2* TW = wsp<float2>(p, OFF_TW);
  bfr* YR = wsp<bfr>(p, OFF_YR); bfr* YI = wsp<bfr>(p, OFF_YI);
  const int l2 = l2t * 32 + r;
#pragma unroll 1
  for (int mh = 0; mh < 2; ++mh) {
    f32x16 yr[2], yi[2];
#pragma unroll
    for (int i = 0; i < 2; ++i) { yr[i] = zero16(); yi[i] = zero16(); }
#pragma unroll 2
    for (int kk = 0; kk < 8; ++kk) {
      bf16x8 zr, zi, nzr;
#pragma unroll
      for (int jj = 0; jj < 8; ++jj) {
        int l1 = kk * 16 + 8 * h + jj;
        zr[jj] = (short)ZRT[l1 * 64]; zi[jj] = (short)ZIT[l1 * 64];
        nzr[jj] = (short)(zr[jj] ^ (short)0x8000);
      }
#pragma unroll
      for (int m2 = 0; m2 < 2; ++m2) {
        const int mt = mh * 2 + m2;
        bf16x8 ca = *(const bf16x8*)(C128 + (mt * 32 + r) * 128 + kk * 16 + 8 * h);
        bf16x8 sa = *(const bf16x8*)(S128 + (mt * 32 + r) * 128 + kk * 16 + 8 * h);
        yr[m2] = MFMA(ca, zr, yr[m2]); yr[m2] = MFMA(sa, zi, yr[m2]);
        yi[m2] = MFMA(ca, zi, yi[m2]); yi[m2] = MFMA(sa, nzr, yi[m2]);
      }
    }
#pragma unroll
    for (int m2 = 0; m2 < 2; ++m2)
#pragma unroll
      for (int i = 0; i < 16; ++i) {
        int k1 = (mh * 2 + m2) * 32 + crow(i, h);
        float2 t = TW[k1 * l2];
        float a = yr[m2][i], bb = yi[m2][i];
        size_t o = ((size_t)(b * 512 + m) * 128 + k1) * 64 + l2;
        YR[o] = f2bf(a * t.x + bb * t.y);
        YI[o] = f2bf(bb * t.x - a * t.y);
      }
  }
}

DI void f1c_item(const DP& p, int item, int lane) {
  const int r = lane & 31, h = lane >> 5;
  const int mt = item & 15, kt = (item >> 4) & 7, b = item >> 7;
  const int m = mt * 32 + r;
  const bfr* ZRT = wsp<bfr>(p, OFF_ZRT) + (size_t)m * R + RL + b * CTX;
  const bfr* ZIT = wsp<bfr>(p, OFF_ZIT) + (size_t)m * R + RL + b * CTX;
  const bfr* C256 = wsp<bfr>(p, OFF_C256) + (kt * 32 + r) * 256;
  const bfr* S256 = wsp<bfr>(p, OFF_S256) + (kt * 32 + r) * 256;
  f32x16 acc = zero16();
#pragma unroll 4
  for (int kk = 0; kk < 16; ++kk) {
    int o = kk * 16 + 8 * h;
    acc = MFMA(*(const bf16x8*)(C256 + o), *(const bf16x8*)(ZRT + o), acc);
    acc = MFMA(*(const bf16x8*)(S256 + o), *(const bf16x8*)(ZIT + o), acc);
  }
  bfr* MIX = wsp<bfr>(p, OFF_MIX);
#pragma unroll
  for (int i = 0; i < 16; ++i)
    MIX[(size_t)(RL + b * CTX + kt * 32 + crow(i, h)) * 2048 + m] = f2bf(acc[i] * (1.f / 128.f));
}

DI void s1f1_phase(const DP& p) {
  const int lane = p.tidl & 63;
  const int wg = p.bidl * 4 + (p.tidl >> 6), nw = gridDim.x * 4;
  const int n_s1 = 2 * NCH * 2 * 24, n_f1 = 2048, n_f1c = 256;
#pragma unroll 1
  for (int it = wg; it < n_s1 + n_f1 + n_f1c; it += nw) {
    if (it < n_s1) s1_item(p, it, lane);
    else if (it < n_s1 + n_f1) f1_item(p, it - n_s1, lane);
    else f1c_item(p, it - n_s1 - n_f1, lane);
  }
}

DI void f2_item(const DP& p, int item, int lane) {
  const int r = lane & 31, h = lane >> 5;
  const int mt16 = item & 15, k1 = (item >> 4) & 127, b = item >> 11;
  const int m = mt16 * 32 + r;
  const bfr* YR = wsp<bfr>(p, OFF_YR) + ((size_t)(b * 512 + m) * 128 + k1) * 64;
  const bfr* YI = wsp<bfr>(p, OFF_YI) + ((size_t)(b * 512 + m) * 128 + k1) * 64;
  const bfr* C64 = wsp<bfr>(p, OFF_C64); const bfr* S64 = wsp<bfr>(p, OFF_S64);
  f32x16 acc[2]; acc[0] = zero16(); acc[1] = zero16();
#pragma unroll
  for (int kk = 0; kk < 4; ++kk) {
    bf16x8 yr = *(const bf16x8*)(YR + kk * 16 + 8 * h), yi = *(const bf16x8*)(YI + kk * 16 + 8 * h);
#pragma unroll
    for (int t = 0; t < 2; ++t) {
      bf16x8 ca = *(const bf16x8*)(C64 + (t * 32 + r) * 64 + kk * 16 + 8 * h);
      bf16x8 sa = *(const bf16x8*)(S64 + (t * 32 + r) * 64 + kk * 16 + 8 * h);
      acc[t] = MFMA(ca, yr, acc[t]); acc[t] = MFMA(sa, yi, acc[t]);
    }
  }
  bfr* MIX = wsp<bfr>(p, OFF_MIX);
  const float scale = 0.001381067932f;
#pragma unroll
  for (int t = 0; t < 2; ++t)
#pragma unroll
    for (int i = 0; i < 16; ++i) {
      int k2 = t * 32 + crow(i, h);
      MIX[(size_t)(b * SEQ + k1 + 128 * k2) * 2048 + m] = f2bf(acc[t][i] * scale);
    }
}

DI void s2f2_phase(const DP& p) {
  const int gt = p.bidl * 256 + p.tidl, nt = gridDim.x * 256;
  bfr* HSb = wsp<bfr>(p, OFF_HS);
  const float* ACUM = wsp<float>(p, OFF_ACUM);
#pragma unroll 1
  for (int it = gt; it < 2 * 2 * 24 * 2048; it += nt) {
    const int e4 = it & 2047; const int rest = it >> 11; const int head = rest % 24, db = rest / 24, dir = db >> 1;
    bf16x4 sv[NCH]; float cd[NCH];
#pragma unroll
    for (int step = 0; step < NCH; ++step) {
      const int c = dir == 0 ? step : (step == 0 ? 0 : NCH - step);
      const size_t ci = (size_t)((db * NCH + c) * 24 + head);
      sv[step] = *(const bf16x4*)(HSb + ci * 8192 + e4 * 4);
      cd[step] = ACUM[ci * 256 + (dir == 0 ? 255 : 0)];
    }
    float h0 = 0.f, h1 = 0.f, h2 = 0.f, h3 = 0.f;
#pragma unroll
    for (int step = 0; step < NCH; ++step) {
      const int c = dir == 0 ? step : (step == 0 ? 0 : NCH - step);
      const size_t ci = (size_t)((db * NCH + c) * 24 + head);
      *(bf16x4*)(HSb + ci * 8192 + e4 * 4) = pack4(h0, h1, h2, h3);
      const float e = __expf(cd[step]);
      h0 = h0 * e + bfs(sv[step][0]); h1 = h1 * e + bfs(sv[step][1]); h2 = h2 * e + bfs(sv[step][2]); h3 = h3 * e + bfs(sv[step][3]);
    }
  }
  const int lane = p.tidl & 63;
  const int wg = p.bidl * 4 + (p.tidl >> 6), nw = gridDim.x * 4;
#pragma unroll 1
  for (int it = wg; it < 4096; it += nw) f2_item(p, it, lane);
}

DI void s3_phase(const DP& p, int j) {
  const int tid = p.tidl, lane = tid & 63, wid = tid >> 6, r = lane & 31, h = lane >> 5;
  const bfr* CN = wsp<bfr>(p, OFF_CN); const bfr* BN = wsp<bfr>(p, OFF_BN); const bfr* XT = wsp<bfr>(p, OFF_XT);
  const bfr* Z = wsp<bfr>(p, OFF_Z); bfr* MIX = wsp<bfr>(p, OFF_MIX);
  bfr* XTs = (bfr*)smem;
  bfr* HSF = (bfr*)(smem + 33792);
  bfr* HSB = (bfr*)(smem + 51200);
  float* LWF = (float*)(smem + 68608);
  float* LWB = LWF + 256;
#pragma unroll 1
  for (int item = p.bidl; item < 2 * NCH * 4 * 2; item += (int)gridDim.x) {
    const int half = item & 1, g = (item >> 1) & 3; const int bc = item >> 3; const int c = bc % NCH, b = bc / NCH;
    const int row0 = chunk_row0(b, c);
    const int lt = half * 4 + wid;
    const int rowl = row0 + lt * 32 + r;
    const bfr* cfp = CN + (size_t)rowl * 512 + g * 128 + 8 * h;
    bf16x8 gtp[8][2];
    {
      bf16x8 cf[8];
#pragma unroll
      for (int kk = 0; kk < 8; ++kk) cf[kk] = *(const bf16x8*)(cfp + kk * 16);
#pragma unroll
      for (int k = 0; k < 8; ++k) { gtp[k][0] = cf[0]; gtp[k][1] = cf[0]; }
#pragma unroll 1
      for (int st = 0; st < 8; ++st) {
        f32x16 gt = zero16();
#pragma unroll
        for (int kk = 0; kk < 8; ++kk)
          gt = MFMA(*(const bf16x8*)(BN + (size_t)(row0 + st * 32 + r) * 512 + g * 128 + kk * 16 + 8 * h), cf[kk], gt);
#pragma unroll
        for (int k = 0; k < 7; ++k) { gtp[k][0] = gtp[k + 1][0]; gtp[k][1] = gtp[k + 1][1]; }
        gtp[7][0] = PACK_HALF(gt, 0); gtp[7][1] = PACK_HALF(gt, 1);
      }
    }
    float sumsq = 0.f;
#pragma unroll 1
    for (int hh = 0; hh < 6; ++hh) {
      const int head = g * 6 + hh;
      const size_t cif = (size_t)(((0 * 2 + b) * NCH + c) * 24 + head), cib = (size_t)(((1 * 2 + b) * NCH + c) * 24 + head);
      const float* acf = wsp<float>(p, OFF_ACUM) + cif * 256; const float* acb = wsp<float>(p, OFF_ACUM) + cib * 256;
      const float* dtf = wsp<float>(p, OFF_DTV) + cif * 256; const float* dtb = wsp<float>(p, OFF_DTV) + cib * 256;
      const bfr* HSf = wsp<bfr>(p, OFF_HS) + cif * 8192; const bfr* HSbk = wsp<bfr>(p, OFF_HS) + cib * 8192;
      __syncthreads();
#pragma unroll 4
      for (int i = 0; i < 8; ++i) {
        const int idx = tid + 256 * i, row = idx >> 5, c16 = idx & 31;
        *(bf16x8*)(XTs + row * 264 + c16 * 8) = *(const bf16x8*)(XT + (size_t)(head * 64 + row) * R + row0 + c16 * 8);
      }
#pragma unroll 2
      for (int i = 0; i < 4; ++i) {
        const int idx = tid + 256 * i, row = idx >> 4, c16 = idx & 15;
        *(bf16x8*)(HSF + row * 136 + c16 * 8) = *(const bf16x8*)(HSf + row * 128 + c16 * 8);
        *(bf16x8*)(HSB + row * 136 + c16 * 8) = *(const bf16x8*)(HSbk + row * 128 + c16 * 8);
      }
      LWF[tid] = __logf(dtf[tid]) - acf[tid];
      LWB[tid] = __logf(dtb[tid]) - acb[tid];
      const float al_f = acf[lt * 32 + r], al_b = acb[lt * 32 + r];
      __syncthreads();
      f32x16 acc[2];
      {
        f32x16 t0 = zero16(), t1 = zero16();
#pragma unroll
        for (int kk = 0; kk < 8; ++kk) {
          const bf16x8 cfk = *(const bf16x8*)(cfp + kk * 16);
          t0 = MFMA(*(const bf16x8*)(HSF + (r) * 136 + kk * 16 + 8 * h), cfk, t0);
          t1 = MFMA(*(const bf16x8*)(HSF + (32 + r) * 136 + kk * 16 + 8 * h), cfk, t1);
        }
        const float ef = __expf(al_f);
#pragma unroll
        for (int i = 0; i < 16; ++i) { acc[0][i] = t0[i] * ef; acc[1][i] = t1[i] * ef; }
        t0 = zero16(); t1 = zero16();
#pragma unroll
        for (int kk = 0; kk < 8; ++kk) {
          const bf16x8 cfk = *(const bf16x8*)(cfp + kk * 16);
          t0 = MFMA(*(const bf16x8*)(HSB + (r) * 136 + kk * 16 + 8 * h), cfk, t0);
          t1 = MFMA(*(const bf16x8*)(HSB + (32 + r) * 136 + kk * 16 + 8 * h), cfk, t1);
        }
        const float eb = __expf(al_b);
#pragma unroll
        for (int i = 0; i < 16; ++i) { acc[0][i] += t0[i] * eb; acc[1][i] += t1[i] * eb; }
      }
#pragma unroll 1
      for (int st = 0; st < 8; ++st) {
        const bf16x8 g0 = gtp[0][0], g1 = gtp[0][1];
#pragma unroll
        for (int k = 0; k < 7; ++k) { gtp[k][0] = gtp[k + 1][0]; gtp[k][1] = gtp[k + 1][1]; }
        gtp[7][0] = g0; gtp[7][1] = g1;
#pragma unroll 1
        for (int dir = 0; dir < 2; ++dir) {
          if (dir == 0 ? (st > lt) : (st < lt)) continue;
          const float* lwd = dir == 0 ? LWF : LWB;
          const float al = dir == 0 ? al_f : al_b;
          f32x16 mm;
#pragma unroll
          for (int g4 = 0; g4 < 4; ++g4) {
            const int sb = st * 32 + 8 * g4 + 4 * h;
            const float4 l4 = *(const float4*)(lwd + sb);
            const float lv[4] = {l4.x, l4.y, l4.z, l4.w};
#pragma unroll
            for (int q = 0; q < 4; ++q) {
              const int i = 4 * g4 + q;
              const int sidx = sb + q, lidx = lt * 32 + r;
              const bool valid = dir == 0 ? (sidx <= lidx) : (sidx >= lidx);
              const float gv = bfs((i >> 3) ? g1[i & 7] : g0[i & 7]);
              const float e = __expf(fminf(al + lv[q], 30.f));
              mm[i] = valid ? gv * e : 0.f;
            }
          }
#pragma unroll
          for (int s2 = 0; s2 < 2; ++s2) {
            bf16x8 pf = PACK_HALF(mm, s2);
#pragma unroll
            for (int pt = 0; pt < 2; ++pt) {
              const bfr* xp = XTs + (pt * 32 + r) * 264 + st * 32 + 16 * s2 + 4 * h;
              bf16x8 xf = join44(*(const bf16x4*)xp, *(const bf16x4*)(xp + 8));
              acc[pt] = MFMA(xf, pf, acc[pt]);
            }
          }
        }
      }
      const float dsk = p.d_skip[j * 24 + head];
#pragma unroll
      for (int pt = 0; pt < 2; ++pt)
#pragma unroll
        for (int g4 = 0; g4 < 4; ++g4) {
          const int pb = pt * 32 + 8 * g4 + 4 * h;
          bf16x4 zv = *(const bf16x4*)(Z + (size_t)rowl * 1536 + head * 64 + pb);
          float y[4];
#pragma unroll
          for (int q = 0; q < 4; ++q) {
            float xv = bf2f(XTs[(pb + q) * 264 + lt * 32 + r]);
            float zz = bfs(zv[q]);
            float v = (acc[pt][4 * g4 + q] + dsk * xv) * (zz / (1.f + __expf(-zz)));
            sumsq += v * v; y[q] = v;
          }
          *(bf16x4*)(MIX + (size_t)rowl * 2048 + 512 + head * 64 + pb) = pack4(y[0], y[1], y[2], y[3]);
        }
    }
    const float tot = sumsq + __shfl_xor(sumsq, 32);
    const float sc = rsqrtf(tot * (1.f / 384.f) + 1e-6f);
    const float* ng = p.ssd_norm_g + (size_t)j * 1536;
#pragma unroll 1
    for (int hh = 0; hh < 6; ++hh) {
      const int head = g * 6 + hh;
#pragma unroll
      for (int pt = 0; pt < 2; ++pt)
#pragma unroll
        for (int g4 = 0; g4 < 4; ++g4) {
          const int pb = pt * 32 + 8 * g4 + 4 * h;
          bfr* mp = MIX + (size_t)rowl * 2048 + 512 + head * 64 + pb;
          bf16x4 yv = *(const bf16x4*)mp;
          float4 gg = *(const float4*)(ng + head * 64 + pb);
          *(bf16x4*)mp = pack4(bfs(yv[0]) * sc * gg.x, bfs(yv[1]) * sc * gg.y, bfs(yv[2]) * sc * gg.z, bfs(yv[3]) * sc * gg.w);
        }
    }
  }
}

DI void qkprep_phase(const DP& p, int j) {
  const int lane = p.tidl & 63;
  const int wg = p.bidl * 4 + (p.tidl >> 6), nw = gridDim.x * 4;
  const bfr* P = wsp<bfr>(p, OFF_P); bfr* QK = wsp<bfr>(p, OFF_QK);
  const float* ROPE = wsp<float>(p, OFF_ROPE);
  const int sub = lane >> 3, d0 = (lane & 7) * 8;
  for (int row = wg; row < R; row += nw) {
#pragma unroll
    for (int ps = 0; ps < 4; ++ps) {
      const int hs = ps * 8 + sub;
      const bool act = hs < 26;
      const int hsc = act ? hs : 25;
      const int col = hsc < 10 ? hsc * 64 : 768 + (hsc - 10) * 64;
      bf16x8 xv = *(const bf16x8*)(P + (size_t)row * 2304 + col + d0);
      float x[8]; float ss = 0.f;
#pragma unroll
      for (int e = 0; e < 8; ++e) { x[e] = bfs(xv[e]); ss += x[e] * x[e]; }
      ss += __shfl_xor(ss, 1); ss += __shfl_xor(ss, 2); ss += __shfl_xor(ss, 4);
      const float rs = rsqrtf(ss * (1.f / 64.f) + 1e-6f);
      const float* gv = hsc < 8 ? p.q_norm_win + j * 64 : hsc < 10 ? p.k_norm_win + j * 64 : hsc < 18 ? p.q_norm_na + j * 64 : p.k_norm_na + j * 64;
#pragma unroll
      for (int e = 0; e < 8; ++e) x[e] = x[e] * rs * gv[d0 + e];
      float pr[8];
#pragma unroll
      for (int e = 0; e < 8; ++e) pr[e] = __shfl_xor(x[e], 2);
      if (hsc < 10 && row < RL) {
        const int pos = row & 8191;
        const int axis = d0 >> 5;
        const int idx = axis == 0 ? (pos >> 6) : (pos & 63);
        const int f0 = d0 & 15;
        const bool second = (d0 & 16) != 0;
        const float* cp = ROPE + (axis * 128 + idx) * 16 + f0;
        const float* sp = cp + 4096;
#pragma unroll
        for (int e = 0; e < 8; ++e) {
          float cs = cp[e], sn = sp[e];
          x[e] = second ? (x[e] * cs + pr[e] * sn) : (x[e] * cs - pr[e] * sn);
        }
      }
      const bool isq = hsc < 8 || (hsc >= 10 && hsc < 18);
      const float qs = isq ? 0.125f : 1.f;
      if (act) *(bf16x8*)(QK + (size_t)row * 1664 + hsc * 64 + d0) = pack8(x[0] * qs, x[1] * qs, x[2] * qs, x[3] * qs, x[4] * qs, x[5] * qs, x[6] * qs, x[7] * qs);
    }
  }
}

struct KVF { bf16x8 k[4]; bf16x8 v[2][2]; };
struct KVS { bf16x8 k[4]; bf16x8 v[4]; };

DI void kv_gload(KVS& g, const bfr* __restrict__ Kt, const bfr* __restrict__ Vt, int lane) {
#pragma unroll
  for (int i = 0; i < 4; ++i) {
    const int idx = lane + 64 * i;
    g.k[i] = *(const bf16x8*)(Kt + (size_t)(idx >> 3) * 1664 + (idx & 7) * 8);
    g.v[i] = *(const bf16x8*)(Vt + (size_t)(idx >> 2) * R + (idx & 3) * 8);
  }
}
DI void kv_sstore(const KVS& g, unsigned char* base, int lane) {
#pragma unroll
  for (int i = 0; i < 4; ++i) {
    const int idx = lane + 64 * i;
    { const int row = idx >> 3, c = idx & 7; *(bf16x8*)(base + row * 128 + ((c ^ (row & 7)) << 4)) = g.k[i]; }
    {
      const int d = idx >> 2, c16 = idx & 3, sw = (d >> 2) & 7;
      bf16x4 lo = __builtin_shufflevector(g.v[i], g.v[i], 0, 1, 2, 3), hi = __builtin_shufflevector(g.v[i], g.v[i], 4, 5, 6, 7);
      *(bf16x4*)(base + 4096 + d * 64 + (((2 * c16) ^ sw) << 3)) = lo;
      *(bf16x4*)(base + 4096 + d * 64 + (((2 * c16 + 1) ^ sw) << 3)) = hi;
    }
  }
}
DI void kv_sload(KVF& f, const unsigned char* base, int r, int h) {
#pragma unroll
  for (int kk = 0; kk < 4; ++kk) f.k[kk] = *(const bf16x8*)(base + r * 128 + (((2 * kk + h) ^ (r & 7)) << 4));
#pragma unroll
  for (int s2 = 0; s2 < 2; ++s2)
#pragma unroll
    for (int dt = 0; dt < 2; ++dt) {
      const int d = dt * 32 + r, sw = (d >> 2) & 7, c8 = 4 * s2 + h;
      const unsigned char* vb = base + 4096 + d * 64;
      f.v[s2][dt] = join44(*(const bf16x4*)(vb + ((c8 ^ sw) << 3)), *(const bf16x4*)(vb + (((c8 + 2) ^ sw) << 3)));
    }
}

DI void attn_compute(f32x16 (&o)[2], float& m, float& l, const unsigned char* qb, const unsigned char* base, int r, int h,
                     int mode, int a0, int a1, const float* __restrict__ rp) {
  f32x16 s = zero16();
#pragma unroll
  for (int kk = 0; kk < 4; ++kk) {
    const int off = r * 128 + (((2 * kk + h) ^ (r & 7)) << 4);
    s = MFMA(*(const bf16x8*)(base + off), *(const bf16x8*)(qb + off), s);
  }
  float tmax = -3.0e38f;
  if (mode == 1) {
#pragma unroll
    for (int i = 0; i < 16; ++i) { int dd = a0 - crow(i, h); dd = dd < 0 ? -dd : dd; s[i] = dd <= 128 ? s[i] : -1.0e30f; }
  } else if (mode == 2) {
#pragma unroll
    for (int i = 0; i < 16; ++i) {
      const int key = crow(i, h);
      const int rel = a0 + key;
      int co = a1 + key; co = co < 0 ? 0 : (co > 30 ? 30 : co);
      s[i] = (rel >= 0 && rel < 16) ? s[i] + rp[co] : -1.0e30f;
    }
  }
#pragma unroll
  for (int i = 0; i < 16; ++i) tmax = fmaxf(tmax, s[i]);
  tmax = fmaxf(tmax, __shfl_xor(tmax, 32));
  const float mn = fmaxf(m, tmax);
  const float alpha = __expf(m - mn);
  float ps = 0.f;
#pragma unroll
  for (int i = 0; i < 16; ++i) { s[i] = __expf(s[i] - mn); ps += s[i]; }
  l = l * alpha + ps; m = mn;
#pragma unroll
  for (int i = 0; i < 16; ++i) { o[0][i] *= alpha; o[1][i] *= alpha; }
#pragma unroll
  for (int s2 = 0; s2 < 2; ++s2) {
    bf16x8 pf = PACK_HALF(s, s2);
#pragma unroll
    for (int dt = 0; dt < 2; ++dt) {
      const int d = dt * 32 + r, sw = (d >> 2) & 7, c8 = 4 * s2 + h;
      const unsigned char* vb = base + 4096 + d * 64;
      bf16x8 vf = join44(*(const bf16x4*)(vb + ((c8 ^ sw) << 3)), *(const bf16x4*)(vb + (((c8 + 2) ^ sw) << 3)));
      o[dt] = MFMA(vf, pf, o[dt]);
    }
  }
}

DI void attn_item(const DP& p, int j, int item, int lane) {
  const int r = lane & 31, h = lane >> 5;
  const bfr* QK = wsp<bfr>(p, OFF_QK); const bfr* VT = wsp<bfr>(p, OFF_VT); bfr* MIX = wsp<bfr>(p, OFF_MIX);
  int kind, b, hd, qt;
  if (item < 4096) { kind = 0; qt = item & 255; hd = (item >> 8) & 7; b = item >> 11; }
  else if (item < 8192) { int v = item - 4096; kind = 1; qt = v & 255; hd = (v >> 8) & 7; b = v >> 11; }
  else if (item < 8320) { int v = item - 8192; kind = 2; qt = v & 7; hd = (v >> 3) & 7; b = v >> 6; }
  else { int v = item - 8320; kind = 3; qt = v & 7; hd = (v >> 3) & 7; b = v >> 6; }
  const bool win = (kind == 0 || kind == 2);
  const bool lat = kind < 2;
  const int q_row0 = lat ? b * SEQ + qt * 32 : RL + b * CTX + qt * 32;
  const int qcol = win ? hd * 64 : (10 + hd) * 64;
  const int kcol = win ? (8 + (hd >> 2)) * 64 : (18 + hd) * 64;
  const bfr* Vb = win ? VT + (size_t)((hd >> 2) * 64) * R : VT + (size_t)(128 + hd * 64) * R;
  const bfr* Kb = QK + kcol;
  f32x16 o[2]; o[0] = zero16(); o[1] = zero16();
  float m = -1.0e30f, l = 0.f;
  if (win) { m = p.sink_win[j * 8 + hd]; l = h == 0 ? 1.f : 0.f; }
  int nloc = 0, lo = 0, gr = 0, kr0 = 0, w = 0, cs = 0;
  const int qpos = qt * 32 + r;
  if (kind == 0) { lo = qt - 4 < 0 ? 0 : qt - 4; const int hi = qt + 4 > 255 ? 255 : qt + 4; nloc = hi - lo + 1; }
  else if (kind == 1) {
    gr = qt >> 1; w = (qt & 1) * 32 + r;
    cs = w - 8; cs = cs < 0 ? 0 : (cs > 48 ? 48 : cs);
    kr0 = gr - 4; kr0 = kr0 < 0 ? 0 : (kr0 > 120 ? 120 : kr0);
    nloc = 16;
  }
  const int ntile = 8 + nloc;
  const float* rpb = p.rpb_na + (size_t)j * 8 * 15 * 31 + hd * 15 * 31;
  auto tile_row = [&](int i) -> int {
    if (i < 8) return RL + b * CTX + i * 32;
    const int li = i - 8;
    if (kind == 0) return b * SEQ + (lo + li) * 32;
    return b * SEQ + (kr0 + (li >> 1)) * 64 + (li & 1) * 32;
  };
  unsigned char* lbase = smem + (p.tidl >> 6) * 12288;
  asm volatile("" ::: "memory");
#pragma unroll
  for (int i = 0; i < 4; ++i) {
    const int idx = lane + 64 * i, row = idx >> 3, c = idx & 7;
    *(bf16x8*)(lbase + 8192 + row * 128 + ((c ^ (row & 7)) << 4)) = *(const bf16x8*)(QK + (size_t)(q_row0 + row) * 1664 + qcol + c * 8);
  }
  KVS g;
  { const int k0 = tile_row(0); kv_gload(g, Kb + (size_t)k0 * 1664, Vb + k0, lane); }
  kv_sstore(g, lbase, lane);
#pragma unroll 1
  for (int i = 0; i < ntile; ++i) {
    { const int in = i + 1 < ntile ? i + 1 : i; const int k0 = tile_row(in); kv_gload(g, Kb + (size_t)k0 * 1664, Vb + k0, lane); }
    int mode = 0, a0 = 0, a1 = 0; const float* rp = rpb;
    if (i >= 8) {
      const int li = i - 8;
      if (kind == 0) { mode = 1; a0 = qpos - (lo + li) * 32; }
      else { mode = 2; const int krow = kr0 + (li >> 1); const int ub = (li & 1) * 32; a0 = ub - cs; a1 = ub - w + 15; rp = rpb + (krow - gr + 7) * 31; }
    }
    asm volatile("" ::: "memory");
    attn_compute(o, m, l, lbase + 8192, lbase, r, h, mode, a0, a1, rp);
    asm volatile("" ::: "memory");
    kv_sstore(g, lbase, lane);
  }
  asm volatile("" ::: "memory");
  const float lt = l + __shfl_xor(l, 32);
  const float inv = 1.f / lt;
  const int ocol = win ? hd * 64 : 512 + hd * 64;
#pragma unroll
  for (int dt = 0; dt < 2; ++dt)
#pragma unroll
    for (int g4 = 0; g4 < 4; ++g4) {
      const int d = dt * 32 + 8 * g4 + 4 * h;
      *(bf16x4*)(MIX + (size_t)(q_row0 + r) * 1024 + ocol + d) =
          pack4(o[dt][4 * g4] * inv, o[dt][4 * g4 + 1] * inv, o[dt][4 * g4 + 2] * inv, o[dt][4 * g4 + 3] * inv);
    }
}

DI void attn_phase(const DP& p, int j) {
  const int lane = p.tidl & 63;
  const int wg = p.bidl * 4 + (p.tidl >> 6), nw = gridDim.x * 4;
#pragma unroll 1
  for (int it = wg; it < 8448; it += nw) attn_item(p, j, it, lane);
}

#define XB_TMO      128
#define XB_XCNT(j)  (256  + 64 * (j))
#define XB_XSUB(j)  (1280 + 64 * (j))
#define XB_XGEN(j)  (2304 + 64 * (j))
#define XB_TOP      3328
#define XB_TOPGEN   3392
#define XCD_BAR_WORDS 3456
#define XB_SPIN_CAP (1u << 18)
#define LAS __attribute__((address_space(3)))

__device__ __forceinline__ unsigned xb_ld(unsigned* p)              { return __hip_atomic_load(p, __ATOMIC_RELAXED, __HIP_MEMORY_SCOPE_AGENT); }
__device__ __forceinline__ unsigned xb_add(unsigned* p, unsigned v) { return __hip_atomic_fetch_add(p, v, __ATOMIC_RELAXED, __HIP_MEMORY_SCOPE_AGENT); }
__device__ __forceinline__ unsigned xb_xcc_id() { return (unsigned)__builtin_amdgcn_s_getreg((3 << 11) | 20) & 0xFu; }
#define XB_SPIN(cond, bar) do { unsigned _sp = 0; while (cond) { __builtin_amdgcn_s_sleep(1); \
    if ((++_sp & 255u) == 0u) { if (xb_ld(&(bar)[XB_TMO])) break; if (_sp > XB_SPIN_CAP) { atomicAdd(&(bar)[XB_TMO], 1u); break; } } } } while (0)

struct XcdBarrier {
    unsigned* bar; unsigned x;
    volatile LAS unsigned* st;
};

__device__ __forceinline__ XcdBarrier xcd_barrier_post(unsigned* bar, volatile LAS unsigned* st) {
    XcdBarrier b; b.bar = bar; b.x = xb_xcc_id(); b.st = st;
    if (threadIdx.x == 0) (void)xb_add(&bar[XB_XCNT(b.x)], 1u);
    return b;
}
__device__ __forceinline__ void xcd_barrier_complete(unsigned* bar, unsigned x, unsigned& nloc, unsigned& nx) {
    const unsigned G = gridDim.x * gridDim.y * gridDim.z;
    unsigned sum, cnt, mine, sp = 0u;
    for (;;) {
        sum = 0u; cnt = 0u; mine = 0u;
#pragma unroll
        for (unsigned j = 0; j < 16; ++j) { const unsigned c = xb_ld(&bar[XB_XCNT(j)]); sum += c; cnt += (c > 0u) ? 1u : 0u; mine = (j == x) ? c : mine; }
        if (sum == G) break;
        __builtin_amdgcn_s_sleep(1);
        if ((++sp & 255u) == 0u) { if (xb_ld(&bar[XB_TMO])) break; if (sp > XB_SPIN_CAP) { atomicAdd(&bar[XB_TMO], 1u); break; } }
    }
    nloc = mine > 0u ? mine : 1u; nx = cnt > 0u ? cnt : 1u;
}

__device__ __forceinline__ void xcd_barrier(const XcdBarrier& b) {
    asm volatile("s_waitcnt vmcnt(0)" ::: "memory");
    __syncthreads();
    if (threadIdx.x == 0) {
        unsigned* bar = b.bar;
        __builtin_amdgcn_s_waitcnt(0);
        unsigned nloc = b.st[0], nx = b.st[1];
        if (nloc == 0u) { xcd_barrier_complete(bar, b.x, nloc, nx); b.st[0] = nloc; b.st[1] = nx; }
        const unsigned old = xb_add(&bar[XB_XSUB(b.x)], 1u);
        const unsigned gen = old / nloc;
        if (old + 1u == (gen + 1u) * nloc) {
            __builtin_amdgcn_fence(__ATOMIC_RELEASE, "agent");
            asm volatile("s_waitcnt vmcnt(0)" ::: "memory");
            const unsigned og = xb_add(&bar[XB_TOP], 1u);
            const unsigned tg = og / nx;
            if (og + 1u == (tg + 1u) * nx) xb_add(&bar[XB_TOPGEN], 1u);
            else XB_SPIN(xb_ld(&bar[XB_TOPGEN]) == tg, bar);
            __builtin_amdgcn_fence(__ATOMIC_ACQUIRE, "agent");
            xb_add(&bar[XB_XGEN(b.x)], 1u);
            asm volatile("s_waitcnt vmcnt(0)" ::: "memory");
        } else {
            XB_SPIN(xb_ld(&bar[XB_XGEN(b.x)]) == gen, bar);
            __builtin_amdgcn_fence(__ATOMIC_ACQUIRE, "agent");
            asm volatile("s_waitcnt vmcnt(0)" ::: "memory");
        }
    }
    __syncthreads();
}


DI void run_phase(const DP& p, int ph, int dry) {
  if (ph == 0) { phase0(p); wconv_phase(p, 0); return; }
  int q = ph - 1, layer, lp;
  if (q < 10) { layer = 0; lp = q; } else if (q < 18) { layer = 1; lp = q - 10; } else if (q < 28) { layer = 2; lp = q - 18; } else { layer = 3; lp = q - 28; }
  const int j = layer >> 1;
  const bool even = (layer & 1) == 0;
  int op, gsel = 0;
  if (even) {
    op = (int)((0x2272654321ull >> (4 * lp)) & 15ull); gsel = (int)((0x3201000000ull >> (4 * lp)) & 15ull);
  } else {
    op = (int)((0x22729821ull >> (4 * lp)) & 15ull); gsel = (int)((0x32010000ull >> (4 * lp)) & 15ull);
  }
  if (op == 1 && layer != 0) wconv_phase(p, layer);
  if (op == 1 || op == 7) {
    const bool first = op == 1;
    norm_phase(p, layer, (first ? p.norm_mix_g : p.norm_ff_g) + layer * 1024, first ? 0 : 3, first ? 1 : 4);
  } else if (op == 2) {
    int mode, lda, N, K, gch; size_t offA, offB;
    if (gsel == 0) { mode = even ? EPI_EVEN_IN : EPI_ODD_IN; offA = OFF_MIX; lda = 1024; offB = OFF_WIN; N = even ? 5168 : 2304; K = 1024; gch = 0; }
    else if (gsel == 1) { mode = EPI_RESID; offA = OFF_MIX; lda = even ? 2048 : 1024; offB = OFF_WOUT; N = 1024; K = even ? 2048 : 1024; gch = 2; }
    else if (gsel == 2) { mode = EPI_RELU2; offA = OFF_MIX; lda = 1024; offB = OFF_WFF1; N = 4096; K = 1024; gch = 0; }
    else { mode = EPI_RESID; offA = OFF_ACT; lda = 4096; offB = OFF_WFF2; N = 1024; K = 4096; gch = 5; }
    if (dry && mode == EPI_RESID) mode = 4;
    gemm_phase(p, mode, wsp<bfr>(p, offA), lda, wsp<bfr>(p, offB), N, K, layer, gch);
  } else if (op == 3) conv_dt_phase(p, j);
  else if (op == 4) s1f1_phase(p);
  else if (op == 5) s2f2_phase(p);
  else if (op == 6) s3_phase(p, j);
  else if (op == 8) qkprep_phase(p, j);
  else if (op == 9) attn_phase(p, j);
}

DI int probe_reps(int ph) {
#ifdef PROBE_MASK
  if (ph == 0) return (PROBE_MASK & 1) ? 2 : 1;
  int q = ph - 1, layer, lp;
  if (q < 10) { layer = 0; lp = q; } else if (q < 18) { layer = 1; lp = q - 10; } else if (q < 28) { layer = 2; lp = q - 18; } else { layer = 3; lp = q - 28; }
  const bool even = (layer & 1) == 0;
  int op, gsel;
  if (even) { op = (int)((0x2272654321ull >> (4 * lp)) & 15ull); gsel = (int)((0x3201000000ull >> (4 * lp)) & 15ull); }
  else { op = (int)((0x22729821ull >> (4 * lp)) & 15ull); gsel = (int)((0x32010000ull >> (4 * lp)) & 15ull); }
  if (op == 5) return 1;
  if (op == 2 && (gsel == 1 || gsel == 3)) return ((PROBE_MASK >> 10) & 1) ? 2 : 1;
  return ((PROBE_MASK >> op) & 1) ? 2 : 1;
#else
  return 1;
#endif
}

__shared__ uint4 xb_words;

__global__ void __launch_bounds__(256, 2) mega(Params p, int ph0, int ph1) {
  cg::grid_group grid = cg::this_grid();
  if (threadIdx.x == 0) xb_words = make_uint4(0u, 0u, 0u, 0u);
  __syncthreads();
  XcdBarrier xb = xcd_barrier_post((unsigned*)(p.ws + OFF_BAR), (volatile LAS unsigned*)&xb_words);
#pragma unroll 1
  for (int ph = ph0; ph < ph1; ++ph) {
    const int nrep = probe_reps(ph);
#pragma unroll 1
    for (int rep = 0; rep < nrep; ++rep) {
      DP q;
      (Params&)q = p;
      int t = threadIdx.x, bb = blockIdx.x;
      asm volatile("" : "+v"(t));
      asm volatile("" : "+s"(bb));
      int z0;
      asm volatile("s_mov_b32 %0, 0" : "=s"(z0));
      q.ws = p.ws + z0;
      q.out = p.out + z0;
      q.tidl = t; q.bidl = bb;
      run_phase(q, ph, rep + 1 < nrep);
    }
    if (ph + 1 < ph1) {
      if (ph == ph0) grid.sync();
      else xcd_barrier(xb);
    }
  }
}

extern "C" void kernel_launch(void* const* d_in, const int* in_sizes, int n_in, void* d_out, int out_size, void* d_ws,
                              size_t ws_size, hipStream_t stream) {
  static int grid_blocks = 0;
  if (!grid_blocks) {
    int dev = 0, cus = 0, per_cu = 0;
    hipGetDevice(&dev);
    hipDeviceGetAttribute(&cus, hipDeviceAttributeMultiprocessorCount, dev);
    hipOccupancyMaxActiveBlocksPerMultiprocessor(&per_cu, mega, 256, 0);
    if (per_cu > 2) per_cu = 2;
    if (per_cu < 1) per_cu = 1;
    grid_blocks = cus * per_cu;
  }
  Params p{};
  const float** pp = (const float**)&p;
  for (int i = 0; i < 26; ++i) pp[i] = (const float*)d_in[i];
  p.out = (float*)d_out;
  p.ws = (unsigned char*)d_ws;
  if (ws_size < WS_TOTAL) fprintf(stderr, "workspace too small: %zu < %zu\n", ws_size, (size_t)WS_TOTAL);
  hipMemsetAsync((unsigned char*)d_ws + OFF_BAR, 0, XCD_BAR_WORDS * 4, stream);
#if MULTI_LAUNCH
  for (int ph = 0; ph < NPHASE; ++ph) {
    int a = ph, b = ph + 1;
    void* args[] = {&p, &a, &b};
    hipLaunchCooperativeKernel((void*)mega, dim3(grid_blocks), dim3(256), args, 0, stream);
  }
#else
  int a = 0, b = NPHASE;
  void* args[] = {&p, &a, &b};
  hipError_t e = hipLaunchCooperativeKernel((void*)mega, dim3(grid_blocks), dim3(256), args, 0, stream);
  if (e != hipSuccess) fprintf(stderr, "cooperative launch failed: %s (grid %d)\n", hipGetErrorString(e), grid_blocks);
#endif
}
```

```cpp
#include <hip/hip_runtime.h>
#include <hip/hip_cooperative_groups.h>
#include <cstdio>
namespace cg = cooperative_groups;

typedef unsigned short bfr;
typedef __attribute__((ext_vector_type(8))) short bf16x8;
typedef __attribute__((ext_vector_type(4))) short bf16x4;
typedef __attribute__((ext_vector_type(16))) float f32x16;
#define DI __device__ __forceinline__
#define MFMA(a, b, c) __builtin_amdgcn_mfma_f32_32x32x16_bf16((a), (b), (c), 0, 0, 0)

#ifndef MULTI_LAUNCH
#define MULTI_LAUNCH 0
#endif

constexpr int RL = 16384, R = 16896, SEQ = 8192, CTX = 256;
constexpr int NCH = 33, CL = 256;
constexpr int NPHASE = 37;

constexpr size_t al(size_t x) { return (x + 255) & ~size_t(255); }
constexpr size_t OFF_HC = 0;
constexpr size_t OFF_MOD = OFF_HC + al(512 * 1024 * 4);
constexpr size_t OFF_TW = OFF_MOD + al(4 * 3 * 6144 * 4);
constexpr size_t OFF_C128 = OFF_TW + al(8192 * 8);
constexpr size_t OFF_S128 = OFF_C128 + al(128 * 128 * 2);
constexpr size_t OFF_C64 = OFF_S128 + al(128 * 128 * 2);
constexpr size_t OFF_S64 = OFF_C64 + al(64 * 64 * 2);
constexpr size_t OFF_C256 = OFF_S64 + al(64 * 64 * 2);
constexpr size_t OFF_S256 = OFF_C256 + al(256 * 256 * 2);
constexpr size_t OFF_ROPE = OFF_S256 + al(256 * 256 * 2);
constexpr size_t OFF_DTV = OFF_ROPE + al(2 * 2 * 128 * 16 * 4);
constexpr size_t DT_BYTES = (size_t)2 * 2 * NCH * 24 * 256 * 4;
constexpr size_t OFF_ACUM = OFF_DTV + al(DT_BYTES);
constexpr size_t OFF_WIN = OFF_ACUM + al(DT_BYTES);
constexpr size_t OFF_WOUT = OFF_WIN + al((size_t)5248 * 1024 * 2);
constexpr size_t OFF_WFF1 = OFF_WOUT + al((size_t)1024 * 2048 * 2);
constexpr size_t OFF_WFF2 = OFF_WFF1 + al((size_t)4096 * 1024 * 2);
constexpr size_t OFF_MIX = OFF_WFF2 + al((size_t)4096 * 1024 * 2);
constexpr size_t OFF_BIG = OFF_MIX + al((size_t)R * 2048 * 2);
constexpr size_t OFF_Z = OFF_BIG;
constexpr size_t OFF_ZRT = OFF_Z + (size_t)R * 1536 * 2;
constexpr size_t OFF_ZIT = OFF_ZRT + (size_t)512 * R * 2;
constexpr size_t OFF_XBC = OFF_ZIT + (size_t)512 * R * 2;
constexpr size_t OFF_DTRAW = OFF_XBC + (size_t)R * 2560 * 2;
constexpr size_t BIG_END = OFF_DTRAW + (size_t)R * 48 * 4;
constexpr size_t OFF_HS = OFF_XBC;
constexpr size_t HS_BYTES = (size_t)2 * 2 * NCH * 24 * 8192 * 2;
constexpr size_t OFF_YR = OFF_HS + HS_BYTES;
constexpr size_t OFF_YI = OFF_YR + (size_t)2 * 512 * 128 * 64 * 2;
static_assert(OFF_YI + (size_t)2 * 512 * 128 * 64 * 2 <= OFF_DTRAW, "fft scratch overflows");
constexpr size_t OFF_ACT = OFF_BIG;
static_assert((size_t)R * 4096 * 2 <= BIG_END - OFF_BIG, "act overflows");
constexpr size_t OFF_P = OFF_BIG;
constexpr size_t OFF_VT = OFF_P + (size_t)R * 2304 * 2;
constexpr size_t OFF_QK = OFF_VT + (size_t)640 * R * 2;
static_assert(OFF_QK + (size_t)R * 1664 * 2 <= BIG_END, "odd overflows");
constexpr size_t OFF_XT = al(BIG_END);
constexpr size_t OFF_BN = OFF_XT + (size_t)1536 * R * 2;
constexpr size_t OFF_BT = OFF_BN + (size_t)R * 512 * 2;
constexpr size_t OFF_CN = OFF_BT + (size_t)512 * R * 2;
constexpr size_t OFF_BAR = al(OFF_CN + (size_t)R * 512 * 2);
constexpr size_t WS_TOTAL = OFF_BAR + 16384;
static_assert(WS_TOTAL <= 402653184ull, "workspace too large");

struct Params {
  const float *x, *c, *ctx, *c_ctx, *w_mod, *b_mod, *norm_mix_g, *norm_ff_g, *w_ff1, *w_ff2;
  const float *w_in_even, *conv_w, *conv_b, *dt_bias, *a_log, *d_skip, *ssd_norm_g, *w_out_even;
  const float *w_in_odd, *q_norm_win, *k_norm_win, *sink_win, *q_norm_na, *k_norm_na, *rpb_na, *w_out_odd;
  float* out;
  unsigned char* ws;
};

struct DP : Params { int tidl, bidl; };

__shared__ __attribute__((aligned(16))) unsigned char smem[73728];

DI bfr f2bf(float x) { unsigned u = __float_as_uint(x); u += 0x7fffu + ((u >> 16) & 1u); return (bfr)(u >> 16); }
DI float bf2f(bfr b) { return __uint_as_float(((unsigned)b) << 16); }
DI float bfs(short s) { return __uint_as_float(((unsigned)(unsigned short)s) << 16); }
DI int crow(int i, int h) { return (i & 3) + 8 * (i >> 2) + 4 * h; }
DI f32x16 zero16() { f32x16 z; for (int i = 0; i < 16; ++i) z[i] = 0.f; return z; }
DI bf16x8 pack8(float a0, float a1, float a2, float a3, float a4, float a5, float a6, float a7) {
  bf16x8 v;
  v[0] = (short)f2bf(a0); v[1] = (short)f2bf(a1); v[2] = (short)f2bf(a2); v[3] = (short)f2bf(a3);
  v[4] = (short)f2bf(a4); v[5] = (short)f2bf(a5); v[6] = (short)f2bf(a6); v[7] = (short)f2bf(a7);
  return v;
}
DI bf16x4 pack4(float a0, float a1, float a2, float a3) {
  bf16x4 v; v[0] = (short)f2bf(a0); v[1] = (short)f2bf(a1); v[2] = (short)f2bf(a2); v[3] = (short)f2bf(a3); return v;
}
#define PACK_HALF(s, s2) pack8(s[8 * (s2)], s[8 * (s2) + 1], s[8 * (s2) + 2], s[8 * (s2) + 3], s[8 * (s2) + 4], s[8 * (s2) + 5], s[8 * (s2) + 6], s[8 * (s2) + 7])
DI bf16x8 join44(bf16x4 lo, bf16x4 hi) { return __builtin_shufflevector(lo, hi, 0, 1, 2, 3, 4, 5, 6, 7); }
DI int chunk_row0(int b, int c) { return c == 0 ? RL + b * CTX : b * SEQ + (c - 1) * CL; }

DI void sincos_turn(double f, float& s, float& c) {
  f -= rint(f);
  double x = f * 6.283185307179586476925;
  double x2 = x * x, ss = 1.0, cc = 1.0;
#pragma unroll
  for (int k = 13; k >= 1; --k) {
    ss = 1.0 - x2 / (double)((2 * k) * (2 * k + 1)) * ss;
    cc = 1.0 - x2 / (double)((2 * k - 1) * (2 * k)) * cc;
  }
  s = (float)(x * ss); c = (float)cc;
}

template <class T> DI T* wsp(const DP& p, size_t off) { return (T*)(p.ws + off); }

DI void phase0(const DP& p) {
  const int tid = p.tidl, bid = p.bidl, G = gridDim.x;
  float* lds = (float*)smem;
  float* MOD = wsp<float>(p, OFF_MOD);
  for (int u = bid; u < 384; u += G) {
    int layer = u / 96, cb = u % 96;
    for (int i = tid; i < 3072; i += 256) {
      int v = i >> 10, k = i & 1023;
      float c = v < 2 ? p.c[v * 1024 + k] : p.c_ctx[k];
      lds[i] = c / (1.f + expf(-c));
    }
    __syncthreads();
    int kq = tid >> 6, cc = tid & 63, col = cb * 64 + cc;
    const float* w = p.w_mod + (size_t)layer * 1024 * 6144 + col;
    float a0 = 0, a1 = 0, a2 = 0;
    for (int k = kq * 256; k < kq * 256 + 256; ++k) {
      float wv = w[(size_t)k * 6144];
      a0 += lds[k] * wv; a1 += lds[1024 + k] * wv; a2 += lds[2048 + k] * wv;
    }
    float* red = lds + 3072;
    red[(kq * 3 + 0) * 64 + cc] = a0; red[(kq * 3 + 1) * 64 + cc] = a1; red[(kq * 3 + 2) * 64 + cc] = a2;
    __syncthreads();
    if (tid < 192) {
      int v = tid >> 6;
      float s = red[(0 * 3 + v) * 64 + cc] + red[(1 * 3 + v) * 64 + cc] + red[(2 * 3 + v) * 64 + cc] + red[(3 * 3 + v) * 64 + cc];
      MOD[(layer * 3 + v) * 6144 + col] = s + p.b_mod[layer * 6144 + col];
    }
    __syncthreads();
  }
  const int gt = bid * 256 + tid, nt = G * 256;
  {
    const float4* xs = (const float4*)p.x; float4* od = (float4*)p.out;
    for (int i = gt; i < RL * 256; i += nt) od[i] = xs[i];
    const float4* cs = (const float4*)p.ctx; float4* hd = wsp<float4>(p, OFF_HC);
    for (int i = gt; i < 512 * 256; i += nt) hd[i] = cs[i];
  }
  float2* TW = wsp<float2>(p, OFF_TW);
  for (int i = gt; i < 8192; i += nt) { float s, c; sincos_turn((double)i / 8192.0, s, c); TW[i] = make_float2(c, s); }
  bfr* C128 = wsp<bfr>(p, OFF_C128); bfr* S128 = wsp<bfr>(p, OFF_S128);
  for (int i = gt; i < 128 * 128; i += nt) { int a = i >> 7, b = i & 127; float s, c; sincos_turn((double)((a * b) & 127) / 128.0, s, c); C128[i] = f2bf(c); S128[i] = f2bf(s); }
  bfr* C64 = wsp<bfr>(p, OFF_C64); bfr* S64 = wsp<bfr>(p, OFF_S64);
  for (int i = gt; i < 64 * 64; i += nt) { int a = i >> 6, b = i & 63; float s, c; sincos_turn((double)((a * b) & 63) / 64.0, s, c); C64[i] = f2bf(c); S64[i] = f2bf(s); }
  bfr* C256 = wsp<bfr>(p, OFF_C256); bfr* S256 = wsp<bfr>(p, OFF_S256);
  for (int i = gt; i < 256 * 256; i += nt) { int a = i >> 8, b = i & 255; float s, c; sincos_turn((double)((a * b) & 255) / 256.0, s, c); C256[i] = f2bf(c); S256[i] = f2bf(s); }
  float* ROPE = wsp<float>(p, OFF_ROPE);
  for (int i = gt; i < 2 * 128 * 16; i += nt) {
    int f = i & 15, idx = (i >> 4) & 127;
    float ang = (float)idx * (float)exp(-(double)f * 0.5756462732485115);
    float s, c; sincos_turn((double)ang / 6.283185307179586476925, s, c);
    ROPE[i] = c; ROPE[4096 + i] = s;
  }
}

DI void tcvt_unit(const float* __restrict__ src, int ld, int c0, int ncols, int K, bfr* __restrict__ dst, int dr0, int u, int tid) {
  const int ntk = K >> 6;
  const int tn = u / ntk, tk = u % ntk, k0 = tk * 64, nb = tn * 64;
  bfr* T = (bfr*)smem;
  float4 v[4];
  const int n4 = (tid & 15) * 4;
#pragma unroll
  for (int i = 0; i < 4; ++i) {
    const int kk = (tid >> 4) + 16 * i;
    v[i] = make_float4(0.f, 0.f, 0.f, 0.f);
    if (nb + n4 < ncols) v[i] = *(const float4*)(src + (size_t)(k0 + kk) * ld + c0 + nb + n4);
  }
#pragma unroll
  for (int i = 0; i < 4; ++i) {
    const int kk = (tid >> 4) + 16 * i;
    T[(n4 + 0) * 72 + kk] = f2bf(v[i].x); T[(n4 + 1) * 72 + kk] = f2bf(v[i].y);
    T[(n4 + 2) * 72 + kk] = f2bf(v[i].z); T[(n4 + 3) * 72 + kk] = f2bf(v[i].w);
  }
  __syncthreads();
  {
    int n = tid >> 2, kseg = (tid & 3) * 16;
    if (nb + n < ncols) {
      bfr* d = dst + (size_t)(dr0 + nb + n) * K + k0 + kseg;
      *(bf16x8*)d = *(const bf16x8*)(T + n * 72 + kseg);
      *(bf16x8*)(d + 8) = *(const bf16x8*)(T + n * 72 + kseg + 8);
    }
  }
  __syncthreads();
}

DI void wconv_phase(const DP& p, int layer) {
  const int tid = p.tidl;
  const int j = layer >> 1;
  bfr* WIN = wsp<bfr>(p, OFF_WIN); bfr* WOUT = wsp<bfr>(p, OFF_WOUT);
  bfr* WFF1 = wsp<bfr>(p, OFF_WFF1); bfr* WFF2 = wsp<bfr>(p, OFF_WFF2);
  const float* ff1 = p.w_ff1 + (size_t)layer * 1024 * 4096;
  const float* ff2 = p.w_ff2 + (size_t)layer * 4096 * 1024;
  float* cst = (float*)(smem + 20480);
  if (tid < 64) { float s, c; sincos_turn((double)tid / 64.0, s, c); cst[tid] = c; cst[64 + tid] = s; }
  __syncthreads();
  if ((layer & 1) == 0) {
    const float* win = p.w_in_even + (size_t)j * 1024 * 4656;
    const float* wout = p.w_out_even + (size_t)j * 2048 * 1024;
    const int n_in = 65 * 16, n_out = 16 * 32, n_f1 = 64 * 16, n_f2 = 16 * 64, n_fold = 128;
    const int total = n_in + n_out + n_f1 + n_f2 + n_fold;
    for (int u = p.bidl; u < total; u += gridDim.x) {
      int v = u;
      if (v < n_in) { tcvt_unit(win, 4656, 512, 4144, 1024, WIN, 1024, v, tid); continue; }
      v -= n_in;
      if (v < n_out) { tcvt_unit(wout, 1024, 0, 1024, 2048, WOUT, 0, v, tid); continue; }
      v -= n_out;
      if (v < n_f1) { tcvt_unit(ff1, 4096, 0, 4096, 1024, WFF1, 0, v, tid); continue; }
      v -= n_f1;
      if (v < n_f2) { tcvt_unit(ff2, 1024, 0, 1024, 4096, WFF2, 0, v, tid); continue; }
      v -= n_f2;
      {
        const int g = v >> 4, kb = v & 15;
        float* wt = (float*)smem;
#pragma unroll
        for (int i = 0; i < 4; ++i) {
          const int idx = tid + 256 * i, kk = idx >> 4, j4 = (idx & 15) * 4;
          const float4 wv = *(const float4*)(win + (size_t)(kb * 64 + kk) * 4656 + g * 64 + j4);
          wt[kk * 65 + j4] = wv.x; wt[kk * 65 + j4 + 1] = wv.y; wt[kk * 65 + j4 + 2] = wv.z; wt[kk * 65 + j4 + 3] = wv.w;
        }
        __syncthreads();
        const int kl = tid & 63, mg = tid >> 6;
#pragma unroll 1
        for (int mi = 0; mi < 16; ++mi) {
          const int m = mg * 16 + mi;
          float sc = 0.f, ss = 0.f;
#pragma unroll 8
          for (int jj = 0; jj < 64; ++jj) { const float w = wt[kl * 65 + jj]; const int idx = (m * jj) & 63; sc += w * cst[idx]; ss += w * cst[64 + idx]; }
          const int ch = g * 64 + m, k = kb * 64 + kl;
          WIN[(size_t)ch * 1024 + k] = f2bf(sc);
          WIN[(size_t)(512 + ch) * 1024 + k] = f2bf(-ss);
        }
        __syncthreads();
      }
    }
  } else {
    const float* win = p.w_in_odd + (size_t)j * 1024 * 2304;
    const float* wout = p.w_out_odd + (size_t)j * 1024 * 1024;
    const int n_in = 36 * 16, n_out = 16 * 16, n_f1 = 64 * 16, n_f2 = 16 * 64;
    const int total = n_in + n_out + n_f1 + n_f2;
    for (int u = p.bidl; u < total; u += gridDim.x) {
      int v = u;
      if (v < n_in) { tcvt_unit(win, 2304, 0, 2304, 1024, WIN, 0, v, tid); continue; }
      v -= n_in;
      if (v < n_out) { tcvt_unit(wout, 1024, 0, 1024, 1024, WOUT, 0, v, tid); continue; }
      v -= n_out;
      if (v < n_f1) { tcvt_unit(ff1, 4096, 0, 4096, 1024, WFF1, 0, v, tid); continue; }
      v -= n_f1;
      tcvt_unit(ff2, 1024, 0, 1024, 4096, WFF2, 0, v, tid);
    }
  }
}

DI void norm_phase(const DP& p, int layer, const float* __restrict__ gvec, int shc, int scc) {
  const int lane = p.tidl & 63;
  const int wg = p.bidl * 4 + (p.tidl >> 6), nw = gridDim.x * 4;
  const float* MOD = wsp<float>(p, OFF_MOD);
  const float* HC = wsp<float>(p, OFF_HC);
  bfr* U = wsp<bfr>(p, OFF_MIX);
  for (int row = wg; row < R; row += nw) {
    const float* hp = row < RL ? p.out + (size_t)row * 1024 : HC + (size_t)(row - RL) * 1024;
    const int ms = row < RL ? (row >> 13) : 2;
    const float* md = MOD + (layer * 3 + ms) * 6144;
    float4 v[4]; float ss = 0.f;
#pragma unroll
    for (int i = 0; i < 4; ++i) {
      v[i] = *(const float4*)(hp + i * 256 + lane * 4);
      ss += v[i].x * v[i].x + v[i].y * v[i].y + v[i].z * v[i].z + v[i].w * v[i].w;
    }
#pragma unroll
    for (int o = 32; o >= 1; o >>= 1) ss += __shfl_xor(ss, o);
    const float rs = rsqrtf(ss * (1.f / 1024.f) + 1e-6f);
#pragma unroll
    for (int i = 0; i < 4; ++i) {
      int col = i * 256 + lane * 4;
      float4 g = *(const float4*)(gvec + col);
      float4 sc = *(const float4*)(md + scc * 1024 + col);
      float4 sh = *(const float4*)(md + shc * 1024 + col);
      bf16x4 o = pack4(v[i].x * rs * g.x * (1.f + sc.x) + sh.x, v[i].y * rs * g.y * (1.f + sc.y) + sh.y,
                       v[i].z * rs * g.z * (1.f + sc.z) + sh.z, v[i].w * rs * g.w * (1.f + sc.w) + sh.w);
      *(bf16x4*)(U + (size_t)row * 1024 + col) = o;
    }
  }
}

enum { EPI_EVEN_IN = 0, EPI_ODD_IN = 1, EPI_RELU2 = 2, EPI_RESID = 3 };

DI void gemm_phase(const DP& p, int mode, const bfr* __restrict__ A, int lda, const bfr* __restrict__ Bt,
                   int N, int K, int layer, int gchunk) {
  const int tid = p.tidl, lane = tid & 63, wid = tid >> 6, r = lane & 31, h = lane >> 5;
  const int wm = wid >> 1, wn = wid & 1;
  const int nN = (N + 127) >> 7, nM = R / 128;
  const int tiles = nM * nN, G = (int)gridDim.x;
  int full = tiles, tail = 0, St = 1;
  if (mode == EPI_RESID) {
    full = (tiles / G) * G; tail = tiles - full;
    if (tail > 0) { int c = G / tail; int kmax = K >> 7; St = 1; while (St * 2 <= c && St * 2 <= 16 && St * 2 <= kmax) St *= 2; }
  }
  const int chunk = (full + 7) >> 3;
  const int units = chunk * 8 + tail * St;
  bfr* sm = (bfr*)smem;
  const int lrow = tid >> 3, lc = (tid & 7) * 8;
#pragma unroll 1
  for (int u = p.bidl; u < units; u += G) {
    int t, ks, Ks; bool atom;
    if (u < chunk * 8) {
      t = (u & 7) * chunk + (u >> 3);
      if (t >= full) continue;
      ks = 0; Ks = K; atom = false;
    } else { const int v = u - chunk * 8; t = full + v / St; ks = v % St; Ks = K / St; atom = St > 1; }
    const int nk = Ks >> 6;
    const int panel = t / (nM * 8); const int rem = t - panel * nM * 8;
    const int pw = (nN - panel * 8) < 8 ? (nN - panel * 8) : 8;
    const int tm = rem / pw, tn = panel * 8 + rem % pw;
    const int m0 = tm * 128, n0 = tn * 128, kbase = ks * Ks;
    f32x16 acc[2][2];
    acc[0][0] = zero16(); acc[0][1] = zero16(); acc[1][0] = zero16(); acc[1][1] = zero16();
    const bfr* Ag = A + (size_t)(m0 + lrow) * lda + kbase + lc;
    const bfr* Bg = Bt + (size_t)(n0 + lrow) * K + kbase + lc;
    bf16x8 ra[4], rb[4];
#pragma unroll
    for (int i = 0; i < 4; ++i) {
      ra[i] = *(const bf16x8*)(Ag + (size_t)(32 * i) * lda);
      rb[i] = *(const bf16x8*)(Bg + (size_t)(32 * i) * K);
    }
#pragma unroll
    for (int i = 0; i < 4; ++i) {
      *(bf16x8*)(sm + (lrow + 32 * i) * 72 + lc) = ra[i];
      *(bf16x8*)(sm + 9216 + (lrow + 32 * i) * 72 + lc) = rb[i];
    }
    if (nk > 1) {
#pragma unroll
      for (int i = 0; i < 4; ++i) {
        ra[i] = *(const bf16x8*)(Ag + (size_t)(32 * i) * lda + 64);
        rb[i] = *(const bf16x8*)(Bg + (size_t)(32 * i) * K + 64);
      }
    }
    __syncthreads();
#pragma unroll 1
    for (int kt = 0; kt < nk; ++kt) {
      if (kt + 1 < nk) {
        bfr* Ad = sm + ((kt + 1) & 1) * 18432;
#pragma unroll
        for (int i = 0; i < 4; ++i) {
          *(bf16x8*)(Ad + (lrow + 32 * i) * 72 + lc) = ra[i];
          *(bf16x8*)(Ad + 9216 + (lrow + 32 * i) * 72 + lc) = rb[i];
        }
      }
      if (kt + 2 < nk) {
#pragma unroll
        for (int i = 0; i < 4; ++i) {
          ra[i] = *(const bf16x8*)(Ag + (size_t)(32 * i) * lda + (kt + 2) * 64);
          rb[i] = *(const bf16x8*)(Bg + (size_t)(32 * i) * K + (kt + 2) * 64);
        }
      }
      const bfr* As = sm + (kt & 1) * 18432;
      const bfr* Bs = As + 9216;
      __builtin_amdgcn_s_setprio(1);
#pragma unroll
      for (int kk = 0; kk < 4; ++kk) {
        bf16x8 a0 = *(const bf16x8*)(As + (wm * 64 + r) * 72 + kk * 16 + h * 8);
        bf16x8 a1 = *(const bf16x8*)(As + (wm * 64 + 32 + r) * 72 + kk * 16 + h * 8);
        bf16x8 b0 = *(const bf16x8*)(Bs + (wn * 64 + r) * 72 + kk * 16 + h * 8);
        bf16x8 b1 = *(const bf16x8*)(Bs + (wn * 64 + 32 + r) * 72 + kk * 16 + h * 8);
        acc[0][0] = MFMA(a0, b0, acc[0][0]);
        acc[0][1] = MFMA(a0, b1, acc[0][1]);
        acc[1][0] = MFMA(a1, b0, acc[1][0]);
        acc[1][1] = MFMA(a1, b1, acc[1][1]);
      }
      __builtin_amdgcn_s_setprio(0);
      __syncthreads();
    }
#pragma unroll
    for (int mi = 0; mi < 2; ++mi)
#pragma unroll
      for (int ni = 0; ni < 2; ++ni)
#pragma unroll
        for (int g4 = 0; g4 < 4; ++g4) {
          const int row = m0 + wm * 64 + mi * 32 + 8 * g4 + 4 * h;
          const int col = n0 + wn * 64 + ni * 32 + r;
          const float v0 = acc[mi][ni][4 * g4], v1 = acc[mi][ni][4 * g4 + 1], v2 = acc[mi][ni][4 * g4 + 2], v3 = acc[mi][ni][4 * g4 + 3];
          if (mode == EPI_EVEN_IN) {
            if (col < 1024) {
              bfr* dst = wsp<bfr>(p, col < 512 ? OFF_ZRT : OFF_ZIT) + (size_t)(col & 511) * R + row;
              *(bf16x4*)dst = pack4(v0, v1, v2, v3);
            } else if (col < 2560) {
              bfr* dst = wsp<bfr>(p, OFF_Z) + (size_t)row * 1536 + (col - 1024);
              dst[0] = f2bf(v0); dst[1536] = f2bf(v1); dst[2 * 1536] = f2bf(v2); dst[3 * 1536] = f2bf(v3);
            } else if (col < 5120) {
              bfr* dst = wsp<bfr>(p, OFF_XBC) + (size_t)row * 2560 + (col - 2560);
              dst[0] = f2bf(v0); dst[2560] = f2bf(v1); dst[2 * 2560] = f2bf(v2); dst[3 * 2560] = f2bf(v3);
            } else if (col < 5168) {
              float* dst = wsp<float>(p, OFF_DTRAW) + (size_t)row * 48 + (col - 5120);
              dst[0] = v0; dst[48] = v1; dst[96] = v2; dst[144] = v3;
            }
          } else if (mode == EPI_ODD_IN) {
            if (col >= 640 && col < 768) {
              *(bf16x4*)(wsp<bfr>(p, OFF_VT) + (size_t)(col - 640) * R + row) = pack4(v0, v1, v2, v3);
            } else if (col >= 1792) {
              *(bf16x4*)(wsp<bfr>(p, OFF_VT) + (size_t)(128 + col - 1792) * R + row) = pack4(v0, v1, v2, v3);
            } else {
              bfr* dst = wsp<bfr>(p, OFF_P) + (size_t)row * 2304 + col;
              dst[0] = f2bf(v0); dst[2304] = f2bf(v1); dst[2 * 2304] = f2bf(v2); dst[3 * 2304] = f2bf(v3);
            }
          } else if (mode == EPI_RELU2) {
            bfr* dst = wsp<bfr>(p, OFF_ACT) + (size_t)row * 4096 + col;
            float t0 = fmaxf(v0, 0.f), t1 = fmaxf(v1, 0.f), t2 = fmaxf(v2, 0.f), t3 = fmaxf(v3, 0.f);
            dst[0] = f2bf(t0 * t0); dst[4096] = f2bf(t1 * t1); dst[2 * 4096] = f2bf(t2 * t2); dst[3 * 4096] = f2bf(t3 * t3);
          } else if (mode == EPI_RESID) {
            const int ms = row < RL ? (row >> 13) : 2;
            const float gate = wsp<float>(p, OFF_MOD)[(layer * 3 + ms) * 6144 + gchunk * 1024 + col];
            float* hp = row < RL ? p.out + (size_t)row * 1024 + col : wsp<float>(p, OFF_HC) + (size_t)(row - RL) * 1024 + col;
            if (atom) {
              unsafeAtomicAdd(hp, gate * v0); unsafeAtomicAdd(hp + 1024, gate * v1);
              unsafeAtomicAdd(hp + 2048, gate * v2); unsafeAtomicAdd(hp + 3072, gate * v3);
            } else {
              hp[0] += gate * v0; hp[1024] += gate * v1; hp[2048] += gate * v2; hp[3072] += gate * v3;
            }
          }
        }
  }
}

DI float softplus_f(float x) { return x > 0.f ? x + log1pf(expf(-x)) : log1pf(expf(x)); }

DI void conv_dt_phase(const DP& p, int j) {
  const int tid = p.tidl, lane = tid & 63, wid = tid >> 6;
  const bfr* XBC = wsp<bfr>(p, OFF_XBC);
  bfr* XT = wsp<bfr>(p, OFF_XT); bfr* BN = wsp<bfr>(p, OFF_BN); bfr* BTt = wsp<bfr>(p, OFF_BT); bfr* CN = wsp<bfr>(p, OFF_CN);
  bfr* TT = (bfr*)smem;
  const float* cw = p.conv_w + (size_t)j * 5 * 2560;
  const float* cb = p.conv_b + (size_t)j * 2560;
  const int n_conv = 264 * 40, n_dt = 792;
  for (int u = p.bidl; u < n_conv + n_dt; u += gridDim.x) {
    if (u < n_conv) {
      const int tb = u / 40, cbk = u % 40, row0 = tb * 64, ch0 = cbk * 64;
      int pos0, len;
      if (row0 < RL) { pos0 = row0 & 8191; len = SEQ; } else { pos0 = (row0 - RL) & 255; len = CTX; }
      const int c8 = tid & 7, ch = ch0 + c8 * 8;
      float w[5][8], bias[8];
#pragma unroll
      for (int k = 0; k < 5; ++k) {
        float4 wa = *(const float4*)(cw + k * 2560 + ch), wb = *(const float4*)(cw + k * 2560 + ch + 4);
        w[k][0] = wa.x; w[k][1] = wa.y; w[k][2] = wa.z; w[k][3] = wa.w; w[k][4] = wb.x; w[k][5] = wb.y; w[k][6] = wb.z; w[k][7] = wb.w;
      }
      {
        float4 wa = *(const float4*)(cb + ch), wb = *(const float4*)(cb + ch + 4);
        bias[0] = wa.x; bias[1] = wa.y; bias[2] = wa.z; bias[3] = wa.w; bias[4] = wb.x; bias[5] = wb.y; bias[6] = wb.z; bias[7] = wb.w;
      }
#pragma unroll
      for (int ps = 0; ps < 2; ++ps) {
        const int tl = (tid >> 3) + 32 * ps, pos = pos0 + tl, row = row0 + tl;
        float a[8];
#pragma unroll
        for (int e = 0; e < 8; ++e) a[e] = bias[e];
        bf16x8 xr[5];
#pragma unroll
        for (int k = 0; k < 5; ++k) {
          const int pp = pos + k - 2;
          const bool ok = pp >= 0 && pp < len;
          const bfr* xp = XBC + (size_t)(ok ? row + k - 2 : row) * 2560 + ch;
          xr[k] = *(const bf16x8*)xp;
          if (!ok) { for (int e = 0; e < 8; ++e) xr[k][e] = 0; }
        }
#pragma unroll
        for (int k = 0; k < 5; ++k)
#pragma unroll
          for (int e = 0; e < 8; ++e) a[e] += w[k][e] * bfs(xr[k][e]);
        bf16x8 o;
#pragma unroll
        for (int e = 0; e < 8; ++e) { float s = a[e] / (1.f + __expf(-a[e])); o[e] = (short)f2bf(s); }
        if (ch0 >= 2048) *(bf16x8*)(CN + (size_t)row * 512 + (ch - 2048)) = o;
        else if (ch0 >= 1536) *(bf16x8*)(BN + (size_t)row * 512 + (ch - 1536)) = o;
        if (ch0 < 2048) {
#pragma unroll
          for (int e = 0; e < 8; ++e) TT[(c8 * 8 + e) * 72 + tl] = (bfr)o[e];
        }
      }
      if (ch0 < 2048) {
        __syncthreads();
        const int chl = tid >> 2, tseg = (tid & 3) * 16;
        bfr* dst = (ch0 < 1536 ? XT + (size_t)(ch0 + chl) * R : BTt + (size_t)(ch0 - 1536 + chl) * R) + row0 + tseg;
        *(bf16x8*)dst = *(const bf16x8*)(TT + chl * 72 + tseg);
        *(bf16x8*)(dst + 8) = *(const bf16x8*)(TT + chl * 72 + tseg + 8);
        __syncthreads();
      }
    } else {
      const int item = (u - n_conv) * 4 + wid;
      const int head = item % 24; int rest = item / 24; const int dir = rest & 1; rest >>= 1; const int c = rest % NCH, b = rest / NCH;
      const int row0 = chunk_row0(b, c), col = dir * 24 + head;
      const float bias = p.dt_bias[j * 48 + col];
      const float a = -expf(p.a_log[j * 48 + col]);
      const float* DTRAW = wsp<float>(p, OFF_DTRAW);
      float dt[4], cs[4];
      float run = 0.f;
#pragma unroll
      for (int q = 0; q < 4; ++q) {
        dt[q] = softplus_f(DTRAW[(size_t)(row0 + lane * 4 + q) * 48 + col] + bias);
        run += dt[q] * a; cs[q] = run;
      }
      float x = run;
#pragma unroll
      for (int o = 1; o < 64; o <<= 1) { float t2 = __shfl_up(x, o); if (lane >= o) x += t2; }
      const float excl = x - run;
      const float total = __shfl(x, 63);
      float ac[4];
#pragma unroll
      for (int q = 0; q < 4; ++q) {
        float inc = excl + cs[q];
        ac[q] = dir == 0 ? inc : total - inc + dt[q] * a;
      }
      const size_t base = ((size_t)(((dir * 2 + b) * NCH + c) * 24 + head)) * 256 + lane * 4;
      *(float4*)(wsp<float>(p, OFF_DTV) + base) = make_float4(dt[0], dt[1], dt[2], dt[3]);
      *(float4*)(wsp<float>(p, OFF_ACUM) + base) = make_float4(ac[0], ac[1], ac[2], ac[3]);
    }
  }
}

DI bf16x8 scale8(bf16x8 a, const float* w) {
  return pack8(bfs(a[0]) * w[0], bfs(a[1]) * w[1], bfs(a[2]) * w[2], bfs(a[3]) * w[3],
               bfs(a[4]) * w[4], bfs(a[5]) * w[5], bfs(a[6]) * w[6], bfs(a[7]) * w[7]);
}

DI void s1_item(const DP& p, int item, int lane) {
  const int r = lane & 31, h = lane >> 5;
  const int head = item % 24; int rest = item / 24; const int dir = rest & 1; rest >>= 1; const int c = rest % NCH, b = rest / NCH;
  const int g = head / 6;
  const int row0 = chunk_row0(b, c);
  const size_t dbase = ((size_t)(((dir * 2 + b) * NCH + c) * 24 + head)) * 256;
  const float* dtv = wsp<float>(p, OFF_DTV) + dbase;
  const float* acm = wsp<float>(p, OFF_ACUM) + dbase;
  const float acend = dir == 0 ? acm[255] : acm[0];
  const bfr* XT = wsp<bfr>(p, OFF_XT); const bfr* BTt = wsp<bfr>(p, OFF_BT);
  bfr* HS = wsp<bfr>(p, OFF_HS) + ((size_t)(((dir * 2 + b) * NCH + c) * 24 + head)) * 8192;
#pragma unroll 1
  for (int pt = 0; pt < 2; ++pt) {
    f32x16 acc[4];
#pragma unroll
    for (int n = 0; n < 4; ++n) acc[n] = zero16();
#pragma unroll 4
    for (int kk = 0; kk < 16; ++kk) {
      const int s0 = kk * 16 + 8 * h;
      float4 d0 = *(const float4*)(dtv + s0), d1 = *(const float4*)(dtv + s0 + 4);
      float4 a0 = *(const float4*)(acm + s0), a1 = *(const float4*)(acm + s0 + 4);
      float w[8];
      w[0] = d0.x * __expf(acend - a0.x); w[1] = d0.y * __expf(acend - a0.y); w[2] = d0.z * __expf(acend - a0.z); w[3] = d0.w * __expf(acend - a0.w);
      w[4] = d1.x * __expf(acend - a1.x); w[5] = d1.y * __expf(acend - a1.y); w[6] = d1.z * __expf(acend - a1.z); w[7] = d1.w * __expf(acend - a1.w);
      bf16x8 af = scale8(*(const bf16x8*)(XT + (size_t)(head * 64 + pt * 32 + r) * R + row0 + s0), w);
#pragma unroll
      for (int nt = 0; nt < 4; ++nt) {
        bf16x8 bfv = *(const bf16x8*)(BTt + (size_t)(g * 128 + nt * 32 + r) * R + row0 + s0);
        acc[nt] = MFMA(af, bfv, acc[nt]);
      }
    }
#pragma unroll
    for (int nt = 0; nt < 4; ++nt)
#pragma unroll
      for (int i = 0; i < 16; ++i) HS[(pt * 32 + crow(i, h)) * 128 + nt * 32 + r] = f2bf(acc[nt][i]);
  }
}

DI void f1_item(const DP& p, int item, int lane) {
  const int r = lane & 31, h = lane >> 5;
  const int l2t = item & 1, m = (item >> 1) & 511, b = item >> 10;
  const bfr* ZRT = wsp<bfr>(p, OFF_ZRT) + (size_t)m * R + b * SEQ + l2t * 32 + r;
  const bfr* ZIT = wsp<bfr>(p, OFF_ZIT) + (size_t)m * R + b * SEQ + l2t * 32 + r;
  const bfr* C128 = wsp<bfr>(p, OFF_C128); const bfr* S128 = wsp<bfr>(p, OFF_S128);
  const float2* TW = wsp<float2>(p, OFF_TW);
  bfr* YR = wsp<bfr>(p, OFF_YR); bfr* YI = wsp<bfr>(p, OFF_YI);
  const int l2 = l2t * 32 + r;
#pragma unroll 1
  for (int mh = 0; mh < 2; ++mh) {
    f32x16 yr[2], yi[2];
#pragma unroll
    for (int i = 0; i < 2; ++i) { yr[i] = zero16(); yi[i] = zero16(); }
#pragma unroll 2
    for (int kk = 0; kk < 8; ++kk) {
      bf16x8 zr, zi, nzr;
#pragma unroll
      for (int jj = 0; jj < 8; ++jj) {
        int l1 = kk * 16 + 8 * h + jj;
        zr[jj] = (short)ZRT[l1 * 64]; zi[jj] = (short)ZIT[l1 * 64];
        nzr[jj] = (short)(zr[jj] ^ (short)0x8000);
      }
#pragma unroll
      for (int m2 = 0; m2 < 2; ++m2) {
        const int mt = mh * 2 + m2;
        bf16x8 ca = *(const bf16x8*)(C128 + (mt * 32 + r) * 128 + kk * 16 + 8 * h);
        bf16x8 sa = *(const bf16x8*)(S128 + (mt * 32 + r) * 128 + kk * 16 + 8 * h);
        yr[m2] = MFMA(ca, zr, yr[m2]); yr[m2] = MFMA(sa, zi, yr[m2]);
        yi[m2] = MFMA(ca, zi, yi[m2]); yi[m2] = MFMA(sa, nzr, yi[m2]);
      }
    }
#pragma unroll
    for (int m2 = 0; m2 < 2; ++m2)
#pragma unroll
      for (int i = 0; i < 16; ++i) {
        int k1 = (mh * 2 + m2) * 32 + crow(i, h);
        float2 t = TW[k1 * l2];
        float a = yr[m2][i], bb = yi[m2][i];
        size_t o = ((size_t)(b * 512 + m) * 128 + k1) * 64 + l2;
        YR[o] = f2bf(a * t.x + bb * t.y);
        YI[o] = f2bf(bb * t.x - a * t.y);
      }
  }
}

DI void f1c_item(const DP& p, int item, int lane) {
  const int r = lane & 31, h = lane >> 5;
  const int mt = item & 15, kt = (item >> 4) & 7, b = item >> 7;
  const int m = mt * 32 + r;
  const bfr* ZRT = wsp<bfr>(p, OFF_ZRT) + (size_t)m * R + RL + b * CTX;
  const bfr* ZIT = wsp<bfr>(p, OFF_ZIT) + (size_t)m * R + RL + b * CTX;
  const bfr* C256 = wsp<bfr>(p, OFF_C256) + (kt * 32 + r) * 256;
  const bfr* S256 = wsp<bfr>(p, OFF_S256) + (kt * 32 + r) * 256;
  f32x16 acc = zero16();
#pragma unroll 4
  for (int kk = 0; kk < 16; ++kk) {
    int o = kk * 16 + 8 * h;
    acc = MFMA(*(const bf16x8*)(C256 + o), *(const bf16x8*)(ZRT + o), acc);
    acc = MFMA(*(const bf16x8*)(S256 + o), *(const bf16x8*)(ZIT + o), acc);
  }
  bfr* MIX = wsp<bfr>(p, OFF_MIX);
#pragma unroll
  for (int i = 0; i < 16; ++i)
    MIX[(size_t)(RL + b * CTX + kt * 32 + crow(i, h)) * 2048 + m] = f2bf(acc[i] * (1.f / 128.f));
}

DI void s1f1_phase(const DP& p) {
  const int lane = p.tidl & 63;
  const int wg = p.bidl * 4 + (p.tidl >> 6), nw = gridDim.x * 4;
  const int n_s1 = 2 * NCH * 2 * 24, n_f1 = 2048, n_f1c = 256;
#pragma unroll 1
  for (int it = wg; it < n_s1 + n_f1 + n_f1c; it += nw) {
    if (it < n_s1) s1_item(p, it, lane);
    else if (it < n_s1 + n_f1) f1_item(p, it - n_s1, lane);
    else f1c_item(p, it - n_s1 - n_f1, lane);
  }
}

DI void f2_item(const DP& p, int item, int lane) {
  const int r = lane & 31, h = lane >> 5;
  const int mt16 = item & 15, k1 = (item >> 4) & 127, b = item >> 11;
  const int m = mt16 * 32 + r;
  const bfr* YR = wsp<bfr>(p, OFF_YR) + ((size_t)(b * 512 + m) * 128 + k1) * 64;
  const bfr* YI = wsp<bfr>(p, OFF_YI) + ((size_t)(b * 512 + m) * 128 + k1) * 64;
  const bfr* C64 = wsp<bfr>(p, OFF_C64); const bfr* S64 = wsp<bfr>(p, OFF_S64);
  f32x16 acc[2]; acc[0] = zero16(); acc[1] = zero16();
#pragma unroll
  for (int kk = 0; kk < 4; ++kk) {
    bf16x8 yr = *(const bf16x8*)(YR + kk * 16 + 8 * h), yi = *(const bf16x8*)(YI + kk * 16 + 8 * h);
#pragma unroll
    for (int t = 0; t < 2; ++t) {
      bf16x8 ca = *(const bf16x8*)(C64 + (t * 32 + r) * 64 + kk * 16 + 8 * h);
      bf16x8 sa = *(const bf16x8*)(S64 + (t * 32 + r) * 64 + kk * 16 + 8 * h);
      acc[t] = MFMA(ca, yr, acc[t]); acc[t] = MFMA(sa, yi, acc[t]);
    }
  }
  bfr* MIX = wsp<bfr>(p, OFF_MIX);
  const float scale = 0.001381067932f;
#pragma unroll
  for (int t = 0; t < 2; ++t)
#pragma unroll
    for (int i = 0; i < 16; ++i) {
      int k2 = t * 32 + crow(i, h);
      MIX[(size_t)(b * SEQ + k1 + 128 * k2) * 2048 + m] = f2bf(acc[t][i] * scale);
    }
}

DI void s3_block(const DP& p, int j, int b, int c, int g, int half);

DI void s2f2_phase(const DP& p, int j) {
  if (p.bidl < 16) {
    const int k = p.bidl;
    s3_block(p, j, k >> 3, 0, (k >> 1) & 3, k & 1);
    return;
  }
  const int gt = (p.bidl - 16) * 256 + p.tidl, nt = ((int)gridDim.x - 16) * 256;
  bfr* HSb = wsp<bfr>(p, OFF_HS);
  const float* ACUM = wsp<float>(p, OFF_ACUM);
#pragma unroll 1
  for (int it = gt; it < 2 * 2 * 24 * 2048; it += nt) {
    const int e4 = it & 2047; const int rest = it >> 11; const int head = rest % 24, db = rest / 24, dir = db >> 1;
    bf16x4 sv[NCH]; float cd[NCH];
#pragma unroll
    for (int step = 0; step < NCH; ++step) {
      const int c = dir == 0 ? step : (step == 0 ? 0 : NCH - step);
      const size_t ci = (size_t)((db * NCH + c) * 24 + head);
      sv[step] = *(const bf16x4*)(HSb + ci * 8192 + e4 * 4);
      cd[step] = ACUM[ci * 256 + (dir == 0 ? 255 : 0)];
    }
    float h0 = 0.f, h1 = 0.f, h2 = 0.f, h3 = 0.f;
#pragma unroll
    for (int step = 0; step < NCH; ++step) {
      const int c = dir == 0 ? step : (step == 0 ? 0 : NCH - step);
      const size_t ci = (size_t)((db * NCH + c) * 24 + head);
      *(bf16x4*)(HSb + ci * 8192 + e4 * 4) = pack4(h0, h1, h2, h3);
      const float e = __expf(cd[step]);
      h0 = h0 * e + bfs(sv[step][0]); h1 = h1 * e + bfs(sv[step][1]); h2 = h2 * e + bfs(sv[step][2]); h3 = h3 * e + bfs(sv[step][3]);
    }
  }
  const int lane = p.tidl & 63;
  const int wg = (p.bidl - 16) * 4 + (p.tidl >> 6), nw = ((int)gridDim.x - 16) * 4;
#pragma unroll 1
  for (int it = wg; it < 4096; it += nw) f2_item(p, it, lane);
}

DI void s3_block(const DP& p, int j, int b, int c, int g, int half) {
  const int tid = p.tidl, lane = tid & 63, wid = tid >> 6, r = lane & 31, h = lane >> 5;
  const bfr* CN = wsp<bfr>(p, OFF_CN); const bfr* BN = wsp<bfr>(p, OFF_BN); const bfr* XT = wsp<bfr>(p, OFF_XT);
  const bfr* Z = wsp<bfr>(p, OFF_Z); bfr* MIX = wsp<bfr>(p, OFF_MIX);
  bfr* XTs = (bfr*)smem;
  bfr* HSF = (bfr*)(smem + 33792);
  bfr* HSB = (bfr*)(smem + 51200);
  float* LWF = (float*)(smem + 68608);
  float* LWB = LWF + 256;
  {
    const int row0 = chunk_row0(b, c);
    const int lt = half * 4 + wid;
    const int rowl = row0 + lt * 32 + r;
    const bfr* cfp = CN + (size_t)rowl * 512 + g * 128 + 8 * h;
    bf16x8 gtp[8][2];
    {
      bf16x8 cf[8];
#pragma unroll
      for (int kk = 0; kk < 8; ++kk) cf[kk] = *(const bf16x8*)(cfp + kk * 16);
#pragma unroll
      for (int k = 0; k < 8; ++k) { gtp[k][0] = cf[0]; gtp[k][1] = cf[0]; }
#pragma unroll 1
      for (int st = 0; st < 8; ++st) {
        f32x16 gt = zero16();
#pragma unroll
        for (int kk = 0; kk < 8; ++kk)
          gt = MFMA(*(const bf16x8*)(BN + (size_t)(row0 + st * 32 + r) * 512 + g * 128 + kk * 16 + 8 * h), cf[kk], gt);
#pragma unroll
        for (int k = 0; k < 7; ++k) { gtp[k][0] = gtp[k + 1][0]; gtp[k][1] = gtp[k + 1][1]; }
        gtp[7][0] = PACK_HALF(gt, 0); gtp[7][1] = PACK_HALF(gt, 1);
      }
    }
    float sumsq = 0.f;
#pragma unroll 1
    for (int hh = 0; hh < 6; ++hh) {
      const int head = g * 6 + hh;
      const size_t cif = (size_t)(((0 * 2 + b) * NCH + c) * 24 + head), cib = (size_t)(((1 * 2 + b) * NCH + c) * 24 + head);
      const float* acf = wsp<float>(p, OFF_ACUM) + cif * 256; const float* acb = wsp<float>(p, OFF_ACUM) + cib * 256;
      const float* dtf = wsp<float>(p, OFF_DTV) + cif * 256; const float* dtb = wsp<float>(p, OFF_DTV) + cib * 256;
      const bfr* HSf = wsp<bfr>(p, OFF_HS) + cif * 8192; const bfr* HSbk = wsp<bfr>(p, OFF_HS) + cib * 8192;
      __syncthreads();
#pragma unroll 4
      for (int i = 0; i < 8; ++i) {
        const int idx = tid + 256 * i, row = idx >> 5, c16 = idx & 31;
        *(bf16x8*)(XTs + row * 264 + c16 * 8) = *(const bf16x8*)(XT + (size_t)(head * 64 + row) * R + row0 + c16 * 8);
      }
      if (c != 0) {
#pragma unroll 2
        for (int i = 0; i < 4; ++i) {
          const int idx = tid + 256 * i, row = idx >> 4, c16 = idx & 15;
          *(bf16x8*)(HSF + row * 136 + c16 * 8) = *(const bf16x8*)(HSf + row * 128 + c16 * 8);
          *(bf16x8*)(HSB + row * 136 + c16 * 8) = *(const bf16x8*)(HSbk + row * 128 + c16 * 8);
        }
      }
      LWF[tid] = __logf(dtf[tid]) - acf[tid];
      LWB[tid] = __logf(dtb[tid]) - acb[tid];
      const float al_f = acf[lt * 32 + r], al_b = acb[lt * 32 + r];
      __syncthreads();
      f32x16 acc[2];
      acc[0] = zero16(); acc[1] = zero16();
      if (c != 0) {
        f32x16 t0 = zero16(), t1 = zero16();
#pragma unroll
        for (int kk = 0; kk < 8; ++kk) {
          const bf16x8 cfk = *(const bf16x8*)(cfp + kk * 16);
          t0 = MFMA(*(const bf16x8*)(HSF + (r) * 136 + kk * 16 + 8 * h), cfk, t0);
          t1 = MFMA(*(const bf16x8*)(HSF + (32 + r) * 136 + kk * 16 + 8 * h), cfk, t1);
        }
        const float ef = __expf(al_f);
#pragma unroll
        for (int i = 0; i < 16; ++i) { acc[0][i] = t0[i] * ef; acc[1][i] = t1[i] * ef; }
        t0 = zero16(); t1 = zero16();
#pragma unroll
        for (int kk = 0; kk < 8; ++kk) {
          const bf16x8 cfk = *(const bf16x8*)(cfp + kk * 16);
          t0 = MFMA(*(const bf16x8*)(HSB + (r) * 136 + kk * 16 + 8 * h), cfk, t0);
          t1 = MFMA(*(const bf16x8*)(HSB + (32 + r) * 136 + kk * 16 + 8 * h), cfk, t1);
        }
        const float eb = __expf(al_b);
#pragma unroll
        for (int i = 0; i < 16; ++i) { acc[0][i] += t0[i] * eb; acc[1][i] += t1[i] * eb; }
      }
#pragma unroll 1
      for (int st = 0; st < 8; ++st) {
        const bf16x8 g0 = gtp[0][0], g1 = gtp[0][1];
#pragma unroll
        for (int k = 0; k < 7; ++k) { gtp[k][0] = gtp[k + 1][0]; gtp[k][1] = gtp[k + 1][1]; }
        gtp[7][0] = g0; gtp[7][1] = g1;
#pragma unroll 1
        for (int dir = 0; dir < 2; ++dir) {
          if (dir == 0 ? (st > lt) : (st < lt)) continue;
          const float* lwd = dir == 0 ? LWF : LWB;
          const float al = dir == 0 ? al_f : al_b;
          f32x16 mm;
#pragma unroll
          for (int g4 = 0; g4 < 4; ++g4) {
            const int sb = st * 32 + 8 * g4 + 4 * h;
            const float4 l4 = *(const float4*)(lwd + sb);
            const float lv[4] = {l4.x, l4.y, l4.z, l4.w};
#pragma unroll
            for (int q = 0; q < 4; ++q) {
              const int i = 4 * g4 + q;
              const int sidx = sb + q, lidx = lt * 32 + r;
              const bool valid = dir == 0 ? (sidx <= lidx) : (sidx >= lidx);
              const float gv = bfs((i >> 3) ? g1[i & 7] : g0[i & 7]);
              const float e = __expf(fminf(al + lv[q], 30.f));
              mm[i] = valid ? gv * e : 0.f;
            }
          }
#pragma unroll
          for (int s2 = 0; s2 < 2; ++s2) {
            bf16x8 pf = PACK_HALF(mm, s2);
#pragma unroll
            for (int pt = 0; pt < 2; ++pt) {
              const bfr* xp = XTs + (pt * 32 + r) * 264 + st * 32 + 16 * s2 + 4 * h;
              bf16x8 xf = join44(*(const bf16x4*)xp, *(const bf16x4*)(xp + 8));
              acc[pt] = MFMA(xf, pf, acc[pt]);
            }
          }
        }
      }
      const float dsk = p.d_skip[j * 24 + head];
#pragma unroll
      for (int pt = 0; pt < 2; ++pt)
#pragma unroll
        for (int g4 = 0; g4 < 4; ++g4) {
          const int pb = pt * 32 + 8 * g4 + 4 * h;
          bf16x4 zv = *(const bf16x4*)(Z + (size_t)rowl * 1536 + head * 64 + pb);
          float y[4];
#pragma unroll
          for (int q = 0; q < 4; ++q) {
            float xv = bf2f(XTs[(pb + q) * 264 + lt * 32 + r]);
            float zz = bfs(zv[q]);
            float v = (acc[pt][4 * g4 + q] + dsk * xv) * (zz / (1.f + __expf(-zz)));
            sumsq += v * v; y[q] = v;
          }
          *(bf16x4*)(MIX + (size_t)rowl * 2048 + 512 + head * 64 + pb) = pack4(y[0], y[1], y[2], y[3]);
        }
    }
    const float tot = sumsq + __shfl_xor(sumsq, 32);
    const float sc = rsqrtf(tot * (1.f / 384.f) + 1e-6f);
    const float* ng = p.ssd_norm_g + (size_t)j * 1536;
#pragma unroll 1
    for (int hh = 0; hh < 6; ++hh) {
      const int head = g * 6 + hh;
#pragma unroll
      for (int pt = 0; pt < 2; ++pt)
#pragma unroll
        for (int g4 = 0; g4 < 4; ++g4) {
          const int pb = pt * 32 + 8 * g4 + 4 * h;
          bfr* mp = MIX + (size_t)rowl * 2048 + 512 + head * 64 + pb;
          bf16x4 yv = *(const bf16x4*)mp;
          float4 gg = *(const float4*)(ng + head * 64 + pb);
          *(bf16x4*)mp = pack4(bfs(yv[0]) * sc * gg.x, bfs(yv[1]) * sc * gg.y, bfs(yv[2]) * sc * gg.z, bfs(yv[3]) * sc * gg.w);
        }
    }
  }
}

DI void s3_phase(const DP& p, int j) {
#pragma unroll 1
  for (int idx = p.bidl; idx < 512; idx += (int)gridDim.x) {
    const int half = idx & 1, g = (idx >> 1) & 3, bcl = idx >> 3;
    s3_block(p, j, bcl >> 5, 1 + (bcl & 31), g, half);
  }
}

DI void qkprep_phase(const DP& p, int j) {
  const int lane = p.tidl & 63;
  const int wg = p.bidl * 4 + (p.tidl >> 6), nw = gridDim.x * 4;
  const bfr* P = wsp<bfr>(p, OFF_P); bfr* QK = wsp<bfr>(p, OFF_QK);
  const float* ROPE = wsp<float>(p, OFF_ROPE);
  const int sub = lane >> 3, d0 = (lane & 7) * 8;
  for (int row = wg; row < R; row += nw) {
#pragma unroll
    for (int ps = 0; ps < 4; ++ps) {
      const int hs = ps * 8 + sub;
      const bool act = hs < 26;
      const int hsc = act ? hs : 25;
      const int col = hsc < 10 ? hsc * 64 : 768 + (hsc - 10) * 64;
      bf16x8 xv = *(const bf16x8*)(P + (size_t)row * 2304 + col + d0);
      float x[8]; float ss = 0.f;
#pragma unroll
      for (int e = 0; e < 8; ++e) { x[e] = bfs(xv[e]); ss += x[e] * x[e]; }
      ss += __shfl_xor(ss, 1); ss += __shfl_xor(ss, 2); ss += __shfl_xor(ss, 4);
      const float rs = rsqrtf(ss * (1.f / 64.f) + 1e-6f);
      const float* gv = hsc < 8 ? p.q_norm_win + j * 64 : hsc < 10 ? p.k_norm_win + j * 64 : hsc < 18 ? p.q_norm_na + j * 64 : p.k_norm_na + j * 64;
#pragma unroll
      for (int e = 0; e < 8; ++e) x[e] = x[e] * rs * gv[d0 + e];
      float pr[8];
#pragma unroll
      for (int e = 0; e < 8; ++e) pr[e] = __shfl_xor(x[e], 2);
      if (hsc < 10 && row < RL) {
        const int pos = row & 8191;
        const int axis = d0 >> 5;
        const int idx = axis == 0 ? (pos >> 6) : (pos & 63);
        const int f0 = d0 & 15;
        const bool second = (d0 & 16) != 0;
        const float* cp = ROPE + (axis * 128 + idx) * 16 + f0;
        const float* sp = cp + 4096;
#pragma unroll
        for (int e = 0; e < 8; ++e) {
          float cs = cp[e], sn = sp[e];
          x[e] = second ? (x[e] * cs + pr[e] * sn) : (x[e] * cs - pr[e] * sn);
        }
      }
      const bool isq = hsc < 8 || (hsc >= 10 && hsc < 18);
      const float qs = isq ? 0.125f : 1.f;
      if (act) *(bf16x8*)(QK + (size_t)row * 1664 + hsc * 64 + d0) = pack8(x[0] * qs, x[1] * qs, x[2] * qs, x[3] * qs, x[4] * qs, x[5] * qs, x[6] * qs, x[7] * qs);
    }
  }
}

struct KVF { bf16x8 k[4]; bf16x8 v[2][2]; };
struct KVS { bf16x8 k[4]; bf16x8 v[4]; };

DI void kv_gload(KVS& g, const bfr* __restrict__ Kt, const bfr* __restrict__ Vt, int lane) {
#pragma unroll
  for (int i = 0; i < 4; ++i) {
    const int idx = lane + 64 * i;
    g.k[i] = *(const bf16x8*)(Kt + (size_t)(idx >> 3) * 1664 + (idx & 7) * 8);
    g.v[i] = *(const bf16x8*)(Vt + (size_t)(idx >> 2) * R + (idx & 3) * 8);
  }
}
DI void kv_sstore(const KVS& g, unsigned char* base, int lane) {
#pragma unroll
  for (int i = 0; i < 4; ++i) {
    const int idx = lane + 64 * i;
    { const int row = idx >> 3, c = idx & 7; *(bf16x8*)(base + row * 128 + ((c ^ (row & 7)) << 4)) = g.k[i]; }
    {
      const int d = idx >> 2, c16 = idx & 3, sw = (d >> 2) & 7;
      bf16x4 lo = __builtin_shufflevector(g.v[i], g.v[i], 0, 1, 2, 3), hi = __builtin_shufflevector(g.v[i], g.v[i], 4, 5, 6, 7);
      *(bf16x4*)(base + 4096 + d * 64 + (((2 * c16) ^ sw) << 3)) = lo;
      *(bf16x4*)(base + 4096 + d * 64 + (((2 * c16 + 1) ^ sw) << 3)) = hi;
    }
  }
}
DI void kv_sload(KVF& f, const unsigned char* base, int r, int h) {
#pragma unroll
  for (int kk = 0; kk < 4; ++kk) f.k[kk] = *(const bf16x8*)(base + r * 128 + (((2 * kk + h) ^ (r & 7)) << 4));
#pragma unroll
  for (int s2 = 0; s2 < 2; ++s2)
#pragma unroll
    for (int dt = 0; dt < 2; ++dt) {
      const int d = dt * 32 + r, sw = (d >> 2) & 7, c8 = 4 * s2 + h;
      const unsigned char* vb = base + 4096 + d * 64;
      f.v[s2][dt] = join44(*(const bf16x4*)(vb + ((c8 ^ sw) << 3)), *(const bf16x4*)(vb + (((c8 + 2) ^ sw) << 3)));
    }
}

DI void attn_compute(f32x16 (&o)[2], float& m, float& l, const unsigned char* qb, const unsigned char* base, int r, int h,
                     int mode, int a0, int a1, const float* __restrict__ rp) {
  f32x16 s = zero16();
#pragma unroll
  for (int kk = 0; kk < 4; ++kk) {
    const int off = r * 128 + (((2 * kk + h) ^ (r & 7)) << 4);
    s = MFMA(*(const bf16x8*)(base + off), *(const bf16x8*)(qb + off), s);
  }
  float tmax = -3.0e38f;
  if (mode == 1) {
#pragma unroll
    for (int i = 0; i < 16; ++i) { int dd = a0 - crow(i, h); dd = dd < 0 ? -dd : dd; s[i] = dd <= 128 ? s[i] : -1.0e30f; }
  } else if (mode == 2) {
#pragma unroll
    for (int i = 0; i < 16; ++i) {
      const int key = crow(i, h);
      const int rel = a0 + key;
      int co = a1 + key; co = co < 0 ? 0 : (co > 30 ? 30 : co);
      s[i] = (rel >= 0 && rel < 16) ? s[i] + rp[co] : -1.0e30f;
    }
  }
#pragma unroll
  for (int i = 0; i < 16; ++i) tmax = fmaxf(tmax, s[i]);
  tmax = fmaxf(tmax, __shfl_xor(tmax, 32));
  const float mn = fmaxf(m, tmax);
  const float alpha = __expf(m - mn);
  float ps = 0.f;
#pragma unroll
  for (int i = 0; i < 16; ++i) { s[i] = __expf(s[i] - mn); ps += s[i]; }
  l = l * alpha + ps; m = mn;
#pragma unroll
  for (int i = 0; i < 16; ++i) { o[0][i] *= alpha; o[1][i] *= alpha; }
#pragma unroll
  for (int s2 = 0; s2 < 2; ++s2) {
    bf16x8 pf = PACK_HALF(s, s2);
#pragma unroll
    for (int dt = 0; dt < 2; ++dt) {
      const int d = dt * 32 + r, sw = (d >> 2) & 7, c8 = 4 * s2 + h;
      const unsigned char* vb = base + 4096 + d * 64;
      bf16x8 vf = join44(*(const bf16x4*)(vb + ((c8 ^ sw) << 3)), *(const bf16x4*)(vb + (((c8 + 2) ^ sw) << 3)));
      o[dt] = MFMA(vf, pf, o[dt]);
    }
  }
}

DI void attn_item(const DP& p, int j, int item, int lane) {
  const int r = lane & 31, h = lane >> 5;
  const bfr* QK = wsp<bfr>(p, OFF_QK); const bfr* VT = wsp<bfr>(p, OFF_VT); bfr* MIX = wsp<bfr>(p, OFF_MIX);
  int kind, b, hd, qt;
  if (item < 4096) { kind = 0; qt = item & 255; hd = (item >> 8) & 7; b = item >> 11; }
  else if (item < 8192) { int v = item - 4096; kind = 1; qt = v & 255; hd = (v >> 8) & 7; b = v >> 11; }
  else if (item < 8320) { int v = item - 8192; kind = 2; qt = v & 7; hd = (v >> 3) & 7; b = v >> 6; }
  else { int v = item - 8320; kind = 3; qt = v & 7; hd = (v >> 3) & 7; b = v >> 6; }
  const bool win = (kind == 0 || kind == 2);
  const bool lat = kind < 2;
  const int q_row0 = lat ? b * SEQ + qt * 32 : RL + b * CTX + qt * 32;
  const int qcol = win ? hd * 64 : (10 + hd) * 64;
  const int kcol = win ? (8 + (hd >> 2)) * 64 : (18 + hd) * 64;
  const bfr* Vb = win ? VT + (size_t)((hd >> 2) * 64) * R : VT + (size_t)(128 + hd * 64) * R;
  const bfr* Kb = QK + kcol;
  f32x16 o[2]; o[0] = zero16(); o[1] = zero16();
  float m = -1.0e30f, l = 0.f;
  if (win) { m = p.sink_win[j * 8 + hd]; l = h == 0 ? 1.f : 0.f; }
  int nloc = 0, lo = 0, gr = 0, kr0 = 0, w = 0, cs = 0;
  const int qpos = qt * 32 + r;
  if (kind == 0) { lo = qt - 4 < 0 ? 0 : qt - 4; const int hi = qt + 4 > 255 ? 255 : qt + 4; nloc = hi - lo + 1; }
  else if (kind == 1) {
    gr = qt >> 1; w = (qt & 1) * 32 + r;
    cs = w - 8; cs = cs < 0 ? 0 : (cs > 48 ? 48 : cs);
    kr0 = gr - 4; kr0 = kr0 < 0 ? 0 : (kr0 > 120 ? 120 : kr0);
    nloc = 16;
  }
  const int ntile = 8 + nloc;
  const float* rpb = p.rpb_na + (size_t)j * 8 * 15 * 31 + hd * 15 * 31;
  auto tile_row = [&](int i) -> int {
    if (i < 8) return RL + b * CTX + i * 32;
    const int li = i - 8;
    if (kind == 0) return b * SEQ + (lo + li) * 32;
    return b * SEQ + (kr0 + (li >> 1)) * 64 + (li & 1) * 32;
  };
  unsigned char* lbase = smem + (p.tidl >> 6) * 12288;
  asm volatile("" ::: "memory");
#pragma unroll
  for (int i = 0; i < 4; ++i) {
    const int idx = lane + 64 * i, row = idx >> 3, c = idx & 7;
    *(bf16x8*)(lbase + 8192 + row * 128 + ((c ^ (row & 7)) << 4)) = *(const bf16x8*)(QK + (size_t)(q_row0 + row) * 1664 + qcol + c * 8);
  }
  KVS g;
  { const int k0 = tile_row(0); kv_gload(g, Kb + (size_t)k0 * 1664, Vb + k0, lane); }
  kv_sstore(g, lbase, lane);
#pragma unroll 1
  for (int i = 0; i < ntile; ++i) {
    { const int in = i + 1 < ntile ? i + 1 : i; const int k0 = tile_row(in); kv_gload(g, Kb + (size_t)k0 * 1664, Vb + k0, lane); }
    int mode = 0, a0 = 0, a1 = 0; const float* rp = rpb;
    if (i >= 8) {
      const int li = i - 8;
      if (kind == 0) { mode = 1; a0 = qpos - (lo + li) * 32; }
      else { mode = 2; const int krow = kr0 + (li >> 1); const int ub = (li & 1) * 32; a0 = ub - cs; a1 = ub - w + 15; rp = rpb + (krow - gr + 7) * 31; }
    }
    asm volatile("" ::: "memory");
    attn_compute(o, m, l, lbase + 8192, lbase, r, h, mode, a0, a1, rp);
    asm volatile("" ::: "memory");
    kv_sstore(g, lbase, lane);
  }
  asm volatile("" ::: "memory");
  const float lt = l + __shfl_xor(l, 32);
  const float inv = 1.f / lt;
  const int ocol = win ? hd * 64 : 512 + hd * 64;
#pragma unroll
  for (int dt = 0; dt < 2; ++dt)
#pragma unroll
    for (int g4 = 0; g4 < 4; ++g4) {
      const int d = dt * 32 + 8 * g4 + 4 * h;
      *(bf16x4*)(MIX + (size_t)(q_row0 + r) * 1024 + ocol + d) =
          pack4(o[dt][4 * g4] * inv, o[dt][4 * g4 + 1] * inv, o[dt][4 * g4 + 2] * inv, o[dt][4 * g4 + 3] * inv);
    }
}

DI void attn_phase(const DP& p, int j) {
  const int lane = p.tidl & 63;
  const int wg = p.bidl * 4 + (p.tidl >> 6), nw = gridDim.x * 4;
#pragma unroll 1
  for (int it = wg; it < 8448; it += nw) attn_item(p, j, it, lane);
}

#define XB_TMO      128
#define XB_XCNT(j)  (256  + 64 * (j))
#define XB_XSUB(j)  (1280 + 64 * (j))
#define XB_XGEN(j)  (2304 + 64 * (j))
#define XB_TOP      3328
#define XB_TOPGEN   3392
#define XCD_BAR_WORDS 3456
#define XB_SPIN_CAP (1u << 18)
#define LAS __attribute__((address_space(3)))

__device__ __forceinline__ unsigned xb_ld(unsigned* p)              { return __hip_atomic_load(p, __ATOMIC_RELAXED, __HIP_MEMORY_SCOPE_AGENT); }
__device__ __forceinline__ unsigned xb_add(unsigned* p, unsigned v) { return __hip_atomic_fetch_add(p, v, __ATOMIC_RELAXED, __HIP_MEMORY_SCOPE_AGENT); }
__device__ __forceinline__ unsigned xb_xcc_id() { return (unsigned)__builtin_amdgcn_s_getreg((3 << 11) | 20) & 0xFu; }
#define XB_SPIN(cond, bar) do { unsigned _sp = 0; while (cond) { __builtin_amdgcn_s_sleep(1); \
    if ((++_sp & 255u) == 0u) { if (xb_ld(&(bar)[XB_TMO])) break; if (_sp > XB_SPIN_CAP) { atomicAdd(&(bar)[XB_TMO], 1u); break; } } } } while (0)

struct XcdBarrier {
    unsigned* bar; unsigned x;
    volatile LAS unsigned* st;
};

__device__ __forceinline__ XcdBarrier xcd_barrier_post(unsigned* bar, volatile LAS unsigned* st) {
    XcdBarrier b; b.bar = bar; b.x = xb_xcc_id(); b.st = st;
    if (threadIdx.x == 0) (void)xb_add(&bar[XB_XCNT(b.x)], 1u);
    return b;
}
__device__ __forceinline__ void xcd_barrier_complete(unsigned* bar, unsigned x, unsigned& nloc, unsigned& nx) {
    const unsigned G = gridDim.x * gridDim.y * gridDim.z;
    unsigned sum, cnt, mine, sp = 0u;
    for (;;) {
        sum = 0u; cnt = 0u; mine = 0u;
#pragma unroll
        for (unsigned j = 0; j < 16; ++j) { const unsigned c = xb_ld(&bar[XB_XCNT(j)]); sum += c; cnt += (c > 0u) ? 1u : 0u; mine = (j == x) ? c : mine; }
        if (sum == G) break;
        __builtin_amdgcn_s_sleep(1);
        if ((++sp & 255u) == 0u) { if (xb_ld(&bar[XB_TMO])) break; if (sp > XB_SPIN_CAP) { atomicAdd(&bar[XB_TMO], 1u); break; } }
    }
    nloc = mine > 0u ? mine : 1u; nx = cnt > 0u ? cnt : 1u;
}

__device__ __forceinline__ void xcd_barrier(const XcdBarrier& b) {
    asm volatile("s_waitcnt vmcnt(0)" ::: "memory");
    __syncthreads();
    if (threadIdx.x == 0) {
        unsigned* bar = b.bar;
        __builtin_amdgcn_s_waitcnt(0);
        unsigned nloc = b.st[0], nx = b.st[1];
        if (nloc == 0u) { xcd_barrier_complete(bar, b.x, nloc, nx); b.st[0] = nloc; b.st[1] = nx; }
        const unsigned old = xb_add(&bar[XB_XSUB(b.x)], 1u);
        const unsigned gen = old / nloc;
        if (old + 1u == (gen + 1u) * nloc) {
            __builtin_amdgcn_fence(__ATOMIC_RELEASE, "agent");
            asm volatile("s_waitcnt vmcnt(0)" ::: "memory");
            const unsigned og = xb_add(&bar[XB_TOP], 1u);
            const unsigned tg = og / nx;
            if (og + 1u == (tg + 1u) * nx) xb_add(&bar[XB_TOPGEN], 1u);
            else XB_SPIN(xb_ld(&bar[XB_TOPGEN]) == tg, bar);
            __builtin_amdgcn_fence(__ATOMIC_ACQUIRE, "agent");
            xb_add(&bar[XB_XGEN(b.x)], 1u);
            asm volatile("s_waitcnt vmcnt(0)" ::: "memory");
        } else {
            XB_SPIN(xb_ld(&bar[XB_XGEN(b.x)]) == gen, bar);
            __builtin_amdgcn_fence(__ATOMIC_ACQUIRE, "agent");
            asm volatile("s_waitcnt vmcnt(0)" ::: "memory");
        }
    }
    __syncthreads();
}


DI void run_phase(const DP& p, int ph, int dry) {
  if (ph == 0) { phase0(p); wconv_phase(p, 0); return; }
  int q = ph - 1, layer, lp;
  if (q < 10) { layer = 0; lp = q; } else if (q < 18) { layer = 1; lp = q - 10; } else if (q < 28) { layer = 2; lp = q - 18; } else { layer = 3; lp = q - 28; }
  const int j = layer >> 1;
  const bool even = (layer & 1) == 0;
  int op, gsel = 0;
  if (even) {
    op = (int)((0x2272654321ull >> (4 * lp)) & 15ull); gsel = (int)((0x3201000000ull >> (4 * lp)) & 15ull);
  } else {
    op = (int)((0x22729821ull >> (4 * lp)) & 15ull); gsel = (int)((0x32010000ull >> (4 * lp)) & 15ull);
  }
  if (op == 1 && layer != 0) wconv_phase(p, layer);
  if (op == 1 || op == 7) {
    const bool first = op == 1;
    norm_phase(p, layer, (first ? p.norm_mix_g : p.norm_ff_g) + layer * 1024, first ? 0 : 3, first ? 1 : 4);
  } else if (op == 2) {
    int mode, lda, N, K, gch; size_t offA, offB;
    if (gsel == 0) { mode = even ? EPI_EVEN_IN : EPI_ODD_IN; offA = OFF_MIX; lda = 1024; offB = OFF_WIN; N = even ? 5168 : 2304; K = 1024; gch = 0; }
    else if (gsel == 1) { mode = EPI_RESID; offA = OFF_MIX; lda = even ? 2048 : 1024; offB = OFF_WOUT; N = 1024; K = even ? 2048 : 1024; gch = 2; }
    else if (gsel == 2) { mode = EPI_RELU2; offA = OFF_MIX; lda = 1024; offB = OFF_WFF1; N = 4096; K = 1024; gch = 0; }
    else { mode = EPI_RESID; offA = OFF_ACT; lda = 4096; offB = OFF_WFF2; N = 1024; K = 4096; gch = 5; }
    if (dry && mode == EPI_RESID) mode = 4;
    gemm_phase(p, mode, wsp<bfr>(p, offA), lda, wsp<bfr>(p, offB), N, K, layer, gch);
  } else if (op == 3) conv_dt_phase(p, j);
  else if (op == 4) s1f1_phase(p);
  else if (op == 5) s2f2_phase(p, j);
  else if (op == 6) s3_phase(p, j);
  else if (op == 8) qkprep_phase(p, j);
  else if (op == 9) attn_phase(p, j);
}

DI int probe_reps(int ph) {
#ifdef PROBE_MASK
  if (ph == 0) return (PROBE_MASK & 1) ? 2 : 1;
  int q = ph - 1, layer, lp;
  if (q < 10) { layer = 0; lp = q; } else if (q < 18) { layer = 1; lp = q - 10; } else if (q < 28) { layer = 2; lp = q - 18; } else { layer = 3; lp = q - 28; }
  const bool even = (layer & 1) == 0;
  int op, gsel;
  if (even) { op = (int)((0x2272654321ull >> (4 * lp)) & 15ull); gsel = (int)((0x3201000000ull >> (4 * lp)) & 15ull); }
  else { op = (int)((0x22729821ull >> (4 * lp)) & 15ull); gsel = (int)((0x32010000ull >> (4 * lp)) & 15ull); }
  if (op == 5) return 1;
  if (op == 2 && (gsel == 1 || gsel == 3)) return ((PROBE_MASK >> 10) & 1) ? 2 : 1;
  return ((PROBE_MASK >> op) & 1) ? 2 : 1;
#else
  return 1;
#endif
}

__shared__ uint4 xb_words;

__global__ void __launch_bounds__(256, 2) mega(Params p, int ph0, int ph1) {
  cg::grid_group grid = cg::this_grid();
  if (threadIdx.x == 0) xb_words = make_uint4(0u, 0u, 0u, 0u);
  __syncthreads();
  XcdBarrier xb = xcd_barrier_post((unsigned*)(p.ws + OFF_BAR), (volatile LAS unsigned*)&xb_words);
#pragma unroll 1
  for (int ph = ph0; ph < ph1; ++ph) {
    const int nrep = probe_reps(ph);
#pragma unroll 1
    for (int rep = 0; rep < nrep; ++rep) {
      DP q;
      (Params&)q = p;
      int t = threadIdx.x, bb = blockIdx.x;
      asm volatile("" : "+v"(t));
      asm volatile("" : "+s"(bb));
      int z0;
      asm volatile("s_mov_b32 %0, 0" : "=s"(z0));
      q.ws = p.ws + z0;
      q.out = p.out + z0;
      q.tidl = t; q.bidl = bb;
      run_phase(q, ph, rep + 1 < nrep);
    }
    if (ph + 1 < ph1) {
      if (ph == ph0) grid.sync();
      else xcd_barrier(xb);
    }
  }
}

extern "C" void kernel_launch(void* const* d_in, const int* in_sizes, int n_in, void* d_out, int out_size, void* d_ws,
                              size_t ws_size, hipStream_t stream) {
  static int grid_blocks = 0;
  if (!grid_blocks) {
    int dev = 0, cus = 0, per_cu = 0;
    hipGetDevice(&dev);
    hipDeviceGetAttribute(&cus, hipDeviceAttributeMultiprocessorCount, dev);
    hipOccupancyMaxActiveBlocksPerMultiprocessor(&per_cu, mega, 256, 0);
    if (per_cu > 2) per_cu = 2;
    if (per_cu < 1) per_cu = 1;
    grid_blocks = cus * per_cu;
  }
  Params p{};
  const float** pp = (const float**)&p;
  for (int i = 0; i < 26; ++i) pp[i] = (const float*)d_in[i];
  p.out = (float*)d_out;
  p.ws = (unsigned char*)d_ws;
  if (ws_size < WS_TOTAL) fprintf(stderr, "workspace too small: %zu < %zu\n", ws_size, (size_t)WS_TOTAL);
  hipMemsetAsync((unsigned char*)d_ws + OFF_BAR, 0, XCD_BAR_WORDS * 4, stream);
#if MULTI_LAUNCH
  for (int ph = 0; ph < NPHASE; ++ph) {
    int a = ph, b = ph + 1;
    void* args[] = {&p, &a, &b};
    hipLaunchCooperativeKernel((void*)mega, dim3(grid_blocks), dim3(256), args, 0, stream);
  }
#else
  int a = 0, b = NPHASE;
  void* args[] = {&p, &a, &b};
  hipError_t e = hipLaunchCooperativeKernel((void*)mega, dim3(grid_blocks), dim3(256), args, 0, stream);
  if (e != hipSuccess) fprintf(stderr, "cooperative launch failed: %s (grid %d)\n", hipGetErrorString(e), grid_blocks);
#endif
}
```

```cpp
#include <hip/hip_runtime.h>
#include <hip/hip_cooperative_groups.h>
#include <cstdio>
namespace cg = cooperative_groups;

typedef unsigned short bfr;
typedef __attribute__((ext_vector_type(8))) short bf16x8;
typedef __attribute__((ext_vector_type(4))) short bf16x4;
typedef __attribute__((ext_vector_type(16))) float f32x16;
#define DI __device__ __forceinline__
#define MFMA(a, b, c) __builtin_amdgcn_mfma_f32_32x32x16_bf16((a), (b), (c), 0, 0, 0)

#ifndef MULTI_LAUNCH
#define MULTI_LAUNCH 0
#endif

constexpr int RL = 16384, R = 16896, SEQ = 8192, CTX = 256;
constexpr int NCH = 33, CL = 256;
constexpr int NPHASE = 37;

constexpr size_t al(size_t x) { return (x + 255) & ~size_t(255); }
constexpr size_t OFF_HC = 0;
constexpr size_t OFF_MOD = OFF_HC + al(512 * 1024 * 4);
constexpr size_t OFF_TW = OFF_MOD + al(4 * 3 * 6144 * 4);
constexpr size_t OFF_C128 = OFF_TW + al(8192 * 8);
constexpr size_t OFF_S128 = OFF_C128 + al(128 * 128 * 2);
constexpr size_t OFF_C64 = OFF_S128 + al(128 * 128 * 2);
constexpr size_t OFF_S64 = OFF_C64 + al(64 * 64 * 2);
constexpr size_t OFF_C256 = OFF_S64 + al(64 * 64 * 2);
constexpr size_t OFF_S256 = OFF_C256 + al(256 * 256 * 2);
constexpr size_t OFF_ROPE = OFF_S256 + al(256 * 256 * 2);
constexpr size_t OFF_DTV = OFF_ROPE + al(2 * 2 * 128 * 16 * 4);
constexpr size_t DT_BYTES = (size_t)2 * 2 * NCH * 24 * 256 * 4;
constexpr size_t OFF_ACUM = OFF_DTV + al(DT_BYTES);
constexpr size_t OFF_WIN = OFF_ACUM + al(DT_BYTES);
constexpr size_t OFF_WOUT = OFF_WIN + al((size_t)5248 * 1024 * 2);
constexpr size_t OFF_WFF1 = OFF_WOUT + al((size_t)1024 * 2048 * 2);
constexpr size_t OFF_WFF2 = OFF_WFF1 + al((size_t)4096 * 1024 * 2);
constexpr size_t OFF_MIX = OFF_WFF2 + al((size_t)4096 * 1024 * 2);
constexpr size_t OFF_BIG = OFF_MIX + al((size_t)R * 2048 * 2);
constexpr size_t OFF_Z = OFF_BIG;
constexpr size_t OFF_ZRT = OFF_Z + (size_t)R * 1536 * 2;
constexpr size_t OFF_ZIT = OFF_ZRT + (size_t)512 * R * 2;
constexpr size_t OFF_XBC = OFF_ZIT + (size_t)512 * R * 2;
constexpr size_t OFF_DTRAW = OFF_XBC + (size_t)R * 2560 * 2;
constexpr size_t BIG_END = OFF_DTRAW + (size_t)R * 48 * 4;
constexpr size_t OFF_HS = OFF_XBC;
constexpr size_t HS_BYTES = (size_t)2 * 2 * NCH * 24 * 8192 * 2;
constexpr size_t OFF_YR = OFF_HS + HS_BYTES;
constexpr size_t OFF_YI = OFF_YR + (size_t)2 * 512 * 128 * 64 * 2;
static_assert(OFF_YI + (size_t)2 * 512 * 128 * 64 * 2 <= OFF_DTRAW, "fft scratch overflows");
constexpr size_t OFF_ACT = OFF_BIG;
static_assert((size_t)R * 4096 * 2 <= BIG_END - OFF_BIG, "act overflows");
constexpr size_t OFF_P = OFF_BIG;
constexpr size_t OFF_VT = OFF_P + (size_t)R * 2304 * 2;
constexpr size_t OFF_QK = OFF_VT + (size_t)640 * R * 2;
static_assert(OFF_QK + (size_t)R * 1664 * 2 <= BIG_END, "odd overflows");
constexpr size_t OFF_XT = al(BIG_END);
constexpr size_t OFF_BN = OFF_XT + (size_t)1536 * R * 2;
constexpr size_t OFF_BT = OFF_BN + (size_t)R * 512 * 2;
constexpr size_t OFF_CN = OFF_BT + (size_t)512 * R * 2;
constexpr size_t OFF_BAR = al(OFF_CN + (size_t)R * 512 * 2);
constexpr size_t WS_TOTAL = OFF_BAR + 16384;
static_assert(WS_TOTAL <= 402653184ull, "workspace too large");

struct Params {
  const float *x, *c, *ctx, *c_ctx, *w_mod, *b_mod, *norm_mix_g, *norm_ff_g, *w_ff1, *w_ff2;
  const float *w_in_even, *conv_w, *conv_b, *dt_bias, *a_log, *d_skip, *ssd_norm_g, *w_out_even;
  const float *w_in_odd, *q_norm_win, *k_norm_win, *sink_win, *q_norm_na, *k_norm_na, *rpb_na, *w_out_odd;
  float* out;
  unsigned char* ws;
};

struct DP : Params { int tidl, bidl; };

__shared__ __attribute__((aligned(16))) unsigned char smem[73728];

DI bfr f2bf(float x) { unsigned u = __float_as_uint(x); u += 0x7fffu + ((u >> 16) & 1u); return (bfr)(u >> 16); }
DI float bf2f(bfr b) { return __uint_as_float(((unsigned)b) << 16); }
DI float bfs(short s) { return __uint_as_float(((unsigned)(unsigned short)s) << 16); }
DI int crow(int i, int h) { return (i & 3) + 8 * (i >> 2) + 4 * h; }
DI f32x16 zero16() { f32x16 z; for (int i = 0; i < 16; ++i) z[i] = 0.f; return z; }
DI bf16x8 pack8(float a0, float a1, float a2, float a3, float a4, float a5, float a6, float a7) {
  bf16x8 v;
  v[0] = (short)f2bf(a0); v[1] = (short)f2bf(a1); v[2] = (short)f2bf(a2); v[3] = (short)f2bf(a3);
  v[4] = (short)f2bf(a4); v[5] = (short)f2bf(a5); v[6] = (short)f2bf(a6); v[7] = (short)f2bf(a7);
  return v;
}
DI bf16x4 pack4(float a0, float a1, float a2, float a3) {
  bf16x4 v; v[0] = (short)f2bf(a0); v[1] = (short)f2bf(a1); v[2] = (short)f2bf(a2); v[3] = (short)f2bf(a3); return v;
}
#define PACK_HALF(s, s2) pack8(s[8 * (s2)], s[8 * (s2) + 1], s[8 * (s2) + 2], s[8 * (s2) + 3], s[8 * (s2) + 4], s[8 * (s2) + 5], s[8 * (s2) + 6], s[8 * (s2) + 7])
DI bf16x8 join44(bf16x4 lo, bf16x4 hi) { return __builtin_shufflevector(lo, hi, 0, 1, 2, 3, 4, 5, 6, 7); }
DI int chunk_row0(int b, int c) { return c == 0 ? RL + b * CTX : b * SEQ + (c - 1) * CL; }

DI void sincos_turn(double f, float& s, float& c) {
  f -= rint(f);
  double x = f * 6.283185307179586476925;
  double x2 = x * x, ss = 1.0, cc = 1.0;
#pragma unroll
  for (int k = 13; k >= 1; --k) {
    ss = 1.0 - x2 / (double)((2 * k) * (2 * k + 1)) * ss;
    cc = 1.0 - x2 / (double)((2 * k - 1) * (2 * k)) * cc;
  }
  s = (float)(x * ss); c = (float)cc;
}

template <class T> DI T* wsp(const DP& p, size_t off) { return (T*)(p.ws + off); }

DI void phase0(const DP& p) {
  const int tid = p.tidl, bid = p.bidl, G = gridDim.x;
  float* lds = (float*)smem;
  float* MOD = wsp<float>(p, OFF_MOD);
  for (int u = bid; u < 384; u += G) {
    int layer = u / 96, cb = u % 96;
    for (int i = tid; i < 3072; i += 256) {
      int v = i >> 10, k = i & 1023;
      float c = v < 2 ? p.c[v * 1024 + k] : p.c_ctx[k];
      lds[i] = c / (1.f + expf(-c));
    }
    __syncthreads();
    int kq = tid >> 6, cc = tid & 63, col = cb * 64 + cc;
    const float* w = p.w_mod + (size_t)layer * 1024 * 6144 + col;
    float a0 = 0, a1 = 0, a2 = 0;
    for (int k = kq * 256; k < kq * 256 + 256; ++k) {
      float wv = w[(size_t)k * 6144];
      a0 += lds[k] * wv; a1 += lds[1024 + k] * wv; a2 += lds[2048 + k] * wv;
    }
    float* red = lds + 3072;
    red[(kq * 3 + 0) * 64 + cc] = a0; red[(kq * 3 + 1) * 64 + cc] = a1; red[(kq * 3 + 2) * 64 + cc] = a2;
    __syncthreads();
    if (tid < 192) {
      int v = tid >> 6;
      float s = red[(0 * 3 + v) * 64 + cc] + red[(1 * 3 + v) * 64 + cc] + red[(2 * 3 + v) * 64 + cc] + red[(3 * 3 + v) * 64 + cc];
      MOD[(layer * 3 + v) * 6144 + col] = s + p.b_mod[layer * 6144 + col];
    }
    __syncthreads();
  }
  const int gt = bid * 256 + tid, nt = G * 256;
  {
    const float4* xs = (const float4*)p.x; float4* od = (float4*)p.out;
    for (int i = gt; i < RL * 256; i += nt) od[i] = xs[i];
    const float4* cs = (const float4*)p.ctx; float4* hd = wsp<float4>(p, OFF_HC);
    for (int i = gt; i < 512 * 256; i += nt) hd[i] = cs[i];
  }
  float2* TW = wsp<float2>(p, OFF_TW);
  for (int i = gt; i < 8192; i += nt) { float s, c; sincos_turn((double)i / 8192.0, s, c); TW[i] = make_float2(c, s); }
  bfr* C128 = wsp<bfr>(p, OFF_C128); bfr* S128 = wsp<bfr>(p, OFF_S128);
  for (int i = gt; i < 128 * 128; i += nt) { int a = i >> 7, b = i & 127; float s, c; sincos_turn((double)((a * b) & 127) / 128.0, s, c); C128[i] = f2bf(c); S128[i] = f2bf(s); }
  bfr* C64 = wsp<bfr>(p, OFF_C64); bfr* S64 = wsp<bfr>(p, OFF_S64);
  for (int i = gt; i < 64 * 64; i += nt) { int a = i >> 6, b = i & 63; float s, c; sincos_turn((double)((a * b) & 63) / 64.0, s, c); C64[i] = f2bf(c); S64[i] = f2bf(s); }
  bfr* C256 = wsp<bfr>(p, OFF_C256); bfr* S256 = wsp<bfr>(p, OFF_S256);
  for (int i = gt; i < 256 * 256; i += nt) { int a = i >> 8, b = i & 255; float s, c; sincos_turn((double)((a * b) & 255) / 256.0, s, c); C256[i] = f2bf(c); S256[i] = f2bf(s); }
  float* ROPE = wsp<float>(p, OFF_ROPE);
  for (int i = gt; i < 2 * 128 * 16; i += nt) {
    int f = i & 15, idx = (i >> 4) & 127;
    float ang = (float)idx * (float)exp(-(double)f * 0.5756462732485115);
    float s, c; sincos_turn((double)ang / 6.283185307179586476925, s, c);
    ROPE[i] = c; ROPE[4096 + i] = s;
  }
}

DI void tcvt_unit(const float* __restrict__ src, int ld, int c0, int ncols, int K, bfr* __restrict__ dst, int dr0, int u, int tid) {
  const int ntk = K >> 6;
  const int tn = u / ntk, tk = u % ntk, k0 = tk * 64, nb = tn * 64;
  bfr* T = (bfr*)smem;
  float4 v[4];
  const int n4 = (tid & 15) * 4;
#pragma unroll
  for (int i = 0; i < 4; ++i) {
    const int kk = (tid >> 4) + 16 * i;
    v[i] = make_float4(0.f, 0.f, 0.f, 0.f);
    if (nb + n4 < ncols) v[i] = *(const float4*)(src + (size_t)(k0 + kk) * ld + c0 + nb + n4);
  }
#pragma unroll
  for (int i = 0; i < 4; ++i) {
    const int kk = (tid >> 4) + 16 * i;
    T[(n4 + 0) * 72 + kk] = f2bf(v[i].x); T[(n4 + 1) * 72 + kk] = f2bf(v[i].y);
    T[(n4 + 2) * 72 + kk] = f2bf(v[i].z); T[(n4 + 3) * 72 + kk] = f2bf(v[i].w);
  }
  __syncthreads();
  {
    int n = tid >> 2, kseg = (tid & 3) * 16;
    if (nb + n < ncols) {
      bfr* d = dst + (size_t)(dr0 + nb + n) * K + k0 + kseg;
      *(bf16x8*)d = *(const bf16x8*)(T + n * 72 + kseg);
      *(bf16x8*)(d + 8) = *(const bf16x8*)(T + n * 72 + kseg + 8);
    }
  }
  __syncthreads();
}

DI void wconv_phase(const DP& p, int layer) {
  const int tid = p.tidl;
  const int j = layer >> 1;
  bfr* WIN = wsp<bfr>(p, OFF_WIN); bfr* WOUT = wsp<bfr>(p, OFF_WOUT);
  bfr* WFF1 = wsp<bfr>(p, OFF_WFF1); bfr* WFF2 = wsp<bfr>(p, OFF_WFF2);
  const float* ff1 = p.w_ff1 + (size_t)layer * 1024 * 4096;
  const float* ff2 = p.w_ff2 + (size_t)layer * 4096 * 1024;
  float* cst = (float*)(smem + 20480);
  if (tid < 64) { float s, c; sincos_turn((double)tid / 64.0, s, c); cst[tid] = c; cst[64 + tid] = s; }
  __syncthreads();
  if ((layer & 1) == 0) {
    const float* win = p.w_in_even + (size_t)j * 1024 * 4656;
    const float* wout = p.w_out_even + (size_t)j * 2048 * 1024;
    const int n_in = 65 * 16, n_out = 16 * 32, n_f1 = 64 * 16, n_f2 = 16 * 64, n_fold = 128;
    const int total = n_in + n_out + n_f1 + n_f2 + n_fold;
    for (int u = p.bidl; u < total; u += gridDim.x) {
      int v = u;
      if (v < n_in) { tcvt_unit(win, 4656, 512, 4144, 1024, WIN, 1024, v, tid); continue; }
      v -= n_in;
      if (v < n_out) { tcvt_unit(wout, 1024, 0, 1024, 2048, WOUT, 0, v, tid); continue; }
      v -= n_out;
      if (v < n_f1) { tcvt_unit(ff1, 4096, 0, 4096, 1024, WFF1, 0, v, tid); continue; }
      v -= n_f1;
      if (v < n_f2) { tcvt_unit(ff2, 1024, 0, 1024, 4096, WFF2, 0, v, tid); continue; }
      v -= n_f2;
      {
        const int g = v >> 4, kb = v & 15;
        float* wt = (float*)smem;
#pragma unroll
        for (int i = 0; i < 4; ++i) {
          const int idx = tid + 256 * i, kk = idx >> 4, j4 = (idx & 15) * 4;
          const float4 wv = *(const float4*)(win + (size_t)(kb * 64 + kk) * 4656 + g * 64 + j4);
          wt[kk * 65 + j4] = wv.x; wt[kk * 65 + j4 + 1] = wv.y; wt[kk * 65 + j4 + 2] = wv.z; wt[kk * 65 + j4 + 3] = wv.w;
        }
        __syncthreads();
        const int kl = tid & 63, mg = tid >> 6;
#pragma unroll 1
        for (int mi = 0; mi < 16; ++mi) {
          const int m = mg * 16 + mi;
          float sc = 0.f, ss = 0.f;
#pragma unroll 8
          for (int jj = 0; jj < 64; ++jj) { const float w = wt[kl * 65 + jj]; const int idx = (m * jj) & 63; sc += w * cst[idx]; ss += w * cst[64 + idx]; }
          const int ch = g * 64 + m, k = kb * 64 + kl;
          WIN[(size_t)ch * 1024 + k] = f2bf(sc);
          WIN[(size_t)(512 + ch) * 1024 + k] = f2bf(-ss);
        }
        __syncthreads();
      }
    }
  } else {
    const float* win = p.w_in_odd + (size_t)j * 1024 * 2304;
    const float* wout = p.w_out_odd + (size_t)j * 1024 * 1024;
    const int n_in = 36 * 16, n_out = 16 * 16, n_f1 = 64 * 16, n_f2 = 16 * 64;
    const int total = n_in + n_out + n_f1 + n_f2;
    for (int u = p.bidl; u < total; u += gridDim.x) {
      int v = u;
      if (v < n_in) { tcvt_unit(win, 2304, 0, 2304, 1024, WIN, 0, v, tid); continue; }
      v -= n_in;
      if (v < n_out) { tcvt_unit(wout, 1024, 0, 1024, 1024, WOUT, 0, v, tid); continue; }
      v -= n_out;
      if (v < n_f1) { tcvt_unit(ff1, 4096, 0, 4096, 1024, WFF1, 0, v, tid); continue; }
      v -= n_f1;
      tcvt_unit(ff2, 1024, 0, 1024, 4096, WFF2, 0, v, tid);
    }
  }
}

DI void norm_phase(const DP& p, int layer, const float* __restrict__ gvec, int shc, int scc) {
  const int lane = p.tidl & 63;
  const int wg = p.bidl * 4 + (p.tidl >> 6), nw = gridDim.x * 4;
  const float* MOD = wsp<float>(p, OFF_MOD);
  const float* HC = wsp<float>(p, OFF_HC);
  bfr* U = wsp<bfr>(p, OFF_MIX);
  for (int row = wg; row < R; row += nw) {
    const float* hp = row < RL ? p.out + (size_t)row * 1024 : HC + (size_t)(row - RL) * 1024;
    const int ms = row < RL ? (row >> 13) : 2;
    const float* md = MOD + (layer * 3 + ms) * 6144;
    float4 v[4]; float ss = 0.f;
#pragma unroll
    for (int i = 0; i < 4; ++i) {
      v[i] = *(const float4*)(hp + i * 256 + lane * 4);
      ss += v[i].x * v[i].x + v[i].y * v[i].y + v[i].z * v[i].z + v[i].w * v[i].w;
    }
#pragma unroll
    for (int o = 32; o >= 1; o >>= 1) ss += __shfl_xor(ss, o);
    const float rs = rsqrtf(ss * (1.f / 1024.f) + 1e-6f);
#pragma unroll
    for (int i = 0; i < 4; ++i) {
      int col = i * 256 + lane * 4;
      float4 g = *(const float4*)(gvec + col);
      float4 sc = *(const float4*)(md + scc * 1024 + col);
      float4 sh = *(const float4*)(md + shc * 1024 + col);
      bf16x4 o = pack4(v[i].x * rs * g.x * (1.f + sc.x) + sh.x, v[i].y * rs * g.y * (1.f + sc.y) + sh.y,
                       v[i].z * rs * g.z * (1.f + sc.z) + sh.z, v[i].w * rs * g.w * (1.f + sc.w) + sh.w);
      *(bf16x4*)(U + (size_t)row * 1024 + col) = o;
    }
  }
}

enum { EPI_EVEN_IN = 0, EPI_ODD_IN = 1, EPI_RELU2 = 2, EPI_RESID = 3 };

DI void gemm_phase(const DP& p, int mode, const bfr* __restrict__ A, int lda, const bfr* __restrict__ Bt,
                   int N, int K, int layer, int gchunk, int nM) {
  const int tid = p.tidl, lane = tid & 63, wid = tid >> 6, r = lane & 31, h = lane >> 5;
  const int wm = wid >> 1, wn = wid & 1;
  const int nN = (N + 127) >> 7;
  const int tiles = nM * nN, G = (int)gridDim.x;
  int full = tiles, tail = 0, St = 1;
  if (mode == EPI_RESID) {
    full = (tiles / G) * G; tail = tiles - full;
    if (tail > 0) { int c = G / tail; int kmax = K >> 7; St = 1; while (St * 2 <= c && St * 2 <= 16 && St * 2 <= kmax) St *= 2; }
  }
  const int chunk = (full + 7) >> 3;
  const int units = chunk * 8 + tail * St;
  bfr* sm = (bfr*)smem;
  const int lrow = tid >> 3, lc = (tid & 7) * 8;
#pragma unroll 1
  for (int u = p.bidl; u < units; u += G) {
    int t, ks, Ks; bool atom;
    if (u < chunk * 8) {
      t = (u & 7) * chunk + (u >> 3);
      if (t >= full) continue;
      ks = 0; Ks = K; atom = false;
    } else { const int v = u - chunk * 8; t = full + v / St; ks = v % St; Ks = K / St; atom = St > 1; }
    const int nk = Ks >> 6;
    const int panel = t / (nM * 8); const int rem = t - panel * nM * 8;
    const int pw = (nN - panel * 8) < 8 ? (nN - panel * 8) : 8;
    const int tm = rem / pw, tn = panel * 8 + rem % pw;
    const int m0 = tm * 128, n0 = tn * 128, kbase = ks * Ks;
    f32x16 acc[2][2];
    acc[0][0] = zero16(); acc[0][1] = zero16(); acc[1][0] = zero16(); acc[1][1] = zero16();
    const bfr* Ag = A + (size_t)(m0 + lrow) * lda + kbase + lc;
    const bfr* Bg = Bt + (size_t)(n0 + lrow) * K + kbase + lc;
    bf16x8 ra[4], rb[4];
#pragma unroll
    for (int i = 0; i < 4; ++i) {
      ra[i] = *(const bf16x8*)(Ag + (size_t)(32 * i) * lda);
      rb[i] = *(const bf16x8*)(Bg + (size_t)(32 * i) * K);
    }
#pragma unroll
    for (int i = 0; i < 4; ++i) {
      *(bf16x8*)(sm + (lrow + 32 * i) * 72 + lc) = ra[i];
      *(bf16x8*)(sm + 9216 + (lrow + 32 * i) * 72 + lc) = rb[i];
    }
    if (nk > 1) {
#pragma unroll
      for (int i = 0; i < 4; ++i) {
        ra[i] = *(const bf16x8*)(Ag + (size_t)(32 * i) * lda + 64);
        rb[i] = *(const bf16x8*)(Bg + (size_t)(32 * i) * K + 64);
      }
    }
    __syncthreads();
#pragma unroll 1
    for (int kt = 0; kt < nk; ++kt) {
      if (kt + 1 < nk) {
        bfr* Ad = sm + ((kt + 1) & 1) * 18432;
#pragma unroll
        for (int i = 0; i < 4; ++i) {
          *(bf16x8*)(Ad + (lrow + 32 * i) * 72 + lc) = ra[i];
          *(bf16x8*)(Ad + 9216 + (lrow + 32 * i) * 72 + lc) = rb[i];
        }
      }
      if (kt + 2 < nk) {
#pragma unroll
        for (int i = 0; i < 4; ++i) {
          ra[i] = *(const bf16x8*)(Ag + (size_t)(32 * i) * lda + (kt + 2) * 64);
          rb[i] = *(const bf16x8*)(Bg + (size_t)(32 * i) * K + (kt + 2) * 64);
        }
      }
      const bfr* As = sm + (kt & 1) * 18432;
      const bfr* Bs = As + 9216;
      __builtin_amdgcn_s_setprio(1);
#pragma unroll
      for (int kk = 0; kk < 4; ++kk) {
        bf16x8 a0 = *(const bf16x8*)(As + (wm * 64 + r) * 72 + kk * 16 + h * 8);
        bf16x8 a1 = *(const bf16x8*)(As + (wm * 64 + 32 + r) * 72 + kk * 16 + h * 8);
        bf16x8 b0 = *(const bf16x8*)(Bs + (wn * 64 + r) * 72 + kk * 16 + h * 8);
        bf16x8 b1 = *(const bf16x8*)(Bs + (wn * 64 + 32 + r) * 72 + kk * 16 + h * 8);
        acc[0][0] = MFMA(a0, b0, acc[0][0]);
        acc[0][1] = MFMA(a0, b1, acc[0][1]);
        acc[1][0] = MFMA(a1, b0, acc[1][0]);
        acc[1][1] = MFMA(a1, b1, acc[1][1]);
      }
      __builtin_amdgcn_s_setprio(0);
      __syncthreads();
    }
#pragma unroll
    for (int mi = 0; mi < 2; ++mi)
#pragma unroll
      for (int ni = 0; ni < 2; ++ni)
#pragma unroll
        for (int g4 = 0; g4 < 4; ++g4) {
          const int row = m0 + wm * 64 + mi * 32 + 8 * g4 + 4 * h;
          const int col = n0 + wn * 64 + ni * 32 + r;
          const float v0 = acc[mi][ni][4 * g4], v1 = acc[mi][ni][4 * g4 + 1], v2 = acc[mi][ni][4 * g4 + 2], v3 = acc[mi][ni][4 * g4 + 3];
          if (mode == EPI_EVEN_IN) {
            if (col < 1024) {
              bfr* dst = wsp<bfr>(p, col < 512 ? OFF_ZRT : OFF_ZIT) + (size_t)(col & 511) * R + row;
              *(bf16x4*)dst = pack4(v0, v1, v2, v3);
            } else if (col < 2560) {
              bfr* dst = wsp<bfr>(p, OFF_Z) + (size_t)row * 1536 + (col - 1024);
              dst[0] = f2bf(v0); dst[1536] = f2bf(v1); dst[2 * 1536] = f2bf(v2); dst[3 * 1536] = f2bf(v3);
            } else if (col < 5120) {
              bfr* dst = wsp<bfr>(p, OFF_XBC) + (size_t)row * 2560 + (col - 2560);
              dst[0] = f2bf(v0); dst[2560] = f2bf(v1); dst[2 * 2560] = f2bf(v2); dst[3 * 2560] = f2bf(v3);
            } else if (col < 5168) {
              float* dst = wsp<float>(p, OFF_DTRAW) + (size_t)row * 48 + (col - 5120);
              dst[0] = v0; dst[48] = v1; dst[96] = v2; dst[144] = v3;
            }
          } else if (mode == EPI_ODD_IN) {
            if (col >= 640 && col < 768) {
              *(bf16x4*)(wsp<bfr>(p, OFF_VT) + (size_t)(col - 640) * R + row) = pack4(v0, v1, v2, v3);
            } else if (col >= 1792) {
              *(bf16x4*)(wsp<bfr>(p, OFF_VT) + (size_t)(128 + col - 1792) * R + row) = pack4(v0, v1, v2, v3);
            } else {
              bfr* dst = wsp<bfr>(p, OFF_P) + (size_t)row * 2304 + col;
              dst[0] = f2bf(v0); dst[2304] = f2bf(v1); dst[2 * 2304] = f2bf(v2); dst[3 * 2304] = f2bf(v3);
            }
          } else if (mode == EPI_RELU2) {
            bfr* dst = wsp<bfr>(p, OFF_ACT) + (size_t)row * 4096 + col;
            float t0 = fmaxf(v0, 0.f), t1 = fmaxf(v1, 0.f), t2 = fmaxf(v2, 0.f), t3 = fmaxf(v3, 0.f);
            dst[0] = f2bf(t0 * t0); dst[4096] = f2bf(t1 * t1); dst[2 * 4096] = f2bf(t2 * t2); dst[3 * 4096] = f2bf(t3 * t3);
          } else if (mode == EPI_RESID) {
            const int ms = row < RL ? (row >> 13) : 2;
            const float gate = wsp<float>(p, OFF_MOD)[(layer * 3 + ms) * 6144 + gchunk * 1024 + col];
            float* hp = row < RL ? p.out + (size_t)row * 1024 + col : wsp<float>(p, OFF_HC) + (size_t)(row - RL) * 1024 + col;
            if (atom) {
              unsafeAtomicAdd(hp, gate * v0); unsafeAtomicAdd(hp + 1024, gate * v1);
              unsafeAtomicAdd(hp + 2048, gate * v2); unsafeAtomicAdd(hp + 3072, gate * v3);
            } else {
              hp[0] += gate * v0; hp[1024] += gate * v1; hp[2048] += gate * v2; hp[3072] += gate * v3;
            }
          }
        }
  }
}

DI float softplus_f(float x) { return x > 0.f ? x + log1pf(expf(-x)) : log1pf(expf(x)); }

DI void conv_dt_phase(const DP& p, int j) {
  const int tid = p.tidl, lane = tid & 63, wid = tid >> 6;
  const bfr* XBC = wsp<bfr>(p, OFF_XBC);
  bfr* XT = wsp<bfr>(p, OFF_XT); bfr* BN = wsp<bfr>(p, OFF_BN); bfr* BTt = wsp<bfr>(p, OFF_BT); bfr* CN = wsp<bfr>(p, OFF_CN);
  bfr* TT = (bfr*)smem;
  const float* cw = p.conv_w + (size_t)j * 5 * 2560;
  const float* cb = p.conv_b + (size_t)j * 2560;
  const int n_conv = 264 * 40, n_dt = 792;
  for (int u = p.bidl; u < n_conv + n_dt; u += gridDim.x) {
    if (u < n_conv) {
      const int tb = u / 40, cbk = u % 40, row0 = tb * 64, ch0 = cbk * 64;
      int pos0, len;
      if (row0 < RL) { pos0 = row0 & 8191; len = SEQ; } else { pos0 = (row0 - RL) & 255; len = CTX; }
      const int c8 = tid & 7, ch = ch0 + c8 * 8;
      float w[5][8], bias[8];
#pragma unroll
      for (int k = 0; k < 5; ++k) {
        float4 wa = *(const float4*)(cw + k * 2560 + ch), wb = *(const float4*)(cw + k * 2560 + ch + 4);
        w[k][0] = wa.x; w[k][1] = wa.y; w[k][2] = wa.z; w[k][3] = wa.w; w[k][4] = wb.x; w[k][5] = wb.y; w[k][6] = wb.z; w[k][7] = wb.w;
      }
      {
        float4 wa = *(const float4*)(cb + ch), wb = *(const float4*)(cb + ch + 4);
        bias[0] = wa.x; bias[1] = wa.y; bias[2] = wa.z; bias[3] = wa.w; bias[4] = wb.x; bias[5] = wb.y; bias[6] = wb.z; bias[7] = wb.w;
      }
#pragma unroll
      for (int ps = 0; ps < 2; ++ps) {
        const int tl = (tid >> 3) + 32 * ps, pos = pos0 + tl, row = row0 + tl;
        float a[8];
#pragma unroll
        for (int e = 0; e < 8; ++e) a[e] = bias[e];
        bf16x8 xr[5];
#pragma unroll
        for (int k = 0; k < 5; ++k) {
          const int pp = pos + k - 2;
          const bool ok = pp >= 0 && pp < len;
          const bfr* xp = XBC + (size_t)(ok ? row + k - 2 : row) * 2560 + ch;
          xr[k] = *(const bf16x8*)xp;
          if (!ok) { for (int e = 0; e < 8; ++e) xr[k][e] = 0; }
        }
#pragma unroll
        for (int k = 0; k < 5; ++k)
#pragma unroll
          for (int e = 0; e < 8; ++e) a[e] += w[k][e] * bfs(xr[k][e]);
        bf16x8 o;
#pragma unroll
        for (int e = 0; e < 8; ++e) { float s = a[e] / (1.f + __expf(-a[e])); o[e] = (short)f2bf(s); }
        if (ch0 >= 2048) *(bf16x8*)(CN + (size_t)row * 512 + (ch - 2048)) = o;
        else if (ch0 >= 1536) *(bf16x8*)(BN + (size_t)row * 512 + (ch - 1536)) = o;
        if (ch0 < 2048) {
#pragma unroll
          for (int e = 0; e < 8; ++e) TT[(c8 * 8 + e) * 72 + tl] = (bfr)o[e];
        }
      }
      if (ch0 < 2048) {
        __syncthreads();
        const int chl = tid >> 2, tseg = (tid & 3) * 16;
        bfr* dst = (ch0 < 1536 ? XT + (size_t)(ch0 + chl) * R : BTt + (size_t)(ch0 - 1536 + chl) * R) + row0 + tseg;
        *(bf16x8*)dst = *(const bf16x8*)(TT + chl * 72 + tseg);
        *(bf16x8*)(dst + 8) = *(const bf16x8*)(TT + chl * 72 + tseg + 8);
        __syncthreads();
      }
    } else {
      const int item = (u - n_conv) * 4 + wid;
      const int head = item % 24; int rest = item / 24; const int dir = rest & 1; rest >>= 1; const int c = rest % NCH, b = rest / NCH;
      const int row0 = chunk_row0(b, c), col = dir * 24 + head;
      const float bias = p.dt_bias[j * 48 + col];
      const float a = -expf(p.a_log[j * 48 + col]);
      const float* DTRAW = wsp<float>(p, OFF_DTRAW);
      float dt[4], cs[4];
      float run = 0.f;
#pragma unroll
      for (int q = 0; q < 4; ++q) {
        dt[q] = softplus_f(DTRAW[(size_t)(row0 + lane * 4 + q) * 48 + col] + bias);
        run += dt[q] * a; cs[q] = run;
      }
      float x = run;
#pragma unroll
      for (int o = 1; o < 64; o <<= 1) { float t2 = __shfl_up(x, o); if (lane >= o) x += t2; }
      const float excl = x - run;
      const float total = __shfl(x, 63);
      float ac[4];
#pragma unroll
      for (int q = 0; q < 4; ++q) {
        float inc = excl + cs[q];
        ac[q] = dir == 0 ? inc : total - inc + dt[q] * a;
      }
      const size_t base = ((size_t)(((dir * 2 + b) * NCH + c) * 24 + head)) * 256 + lane * 4;
      *(float4*)(wsp<float>(p, OFF_DTV) + base) = make_float4(dt[0], dt[1], dt[2], dt[3]);
      *(float4*)(wsp<float>(p, OFF_ACUM) + base) = make_float4(ac[0], ac[1], ac[2], ac[3]);
    }
  }
}

DI bf16x8 scale8(bf16x8 a, const float* w) {
  return pack8(bfs(a[0]) * w[0], bfs(a[1]) * w[1], bfs(a[2]) * w[2], bfs(a[3]) * w[3],
               bfs(a[4]) * w[4], bfs(a[5]) * w[5], bfs(a[6]) * w[6], bfs(a[7]) * w[7]);
}

DI void s1_item(const DP& p, int item, int lane) {
  const int r = lane & 31, h = lane >> 5;
  const int head = item % 24; int rest = item / 24; const int dir = rest & 1; rest >>= 1; const int c = rest % NCH, b = rest / NCH;
  const int g = head / 6;
  const int row0 = chunk_row0(b, c);
  const size_t dbase = ((size_t)(((dir * 2 + b) * NCH + c) * 24 + head)) * 256;
  const float* dtv = wsp<float>(p, OFF_DTV) + dbase;
  const float* acm = wsp<float>(p, OFF_ACUM) + dbase;
  const float acend = dir == 0 ? acm[255] : acm[0];
  const bfr* XT = wsp<bfr>(p, OFF_XT); const bfr* BTt = wsp<bfr>(p, OFF_BT);
  bfr* HS = wsp<bfr>(p, OFF_HS) + ((size_t)(((dir * 2 + b) * NCH + c) * 24 + head)) * 8192;
#pragma unroll 1
  for (int pt = 0; pt < 2; ++pt) {
    f32x16 acc[4];
#pragma unroll
    for (int n = 0; n < 4; ++n) acc[n] = zero16();
#pragma unroll 4
    for (int kk = 0; kk < 16; ++kk) {
      const int s0 = kk * 16 + 8 * h;
      float4 d0 = *(const float4*)(dtv + s0), d1 = *(const float4*)(dtv + s0 + 4);
      float4 a0 = *(const float4*)(acm + s0), a1 = *(const float4*)(acm + s0 + 4);
      float w[8];
      w[0] = d0.x * __expf(acend - a0.x); w[1] = d0.y * __expf(acend - a0.y); w[2] = d0.z * __expf(acend - a0.z); w[3] = d0.w * __expf(acend - a0.w);
      w[4] = d1.x * __expf(acend - a1.x); w[5] = d1.y * __expf(acend - a1.y); w[6] = d1.z * __expf(acend - a1.z); w[7] = d1.w * __expf(acend - a1.w);
      bf16x8 af = scale8(*(const bf16x8*)(XT + (size_t)(head * 64 + pt * 32 + r) * R + row0 + s0), w);
#pragma unroll
      for (int nt = 0; nt < 4; ++nt) {
        bf16x8 bfv = *(const bf16x8*)(BTt + (size_t)(g * 128 + nt * 32 + r) * R + row0 + s0);
        acc[nt] = MFMA(af, bfv, acc[nt]);
      }
    }
#pragma unroll
    for (int nt = 0; nt < 4; ++nt)
#pragma unroll
      for (int i = 0; i < 16; ++i) HS[(pt * 32 + crow(i, h)) * 128 + nt * 32 + r] = f2bf(acc[nt][i]);
  }
}

DI void f1_item(const DP& p, int item, int lane) {
  const int r = lane & 31, h = lane >> 5;
  const int l2t = item & 1, m = (item >> 1) & 511, b = item >> 10;
  const bfr* ZRT = wsp<bfr>(p, OFF_ZRT) + (size_t)m * R + b * SEQ + l2t * 32 + r;
  const bfr* ZIT = wsp<bfr>(p, OFF_ZIT) + (size_t)m * R + b * SEQ + l2t * 32 + r;
  const bfr* C128 = wsp<bfr>(p, OFF_C128); const bfr* S128 = wsp<bfr>(p, OFF_S128);
  const float2* TW = wsp<float2>(p, OFF_TW);
  bfr* YR = wsp<bfr>(p, OFF_YR); bfr* YI = wsp<bfr>(p, OFF_YI);
  const int l2 = l2t * 32 + r;
#pragma unroll 1
  for (int mh = 0; mh < 2; ++mh) {
    f32x16 yr[2], yi[2];
#pragma unroll
    for (int i = 0; i < 2; ++i) { yr[i] = zero16(); yi[i] = zero16(); }
#pragma unroll 2
    for (int kk = 0; kk < 8; ++kk) {
      bf16x8 zr, zi, nzr;
#pragma unroll
      for (int jj = 0; jj < 8; ++jj) {
        int l1 = kk * 16 + 8 * h + jj;
        zr[jj] = (short)ZRT[l1 * 64]; zi[jj] = (short)ZIT[l1 * 64];
        nzr[jj] = (short)(zr[jj] ^ (short)0x8000);
      }
#pragma unroll
      for (int m2 = 0; m2 < 2; ++m2) {
        const int mt = mh * 2 + m2;
        bf16x8 ca = *(const bf16x8*)(C128 + (mt * 32 + r) * 128 + kk * 16 + 8 * h);
        bf16x8 sa = *(const bf16x8*)(S128 + (mt * 32 + r) * 128 + kk * 16 + 8 * h);
        yr[m2] = MFMA(ca, zr, yr[m2]); yr[m2] = MFMA(sa, zi, yr[m2]);
        yi[m2] = MFMA(ca, zi, yi[m2]); yi[m2] = MFMA(sa, nzr, yi[m2]);
      }
    }
#pragma unroll
    for (int m2 = 0; m2 < 2; ++m2)
#pragma unroll
      for (int i = 0; i < 16; ++i) {
        int k1 = (mh * 2 + m2) * 32 + crow(i, h);
        float2 t = TW[k1 * l2];
        float a = yr[m2][i], bb = yi[m2][i];
        size_t o = ((size_t)(b * 512 + m) * 128 + k1) * 64 + l2;
        YR[o] = f2bf(a * t.x + bb * t.y);
        YI[o] = f2bf(bb * t.x - a * t.y);
      }
  }
}

DI void f1c_item(const DP& p, int item, int lane) {
  const int r = lane & 31, h = lane >> 5;
  const int mt = item & 15, kt = (item >> 4) & 7, b = item >> 7;
  const int m = mt * 32 + r;
  const bfr* ZRT = wsp<bfr>(p, OFF_ZRT) + (size_t)m * R + RL + b * CTX;
  const bfr* ZIT = wsp<bfr>(p, OFF_ZIT) + (size_t)m * R + RL + b * CTX;
  const bfr* C256 = wsp<bfr>(p, OFF_C256) + (kt * 32 + r) * 256;
  const bfr* S256 = wsp<bfr>(p, OFF_S256) + (kt * 32 + r) * 256;
  f32x16 acc = zero16();
#pragma unroll 4
  for (int kk = 0; kk < 16; ++kk) {
    int o = kk * 16 + 8 * h;
    acc = MFMA(*(const bf16x8*)(C256 + o), *(const bf16x8*)(ZRT + o), acc);
    acc = MFMA(*(const bf16x8*)(S256 + o), *(const bf16x8*)(ZIT + o), acc);
  }
  bfr* MIX = wsp<bfr>(p, OFF_MIX);
#pragma unroll
  for (int i = 0; i < 16; ++i)
    MIX[(size_t)(RL + b * CTX + kt * 32 + crow(i, h)) * 2048 + m] = f2bf(acc[i] * (1.f / 128.f));
}

DI void s1f1_phase(const DP& p) {
  const int lane = p.tidl & 63;
  const int wg = p.bidl * 4 + (p.tidl >> 6), nw = gridDim.x * 4;
  const int n_s1 = 2 * NCH * 2 * 24, n_f1 = 2048, n_f1c = 256;
#pragma unroll 1
  for (int it = wg; it < n_s1 + n_f1 + n_f1c; it += nw) {
    if (it < n_s1) s1_item(p, it, lane);
    else if (it < n_s1 + n_f1) f1_item(p, it - n_s1, lane);
    else f1c_item(p, it - n_s1 - n_f1, lane);
  }
}

DI void f2_item(const DP& p, int item, int lane) {
  const int r = lane & 31, h = lane >> 5;
  const int mt16 = item & 15, k1 = (item >> 4) & 127, b = item >> 11;
  const int m = mt16 * 32 + r;
  const bfr* YR = wsp<bfr>(p, OFF_YR) + ((size_t)(b * 512 + m) * 128 + k1) * 64;
  const bfr* YI = wsp<bfr>(p, OFF_YI) + ((size_t)(b * 512 + m) * 128 + k1) * 64;
  const bfr* C64 = wsp<bfr>(p, OFF_C64); const bfr* S64 = wsp<bfr>(p, OFF_S64);
  f32x16 acc[2]; acc[0] = zero16(); acc[1] = zero16();
#pragma unroll
  for (int kk = 0; kk < 4; ++kk) {
    bf16x8 yr = *(const bf16x8*)(YR + kk * 16 + 8 * h), yi = *(const bf16x8*)(YI + kk * 16 + 8 * h);
#pragma unroll
    for (int t = 0; t < 2; ++t) {
      bf16x8 ca = *(const bf16x8*)(C64 + (t * 32 + r) * 64 + kk * 16 + 8 * h);
      bf16x8 sa = *(const bf16x8*)(S64 + (t * 32 + r) * 64 + kk * 16 + 8 * h);
      acc[t] = MFMA(ca, yr, acc[t]); acc[t] = MFMA(sa, yi, acc[t]);
    }
  }
  bfr* MIX = wsp<bfr>(p, OFF_MIX);
  const float scale = 0.001381067932f;
#pragma unroll
  for (int t = 0; t < 2; ++t)
#pragma unroll
    for (int i = 0; i < 16; ++i) {
      int k2 = t * 32 + crow(i, h);
      MIX[(size_t)(b * SEQ + k1 + 128 * k2) * 2048 + m] = f2bf(acc[t][i] * scale);
    }
}

DI void s3_block(const DP& p, int j, int b, int c, int g, int half);

DI void s2f2_phase(const DP& p, int j) {
  if (p.bidl < 16) {
    const int k = p.bidl;
    s3_block(p, j, k >> 3, 0, (k >> 1) & 3, k & 1);
    return;
  }
  const int gt = (p.bidl - 16) * 256 + p.tidl, nt = ((int)gridDim.x - 16) * 256;
  bfr* HSb = wsp<bfr>(p, OFF_HS);
  const float* ACUM = wsp<float>(p, OFF_ACUM);
#pragma unroll 1
  for (int it = gt; it < 2 * 2 * 24 * 2048; it += nt) {
    const int e4 = it & 2047; const int rest = it >> 11; const int head = rest % 24, db = rest / 24, dir = db >> 1;
    bf16x4 sv[NCH]; float cd[NCH];
#pragma unroll
    for (int step = 0; step < NCH; ++step) {
      const int c = dir == 0 ? step : (step == 0 ? 0 : NCH - step);
      const size_t ci = (size_t)((db * NCH + c) * 24 + head);
      sv[step] = *(const bf16x4*)(HSb + ci * 8192 + e4 * 4);
      cd[step] = ACUM[ci * 256 + (dir == 0 ? 255 : 0)];
    }
    float h0 = 0.f, h1 = 0.f, h2 = 0.f, h3 = 0.f;
#pragma unroll
    for (int step = 0; step < NCH; ++step) {
      const int c = dir == 0 ? step : (step == 0 ? 0 : NCH - step);
      const size_t ci = (size_t)((db * NCH + c) * 24 + head);
      *(bf16x4*)(HSb + ci * 8192 + e4 * 4) = pack4(h0, h1, h2, h3);
      const float e = __expf(cd[step]);
      h0 = h0 * e + bfs(sv[step][0]); h1 = h1 * e + bfs(sv[step][1]); h2 = h2 * e + bfs(sv[step][2]); h3 = h3 * e + bfs(sv[step][3]);
    }
  }
  const int lane = p.tidl & 63;
  const int wg = (p.bidl - 16) * 4 + (p.tidl >> 6), nw = ((int)gridDim.x - 16) * 4;
#pragma unroll 1
  for (int it = wg; it < 4096; it += nw) f2_item(p, it, lane);
}

DI void s3_block(const DP& p, int j, int b, int c, int g, int half) {
  const int tid = p.tidl, lane = tid & 63, wid = tid >> 6, r = lane & 31, h = lane >> 5;
  const bfr* CN = wsp<bfr>(p, OFF_CN); const bfr* BN = wsp<bfr>(p, OFF_BN); const bfr* XT = wsp<bfr>(p, OFF_XT);
  const bfr* Z = wsp<bfr>(p, OFF_Z); bfr* MIX = wsp<bfr>(p, OFF_MIX);
  bfr* XTs = (bfr*)smem;
  bfr* HSF = (bfr*)(smem + 33792);
  bfr* HSB = (bfr*)(smem + 51200);
  float* LWF = (float*)(smem + 68608);
  float* LWB = LWF + 256;
  {
    const int row0 = chunk_row0(b, c);
    const int lt = half * 4 + wid;
    const int rowl = row0 + lt * 32 + r;
    const bfr* cfp = CN + (size_t)rowl * 512 + g * 128 + 8 * h;
    bf16x8 gtp[8][2];
    {
      bf16x8 cf[8];
#pragma unroll
      for (int kk = 0; kk < 8; ++kk) cf[kk] = *(const bf16x8*)(cfp + kk * 16);
#pragma unroll
      for (int k = 0; k < 8; ++k) { gtp[k][0] = cf[0]; gtp[k][1] = cf[0]; }
#pragma unroll 1
      for (int st = 0; st < 8; ++st) {
        f32x16 gt = zero16();
#pragma unroll
        for (int kk = 0; kk < 8; ++kk)
          gt = MFMA(*(const bf16x8*)(BN + (size_t)(row0 + st * 32 + r) * 512 + g * 128 + kk * 16 + 8 * h), cf[kk], gt);
#pragma unroll
        for (int k = 0; k < 7; ++k) { gtp[k][0] = gtp[k + 1][0]; gtp[k][1] = gtp[k + 1][1]; }
        gtp[7][0] = PACK_HALF(gt, 0); gtp[7][1] = PACK_HALF(gt, 1);
      }
    }
    float sumsq = 0.f;
#pragma unroll 1
    for (int hh = 0; hh < 6; ++hh) {
      const int head = g * 6 + hh;
      const size_t cif = (size_t)(((0 * 2 + b) * NCH + c) * 24 + head), cib = (size_t)(((1 * 2 + b) * NCH + c) * 24 + head);
      const float* acf = wsp<float>(p, OFF_ACUM) + cif * 256; const float* acb = wsp<float>(p, OFF_ACUM) + cib * 256;
      const float* dtf = wsp<float>(p, OFF_DTV) + cif * 256; const float* dtb = wsp<float>(p, OFF_DTV) + cib * 256;
      const bfr* HSf = wsp<bfr>(p, OFF_HS) + cif * 8192; const bfr* HSbk = wsp<bfr>(p, OFF_HS) + cib * 8192;
      __syncthreads();
#pragma unroll 4
      for (int i = 0; i < 8; ++i) {
        const int idx = tid + 256 * i, row = idx >> 5, c16 = idx & 31;
        *(bf16x8*)(XTs + row * 264 + c16 * 8) = *(const bf16x8*)(XT + (size_t)(head * 64 + row) * R + row0 + c16 * 8);
      }
      if (c != 0) {
#pragma unroll 2
        for (int i = 0; i < 4; ++i) {
          const int idx = tid + 256 * i, row = idx >> 4, c16 = idx & 15;
          *(bf16x8*)(HSF + row * 136 + c16 * 8) = *(const bf16x8*)(HSf + row * 128 + c16 * 8);
          *(bf16x8*)(HSB + row * 136 + c16 * 8) = *(const bf16x8*)(HSbk + row * 128 + c16 * 8);
        }
      }
      LWF[tid] = __logf(dtf[tid]) - acf[tid];
      LWB[tid] = __logf(dtb[tid]) - acb[tid];
      const float al_f = acf[lt * 32 + r], al_b = acb[lt * 32 + r];
      __syncthreads();
      f32x16 acc[2];
      acc[0] = zero16(); acc[1] = zero16();
      if (c != 0) {
        f32x16 t0 = zero16(), t1 = zero16();
#pragma unroll
        for (int kk = 0; kk < 8; ++kk) {
          const bf16x8 cfk = *(const bf16x8*)(cfp + kk * 16);
          t0 = MFMA(*(const bf16x8*)(HSF + (r) * 136 + kk * 16 + 8 * h), cfk, t0);
          t1 = MFMA(*(const bf16x8*)(HSF + (32 + r) * 136 + kk * 16 + 8 * h), cfk, t1);
        }
        const float ef = __expf(al_f);
#pragma unroll
        for (int i = 0; i < 16; ++i) { acc[0][i] = t0[i] * ef; acc[1][i] = t1[i] * ef; }
        t0 = zero16(); t1 = zero16();
#pragma unroll
        for (int kk = 0; kk < 8; ++kk) {
          const bf16x8 cfk = *(const bf16x8*)(cfp + kk * 16);
          t0 = MFMA(*(const bf16x8*)(HSB + (r) * 136 + kk * 16 + 8 * h), cfk, t0);
          t1 = MFMA(*(const bf16x8*)(HSB + (32 + r) * 136 + kk * 16 + 8 * h), cfk, t1);
        }
        const float eb = __expf(al_b);
#pragma unroll
        for (int i = 0; i < 16; ++i) { acc[0][i] += t0[i] * eb; acc[1][i] += t1[i] * eb; }
      }
#pragma unroll 1
      for (int st = 0; st < 8; ++st) {
        const bf16x8 g0 = gtp[0][0], g1 = gtp[0][1];
#pragma unroll
        for (int k = 0; k < 7; ++k) { gtp[k][0] = gtp[k + 1][0]; gtp[k][1] = gtp[k + 1][1]; }
        gtp[7][0] = g0; gtp[7][1] = g1;
#pragma unroll 1
        for (int dir = 0; dir < 2; ++dir) {
          if (dir == 0 ? (st > lt) : (st < lt)) continue;
          const float* lwd = dir == 0 ? LWF : LWB;
          const float al = dir == 0 ? al_f : al_b;
          f32x16 mm;
#pragma unroll
          for (int g4 = 0; g4 < 4; ++g4) {
            const int sb = st * 32 + 8 * g4 + 4 * h;
            const float4 l4 = *(const float4*)(lwd + sb);
            const float lv[4] = {l4.x, l4.y, l4.z, l4.w};
#pragma unroll
            for (int q = 0; q < 4; ++q) {
              const int i = 4 * g4 + q;
              const int sidx = sb + q, lidx = lt * 32 + r;
              const bool valid = dir == 0 ? (sidx <= lidx) : (sidx >= lidx);
              const float gv = bfs((i >> 3) ? g1[i & 7] : g0[i & 7]);
              const float e = __expf(fminf(al + lv[q], 30.f));
              mm[i] = valid ? gv * e : 0.f;
            }
          }
#pragma unroll
          for (int s2 = 0; s2 < 2; ++s2) {
            bf16x8 pf = PACK_HALF(mm, s2);
#pragma unroll
            for (int pt = 0; pt < 2; ++pt) {
              const bfr* xp = XTs + (pt * 32 + r) * 264 + st * 32 + 16 * s2 + 4 * h;
              bf16x8 xf = join44(*(const bf16x4*)xp, *(const bf16x4*)(xp + 8));
              acc[pt] = MFMA(xf, pf, acc[pt]);
            }
          }
        }
      }
      const float dsk = p.d_skip[j * 24 + head];
#pragma unroll
      for (int pt = 0; pt < 2; ++pt)
#pragma unroll
        for (int g4 = 0; g4 < 4; ++g4) {
          const int pb = pt * 32 + 8 * g4 + 4 * h;
          bf16x4 zv = *(const bf16x4*)(Z + (size_t)rowl * 1536 + head * 64 + pb);
          float y[4];
#pragma unroll
          for (int q = 0; q < 4; ++q) {
            float xv = bf2f(XTs[(pb + q) * 264 + lt * 32 + r]);
            float zz = bfs(zv[q]);
            float v = (acc[pt][4 * g4 + q] + dsk * xv) * (zz / (1.f + __expf(-zz)));
            sumsq += v * v; y[q] = v;
          }
          *(bf16x4*)(MIX + (size_t)rowl * 2048 + 512 + head * 64 + pb) = pack4(y[0], y[1], y[2], y[3]);
        }
    }
    const float tot = sumsq + __shfl_xor(sumsq, 32);
    const float sc = rsqrtf(tot * (1.f / 384.f) + 1e-6f);
    const float* ng = p.ssd_norm_g + (size_t)j * 1536;
#pragma unroll 1
    for (int hh = 0; hh < 6; ++hh) {
      const int head = g * 6 + hh;
#pragma unroll
      for (int pt = 0; pt < 2; ++pt)
#pragma unroll
        for (int g4 = 0; g4 < 4; ++g4) {
          const int pb = pt * 32 + 8 * g4 + 4 * h;
          bfr* mp = MIX + (size_t)rowl * 2048 + 512 + head * 64 + pb;
          bf16x4 yv = *(const bf16x4*)mp;
          float4 gg = *(const float4*)(ng + head * 64 + pb);
          *(bf16x4*)mp = pack4(bfs(yv[0]) * sc * gg.x, bfs(yv[1]) * sc * gg.y, bfs(yv[2]) * sc * gg.z, bfs(yv[3]) * sc * gg.w);
        }
    }
  }
}

DI void s3_phase(const DP& p, int j) {
#pragma unroll 1
  for (int idx = p.bidl; idx < 512; idx += (int)gridDim.x) {
    const int half = idx & 1, g = (idx >> 1) & 3, bcl = idx >> 3;
    s3_block(p, j, bcl >> 5, 1 + (bcl & 31), g, half);
  }
}

DI void qkprep_phase(const DP& p, int j) {
  const int lane = p.tidl & 63;
  const int wg = p.bidl * 4 + (p.tidl >> 6), nw = gridDim.x * 4;
  const bfr* P = wsp<bfr>(p, OFF_P); bfr* QK = wsp<bfr>(p, OFF_QK);
  const float* ROPE = wsp<float>(p, OFF_ROPE);
  const int sub = lane >> 3, d0 = (lane & 7) * 8;
  for (int row = wg; row < R; row += nw) {
#pragma unroll
    for (int ps = 0; ps < 4; ++ps) {
      const int hs = ps * 8 + sub;
      const bool act = hs < 26;
      const int hsc = act ? hs : 25;
      const int col = hsc < 10 ? hsc * 64 : 768 + (hsc - 10) * 64;
      bf16x8 xv = *(const bf16x8*)(P + (size_t)row * 2304 + col + d0);
      float x[8]; float ss = 0.f;
#pragma unroll
      for (int e = 0; e < 8; ++e) { x[e] = bfs(xv[e]); ss += x[e] * x[e]; }
      ss += __shfl_xor(ss, 1); ss += __shfl_xor(ss, 2); ss += __shfl_xor(ss, 4);
      const float rs = rsqrtf(ss * (1.f / 64.f) + 1e-6f);
      const float* gv = hsc < 8 ? p.q_norm_win + j * 64 : hsc < 10 ? p.k_norm_win + j * 64 : hsc < 18 ? p.q_norm_na + j * 64 : p.k_norm_na + j * 64;
#pragma unroll
      for (int e = 0; e < 8; ++e) x[e] = x[e] * rs * gv[d0 + e];
      float pr[8];
#pragma unroll
      for (int e = 0; e < 8; ++e) pr[e] = __shfl_xor(x[e], 2);
      if (hsc < 10 && row < RL) {
        const int pos = row & 8191;
        const int axis = d0 >> 5;
        const int idx = axis == 0 ? (pos >> 6) : (pos & 63);
        const int f0 = d0 & 15;
        const bool second = (d0 & 16) != 0;
        const float* cp = ROPE + (axis * 128 + idx) * 16 + f0;
        const float* sp = cp + 4096;
#pragma unroll
        for (int e = 0; e < 8; ++e) {
          float cs = cp[e], sn = sp[e];
          x[e] = second ? (x[e] * cs + pr[e] * sn) : (x[e] * cs - pr[e] * sn);
        }
      }
      const bool isq = hsc < 8 || (hsc >= 10 && hsc < 18);
      const float qs = isq ? 0.125f : 1.f;
      if (act) *(bf16x8*)(QK + (size_t)row * 1664 + hsc * 64 + d0) = pack8(x[0] * qs, x[1] * qs, x[2] * qs, x[3] * qs, x[4] * qs, x[5] * qs, x[6] * qs, x[7] * qs);
    }
  }
}

struct KVF { bf16x8 k[4]; bf16x8 v[2][2]; };
struct KVS { bf16x8 k[4]; bf16x8 v[4]; };

DI void kv_gload(KVS& g, const bfr* __restrict__ Kt, const bfr* __restrict__ Vt, int lane) {
#pragma unroll
  for (int i = 0; i < 4; ++i) {
    const int idx = lane + 64 * i;
    g.k[i] = *(const bf16x8*)(Kt + (size_t)(idx >> 3) * 1664 + (idx & 7) * 8);
    g.v[i] = *(const bf16x8*)(Vt + (size_t)(idx >> 2) * R + (idx & 3) * 8);
  }
}
DI void kv_sstore(const KVS& g, unsigned char* base, int lane) {
#pragma unroll
  for (int i = 0; i < 4; ++i) {
    const int idx = lane + 64 * i;
    { const int row = idx >> 3, c = idx & 7; *(bf16x8*)(base + row * 128 + ((c ^ (row & 7)) << 4)) = g.k[i]; }
    {
      const int d = idx >> 2, c16 = idx & 3, sw = (d >> 2) & 7;
      bf16x4 lo = __builtin_shufflevector(g.v[i], g.v[i], 0, 1, 2, 3), hi = __builtin_shufflevector(g.v[i], g.v[i], 4, 5, 6, 7);
      *(bf16x4*)(base + 4096 + d * 64 + (((2 * c16) ^ sw) << 3)) = lo;
      *(bf16x4*)(base + 4096 + d * 64 + (((2 * c16 + 1) ^ sw) << 3)) = hi;
    }
  }
}
DI void kv_sload(KVF& f, const unsigned char* base, int r, int h) {
#pragma unroll
  for (int kk = 0; kk < 4; ++kk) f.k[kk] = *(const bf16x8*)(base + r * 128 + (((2 * kk + h) ^ (r & 7)) << 4));
#pragma unroll
  for (int s2 = 0; s2 < 2; ++s2)
#pragma unroll
    for (int dt = 0; dt < 2; ++dt) {
      const int d = dt * 32 + r, sw = (d >> 2) & 7, c8 = 4 * s2 + h;
      const unsigned char* vb = base + 4096 + d * 64;
      f.v[s2][dt] = join44(*(const bf16x4*)(vb + ((c8 ^ sw) << 3)), *(const bf16x4*)(vb + (((c8 + 2) ^ sw) << 3)));
    }
}

DI void attn_compute(f32x16 (&o)[2], float& m, float& l, const unsigned char* qb, const unsigned char* base, int r, int h,
                     int mode, int a0, int a1, const float* __restrict__ rp) {
  f32x16 s = zero16();
#pragma unroll
  for (int kk = 0; kk < 4; ++kk) {
    const int off = r * 128 + (((2 * kk + h) ^ (r & 7)) << 4);
    s = MFMA(*(const bf16x8*)(base + off), *(const bf16x8*)(qb + off), s);
  }
  float tmax = -3.0e38f;
  if (mode == 1) {
#pragma unroll
    for (int i = 0; i < 16; ++i) { int dd = a0 - crow(i, h); dd = dd < 0 ? -dd : dd; s[i] = dd <= 128 ? s[i] : -1.0e30f; }
  } else if (mode == 2) {
#pragma unroll
    for (int i = 0; i < 16; ++i) {
      const int key = crow(i, h);
      const int rel = a0 + key;
      int co = a1 + key; co = co < 0 ? 0 : (co > 30 ? 30 : co);
      s[i] = (rel >= 0 && rel < 16) ? s[i] + rp[co] : -1.0e30f;
    }
  }
#pragma unroll
  for (int i = 0; i < 16; ++i) tmax = fmaxf(tmax, s[i]);
  tmax = fmaxf(tmax, __shfl_xor(tmax, 32));
  const float mn = fmaxf(m, tmax);
  const float alpha = __expf(m - mn);
  float ps = 0.f;
#pragma unroll
  for (int i = 0; i < 16; ++i) { s[i] = __expf(s[i] - mn); ps += s[i]; }
  l = l * alpha + ps; m = mn;
#pragma unroll
  for (int i = 0; i < 16; ++i) { o[0][i] *= alpha; o[1][i] *= alpha; }
#pragma unroll
  for (int s2 = 0; s2 < 2; ++s2) {
    bf16x8 pf = PACK_HALF(s, s2);
#pragma unroll
    for (int dt = 0; dt < 2; ++dt) {
      const int d = dt * 32 + r, sw = (d >> 2) & 7, c8 = 4 * s2 + h;
      const unsigned char* vb = base + 4096 + d * 64;
      bf16x8 vf = join44(*(const bf16x4*)(vb + ((c8 ^ sw) << 3)), *(const bf16x4*)(vb + (((c8 + 2) ^ sw) << 3)));
      o[dt] = MFMA(vf, pf, o[dt]);
    }
  }
}

DI void attn_item(const DP& p, int j, int item, int lane) {
  const int r = lane & 31, h = lane >> 5;
  const bfr* QK = wsp<bfr>(p, OFF_QK); const bfr* VT = wsp<bfr>(p, OFF_VT); bfr* MIX = wsp<bfr>(p, OFF_MIX);
  int kind, b, hd, qt;
  if (item < 4096) { kind = 0; qt = item & 255; hd = (item >> 8) & 7; b = item >> 11; }
  else if (item < 8192) { int v = item - 4096; kind = 1; qt = v & 255; hd = (v >> 8) & 7; b = v >> 11; }
  else if (item < 8320) { int v = item - 8192; kind = 2; qt = v & 7; hd = (v >> 3) & 7; b = v >> 6; }
  else { int v = item - 8320; kind = 3; qt = v & 7; hd = (v >> 3) & 7; b = v >> 6; }
  const bool win = (kind == 0 || kind == 2);
  const bool lat = kind < 2;
  const int q_row0 = lat ? b * SEQ + qt * 32 : RL + b * CTX + qt * 32;
  const int qcol = win ? hd * 64 : (10 + hd) * 64;
  const int kcol = win ? (8 + (hd >> 2)) * 64 : (18 + hd) * 64;
  const bfr* Vb = win ? VT + (size_t)((hd >> 2) * 64) * R : VT + (size_t)(128 + hd * 64) * R;
  const bfr* Kb = QK + kcol;
  f32x16 o[2]; o[0] = zero16(); o[1] = zero16();
  float m = -1.0e30f, l = 0.f;
  if (win) { m = p.sink_win[j * 8 + hd]; l = h == 0 ? 1.f : 0.f; }
  int nloc = 0, lo = 0, gr = 0, kr0 = 0, w = 0, cs = 0;
  const int qpos = qt * 32 + r;
  if (kind == 0) { lo = qt - 4 < 0 ? 0 : qt - 4; const int hi = qt + 4 > 255 ? 255 : qt + 4; nloc = hi - lo + 1; }
  else if (kind == 1) {
    gr = qt >> 1; w = (qt & 1) * 32 + r;
    cs = w - 8; cs = cs < 0 ? 0 : (cs > 48 ? 48 : cs);
    kr0 = gr - 4; kr0 = kr0 < 0 ? 0 : (kr0 > 120 ? 120 : kr0);
    nloc = 16;
  }
  const int ntile = 8 + nloc;
  const float* rpb = p.rpb_na + (size_t)j * 8 * 15 * 31 + hd * 15 * 31;
  auto tile_row = [&](int i) -> int {
    if (i < 8) return RL + b * CTX + i * 32;
    const int li = i - 8;
    if (kind == 0) return b * SEQ + (lo + li) * 32;
    return b * SEQ + (kr0 + (li >> 1)) * 64 + (li & 1) * 32;
  };
  unsigned char* lbase = smem + (p.tidl >> 6) * 12288;
  asm volatile("" ::: "memory");
#pragma unroll
  for (int i = 0; i < 4; ++i) {
    const int idx = lane + 64 * i, row = idx >> 3, c = idx & 7;
    *(bf16x8*)(lbase + 8192 + row * 128 + ((c ^ (row & 7)) << 4)) = *(const bf16x8*)(QK + (size_t)(q_row0 + row) * 1664 + qcol + c * 8);
  }
  KVS g;
  { const int k0 = tile_row(0); kv_gload(g, Kb + (size_t)k0 * 1664, Vb + k0, lane); }
  kv_sstore(g, lbase, lane);
#pragma unroll 1
  for (int i = 0; i < ntile; ++i) {
    { const int in = i + 1 < ntile ? i + 1 : i; const int k0 = tile_row(in); kv_gload(g, Kb + (size_t)k0 * 1664, Vb + k0, lane); }
    int mode = 0, a0 = 0, a1 = 0; const float* rp = rpb;
    if (i >= 8) {
      const int li = i - 8;
      if (kind == 0) { mode = 1; a0 = qpos - (lo + li) * 32; }
      else { mode = 2; const int krow = kr0 + (li >> 1); const int ub = (li & 1) * 32; a0 = ub - cs; a1 = ub - w + 15; rp = rpb + (krow - gr + 7) * 31; }
    }
    asm volatile("" ::: "memory");
    attn_compute(o, m, l, lbase + 8192, lbase, r, h, mode, a0, a1, rp);
    asm volatile("" ::: "memory");
    kv_sstore(g, lbase, lane);
  }
  asm volatile("" ::: "memory");
  const float lt = l + __shfl_xor(l, 32);
  const float inv = 1.f / lt;
  const int ocol = win ? hd * 64 : 512 + hd * 64;
#pragma unroll
  for (int dt = 0; dt < 2; ++dt)
#pragma unroll
    for (int g4 = 0; g4 < 4; ++g4) {
      const int d = dt * 32 + 8 * g4 + 4 * h;
      *(bf16x4*)(MIX + (size_t)(q_row0 + r) * 1024 + ocol + d) =
          pack4(o[dt][4 * g4] * inv, o[dt][4 * g4 + 1] * inv, o[dt][4 * g4 + 2] * inv, o[dt][4 * g4 + 3] * inv);
    }
}

DI void attn_phase(const DP& p, int j) {
  const int lane = p.tidl & 63;
  const int wg = p.bidl * 4 + (p.tidl >> 6), nw = gridDim.x * 4;
#pragma unroll 1
  for (int it = wg; it < 8448; it += nw) attn_item(p, j, it, lane);
}

#define XB_TMO      128
#define XB_XCNT(j)  (256  + 64 * (j))
#define XB_XSUB(j)  (1280 + 64 * (j))
#define XB_XGEN(j)  (2304 + 64 * (j))
#define XB_TOP      3328
#define XB_TOPGEN   3392
#define XCD_BAR_WORDS 3456
#define XB_SPIN_CAP (1u << 18)
#define LAS __attribute__((address_space(3)))

__device__ __forceinline__ unsigned xb_ld(unsigned* p)              { return __hip_atomic_load(p, __ATOMIC_RELAXED, __HIP_MEMORY_SCOPE_AGENT); }
__device__ __forceinline__ unsigned xb_add(unsigned* p, unsigned v) { return __hip_atomic_fetch_add(p, v, __ATOMIC_RELAXED, __HIP_MEMORY_SCOPE_AGENT); }
__device__ __forceinline__ unsigned xb_xcc_id() { return (unsigned)__builtin_amdgcn_s_getreg((3 << 11) | 20) & 0xFu; }
#define XB_SPIN(cond, bar) do { unsigned _sp = 0; while (cond) { __builtin_amdgcn_s_sleep(1); \
    if ((++_sp & 255u) == 0u) { if (xb_ld(&(bar)[XB_TMO])) break; if (_sp > XB_SPIN_CAP) { atomicAdd(&(bar)[XB_TMO], 1u); break; } } } } while (0)

struct XcdBarrier {
    unsigned* bar; unsigned x;
    volatile LAS unsigned* st;
};

__device__ __forceinline__ XcdBarrier xcd_barrier_post(unsigned* bar, volatile LAS unsigned* st) {
    XcdBarrier b; b.bar = bar; b.x = xb_xcc_id(); b.st = st;
    if (threadIdx.x == 0) (void)xb_add(&bar[XB_XCNT(b.x)], 1u);
    return b;
}
__device__ __forceinline__ void xcd_barrier_complete(unsigned* bar, unsigned x, unsigned& nloc, unsigned& nx) {
    const unsigned G = gridDim.x * gridDim.y * gridDim.z;
    unsigned sum, cnt, mine, sp = 0u;
    for (;;) {
        sum = 0u; cnt = 0u; mine = 0u;
#pragma unroll
        for (unsigned j = 0; j < 16; ++j) { const unsigned c = xb_ld(&bar[XB_XCNT(j)]); sum += c; cnt += (c > 0u) ? 1u : 0u; mine = (j == x) ? c : mine; }
        if (sum == G) break;
        __builtin_amdgcn_s_sleep(1);
        if ((++sp & 255u) == 0u) { if (xb_ld(&bar[XB_TMO])) break; if (sp > XB_SPIN_CAP) { atomicAdd(&bar[XB_TMO], 1u); break; } }
    }
    nloc = mine > 0u ? mine : 1u; nx = cnt > 0u ? cnt : 1u;
}

__device__ __forceinline__ void xcd_barrier(const XcdBarrier& b) {
    asm volatile("s_waitcnt vmcnt(0)" ::: "memory");
    __syncthreads();
    if (threadIdx.x == 0) {
        unsigned* bar = b.bar;
        __builtin_amdgcn_s_waitcnt(0);
        unsigned nloc = b.st[0], nx = b.st[1];
        if (nloc == 0u) { xcd_barrier_complete(bar, b.x, nloc, nx); b.st[0] = nloc; b.st[1] = nx; }
        const unsigned old = xb_add(&bar[XB_XSUB(b.x)], 1u);
        const unsigned gen = old / nloc;
        if (old + 1u == (gen + 1u) * nloc) {
            __builtin_amdgcn_fence(__ATOMIC_RELEASE, "agent");
            asm volatile("s_waitcnt vmcnt(0)" ::: "memory");
            const unsigned og = xb_add(&bar[XB_TOP], 1u);
            const unsigned tg = og / nx;
            if (og + 1u == (tg + 1u) * nx) xb_add(&bar[XB_TOPGEN], 1u);
            else XB_SPIN(xb_ld(&bar[XB_TOPGEN]) == tg, bar);
            __builtin_amdgcn_fence(__ATOMIC_ACQUIRE, "agent");
            xb_add(&bar[XB_XGEN(b.x)], 1u);
            asm volatile("s_waitcnt vmcnt(0)" ::: "memory");
        } else {
            XB_SPIN(xb_ld(&bar[XB_XGEN(b.x)]) == gen, bar);
            __builtin_amdgcn_fence(__ATOMIC_ACQUIRE, "agent");
            asm volatile("s_waitcnt vmcnt(0)" ::: "memory");
        }
    }
    __syncthreads();
}


DI void run_phase(const DP& p, int ph, int dry) {
  if (ph == 0) { phase0(p); wconv_phase(p, 0); return; }
  int q = ph - 1, layer, lp;
  if (q < 10) { layer = 0; lp = q; } else if (q < 18) { layer = 1; lp = q - 10; } else if (q < 28) { layer = 2; lp = q - 18; } else { layer = 3; lp = q - 28; }
  const int j = layer >> 1;
  const bool even = (layer & 1) == 0;
  int op, gsel = 0;
  if (even) {
    op = (int)((0x2272654321ull >> (4 * lp)) & 15ull); gsel = (int)((0x3201000000ull >> (4 * lp)) & 15ull);
  } else {
    op = (int)((0x22729821ull >> (4 * lp)) & 15ull); gsel = (int)((0x32010000ull >> (4 * lp)) & 15ull);
  }
  if (op == 1 && layer != 0) wconv_phase(p, layer);
  if (op == 1 || op == 7) {
    const bool first = op == 1;
    norm_phase(p, layer, (first ? p.norm_mix_g : p.norm_ff_g) + layer * 1024, first ? 0 : 3, first ? 1 : 4);
  } else if (op == 2) {
    int mode, lda, N, K, gch; size_t offA, offB;
    if (gsel == 0) { mode = even ? EPI_EVEN_IN : EPI_ODD_IN; offA = OFF_MIX; lda = 1024; offB = OFF_WIN; N = even ? 5168 : 2304; K = 1024; gch = 0; }
    else if (gsel == 1) { mode = EPI_RESID; offA = OFF_MIX; lda = even ? 2048 : 1024; offB = OFF_WOUT; N = 1024; K = even ? 2048 : 1024; gch = 2; }
    else if (gsel == 2) { mode = EPI_RELU2; offA = OFF_MIX; lda = 1024; offB = OFF_WFF1; N = 4096; K = 1024; gch = 0; }
    else { mode = EPI_RESID; offA = OFF_ACT; lda = 4096; offB = OFF_WFF2; N = 1024; K = 4096; gch = 5; }
    if (dry && mode == EPI_RESID) mode = 4;
    gemm_phase(p, mode, wsp<bfr>(p, offA), lda, wsp<bfr>(p, offB), N, K, layer, gch, (layer == 3 && gsel != 0) ? RL / 128 : R / 128);
  } else if (op == 3) conv_dt_phase(p, j);
  else if (op == 4) s1f1_phase(p);
  else if (op == 5) s2f2_phase(p, j);
  else if (op == 6) s3_phase(p, j);
  else if (op == 8) qkprep_phase(p, j);
  else if (op == 9) attn_phase(p, j);
}

DI int probe_reps(int ph) {
#ifdef PROBE_MASK
  if (ph == 0) return (PROBE_MASK & 1) ? 2 : 1;
  int q = ph - 1, layer, lp;
  if (q < 10) { layer = 0; lp = q; } else if (q < 18) { layer = 1; lp = q - 10; } else if (q < 28) { layer = 2; lp = q - 18; } else { layer = 3; lp = q - 28; }
  const bool even = (layer & 1) == 0;
  int op, gsel;
  if (even) { op = (int)((0x2272654321ull >> (4 * lp)) & 15ull); gsel = (int)((0x3201000000ull >> (4 * lp)) & 15ull); }
  else { op = (int)((0x22729821ull >> (4 * lp)) & 15ull); gsel = (int)((0x32010000ull >> (4 * lp)) & 15ull); }
  if (op == 5) return 1;
  if (op == 2 && (gsel == 1 || gsel == 3)) return ((PROBE_MASK >> 10) & 1) ? 2 : 1;
  return ((PROBE_MASK >> op) & 1) ? 2 : 1;
#else
  return 1;
#endif
}

__shared__ uint4 xb_words;

__global__ void __launch_bounds__(256, 2) mega(Params p, int ph0, int ph1) {
  cg::grid_group grid = cg::this_grid();
  if (threadIdx.x == 0) xb_words = make_uint4(0u, 0u, 0u, 0u);
  __syncthreads();
  XcdBarrier xb = xcd_barrier_post((unsigned*)(p.ws + OFF_BAR), (volatile LAS unsigned*)&xb_words);
#pragma unroll 1
  for (int ph = ph0; ph < ph1; ++ph) {
    const int nrep = probe_reps(ph);
#pragma unroll 1
    for (int rep = 0; rep < nrep; ++rep) {
      DP q;
      (Params&)q = p;
      int t = threadIdx.x, bb = blockIdx.x;
      asm volatile("" : "+v"(t));
      asm volatile("" : "+s"(bb));
      int z0;
      asm volatile("s_mov_b32 %0, 0" : "=s"(z0));
      q.ws = p.ws + z0;
      q.out = p.out + z0;
      q.tidl = t; q.bidl = bb;
      run_phase(q, ph, rep + 1 < nrep);
    }
    if (ph + 1 < ph1) {
      if (ph == ph0) grid.sync();
      else xcd_barrier(xb);
    }
  }
}

extern "C" void kernel_launch(void* const* d_in, const int* in_sizes, int n_in, void* d_out, int out_size, void* d_ws,
                              size_t ws_size, hipStream_t stream) {
  static int grid_blocks = 0;
  if (!grid_blocks) {
    int dev = 0, cus = 0, per_cu = 0;
    hipGetDevice(&dev);
    hipDeviceGetAttribute(&cus, hipDeviceAttributeMultiprocessorCount, dev);
    hipOccupancyMaxActiveBlocksPerMultiprocessor(&per_cu, mega, 256, 0);
    if (per_cu > 2) per_cu = 2;
    if (per_cu < 1) per_cu = 1;
    grid_blocks = cus * per_cu;
  }
  Params p{};
  const float** pp = (const float**)&p;
  for (int i = 0; i < 26; ++i) pp[i] = (const float*)d_in[i];
  p.out = (float*)d_out;
  p.ws = (unsigned char*)d_ws;
  if (ws_size < WS_TOTAL) fprintf(stderr, "workspace too small: %zu < %zu\n", ws_size, (size_t)WS_TOTAL);
  hipMemsetAsync((unsigned char*)d_ws + OFF_BAR, 0, XCD_BAR_WORDS * 4, stream);
#if MULTI_LAUNCH
  for (int ph = 0; ph < NPHASE; ++ph) {
    int a = ph, b = ph + 1;
    void* args[] = {&p, &a, &b};
    hipLaunchCooperativeKernel((void*)mega, dim3(grid_blocks), dim3(256), args, 0, stream);
  }
#else
  int a = 0, b = NPHASE;
  void* args[] = {&p, &a, &b};
  hipError_t e = hipLaunchCooperativeKernel((void*)mega, dim3(grid_blocks), dim3(256), args, 0, stream);
  if (e != hipSuccess) fprintf(stderr, "cooperative launch failed: %s (grid %d)\n", hipGetErrorString(e), grid_blocks);
#endif
}
```

```cpp
#include <hip/hip_runtime.h>
#include <hip/hip_cooperative_groups.h>
#include <cstdio>
namespace cg = cooperative_groups;

typedef unsigned short bfr;
typedef __attribute__((ext_vector_type(8))) short bf16x8;
typedef __attribute__((ext_vector_type(4))) short bf16x4;
typedef __attribute__((ext_vector_type(16))) float f32x16;
#define DI __device__ __forceinline__
#define MFMA(a, b, c) __builtin_amdgcn_mfma_f32_32x32x16_bf16((a), (b), (c), 0, 0, 0)

#ifndef MULTI_LAUNCH
#define MULTI_LAUNCH 0
#endif

constexpr int RL = 16384, R = 16896, SEQ = 8192, CTX = 256;
constexpr int NCH = 33, CL = 256;
constexpr int NPHASE = 37;

constexpr size_t al(size_t x) { return (x + 255) & ~size_t(255); }
constexpr size_t OFF_HC = 0;
constexpr size_t OFF_MOD = OFF_HC + al(512 * 1024 * 4);
constexpr size_t OFF_TW = OFF_MOD + al(4 * 3 * 6144 * 4);
constexpr size_t OFF_C128 = OFF_TW + al(8192 * 8);
constexpr size_t OFF_S128 = OFF_C128 + al(128 * 128 * 2);
constexpr size_t OFF_C64 = OFF_S128 + al(128 * 128 * 2);
constexpr size_t OFF_S64 = OFF_C64 + al(64 * 64 * 2);
constexpr size_t OFF_C256 = OFF_S64 + al(64 * 64 * 2);
constexpr size_t OFF_S256 = OFF_C256 + al(256 * 256 * 2);
constexpr size_t OFF_ROPE = OFF_S256 + al(256 * 256 * 2);
constexpr size_t OFF_DTV = OFF_ROPE + al(2 * 2 * 128 * 16 * 4);
constexpr size_t DT_BYTES = (size_t)2 * 2 * NCH * 24 * 256 * 4;
constexpr size_t OFF_ACUM = OFF_DTV + al(DT_BYTES);
constexpr size_t OFF_WIN = OFF_ACUM + al(DT_BYTES);
constexpr size_t OFF_WOUT = OFF_WIN + al((size_t)5248 * 1024 * 2);
constexpr size_t OFF_WFF1 = OFF_WOUT + al((size_t)1024 * 2048 * 2);
constexpr size_t OFF_WFF2 = OFF_WFF1 + al((size_t)4096 * 1024 * 2);
constexpr size_t OFF_MIX = OFF_WFF2 + al((size_t)4096 * 1024 * 2);
constexpr size_t OFF_BIG = OFF_MIX + al((size_t)R * 2048 * 2);
constexpr size_t OFF_Z = OFF_BIG;
constexpr size_t OFF_ZRT = OFF_Z + (size_t)R * 1536 * 2;
constexpr size_t OFF_ZIT = OFF_ZRT + (size_t)512 * R * 2;
constexpr size_t OFF_XBC = OFF_ZIT + (size_t)512 * R * 2;
constexpr size_t OFF_DTRAW = OFF_XBC + (size_t)R * 2560 * 2;
constexpr size_t BIG_END = OFF_DTRAW + (size_t)R * 48 * 4;
constexpr size_t OFF_HS = OFF_XBC;
constexpr size_t HS_BYTES = (size_t)2 * 2 * NCH * 24 * 8192 * 2;
constexpr size_t OFF_YR = OFF_HS + HS_BYTES;
constexpr size_t OFF_YI = OFF_YR + (size_t)2 * 512 * 128 * 64 * 2;
static_assert(OFF_YI + (size_t)2 * 512 * 128 * 64 * 2 <= OFF_DTRAW, "fft scratch overflows");
constexpr size_t OFF_ACT = OFF_BIG;
static_assert((size_t)R * 4096 * 2 <= BIG_END - OFF_BIG, "act overflows");
constexpr size_t OFF_P = OFF_BIG;
constexpr size_t OFF_VT = OFF_P + (size_t)R * 2304 * 2;
constexpr size_t OFF_QK = OFF_VT + (size_t)640 * R * 2;
static_assert(OFF_QK + (size_t)R * 1664 * 2 <= BIG_END, "odd overflows");
constexpr size_t OFF_XT = al(BIG_END);
constexpr size_t OFF_BN = OFF_XT + (size_t)1536 * R * 2;
constexpr size_t OFF_BT = OFF_BN + (size_t)R * 512 * 2;
constexpr size_t OFF_CN = OFF_BT + (size_t)512 * R * 2;
constexpr size_t OFF_BAR = al(OFF_CN + (size_t)R * 512 * 2);
constexpr size_t WS_TOTAL = OFF_BAR + 16384;
static_assert(WS_TOTAL <= 402653184ull, "workspace too large");

struct Params {
  const float *x, *c, *ctx, *c_ctx, *w_mod, *b_mod, *norm_mix_g, *norm_ff_g, *w_ff1, *w_ff2;
  const float *w_in_even, *conv_w, *conv_b, *dt_bias, *a_log, *d_skip, *ssd_norm_g, *w_out_even;
  const float *w_in_odd, *q_norm_win, *k_norm_win, *sink_win, *q_norm_na, *k_norm_na, *rpb_na, *w_out_odd;
  float* out;
  unsigned char* ws;
};

struct DP : Params { int tidl, bidl; };

__shared__ __attribute__((aligned(16))) unsigned char smem[73728];

typedef __attribute__((ext_vector_type(2))) __bf16 bf2_t;
typedef __attribute__((ext_vector_type(2))) float f2_t;
typedef __attribute__((ext_vector_type(4))) unsigned u32x4_t;
typedef __attribute__((ext_vector_type(2))) unsigned u32x2_t;
DI unsigned pk2(float a, float b) { f2_t v = {a, b}; return __builtin_bit_cast(unsigned, __builtin_convertvector(v, bf2_t)); }
DI bfr f2bf(float x) { return (bfr)(pk2(x, 0.f) & 0xffffu); }
DI float bf2f(bfr b) { return __uint_as_float(((unsigned)b) << 16); }
DI float bfs(short s) { return __uint_as_float(((unsigned)(unsigned short)s) << 16); }
DI int crow(int i, int h) { return (i & 3) + 8 * (i >> 2) + 4 * h; }
DI f32x16 zero16() { f32x16 z; for (int i = 0; i < 16; ++i) z[i] = 0.f; return z; }
DI bf16x8 pack8(float a0, float a1, float a2, float a3, float a4, float a5, float a6, float a7) {
  u32x4_t v = {pk2(a0, a1), pk2(a2, a3), pk2(a4, a5), pk2(a6, a7)};
  return __builtin_bit_cast(bf16x8, v);
}
DI bf16x4 pack4(float a0, float a1, float a2, float a3) {
  u32x2_t v = {pk2(a0, a1), pk2(a2, a3)};
  return __builtin_bit_cast(bf16x4, v);
}
#define PACK_HALF(s, s2) pack8(s[8 * (s2)], s[8 * (s2) + 1], s[8 * (s2) + 2], s[8 * (s2) + 3], s[8 * (s2) + 4], s[8 * (s2) + 5], s[8 * (s2) + 6], s[8 * (s2) + 7])
DI bf16x8 join44(bf16x4 lo, bf16x4 hi) { return __builtin_shufflevector(lo, hi, 0, 1, 2, 3, 4, 5, 6, 7); }
DI int chunk_row0(int b, int c) { return c == 0 ? RL + b * CTX : b * SEQ + (c - 1) * CL; }

DI void sincos_turn(double f, float& s, float& c) {
  f -= rint(f);
  double x = f * 6.283185307179586476925;
  double x2 = x * x, ss = 1.0, cc = 1.0;
#pragma unroll
  for (int k = 13; k >= 1; --k) {
    ss = 1.0 - x2 / (double)((2 * k) * (2 * k + 1)) * ss;
    cc = 1.0 - x2 / (double)((2 * k - 1) * (2 * k)) * cc;
  }
  s = (float)(x * ss); c = (float)cc;
}

template <class T> DI T* wsp(const DP& p, size_t off) { return (T*)(p.ws + off); }

DI void phase0(const DP& p) {
  const int tid = p.tidl, bid = p.bidl, G = gridDim.x;
  float* lds = (float*)smem;
  float* MOD = wsp<float>(p, OFF_MOD);
  for (int u = bid; u < 384; u += G) {
    int layer = u / 96, cb = u % 96;
    for (int i = tid; i < 3072; i += 256) {
      int v = i >> 10, k = i & 1023;
      float c = v < 2 ? p.c[v * 1024 + k] : p.c_ctx[k];
      lds[i] = c / (1.f + expf(-c));
    }
    __syncthreads();
    int kq = tid >> 6, cc = tid & 63, col = cb * 64 + cc;
    const float* w = p.w_mod + (size_t)layer * 1024 * 6144 + col;
    float a0 = 0, a1 = 0, a2 = 0;
    for (int k = kq * 256; k < kq * 256 + 256; ++k) {
      float wv = w[(size_t)k * 6144];
      a0 += lds[k] * wv; a1 += lds[1024 + k] * wv; a2 += lds[2048 + k] * wv;
    }
    float* red = lds + 3072;
    red[(kq * 3 + 0) * 64 + cc] = a0; red[(kq * 3 + 1) * 64 + cc] = a1; red[(kq * 3 + 2) * 64 + cc] = a2;
    __syncthreads();
    if (tid < 192) {
      int v = tid >> 6;
      float s = red[(0 * 3 + v) * 64 + cc] + red[(1 * 3 + v) * 64 + cc] + red[(2 * 3 + v) * 64 + cc] + red[(3 * 3 + v) * 64 + cc];
      MOD[(layer * 3 + v) * 6144 + col] = s + p.b_mod[layer * 6144 + col];
    }
    __syncthreads();
  }
  const int gt = bid * 256 + tid, nt = G * 256;
  {
    const float4* xs = (const float4*)p.x; float4* od = (float4*)p.out;
    for (int i = gt; i < RL * 256; i += nt) od[i] = xs[i];
    const float4* cs = (const float4*)p.ctx; float4* hd = wsp<float4>(p, OFF_HC);
    for (int i = gt; i < 512 * 256; i += nt) hd[i] = cs[i];
  }
  float2* TW = wsp<float2>(p, OFF_TW);
  for (int i = gt; i < 8192; i += nt) { float s, c; sincos_turn((double)i / 8192.0, s, c); TW[i] = make_float2(c, s); }
  bfr* C128 = wsp<bfr>(p, OFF_C128); bfr* S128 = wsp<bfr>(p, OFF_S128);
  for (int i = gt; i < 128 * 128; i += nt) { int a = i >> 7, b = i & 127; float s, c; sincos_turn((double)((a * b) & 127) / 128.0, s, c); C128[i] = f2bf(c); S128[i] = f2bf(s); }
  bfr* C64 = wsp<bfr>(p, OFF_C64); bfr* S64 = wsp<bfr>(p, OFF_S64);
  for (int i = gt; i < 64 * 64; i += nt) { int a = i >> 6, b = i & 63; float s, c; sincos_turn((double)((a * b) & 63) / 64.0, s, c); C64[i] = f2bf(c); S64[i] = f2bf(s); }
  bfr* C256 = wsp<bfr>(p, OFF_C256); bfr* S256 = wsp<bfr>(p, OFF_S256);
  for (int i = gt; i < 256 * 256; i += nt) { int a = i >> 8, b = i & 255; float s, c; sincos_turn((double)((a * b) & 255) / 256.0, s, c); C256[i] = f2bf(c); S256[i] = f2bf(s); }
  float* ROPE = wsp<float>(p, OFF_ROPE);
  for (int i = gt; i < 2 * 128 * 16; i += nt) {
    int f = i & 15, idx = (i >> 4) & 127;
    float ang = (float)idx * (float)exp(-(double)f * 0.5756462732485115);
    float s, c; sincos_turn((double)ang / 6.283185307179586476925, s, c);
    ROPE[i] = c; ROPE[4096 + i] = s;
  }
}

DI void tcvt_unit(const float* __restrict__ src, int ld, int c0, int ncols, int K, bfr* __restrict__ dst, int dr0, int u, int tid) {
  const int ntk = K >> 6;
  const int tn = u / ntk, tk = u % ntk, k0 = tk * 64, nb = tn * 64;
  bfr* T = (bfr*)smem;
  float4 v[4];
  const int n4 = (tid & 15) * 4;
#pragma unroll
  for (int i = 0; i < 4; ++i) {
    const int kk = (tid >> 4) + 16 * i;
    v[i] = make_float4(0.f, 0.f, 0.f, 0.f);
    if (nb + n4 < ncols) v[i] = *(const float4*)(src + (size_t)(k0 + kk) * ld + c0 + nb + n4);
  }
#pragma unroll
  for (int i = 0; i < 4; ++i) {
    const int kk = (tid >> 4) + 16 * i;
    T[(n4 + 0) * 72 + kk] = f2bf(v[i].x); T[(n4 + 1) * 72 + kk] = f2bf(v[i].y);
    T[(n4 + 2) * 72 + kk] = f2bf(v[i].z); T[(n4 + 3) * 72 + kk] = f2bf(v[i].w);
  }
  __syncthreads();
  {
    int n = tid >> 2, kseg = (tid & 3) * 16;
    if (nb + n < ncols) {
      bfr* d = dst + (size_t)(dr0 + nb + n) * K + k0 + kseg;
      *(bf16x8*)d = *(const bf16x8*)(T + n * 72 + kseg);
      *(bf16x8*)(d + 8) = *(const bf16x8*)(T + n * 72 + kseg + 8);
    }
  }
  __syncthreads();
}

DI void wconv_phase(const DP& p, int layer) {
  const int tid = p.tidl;
  const int j = layer >> 1;
  bfr* WIN = wsp<bfr>(p, OFF_WIN); bfr* WOUT = wsp<bfr>(p, OFF_WOUT);
  bfr* WFF1 = wsp<bfr>(p, OFF_WFF1); bfr* WFF2 = wsp<bfr>(p, OFF_WFF2);
  const float* ff1 = p.w_ff1 + (size_t)layer * 1024 * 4096;
  const float* ff2 = p.w_ff2 + (size_t)layer * 4096 * 1024;
  float* cst = (float*)(smem + 20480);
  if (tid < 64) { float s, c; sincos_turn((double)tid / 64.0, s, c); cst[tid] = c; cst[64 + tid] = s; }
  __syncthreads();
  if ((layer & 1) == 0) {
    const float* win = p.w_in_even + (size_t)j * 1024 * 4656;
    const float* wout = p.w_out_even + (size_t)j * 2048 * 1024;
    const int n_in = 65 * 16, n_out = 16 * 32, n_f1 = 64 * 16, n_f2 = 16 * 64, n_fold = 128;
    const int total = n_in + n_out + n_f1 + n_f2 + n_fold;
    for (int u = p.bidl; u < total; u += gridDim.x) {
      int v = u;
      if (v < n_in) { tcvt_unit(win, 4656, 512, 4144, 1024, WIN, 1024, v, tid); continue; }
      v -= n_in;
      if (v < n_out) { tcvt_unit(wout, 1024, 0, 1024, 2048, WOUT, 0, v, tid); continue; }
      v -= n_out;
      if (v < n_f1) { tcvt_unit(ff1, 4096, 0, 4096, 1024, WFF1, 0, v, tid); continue; }
      v -= n_f1;
      if (v < n_f2) { tcvt_unit(ff2, 1024, 0, 1024, 4096, WFF2, 0, v, tid); continue; }
      v -= n_f2;
      {
        const int g = v >> 4, kb = v & 15;
        float* wt = (float*)smem;
#pragma unroll
        for (int i = 0; i < 4; ++i) {
          const int idx = tid + 256 * i, kk = idx >> 4, j4 = (idx & 15) * 4;
          const float4 wv = *(const float4*)(win + (size_t)(kb * 64 + kk) * 4656 + g * 64 + j4);
          wt[kk * 65 + j4] = wv.x; wt[kk * 65 + j4 + 1] = wv.y; wt[kk * 65 + j4 + 2] = wv.z; wt[kk * 65 + j4 + 3] = wv.w;
        }
        __syncthreads();
        const int kl = tid & 63, mg = tid >> 6;
#pragma unroll 1
        for (int mi = 0; mi < 16; ++mi) {
          const int m = mg * 16 + mi;
          float sc = 0.f, ss = 0.f;
#pragma unroll 8
          for (int jj = 0; jj < 64; ++jj) { const float w = wt[kl * 65 + jj]; const int idx = (m * jj) & 63; sc += w * cst[idx]; ss += w * cst[64 + idx]; }
          const int ch = g * 64 + m, k = kb * 64 + kl;
          WIN[(size_t)ch * 1024 + k] = f2bf(sc);
          WIN[(size_t)(512 + ch) * 1024 + k] = f2bf(-ss);
        }
        __syncthreads();
      }
    }
  } else {
    const float* win = p.w_in_odd + (size_t)j * 1024 * 2304;
    const float* wout = p.w_out_odd + (size_t)j * 1024 * 1024;
    const int n_in = 36 * 16, n_out = 16 * 16, n_f1 = 64 * 16, n_f2 = 16 * 64;
    const int total = n_in + n_out + n_f1 + n_f2;
    for (int u = p.bidl; u < total; u += gridDim.x) {
      int v = u;
      if (v < n_in) { tcvt_unit(win, 2304, 0, 2304, 1024, WIN, 0, v, tid); continue; }
      v -= n_in;
      if (v < n_out) { tcvt_unit(wout, 1024, 0, 1024, 1024, WOUT, 0, v, tid); continue; }
      v -= n_out;
      if (v < n_f1) { tcvt_unit(ff1, 4096, 0, 4096, 1024, WFF1, 0, v, tid); continue; }
      v -= n_f1;
      tcvt_unit(ff2, 1024, 0, 1024, 4096, WFF2, 0, v, tid);
    }
  }
}

DI void norm_phase(const DP& p, int layer, const float* __restrict__ gvec, int shc, int scc) {
  const int lane = p.tidl & 63;
  const int wg = p.bidl * 4 + (p.tidl >> 6), nw = gridDim.x * 4;
  const float* MOD = wsp<float>(p, OFF_MOD);
  const float* HC = wsp<float>(p, OFF_HC);
  bfr* U = wsp<bfr>(p, OFF_MIX);
  for (int row = wg; row < R; row += nw) {
    const float* hp = row < RL ? p.out + (size_t)row * 1024 : HC + (size_t)(row - RL) * 1024;
    const int ms = row < RL ? (row >> 13) : 2;
    const float* md = MOD + (layer * 3 + ms) * 6144;
    float4 v[4]; float ss = 0.f;
#pragma unroll
    for (int i = 0; i < 4; ++i) {
      v[i] = *(const float4*)(hp + i * 256 + lane * 4);
      ss += v[i].x * v[i].x + v[i].y * v[i].y + v[i].z * v[i].z + v[i].w * v[i].w;
    }
#pragma unroll
    for (int o = 32; o >= 1; o >>= 1) ss += __shfl_xor(ss, o);
    const float rs = rsqrtf(ss * (1.f / 1024.f) + 1e-6f);
#pragma unroll
    for (int i = 0; i < 4; ++i) {
      int col = i * 256 + lane * 4;
      float4 g = *(const float4*)(gvec + col);
      float4 sc = *(const float4*)(md + scc * 1024 + col);
      float4 sh = *(const float4*)(md + shc * 1024 + col);
      bf16x4 o = pack4(v[i].x * rs * g.x * (1.f + sc.x) + sh.x, v[i].y * rs * g.y * (1.f + sc.y) + sh.y,
                       v[i].z * rs * g.z * (1.f + sc.z) + sh.z, v[i].w * rs * g.w * (1.f + sc.w) + sh.w);
      *(bf16x4*)(U + (size_t)row * 1024 + col) = o;
    }
  }
}

enum { EPI_EVEN_IN = 0, EPI_ODD_IN = 1, EPI_RELU2 = 2, EPI_RESID = 3 };

DI void gemm_phase(const DP& p, int mode, const bfr* __restrict__ A, int lda, const bfr* __restrict__ Bt,
                   int N, int K, int layer, int gchunk, int nM) {
  const int tid = p.tidl, lane = tid & 63, wid = tid >> 6, r = lane & 31, h = lane >> 5;
  const int wm = wid >> 1, wn = wid & 1;
  const int nN = (N + 127) >> 7;
  const int tiles = nM * nN, G = (int)gridDim.x;
  int full = tiles, tail = 0, St = 1;
  if (mode == EPI_RESID) {
    full = (tiles / G) * G; tail = tiles - full;
    if (tail > 0) { int c = G / tail; int kmax = K >> 7; St = 1; while (St * 2 <= c && St * 2 <= 16 && St * 2 <= kmax) St *= 2; }
  }
  const int chunk = (full + 7) >> 3;
  const int units = chunk * 8 + tail * St;
  bfr* sm = (bfr*)smem;
  const int lrow = tid >> 3, lc = (tid & 7) * 8;
#pragma unroll 1
  for (int u = p.bidl; u < units; u += G) {
    int t, ks, Ks; bool atom;
    if (u < chunk * 8) {
      t = (u & 7) * chunk + (u >> 3);
      if (t >= full) continue;
      ks = 0; Ks = K; atom = false;
    } else { const int v = u - chunk * 8; t = full + v / St; ks = v % St; Ks = K / St; atom = St > 1; }
    const int nk = Ks >> 6;
    const int panel = t / (nM * 8); const int rem = t - panel * nM * 8;
    const int pw = (nN - panel * 8) < 8 ? (nN - panel * 8) : 8;
    const int tm = rem / pw, tn = panel * 8 + rem % pw;
    const int m0 = tm * 128, n0 = tn * 128, kbase = ks * Ks;
    f32x16 acc[2][2];
    acc[0][0] = zero16(); acc[0][1] = zero16(); acc[1][0] = zero16(); acc[1][1] = zero16();
    const bfr* Ag = A + (size_t)(m0 + lrow) * lda + kbase + lc;
    const bfr* Bg = Bt + (size_t)(n0 + lrow) * K + kbase + lc;
    bf16x8 ra[4], rb[4];
#pragma unroll
    for (int i = 0; i < 4; ++i) {
      ra[i] = *(const bf16x8*)(Ag + (size_t)(32 * i) * lda);
      rb[i] = *(const bf16x8*)(Bg + (size_t)(32 * i) * K);
    }
#pragma unroll
    for (int i = 0; i < 4; ++i) {
      *(bf16x8*)(sm + (lrow + 32 * i) * 72 + lc) = ra[i];
      *(bf16x8*)(sm + 9216 + (lrow + 32 * i) * 72 + lc) = rb[i];
    }
    if (nk > 1) {
#pragma unroll
      for (int i = 0; i < 4; ++i) {
        ra[i] = *(const bf16x8*)(Ag + (size_t)(32 * i) * lda + 64);
        rb[i] = *(const bf16x8*)(Bg + (size_t)(32 * i) * K + 64);
      }
    }
    __syncthreads();
#pragma unroll 1
    for (int kt = 0; kt < nk; ++kt) {
      if (kt + 1 < nk) {
        bfr* Ad = sm + ((kt + 1) & 1) * 18432;
#pragma unroll
        for (int i = 0; i < 4; ++i) {
          *(bf16x8*)(Ad + (lrow + 32 * i) * 72 + lc) = ra[i];
          *(bf16x8*)(Ad + 9216 + (lrow + 32 * i) * 72 + lc) = rb[i];
        }
      }
      if (kt + 2 < nk) {
#pragma unroll
        for (int i = 0; i < 4; ++i) {
          ra[i] = *(const bf16x8*)(Ag + (size_t)(32 * i) * lda + (kt + 2) * 64);
          rb[i] = *(const bf16x8*)(Bg + (size_t)(32 * i) * K + (kt + 2) * 64);
        }
      }
      const bfr* As = sm + (kt & 1) * 18432;
      const bfr* Bs = As + 9216;
      __builtin_amdgcn_s_setprio(1);
#pragma unroll
      for (int kk = 0; kk < 4; ++kk) {
        bf16x8 a0 = *(const bf16x8*)(As + (wm * 64 + r) * 72 + kk * 16 + h * 8);
        bf16x8 a1 = *(const bf16x8*)(As + (wm * 64 + 32 + r) * 72 + kk * 16 + h * 8);
        bf16x8 b0 = *(const bf16x8*)(Bs + (wn * 64 + r) * 72 + kk * 16 + h * 8);
        bf16x8 b1 = *(const bf16x8*)(Bs + (wn * 64 + 32 + r) * 72 + kk * 16 + h * 8);
        acc[0][0] = MFMA(a0, b0, acc[0][0]);
        acc[0][1] = MFMA(a0, b1, acc[0][1]);
        acc[1][0] = MFMA(a1, b0, acc[1][0]);
        acc[1][1] = MFMA(a1, b1, acc[1][1]);
      }
      __builtin_amdgcn_s_setprio(0);
      __syncthreads();
    }
#pragma unroll
    for (int mi = 0; mi < 2; ++mi)
#pragma unroll
      for (int ni = 0; ni < 2; ++ni)
#pragma unroll
        for (int g4 = 0; g4 < 4; ++g4) {
          const int row = m0 + wm * 64 + mi * 32 + 8 * g4 + 4 * h;
          const int col = n0 + wn * 64 + ni * 32 + r;
          const float v0 = acc[mi][ni][4 * g4], v1 = acc[mi][ni][4 * g4 + 1], v2 = acc[mi][ni][4 * g4 + 2], v3 = acc[mi][ni][4 * g4 + 3];
          if (mode == EPI_EVEN_IN) {
            if (col < 1024) {
              bfr* dst = wsp<bfr>(p, col < 512 ? OFF_ZRT : OFF_ZIT) + (size_t)(col & 511) * R + row;
              *(bf16x4*)dst = pack4(v0, v1, v2, v3);
            } else if (col < 2560) {
              bfr* dst = wsp<bfr>(p, OFF_Z) + (size_t)row * 1536 + (col - 1024);
              dst[0] = f2bf(v0); dst[1536] = f2bf(v1); dst[2 * 1536] = f2bf(v2); dst[3 * 1536] = f2bf(v3);
            } else if (col < 5120) {
              bfr* dst = wsp<bfr>(p, OFF_XBC) + (size_t)row * 2560 + (col - 2560);
              dst[0] = f2bf(v0); dst[2560] = f2bf(v1); dst[2 * 2560] = f2bf(v2); dst[3 * 2560] = f2bf(v3);
            } else if (col < 5168) {
              float* dst = wsp<float>(p, OFF_DTRAW) + (size_t)row * 48 + (col - 5120);
              dst[0] = v0; dst[48] = v1; dst[96] = v2; dst[144] = v3;
            }
          } else if (mode == EPI_ODD_IN) {
            if (col >= 640 && col < 768) {
              *(bf16x4*)(wsp<bfr>(p, OFF_VT) + (size_t)(col - 640) * R + row) = pack4(v0, v1, v2, v3);
            } else if (col >= 1792) {
              *(bf16x4*)(wsp<bfr>(p, OFF_VT) + (size_t)(128 + col - 1792) * R + row) = pack4(v0, v1, v2, v3);
            } else {
              bfr* dst = wsp<bfr>(p, OFF_P) + (size_t)row * 2304 + col;
              dst[0] = f2bf(v0); dst[2304] = f2bf(v1); dst[2 * 2304] = f2bf(v2); dst[3 * 2304] = f2bf(v3);
            }
          } else if (mode == EPI_RELU2) {
            bfr* dst = wsp<bfr>(p, OFF_ACT) + (size_t)row * 4096 + col;
            float t0 = fmaxf(v0, 0.f), t1 = fmaxf(v1, 0.f), t2 = fmaxf(v2, 0.f), t3 = fmaxf(v3, 0.f);
            dst[0] = f2bf(t0 * t0); dst[4096] = f2bf(t1 * t1); dst[2 * 4096] = f2bf(t2 * t2); dst[3 * 4096] = f2bf(t3 * t3);
          } else if (mode == EPI_RESID) {
            const int ms = row < RL ? (row >> 13) : 2;
            const float gate = wsp<float>(p, OFF_MOD)[(layer * 3 + ms) * 6144 + gchunk * 1024 + col];
            float* hp = row < RL ? p.out + (size_t)row * 1024 + col : wsp<float>(p, OFF_HC) + (size_t)(row - RL) * 1024 + col;
            if (atom) {
              unsafeAtomicAdd(hp, gate * v0); unsafeAtomicAdd(hp + 1024, gate * v1);
              unsafeAtomicAdd(hp + 2048, gate * v2); unsafeAtomicAdd(hp + 3072, gate * v3);
            } else {
              hp[0] += gate * v0; hp[1024] += gate * v1; hp[2048] += gate * v2; hp[3072] += gate * v3;
            }
          }
        }
  }
}

DI float softplus_f(float x) { return x > 0.f ? x + log1pf(expf(-x)) : log1pf(expf(x)); }

DI void conv_dt_phase(const DP& p, int j) {
  const int tid = p.tidl, lane = tid & 63, wid = tid >> 6;
  const bfr* XBC = wsp<bfr>(p, OFF_XBC);
  bfr* XT = wsp<bfr>(p, OFF_XT); bfr* BN = wsp<bfr>(p, OFF_BN); bfr* BTt = wsp<bfr>(p, OFF_BT); bfr* CN = wsp<bfr>(p, OFF_CN);
  bfr* TT = (bfr*)smem;
  const float* cw = p.conv_w + (size_t)j * 5 * 2560;
  const float* cb = p.conv_b + (size_t)j * 2560;
  const int n_conv = 264 * 40, n_dt = 792;
  for (int u = p.bidl; u < n_conv + n_dt; u += gridDim.x) {
    if (u < n_conv) {
      const int tb = u / 40, cbk = u % 40, row0 = tb * 64, ch0 = cbk * 64;
      int pos0, len;
      if (row0 < RL) { pos0 = row0 & 8191; len = SEQ; } else { pos0 = (row0 - RL) & 255; len = CTX; }
      const int c8 = tid & 7, ch = ch0 + c8 * 8;
      float w[5][8], bias[8];
#pragma unroll
      for (int k = 0; k < 5; ++k) {
        float4 wa = *(const float4*)(cw + k * 2560 + ch), wb = *(const float4*)(cw + k * 2560 + ch + 4);
        w[k][0] = wa.x; w[k][1] = wa.y; w[k][2] = wa.z; w[k][3] = wa.w; w[k][4] = wb.x; w[k][5] = wb.y; w[k][6] = wb.z; w[k][7] = wb.w;
      }
      {
        float4 wa = *(const float4*)(cb + ch), wb = *(const float4*)(cb + ch + 4);
        bias[0] = wa.x; bias[1] = wa.y; bias[2] = wa.z; bias[3] = wa.w; bias[4] = wb.x; bias[5] = wb.y; bias[6] = wb.z; bias[7] = wb.w;
      }
#pragma unroll
      for (int ps = 0; ps < 2; ++ps) {
        const int tl = (tid >> 3) + 32 * ps, pos = pos0 + tl, row = row0 + tl;
        float a[8];
#pragma unroll
        for (int e = 0; e < 8; ++e) a[e] = bias[e];
        bf16x8 xr[5];
#pragma unroll
        for (int k = 0; k < 5; ++k) {
          const int pp = pos + k - 2;
          const bool ok = pp >= 0 && pp < len;
          const bfr* xp = XBC + (size_t)(ok ? row + k - 2 : row) * 2560 + ch;
          xr[k] = *(const bf16x8*)xp;
          if (!ok) { for (int e = 0; e < 8; ++e) xr[k][e] = 0; }
        }
#pragma unroll
        for (int k = 0; k < 5; ++k)
#pragma unroll
          for (int e = 0; e < 8; ++e) a[e] += w[k][e] * bfs(xr[k][e]);
        bf16x8 o;
#pragma unroll
        for (int e = 0; e < 8; ++e) { float s = a[e] / (1.f + __expf(-a[e])); o[e] = (short)f2bf(s); }
        if (ch0 >= 2048) *(bf16x8*)(CN + (size_t)row * 512 + (ch - 2048)) = o;
        else if (ch0 >= 1536) *(bf16x8*)(BN + (size_t)row * 512 + (ch - 1536)) = o;
        if (ch0 < 2048) {
#pragma unroll
          for (int e = 0; e < 8; ++e) TT[(c8 * 8 + e) * 72 + tl] = (bfr)o[e];
        }
      }
      if (ch0 < 2048) {
        __syncthreads();
        const int chl = tid >> 2, tseg = (tid & 3) * 16;
        bfr* dst = (ch0 < 1536 ? XT + (size_t)(ch0 + chl) * R : BTt + (size_t)(ch0 - 1536 + chl) * R) + row0 + tseg;
        *(bf16x8*)dst = *(const bf16x8*)(TT + chl * 72 + tseg);
        *(bf16x8*)(dst + 8) = *(const bf16x8*)(TT + chl * 72 + tseg + 8);
        __syncthreads();
      }
    } else {
      const int item = (u - n_conv) * 4 + wid;
      const int head = item % 24; int rest = item / 24; const int dir = rest & 1; rest >>= 1; const int c = rest % NCH, b = rest / NCH;
      const int row0 = chunk_row0(b, c), col = dir * 24 + head;
      const float bias = p.dt_bias[j * 48 + col];
      const float a = -expf(p.a_log[j * 48 + col]);
      const float* DTRAW = wsp<float>(p, OFF_DTRAW);
      float dt[4], cs[4];
      float run = 0.f;
#pragma unroll
      for (int q = 0; q < 4; ++q) {
        dt[q] = softplus_f(DTRAW[(size_t)(row0 + lane * 4 + q) * 48 + col] + bias);
        run += dt[q] * a; cs[q] = run;
      }
      float x = run;
#pragma unroll
      for (int o = 1; o < 64; o <<= 1) { float t2 = __shfl_up(x, o); if (lane >= o) x += t2; }
      const float excl = x - run;
      const float total = __shfl(x, 63);
      float ac[4];
#pragma unroll
      for (int q = 0; q < 4; ++q) {
        float inc = excl + cs[q];
        ac[q] = dir == 0 ? inc : total - inc + dt[q] * a;
      }
      const size_t base = ((size_t)(((dir * 2 + b) * NCH + c) * 24 + head)) * 256 + lane * 4;
      *(float4*)(wsp<float>(p, OFF_DTV) + base) = make_float4(dt[0], dt[1], dt[2], dt[3]);
      *(float4*)(wsp<float>(p, OFF_ACUM) + base) = make_float4(ac[0], ac[1], ac[2], ac[3]);
    }
  }
}

DI bf16x8 scale8(bf16x8 a, const float* w) {
  return pack8(bfs(a[0]) * w[0], bfs(a[1]) * w[1], bfs(a[2]) * w[2], bfs(a[3]) * w[3],
               bfs(a[4]) * w[4], bfs(a[5]) * w[5], bfs(a[6]) * w[6], bfs(a[7]) * w[7]);
}

DI void s1_item(const DP& p, int item, int lane) {
  const int r = lane & 31, h = lane >> 5;
  const int head = item % 24; int rest = item / 24; const int dir = rest & 1; rest >>= 1; const int c = rest % NCH, b = rest / NCH;
  const int g = head / 6;
  const int row0 = chunk_row0(b, c);
  const size_t dbase = ((size_t)(((dir * 2 + b) * NCH + c) * 24 + head)) * 256;
  const float* dtv = wsp<float>(p, OFF_DTV) + dbase;
  const float* acm = wsp<float>(p, OFF_ACUM) + dbase;
  const float acend = dir == 0 ? acm[255] : acm[0];
  const bfr* XT = wsp<bfr>(p, OFF_XT); const bfr* BTt = wsp<bfr>(p, OFF_BT);
  bfr* HS = wsp<bfr>(p, OFF_HS) + ((size_t)(((dir * 2 + b) * NCH + c) * 24 + head)) * 8192;
#pragma unroll 1
  for (int pt = 0; pt < 2; ++pt) {
    f32x16 acc[4];
#pragma unroll
    for (int n = 0; n < 4; ++n) acc[n] = zero16();
#pragma unroll 4
    for (int kk = 0; kk < 16; ++kk) {
      const int s0 = kk * 16 + 8 * h;
      float4 d0 = *(const float4*)(dtv + s0), d1 = *(const float4*)(dtv + s0 + 4);
      float4 a0 = *(const float4*)(acm + s0), a1 = *(const float4*)(acm + s0 + 4);
      float w[8];
      w[0] = d0.x * __expf(acend - a0.x); w[1] = d0.y * __expf(acend - a0.y); w[2] = d0.z * __expf(acend - a0.z); w[3] = d0.w * __expf(acend - a0.w);
      w[4] = d1.x * __expf(acend - a1.x); w[5] = d1.y * __expf(acend - a1.y); w[6] = d1.z * __expf(acend - a1.z); w[7] = d1.w * __expf(acend - a1.w);
      bf16x8 af = scale8(*(const bf16x8*)(XT + (size_t)(head * 64 + pt * 32 + r) * R + row0 + s0), w);
#pragma unroll
      for (int nt = 0; nt < 4; ++nt) {
        bf16x8 bfv = *(const bf16x8*)(BTt + (size_t)(g * 128 + nt * 32 + r) * R + row0 + s0);
        acc[nt] = MFMA(af, bfv, acc[nt]);
      }
    }
#pragma unroll
    for (int nt = 0; nt < 4; ++nt)
#pragma unroll
      for (int i = 0; i < 16; ++i) HS[(pt * 32 + crow(i, h)) * 128 + nt * 32 + r] = f2bf(acc[nt][i]);
  }
}

DI void f1_item(const DP& p, int item, int lane) {
  const int r = lane & 31, h = lane >> 5;
  const int l2t = item & 1, m = (item >> 1) & 511, b = item >> 10;
  const bfr* ZRT = wsp<bfr>(p, OFF_ZRT) + (size_t)m * R + b * SEQ + l2t * 32 + r;
  const bfr* ZIT = wsp<bfr>(p, OFF_ZIT) + (size_t)m * R + b * SEQ + l2t * 32 + r;
  const bfr* C128 = wsp<bfr>(p, OFF_C128); const bfr* S128 = wsp<bfr>(p, OFF_S128);
  const float2* TW = wsp<float2>(p, OFF_TW);
  bfr* YR = wsp<bfr>(p, OFF_YR); bfr* YI = wsp<bfr>(p, OFF_YI);
  const int l2 = l2t * 32 + r;
#pragma unroll 1
  for (int mh = 0; mh < 2; ++mh) {
    f32x16 yr[2], yi[2];
#pragma unroll
    for (int i = 0; i < 2; ++i) { yr[i] = zero16(); yi[i] = zero16(); }
#pragma unroll 2
    for (int kk = 0; kk < 8; ++kk) {
      bf16x8 zr, zi, nzr;
#pragma unroll
      for (int jj = 0; jj < 8; ++jj) {
        int l1 = kk * 16 + 8 * h + jj;
        zr[jj] = (short)ZRT[l1 * 64]; zi[jj] = (short)ZIT[l1 * 64];
        nzr[jj] = (short)(zr[jj] ^ (short)0x8000);
      }
#pragma unroll
      for (int m2 = 0; m2 < 2; ++m2) {
        const int mt = mh * 2 + m2;
        bf16x8 ca = *(const bf16x8*)(C128 + (mt * 32 + r) * 128 + kk * 16 + 8 * h);
        bf16x8 sa = *(const bf16x8*)(S128 + (mt * 32 + r) * 128 + kk * 16 + 8 * h);
        yr[m2] = MFMA(ca, zr, yr[m2]); yr[m2] = MFMA(sa, zi, yr[m2]);
        yi[m2] = MFMA(ca, zi, yi[m2]); yi[m2] = MFMA(sa, nzr, yi[m2]);
      }
    }
#pragma unroll
    for (int m2 = 0; m2 < 2; ++m2)
#pragma unroll
      for (int i = 0; i < 16; ++i) {
        int k1 = (mh * 2 + m2) * 32 + crow(i, h);
        float2 t = TW[k1 * l2];
        float a = yr[m2][i], bb = yi[m2][i];
        size_t o = ((size_t)(b * 512 + m) * 128 + k1) * 64 + l2;
        YR[o] = f2bf(a * t.x + bb * t.y);
        YI[o] = f2bf(bb * t.x - a * t.y);
      }
  }
}

DI void f1c_item(const DP& p, int item, int lane) {
  const int r = lane & 31, h = lane >> 5;
  const int mt = item & 15, kt = (item >> 4) & 7, b = item >> 7;
  const int m = mt * 32 + r;
  const bfr* ZRT = wsp<bfr>(p, OFF_ZRT) + (size_t)m * R + RL + b * CTX;
  const bfr* ZIT = wsp<bfr>(p, OFF_ZIT) + (size_t)m * R + RL + b * CTX;
  const bfr* C256 = wsp<bfr>(p, OFF_C256) + (kt * 32 + r) * 256;
  const bfr* S256 = wsp<bfr>(p, OFF_S256) + (kt * 32 + r) * 256;
  f32x16 acc = zero16();
#pragma unroll 4
  for (int kk = 0; kk < 16; ++kk) {
    int o = kk * 16 + 8 * h;
    acc = MFMA(*(const bf16x8*)(C256 + o), *(const bf16x8*)(ZRT + o), acc);
    acc = MFMA(*(const bf16x8*)(S256 + o), *(const bf16x8*)(ZIT + o), acc);
  }
  bfr* MIX = wsp<bfr>(p, OFF_MIX);
#pragma unroll
  for (int i = 0; i < 16; ++i)
    MIX[(size_t)(RL + b * CTX + kt * 32 + crow(i, h)) * 2048 + m] = f2bf(acc[i] * (1.f / 128.f));
}

DI void s1f1_phase(const DP& p) {
  const int lane = p.tidl & 63;
  const int wg = p.bidl * 4 + (p.tidl >> 6), nw = gridDim.x * 4;
  const int n_s1 = 2 * NCH * 2 * 24, n_f1 = 2048, n_f1c = 256;
#pragma unroll 1
  for (int it = wg; it < n_s1 + n_f1 + n_f1c; it += nw) {
    if (it < n_s1) s1_item(p, it, lane);
    else if (it < n_s1 + n_f1) f1_item(p, it - n_s1, lane);
    else f1c_item(p, it - n_s1 - n_f1, lane);
  }
}

DI void f2_item(const DP& p, int item, int lane) {
  const int r = lane & 31, h = lane >> 5;
  const int mt16 = item & 15, k1 = (item >> 4) & 127, b = item >> 11;
  const int m = mt16 * 32 + r;
  const bfr* YR = wsp<bfr>(p, OFF_YR) + ((size_t)(b * 512 + m) * 128 + k1) * 64;
  const bfr* YI = wsp<bfr>(p, OFF_YI) + ((size_t)(b * 512 + m) * 128 + k1) * 64;
  const bfr* C64 = wsp<bfr>(p, OFF_C64); const bfr* S64 = wsp<bfr>(p, OFF_S64);
  f32x16 acc[2]; acc[0] = zero16(); acc[1] = zero16();
#pragma unroll
  for (int kk = 0; kk < 4; ++kk) {
    bf16x8 yr = *(const bf16x8*)(YR + kk * 16 + 8 * h), yi = *(const bf16x8*)(YI + kk * 16 + 8 * h);
#pragma unroll
    for (int t = 0; t < 2; ++t) {
      bf16x8 ca = *(const bf16x8*)(C64 + (t * 32 + r) * 64 + kk * 16 + 8 * h);
      bf16x8 sa = *(const bf16x8*)(S64 + (t * 32 + r) * 64 + kk * 16 + 8 * h);
      acc[t] = MFMA(ca, yr, acc[t]); acc[t] = MFMA(sa, yi, acc[t]);
    }
  }
  bfr* MIX = wsp<bfr>(p, OFF_MIX);
  const float scale = 0.001381067932f;
#pragma unroll
  for (int t = 0; t < 2; ++t)
#pragma unroll
    for (int i = 0; i < 16; ++i) {
      int k2 = t * 32 + crow(i, h);
      MIX[(size_t)(b * SEQ + k1 + 128 * k2) * 2048 + m] = f2bf(acc[t][i] * scale);
    }
}

DI void s3_block(const DP& p, int j, int b, int c, int g, int half);

DI void s2f2_phase(const DP& p, int j) {
  if (p.bidl < 16) {
    const int k = p.bidl;
    s3_block(p, j, k >> 3, 0, (k >> 1) & 3, k & 1);
    return;
  }
  const int gt = (p.bidl - 16) * 256 + p.tidl, nt = ((int)gridDim.x - 16) * 256;
  bfr* HSb = wsp<bfr>(p, OFF_HS);
  const float* ACUM = wsp<float>(p, OFF_ACUM);
#pragma unroll 1
  for (int it = gt; it < 2 * 2 * 24 * 2048; it += nt) {
    const int e4 = it & 2047; const int rest = it >> 11; const int head = rest % 24, db = rest / 24, dir = db >> 1;
    bf16x4 sv[NCH]; float cd[NCH];
#pragma unroll
    for (int step = 0; step < NCH; ++step) {
      const int c = dir == 0 ? step : (step == 0 ? 0 : NCH - step);
      const size_t ci = (size_t)((db * NCH + c) * 24 + head);
      sv[step] = *(const bf16x4*)(HSb + ci * 8192 + e4 * 4);
      cd[step] = ACUM[ci * 256 + (dir == 0 ? 255 : 0)];
    }
    float h0 = 0.f, h1 = 0.f, h2 = 0.f, h3 = 0.f;
#pragma unroll
    for (int step = 0; step < NCH; ++step) {
      const int c = dir == 0 ? step : (step == 0 ? 0 : NCH - step);
      const size_t ci = (size_t)((db * NCH + c) * 24 + head);
      *(bf16x4*)(HSb + ci * 8192 + e4 * 4) = pack4(h0, h1, h2, h3);
      const float e = __expf(cd[step]);
      h0 = h0 * e + bfs(sv[step][0]); h1 = h1 * e + bfs(sv[step][1]); h2 = h2 * e + bfs(sv[step][2]); h3 = h3 * e + bfs(sv[step][3]);
    }
  }
  const int lane = p.tidl & 63;
  const int wg = (p.bidl - 16) * 4 + (p.tidl >> 6), nw = ((int)gridDim.x - 16) * 4;
#pragma unroll 1
  for (int it = wg; it < 4096; it += nw) f2_item(p, it, lane);
}

DI void s3_block(const DP& p, int j, int b, int c, int g, int half) {
  const int tid = p.tidl, lane = tid & 63, wid = tid >> 6, r = lane & 31, h = lane >> 5;
  const bfr* CN = wsp<bfr>(p, OFF_CN); const bfr* BN = wsp<bfr>(p, OFF_BN); const bfr* XT = wsp<bfr>(p, OFF_XT);
  const bfr* Z = wsp<bfr>(p, OFF_Z); bfr* MIX = wsp<bfr>(p, OFF_MIX);
  bfr* XTs = (bfr*)smem;
  bfr* HSF = (bfr*)(smem + 33792);
  bfr* HSB = (bfr*)(smem + 51200);
  float* LWF = (float*)(smem + 68608);
  float* LWB = LWF + 256;
  {
    const int row0 = chunk_row0(b, c);
    const int lt = half * 4 + wid;
    const int rowl = row0 + lt * 32 + r;
    const bfr* cfp = CN + (size_t)rowl * 512 + g * 128 + 8 * h;
    bf16x8 gtp[8][2];
    {
      bf16x8 cf[8];
#pragma unroll
      for (int kk = 0; kk < 8; ++kk) cf[kk] = *(const bf16x8*)(cfp + kk * 16);
#pragma unroll
      for (int k = 0; k < 8; ++k) { gtp[k][0] = cf[0]; gtp[k][1] = cf[0]; }
#pragma unroll 1
      for (int st = 0; st < 8; ++st) {
        f32x16 gt = zero16();
#pragma unroll
        for (int kk = 0; kk < 8; ++kk)
          gt = MFMA(*(const bf16x8*)(BN + (size_t)(row0 + st * 32 + r) * 512 + g * 128 + kk * 16 + 8 * h), cf[kk], gt);
#pragma unroll
        for (int k = 0; k < 7; ++k) { gtp[k][0] = gtp[k + 1][0]; gtp[k][1] = gtp[k + 1][1]; }
        gtp[7][0] = PACK_HALF(gt, 0); gtp[7][1] = PACK_HALF(gt, 1);
      }
    }
    float sumsq = 0.f;
#pragma unroll 1
    for (int hh = 0; hh < 6; ++hh) {
      const int head = g * 6 + hh;
      const size_t cif = (size_t)(((0 * 2 + b) * NCH + c) * 24 + head), cib = (size_t)(((1 * 2 + b) * NCH + c) * 24 + head);
      const float* acf = wsp<float>(p, OFF_ACUM) + cif * 256; const float* acb = wsp<float>(p, OFF_ACUM) + cib * 256;
      const float* dtf = wsp<float>(p, OFF_DTV) + cif * 256; const float* dtb = wsp<float>(p, OFF_DTV) + cib * 256;
      const bfr* HSf = wsp<bfr>(p, OFF_HS) + cif * 8192; const bfr* HSbk = wsp<bfr>(p, OFF_HS) + cib * 8192;
      __syncthreads();
#pragma unroll 4
      for (int i = 0; i < 16; ++i) {
        const int row = wid * 16 + i;
        if (lane < 32)
          __builtin_amdgcn_global_load_lds((const unsigned*)(XT + (size_t)(head * 64 + row) * R + row0 + lane * 8),
                                           (unsigned*)(XTs + row * 264 + lane * 8), 16, 0, 0);
      }
      if (c != 0) {
#pragma unroll 4
        for (int i = 0; i < 16; ++i) {
          const int row = wid * 16 + i;
          if (lane < 16) {
            __builtin_amdgcn_global_load_lds((const unsigned*)(HSf + row * 128 + lane * 8), (unsigned*)(HSF + row * 136 + lane * 8), 16, 0, 0);
            __builtin_amdgcn_global_load_lds((const unsigned*)(HSbk + row * 128 + lane * 8), (unsigned*)(HSB + row * 136 + lane * 8), 16, 0, 0);
          }
        }
      }
      bf16x8 cfh[8];
#pragma unroll
      for (int kk = 0; kk < 8; ++kk) cfh[kk] = *(const bf16x8*)(cfp + kk * 16);
      LWF[tid] = __logf(dtf[tid]) - acf[tid];
      LWB[tid] = __logf(dtb[tid]) - acb[tid];
      const float al_f = acf[lt * 32 + r], al_b = acb[lt * 32 + r];
      asm volatile("s_waitcnt vmcnt(0)" ::: "memory");
      __syncthreads();
      f32x16 acc[2];
      acc[0] = zero16(); acc[1] = zero16();
      if (c != 0) {
        f32x16 t0 = zero16(), t1 = zero16();
#pragma unroll
        for (int kk = 0; kk < 8; ++kk) {
          t0 = MFMA(*(const bf16x8*)(HSF + (r) * 136 + kk * 16 + 8 * h), cfh[kk], t0);
          t1 = MFMA(*(const bf16x8*)(HSF + (32 + r) * 136 + kk * 16 + 8 * h), cfh[kk], t1);
        }
        const float ef = __expf(al_f);
#pragma unroll
        for (int i = 0; i < 16; ++i) { acc[0][i] = t0[i] * ef; acc[1][i] = t1[i] * ef; }
        t0 = zero16(); t1 = zero16();
#pragma unroll
        for (int kk = 0; kk < 8; ++kk) {
          t0 = MFMA(*(const bf16x8*)(HSB + (r) * 136 + kk * 16 + 8 * h), cfh[kk], t0);
          t1 = MFMA(*(const bf16x8*)(HSB + (32 + r) * 136 + kk * 16 + 8 * h), cfh[kk], t1);
        }
        const float eb = __expf(al_b);
#pragma unroll
        for (int i = 0; i < 16; ++i) { acc[0][i] += t0[i] * eb; acc[1][i] += t1[i] * eb; }
      }
      bf16x4 zpre[2][4];
#pragma unroll
      for (int pt = 0; pt < 2; ++pt)
#pragma unroll
        for (int g4 = 0; g4 < 4; ++g4) zpre[pt][g4] = *(const bf16x4*)(Z + (size_t)rowl * 1536 + head * 64 + pt * 32 + 8 * g4 + 4 * h);
#pragma unroll 1
      for (int st = 0; st < 8; ++st) {
        const bf16x8 g0 = gtp[0][0], g1 = gtp[0][1];
#pragma unroll
        for (int k = 0; k < 7; ++k) { gtp[k][0] = gtp[k + 1][0]; gtp[k][1] = gtp[k + 1][1]; }
        gtp[7][0] = g0; gtp[7][1] = g1;
#pragma unroll 1
        for (int dir = 0; dir < 2; ++dir) {
          if (dir == 0 ? (st > lt) : (st < lt)) continue;
          const float* lwd = dir == 0 ? LWF : LWB;
          const float al = dir == 0 ? al_f : al_b;
          f32x16 mm;
#pragma unroll
          for (int g4 = 0; g4 < 4; ++g4) {
            const int sb = st * 32 + 8 * g4 + 4 * h;
            const float4 l4 = *(const float4*)(lwd + sb);
            const float lv[4] = {l4.x, l4.y, l4.z, l4.w};
#pragma unroll
            for (int q = 0; q < 4; ++q) {
              const int i = 4 * g4 + q;
              const int sidx = sb + q, lidx = lt * 32 + r;
              const bool valid = dir == 0 ? (sidx <= lidx) : (sidx >= lidx);
              const float gv = bfs((i >> 3) ? g1[i & 7] : g0[i & 7]);
              const float e = __expf(fminf(al + lv[q], 30.f));
              mm[i] = valid ? gv * e : 0.f;
            }
          }
#pragma unroll
          for (int s2 = 0; s2 < 2; ++s2) {
            bf16x8 pf = PACK_HALF(mm, s2);
#pragma unroll
            for (int pt = 0; pt < 2; ++pt) {
              const bfr* xp = XTs + (pt * 32 + r) * 264 + st * 32 + 16 * s2 + 4 * h;
              bf16x8 xf = join44(*(const bf16x4*)xp, *(const bf16x4*)(xp + 8));
              acc[pt] = MFMA(xf, pf, acc[pt]);
            }
          }
        }
      }
      const float dsk = p.d_skip[j * 24 + head];
#pragma unroll
      for (int pt = 0; pt < 2; ++pt)
#pragma unroll
        for (int g4 = 0; g4 < 4; ++g4) {
          const int pb = pt * 32 + 8 * g4 + 4 * h;
          bf16x4 zv = zpre[pt][g4];
          float y[4];
#pragma unroll
          for (int q = 0; q < 4; ++q) {
            float xv = bf2f(XTs[(pb + q) * 264 + lt * 32 + r]);
            float zz = bfs(zv[q]);
            float v = (acc[pt][4 * g4 + q] + dsk * xv) * (zz / (1.f + __expf(-zz)));
            sumsq += v * v; y[q] = v;
          }
          *(bf16x4*)(MIX + (size_t)rowl * 2048 + 512 + head * 64 + pb) = pack4(y[0], y[1], y[2], y[3]);
        }
    }
    const float tot = sumsq + __shfl_xor(sumsq, 32);
    const float sc = rsqrtf(tot * (1.f / 384.f) + 1e-6f);
    const float* ng = p.ssd_norm_g + (size_t)j * 1536;
#pragma unroll 1
    for (int hh = 0; hh < 6; ++hh) {
      const int head = g * 6 + hh;
#pragma unroll
      for (int pt = 0; pt < 2; ++pt)
#pragma unroll
        for (int g4 = 0; g4 < 4; ++g4) {
          const int pb = pt * 32 + 8 * g4 + 4 * h;
          bfr* mp = MIX + (size_t)rowl * 2048 + 512 + head * 64 + pb;
          bf16x4 yv = *(const bf16x4*)mp;
          float4 gg = *(const float4*)(ng + head * 64 + pb);
          *(bf16x4*)mp = pack4(bfs(yv[0]) * sc * gg.x, bfs(yv[1]) * sc * gg.y, bfs(yv[2]) * sc * gg.z, bfs(yv[3]) * sc * gg.w);
        }
    }
  }
}

DI void s3_phase(const DP& p, int j) {
#pragma unroll 1
  for (int idx = p.bidl; idx < 512; idx += (int)gridDim.x) {
    const int half = idx & 1, g = (idx >> 1) & 3, bcl = idx >> 3;
    s3_block(p, j, bcl >> 5, 1 + (bcl & 31), g, half);
  }
}

DI void qkprep_phase(const DP& p, int j) {
  const int lane = p.tidl & 63;
  const int wg = p.bidl * 4 + (p.tidl >> 6), nw = gridDim.x * 4;
  const bfr* P = wsp<bfr>(p, OFF_P); bfr* QK = wsp<bfr>(p, OFF_QK);
  const float* ROPE = wsp<float>(p, OFF_ROPE);
  const int sub = lane >> 3, d0 = (lane & 7) * 8;
  for (int row = wg; row < R; row += nw) {
#pragma unroll
    for (int ps = 0; ps < 4; ++ps) {
      const int hs = ps * 8 + sub;
      const bool act = hs < 26;
      const int hsc = act ? hs : 25;
      const int col = hsc < 10 ? hsc * 64 : 768 + (hsc - 10) * 64;
      bf16x8 xv = *(const bf16x8*)(P + (size_t)row * 2304 + col + d0);
      float x[8]; float ss = 0.f;
#pragma unroll
      for (int e = 0; e < 8; ++e) { x[e] = bfs(xv[e]); ss += x[e] * x[e]; }
      ss += __shfl_xor(ss, 1); ss += __shfl_xor(ss, 2); ss += __shfl_xor(ss, 4);
      const float rs = rsqrtf(ss * (1.f / 64.f) + 1e-6f);
      const float* gv = hsc < 8 ? p.q_norm_win + j * 64 : hsc < 10 ? p.k_norm_win + j * 64 : hsc < 18 ? p.q_norm_na + j * 64 : p.k_norm_na + j * 64;
#pragma unroll
      for (int e = 0; e < 8; ++e) x[e] = x[e] * rs * gv[d0 + e];
      float pr[8];
#pragma unroll
      for (int e = 0; e < 8; ++e) pr[e] = __shfl_xor(x[e], 2);
      if (hsc < 10 && row < RL) {
        const int pos = row & 8191;
        const int axis = d0 >> 5;
        const int idx = axis == 0 ? (pos >> 6) : (pos & 63);
        const int f0 = d0 & 15;
        const bool second = (d0 & 16) != 0;
        const float* cp = ROPE + (axis * 128 + idx) * 16 + f0;
        const float* sp = cp + 4096;
#pragma unroll
        for (int e = 0; e < 8; ++e) {
          float cs = cp[e], sn = sp[e];
          x[e] = second ? (x[e] * cs + pr[e] * sn) : (x[e] * cs - pr[e] * sn);
        }
      }
      const bool isq = hsc < 8 || (hsc >= 10 && hsc < 18);
      const float qs = isq ? 0.125f : 1.f;
      if (act) *(bf16x8*)(QK + (size_t)row * 1664 + hsc * 64 + d0) = pack8(x[0] * qs, x[1] * qs, x[2] * qs, x[3] * qs, x[4] * qs, x[5] * qs, x[6] * qs, x[7] * qs);
    }
  }
}

struct KVF { bf16x8 k[4]; bf16x8 v[2][2]; };
struct KVS { bf16x8 k[4]; bf16x8 v[4]; };

DI void kv_gload(KVS& g, const bfr* __restrict__ Kt, const bfr* __restrict__ Vt, int lane) {
#pragma unroll
  for (int i = 0; i < 4; ++i) {
    const int idx = lane + 64 * i;
    g.k[i] = *(const bf16x8*)(Kt + (size_t)(idx >> 3) * 1664 + (idx & 7) * 8);
    g.v[i] = *(const bf16x8*)(Vt + (size_t)(idx >> 2) * R + (idx & 3) * 8);
  }
}
DI void kv_sstore(const KVS& g, unsigned char* base, int lane) {
#pragma unroll
  for (int i = 0; i < 4; ++i) {
    const int idx = lane + 64 * i;
    { const int row = idx >> 3, c = idx & 7; *(bf16x8*)(base + row * 128 + ((c ^ (row & 7)) << 4)) = g.k[i]; }
    {
      const int d = idx >> 2, c16 = idx & 3, sw = (d >> 2) & 7;
      bf16x4 lo = __builtin_shufflevector(g.v[i], g.v[i], 0, 1, 2, 3), hi = __builtin_shufflevector(g.v[i], g.v[i], 4, 5, 6, 7);
      *(bf16x4*)(base + 4096 + d * 64 + (((2 * c16) ^ sw) << 3)) = lo;
      *(bf16x4*)(base + 4096 + d * 64 + (((2 * c16 + 1) ^ sw) << 3)) = hi;
    }
  }
}
DI void kv_sload(KVF& f, const unsigned char* base, int r, int h) {
#pragma unroll
  for (int kk = 0; kk < 4; ++kk) f.k[kk] = *(const bf16x8*)(base + r * 128 + (((2 * kk + h) ^ (r & 7)) << 4));
#pragma unroll
  for (int s2 = 0; s2 < 2; ++s2)
#pragma unroll
    for (int dt = 0; dt < 2; ++dt) {
      const int d = dt * 32 + r, sw = (d >> 2) & 7, c8 = 4 * s2 + h;
      const unsigned char* vb = base + 4096 + d * 64;
      f.v[s2][dt] = join44(*(const bf16x4*)(vb + ((c8 ^ sw) << 3)), *(const bf16x4*)(vb + (((c8 + 2) ^ sw) << 3)));
    }
}

DI void attn_compute(f32x16 (&o)[2], float& m, float& l, const unsigned char* qb, const unsigned char* base, int r, int h,
                     int mode, int a0, int a1, const float* __restrict__ rp) {
  f32x16 s = zero16();
#pragma unroll
  for (int kk = 0; kk < 4; ++kk) {
    const int off = r * 128 + (((2 * kk + h) ^ (r & 7)) << 4);
    s = MFMA(*(const bf16x8*)(base + off), *(const bf16x8*)(qb + off), s);
  }
  float tmax = -3.0e38f;
  if (mode == 1) {
#pragma unroll
    for (int i = 0; i < 16; ++i) { int dd = a0 - crow(i, h); dd = dd < 0 ? -dd : dd; s[i] = dd <= 128 ? s[i] : -1.0e30f; }
  } else if (mode == 2) {
#pragma unroll
    for (int i = 0; i < 16; ++i) {
      const int key = crow(i, h);
      const int rel = a0 + key;
      int co = a1 + key; co = co < 0 ? 0 : (co > 30 ? 30 : co);
      s[i] = (rel >= 0 && rel < 16) ? s[i] + rp[co] : -1.0e30f;
    }
  }
#pragma unroll
  for (int i = 0; i < 16; ++i) tmax = fmaxf(tmax, s[i]);
  tmax = fmaxf(tmax, __shfl_xor(tmax, 32));
  const float mn = fmaxf(m, tmax);
  const float alpha = __expf(m - mn);
  float ps = 0.f;
#pragma unroll
  for (int i = 0; i < 16; ++i) { s[i] = __expf(s[i] - mn); ps += s[i]; }
  l = l * alpha + ps; m = mn;
#pragma unroll
  for (int i = 0; i < 16; ++i) { o[0][i] *= alpha; o[1][i] *= alpha; }
#pragma unroll
  for (int s2 = 0; s2 < 2; ++s2) {
    bf16x8 pf = PACK_HALF(s, s2);
#pragma unroll
    for (int dt = 0; dt < 2; ++dt) {
      const int d = dt * 32 + r, sw = (d >> 2) & 7, c8 = 4 * s2 + h;
      const unsigned char* vb = base + 4096 + d * 64;
      bf16x8 vf = join44(*(const bf16x4*)(vb + ((c8 ^ sw) << 3)), *(const bf16x4*)(vb + (((c8 + 2) ^ sw) << 3)));
      o[dt] = MFMA(vf, pf, o[dt]);
    }
  }
}

DI void attn_item(const DP& p, int j, int item, int lane) {
  const int r = lane & 31, h = lane >> 5;
  const bfr* QK = wsp<bfr>(p, OFF_QK); const bfr* VT = wsp<bfr>(p, OFF_VT); bfr* MIX = wsp<bfr>(p, OFF_MIX);
  int kind, b, hd, qt;
  if (item < 4096) { kind = 0; qt = item & 255; hd = (item >> 8) & 7; b = item >> 11; }
  else if (item < 8192) { int v = item - 4096; kind = 1; qt = v & 255; hd = (v >> 8) & 7; b = v >> 11; }
  else if (item < 8320) { int v = item - 8192; kind = 2; qt = v & 7; hd = (v >> 3) & 7; b = v >> 6; }
  else { int v = item - 8320; kind = 3; qt = v & 7; hd = (v >> 3) & 7; b = v >> 6; }
  const bool win = (kind == 0 || kind == 2);
  const bool lat = kind < 2;
  const int q_row0 = lat ? b * SEQ + qt * 32 : RL + b * CTX + qt * 32;
  const int qcol = win ? hd * 64 : (10 + hd) * 64;
  const int kcol = win ? (8 + (hd >> 2)) * 64 : (18 + hd) * 64;
  const bfr* Vb = win ? VT + (size_t)((hd >> 2) * 64) * R : VT + (size_t)(128 + hd * 64) * R;
  const bfr* Kb = QK + kcol;
  f32x16 o[2]; o[0] = zero16(); o[1] = zero16();
  float m = -1.0e30f, l = 0.f;
  if (win) { m = p.sink_win[j * 8 + hd]; l = h == 0 ? 1.f : 0.f; }
  int nloc = 0, lo = 0, gr = 0, kr0 = 0, w = 0, cs = 0;
  const int qpos = qt * 32 + r;
  if (kind == 0) { lo = qt - 4 < 0 ? 0 : qt - 4; const int hi = qt + 4 > 255 ? 255 : qt + 4; nloc = hi - lo + 1; }
  else if (kind == 1) {
    gr = qt >> 1; w = (qt & 1) * 32 + r;
    cs = w - 8; cs = cs < 0 ? 0 : (cs > 48 ? 48 : cs);
    kr0 = gr - 4; kr0 = kr0 < 0 ? 0 : (kr0 > 120 ? 120 : kr0);
    nloc = 16;
  }
  const int ntile = 8 + nloc;
  const float* rpb = p.rpb_na + (size_t)j * 8 * 15 * 31 + hd * 15 * 31;
  auto tile_row = [&](int i) -> int {
    if (i < 8) return RL + b * CTX + i * 32;
    const int li = i - 8;
    if (kind == 0) return b * SEQ + (lo + li) * 32;
    return b * SEQ + (kr0 + (li >> 1)) * 64 + (li & 1) * 32;
  };
  unsigned char* lbase = smem + (p.tidl >> 6) * 12288;
  asm volatile("" ::: "memory");
#pragma unroll
  for (int i = 0; i < 4; ++i) {
    const int idx = lane + 64 * i, row = idx >> 3, c = idx & 7;
    *(bf16x8*)(lbase + 8192 + row * 128 + ((c ^ (row & 7)) << 4)) = *(const bf16x8*)(QK + (size_t)(q_row0 + row) * 1664 + qcol + c * 8);
  }
  KVS g;
  { const int k0 = tile_row(0); kv_gload(g, Kb + (size_t)k0 * 1664, Vb + k0, lane); }
  kv_sstore(g, lbase, lane);
#pragma unroll 1
  for (int i = 0; i < ntile; ++i) {
    { const int in = i + 1 < ntile ? i + 1 : i; const int k0 = tile_row(in); kv_gload(g, Kb + (size_t)k0 * 1664, Vb + k0, lane); }
    int mode = 0, a0 = 0, a1 = 0; const float* rp = rpb;
    if (i >= 8) {
      const int li = i - 8;
      if (kind == 0) { mode = 1; a0 = qpos - (lo + li) * 32; }
      else { mode = 2; const int krow = kr0 + (li >> 1); const int ub = (li & 1) * 32; a0 = ub - cs; a1 = ub - w + 15; rp = rpb + (krow - gr + 7) * 31; }
    }
    asm volatile("" ::: "memory");
    attn_compute(o, m, l, lbase + 8192, lbase, r, h, mode, a0, a1, rp);
    asm volatile("" ::: "memory");
    kv_sstore(g, lbase, lane);
  }
  asm volatile("" ::: "memory");
  const float lt = l + __shfl_xor(l, 32);
  const float inv = 1.f / lt;
  const int ocol = win ? hd * 64 : 512 + hd * 64;
#pragma unroll
  for (int dt = 0; dt < 2; ++dt)
#pragma unroll
    for (int g4 = 0; g4 < 4; ++g4) {
      const int d = dt * 32 + 8 * g4 + 4 * h;
      *(bf16x4*)(MIX + (size_t)(q_row0 + r) * 1024 + ocol + d) =
          pack4(o[dt][4 * g4] * inv, o[dt][4 * g4 + 1] * inv, o[dt][4 * g4 + 2] * inv, o[dt][4 * g4 + 3] * inv);
    }
}

DI void attn_phase(const DP& p, int j) {
  const int lane = p.tidl & 63;
  const int wg = p.bidl * 4 + (p.tidl >> 6), nw = gridDim.x * 4;
#pragma unroll 1
  for (int it = wg; it < 8448; it += nw) attn_item(p, j, it, lane);
}

#define XB_TMO      128
#define XB_XCNT(j)  (256  + 64 * (j))
#define XB_XSUB(j)  (1280 + 64 * (j))
#define XB_XGEN(j)  (2304 + 64 * (j))
#define XB_TOP      3328
#define XB_TOPGEN   3392
#define XCD_BAR_WORDS 3456
#define XB_SPIN_CAP (1u << 18)
#define LAS __attribute__((address_space(3)))

__device__ __forceinline__ unsigned xb_ld(unsigned* p)              { return __hip_atomic_load(p, __ATOMIC_RELAXED, __HIP_MEMORY_SCOPE_AGENT); }
__device__ __forceinline__ unsigned xb_add(unsigned* p, unsigned v) { return __hip_atomic_fetch_add(p, v, __ATOMIC_RELAXED, __HIP_MEMORY_SCOPE_AGENT); }
__device__ __forceinline__ unsigned xb_xcc_id() { return (unsigned)__builtin_amdgcn_s_getreg((3 << 11) | 20) & 0xFu; }
#define XB_SPIN(cond, bar) do { unsigned _sp = 0; while (cond) { __builtin_amdgcn_s_sleep(1); \
    if ((++_sp & 255u) == 0u) { if (xb_ld(&(bar)[XB_TMO])) break; if (_sp > XB_SPIN_CAP) { atomicAdd(&(bar)[XB_TMO], 1u); break; } } } } while (0)

struct XcdBarrier {
    unsigned* bar; unsigned x;
    volatile LAS unsigned* st;
};

__device__ __forceinline__ XcdBarrier xcd_barrier_post(unsigned* bar, volatile LAS unsigned* st) {
    XcdBarrier b; b.bar = bar; b.x = xb_xcc_id(); b.st = st;
    if (threadIdx.x == 0) (void)xb_add(&bar[XB_XCNT(b.x)], 1u);
    return b;
}
__device__ __forceinline__ void xcd_barrier_complete(unsigned* bar, unsigned x, unsigned& nloc, unsigned& nx) {
    const unsigned G = gridDim.x * gridDim.y * gridDim.z;
    unsigned sum, cnt, mine, sp = 0u;
    for (;;) {
        sum = 0u; cnt = 0u; mine = 0u;
#pragma unroll
        for (unsigned j = 0; j < 16; ++j) { const unsigned c = xb_ld(&bar[XB_XCNT(j)]); sum += c; cnt += (c > 0u) ? 1u : 0u; mine = (j == x) ? c : mine; }
        if (sum == G) break;
        __builtin_amdgcn_s_sleep(1);
        if ((++sp & 255u) == 0u) { if (xb_ld(&bar[XB_TMO])) break; if (sp > XB_SPIN_CAP) { atomicAdd(&bar[XB_TMO], 1u); break; } }
    }
    nloc = mine > 0u ? mine : 1u; nx = cnt > 0u ? cnt : 1u;
}

__device__ __forceinline__ void xcd_barrier(const XcdBarrier& b) {
    asm volatile("s_waitcnt vmcnt(0)" ::: "memory");
    __syncthreads();
    if (threadIdx.x == 0) {
        unsigned* bar = b.bar;
        __builtin_amdgcn_s_waitcnt(0);
        unsigned nloc = b.st[0], nx = b.st[1];
        if (nloc == 0u) { xcd_barrier_complete(bar, b.x, nloc, nx); b.st[0] = nloc; b.st[1] = nx; }
        const unsigned old = xb_add(&bar[XB_XSUB(b.x)], 1u);
        const unsigned gen = old / nloc;
        if (old + 1u == (gen + 1u) * nloc) {
            __builtin_amdgcn_fence(__ATOMIC_RELEASE, "agent");
            asm volatile("s_waitcnt vmcnt(0)" ::: "memory");
            const unsigned og = xb_add(&bar[XB_TOP], 1u);
            const unsigned tg = og / nx;
            if (og + 1u == (tg + 1u) * nx) xb_add(&bar[XB_TOPGEN], 1u);
            else XB_SPIN(xb_ld(&bar[XB_TOPGEN]) == tg, bar);
            __builtin_amdgcn_fence(__ATOMIC_ACQUIRE, "agent");
            xb_add(&bar[XB_XGEN(b.x)], 1u);
            asm volatile("s_waitcnt vmcnt(0)" ::: "memory");
        } else {
            XB_SPIN(xb_ld(&bar[XB_XGEN(b.x)]) == gen, bar);
            __builtin_amdgcn_fence(__ATOMIC_ACQUIRE, "agent");
            asm volatile("s_waitcnt vmcnt(0)" ::: "memory");
        }
    }
    __syncthreads();
}


DI void run_phase(const DP& p, int ph, int dry) {
  if (ph == 0) { phase0(p); wconv_phase(p, 0); return; }
  int q = ph - 1, layer, lp;
  if (q < 10) { layer = 0; lp = q; } else if (q < 18) { layer = 1; lp = q - 10; } else if (q < 28) { layer = 2; lp = q - 18; } else { layer = 3; lp = q - 28; }
  const int j = layer >> 1;
  const bool even = (layer & 1) == 0;
  int op, gsel = 0;
  if (even) {
    op = (int)((0x2272654321ull >> (4 * lp)) & 15ull); gsel = (int)((0x3201000000ull >> (4 * lp)) & 15ull);
  } else {
    op = (int)((0x22729821ull >> (4 * lp)) & 15ull); gsel = (int)((0x32010000ull >> (4 * lp)) & 15ull);
  }
  if (op == 1 && layer != 0) wconv_phase(p, layer);
  if (op == 1 || op == 7) {
    const bool first = op == 1;
    norm_phase(p, layer, (first ? p.norm_mix_g : p.norm_ff_g) + layer * 1024, first ? 0 : 3, first ? 1 : 4);
  } else if (op == 2) {
    int mode, lda, N, K, gch; size_t offA, offB;
    if (gsel == 0) { mode = even ? EPI_EVEN_IN : EPI_ODD_IN; offA = OFF_MIX; lda = 1024; offB = OFF_WIN; N = even ? 5168 : 2304; K = 1024; gch = 0; }
    else if (gsel == 1) { mode = EPI_RESID; offA = OFF_MIX; lda = even ? 2048 : 1024; offB = OFF_WOUT; N = 1024; K = even ? 2048 : 1024; gch = 2; }
    else if (gsel == 2) { mode = EPI_RELU2; offA = OFF_MIX; lda = 1024; offB = OFF_WFF1; N = 4096; K = 1024; gch = 0; }
    else { mode = EPI_RESID; offA = OFF_ACT; lda = 4096; offB = OFF_WFF2; N = 1024; K = 4096; gch = 5; }
    if (dry && mode == EPI_RESID) mode = 4;
    gemm_phase(p, mode, wsp<bfr>(p, offA), lda, wsp<bfr>(p, offB), N, K, layer, gch, (layer == 3 && gsel != 0) ? RL / 128 : R / 128);
  } else if (op == 3) conv_dt_phase(p, j);
  else if (op == 4) s1f1_phase(p);
  else if (op == 5) s2f2_phase(p, j);
  else if (op == 6) s3_phase(p, j);
  else if (op == 8) qkprep_phase(p, j);
  else if (op == 9) attn_phase(p, j);
}

DI int probe_reps(int ph) {
#ifdef PROBE_MASK
  if (ph == 0) return (PROBE_MASK & 1) ? 2 : 1;
  int q = ph - 1, layer, lp;
  if (q < 10) { layer = 0; lp = q; } else if (q < 18) { layer = 1; lp = q - 10; } else if (q < 28) { layer = 2; lp = q - 18; } else { layer = 3; lp = q - 28; }
  const bool even = (layer & 1) == 0;
  int op, gsel;
  if (even) { op = (int)((0x2272654321ull >> (4 * lp)) & 15ull); gsel = (int)((0x3201000000ull >> (4 * lp)) & 15ull); }
  else { op = (int)((0x22729821ull >> (4 * lp)) & 15ull); gsel = (int)((0x32010000ull >> (4 * lp)) & 15ull); }
  if (op == 5) return 1;
  if (op == 2 && (gsel == 1 || gsel == 3)) return ((PROBE_MASK >> 10) & 1) ? 2 : 1;
  return ((PROBE_MASK >> op) & 1) ? 2 : 1;
#else
  return 1;
#endif
}

__shared__ uint4 xb_words;

__global__ void __launch_bounds__(256, 2) mega(Params p, int ph0, int ph1) {
  cg::grid_group grid = cg::this_grid();
  if (threadIdx.x == 0) xb_words = make_uint4(0u, 0u, 0u, 0u);
  __syncthreads();
  XcdBarrier xb = xcd_barrier_post((unsigned*)(p.ws + OFF_BAR), (volatile LAS unsigned*)&xb_words);
#pragma unroll 1
  for (int ph = ph0; ph < ph1; ++ph) {
    const int nrep = probe_reps(ph);
#pragma unroll 1
    for (int rep = 0; rep < nrep; ++rep) {
      DP q;
      (Params&)q = p;
      int t = threadIdx.x, bb = blockIdx.x;
      asm volatile("" : "+v"(t));
      asm volatile("" : "+s"(bb));
      int z0;
      asm volatile("s_mov_b32 %0, 0" : "=s"(z0));
      q.ws = p.ws + z0;
      q.out = p.out + z0;
      q.tidl = t; q.bidl = bb;
      run_phase(q, ph, rep + 1 < nrep);
    }
    if (ph + 1 < ph1) {
      if (ph == ph0) grid.sync();
      else xcd_barrier(xb);
    }
  }
}

extern "C" void kernel_launch(void* const* d_in, const int* in_sizes, int n_in, void* d_out, int out_size, void* d_ws,
                              size_t ws_size, hipStream_t stream) {
  static int grid_blocks = 0;
  if (!grid_blocks) {
    int dev = 0, cus = 0, per_cu = 0;
    hipGetDevice(&dev);
    hipDeviceGetAttribute(&cus, hipDeviceAttributeMultiprocessorCount, dev);
    hipOccupancyMaxActiveBlocksPerMultiprocessor(&per_cu, mega, 256, 0);
    if (per_cu > 2) per_cu = 2;
    if (per_cu < 1) per_cu = 1;
    grid_blocks = cus * per_cu;
  }
  Params p{};
  const float** pp = (const float**)&p;
  for (int i = 0; i < 26; ++i) pp[i] = (const float*)d_in[i];
  p.out = (float*)d_out;
  p.ws = (unsigned char*)d_ws;
  if (ws_size < WS_TOTAL) fprintf(stderr, "workspace too small: %zu < %zu\n", ws_size, (size_t)WS_TOTAL);
  hipMemsetAsync((unsigned char*)d_ws + OFF_BAR, 0, XCD_BAR_WORDS * 4, stream);
#if MULTI_LAUNCH
  for (int ph = 0; ph < NPHASE; ++ph) {
    int a = ph, b = ph + 1;
    void* args[] = {&p, &a, &b};
    hipLaunchCooperativeKernel((void*)mega, dim3(grid_blocks), dim3(256), args, 0, stream);
  }
#else
  int a = 0, b = NPHASE;
  void* args[] = {&p, &a, &b};
  hipError_t e = hipLaunchCooperativeKernel((void*)mega, dim3(grid_blocks), dim3(256), args, 0, stream);
  if (e != hipSuccess) fprintf(stderr, "cooperative launch failed: %s (grid %d)\n", hipGetErrorString(e), grid_blocks);
#endif
}
```

```cpp
#include <hip/hip_runtime.h>
#include <hip/hip_cooperative_groups.h>
#include <cstdio>
namespace cg = cooperative_groups;

typedef unsigned short bfr;
typedef __attribute__((ext_vector_type(8))) short bf16x8;
typedef __attribute__((ext_vector_type(4))) short bf16x4;
typedef __attribute__((ext_vector_type(16))) float f32x16;
#define DI __device__ __forceinline__
#define MFMA(a, b, c) __builtin_amdgcn_mfma_f32_32x32x16_bf16((a), (b), (c), 0, 0, 0)

#ifndef MULTI_LAUNCH
#define MULTI_LAUNCH 0
#endif

constexpr int RL = 16384, R = 16896, SEQ = 8192, CTX = 256;
constexpr int NCH = 33, CL = 256;
constexpr int NPHASE = 37;

constexpr size_t al(size_t x) { return (x + 255) & ~size_t(255); }
constexpr size_t OFF_HC = 0;
constexpr size_t OFF_MOD = OFF_HC + al(512 * 1024 * 4);
constexpr size_t OFF_TW = OFF_MOD + al(4 * 3 * 6144 * 4);
constexpr size_t OFF_C128 = OFF_TW + al(8192 * 8);
constexpr size_t OFF_S128 = OFF_C128 + al(128 * 128 * 2);
constexpr size_t OFF_C64 = OFF_S128 + al(128 * 128 * 2);
constexpr size_t OFF_S64 = OFF_C64 + al(64 * 64 * 2);
constexpr size_t OFF_C256 = OFF_S64 + al(64 * 64 * 2);
constexpr size_t OFF_S256 = OFF_C256 + al(256 * 256 * 2);
constexpr size_t OFF_ROPE = OFF_S256 + al(256 * 256 * 2);
constexpr size_t OFF_DTV = OFF_ROPE + al(2 * 2 * 128 * 16 * 4);
constexpr size_t DT_BYTES = (size_t)2 * 2 * NCH * 24 * 256 * 4;
constexpr size_t OFF_ACUM = OFF_DTV + al(DT_BYTES);
constexpr size_t OFF_WIN = OFF_ACUM + al(DT_BYTES);
constexpr size_t OFF_WOUT = OFF_WIN + al((size_t)5248 * 1024 * 2);
constexpr size_t OFF_WFF1 = OFF_WOUT + al((size_t)1024 * 2048 * 2);
constexpr size_t OFF_WFF2 = OFF_WFF1 + al((size_t)4096 * 1024 * 2);
constexpr size_t OFF_MIX = OFF_WFF2 + al((size_t)4096 * 1024 * 2);
constexpr size_t OFF_BIG = OFF_MIX + al((size_t)R * 2048 * 2);
constexpr size_t OFF_Z = OFF_BIG;
constexpr size_t OFF_ZRT = OFF_Z + (size_t)R * 1536 * 2;
constexpr size_t OFF_ZIT = OFF_ZRT + (size_t)512 * R * 2;
constexpr size_t OFF_XBC = OFF_ZIT + (size_t)512 * R * 2;
constexpr size_t OFF_DTRAW = OFF_XBC + (size_t)R * 2560 * 2;
constexpr size_t BIG_END = OFF_DTRAW + (size_t)R * 48 * 4;
constexpr size_t OFF_HS = OFF_XBC;
constexpr size_t HS_BYTES = (size_t)2 * 2 * NCH * 24 * 8192 * 2;
constexpr size_t OFF_YR = OFF_HS + HS_BYTES;
constexpr size_t OFF_YI = OFF_YR + (size_t)2 * 512 * 128 * 64 * 2;
static_assert(OFF_YI + (size_t)2 * 512 * 128 * 64 * 2 <= OFF_DTRAW, "fft scratch overflows");
constexpr size_t OFF_ACT = OFF_BIG;
static_assert((size_t)R * 4096 * 2 <= BIG_END - OFF_BIG, "act overflows");
constexpr size_t OFF_P = OFF_BIG;
constexpr size_t OFF_VT = OFF_P + (size_t)R * 2304 * 2;
constexpr size_t OFF_QK = OFF_VT + (size_t)640 * R * 2;
static_assert(OFF_QK + (size_t)R * 1664 * 2 <= BIG_END, "odd overflows");
constexpr size_t OFF_XT = al(BIG_END);
constexpr size_t OFF_BN = OFF_XT + (size_t)1536 * R * 2;
constexpr size_t OFF_BT = OFF_BN + (size_t)R * 512 * 2;
constexpr size_t OFF_CN = OFF_BT + (size_t)512 * R * 2;
constexpr size_t OFF_BAR = al(OFF_CN + (size_t)R * 512 * 2);
constexpr size_t WS_TOTAL = OFF_BAR + 16384;
static_assert(WS_TOTAL <= 402653184ull, "workspace too large");

struct Params {
  const float *x, *c, *ctx, *c_ctx, *w_mod, *b_mod, *norm_mix_g, *norm_ff_g, *w_ff1, *w_ff2;
  const float *w_in_even, *conv_w, *conv_b, *dt_bias, *a_log, *d_skip, *ssd_norm_g, *w_out_even;
  const float *w_in_odd, *q_norm_win, *k_norm_win, *sink_win, *q_norm_na, *k_norm_na, *rpb_na, *w_out_odd;
  float* out;
  unsigned char* ws;
};

struct DP : Params { int tidl, bidl; };

__shared__ __attribute__((aligned(16))) unsigned char smem[73728];

typedef __attribute__((ext_vector_type(2))) __bf16 bf2_t;
typedef __attribute__((ext_vector_type(2))) float f2_t;
typedef __attribute__((ext_vector_type(4))) unsigned u32x4_t;
typedef __attribute__((ext_vector_type(2))) unsigned u32x2_t;
DI unsigned pk2(float a, float b) { f2_t v = {a, b}; return __builtin_bit_cast(unsigned, __builtin_convertvector(v, bf2_t)); }
DI bfr f2bf(float x) { return (bfr)(pk2(x, 0.f) & 0xffffu); }
DI float bf2f(bfr b) { return __uint_as_float(((unsigned)b) << 16); }
DI float bfs(short s) { return __uint_as_float(((unsigned)(unsigned short)s) << 16); }
DI int crow(int i, int h) { return (i & 3) + 8 * (i >> 2) + 4 * h; }
DI f32x16 zero16() { f32x16 z; for (int i = 0; i < 16; ++i) z[i] = 0.f; return z; }
DI bf16x8 pack8(float a0, float a1, float a2, float a3, float a4, float a5, float a6, float a7) {
  u32x4_t v = {pk2(a0, a1), pk2(a2, a3), pk2(a4, a5), pk2(a6, a7)};
  return __builtin_bit_cast(bf16x8, v);
}
DI bf16x4 pack4(float a0, float a1, float a2, float a3) {
  u32x2_t v = {pk2(a0, a1), pk2(a2, a3)};
  return __builtin_bit_cast(bf16x4, v);
}
#define PACK_HALF(s, s2) pack8(s[8 * (s2)], s[8 * (s2) + 1], s[8 * (s2) + 2], s[8 * (s2) + 3], s[8 * (s2) + 4], s[8 * (s2) + 5], s[8 * (s2) + 6], s[8 * (s2) + 7])
DI bf16x8 join44(bf16x4 lo, bf16x4 hi) { return __builtin_shufflevector(lo, hi, 0, 1, 2, 3, 4, 5, 6, 7); }
DI int chunk_row0(int b, int c) { return c == 0 ? RL + b * CTX : b * SEQ + (c - 1) * CL; }

DI void sincos_turn(double f, float& s, float& c) {
  f -= rint(f);
  double x = f * 6.283185307179586476925;
  double x2 = x * x, ss = 1.0, cc = 1.0;
#pragma unroll
  for (int k = 13; k >= 1; --k) {
    ss = 1.0 - x2 / (double)((2 * k) * (2 * k + 1)) * ss;
    cc = 1.0 - x2 / (double)((2 * k - 1) * (2 * k)) * cc;
  }
  s = (float)(x * ss); c = (float)cc;
}

template <class T> DI T* wsp(const DP& p, size_t off) { return (T*)(p.ws + off); }

DI void phase0(const DP& p) {
  const int tid = p.tidl, bid = p.bidl, G = gridDim.x;
  float* lds = (float*)smem;
  float* MOD = wsp<float>(p, OFF_MOD);
  for (int u = bid; u < 384; u += G) {
    int layer = u / 96, cb = u % 96;
    for (int i = tid; i < 3072; i += 256) {
      int v = i >> 10, k = i & 1023;
      float c = v < 2 ? p.c[v * 1024 + k] : p.c_ctx[k];
      lds[i] = c / (1.f + expf(-c));
    }
    __syncthreads();
    int kq = tid >> 6, cc = tid & 63, col = cb * 64 + cc;
    const float* w = p.w_mod + (size_t)layer * 1024 * 6144 + col;
    float a0 = 0, a1 = 0, a2 = 0;
    for (int k = kq * 256; k < kq * 256 + 256; ++k) {
      float wv = w[(size_t)k * 6144];
      a0 += lds[k] * wv; a1 += lds[1024 + k] * wv; a2 += lds[2048 + k] * wv;
    }
    float* red = lds + 3072;
    red[(kq * 3 + 0) * 64 + cc] = a0; red[(kq * 3 + 1) * 64 + cc] = a1; red[(kq * 3 + 2) * 64 + cc] = a2;
    __syncthreads();
    if (tid < 192) {
      int v = tid >> 6;
      float s = red[(0 * 3 + v) * 64 + cc] + red[(1 * 3 + v) * 64 + cc] + red[(2 * 3 + v) * 64 + cc] + red[(3 * 3 + v) * 64 + cc];
      MOD[(layer * 3 + v) * 6144 + col] = s + p.b_mod[layer * 6144 + col];
    }
    __syncthreads();
  }
  const int gt = bid * 256 + tid, nt = G * 256;
  {
    const float4* xs = (const float4*)p.x; float4* od = (float4*)p.out;
    for (int i = gt; i < RL * 256; i += 4 * nt) {
      float4 t4[4];
#pragma unroll
      for (int q = 0; q < 4; ++q) { const int ii = i + q * nt; t4[q] = ii < RL * 256 ? xs[ii] : make_float4(0.f, 0.f, 0.f, 0.f); }
#pragma unroll
      for (int q = 0; q < 4; ++q) { const int ii = i + q * nt; if (ii < RL * 256) od[ii] = t4[q]; }
    }
    const float4* cs = (const float4*)p.ctx; float4* hd = wsp<float4>(p, OFF_HC);
    for (int i = gt; i < 512 * 256; i += nt) hd[i] = cs[i];
  }
  float2* TW = wsp<float2>(p, OFF_TW);
  for (int i = gt; i < 8192; i += nt) { float s, c; sincos_turn((double)i / 8192.0, s, c); TW[i] = make_float2(c, s); }
  bfr* C128 = wsp<bfr>(p, OFF_C128); bfr* S128 = wsp<bfr>(p, OFF_S128);
  for (int i = gt; i < 128 * 128; i += nt) { int a = i >> 7, b = i & 127; float s, c; sincos_turn((double)((a * b) & 127) / 128.0, s, c); C128[i] = f2bf(c); S128[i] = f2bf(s); }
  bfr* C64 = wsp<bfr>(p, OFF_C64); bfr* S64 = wsp<bfr>(p, OFF_S64);
  for (int i = gt; i < 64 * 64; i += nt) { int a = i >> 6, b = i & 63; float s, c; sincos_turn((double)((a * b) & 63) / 64.0, s, c); C64[i] = f2bf(c); S64[i] = f2bf(s); }
  bfr* C256 = wsp<bfr>(p, OFF_C256); bfr* S256 = wsp<bfr>(p, OFF_S256);
  for (int i = gt; i < 256 * 256; i += nt) { int a = i >> 8, b = i & 255; float s, c; sincos_turn((double)((a * b) & 255) / 256.0, s, c); C256[i] = f2bf(c); S256[i] = f2bf(s); }
  float* ROPE = wsp<float>(p, OFF_ROPE);
  for (int i = gt; i < 2 * 128 * 16; i += nt) {
    int f = i & 15, idx = (i >> 4) & 127;
    float ang = (float)idx * (float)exp(-(double)f * 0.5756462732485115);
    float s, c; sincos_turn((double)ang / 6.283185307179586476925, s, c);
    ROPE[i] = c; ROPE[4096 + i] = s;
  }
}

DI void tcvt_unit(const float* __restrict__ src, int ld, int c0, int ncols, int K, bfr* __restrict__ dst, int dr0, int u, int tid) {
  const int ntk = K >> 6;
  const int tn = u / ntk, tk = u % ntk, k0 = tk * 64, nb = tn * 64;
  bfr* T = (bfr*)smem;
  float4 v[4];
  const int n4 = (tid & 15) * 4;
#pragma unroll
  for (int i = 0; i < 4; ++i) {
    const int kk = (tid >> 4) + 16 * i;
    v[i] = make_float4(0.f, 0.f, 0.f, 0.f);
    if (nb + n4 < ncols) v[i] = *(const float4*)(src + (size_t)(k0 + kk) * ld + c0 + nb + n4);
  }
#pragma unroll
  for (int i = 0; i < 4; ++i) {
    const int kk = (tid >> 4) + 16 * i;
    T[(n4 + 0) * 72 + kk] = f2bf(v[i].x); T[(n4 + 1) * 72 + kk] = f2bf(v[i].y);
    T[(n4 + 2) * 72 + kk] = f2bf(v[i].z); T[(n4 + 3) * 72 + kk] = f2bf(v[i].w);
  }
  __syncthreads();
  {
    int n = tid >> 2, kseg = (tid & 3) * 16;
    if (nb + n < ncols) {
      bfr* d = dst + (size_t)(dr0 + nb + n) * K + k0 + kseg;
      *(bf16x8*)d = *(const bf16x8*)(T + n * 72 + kseg);
      *(bf16x8*)(d + 8) = *(const bf16x8*)(T + n * 72 + kseg + 8);
    }
  }
  __syncthreads();
}

DI void wconv_phase(const DP& p, int layer) {
  const int tid = p.tidl;
  const int j = layer >> 1;
  bfr* WIN = wsp<bfr>(p, OFF_WIN); bfr* WOUT = wsp<bfr>(p, OFF_WOUT);
  bfr* WFF1 = wsp<bfr>(p, OFF_WFF1); bfr* WFF2 = wsp<bfr>(p, OFF_WFF2);
  const float* ff1 = p.w_ff1 + (size_t)layer * 1024 * 4096;
  const float* ff2 = p.w_ff2 + (size_t)layer * 4096 * 1024;
  float* cst = (float*)(smem + 20480);
  if (tid < 64) { float s, c; sincos_turn((double)tid / 64.0, s, c); cst[tid] = c; cst[64 + tid] = s; }
  __syncthreads();
  if ((layer & 1) == 0) {
    const float* win = p.w_in_even + (size_t)j * 1024 * 4656;
    const float* wout = p.w_out_even + (size_t)j * 2048 * 1024;
    const int n_in = 65 * 16, n_out = 16 * 32, n_f1 = 64 * 16, n_f2 = 16 * 64, n_fold = 128;
    const int total = n_in + n_out + n_f1 + n_f2 + n_fold;
    for (int u = p.bidl; u < total; u += gridDim.x) {
      int v = u;
      if (v < n_in) { tcvt_unit(win, 4656, 512, 4144, 1024, WIN, 1024, v, tid); continue; }
      v -= n_in;
      if (v < n_out) { tcvt_unit(wout, 1024, 0, 1024, 2048, WOUT, 0, v, tid); continue; }
      v -= n_out;
      if (v < n_f1) { tcvt_unit(ff1, 4096, 0, 4096, 1024, WFF1, 0, v, tid); continue; }
      v -= n_f1;
      if (v < n_f2) { tcvt_unit(ff2, 1024, 0, 1024, 4096, WFF2, 0, v, tid); continue; }
      v -= n_f2;
      {
        const int g = v >> 4, kb = v & 15;
        float* wt = (float*)smem;
#pragma unroll
        for (int i = 0; i < 4; ++i) {
          const int idx = tid + 256 * i, kk = idx >> 4, j4 = (idx & 15) * 4;
          const float4 wv = *(const float4*)(win + (size_t)(kb * 64 + kk) * 4656 + g * 64 + j4);
          wt[kk * 65 + j4] = wv.x; wt[kk * 65 + j4 + 1] = wv.y; wt[kk * 65 + j4 + 2] = wv.z; wt[kk * 65 + j4 + 3] = wv.w;
        }
        __syncthreads();
        const int kl = tid & 63, mg = tid >> 6;
#pragma unroll 1
        for (int mi = 0; mi < 16; ++mi) {
          const int m = mg * 16 + mi;
          float sc = 0.f, ss = 0.f;
#pragma unroll 8
          for (int jj = 0; jj < 64; ++jj) { const float w = wt[kl * 65 + jj]; const int idx = (m * jj) & 63; sc += w * cst[idx]; ss += w * cst[64 + idx]; }
          const int ch = g * 64 + m, k = kb * 64 + kl;
          WIN[(size_t)ch * 1024 + k] = f2bf(sc);
          WIN[(size_t)(512 + ch) * 1024 + k] = f2bf(-ss);
        }
        __syncthreads();
      }
    }
  } else {
    const float* win = p.w_in_odd + (size_t)j * 1024 * 2304;
    const float* wout = p.w_out_odd + (size_t)j * 1024 * 1024;
    const int n_in = 36 * 16, n_out = 16 * 16, n_f1 = 64 * 16, n_f2 = 16 * 64;
    const int total = n_in + n_out + n_f1 + n_f2;
    for (int u = p.bidl; u < total; u += gridDim.x) {
      int v = u;
      if (v < n_in) { tcvt_unit(win, 2304, 0, 2304, 1024, WIN, 0, v, tid); continue; }
      v -= n_in;
      if (v < n_out) { tcvt_unit(wout, 1024, 0, 1024, 1024, WOUT, 0, v, tid); continue; }
      v -= n_out;
      if (v < n_f1) { tcvt_unit(ff1, 4096, 0, 4096, 1024, WFF1, 0, v, tid); continue; }
      v -= n_f1;
      tcvt_unit(ff2, 1024, 0, 1024, 4096, WFF2, 0, v, tid);
    }
  }
}

DI void norm_phase(const DP& p, int layer, const float* __restrict__ gvec, int shc, int scc) {
  const int lane = p.tidl & 63;
  const int wg = p.bidl * 4 + (p.tidl >> 6), nw = gridDim.x * 4;
  const float* MOD = wsp<float>(p, OFF_MOD);
  const float* HC = wsp<float>(p, OFF_HC);
  bfr* U = wsp<bfr>(p, OFF_MIX);
#pragma unroll 1
  for (int row0 = wg; row0 < R; row0 += 2 * nw) {
    float4 v[2][4]; float ss[2] = {0.f, 0.f};
#pragma unroll
    for (int q = 0; q < 2; ++q) {
      const int row = row0 + q * nw < R ? row0 + q * nw : row0;
      const float* hp = row < RL ? p.out + (size_t)row * 1024 : HC + (size_t)(row - RL) * 1024;
#pragma unroll
      for (int i = 0; i < 4; ++i) v[q][i] = *(const float4*)(hp + i * 256 + lane * 4);
    }
#pragma unroll
    for (int q = 0; q < 2; ++q) {
#pragma unroll
      for (int i = 0; i < 4; ++i) ss[q] += v[q][i].x * v[q][i].x + v[q][i].y * v[q][i].y + v[q][i].z * v[q][i].z + v[q][i].w * v[q][i].w;
#pragma unroll
      for (int o = 32; o >= 1; o >>= 1) ss[q] += __shfl_xor(ss[q], o);
    }
#pragma unroll
    for (int q = 0; q < 2; ++q) {
      const int row = row0 + q * nw;
      if (row >= R) continue;
      const int ms = row < RL ? (row >> 13) : 2;
      const float* md = MOD + (layer * 3 + ms) * 6144;
      const float rs = rsqrtf(ss[q] * (1.f / 1024.f) + 1e-6f);
#pragma unroll
      for (int i = 0; i < 4; ++i) {
        int col = i * 256 + lane * 4;
        float4 g = *(const float4*)(gvec + col);
        float4 sc = *(const float4*)(md + scc * 1024 + col);
        float4 sh = *(const float4*)(md + shc * 1024 + col);
        bf16x4 o = pack4(v[q][i].x * rs * g.x * (1.f + sc.x) + sh.x, v[q][i].y * rs * g.y * (1.f + sc.y) + sh.y,
                         v[q][i].z * rs * g.z * (1.f + sc.z) + sh.z, v[q][i].w * rs * g.w * (1.f + sc.w) + sh.w);
        *(bf16x4*)(U + (size_t)row * 1024 + col) = o;
      }
    }
  }
}

enum { EPI_EVEN_IN = 0, EPI_ODD_IN = 1, EPI_RELU2 = 2, EPI_RESID = 3 };

DI void gemm_phase(const DP& p, int mode, const bfr* __restrict__ A, int lda, const bfr* __restrict__ Bt,
                   int N, int K, int layer, int gchunk, int nM) {
  const int tid = p.tidl, lane = tid & 63, wid = tid >> 6, r = lane & 31, h = lane >> 5;
  const int wm = wid >> 1, wn = wid & 1;
  const int nN = (N + 127) >> 7;
  const int tiles = nM * nN, G = (int)gridDim.x;
  int full = tiles, tail = 0, St = 1;
  if (mode == EPI_RESID) {
    full = (tiles / G) * G; tail = tiles - full;
    if (tail > 0) { int c = G / tail; int kmax = K >> 7; St = 1; while (St * 2 <= c && St * 2 <= 16 && St * 2 <= kmax) St *= 2; }
  }
  const int chunk = (full + 7) >> 3;
  const int units = chunk * 8 + tail * St;
  bfr* sm = (bfr*)smem;
  const int lrow = tid >> 3, lc = (tid & 7) * 8;
#pragma unroll 1
  for (int u = p.bidl; u < units; u += G) {
    int t, ks, Ks; bool atom;
    if (u < chunk * 8) {
      t = (u & 7) * chunk + (u >> 3);
      if (t >= full) continue;
      ks = 0; Ks = K; atom = false;
    } else { const int v = u - chunk * 8; t = full + v / St; ks = v % St; Ks = K / St; atom = St > 1; }
    const int nk = Ks >> 6;
    const int panel = t / (nM * 8); const int rem = t - panel * nM * 8;
    const int pw = (nN - panel * 8) < 8 ? (nN - panel * 8) : 8;
    const int tm = rem / pw, tn = panel * 8 + rem % pw;
    const int m0 = tm * 128, n0 = tn * 128, kbase = ks * Ks;
    f32x16 acc[2][2];
    acc[0][0] = zero16(); acc[0][1] = zero16(); acc[1][0] = zero16(); acc[1][1] = zero16();
    const bfr* Ag = A + (size_t)(m0 + lrow) * lda + kbase + lc;
    const bfr* Bg = Bt + (size_t)(n0 + lrow) * K + kbase + lc;
    bf16x8 ra[4], rb[4];
#pragma unroll
    for (int i = 0; i < 4; ++i) {
      ra[i] = *(const bf16x8*)(Ag + (size_t)(32 * i) * lda);
      rb[i] = *(const bf16x8*)(Bg + (size_t)(32 * i) * K);
    }
#pragma unroll
    for (int i = 0; i < 4; ++i) {
      *(bf16x8*)(sm + (lrow + 32 * i) * 72 + lc) = ra[i];
      *(bf16x8*)(sm + 9216 + (lrow + 32 * i) * 72 + lc) = rb[i];
    }
    if (nk > 1) {
#pragma unroll
      for (int i = 0; i < 4; ++i) {
        ra[i] = *(const bf16x8*)(Ag + (size_t)(32 * i) * lda + 64);
        rb[i] = *(const bf16x8*)(Bg + (size_t)(32 * i) * K + 64);
      }
    }
    __syncthreads();
#pragma unroll 1
    for (int kt = 0; kt < nk; ++kt) {
      if (kt + 1 < nk) {
        bfr* Ad = sm + ((kt + 1) & 1) * 18432;
#pragma unroll
        for (int i = 0; i < 4; ++i) {
          *(bf16x8*)(Ad + (lrow + 32 * i) * 72 + lc) = ra[i];
          *(bf16x8*)(Ad + 9216 + (lrow + 32 * i) * 72 + lc) = rb[i];
        }
      }
      if (kt + 2 < nk) {
#pragma unroll
        for (int i = 0; i < 4; ++i) {
          ra[i] = *(const bf16x8*)(Ag + (size_t)(32 * i) * lda + (kt + 2) * 64);
          rb[i] = *(const bf16x8*)(Bg + (size_t)(32 * i) * K + (kt + 2) * 64);
        }
      }
      const bfr* As = sm + (kt & 1) * 18432;
      const bfr* Bs = As + 9216;
      __builtin_amdgcn_s_setprio(1);
#pragma unroll
      for (int kk = 0; kk < 4; ++kk) {
        bf16x8 a0 = *(const bf16x8*)(As + (wm * 64 + r) * 72 + kk * 16 + h * 8);
        bf16x8 a1 = *(const bf16x8*)(As + (wm * 64 + 32 + r) * 72 + kk * 16 + h * 8);
        bf16x8 b0 = *(const bf16x8*)(Bs + (wn * 64 + r) * 72 + kk * 16 + h * 8);
        bf16x8 b1 = *(const bf16x8*)(Bs + (wn * 64 + 32 + r) * 72 + kk * 16 + h * 8);
        acc[0][0] = MFMA(a0, b0, acc[0][0]);
        acc[0][1] = MFMA(a0, b1, acc[0][1]);
        acc[1][0] = MFMA(a1, b0, acc[1][0]);
        acc[1][1] = MFMA(a1, b1, acc[1][1]);
      }
      __builtin_amdgcn_s_setprio(0);
      __syncthreads();
    }
    if (mode == EPI_RESID && !atom) {
      float hv[2][2][16], gt2[2][2];
#pragma unroll
      for (int mi = 0; mi < 2; ++mi)
#pragma unroll
        for (int ni = 0; ni < 2; ++ni) {
          const int col = n0 + wn * 64 + ni * 32 + r;
          const int rowb = m0 + wm * 64 + mi * 32 + 4 * h;
          const int ms = rowb < RL ? (rowb >> 13) : 2;
          gt2[mi][ni] = wsp<float>(p, OFF_MOD)[(layer * 3 + ms) * 6144 + gchunk * 1024 + col];
          const float* hp = rowb < RL ? p.out + (size_t)rowb * 1024 + col : wsp<float>(p, OFF_HC) + (size_t)(rowb - RL) * 1024 + col;
#pragma unroll
          for (int i = 0; i < 16; ++i) hv[mi][ni][i] = hp[(size_t)((i & 3) + 8 * (i >> 2)) * 1024];
        }
#pragma unroll
      for (int mi = 0; mi < 2; ++mi)
#pragma unroll
        for (int ni = 0; ni < 2; ++ni) {
          const int col = n0 + wn * 64 + ni * 32 + r;
          const int rowb = m0 + wm * 64 + mi * 32 + 4 * h;
          float* hp = rowb < RL ? p.out + (size_t)rowb * 1024 + col : wsp<float>(p, OFF_HC) + (size_t)(rowb - RL) * 1024 + col;
#pragma unroll
          for (int i = 0; i < 16; ++i) hp[(size_t)((i & 3) + 8 * (i >> 2)) * 1024] = hv[mi][ni][i] + gt2[mi][ni] * acc[mi][ni][i];
        }
      continue;
    }
#pragma unroll
    for (int mi = 0; mi < 2; ++mi)
#pragma unroll
      for (int ni = 0; ni < 2; ++ni)
#pragma unroll
        for (int g4 = 0; g4 < 4; ++g4) {
          const int row = m0 + wm * 64 + mi * 32 + 8 * g4 + 4 * h;
          const int col = n0 + wn * 64 + ni * 32 + r;
          const float v0 = acc[mi][ni][4 * g4], v1 = acc[mi][ni][4 * g4 + 1], v2 = acc[mi][ni][4 * g4 + 2], v3 = acc[mi][ni][4 * g4 + 3];
          if (mode == EPI_EVEN_IN) {
            if (col < 1024) {
              bfr* dst = wsp<bfr>(p, col < 512 ? OFF_ZRT : OFF_ZIT) + (size_t)(col & 511) * R + row;
              *(bf16x4*)dst = pack4(v0, v1, v2, v3);
            } else if (col < 2560) {
              bfr* dst = wsp<bfr>(p, OFF_Z) + (size_t)row * 1536 + (col - 1024);
              dst[0] = f2bf(v0); dst[1536] = f2bf(v1); dst[2 * 1536] = f2bf(v2); dst[3 * 1536] = f2bf(v3);
            } else if (col < 5120) {
              bfr* dst = wsp<bfr>(p, OFF_XBC) + (size_t)row * 2560 + (col - 2560);
              dst[0] = f2bf(v0); dst[2560] = f2bf(v1); dst[2 * 2560] = f2bf(v2); dst[3 * 2560] = f2bf(v3);
            } else if (col < 5168) {
              float* dst = wsp<float>(p, OFF_DTRAW) + (size_t)row * 48 + (col - 5120);
              dst[0] = v0; dst[48] = v1; dst[96] = v2; dst[144] = v3;
            }
          } else if (mode == EPI_ODD_IN) {
            if (col >= 640 && col < 768) {
              *(bf16x4*)(wsp<bfr>(p, OFF_VT) + (size_t)(col - 640) * R + row) = pack4(v0, v1, v2, v3);
            } else if (col >= 1792) {
              *(bf16x4*)(wsp<bfr>(p, OFF_VT) + (size_t)(128 + col - 1792) * R + row) = pack4(v0, v1, v2, v3);
            } else {
              bfr* dst = wsp<bfr>(p, OFF_P) + (size_t)row * 2304 + col;
              dst[0] = f2bf(v0); dst[2304] = f2bf(v1); dst[2 * 2304] = f2bf(v2); dst[3 * 2304] = f2bf(v3);
            }
          } else if (mode == EPI_RELU2) {
            bfr* dst = wsp<bfr>(p, OFF_ACT) + (size_t)row * 4096 + col;
            float t0 = fmaxf(v0, 0.f), t1 = fmaxf(v1, 0.f), t2 = fmaxf(v2, 0.f), t3 = fmaxf(v3, 0.f);
            dst[0] = f2bf(t0 * t0); dst[4096] = f2bf(t1 * t1); dst[2 * 4096] = f2bf(t2 * t2); dst[3 * 4096] = f2bf(t3 * t3);
          } else if (mode == EPI_RESID) {
            const int ms = row < RL ? (row >> 13) : 2;
            const float gate = wsp<float>(p, OFF_MOD)[(layer * 3 + ms) * 6144 + gchunk * 1024 + col];
            float* hp = row < RL ? p.out + (size_t)row * 1024 + col : wsp<float>(p, OFF_HC) + (size_t)(row - RL) * 1024 + col;
            if (atom) {
              unsafeAtomicAdd(hp, gate * v0); unsafeAtomicAdd(hp + 1024, gate * v1);
              unsafeAtomicAdd(hp + 2048, gate * v2); unsafeAtomicAdd(hp + 3072, gate * v3);
            } else {
              hp[0] += gate * v0; hp[1024] += gate * v1; hp[2048] += gate * v2; hp[3072] += gate * v3;
            }
          }
        }
  }
}

DI float softplus_f(float x) { return x > 0.f ? x + log1pf(expf(-x)) : log1pf(expf(x)); }

DI void conv_dt_phase(const DP& p, int j) {
  const int tid = p.tidl, lane = tid & 63, wid = tid >> 6;
  const bfr* XBC = wsp<bfr>(p, OFF_XBC);
  bfr* XT = wsp<bfr>(p, OFF_XT); bfr* BN = wsp<bfr>(p, OFF_BN); bfr* BTt = wsp<bfr>(p, OFF_BT); bfr* CN = wsp<bfr>(p, OFF_CN);
  bfr* TT = (bfr*)smem;
  const float* cw = p.conv_w + (size_t)j * 5 * 2560;
  const float* cb = p.conv_b + (size_t)j * 2560;
  const int n_conv = 264 * 40, n_dt = 792;
  for (int u = p.bidl; u < n_conv + n_dt; u += gridDim.x) {
    if (u < n_conv) {
      const int tb = u / 40, cbk = u % 40, row0 = tb * 64, ch0 = cbk * 64;
      int pos0, len;
      if (row0 < RL) { pos0 = row0 & 8191; len = SEQ; } else { pos0 = (row0 - RL) & 255; len = CTX; }
      const int c8 = tid & 7, ch = ch0 + c8 * 8;
      float w[5][8], bias[8];
#pragma unroll
      for (int k = 0; k < 5; ++k) {
        float4 wa = *(const float4*)(cw + k * 2560 + ch), wb = *(const float4*)(cw + k * 2560 + ch + 4);
        w[k][0] = wa.x; w[k][1] = wa.y; w[k][2] = wa.z; w[k][3] = wa.w; w[k][4] = wb.x; w[k][5] = wb.y; w[k][6] = wb.z; w[k][7] = wb.w;
      }
      {
        float4 wa = *(const float4*)(cb + ch), wb = *(const float4*)(cb + ch + 4);
        bias[0] = wa.x; bias[1] = wa.y; bias[2] = wa.z; bias[3] = wa.w; bias[4] = wb.x; bias[5] = wb.y; bias[6] = wb.z; bias[7] = wb.w;
      }
#pragma unroll
      for (int ps = 0; ps < 2; ++ps) {
        const int tl = (tid >> 3) + 32 * ps, pos = pos0 + tl, row = row0 + tl;
        float a[8];
#pragma unroll
        for (int e = 0; e < 8; ++e) a[e] = bias[e];
        bf16x8 xr[5];
#pragma unroll
        for (int k = 0; k < 5; ++k) {
          const int pp = pos + k - 2;
          const bool ok = pp >= 0 && pp < len;
          const bfr* xp = XBC + (size_t)(ok ? row + k - 2 : row) * 2560 + ch;
          xr[k] = *(const bf16x8*)xp;
          if (!ok) { for (int e = 0; e < 8; ++e) xr[k][e] = 0; }
        }
#pragma unroll
        for (int k = 0; k < 5; ++k)
#pragma unroll
          for (int e = 0; e < 8; ++e) a[e] += w[k][e] * bfs(xr[k][e]);
        bf16x8 o;
#pragma unroll
        for (int e = 0; e < 8; ++e) { float s = a[e] / (1.f + __expf(-a[e])); o[e] = (short)f2bf(s); }
        if (ch0 >= 2048) *(bf16x8*)(CN + (size_t)row * 512 + (ch - 2048)) = o;
        else if (ch0 >= 1536) *(bf16x8*)(BN + (size_t)row * 512 + (ch - 1536)) = o;
        if (ch0 < 2048) {
#pragma unroll
          for (int e = 0; e < 8; ++e) TT[(c8 * 8 + e) * 72 + tl] = (bfr)o[e];
        }
      }
      if (ch0 < 2048) {
        __syncthreads();
        const int chl = tid >> 2, tseg = (tid & 3) * 16;
        bfr* dst = (ch0 < 1536 ? XT + (size_t)(ch0 + chl) * R : BTt + (size_t)(ch0 - 1536 + chl) * R) + row0 + tseg;
        *(bf16x8*)dst = *(const bf16x8*)(TT + chl * 72 + tseg);
        *(bf16x8*)(dst + 8) = *(const bf16x8*)(TT + chl * 72 + tseg + 8);
        __syncthreads();
      }
    } else {
      const int item = (u - n_conv) * 4 + wid;
      const int head = item % 24; int rest = item / 24; const int dir = rest & 1; rest >>= 1; const int c = rest % NCH, b = rest / NCH;
      const int row0 = chunk_row0(b, c), col = dir * 24 + head;
      const float bias = p.dt_bias[j * 48 + col];
      const float a = -expf(p.a_log[j * 48 + col]);
      const float* DTRAW = wsp<float>(p, OFF_DTRAW);
      float dt[4], cs[4];
      float run = 0.f;
#pragma unroll
      for (int q = 0; q < 4; ++q) {
        dt[q] = softplus_f(DTRAW[(size_t)(row0 + lane * 4 + q) * 48 + col] + bias);
        run += dt[q] * a; cs[q] = run;
      }
      float x = run;
#pragma unroll
      for (int o = 1; o < 64; o <<= 1) { float t2 = __shfl_up(x, o); if (lane >= o) x += t2; }
      const float excl = x - run;
      const float total = __shfl(x, 63);
      float ac[4];
#pragma unroll
      for (int q = 0; q < 4; ++q) {
        float inc = excl + cs[q];
        ac[q] = dir == 0 ? inc : total - inc + dt[q] * a;
      }
      const size_t base = ((size_t)(((dir * 2 + b) * NCH + c) * 24 + head)) * 256 + lane * 4;
      *(float4*)(wsp<float>(p, OFF_DTV) + base) = make_float4(dt[0], dt[1], dt[2], dt[3]);
      *(float4*)(wsp<float>(p, OFF_ACUM) + base) = make_float4(ac[0], ac[1], ac[2], ac[3]);
    }
  }
}

DI bf16x8 scale8(bf16x8 a, const float* w) {
  return pack8(bfs(a[0]) * w[0], bfs(a[1]) * w[1], bfs(a[2]) * w[2], bfs(a[3]) * w[3],
               bfs(a[4]) * w[4], bfs(a[5]) * w[5], bfs(a[6]) * w[6], bfs(a[7]) * w[7]);
}

DI void s1_item(const DP& p, int item, int lane) {
  const int r = lane & 31, h = lane >> 5;
  const int head = item % 24; int rest = item / 24; const int dir = rest & 1; rest >>= 1; const int c = rest % NCH, b = rest / NCH;
  const int g = head / 6;
  const int row0 = chunk_row0(b, c);
  const size_t dbase = ((size_t)(((dir * 2 + b) * NCH + c) * 24 + head)) * 256;
  const float* dtv = wsp<float>(p, OFF_DTV) + dbase;
  const float* acm = wsp<float>(p, OFF_ACUM) + dbase;
  const float acend = dir == 0 ? acm[255] : acm[0];
  const bfr* XT = wsp<bfr>(p, OFF_XT); const bfr* BTt = wsp<bfr>(p, OFF_BT);
  bfr* HS = wsp<bfr>(p, OFF_HS) + ((size_t)(((dir * 2 + b) * NCH + c) * 24 + head)) * 8192;
#pragma unroll 1
  for (int pt = 0; pt < 2; ++pt) {
    f32x16 acc[4];
#pragma unroll
    for (int n = 0; n < 4; ++n) acc[n] = zero16();
#pragma unroll 4
    for (int kk = 0; kk < 16; ++kk) {
      const int s0 = kk * 16 + 8 * h;
      float4 d0 = *(const float4*)(dtv + s0), d1 = *(const float4*)(dtv + s0 + 4);
      float4 a0 = *(const float4*)(acm + s0), a1 = *(const float4*)(acm + s0 + 4);
      float w[8];
      w[0] = d0.x * __expf(acend - a0.x); w[1] = d0.y * __expf(acend - a0.y); w[2] = d0.z * __expf(acend - a0.z); w[3] = d0.w * __expf(acend - a0.w);
      w[4] = d1.x * __expf(acend - a1.x); w[5] = d1.y * __expf(acend - a1.y); w[6] = d1.z * __expf(acend - a1.z); w[7] = d1.w * __expf(acend - a1.w);
      bf16x8 af = scale8(*(const bf16x8*)(XT + (size_t)(head * 64 + pt * 32 + r) * R + row0 + s0), w);
#pragma unroll
      for (int nt = 0; nt < 4; ++nt) {
        bf16x8 bfv = *(const bf16x8*)(BTt + (size_t)(g * 128 + nt * 32 + r) * R + row0 + s0);
        acc[nt] = MFMA(af, bfv, acc[nt]);
      }
    }
#pragma unroll
    for (int nt = 0; nt < 4; ++nt)
#pragma unroll
      for (int i = 0; i < 16; ++i) HS[(pt * 32 + crow(i, h)) * 128 + nt * 32 + r] = f2bf(acc[nt][i]);
  }
}

DI void f1_item(const DP& p, int item, int lane) {
  const int r = lane & 31, h = lane >> 5;
  const int l2t = item & 1, m = (item >> 1) & 511, b = item >> 10;
  const bfr* ZRT = wsp<bfr>(p, OFF_ZRT) + (size_t)m * R + b * SEQ + l2t * 32 + r;
  const bfr* ZIT = wsp<bfr>(p, OFF_ZIT) + (size_t)m * R + b * SEQ + l2t * 32 + r;
  const bfr* C128 = wsp<bfr>(p, OFF_C128); const bfr* S128 = wsp<bfr>(p, OFF_S128);
  const float2* TW = wsp<float2>(p, OFF_TW);
  bfr* YR = wsp<bfr>(p, OFF_YR); bfr* YI = wsp<bfr>(p, OFF_YI);
  const int l2 = l2t * 32 + r;
#pragma unroll 1
  for (int mh = 0; mh < 2; ++mh) {
    f32x16 yr[2], yi[2];
#pragma unroll
    for (int i = 0; i < 2; ++i) { yr[i] = zero16(); yi[i] = zero16(); }
#pragma unroll 2
    for (int kk = 0; kk < 8; ++kk) {
      bf16x8 zr, zi, nzr;
#pragma unroll
      for (int jj = 0; jj < 8; ++jj) {
        int l1 = kk * 16 + 8 * h + jj;
        zr[jj] = (short)ZRT[l1 * 64]; zi[jj] = (short)ZIT[l1 * 64];
        nzr[jj] = (short)(zr[jj] ^ (short)0x8000);
      }
#pragma unroll
      for (int m2 = 0; m2 < 2; ++m2) {
        const int mt = mh * 2 + m2;
        bf16x8 ca = *(const bf16x8*)(C128 + (mt * 32 + r) * 128 + kk * 16 + 8 * h);
        bf16x8 sa = *(const bf16x8*)(S128 + (mt * 32 + r) * 128 + kk * 16 + 8 * h);
        yr[m2] = MFMA(ca, zr, yr[m2]); yr[m2] = MFMA(sa, zi, yr[m2]);
        yi[m2] = MFMA(ca, zi, yi[m2]); yi[m2] = MFMA(sa, nzr, yi[m2]);
      }
    }
#pragma unroll
    for (int m2 = 0; m2 < 2; ++m2)
#pragma unroll
      for (int i = 0; i < 16; ++i) {
        int k1 = (mh * 2 + m2) * 32 + crow(i, h);
        float2 t = TW[k1 * l2];
        float a = yr[m2][i], bb = yi[m2][i];
        size_t o = ((size_t)(b * 512 + m) * 128 + k1) * 64 + l2;
        YR[o] = f2bf(a * t.x + bb * t.y);
        YI[o] = f2bf(bb * t.x - a * t.y);
      }
  }
}

DI void f1c_item(const DP& p, int item, int lane) {
  const int r = lane & 31, h = lane >> 5;
  const int mt = item & 15, kt = (item >> 4) & 7, b = item >> 7;
  const int m = mt * 32 + r;
  const bfr* ZRT = wsp<bfr>(p, OFF_ZRT) + (size_t)m * R + RL + b * CTX;
  const bfr* ZIT = wsp<bfr>(p, OFF_ZIT) + (size_t)m * R + RL + b * CTX;
  const bfr* C256 = wsp<bfr>(p, OFF_C256) + (kt * 32 + r) * 256;
  const bfr* S256 = wsp<bfr>(p, OFF_S256) + (kt * 32 + r) * 256;
  f32x16 acc = zero16();
#pragma unroll 4
  for (int kk = 0; kk < 16; ++kk) {
    int o = kk * 16 + 8 * h;
    acc = MFMA(*(const bf16x8*)(C256 + o), *(const bf16x8*)(ZRT + o), acc);
    acc = MFMA(*(const bf16x8*)(S256 + o), *(const bf16x8*)(ZIT + o), acc);
  }
  bfr* MIX = wsp<bfr>(p, OFF_MIX);
#pragma unroll
  for (int i = 0; i < 16; ++i)
    MIX[(size_t)(RL + b * CTX + kt * 32 + crow(i, h)) * 2048 + m] = f2bf(acc[i] * (1.f / 128.f));
}

DI void s1f1_phase(const DP& p) {
  const int lane = p.tidl & 63;
  const int wg = p.bidl * 4 + (p.tidl >> 6), nw = gridDim.x * 4;
  const int n_s1 = 2 * NCH * 2 * 24, n_f1 = 2048, n_f1c = 256;
#pragma unroll 1
  for (int it = wg; it < n_s1 + n_f1 + n_f1c; it += nw) {
    if (it < n_s1) s1_item(p, it, lane);
    else if (it < n_s1 + n_f1) f1_item(p, it - n_s1, lane);
    else f1c_item(p, it - n_s1 - n_f1, lane);
  }
}

DI void f2_item(const DP& p, int item, int lane) {
  const int r = lane & 31, h = lane >> 5;
  const int mt16 = item & 15, k1 = (item >> 4) & 127, b = item >> 11;
  const int m = mt16 * 32 + r;
  const bfr* YR = wsp<bfr>(p, OFF_YR) + ((size_t)(b * 512 + m) * 128 + k1) * 64;
  const bfr* YI = wsp<bfr>(p, OFF_YI) + ((size_t)(b * 512 + m) * 128 + k1) * 64;
  const bfr* C64 = wsp<bfr>(p, OFF_C64); const bfr* S64 = wsp<bfr>(p, OFF_S64);
  f32x16 acc[2]; acc[0] = zero16(); acc[1] = zero16();
#pragma unroll
  for (int kk = 0; kk < 4; ++kk) {
    bf16x8 yr = *(const bf16x8*)(YR + kk * 16 + 8 * h), yi = *(const bf16x8*)(YI + kk * 16 + 8 * h);
#pragma unroll
    for (int t = 0; t < 2; ++t) {
      bf16x8 ca = *(const bf16x8*)(C64 + (t * 32 + r) * 64 + kk * 16 + 8 * h);
      bf16x8 sa = *(const bf16x8*)(S64 + (t * 32 + r) * 64 + kk * 16 + 8 * h);
      acc[t] = MFMA(ca, yr, acc[t]); acc[t] = MFMA(sa, yi, acc[t]);
    }
  }
  bfr* MIX = wsp<bfr>(p, OFF_MIX);
  const float scale = 0.001381067932f;
#pragma unroll
  for (int t = 0; t < 2; ++t)
#pragma unroll
    for (int i = 0; i < 16; ++i) {
      int k2 = t * 32 + crow(i, h);
      MIX[(size_t)(b * SEQ + k1 + 128 * k2) * 2048 + m] = f2bf(acc[t][i] * scale);
    }
}

DI void s3_block(const DP& p, int j, int b, int c, int g, int half);

DI void s2f2_phase(const DP& p, int j) {
  if (p.bidl < 16) {
    const int k = p.bidl;
    s3_block(p, j, k >> 3, 0, (k >> 1) & 3, k & 1);
    return;
  }
  const int gt = (p.bidl - 16) * 256 + p.tidl, nt = ((int)gridDim.x - 16) * 256;
  bfr* HSb = wsp<bfr>(p, OFF_HS);
  const float* ACUM = wsp<float>(p, OFF_ACUM);
#pragma unroll 1
  for (int it = gt; it < 2 * 2 * 24 * 2048; it += nt) {
    const int e4 = it & 2047; const int rest = it >> 11; const int head = rest % 24, db = rest / 24, dir = db >> 1;
    bf16x4 sv[NCH]; float cd[NCH];
#pragma unroll
    for (int step = 0; step < NCH; ++step) {
      const int c = dir == 0 ? step : (step == 0 ? 0 : NCH - step);
      const size_t ci = (size_t)((db * NCH + c) * 24 + head);
      sv[step] = *(const bf16x4*)(HSb + ci * 8192 + e4 * 4);
      cd[step] = ACUM[ci * 256 + (dir == 0 ? 255 : 0)];
    }
    float h0 = 0.f, h1 = 0.f, h2 = 0.f, h3 = 0.f;
#pragma unroll
    for (int step = 0; step < NCH; ++step) {
      const int c = dir == 0 ? step : (step == 0 ? 0 : NCH - step);
      const size_t ci = (size_t)((db * NCH + c) * 24 + head);
      *(bf16x4*)(HSb + ci * 8192 + e4 * 4) = pack4(h0, h1, h2, h3);
      const float e = __expf(cd[step]);
      h0 = h0 * e + bfs(sv[step][0]); h1 = h1 * e + bfs(sv[step][1]); h2 = h2 * e + bfs(sv[step][2]); h3 = h3 * e + bfs(sv[step][3]);
    }
  }
  const int lane = p.tidl & 63;
  const int wg = (p.bidl - 16) * 4 + (p.tidl >> 6), nw = ((int)gridDim.x - 16) * 4;
#pragma unroll 1
  for (int it = wg; it < 4096; it += nw) f2_item(p, it, lane);
}

DI void s3_block(const DP& p, int j, int b, int c, int g, int half) {
  const int tid = p.tidl, lane = tid & 63, wid = tid >> 6, r = lane & 31, h = lane >> 5;
  const bfr* CN = wsp<bfr>(p, OFF_CN); const bfr* BN = wsp<bfr>(p, OFF_BN); const bfr* XT = wsp<bfr>(p, OFF_XT);
  const bfr* Z = wsp<bfr>(p, OFF_Z); bfr* MIX = wsp<bfr>(p, OFF_MIX);
  bfr* XTs = (bfr*)smem;
  bfr* HSF = (bfr*)(smem + 33792);
  bfr* HSB = (bfr*)(smem + 51200);
  float* LWF = (float*)(smem + 68608);
  float* LWB = LWF + 256;
  {
    const int row0 = chunk_row0(b, c);
    const int lt = half * 4 + wid;
    const int rowl = row0 + lt * 32 + r;
    const bfr* cfp = CN + (size_t)rowl * 512 + g * 128 + 8 * h;
    bf16x8 gtp[8][2];
    {
      bf16x8 cf[8];
#pragma unroll
      for (int kk = 0; kk < 8; ++kk) cf[kk] = *(const bf16x8*)(cfp + kk * 16);
#pragma unroll
      for (int k = 0; k < 8; ++k) { gtp[k][0] = cf[0]; gtp[k][1] = cf[0]; }
      __syncthreads();
      {
        bfr* BS = (bfr*)smem;
#pragma unroll 4
        for (int i = 0; i < 64; ++i) {
          const int row = wid * 64 + i;
          if (lane < 16)
            __builtin_amdgcn_global_load_lds((const unsigned*)(BN + (size_t)(row0 + row) * 512 + g * 128 + lane * 8),
                                             (unsigned*)(BS + row * 136 + lane * 8), 16, 0, 0);
        }
      }
      asm volatile("s_waitcnt vmcnt(0)" ::: "memory");
      __syncthreads();
#pragma unroll 1
      for (int st = 0; st < 8; ++st) {
        f32x16 gt = zero16();
#pragma unroll
        for (int kk = 0; kk < 8; ++kk)
          gt = MFMA(*(const bf16x8*)((const bfr*)smem + (st * 32 + r) * 136 + kk * 16 + 8 * h), cf[kk], gt);
#pragma unroll
        for (int k = 0; k < 7; ++k) { gtp[k][0] = gtp[k + 1][0]; gtp[k][1] = gtp[k + 1][1]; }
        gtp[7][0] = PACK_HALF(gt, 0); gtp[7][1] = PACK_HALF(gt, 1);
      }
    }
    float sumsq = 0.f;
#pragma unroll 1
    for (int hh = 0; hh < 6; ++hh) {
      const int head = g * 6 + hh;
      const size_t cif = (size_t)(((0 * 2 + b) * NCH + c) * 24 + head), cib = (size_t)(((1 * 2 + b) * NCH + c) * 24 + head);
      const float* acf = wsp<float>(p, OFF_ACUM) + cif * 256; const float* acb = wsp<float>(p, OFF_ACUM) + cib * 256;
      const float* dtf = wsp<float>(p, OFF_DTV) + cif * 256; const float* dtb = wsp<float>(p, OFF_DTV) + cib * 256;
      const bfr* HSf = wsp<bfr>(p, OFF_HS) + cif * 8192; const bfr* HSbk = wsp<bfr>(p, OFF_HS) + cib * 8192;
      __syncthreads();
#pragma unroll 4
      for (int i = 0; i < 16; ++i) {
        const int row = wid * 16 + i;
        if (lane < 32)
          __builtin_amdgcn_global_load_lds((const unsigned*)(XT + (size_t)(head * 64 + row) * R + row0 + lane * 8),
                                           (unsigned*)(XTs + row * 264 + lane * 8), 16, 0, 0);
      }
      if (c != 0) {
#pragma unroll 4
        for (int i = 0; i < 16; ++i) {
          const int row = wid * 16 + i;
          if (lane < 16) {
            __builtin_amdgcn_global_load_lds((const unsigned*)(HSf + row * 128 + lane * 8), (unsigned*)(HSF + row * 136 + lane * 8), 16, 0, 0);
            __builtin_amdgcn_global_load_lds((const unsigned*)(HSbk + row * 128 + lane * 8), (unsigned*)(HSB + row * 136 + lane * 8), 16, 0, 0);
          }
        }
      }
      bf16x8 cfh[8];
#pragma unroll
      for (int kk = 0; kk < 8; ++kk) cfh[kk] = *(const bf16x8*)(cfp + kk * 16);
      LWF[tid] = __logf(dtf[tid]) - acf[tid];
      LWB[tid] = __logf(dtb[tid]) - acb[tid];
      const float al_f = acf[lt * 32 + r], al_b = acb[lt * 32 + r];
      asm volatile("s_waitcnt vmcnt(0)" ::: "memory");
      __syncthreads();
      f32x16 acc[2];
      acc[0] = zero16(); acc[1] = zero16();
      if (c != 0) {
        f32x16 t0 = zero16(), t1 = zero16();
#pragma unroll
        for (int kk = 0; kk < 8; ++kk) {
          t0 = MFMA(*(const bf16x8*)(HSF + (r) * 136 + kk * 16 + 8 * h), cfh[kk], t0);
          t1 = MFMA(*(const bf16x8*)(HSF + (32 + r) * 136 + kk * 16 + 8 * h), cfh[kk], t1);
        }
        const float ef = __expf(al_f);
#pragma unroll
        for (int i = 0; i < 16; ++i) { acc[0][i] = t0[i] * ef; acc[1][i] = t1[i] * ef; }
        t0 = zero16(); t1 = zero16();
#pragma unroll
        for (int kk = 0; kk < 8; ++kk) {
          t0 = MFMA(*(const bf16x8*)(HSB + (r) * 136 + kk * 16 + 8 * h), cfh[kk], t0);
          t1 = MFMA(*(const bf16x8*)(HSB + (32 + r) * 136 + kk * 16 + 8 * h), cfh[kk], t1);
        }
        const float eb = __expf(al_b);
#pragma unroll
        for (int i = 0; i < 16; ++i) { acc[0][i] += t0[i] * eb; acc[1][i] += t1[i] * eb; }
      }
      bf16x4 zpre[2][4];
#pragma unroll
      for (int pt = 0; pt < 2; ++pt)
#pragma unroll
        for (int g4 = 0; g4 < 4; ++g4) zpre[pt][g4] = *(const bf16x4*)(Z + (size_t)rowl * 1536 + head * 64 + pt * 32 + 8 * g4 + 4 * h);
#pragma unroll 1
      for (int st = 0; st < 8; ++st) {
        const bf16x8 g0 = gtp[0][0], g1 = gtp[0][1];
#pragma unroll
        for (int k = 0; k < 7; ++k) { gtp[k][0] = gtp[k + 1][0]; gtp[k][1] = gtp[k + 1][1]; }
        gtp[7][0] = g0; gtp[7][1] = g1;
#pragma unroll 1
        for (int dir = 0; dir < 2; ++dir) {
          if (dir == 0 ? (st > lt) : (st < lt)) continue;
          const float* lwd = dir == 0 ? LWF : LWB;
          const float al = dir == 0 ? al_f : al_b;
          f32x16 mm;
#pragma unroll
          for (int g4 = 0; g4 < 4; ++g4) {
            const int sb = st * 32 + 8 * g4 + 4 * h;
            const float4 l4 = *(const float4*)(lwd + sb);
            const float lv[4] = {l4.x, l4.y, l4.z, l4.w};
#pragma unroll
            for (int q = 0; q < 4; ++q) {
              const int i = 4 * g4 + q;
              const int sidx = sb + q, lidx = lt * 32 + r;
              const bool valid = dir == 0 ? (sidx <= lidx) : (sidx >= lidx);
              const float gv = bfs((i >> 3) ? g1[i & 7] : g0[i & 7]);
              const float e = __expf(fminf(al + lv[q], 30.f));
              mm[i] = valid ? gv * e : 0.f;
            }
          }
#pragma unroll
          for (int s2 = 0; s2 < 2; ++s2) {
            bf16x8 pf = PACK_HALF(mm, s2);
#pragma unroll
            for (int pt = 0; pt < 2; ++pt) {
              const bfr* xp = XTs + (pt * 32 + r) * 264 + st * 32 + 16 * s2 + 4 * h;
              bf16x8 xf = join44(*(const bf16x4*)xp, *(const bf16x4*)(xp + 8));
              acc[pt] = MFMA(xf, pf, acc[pt]);
            }
          }
        }
      }
      const float dsk = p.d_skip[j * 24 + head];
#pragma unroll
      for (int pt = 0; pt < 2; ++pt)
#pragma unroll
        for (int g4 = 0; g4 < 4; ++g4) {
          const int pb = pt * 32 + 8 * g4 + 4 * h;
          bf16x4 zv = zpre[pt][g4];
          float y[4];
#pragma unroll
          for (int q = 0; q < 4; ++q) {
            float xv = bf2f(XTs[(pb + q) * 264 + lt * 32 + r]);
            float zz = bfs(zv[q]);
            float v = (acc[pt][4 * g4 + q] + dsk * xv) * (zz / (1.f + __expf(-zz)));
            sumsq += v * v; y[q] = v;
          }
          *(bf16x4*)(MIX + (size_t)rowl * 2048 + 512 + head * 64 + pb) = pack4(y[0], y[1], y[2], y[3]);
        }
    }
    const float tot = sumsq + __shfl_xor(sumsq, 32);
    const float sc = rsqrtf(tot * (1.f / 384.f) + 1e-6f);
    const float* ng = p.ssd_norm_g + (size_t)j * 1536;
    bf16x4 yv[6][2][4];
#pragma unroll
    for (int hh = 0; hh < 6; ++hh)
#pragma unroll
      for (int pt = 0; pt < 2; ++pt)
#pragma unroll
        for (int g4 = 0; g4 < 4; ++g4)
          yv[hh][pt][g4] = *(const bf16x4*)(MIX + (size_t)rowl * 2048 + 512 + (g * 6 + hh) * 64 + pt * 32 + 8 * g4 + 4 * h);
#pragma unroll
    for (int hh = 0; hh < 6; ++hh)
#pragma unroll
      for (int pt = 0; pt < 2; ++pt)
#pragma unroll
        for (int g4 = 0; g4 < 4; ++g4) {
          const int pb = pt * 32 + 8 * g4 + 4 * h, head = g * 6 + hh;
          const float4 gg = *(const float4*)(ng + head * 64 + pb);
          const bf16x4 y4 = yv[hh][pt][g4];
          *(bf16x4*)(MIX + (size_t)rowl * 2048 + 512 + head * 64 + pb) =
              pack4(bfs(y4[0]) * sc * gg.x, bfs(y4[1]) * sc * gg.y, bfs(y4[2]) * sc * gg.z, bfs(y4[3]) * sc * gg.w);
        }
  }
}

DI void s3_phase(const DP& p, int j) {
#pragma unroll 1
  for (int idx = p.bidl; idx < 512; idx += (int)gridDim.x) {
    const int half = idx & 1, g = (idx >> 1) & 3, bcl = idx >> 3;
    s3_block(p, j, bcl >> 5, 1 + (bcl & 31), g, half);
  }
}

DI void qkprep_phase(const DP& p, int j) {
  const int lane = p.tidl & 63;
  const int wg = p.bidl * 4 + (p.tidl >> 6), nw = gridDim.x * 4;
  const bfr* P = wsp<bfr>(p, OFF_P); bfr* QK = wsp<bfr>(p, OFF_QK);
  const float* ROPE = wsp<float>(p, OFF_ROPE);
  const int sub = lane >> 3, d0 = (lane & 7) * 8;
  for (int row = wg; row < R; row += nw) {
    bf16x8 xin[4];
#pragma unroll
    for (int ps = 0; ps < 4; ++ps) {
      const int hs0 = ps * 8 + sub, hsc0 = hs0 < 26 ? hs0 : 25;
      xin[ps] = *(const bf16x8*)(P + (size_t)row * 2304 + (hsc0 < 10 ? hsc0 * 64 : 768 + (hsc0 - 10) * 64) + d0);
    }
#pragma unroll
    for (int ps = 0; ps < 4; ++ps) {
      const int hs = ps * 8 + sub;
      const bool act = hs < 26;
      const int hsc = act ? hs : 25;
      bf16x8 xv = xin[ps];
      float x[8]; float ss = 0.f;
#pragma unroll
      for (int e = 0; e < 8; ++e) { x[e] = bfs(xv[e]); ss += x[e] * x[e]; }
      ss += __shfl_xor(ss, 1); ss += __shfl_xor(ss, 2); ss += __shfl_xor(ss, 4);
      const float rs = rsqrtf(ss * (1.f / 64.f) + 1e-6f);
      const float* gv = hsc < 8 ? p.q_norm_win + j * 64 : hsc < 10 ? p.k_norm_win + j * 64 : hsc < 18 ? p.q_norm_na + j * 64 : p.k_norm_na + j * 64;
#pragma unroll
      for (int e = 0; e < 8; ++e) x[e] = x[e] * rs * gv[d0 + e];
      float pr[8];
#pragma unroll
      for (int e = 0; e < 8; ++e) pr[e] = __shfl_xor(x[e], 2);
      if (hsc < 10 && row < RL) {
        const int pos = row & 8191;
        const int axis = d0 >> 5;
        const int idx = axis == 0 ? (pos >> 6) : (pos & 63);
        const int f0 = d0 & 15;
        const bool second = (d0 & 16) != 0;
        const float* cp = ROPE + (axis * 128 + idx) * 16 + f0;
        const float* sp = cp + 4096;
#pragma unroll
        for (int e = 0; e < 8; ++e) {
          float cs = cp[e], sn = sp[e];
          x[e] = second ? (x[e] * cs + pr[e] * sn) : (x[e] * cs - pr[e] * sn);
        }
      }
      const bool isq = hsc < 8 || (hsc >= 10 && hsc < 18);
      const float qs = isq ? 0.125f : 1.f;
      if (act) *(bf16x8*)(QK + (size_t)row * 1664 + hsc * 64 + d0) = pack8(x[0] * qs, x[1] * qs, x[2] * qs, x[3] * qs, x[4] * qs, x[5] * qs, x[6] * qs, x[7] * qs);
    }
  }
}

struct KVF { bf16x8 k[4]; bf16x8 v[2][2]; };
struct KVS { bf16x8 k[4]; bf16x8 v[4]; };

DI void kv_gload(KVS& g, const bfr* __restrict__ Kt, const bfr* __restrict__ Vt, int lane) {
#pragma unroll
  for (int i = 0; i < 4; ++i) {
    const int idx = lane + 64 * i;
    g.k[i] = *(const bf16x8*)(Kt + (size_t)(idx >> 3) * 1664 + (idx & 7) * 8);
    g.v[i] = *(const bf16x8*)(Vt + (size_t)(idx >> 2) * R + (idx & 3) * 8);
  }
}
DI void kv_sstore(const KVS& g, unsigned char* base, int lane) {
#pragma unroll
  for (int i = 0; i < 4; ++i) {
    const int idx = lane + 64 * i;
    { const int row = idx >> 3, c = idx & 7; *(bf16x8*)(base + row * 128 + ((c ^ (row & 7)) << 4)) = g.k[i]; }
    {
      const int d = idx >> 2, c16 = idx & 3, sw = (d >> 2) & 7;
      bf16x4 lo = __builtin_shufflevector(g.v[i], g.v[i], 0, 1, 2, 3), hi = __builtin_shufflevector(g.v[i], g.v[i], 4, 5, 6, 7);
      *(bf16x4*)(base + 4096 + d * 64 + (((2 * c16) ^ sw) << 3)) = lo;
      *(bf16x4*)(base + 4096 + d * 64 + (((2 * c16 + 1) ^ sw) << 3)) = hi;
    }
  }
}
DI void kv_sload(KVF& f, const unsigned char* base, int r, int h) {
#pragma unroll
  for (int kk = 0; kk < 4; ++kk) f.k[kk] = *(const bf16x8*)(base + r * 128 + (((2 * kk + h) ^ (r & 7)) << 4));
#pragma unroll
  for (int s2 = 0; s2 < 2; ++s2)
#pragma unroll
    for (int dt = 0; dt < 2; ++dt) {
      const int d = dt * 32 + r, sw = (d >> 2) & 7, c8 = 4 * s2 + h;
      const unsigned char* vb = base + 4096 + d * 64;
      f.v[s2][dt] = join44(*(const bf16x4*)(vb + ((c8 ^ sw) << 3)), *(const bf16x4*)(vb + (((c8 + 2) ^ sw) << 3)));
    }
}

DI void attn_compute(f32x16 (&o)[2], float& m, float& l, const unsigned char* qb, const unsigned char* base, int r, int h,
                     int mode, int a0, int a1, const float* __restrict__ rp) {
  f32x16 s = zero16();
#pragma unroll
  for (int kk = 0; kk < 4; ++kk) {
    const int off = r * 128 + (((2 * kk + h) ^ (r & 7)) << 4);
    s = MFMA(*(const bf16x8*)(base + off), *(const bf16x8*)(qb + off), s);
  }
  float tmax = -3.0e38f;
  if (mode == 1) {
#pragma unroll
    for (int i = 0; i < 16; ++i) { int dd = a0 - crow(i, h); dd = dd < 0 ? -dd : dd; s[i] = dd <= 128 ? s[i] : -1.0e30f; }
  } else if (mode == 2) {
#pragma unroll
    for (int i = 0; i < 16; ++i) {
      const int key = crow(i, h);
      const int rel = a0 + key;
      int co = a1 + key; co = co < 0 ? 0 : (co > 30 ? 30 : co);
      s[i] = (rel >= 0 && rel < 16) ? s[i] + rp[co] : -1.0e30f;
    }
  }
#pragma unroll
  for (int i = 0; i < 16; ++i) tmax = fmaxf(tmax, s[i]);
  tmax = fmaxf(tmax, __shfl_xor(tmax, 32));
  const float mn = fmaxf(m, tmax);
  const float alpha = __expf(m - mn);
  float ps = 0.f;
#pragma unroll
  for (int i = 0; i < 16; ++i) { s[i] = __expf(s[i] - mn); ps += s[i]; }
  l = l * alpha + ps; m = mn;
#pragma unroll
  for (int i = 0; i < 16; ++i) { o[0][i] *= alpha; o[1][i] *= alpha; }
#pragma unroll
  for (int s2 = 0; s2 < 2; ++s2) {
    bf16x8 pf = PACK_HALF(s, s2);
#pragma unroll
    for (int dt = 0; dt < 2; ++dt) {
      const int d = dt * 32 + r, sw = (d >> 2) & 7, c8 = 4 * s2 + h;
      const unsigned char* vb = base + 4096 + d * 64;
      bf16x8 vf = join44(*(const bf16x4*)(vb + ((c8 ^ sw) << 3)), *(const bf16x4*)(vb + (((c8 + 2) ^ sw) << 3)));
      o[dt] = MFMA(vf, pf, o[dt]);
    }
  }
}

DI void attn_item(const DP& p, int j, int item, int lane) {
  const int r = lane & 31, h = lane >> 5;
  const bfr* QK = wsp<bfr>(p, OFF_QK); const bfr* VT = wsp<bfr>(p, OFF_VT); bfr* MIX = wsp<bfr>(p, OFF_MIX);
  int kind, b, hd, qt;
  if (item < 4096) { kind = 0; qt = item & 255; hd = (item >> 8) & 7; b = item >> 11; }
  else if (item < 8192) { int v = item - 4096; kind = 1; qt = v & 255; hd = (v >> 8) & 7; b = v >> 11; }
  else if (item < 8320) { int v = item - 8192; kind = 2; qt = v & 7; hd = (v >> 3) & 7; b = v >> 6; }
  else { int v = item - 8320; kind = 3; qt = v & 7; hd = (v >> 3) & 7; b = v >> 6; }
  const bool win = (kind == 0 || kind == 2);
  const bool lat = kind < 2;
  const int q_row0 = lat ? b * SEQ + qt * 32 : RL + b * CTX + qt * 32;
  const int qcol = win ? hd * 64 : (10 + hd) * 64;
  const int kcol = win ? (8 + (hd >> 2)) * 64 : (18 + hd) * 64;
  const bfr* Vb = win ? VT + (size_t)((hd >> 2) * 64) * R : VT + (size_t)(128 + hd * 64) * R;
  const bfr* Kb = QK + kcol;
  f32x16 o[2]; o[0] = zero16(); o[1] = zero16();
  float m = -1.0e30f, l = 0.f;
  if (win) { m = p.sink_win[j * 8 + hd]; l = h == 0 ? 1.f : 0.f; }
  int nloc = 0, lo = 0, gr = 0, kr0 = 0, w = 0, cs = 0;
  const int qpos = qt * 32 + r;
  if (kind == 0) { lo = qt - 4 < 0 ? 0 : qt - 4; const int hi = qt + 4 > 255 ? 255 : qt + 4; nloc = hi - lo + 1; }
  else if (kind == 1) {
    gr = qt >> 1; w = (qt & 1) * 32 + r;
    cs = w - 8; cs = cs < 0 ? 0 : (cs > 48 ? 48 : cs);
    kr0 = gr - 4; kr0 = kr0 < 0 ? 0 : (kr0 > 120 ? 120 : kr0);
    nloc = 16;
  }
  const int ntile = 8 + nloc;
  const float* rpb = p.rpb_na + (size_t)j * 8 * 15 * 31 + hd * 15 * 31;
  auto tile_row = [&](int i) -> int {
    if (i < 8) return RL + b * CTX + i * 32;
    const int li = i - 8;
    if (kind == 0) return b * SEQ + (lo + li) * 32;
    return b * SEQ + (kr0 + (li >> 1)) * 64 + (li & 1) * 32;
  };
  unsigned char* lbase = smem + (p.tidl >> 6) * 12288;
  asm volatile("" ::: "memory");
#pragma unroll
  for (int i = 0; i < 4; ++i) {
    const int idx = lane + 64 * i, row = idx >> 3, c = idx & 7;
    *(bf16x8*)(lbase + 8192 + row * 128 + ((c ^ (row & 7)) << 4)) = *(const bf16x8*)(QK + (size_t)(q_row0 + row) * 1664 + qcol + c * 8);
  }
  KVS g;
  { const int k0 = tile_row(0); kv_gload(g, Kb + (size_t)k0 * 1664, Vb + k0, lane); }
  kv_sstore(g, lbase, lane);
#pragma unroll 1
  for (int i = 0; i < ntile; ++i) {
    { const int in = i + 1 < ntile ? i + 1 : i; const int k0 = tile_row(in); kv_gload(g, Kb + (size_t)k0 * 1664, Vb + k0, lane); }
    int mode = 0, a0 = 0, a1 = 0; const float* rp = rpb;
    if (i >= 8) {
      const int li = i - 8;
      if (kind == 0) { mode = 1; a0 = qpos - (lo + li) * 32; }
      else { mode = 2; const int krow = kr0 + (li >> 1); const int ub = (li & 1) * 32; a0 = ub - cs; a1 = ub - w + 15; rp = rpb + (krow - gr + 7) * 31; }
    }
    asm volatile("" ::: "memory");
    attn_compute(o, m, l, lbase + 8192, lbase, r, h, mode, a0, a1, rp);
    asm volatile("" ::: "memory");
    kv_sstore(g, lbase, lane);
  }
  asm volatile("" ::: "memory");
  const float lt = l + __shfl_xor(l, 32);
  const float inv = 1.f / lt;
  const int ocol = win ? hd * 64 : 512 + hd * 64;
#pragma unroll
  for (int dt = 0; dt < 2; ++dt)
#pragma unroll
    for (int g4 = 0; g4 < 4; ++g4) {
      const int d = dt * 32 + 8 * g4 + 4 * h;
      *(bf16x4*)(MIX + (size_t)(q_row0 + r) * 1024 + ocol + d) =
          pack4(o[dt][4 * g4] * inv, o[dt][4 * g4 + 1] * inv, o[dt][4 * g4 + 2] * inv, o[dt][4 * g4 + 3] * inv);
    }
}

DI void attn_phase(const DP& p, int j) {
  const int lane = p.tidl & 63;
  const int wg = p.bidl * 4 + (p.tidl >> 6), nw = gridDim.x * 4;
#pragma unroll 1
  for (int it = wg; it < 8448; it += nw) attn_item(p, j, it, lane);
}

#define XB_TMO      128
#define XB_XCNT(j)  (256  + 64 * (j))
#define XB_XSUB(j)  (1280 + 64 * (j))
#define XB_XGEN(j)  (2304 + 64 * (j))
#define XB_TOP      3328
#define XB_TOPGEN   3392
#define XCD_BAR_WORDS 3456
#define XB_SPIN_CAP (1u << 18)
#define LAS __attribute__((address_space(3)))

__device__ __forceinline__ unsigned xb_ld(unsigned* p)              { return __hip_atomic_load(p, __ATOMIC_RELAXED, __HIP_MEMORY_SCOPE_AGENT); }
__device__ __forceinline__ unsigned xb_add(unsigned* p, unsigned v) { return __hip_atomic_fetch_add(p, v, __ATOMIC_RELAXED, __HIP_MEMORY_SCOPE_AGENT); }
__device__ __forceinline__ unsigned xb_xcc_id() { return (unsigned)__builtin_amdgcn_s_getreg((3 << 11) | 20) & 0xFu; }
#define XB_SPIN(cond, bar) do { unsigned _sp = 0; while (cond) { __builtin_amdgcn_s_sleep(1); \
    if ((++_sp & 255u) == 0u) { if (xb_ld(&(bar)[XB_TMO])) break; if (_sp > XB_SPIN_CAP) { atomicAdd(&(bar)[XB_TMO], 1u); break; } } } } while (0)

struct XcdBarrier {
    unsigned* bar; unsigned x;
    volatile LAS unsigned* st;
};

__device__ __forceinline__ XcdBarrier xcd_barrier_post(unsigned* bar, volatile LAS unsigned* st) {
    XcdBarrier b; b.bar = bar; b.x = xb_xcc_id(); b.st = st;
    if (threadIdx.x == 0) (void)xb_add(&bar[XB_XCNT(b.x)], 1u);
    return b;
}
__device__ __forceinline__ void xcd_barrier_complete(unsigned* bar, unsigned x, unsigned& nloc, unsigned& nx) {
    const unsigned G = gridDim.x * gridDim.y * gridDim.z;
    unsigned sum, cnt, mine, sp = 0u;
    for (;;) {
        sum = 0u; cnt = 0u; mine = 0u;
#pragma unroll
        for (unsigned j = 0; j < 16; ++j) { const unsigned c = xb_ld(&bar[XB_XCNT(j)]); sum += c; cnt += (c > 0u) ? 1u : 0u; mine = (j == x) ? c : mine; }
        if (sum == G) break;
        __builtin_amdgcn_s_sleep(1);
        if ((++sp & 255u) == 0u) { if (xb_ld(&bar[XB_TMO])) break; if (sp > XB_SPIN_CAP) { atomicAdd(&bar[XB_TMO], 1u); break; } }
    }
    nloc = mine > 0u ? mine : 1u; nx = cnt > 0u ? cnt : 1u;
}

__device__ __forceinline__ void xcd_barrier(const XcdBarrier& b) {
    asm volatile("s_waitcnt vmcnt(0)" ::: "memory");
    __syncthreads();
    if (threadIdx.x == 0) {
        unsigned* bar = b.bar;
        __builtin_amdgcn_s_waitcnt(0);
        unsigned nloc = b.st[0], nx = b.st[1];
        if (nloc == 0u) { xcd_barrier_complete(bar, b.x, nloc, nx); b.st[0] = nloc; b.st[1] = nx; }
        const unsigned old = xb_add(&bar[XB_XSUB(b.x)], 1u);
        const unsigned gen = old / nloc;
        if (old + 1u == (gen + 1u) * nloc) {
            __builtin_amdgcn_fence(__ATOMIC_RELEASE, "agent");
            asm volatile("s_waitcnt vmcnt(0)" ::: "memory");
            const unsigned og = xb_add(&bar[XB_TOP], 1u);
            const unsigned tg = og / nx;
            if (og + 1u == (tg + 1u) * nx) xb_add(&bar[XB_TOPGEN], 1u);
            else XB_SPIN(xb_ld(&bar[XB_TOPGEN]) == tg, bar);
            __builtin_amdgcn_fence(__ATOMIC_ACQUIRE, "agent");
            xb_add(&bar[XB_XGEN(b.x)], 1u);
            asm volatile("s_waitcnt vmcnt(0)" ::: "memory");
        } else {
            XB_SPIN(xb_ld(&bar[XB_XGEN(b.x)]) == gen, bar);
            __builtin_amdgcn_fence(__ATOMIC_ACQUIRE, "agent");
            asm volatile("s_waitcnt vmcnt(0)" ::: "memory");
        }
    }
    __syncthreads();
}


DI void run_phase(const DP& p, int ph, int dry) {
  if (ph == 0) { phase0(p); wconv_phase(p, 0); return; }
  int q = ph - 1, layer, lp;
  if (q < 10) { layer = 0; lp = q; } else if (q < 18) { layer = 1; lp = q - 10; } else if (q < 28) { layer = 2; lp = q - 18; } else { layer = 3; lp = q - 28; }
  const int j = layer >> 1;
  const bool even = (layer & 1) == 0;
  int op, gsel = 0;
  if (even) {
    op = (int)((0x2272654321ull >> (4 * lp)) & 15ull); gsel = (int)((0x3201000000ull >> (4 * lp)) & 15ull);
  } else {
    op = (int)((0x22729821ull >> (4 * lp)) & 15ull); gsel = (int)((0x32010000ull >> (4 * lp)) & 15ull);
  }
  if (op == 1 && layer != 0) wconv_phase(p, layer);
  if (op == 1 || op == 7) {
    const bool first = op == 1;
    norm_phase(p, layer, (first ? p.norm_mix_g : p.norm_ff_g) + layer * 1024, first ? 0 : 3, first ? 1 : 4);
  } else if (op == 2) {
    int mode, lda, N, K, gch; size_t offA, offB;
    if (gsel == 0) { mode = even ? EPI_EVEN_IN : EPI_ODD_IN; offA = OFF_MIX; lda = 1024; offB = OFF_WIN; N = even ? 5168 : 2304; K = 1024; gch = 0; }
    else if (gsel == 1) { mode = EPI_RESID; offA = OFF_MIX; lda = even ? 2048 : 1024; offB = OFF_WOUT; N = 1024; K = even ? 2048 : 1024; gch = 2; }
    else if (gsel == 2) { mode = EPI_RELU2; offA = OFF_MIX; lda = 1024; offB = OFF_WFF1; N = 4096; K = 1024; gch = 0; }
    else { mode = EPI_RESID; offA = OFF_ACT; lda = 4096; offB = OFF_WFF2; N = 1024; K = 4096; gch = 5; }
    if (dry && mode == EPI_RESID) mode = 4;
    gemm_phase(p, mode, wsp<bfr>(p, offA), lda, wsp<bfr>(p, offB), N, K, layer, gch, (layer == 3 && gsel != 0) ? RL / 128 : R / 128);
  } else if (op == 3) conv_dt_phase(p, j);
  else if (op == 4) s1f1_phase(p);
  else if (op == 5) s2f2_phase(p, j);
  else if (op == 6) s3_phase(p, j);
  else if (op == 8) qkprep_phase(p, j);
  else if (op == 9) attn_phase(p, j);
}

DI int probe_reps(int ph) {
#ifdef PROBE_MASK
  if (ph == 0) return (PROBE_MASK & 1) ? 2 : 1;
  int q = ph - 1, layer, lp;
  if (q < 10) { layer = 0; lp = q; } else if (q < 18) { layer = 1; lp = q - 10; } else if (q < 28) { layer = 2; lp = q - 18; } else { layer = 3; lp = q - 28; }
  const bool even = (layer & 1) == 0;
  int op, gsel;
  if (even) { op = (int)((0x2272654321ull >> (4 * lp)) & 15ull); gsel = (int)((0x3201000000ull >> (4 * lp)) & 15ull); }
  else { op = (int)((0x22729821ull >> (4 * lp)) & 15ull); gsel = (int)((0x32010000ull >> (4 * lp)) & 15ull); }
  if (op == 5) return 1;
  if (op == 2 && (gsel == 1 || gsel == 3)) return ((PROBE_MASK >> 10) & 1) ? 2 : 1;
  return ((PROBE_MASK >> op) & 1) ? 2 : 1;
#else
  return 1;
#endif
}

__shared__ uint4 xb_words;

__global__ void __launch_bounds__(256, 2) mega(Params p, int ph0, int ph1) {
  cg::grid_group grid = cg::this_grid();
  if (threadIdx.x == 0) xb_words = make_uint4(0u, 0u, 0u, 0u);
  __syncthreads();
  XcdBarrier xb = xcd_barrier_post((unsigned*)(p.ws + OFF_BAR), (volatile LAS unsigned*)&xb_words);
#pragma unroll 1
  for (int ph = ph0; ph < ph1; ++ph) {
    const int nrep = probe_reps(ph);
#pragma unroll 1
    for (int rep = 0; rep < nrep; ++rep) {
      DP q;
      (Params&)q = p;
      int t = threadIdx.x, bb = blockIdx.x;
      asm volatile("" : "+v"(t));
      asm volatile("" : "+s"(bb));
      int z0;
      asm volatile("s_mov_b32 %0, 0" : "=s"(z0));
      q.ws = p.ws + z0;
      q.out = p.out + z0;
      q.tidl = t; q.bidl = bb;
      run_phase(q, ph, rep + 1 < nrep);
    }
    if (ph + 1 < ph1) {
      if (ph == ph0) grid.sync();
      else xcd_barrier(xb);
    }
  }
}

extern "C" void kernel_launch(void* const* d_in, const int* in_sizes, int n_in, void* d_out, int out_size, void* d_ws,
                              size_t ws_size, hipStream_t stream) {
  static int grid_blocks = 0;
  if (!grid_blocks) {
    int dev = 0, cus = 0, per_cu = 0;
    hipGetDevice(&dev);
    hipDeviceGetAttribute(&cus, hipDeviceAttributeMultiprocessorCount, dev);
    hipOccupancyMaxActiveBlocksPerMultiprocessor(&per_cu, mega, 256, 0);
    if (per_cu > 2) per_cu = 2;
    if (per_cu < 1) per_cu = 1;
    grid_blocks = cus * per_cu;
  }
  Params p{};
  const float** pp = (const float**)&p;
  for (int i = 0; i < 26; ++i) pp[i] = (const float*)d_in[i];
  p.out = (float*)d_out;
  p.ws = (unsigned char*)d_ws;
  if (ws_size < WS_TOTAL) fprintf(stderr, "workspace too small: %zu < %zu\n", ws_size, (size_t)WS_TOTAL);
  hipMemsetAsync((unsigned char*)d_ws + OFF_BAR, 0, XCD_BAR_WORDS * 4, stream);
#if MULTI_LAUNCH
  for (int ph = 0; ph < NPHASE; ++ph) {
    int a = ph, b = ph + 1;
    void* args[] = {&p, &a, &b};
    hipLaunchCooperativeKernel((void*)mega, dim3(grid_blocks), dim3(256), args, 0, stream);
  }
#else
  int a = 0, b = NPHASE;
  void* args[] = {&p, &a, &b};
  hipError_t e = hipLaunchCooperativeKernel((void*)mega, dim3(grid_blocks), dim3(256), args, 0, stream);
  if (e != hipSuccess) fprintf(stderr, "cooperative launch failed: %s (grid %d)\n", hipGetErrorString(e), grid_blocks);
#endif
}
```

```cpp
#include <hip/hip_runtime.h>
#include <hip/hip_cooperative_groups.h>
#include <cstdio>
namespace cg = cooperative_groups;

typedef unsigned short bfr;
typedef __attribute__((ext_vector_type(8))) short bf16x8;
typedef __attribute__((ext_vector_type(4))) short bf16x4;
typedef __attribute__((ext_vector_type(16))) float f32x16;
#define DI __device__ __forceinline__
#define MFMA(a, b, c) __builtin_amdgcn_mfma_f32_32x32x16_bf16((a), (b), (c), 0, 0, 0)

#ifndef MULTI_LAUNCH
#define MULTI_LAUNCH 0
#endif

constexpr int RL = 16384, R = 16896, SEQ = 8192, CTX = 256;
constexpr int NCH = 33, CL = 256;
constexpr int NPHASE = 37;

constexpr size_t al(size_t x) { return (x + 255) & ~size_t(255); }
constexpr size_t OFF_HC = 0;
constexpr size_t OFF_MOD = OFF_HC + al(512 * 1024 * 4);
constexpr size_t OFF_TW = OFF_MOD + al(4 * 3 * 6144 * 4);
constexpr size_t OFF_C128 = OFF_TW + al(8192 * 8);
constexpr size_t OFF_S128 = OFF_C128 + al(128 * 128 * 2);
constexpr size_t OFF_C64 = OFF_S128 + al(128 * 128 * 2);
constexpr size_t OFF_S64 = OFF_C64 + al(64 * 64 * 2);
constexpr size_t OFF_C256 = OFF_S64 + al(64 * 64 * 2);
constexpr size_t OFF_S256 = OFF_C256 + al(256 * 256 * 2);
constexpr size_t OFF_ROPE = OFF_S256 + al(256 * 256 * 2);
constexpr size_t OFF_DTV = OFF_ROPE + al(2 * 2 * 128 * 16 * 4);
constexpr size_t DT_BYTES = (size_t)2 * 2 * NCH * 24 * 256 * 4;
constexpr size_t OFF_ACUM = OFF_DTV + al(DT_BYTES);
constexpr size_t OFF_WIN = OFF_ACUM + al(DT_BYTES);
constexpr size_t OFF_WOUT = OFF_WIN + al((size_t)5248 * 1024 * 2);
constexpr size_t OFF_WFF1 = OFF_WOUT + al((size_t)1024 * 2048 * 2);
constexpr size_t OFF_WFF2 = OFF_WFF1 + al((size_t)4096 * 1024 * 2);
constexpr size_t OFF_MIX = OFF_WFF2 + al((size_t)4096 * 1024 * 2);
constexpr size_t OFF_BIG = OFF_MIX + al((size_t)R * 2048 * 2);
constexpr size_t OFF_Z = OFF_BIG;
constexpr size_t OFF_ZRT = OFF_Z + (size_t)R * 1536 * 2;
constexpr size_t OFF_ZIT = OFF_ZRT + (size_t)512 * R * 2;
constexpr size_t OFF_XBC = OFF_ZIT + (size_t)512 * R * 2;
constexpr size_t OFF_DTRAW = OFF_XBC + (size_t)R * 2560 * 2;
constexpr size_t BIG_END = OFF_DTRAW + (size_t)R * 48 * 4;
constexpr size_t OFF_HS = OFF_XBC;
constexpr size_t HS_BYTES = (size_t)2 * 2 * NCH * 24 * 8192 * 2;
constexpr size_t OFF_YR = OFF_HS + HS_BYTES;
constexpr size_t OFF_YI = OFF_YR + (size_t)2 * 512 * 128 * 64 * 2;
static_assert(OFF_YI + (size_t)2 * 512 * 128 * 64 * 2 <= OFF_DTRAW, "fft scratch overflows");
constexpr size_t OFF_ACT = OFF_BIG;
static_assert((size_t)R * 4096 * 2 <= BIG_END - OFF_BIG, "act overflows");
constexpr size_t OFF_P = OFF_BIG;
constexpr size_t OFF_VT = OFF_P + (size_t)R * 2304 * 2;
constexpr size_t OFF_QK = OFF_VT + (size_t)640 * R * 2;
static_assert(OFF_QK + (size_t)R * 1664 * 2 <= BIG_END, "odd overflows");
constexpr size_t OFF_XT = al(BIG_END);
constexpr size_t OFF_BN = OFF_XT + (size_t)1536 * R * 2;
constexpr size_t OFF_BT = OFF_BN + (size_t)R * 512 * 2;
constexpr size_t OFF_CN = OFF_BT + (size_t)512 * R * 2;
constexpr size_t OFF_BAR = al(OFF_CN + (size_t)R * 512 * 2);
constexpr size_t WS_TOTAL = OFF_BAR + 16384;
static_assert(WS_TOTAL <= 402653184ull, "workspace too large");

struct Params {
  const float *x, *c, *ctx, *c_ctx, *w_mod, *b_mod, *norm_mix_g, *norm_ff_g, *w_ff1, *w_ff2;
  const float *w_in_even, *conv_w, *conv_b, *dt_bias, *a_log, *d_skip, *ssd_norm_g, *w_out_even;
  const float *w_in_odd, *q_norm_win, *k_norm_win, *sink_win, *q_norm_na, *k_norm_na, *rpb_na, *w_out_odd;
  float* out;
  unsigned char* ws;
};

struct DP : Params { int tidl, bidl; };

__shared__ __attribute__((aligned(16))) unsigned char smem[73728];

typedef __attribute__((ext_vector_type(2))) __bf16 bf2_t;
typedef __attribute__((ext_vector_type(2))) float f2_t;
typedef __attribute__((ext_vector_type(4))) unsigned u32x4_t;
typedef __attribute__((ext_vector_type(2))) unsigned u32x2_t;
DI unsigned pk2(float a, float b) { f2_t v = {a, b}; return __builtin_bit_cast(unsigned, __builtin_convertvector(v, bf2_t)); }
DI bfr f2bf(float x) { return (bfr)(pk2(x, 0.f) & 0xffffu); }
DI float bf2f(bfr b) { return __uint_as_float(((unsigned)b) << 16); }
DI float bfs(short s) { return __uint_as_float(((unsigned)(unsigned short)s) << 16); }
DI int crow(int i, int h) { return (i & 3) + 8 * (i >> 2) + 4 * h; }
DI f32x16 zero16() { f32x16 z; for (int i = 0; i < 16; ++i) z[i] = 0.f; return z; }
DI bf16x8 pack8(float a0, float a1, float a2, float a3, float a4, float a5, float a6, float a7) {
  u32x4_t v = {pk2(a0, a1), pk2(a2, a3), pk2(a4, a5), pk2(a6, a7)};
  return __builtin_bit_cast(bf16x8, v);
}
DI bf16x4 pack4(float a0, float a1, float a2, float a3) {
  u32x2_t v = {pk2(a0, a1), pk2(a2, a3)};
  return __builtin_bit_cast(bf16x4, v);
}
#define PACK_HALF(s, s2) pack8(s[8 * (s2)], s[8 * (s2) + 1], s[8 * (s2) + 2], s[8 * (s2) + 3], s[8 * (s2) + 4], s[8 * (s2) + 5], s[8 * (s2) + 6], s[8 * (s2) + 7])
DI bf16x8 join44(bf16x4 lo, bf16x4 hi) { return __builtin_shufflevector(lo, hi, 0, 1, 2, 3, 4, 5, 6, 7); }
DI int chunk_row0(int b, int c) { return c == 0 ? RL + b * CTX : b * SEQ + (c - 1) * CL; }

DI void sincos_turn(double f, float& s, float& c) {
  f -= rint(f);
  double x = f * 6.283185307179586476925;
  double x2 = x * x, ss = 1.0, cc = 1.0;
#pragma unroll
  for (int k = 13; k >= 1; --k) {
    ss = 1.0 - x2 / (double)((2 * k) * (2 * k + 1)) * ss;
    cc = 1.0 - x2 / (double)((2 * k - 1) * (2 * k)) * cc;
  }
  s = (float)(x * ss); c = (float)cc;
}

template <class T> DI T* wsp(const DP& p, size_t off) { return (T*)(p.ws + off); }

DI void phase0(const DP& p) {
  const int tid = p.tidl, bid = p.bidl, G = gridDim.x;
  float* lds = (float*)smem;
  float* MOD = wsp<float>(p, OFF_MOD);
  for (int u = bid; u < 384; u += G) {
    int layer = u / 96, cb = u % 96;
    for (int i = tid; i < 3072; i += 256) {
      int v = i >> 10, k = i & 1023;
      float c = v < 2 ? p.c[v * 1024 + k] : p.c_ctx[k];
      lds[i] = c / (1.f + expf(-c));
    }
    __syncthreads();
    int kq = tid >> 6, cc = tid & 63, col = cb * 64 + cc;
    const float* w = p.w_mod + (size_t)layer * 1024 * 6144 + col;
    float a0 = 0, a1 = 0, a2 = 0;
    for (int k = kq * 256; k < kq * 256 + 256; ++k) {
      float wv = w[(size_t)k * 6144];
      a0 += lds[k] * wv; a1 += lds[1024 + k] * wv; a2 += lds[2048 + k] * wv;
    }
    float* red = lds + 3072;
    red[(kq * 3 + 0) * 64 + cc] = a0; red[(kq * 3 + 1) * 64 + cc] = a1; red[(kq * 3 + 2) * 64 + cc] = a2;
    __syncthreads();
    if (tid < 192) {
      int v = tid >> 6;
      float s = red[(0 * 3 + v) * 64 + cc] + red[(1 * 3 + v) * 64 + cc] + red[(2 * 3 + v) * 64 + cc] + red[(3 * 3 + v) * 64 + cc];
      MOD[(layer * 3 + v) * 6144 + col] = s + p.b_mod[layer * 6144 + col];
    }
    __syncthreads();
  }
  const int gt = bid * 256 + tid, nt = G * 256;
  {
    const float4* xs = (const float4*)p.x; float4* od = (float4*)p.out;
    for (int i = gt; i < RL * 256; i += 4 * nt) {
      float4 t4[4];
#pragma unroll
      for (int q = 0; q < 4; ++q) { const int ii = i + q * nt; t4[q] = ii < RL * 256 ? xs[ii] : make_float4(0.f, 0.f, 0.f, 0.f); }
#pragma unroll
      for (int q = 0; q < 4; ++q) { const int ii = i + q * nt; if (ii < RL * 256) od[ii] = t4[q]; }
    }
    const float4* cs = (const float4*)p.ctx; float4* hd = wsp<float4>(p, OFF_HC);
    for (int i = gt; i < 512 * 256; i += nt) hd[i] = cs[i];
  }
  float2* TW = wsp<float2>(p, OFF_TW);
  for (int i = gt; i < 8192; i += nt) { float s, c; sincos_turn((double)i / 8192.0, s, c); TW[i] = make_float2(c, s); }
  bfr* C128 = wsp<bfr>(p, OFF_C128); bfr* S128 = wsp<bfr>(p, OFF_S128);
  for (int i = gt; i < 128 * 128; i += nt) { int a = i >> 7, b = i & 127; float s, c; sincos_turn((double)((a * b) & 127) / 128.0, s, c); C128[i] = f2bf(c); S128[i] = f2bf(s); }
  bfr* C64 = wsp<bfr>(p, OFF_C64); bfr* S64 = wsp<bfr>(p, OFF_S64);
  for (int i = gt; i < 64 * 64; i += nt) { int a = i >> 6, b = i & 63; float s, c; sincos_turn((double)((a * b) & 63) / 64.0, s, c); C64[i] = f2bf(c); S64[i] = f2bf(s); }
  bfr* C256 = wsp<bfr>(p, OFF_C256); bfr* S256 = wsp<bfr>(p, OFF_S256);
  for (int i = gt; i < 256 * 256; i += nt) { int a = i >> 8, b = i & 255; float s, c; sincos_turn((double)((a * b) & 255) / 256.0, s, c); C256[i] = f2bf(c); S256[i] = f2bf(s); }
  float* ROPE = wsp<float>(p, OFF_ROPE);
  for (int i = gt; i < 2 * 128 * 16; i += nt) {
    int f = i & 15, idx = (i >> 4) & 127;
    float ang = (float)idx * (float)exp(-(double)f * 0.5756462732485115);
    float s, c; sincos_turn((double)ang / 6.283185307179586476925, s, c);
    ROPE[i] = c; ROPE[4096 + i] = s;
  }
}

DI void tcvt_unit(const float* __restrict__ src, int ld, int c0, int ncols, int K, bfr* __restrict__ dst, int dr0, int u, int tid) {
  const int ntk = K >> 6;
  const int tn = u / ntk, tk = u % ntk, k0 = tk * 64, nb = tn * 64;
  bfr* T = (bfr*)smem;
  float4 v[4];
  const int n4 = (tid & 15) * 4;
#pragma unroll
  for (int i = 0; i < 4; ++i) {
    const int kk = (tid >> 4) + 16 * i;
    v[i] = make_float4(0.f, 0.f, 0.f, 0.f);
    if (nb + n4 < ncols) v[i] = *(const float4*)(src + (size_t)(k0 + kk) * ld + c0 + nb + n4);
  }
#pragma unroll
  for (int i = 0; i < 4; ++i) {
    const int kk = (tid >> 4) + 16 * i;
    T[(n4 + 0) * 72 + kk] = f2bf(v[i].x); T[(n4 + 1) * 72 + kk] = f2bf(v[i].y);
    T[(n4 + 2) * 72 + kk] = f2bf(v[i].z); T[(n4 + 3) * 72 + kk] = f2bf(v[i].w);
  }
  __syncthreads();
  {
    int n = tid >> 2, kseg = (tid & 3) * 16;
    if (nb + n < ncols) {
      bfr* d = dst + (size_t)(dr0 + nb + n) * K + k0 + kseg;
      *(bf16x8*)d = *(const bf16x8*)(T + n * 72 + kseg);
      *(bf16x8*)(d + 8) = *(const bf16x8*)(T + n * 72 + kseg + 8);
    }
  }
  __syncthreads();
}

DI void wconv_phase(const DP& p, int layer) {
  const int tid = p.tidl;
  const int j = layer >> 1;
  bfr* WIN = wsp<bfr>(p, OFF_WIN); bfr* WOUT = wsp<bfr>(p, OFF_WOUT);
  bfr* WFF1 = wsp<bfr>(p, OFF_WFF1); bfr* WFF2 = wsp<bfr>(p, OFF_WFF2);
  const float* ff1 = p.w_ff1 + (size_t)layer * 1024 * 4096;
  const float* ff2 = p.w_ff2 + (size_t)layer * 4096 * 1024;
  float* cst = (float*)(smem + 20480);
  if (tid < 64) { float s, c; sincos_turn((double)tid / 64.0, s, c); cst[tid] = c; cst[64 + tid] = s; }
  __syncthreads();
  if ((layer & 1) == 0) {
    const float* win = p.w_in_even + (size_t)j * 1024 * 4656;
    const float* wout = p.w_out_even + (size_t)j * 2048 * 1024;
    const int n_in = 65 * 16, n_out = 16 * 32, n_f1 = 64 * 16, n_f2 = 16 * 64, n_fold = 128;
    const int total = n_in + n_out + n_f1 + n_f2 + n_fold;
    for (int u = p.bidl; u < total; u += gridDim.x) {
      int v = u;
      if (v < n_in) { tcvt_unit(win, 4656, 512, 4144, 1024, WIN, 1024, v, tid); continue; }
      v -= n_in;
      if (v < n_out) { tcvt_unit(wout, 1024, 0, 1024, 2048, WOUT, 0, v, tid); continue; }
      v -= n_out;
      if (v < n_f1) { tcvt_unit(ff1, 4096, 0, 4096, 1024, WFF1, 0, v, tid); continue; }
      v -= n_f1;
      if (v < n_f2) { tcvt_unit(ff2, 1024, 0, 1024, 4096, WFF2, 0, v, tid); continue; }
      v -= n_f2;
      {
        const int g = v >> 4, kb = v & 15;
        float* wt = (float*)smem;
#pragma unroll
        for (int i = 0; i < 4; ++i) {
          const int idx = tid + 256 * i, kk = idx >> 4, j4 = (idx & 15) * 4;
          const float4 wv = *(const float4*)(win + (size_t)(kb * 64 + kk) * 4656 + g * 64 + j4);
          wt[kk * 65 + j4] = wv.x; wt[kk * 65 + j4 + 1] = wv.y; wt[kk * 65 + j4 + 2] = wv.z; wt[kk * 65 + j4 + 3] = wv.w;
        }
        __syncthreads();
        const int kl = tid & 63, mg = tid >> 6;
#pragma unroll 1
        for (int mi = 0; mi < 16; ++mi) {
          const int m = mg * 16 + mi;
          float sc = 0.f, ss = 0.f;
#pragma unroll 8
          for (int jj = 0; jj < 64; ++jj) { const float w = wt[kl * 65 + jj]; const int idx = (m * jj) & 63; sc += w * cst[idx]; ss += w * cst[64 + idx]; }
          const int ch = g * 64 + m, k = kb * 64 + kl;
          WIN[(size_t)ch * 1024 + k] = f2bf(sc);
          WIN[(size_t)(512 + ch) * 1024 + k] = f2bf(-ss);
        }
        __syncthreads();
      }
    }
  } else {
    const float* win = p.w_in_odd + (size_t)j * 1024 * 2304;
    const float* wout = p.w_out_odd + (size_t)j * 1024 * 1024;
    const int n_in = 36 * 16, n_out = 16 * 16, n_f1 = 64 * 16, n_f2 = 16 * 64;
    const int total = n_in + n_out + n_f1 + n_f2;
    for (int u = p.bidl; u < total; u += gridDim.x) {
      int v = u;
      if (v < n_in) { tcvt_unit(win, 2304, 0, 2304, 1024, WIN, 0, v, tid); continue; }
      v -= n_in;
      if (v < n_out) { tcvt_unit(wout, 1024, 0, 1024, 1024, WOUT, 0, v, tid); continue; }
      v -= n_out;
      if (v < n_f1) { tcvt_unit(ff1, 4096, 0, 4096, 1024, WFF1, 0, v, tid); continue; }
      v -= n_f1;
      tcvt_unit(ff2, 1024, 0, 1024, 4096, WFF2, 0, v, tid);
    }
  }
}

DI void norm_phase(const DP& p, int layer, const float* __restrict__ gvec, int shc, int scc) {
  const int lane = p.tidl & 63;
  const int wg = p.bidl * 4 + (p.tidl >> 6), nw = gridDim.x * 4;
  const float* MOD = wsp<float>(p, OFF_MOD);
  const float* HC = wsp<float>(p, OFF_HC);
  bfr* U = wsp<bfr>(p, OFF_MIX);
#pragma unroll 1
  for (int row0 = wg; row0 < R; row0 += 2 * nw) {
    float4 v[2][4]; float ss[2] = {0.f, 0.f};
#pragma unroll
    for (int q = 0; q < 2; ++q) {
      const int row = row0 + q * nw < R ? row0 + q * nw : row0;
      const float* hp = row < RL ? p.out + (size_t)row * 1024 : HC + (size_t)(row - RL) * 1024;
#pragma unroll
      for (int i = 0; i < 4; ++i) v[q][i] = *(const float4*)(hp + i * 256 + lane * 4);
    }
#pragma unroll
    for (int q = 0; q < 2; ++q) {
#pragma unroll
      for (int i = 0; i < 4; ++i) ss[q] += v[q][i].x * v[q][i].x + v[q][i].y * v[q][i].y + v[q][i].z * v[q][i].z + v[q][i].w * v[q][i].w;
#pragma unroll
      for (int o = 32; o >= 1; o >>= 1) ss[q] += __shfl_xor(ss[q], o);
    }
#pragma unroll
    for (int q = 0; q < 2; ++q) {
      const int row = row0 + q * nw;
      if (row >= R) continue;
      const int ms = row < RL ? (row >> 13) : 2;
      const float* md = MOD + (layer * 3 + ms) * 6144;
      const float rs = rsqrtf(ss[q] * (1.f / 1024.f) + 1e-6f);
#pragma unroll
      for (int i = 0; i < 4; ++i) {
        int col = i * 256 + lane * 4;
        float4 g = *(const float4*)(gvec + col);
        float4 sc = *(const float4*)(md + scc * 1024 + col);
        float4 sh = *(const float4*)(md + shc * 1024 + col);
        bf16x4 o = pack4(v[q][i].x * rs * g.x * (1.f + sc.x) + sh.x, v[q][i].y * rs * g.y * (1.f + sc.y) + sh.y,
                         v[q][i].z * rs * g.z * (1.f + sc.z) + sh.z, v[q][i].w * rs * g.w * (1.f + sc.w) + sh.w);
        *(bf16x4*)(U + (size_t)row * 1024 + col) = o;
      }
    }
  }
}

enum { EPI_EVEN_IN = 0, EPI_ODD_IN = 1, EPI_RELU2 = 2, EPI_RESID = 3 };

DI void gemm_phase(const DP& p, int mode, const bfr* __restrict__ A, int lda, const bfr* __restrict__ Bt,
                   int N, int K, int layer, int gchunk, int nM) {
  const int tid = p.tidl, lane = tid & 63, wid = tid >> 6, r = lane & 31, h = lane >> 5;
  const int wm = wid >> 1, wn = wid & 1;
  const int nN = (N + 127) >> 7;
  const int tiles = nM * nN, G = (int)gridDim.x;
  int full = tiles, tail = 0, St = 1;
  if (mode == EPI_RESID) {
    full = (tiles / G) * G; tail = tiles - full;
    if (tail > 0) { int c = G / tail; int kmax = K >> 7; St = 1; while (St * 2 <= c && St * 2 <= 16 && St * 2 <= kmax) St *= 2; }
  }
  const int chunk = (full + 7) >> 3;
  const int units = chunk * 8 + tail * St;
  bfr* sm = (bfr*)smem;
  const int lrow = tid >> 3, lc = (tid & 7) * 8;
#pragma unroll 1
  for (int u = p.bidl; u < units; u += G) {
    int t, ks, Ks; bool atom;
    if (u < chunk * 8) {
      t = (u & 7) * chunk + (u >> 3);
      if (t >= full) continue;
      ks = 0; Ks = K; atom = false;
    } else { const int v = u - chunk * 8; t = full + v / St; ks = v % St; Ks = K / St; atom = St > 1; }
    const int nk = Ks >> 6;
    const int panel = t / (nM * 8); const int rem = t - panel * nM * 8;
    const int pw = (nN - panel * 8) < 8 ? (nN - panel * 8) : 8;
    const int tm = rem / pw, tn = panel * 8 + rem % pw;
    const int m0 = tm * 128, n0 = tn * 128, kbase = ks * Ks;
    f32x16 acc[2][2];
    acc[0][0] = zero16(); acc[0][1] = zero16(); acc[1][0] = zero16(); acc[1][1] = zero16();
    const bfr* Ag = A + (size_t)(m0 + lrow) * lda + kbase + lc;
    const bfr* Bg = Bt + (size_t)(n0 + lrow) * K + kbase + lc;
    bf16x8 ra[4], rb[4];
#pragma unroll
    for (int i = 0; i < 4; ++i) {
      ra[i] = *(const bf16x8*)(Ag + (size_t)(32 * i) * lda);
      rb[i] = *(const bf16x8*)(Bg + (size_t)(32 * i) * K);
    }
#pragma unroll
    for (int i = 0; i < 4; ++i) {
      *(bf16x8*)(sm + (lrow + 32 * i) * 72 + lc) = ra[i];
      *(bf16x8*)(sm + 9216 + (lrow + 32 * i) * 72 + lc) = rb[i];
    }
    if (nk > 1) {
#pragma unroll
      for (int i = 0; i < 4; ++i) {
        ra[i] = *(const bf16x8*)(Ag + (size_t)(32 * i) * lda + 64);
        rb[i] = *(const bf16x8*)(Bg + (size_t)(32 * i) * K + 64);
      }
    }
    __syncthreads();
#pragma unroll 1
    for (int kt = 0; kt < nk; ++kt) {
      if (kt + 1 < nk) {
        bfr* Ad = sm + ((kt + 1) & 1) * 18432;
#pragma unroll
        for (int i = 0; i < 4; ++i) {
          *(bf16x8*)(Ad + (lrow + 32 * i) * 72 + lc) = ra[i];
          *(bf16x8*)(Ad + 9216 + (lrow + 32 * i) * 72 + lc) = rb[i];
        }
      }
      if (kt + 2 < nk) {
#pragma unroll
        for (int i = 0; i < 4; ++i) {
          ra[i] = *(const bf16x8*)(Ag + (size_t)(32 * i) * lda + (kt + 2) * 64);
          rb[i] = *(const bf16x8*)(Bg + (size_t)(32 * i) * K + (kt + 2) * 64);
        }
      }
      const bfr* As = sm + (kt & 1) * 18432;
      const bfr* Bs = As + 9216;
      __builtin_amdgcn_s_setprio(1);
#pragma unroll
      for (int kk = 0; kk < 4; ++kk) {
        bf16x8 a0 = *(const bf16x8*)(As + (wm * 64 + r) * 72 + kk * 16 + h * 8);
        bf16x8 a1 = *(const bf16x8*)(As + (wm * 64 + 32 + r) * 72 + kk * 16 + h * 8);
        bf16x8 b0 = *(const bf16x8*)(Bs + (wn * 64 + r) * 72 + kk * 16 + h * 8);
        bf16x8 b1 = *(const bf16x8*)(Bs + (wn * 64 + 32 + r) * 72 + kk * 16 + h * 8);
        acc[0][0] = MFMA(a0, b0, acc[0][0]);
        acc[0][1] = MFMA(a0, b1, acc[0][1]);
        acc[1][0] = MFMA(a1, b0, acc[1][0]);
        acc[1][1] = MFMA(a1, b1, acc[1][1]);
      }
      __builtin_amdgcn_s_setprio(0);
      __syncthreads();
    }
    if (mode == EPI_RESID && !atom) {
      float hv[2][2][16], gt2[2][2];
#pragma unroll
      for (int mi = 0; mi < 2; ++mi)
#pragma unroll
        for (int ni = 0; ni < 2; ++ni) {
          const int col = n0 + wn * 64 + ni * 32 + r;
          const int rowb = m0 + wm * 64 + mi * 32 + 4 * h;
          const int ms = rowb < RL ? (rowb >> 13) : 2;
          gt2[mi][ni] = wsp<float>(p, OFF_MOD)[(layer * 3 + ms) * 6144 + gchunk * 1024 + col];
          const float* hp = rowb < RL ? p.out + (size_t)rowb * 1024 + col : wsp<float>(p, OFF_HC) + (size_t)(rowb - RL) * 1024 + col;
#pragma unroll
          for (int i = 0; i < 16; ++i) hv[mi][ni][i] = hp[(size_t)((i & 3) + 8 * (i >> 2)) * 1024];
        }
#pragma unroll
      for (int mi = 0; mi < 2; ++mi)
#pragma unroll
        for (int ni = 0; ni < 2; ++ni) {
          const int col = n0 + wn * 64 + ni * 32 + r;
          const int rowb = m0 + wm * 64 + mi * 32 + 4 * h;
          float* hp = rowb < RL ? p.out + (size_t)rowb * 1024 + col : wsp<float>(p, OFF_HC) + (size_t)(rowb - RL) * 1024 + col;
#pragma unroll
          for (int i = 0; i < 16; ++i) hp[(size_t)((i & 3) + 8 * (i >> 2)) * 1024] = hv[mi][ni][i] + gt2[mi][ni] * acc[mi][ni][i];
        }
      continue;
    }
#pragma unroll
    for (int mi = 0; mi < 2; ++mi)
#pragma unroll
      for (int ni = 0; ni < 2; ++ni)
#pragma unroll
        for (int g4 = 0; g4 < 4; ++g4) {
          const int row = m0 + wm * 64 + mi * 32 + 8 * g4 + 4 * h;
          const int col = n0 + wn * 64 + ni * 32 + r;
          const float v0 = acc[mi][ni][4 * g4], v1 = acc[mi][ni][4 * g4 + 1], v2 = acc[mi][ni][4 * g4 + 2], v3 = acc[mi][ni][4 * g4 + 3];
          if (mode == EPI_EVEN_IN) {
            if (col < 1024) {
              bfr* dst = wsp<bfr>(p, col < 512 ? OFF_ZRT : OFF_ZIT) + (size_t)(col & 511) * R + row;
              *(bf16x4*)dst = pack4(v0, v1, v2, v3);
            } else if (col < 2560) {
              bfr* dst = wsp<bfr>(p, OFF_Z) + (size_t)row * 1536 + (col - 1024);
              dst[0] = f2bf(v0); dst[1536] = f2bf(v1); dst[2 * 1536] = f2bf(v2); dst[3 * 1536] = f2bf(v3);
            } else if (col < 5120) {
              bfr* dst = wsp<bfr>(p, OFF_XBC) + (size_t)row * 2560 + (col - 2560);
              dst[0] = f2bf(v0); dst[2560] = f2bf(v1); dst[2 * 2560] = f2bf(v2); dst[3 * 2560] = f2bf(v3);
            } else if (col < 5168) {
              float* dst = wsp<float>(p, OFF_DTRAW) + (size_t)row * 48 + (col - 5120);
              dst[0] = v0; dst[48] = v1; dst[96] = v2; dst[144] = v3;
            }
          } else if (mode == EPI_ODD_IN) {
            if (col >= 640 && col < 768) {
              *(bf16x4*)(wsp<bfr>(p, OFF_VT) + (size_t)(col - 640) * R + row) = pack4(v0, v1, v2, v3);
            } else if (col >= 1792) {
              *(bf16x4*)(wsp<bfr>(p, OFF_VT) + (size_t)(128 + col - 1792) * R + row) = pack4(v0, v1, v2, v3);
            } else {
              bfr* dst = wsp<bfr>(p, OFF_P) + (size_t)row * 2304 + col;
              dst[0] = f2bf(v0); dst[2304] = f2bf(v1); dst[2 * 2304] = f2bf(v2); dst[3 * 2304] = f2bf(v3);
            }
          } else if (mode == EPI_RELU2) {
            bfr* dst = wsp<bfr>(p, OFF_ACT) + (size_t)row * 4096 + col;
            float t0 = fmaxf(v0, 0.f), t1 = fmaxf(v1, 0.f), t2 = fmaxf(v2, 0.f), t3 = fmaxf(v3, 0.f);
            dst[0] = f2bf(t0 * t0); dst[4096] = f2bf(t1 * t1); dst[2 * 4096] = f2bf(t2 * t2); dst[3 * 4096] = f2bf(t3 * t3);
          } else if (mode == EPI_RESID) {
            const int ms = row < RL ? (row >> 13) : 2;
            const float gate = wsp<float>(p, OFF_MOD)[(layer * 3 + ms) * 6144 + gchunk * 1024 + col];
            float* hp = row < RL ? p.out + (size_t)row * 1024 + col : wsp<float>(p, OFF_HC) + (size_t)(row - RL) * 1024 + col;
            if (atom) {
              unsafeAtomicAdd(hp, gate * v0); unsafeAtomicAdd(hp + 1024, gate * v1);
              unsafeAtomicAdd(hp + 2048, gate * v2); unsafeAtomicAdd(hp + 3072, gate * v3);
            } else {
              hp[0] += gate * v0; hp[1024] += gate * v1; hp[2048] += gate * v2; hp[3072] += gate * v3;
            }
          }
        }
  }
}

DI float softplus_f(float x) { return x > 0.f ? x + log1pf(expf(-x)) : log1pf(expf(x)); }

DI void conv_dt_phase(const DP& p, int j) {
  const int tid = p.tidl, lane = tid & 63, wid = tid >> 6;
  const bfr* XBC = wsp<bfr>(p, OFF_XBC);
  bfr* XT = wsp<bfr>(p, OFF_XT); bfr* BN = wsp<bfr>(p, OFF_BN); bfr* BTt = wsp<bfr>(p, OFF_BT); bfr* CN = wsp<bfr>(p, OFF_CN);
  bfr* TT = (bfr*)smem;
  const float* cw = p.conv_w + (size_t)j * 5 * 2560;
  const float* cb = p.conv_b + (size_t)j * 2560;
  const int n_conv = 264 * 40, n_dt = 792;
  for (int u = p.bidl; u < n_conv + n_dt; u += gridDim.x) {
    if (u < n_conv) {
      const int tb = u / 40, cbk = u % 40, row0 = tb * 64, ch0 = cbk * 64;
      int pos0, len;
      if (row0 < RL) { pos0 = row0 & 8191; len = SEQ; } else { pos0 = (row0 - RL) & 255; len = CTX; }
      const int c8 = tid & 7, ch = ch0 + c8 * 8;
      float w[5][8], bias[8];
#pragma unroll
      for (int k = 0; k < 5; ++k) {
        float4 wa = *(const float4*)(cw + k * 2560 + ch), wb = *(const float4*)(cw + k * 2560 + ch + 4);
        w[k][0] = wa.x; w[k][1] = wa.y; w[k][2] = wa.z; w[k][3] = wa.w; w[k][4] = wb.x; w[k][5] = wb.y; w[k][6] = wb.z; w[k][7] = wb.w;
      }
      {
        float4 wa = *(const float4*)(cb + ch), wb = *(const float4*)(cb + ch + 4);
        bias[0] = wa.x; bias[1] = wa.y; bias[2] = wa.z; bias[3] = wa.w; bias[4] = wb.x; bias[5] = wb.y; bias[6] = wb.z; bias[7] = wb.w;
      }
#pragma unroll
      for (int ps = 0; ps < 2; ++ps) {
        const int tl = (tid >> 3) + 32 * ps, pos = pos0 + tl, row = row0 + tl;
        float a[8];
#pragma unroll
        for (int e = 0; e < 8; ++e) a[e] = bias[e];
        bf16x8 xr[5];
#pragma unroll
        for (int k = 0; k < 5; ++k) {
          const int pp = pos + k - 2;
          const bool ok = pp >= 0 && pp < len;
          const bfr* xp = XBC + (size_t)(ok ? row + k - 2 : row) * 2560 + ch;
          xr[k] = *(const bf16x8*)xp;
          if (!ok) { for (int e = 0; e < 8; ++e) xr[k][e] = 0; }
        }
#pragma unroll
        for (int k = 0; k < 5; ++k)
#pragma unroll
          for (int e = 0; e < 8; ++e) a[e] += w[k][e] * bfs(xr[k][e]);
        bf16x8 o;
#pragma unroll
        for (int e = 0; e < 8; ++e) { float s = a[e] / (1.f + __expf(-a[e])); o[e] = (short)f2bf(s); }
        if (ch0 >= 2048) *(bf16x8*)(CN + (size_t)row * 512 + (ch - 2048)) = o;
        else if (ch0 >= 1536) *(bf16x8*)(BN + (size_t)row * 512 + (ch - 1536)) = o;
        if (ch0 < 2048) {
#pragma unroll
          for (int e = 0; e < 8; ++e) TT[(c8 * 8 + e) * 72 + tl] = (bfr)o[e];
        }
      }
      if (ch0 < 2048) {
        __syncthreads();
        const int chl = tid >> 2, tseg = (tid & 3) * 16;
        bfr* dst = (ch0 < 1536 ? XT + (size_t)(ch0 + chl) * R : BTt + (size_t)(ch0 - 1536 + chl) * R) + row0 + tseg;
        *(bf16x8*)dst = *(const bf16x8*)(TT + chl * 72 + tseg);
        *(bf16x8*)(dst + 8) = *(const bf16x8*)(TT + chl * 72 + tseg + 8);
        __syncthreads();
      }
    } else {
      const int item = (u - n_conv) * 4 + wid;
      const int head = item % 24; int rest = item / 24; const int dir = rest & 1; rest >>= 1; const int c = rest % NCH, b = rest / NCH;
      const int row0 = chunk_row0(b, c), col = dir * 24 + head;
      const float bias = p.dt_bias[j * 48 + col];
      const float a = -expf(p.a_log[j * 48 + col]);
      const float* DTRAW = wsp<float>(p, OFF_DTRAW);
      float dt[4], cs[4];
      float run = 0.f;
#pragma unroll
      for (int q = 0; q < 4; ++q) {
        dt[q] = softplus_f(DTRAW[(size_t)(row0 + lane * 4 + q) * 48 + col] + bias);
        run += dt[q] * a; cs[q] = run;
      }
      float x = run;
#pragma unroll
      for (int o = 1; o < 64; o <<= 1) { float t2 = __shfl_up(x, o); if (lane >= o) x += t2; }
      const float excl = x - run;
      const float total = __shfl(x, 63);
      float ac[4];
#pragma unroll
      for (int q = 0; q < 4; ++q) {
        float inc = excl + cs[q];
        ac[q] = dir == 0 ? inc : total - inc + dt[q] * a;
      }
      const size_t base = ((size_t)(((dir * 2 + b) * NCH + c) * 24 + head)) * 256 + lane * 4;
      *(float4*)(wsp<float>(p, OFF_DTV) + base) = make_float4(dt[0], dt[1], dt[2], dt[3]);
      *(float4*)(wsp<float>(p, OFF_ACUM) + base) = make_float4(ac[0], ac[1], ac[2], ac[3]);
    }
  }
}

DI bf16x8 scale8(bf16x8 a, const float* w) {
  return pack8(bfs(a[0]) * w[0], bfs(a[1]) * w[1], bfs(a[2]) * w[2], bfs(a[3]) * w[3],
               bfs(a[4]) * w[4], bfs(a[5]) * w[5], bfs(a[6]) * w[6], bfs(a[7]) * w[7]);
}

DI void s1_item(const DP& p, int item, int lane) {
  const int r = lane & 31, h = lane >> 5;
  const int head = item % 24; int rest = item / 24; const int dir = rest & 1; rest >>= 1; const int c = rest % NCH, b = rest / NCH;
  const int g = head / 6;
  const int row0 = chunk_row0(b, c);
  const size_t dbase = ((size_t)(((dir * 2 + b) * NCH + c) * 24 + head)) * 256;
  const float* dtv = wsp<float>(p, OFF_DTV) + dbase;
  const float* acm = wsp<float>(p, OFF_ACUM) + dbase;
  const float acend = dir == 0 ? acm[255] : acm[0];
  const bfr* XT = wsp<bfr>(p, OFF_XT); const bfr* BTt = wsp<bfr>(p, OFF_BT);
  bfr* HS = wsp<bfr>(p, OFF_HS) + ((size_t)(((dir * 2 + b) * NCH + c) * 24 + head)) * 8192;
#pragma unroll 1
  for (int pt = 0; pt < 2; ++pt) {
    f32x16 acc[4];
#pragma unroll
    for (int n = 0; n < 4; ++n) acc[n] = zero16();
#pragma unroll 4
    for (int kk = 0; kk < 16; ++kk) {
      const int s0 = kk * 16 + 8 * h;
      float4 d0 = *(const float4*)(dtv + s0), d1 = *(const float4*)(dtv + s0 + 4);
      float4 a0 = *(const float4*)(acm + s0), a1 = *(const float4*)(acm + s0 + 4);
      float w[8];
      w[0] = d0.x * __expf(acend - a0.x); w[1] = d0.y * __expf(acend - a0.y); w[2] = d0.z * __expf(acend - a0.z); w[3] = d0.w * __expf(acend - a0.w);
      w[4] = d1.x * __expf(acend - a1.x); w[5] = d1.y * __expf(acend - a1.y); w[6] = d1.z * __expf(acend - a1.z); w[7] = d1.w * __expf(acend - a1.w);
      bf16x8 af = scale8(*(const bf16x8*)(XT + (size_t)(head * 64 + pt * 32 + r) * R + row0 + s0), w);
#pragma unroll
      for (int nt = 0; nt < 4; ++nt) {
        bf16x8 bfv = *(const bf16x8*)(BTt + (size_t)(g * 128 + nt * 32 + r) * R + row0 + s0);
        acc[nt] = MFMA(af, bfv, acc[nt]);
      }
    }
#pragma unroll
    for (int nt = 0; nt < 4; ++nt)
#pragma unroll
      for (int i = 0; i < 16; ++i) HS[(pt * 32 + crow(i, h)) * 128 + nt * 32 + r] = f2bf(acc[nt][i]);
  }
}

DI void s1_block(const DP& p, int item) {
  const int tid = p.tidl, lane = tid & 63, wid = tid >> 6, r = lane & 31, h = lane >> 5;
  const int g = item & 3; const int bc = item >> 2; const int c = bc % NCH, b = bc / NCH;
  const int row0 = chunk_row0(b, c);
  const bfr* XT = wsp<bfr>(p, OFF_XT); const bfr* BTt = wsp<bfr>(p, OFF_BT);
  bfr* BS = (bfr*)smem;
  __syncthreads();
#pragma unroll 4
  for (int i = 0; i < 32; ++i) {
    const int row = wid * 32 + i;
    if (lane < 32)
      __builtin_amdgcn_global_load_lds((const unsigned*)(BTt + (size_t)(g * 128 + row) * R + row0 + lane * 8),
                                       (unsigned*)(BS + row * 264 + lane * 8), 16, 0, 0);
  }
  asm volatile("s_waitcnt vmcnt(0)" ::: "memory");
  __syncthreads();
#pragma unroll 1
  for (int j3 = 0; j3 < 3; ++j3) {
    const int pi = wid * 3 + j3, dir = pi / 6, head = g * 6 + pi % 6;
    const size_t ci = (size_t)(((dir * 2 + b) * NCH + c) * 24 + head);
    const float* dtv = wsp<float>(p, OFF_DTV) + ci * 256;
    const float* acm = wsp<float>(p, OFF_ACUM) + ci * 256;
    const float acend = dir == 0 ? acm[255] : acm[0];
    bfr* HS = wsp<bfr>(p, OFF_HS) + ci * 8192;
#pragma unroll 1
    for (int pt = 0; pt < 2; ++pt) {
      f32x16 acc[4];
#pragma unroll
      for (int n = 0; n < 4; ++n) acc[n] = zero16();
#pragma unroll 4
      for (int kk = 0; kk < 16; ++kk) {
        const int s0 = kk * 16 + 8 * h;
        float4 d0 = *(const float4*)(dtv + s0), d1 = *(const float4*)(dtv + s0 + 4);
        float4 a0 = *(const float4*)(acm + s0), a1 = *(const float4*)(acm + s0 + 4);
        float w[8];
        w[0] = d0.x * __expf(acend - a0.x); w[1] = d0.y * __expf(acend - a0.y); w[2] = d0.z * __expf(acend - a0.z); w[3] = d0.w * __expf(acend - a0.w);
        w[4] = d1.x * __expf(acend - a1.x); w[5] = d1.y * __expf(acend - a1.y); w[6] = d1.z * __expf(acend - a1.z); w[7] = d1.w * __expf(acend - a1.w);
        bf16x8 af = scale8(*(const bf16x8*)(XT + (size_t)(head * 64 + pt * 32 + r) * R + row0 + s0), w);
#pragma unroll
        for (int nt = 0; nt < 4; ++nt) {
          bf16x8 bfv = *(const bf16x8*)(BS + (nt * 32 + r) * 264 + s0);
          acc[nt] = MFMA(af, bfv, acc[nt]);
        }
      }
#pragma unroll
      for (int nt = 0; nt < 4; ++nt)
#pragma unroll
        for (int i = 0; i < 16; ++i) HS[(pt * 32 + crow(i, h)) * 128 + nt * 32 + r] = f2bf(acc[nt][i]);
    }
  }
}

DI void f1_item(const DP& p, int item, int lane) {
  const int r = lane & 31, h = lane >> 5;
  const int l2t = item & 1, m = (item >> 1) & 511, b = item >> 10;
  const bfr* ZRT = wsp<bfr>(p, OFF_ZRT) + (size_t)m * R + b * SEQ + l2t * 32 + r;
  const bfr* ZIT = wsp<bfr>(p, OFF_ZIT) + (size_t)m * R + b * SEQ + l2t * 32 + r;
  const bfr* C128 = wsp<bfr>(p, OFF_C128); const bfr* S128 = wsp<bfr>(p, OFF_S128);
  const float2* TW = wsp<float2>(p, OFF_TW);
  bfr* YR = wsp<bfr>(p, OFF_YR); bfr* YI = wsp<bfr>(p, OFF_YI);
  const int l2 = l2t * 32 + r;
#pragma unroll 1
  for (int mh = 0; mh < 2; ++mh) {
    f32x16 yr[2], yi[2];
#pragma unroll
    for (int i = 0; i < 2; ++i) { yr[i] = zero16(); yi[i] = zero16(); }
#pragma unroll 2
    for (int kk = 0; kk < 8; ++kk) {
      bf16x8 zr, zi, nzr;
#pragma unroll
      for (int jj = 0; jj < 8; ++jj) {
        int l1 = kk * 16 + 8 * h + jj;
        zr[jj] = (short)ZRT[l1 * 64]; zi[jj] = (short)ZIT[l1 * 64];
        nzr[jj] = (short)(zr[jj] ^ (short)0x8000);
      }
#pragma unroll
      for (int m2 = 0; m2 < 2; ++m2) {
        const int mt = mh * 2 + m2;
        bf16x8 ca = *(const bf16x8*)(C128 + (mt * 32 + r) * 128 + kk * 16 + 8 * h);
        bf16x8 sa = *(const bf16x8*)(S128 + (mt * 32 + r) * 128 + kk * 16 + 8 * h);
        yr[m2] = MFMA(ca, zr, yr[m2]); yr[m2] = MFMA(sa, zi, yr[m2]);
        yi[m2] = MFMA(ca, zi, yi[m2]); yi[m2] = MFMA(sa, nzr, yi[m2]);
      }
    }
#pragma unroll
    for (int m2 = 0; m2 < 2; ++m2)
#pragma unroll
      for (int i = 0; i < 16; ++i) {
        int k1 = (mh * 2 + m2) * 32 + crow(i, h);
        float2 t = TW[k1 * l2];
        float a = yr[m2][i], bb = yi[m2][i];
        size_t o = ((size_t)(b * 512 + m) * 128 + k1) * 64 + l2;
        YR[o] = f2bf(a * t.x + bb * t.y);
        YI[o] = f2bf(bb * t.x - a * t.y);
      }
  }
}

DI void f1c_item(const DP& p, int item, int lane) {
  const int r = lane & 31, h = lane >> 5;
  const int mt = item & 15, kt = (item >> 4) & 7, b = item >> 7;
  const int m = mt * 32 + r;
  const bfr* ZRT = wsp<bfr>(p, OFF_ZRT) + (size_t)m * R + RL + b * CTX;
  const bfr* ZIT = wsp<bfr>(p, OFF_ZIT) + (size_t)m * R + RL + b * CTX;
  const bfr* C256 = wsp<bfr>(p, OFF_C256) + (kt * 32 + r) * 256;
  const bfr* S256 = wsp<bfr>(p, OFF_S256) + (kt * 32 + r) * 256;
  f32x16 acc = zero16();
#pragma unroll 4
  for (int kk = 0; kk < 16; ++kk) {
    int o = kk * 16 + 8 * h;
    acc = MFMA(*(const bf16x8*)(C256 + o), *(const bf16x8*)(ZRT + o), acc);
    acc = MFMA(*(const bf16x8*)(S256 + o), *(const bf16x8*)(ZIT + o), acc);
  }
  bfr* MIX = wsp<bfr>(p, OFF_MIX);
#pragma unroll
  for (int i = 0; i < 16; ++i)
    MIX[(size_t)(RL + b * CTX + kt * 32 + crow(i, h)) * 2048 + m] = f2bf(acc[i] * (1.f / 128.f));
}

DI void s1f1_phase(const DP& p) {
  const int nS1 = 2 * NCH * 4;
  const int G = (int)gridDim.x;
  if (G > nS1 + 64) {
    if (p.bidl < nS1) { s1_block(p, p.bidl); return; }
    const int lane = p.tidl & 63;
    const int wg = (p.bidl - nS1) * 4 + (p.tidl >> 6), nw = (G - nS1) * 4;
#pragma unroll 1
    for (int it = wg; it < 2048 + 256; it += nw) {
      if (it < 2048) f1_item(p, it, lane); else f1c_item(p, it - 2048, lane);
    }
  } else {
#pragma unroll 1
    for (int it = p.bidl; it < nS1; it += G) s1_block(p, it);
    const int lane = p.tidl & 63;
    const int wg = p.bidl * 4 + (p.tidl >> 6), nw = G * 4;
#pragma unroll 1
    for (int it = wg; it < 2048 + 256; it += nw) {
      if (it < 2048) f1_item(p, it, lane); else f1c_item(p, it - 2048, lane);
    }
  }
}

DI void f2_item(const DP& p, int item, int lane) {
  const int r = lane & 31, h = lane >> 5;
  const int mt16 = item & 15, k1 = (item >> 4) & 127, b = item >> 11;
  const int m = mt16 * 32 + r;
  const bfr* YR = wsp<bfr>(p, OFF_YR) + ((size_t)(b * 512 + m) * 128 + k1) * 64;
  const bfr* YI = wsp<bfr>(p, OFF_YI) + ((size_t)(b * 512 + m) * 128 + k1) * 64;
  const bfr* C64 = wsp<bfr>(p, OFF_C64); const bfr* S64 = wsp<bfr>(p, OFF_S64);
  f32x16 acc[2]; acc[0] = zero16(); acc[1] = zero16();
#pragma unroll
  for (int kk = 0; kk < 4; ++kk) {
    bf16x8 yr = *(const bf16x8*)(YR + kk * 16 + 8 * h), yi = *(const bf16x8*)(YI + kk * 16 + 8 * h);
#pragma unroll
    for (int t = 0; t < 2; ++t) {
      bf16x8 ca = *(const bf16x8*)(C64 + (t * 32 + r) * 64 + kk * 16 + 8 * h);
      bf16x8 sa = *(const bf16x8*)(S64 + (t * 32 + r) * 64 + kk * 16 + 8 * h);
      acc[t] = MFMA(ca, yr, acc[t]); acc[t] = MFMA(sa, yi, acc[t]);
    }
  }
  bfr* MIX = wsp<bfr>(p, OFF_MIX);
  const float scale = 0.001381067932f;
#pragma unroll
  for (int t = 0; t < 2; ++t)
#pragma unroll
    for (int i = 0; i < 16; ++i) {
      int k2 = t * 32 + crow(i, h);
      MIX[(size_t)(b * SEQ + k1 + 128 * k2) * 2048 + m] = f2bf(acc[t][i] * scale);
    }
}

DI void s3_block(const DP& p, int j, int b, int c, int g, int half);

DI void s2f2_phase(const DP& p, int j) {
  if (p.bidl < 16) {
    const int k = p.bidl;
    s3_block(p, j, k >> 3, 0, (k >> 1) & 3, k & 1);
    return;
  }
  const int gt = (p.bidl - 16) * 256 + p.tidl, nt = ((int)gridDim.x - 16) * 256;
  bfr* HSb = wsp<bfr>(p, OFF_HS);
  const float* ACUM = wsp<float>(p, OFF_ACUM);
#pragma unroll 1
  for (int it = gt; it < 2 * 2 * 24 * 2048; it += nt) {
    const int e4 = it & 2047; const int rest = it >> 11; const int head = rest % 24, db = rest / 24, dir = db >> 1;
    bf16x4 sv[NCH]; float cd[NCH];
#pragma unroll
    for (int step = 0; step < NCH; ++step) {
      const int c = dir == 0 ? step : (step == 0 ? 0 : NCH - step);
      const size_t ci = (size_t)((db * NCH + c) * 24 + head);
      sv[step] = *(const bf16x4*)(HSb + ci * 8192 + e4 * 4);
      cd[step] = ACUM[ci * 256 + (dir == 0 ? 255 : 0)];
    }
    float h0 = 0.f, h1 = 0.f, h2 = 0.f, h3 = 0.f;
#pragma unroll
    for (int step = 0; step < NCH; ++step) {
      const int c = dir == 0 ? step : (step == 0 ? 0 : NCH - step);
      const size_t ci = (size_t)((db * NCH + c) * 24 + head);
      *(bf16x4*)(HSb + ci * 8192 + e4 * 4) = pack4(h0, h1, h2, h3);
      const float e = __expf(cd[step]);
      h0 = h0 * e + bfs(sv[step][0]); h1 = h1 * e + bfs(sv[step][1]); h2 = h2 * e + bfs(sv[step][2]); h3 = h3 * e + bfs(sv[step][3]);
    }
  }
  const int lane = p.tidl & 63;
  const int wg = (p.bidl - 16) * 4 + (p.tidl >> 6), nw = ((int)gridDim.x - 16) * 4;
#pragma unroll 1
  for (int it = wg; it < 4096; it += nw) f2_item(p, it, lane);
}

DI void s3_block(const DP& p, int j, int b, int c, int g, int half) {
  const int tid = p.tidl, lane = tid & 63, wid = tid >> 6, r = lane & 31, h = lane >> 5;
  const bfr* CN = wsp<bfr>(p, OFF_CN); const bfr* BN = wsp<bfr>(p, OFF_BN); const bfr* XT = wsp<bfr>(p, OFF_XT);
  const bfr* Z = wsp<bfr>(p, OFF_Z); bfr* MIX = wsp<bfr>(p, OFF_MIX);
  bfr* XTs = (bfr*)smem;
  bfr* HSF = (bfr*)(smem + 33792);
  bfr* HSB = (bfr*)(smem + 51200);
  float* LWF = (float*)(smem + 68608);
  float* LWB = LWF + 256;
  {
    const int row0 = chunk_row0(b, c);
    const int lt = half * 4 + wid;
    const int rowl = row0 + lt * 32 + r;
    const bfr* cfp = CN + (size_t)rowl * 512 + g * 128 + 8 * h;
    bf16x8 gtp[8][2];
    {
      bf16x8 cf[8];
#pragma unroll
      for (int kk = 0; kk < 8; ++kk) cf[kk] = *(const bf16x8*)(cfp + kk * 16);
#pragma unroll
      for (int k = 0; k < 8; ++k) { gtp[k][0] = cf[0]; gtp[k][1] = cf[0]; }
      __syncthreads();
      {
        bfr* BS = (bfr*)smem;
#pragma unroll 4
        for (int i = 0; i < 64; ++i) {
          const int row = wid * 64 + i;
          if (lane < 16)
            __builtin_amdgcn_global_load_lds((const unsigned*)(BN + (size_t)(row0 + row) * 512 + g * 128 + lane * 8),
                                             (unsigned*)(BS + row * 136 + lane * 8), 16, 0, 0);
        }
      }
      asm volatile("s_waitcnt vmcnt(0)" ::: "memory");
      __syncthreads();
#pragma unroll 1
      for (int st = 0; st < 8; ++st) {
        f32x16 gt = zero16();
#pragma unroll
        for (int kk = 0; kk < 8; ++kk)
          gt = MFMA(*(const bf16x8*)((const bfr*)smem + (st * 32 + r) * 136 + kk * 16 + 8 * h), cf[kk], gt);
#pragma unroll
        for (int k = 0; k < 7; ++k) { gtp[k][0] = gtp[k + 1][0]; gtp[k][1] = gtp[k + 1][1]; }
        gtp[7][0] = PACK_HALF(gt, 0); gtp[7][1] = PACK_HALF(gt, 1);
      }
    }
    float sumsq = 0.f;
#pragma unroll 1
    for (int hh = 0; hh < 6; ++hh) {
      const int head = g * 6 + hh;
      const size_t cif = (size_t)(((0 * 2 + b) * NCH + c) * 24 + head), cib = (size_t)(((1 * 2 + b) * NCH + c) * 24 + head);
      const float* acf = wsp<float>(p, OFF_ACUM) + cif * 256; const float* acb = wsp<float>(p, OFF_ACUM) + cib * 256;
      const float* dtf = wsp<float>(p, OFF_DTV) + cif * 256; const float* dtb = wsp<float>(p, OFF_DTV) + cib * 256;
      const bfr* HSf = wsp<bfr>(p, OFF_HS) + cif * 8192; const bfr* HSbk = wsp<bfr>(p, OFF_HS) + cib * 8192;
      __syncthreads();
#pragma unroll 4
      for (int i = 0; i < 16; ++i) {
        const int row = wid * 16 + i;
        if (lane < 32)
          __builtin_amdgcn_global_load_lds((const unsigned*)(XT + (size_t)(head * 64 + row) * R + row0 + lane * 8),
                                           (unsigned*)(XTs + row * 264 + lane * 8), 16, 0, 0);
      }
      if (c != 0) {
#pragma unroll 4
        for (int i = 0; i < 16; ++i) {
          const int row = wid * 16 + i;
          if (lane < 16) {
            __builtin_amdgcn_global_load_lds((const unsigned*)(HSf + row * 128 + lane * 8), (unsigned*)(HSF + row * 136 + lane * 8), 16, 0, 0);
            __builtin_amdgcn_global_load_lds((const unsigned*)(HSbk + row * 128 + lane * 8), (unsigned*)(HSB + row * 136 + lane * 8), 16, 0, 0);
          }
        }
      }
      bf16x8 cfh[8];
#pragma unroll
      for (int kk = 0; kk < 8; ++kk) cfh[kk] = *(const bf16x8*)(cfp + kk * 16);
      LWF[tid] = __logf(dtf[tid]) - acf[tid];
      LWB[tid] = __logf(dtb[tid]) - acb[tid];
      const float al_f = acf[lt * 32 + r], al_b = acb[lt * 32 + r];
      asm volatile("s_waitcnt vmcnt(0)" ::: "memory");
      __syncthreads();
      f32x16 acc[2];
      acc[0] = zero16(); acc[1] = zero16();
      if (c != 0) {
        f32x16 t0 = zero16(), t1 = zero16();
#pragma unroll
        for (int kk = 0; kk < 8; ++kk) {
          t0 = MFMA(*(const bf16x8*)(HSF + (r) * 136 + kk * 16 + 8 * h), cfh[kk], t0);
          t1 = MFMA(*(const bf16x8*)(HSF + (32 + r) * 136 + kk * 16 + 8 * h), cfh[kk], t1);
        }
        const float ef = __expf(al_f);
#pragma unroll
        for (int i = 0; i < 16; ++i) { acc[0][i] = t0[i] * ef; acc[1][i] = t1[i] * ef; }
        t0 = zero16(); t1 = zero16();
#pragma unroll
        for (int kk = 0; kk < 8; ++kk) {
          t0 = MFMA(*(const bf16x8*)(HSB + (r) * 136 + kk * 16 + 8 * h), cfh[kk], t0);
          t1 = MFMA(*(const bf16x8*)(HSB + (32 + r) * 136 + kk * 16 + 8 * h), cfh[kk], t1);
        }
        const float eb = __expf(al_b);
#pragma unroll
        for (int i = 0; i < 16; ++i) { acc[0][i] += t0[i] * eb; acc[1][i] += t1[i] * eb; }
      }
      bf16x4 zpre[2][4];
#pragma unroll
      for (int pt = 0; pt < 2; ++pt)
#pragma unroll
        for (int g4 = 0; g4 < 4; ++g4) zpre[pt][g4] = *(const bf16x4*)(Z + (size_t)rowl * 1536 + head * 64 + pt * 32 + 8 * g4 + 4 * h);
#pragma unroll 1
      for (int st = 0; st < 8; ++st) {
        const bf16x8 g0 = gtp[0][0], g1 = gtp[0][1];
#pragma unroll
        for (int k = 0; k < 7; ++k) { gtp[k][0] = gtp[k + 1][0]; gtp[k][1] = gtp[k + 1][1]; }
        gtp[7][0] = g0; gtp[7][1] = g1;
#pragma unroll 1
        for (int dir = 0; dir < 2; ++dir) {
          if (dir == 0 ? (st > lt) : (st < lt)) continue;
          const float* lwd = dir == 0 ? LWF : LWB;
          const float al = dir == 0 ? al_f : al_b;
          f32x16 mm;
#pragma unroll
          for (int g4 = 0; g4 < 4; ++g4) {
            const int sb = st * 32 + 8 * g4 + 4 * h;
            const float4 l4 = *(const float4*)(lwd + sb);
            const float lv[4] = {l4.x, l4.y, l4.z, l4.w};
#pragma unroll
            for (int q = 0; q < 4; ++q) {
              const int i = 4 * g4 + q;
              const int sidx = sb + q, lidx = lt * 32 + r;
              const bool valid = dir == 0 ? (sidx <= lidx) : (sidx >= lidx);
              const float gv = bfs((i >> 3) ? g1[i & 7] : g0[i & 7]);
              const float e = __expf(fminf(al + lv[q], 30.f));
              mm[i] = valid ? gv * e : 0.f;
            }
          }
#pragma unroll
          for (int s2 = 0; s2 < 2; ++s2) {
            bf16x8 pf = PACK_HALF(mm, s2);
#pragma unroll
            for (int pt = 0; pt < 2; ++pt) {
              const bfr* xp = XTs + (pt * 32 + r) * 264 + st * 32 + 16 * s2 + 4 * h;
              bf16x8 xf = join44(*(const bf16x4*)xp, *(const bf16x4*)(xp + 8));
              acc[pt] = MFMA(xf, pf, acc[pt]);
            }
          }
        }
      }
      const float dsk = p.d_skip[j * 24 + head];
#pragma unroll
      for (int pt = 0; pt < 2; ++pt)
#pragma unroll
        for (int g4 = 0; g4 < 4; ++g4) {
          const int pb = pt * 32 + 8 * g4 + 4 * h;
          bf16x4 zv = zpre[pt][g4];
          float y[4];
#pragma unroll
          for (int q = 0; q < 4; ++q) {
            float xv = bf2f(XTs[(pb + q) * 264 + lt * 32 + r]);
            float zz = bfs(zv[q]);
            float v = (acc[pt][4 * g4 + q] + dsk * xv) * (zz / (1.f + __expf(-zz)));
            sumsq += v * v; y[q] = v;
          }
          *(bf16x4*)(MIX + (size_t)rowl * 2048 + 512 + head * 64 + pb) = pack4(y[0], y[1], y[2], y[3]);
        }
    }
    const float tot = sumsq + __shfl_xor(sumsq, 32);
    const float sc = rsqrtf(tot * (1.f / 384.f) + 1e-6f);
    const float* ng = p.ssd_norm_g + (size_t)j * 1536;
    bf16x4 yv[6][2][4];
#pragma unroll
    for (int hh = 0; hh < 6; ++hh)
#pragma unroll
      for (int pt = 0; pt < 2; ++pt)
#pragma unroll
        for (int g4 = 0; g4 < 4; ++g4)
          yv[hh][pt][g4] = *(const bf16x4*)(MIX + (size_t)rowl * 2048 + 512 + (g * 6 + hh) * 64 + pt * 32 + 8 * g4 + 4 * h);
#pragma unroll
    for (int hh = 0; hh < 6; ++hh)
#pragma unroll
      for (int pt = 0; pt < 2; ++pt)
#pragma unroll
        for (int g4 = 0; g4 < 4; ++g4) {
          const int pb = pt * 32 + 8 * g4 + 4 * h, head = g * 6 + hh;
          const float4 gg = *(const float4*)(ng + head * 64 + pb);
          const bf16x4 y4 = yv[hh][pt][g4];
          *(bf16x4*)(MIX + (size_t)rowl * 2048 + 512 + head * 64 + pb) =
              pack4(bfs(y4[0]) * sc * gg.x, bfs(y4[1]) * sc * gg.y, bfs(y4[2]) * sc * gg.z, bfs(y4[3]) * sc * gg.w);
        }
  }
}

DI void s3_phase(const DP& p, int j) {
#pragma unroll 1
  for (int idx = p.bidl; idx < 512; idx += (int)gridDim.x) {
    const int half = idx & 1, g = (idx >> 1) & 3, bcl = idx >> 3;
    s3_block(p, j, bcl >> 5, 1 + (bcl & 31), g, half);
  }
}

DI void qkprep_phase(const DP& p, int j) {
  const int lane = p.tidl & 63;
  const int wg = p.bidl * 4 + (p.tidl >> 6), nw = gridDim.x * 4;
  const bfr* P = wsp<bfr>(p, OFF_P); bfr* QK = wsp<bfr>(p, OFF_QK);
  const float* ROPE = wsp<float>(p, OFF_ROPE);
  const int sub = lane >> 3, d0 = (lane & 7) * 8;
  for (int row = wg; row < R; row += nw) {
    bf16x8 xin[4];
#pragma unroll
    for (int ps = 0; ps < 4; ++ps) {
      const int hs0 = ps * 8 + sub, hsc0 = hs0 < 26 ? hs0 : 25;
      xin[ps] = *(const bf16x8*)(P + (size_t)row * 2304 + (hsc0 < 10 ? hsc0 * 64 : 768 + (hsc0 - 10) * 64) + d0);
    }
#pragma unroll
    for (int ps = 0; ps < 4; ++ps) {
      const int hs = ps * 8 + sub;
      const bool act = hs < 26;
      const int hsc = act ? hs : 25;
      bf16x8 xv = xin[ps];
      float x[8]; float ss = 0.f;
#pragma unroll
      for (int e = 0; e < 8; ++e) { x[e] = bfs(xv[e]); ss += x[e] * x[e]; }
      ss += __shfl_xor(ss, 1); ss += __shfl_xor(ss, 2); ss += __shfl_xor(ss, 4);
      const float rs = rsqrtf(ss * (1.f / 64.f) + 1e-6f);
      const float* gv = hsc < 8 ? p.q_norm_win + j * 64 : hsc < 10 ? p.k_norm_win + j * 64 : hsc < 18 ? p.q_norm_na + j * 64 : p.k_norm_na + j * 64;
#pragma unroll
      for (int e = 0; e < 8; ++e) x[e] = x[e] * rs * gv[d0 + e];
      float pr[8];
#pragma unroll
      for (int e = 0; e < 8; ++e) pr[e] = __shfl_xor(x[e], 2);
      if (hsc < 10 && row < RL) {
        const int pos = row & 8191;
        const int axis = d0 >> 5;
        const int idx = axis == 0 ? (pos >> 6) : (pos & 63);
        const int f0 = d0 & 15;
        const bool second = (d0 & 16) != 0;
        const float* cp = ROPE + (axis * 128 + idx) * 16 + f0;
        const float* sp = cp + 4096;
#pragma unroll
        for (int e = 0; e < 8; ++e) {
          float cs = cp[e], sn = sp[e];
          x[e] = second ? (x[e] * cs + pr[e] * sn) : (x[e] * cs - pr[e] * sn);
        }
      }
      const bool isq = hsc < 8 || (hsc >= 10 && hsc < 18);
      const float qs = isq ? 0.125f : 1.f;
      if (act) *(bf16x8*)(QK + (size_t)row * 1664 + hsc * 64 + d0) = pack8(x[0] * qs, x[1] * qs, x[2] * qs, x[3] * qs, x[4] * qs, x[5] * qs, x[6] * qs, x[7] * qs);
    }
  }
}

struct KVF { bf16x8 k[4]; bf16x8 v[2][2]; };
struct KVS { bf16x8 k[4]; bf16x8 v[4]; };

DI void kv_gload(KVS& g, const bfr* __restrict__ Kt, const bfr* __restrict__ Vt, int lane) {
#pragma unroll
  for (int i = 0; i < 4; ++i) {
    const int idx = lane + 64 * i;
    g.k[i] = *(const bf16x8*)(Kt + (size_t)(idx >> 3) * 1664 + (idx & 7) * 8);
    g.v[i] = *(const bf16x8*)(Vt + (size_t)(idx >> 2) * R + (idx & 3) * 8);
  }
}
DI void kv_sstore(const KVS& g, unsigned char* base, int lane) {
#pragma unroll
  for (int i = 0; i < 4; ++i) {
    const int idx = lane + 64 * i;
    { const int row = idx >> 3, c = idx & 7; *(bf16x8*)(base + row * 128 + ((c ^ (row & 7)) << 4)) = g.k[i]; }
    {
      const int d = idx >> 2, c16 = idx & 3, sw = (d >> 2) & 7;
      bf16x4 lo = __builtin_shufflevector(g.v[i], g.v[i], 0, 1, 2, 3), hi = __builtin_shufflevector(g.v[i], g.v[i], 4, 5, 6, 7);
      *(bf16x4*)(base + 4096 + d * 64 + (((2 * c16) ^ sw) << 3)) = lo;
      *(bf16x4*)(base + 4096 + d * 64 + (((2 * c16 + 1) ^ sw) << 3)) = hi;
    }
  }
}
DI void kv_sload(KVF& f, const unsigned char* base, int r, int h) {
#pragma unroll
  for (int kk = 0; kk < 4; ++kk) f.k[kk] = *(const bf16x8*)(base + r * 128 + (((2 * kk + h) ^ (r & 7)) << 4));
#pragma unroll
  for (int s2 = 0; s2 < 2; ++s2)
#pragma unroll
    for (int dt = 0; dt < 2; ++dt) {
      const int d = dt * 32 + r, sw = (d >> 2) & 7, c8 = 4 * s2 + h;
      const unsigned char* vb = base + 4096 + d * 64;
      f.v[s2][dt] = join44(*(const bf16x4*)(vb + ((c8 ^ sw) << 3)), *(const bf16x4*)(vb + (((c8 + 2) ^ sw) << 3)));
    }
}

DI void attn_compute(f32x16 (&o)[2], float& m, float& l, const unsigned char* qb, const unsigned char* base, int r, int h,
                     int mode, int a0, int a1, const float* __restrict__ rp) {
  f32x16 s = zero16();
#pragma unroll
  for (int kk = 0; kk < 4; ++kk) {
    const int off = r * 128 + (((2 * kk + h) ^ (r & 7)) << 4);
    s = MFMA(*(const bf16x8*)(base + off), *(const bf16x8*)(qb + off), s);
  }
  float tmax = -3.0e38f;
  if (mode == 1) {
#pragma unroll
    for (int i = 0; i < 16; ++i) { int dd = a0 - crow(i, h); dd = dd < 0 ? -dd : dd; s[i] = dd <= 128 ? s[i] : -1.0e30f; }
  } else if (mode == 2) {
#pragma unroll
    for (int i = 0; i < 16; ++i) {
      const int key = crow(i, h);
      const int rel = a0 + key;
      int co = a1 + key; co = co < 0 ? 0 : (co > 30 ? 30 : co);
      s[i] = (rel >= 0 && rel < 16) ? s[i] + rp[co] : -1.0e30f;
    }
  }
#pragma unroll
  for (int i = 0; i < 16; ++i) tmax = fmaxf(tmax, s[i]);
  tmax = fmaxf(tmax, __shfl_xor(tmax, 32));
  const float mn = fmaxf(m, tmax);
  const float alpha = __expf(m - mn);
  float ps = 0.f;
#pragma unroll
  for (int i = 0; i < 16; ++i) { s[i] = __expf(s[i] - mn); ps += s[i]; }
  l = l * alpha + ps; m = mn;
#pragma unroll
  for (int i = 0; i < 16; ++i) { o[0][i] *= alpha; o[1][i] *= alpha; }
#pragma unroll
  for (int s2 = 0; s2 < 2; ++s2) {
    bf16x8 pf = PACK_HALF(s, s2);
#pragma unroll
    for (int dt = 0; dt < 2; ++dt) {
      const int d = dt * 32 + r, sw = (d >> 2) & 7, c8 = 4 * s2 + h;
      const unsigned char* vb = base + 4096 + d * 64;
      bf16x8 vf = join44(*(const bf16x4*)(vb + ((c8 ^ sw) << 3)), *(const bf16x4*)(vb + (((c8 + 2) ^ sw) << 3)));
      o[dt] = MFMA(vf, pf, o[dt]);
    }
  }
}

DI void attn_item(const DP& p, int j, int item, int lane) {
  const int r = lane & 31, h = lane >> 5;
  const bfr* QK = wsp<bfr>(p, OFF_QK); const bfr* VT = wsp<bfr>(p, OFF_VT); bfr* MIX = wsp<bfr>(p, OFF_MIX);
  int kind, b, hd, qt;
  if (item < 4096) { kind = 0; qt = item & 255; hd = (item >> 8) & 7; b = item >> 11; }
  else if (item < 8192) { int v = item - 4096; kind = 1; qt = v & 255; hd = (v >> 8) & 7; b = v >> 11; }
  else if (item < 8320) { int v = item - 8192; kind = 2; qt = v & 7; hd = (v >> 3) & 7; b = v >> 6; }
  else { int v = item - 8320; kind = 3; qt = v & 7; hd = (v >> 3) & 7; b = v >> 6; }
  const bool win = (kind == 0 || kind == 2);
  const bool lat = kind < 2;
  const int q_row0 = lat ? b * SEQ + qt * 32 : RL + b * CTX + qt * 32;
  const int qcol = win ? hd * 64 : (10 + hd) * 64;
  const int kcol = win ? (8 + (hd >> 2)) * 64 : (18 + hd) * 64;
  const bfr* Vb = win ? VT + (size_t)((hd >> 2) * 64) * R : VT + (size_t)(128 + hd * 64) * R;
  const bfr* Kb = QK + kcol;
  f32x16 o[2]; o[0] = zero16(); o[1] = zero16();
  float m = -1.0e30f, l = 0.f;
  if (win) { m = p.sink_win[j * 8 + hd]; l = h == 0 ? 1.f : 0.f; }
  int nloc = 0, lo = 0, gr = 0, kr0 = 0, w = 0, cs = 0;
  const int qpos = qt * 32 + r;
  if (kind == 0) { lo = qt - 4 < 0 ? 0 : qt - 4; const int hi = qt + 4 > 255 ? 255 : qt + 4; nloc = hi - lo + 1; }
  else if (kind == 1) {
    gr = qt >> 1; w = (qt & 1) * 32 + r;
    cs = w - 8; cs = cs < 0 ? 0 : (cs > 48 ? 48 : cs);
    kr0 = gr - 4; kr0 = kr0 < 0 ? 0 : (kr0 > 120 ? 120 : kr0);
    nloc = 16;
  }
  const int ntile = 8 + nloc;
  const float* rpb = p.rpb_na + (size_t)j * 8 * 15 * 31 + hd * 15 * 31;
  auto tile_row = [&](int i) -> int {
    if (i < 8) return RL + b * CTX + i * 32;
    const int li = i - 8;
    if (kind == 0) return b * SEQ + (lo + li) * 32;
    return b * SEQ + (kr0 + (li >> 1)) * 64 + (li & 1) * 32;
  };
  unsigned char* lbase = smem + (p.tidl >> 6) * 12288;
  asm volatile("" ::: "memory");
#pragma unroll
  for (int i = 0; i < 4; ++i) {
    const int idx = lane + 64 * i, row = idx >> 3, c = idx & 7;
    *(bf16x8*)(lbase + 8192 + row * 128 + ((c ^ (row & 7)) << 4)) = *(const bf16x8*)(QK + (size_t)(q_row0 + row) * 1664 + qcol + c * 8);
  }
  KVS g;
  { const int k0 = tile_row(0); kv_gload(g, Kb + (size_t)k0 * 1664, Vb + k0, lane); }
  kv_sstore(g, lbase, lane);
#pragma unroll 1
  for (int i = 0; i < ntile; ++i) {
    { const int in = i + 1 < ntile ? i + 1 : i; const int k0 = tile_row(in); kv_gload(g, Kb + (size_t)k0 * 1664, Vb + k0, lane); }
    int mode = 0, a0 = 0, a1 = 0; const float* rp = rpb;
    if (i >= 8) {
      const int li = i - 8;
      if (kind == 0) { mode = 1; a0 = qpos - (lo + li) * 32; }
      else { mode = 2; const int krow = kr0 + (li >> 1); const int ub = (li & 1) * 32; a0 = ub - cs; a1 = ub - w + 15; rp = rpb + (krow - gr + 7) * 31; }
    }
    asm volatile("" ::: "memory");
    attn_compute(o, m, l, lbase + 8192, lbase, r, h, mode, a0, a1, rp);
    asm volatile("" ::: "memory");
    kv_sstore(g, lbase, lane);
  }
  asm volatile("" ::: "memory");
  const float lt = l + __shfl_xor(l, 32);
  const float inv = 1.f / lt;
  const int ocol = win ? hd * 64 : 512 + hd * 64;
#pragma unroll
  for (int dt = 0; dt < 2; ++dt)
#pragma unroll
    for (int g4 = 0; g4 < 4; ++g4) {
      const int d = dt * 32 + 8 * g4 + 4 * h;
      *(bf16x4*)(MIX + (size_t)(q_row0 + r) * 1024 + ocol + d) =
          pack4(o[dt][4 * g4] * inv, o[dt][4 * g4 + 1] * inv, o[dt][4 * g4 + 2] * inv, o[dt][4 * g4 + 3] * inv);
    }
}

DI void attn_phase(const DP& p, int j) {
  const int lane = p.tidl & 63;
  const int wg = p.bidl * 4 + (p.tidl >> 6), nw = gridDim.x * 4;
#pragma unroll 1
  for (int it = wg; it < 8448; it += nw) attn_item(p, j, it, lane);
}

#define XB_TMO      128
#define XB_XCNT(j)  (256  + 64 * (j))
#define XB_XSUB(j)  (1280 + 64 * (j))
#define XB_XGEN(j)  (2304 + 64 * (j))
#define XB_TOP      3328
#define XB_TOPGEN   3392
#define XCD_BAR_WORDS 3456
#define XB_SPIN_CAP (1u << 18)
#define LAS __attribute__((address_space(3)))

__device__ __forceinline__ unsigned xb_ld(unsigned* p)              { return __hip_atomic_load(p, __ATOMIC_RELAXED, __HIP_MEMORY_SCOPE_AGENT); }
__device__ __forceinline__ unsigned xb_add(unsigned* p, unsigned v) { return __hip_atomic_fetch_add(p, v, __ATOMIC_RELAXED, __HIP_MEMORY_SCOPE_AGENT); }
__device__ __forceinline__ unsigned xb_xcc_id() { return (unsigned)__builtin_amdgcn_s_getreg((3 << 11) | 20) & 0xFu; }
#define XB_SPIN(cond, bar) do { unsigned _sp = 0; while (cond) { __builtin_amdgcn_s_sleep(1); \
    if ((++_sp & 255u) == 0u) { if (xb_ld(&(bar)[XB_TMO])) break; if (_sp > XB_SPIN_CAP) { atomicAdd(&(bar)[XB_TMO], 1u); break; } } } } while (0)

struct XcdBarrier {
    unsigned* bar; unsigned x;
    volatile LAS unsigned* st;
};

__device__ __forceinline__ XcdBarrier xcd_barrier_post(unsigned* bar, volatile LAS unsigned* st) {
    XcdBarrier b; b.bar = bar; b.x = xb_xcc_id(); b.st = st;
    if (threadIdx.x == 0) (void)xb_add(&bar[XB_XCNT(b.x)], 1u);
    return b;
}
__device__ __forceinline__ void xcd_barrier_complete(unsigned* bar, unsigned x, unsigned& nloc, unsigned& nx) {
    const unsigned G = gridDim.x * gridDim.y * gridDim.z;
    unsigned sum, cnt, mine, sp = 0u;
    for (;;) {
        sum = 0u; cnt = 0u; mine = 0u;
#pragma unroll
        for (unsigned j = 0; j < 16; ++j) { const unsigned c = xb_ld(&bar[XB_XCNT(j)]); sum += c; cnt += (c > 0u) ? 1u : 0u; mine = (j == x) ? c : mine; }
        if (sum == G) break;
        __builtin_amdgcn_s_sleep(1);
        if ((++sp & 255u) == 0u) { if (xb_ld(&bar[XB_TMO])) break; if (sp > XB_SPIN_CAP) { atomicAdd(&bar[XB_TMO], 1u); break; } }
    }
    nloc = mine > 0u ? mine : 1u; nx = cnt > 0u ? cnt : 1u;
}

__device__ __forceinline__ void xcd_barrier(const XcdBarrier& b) {
    asm volatile("s_waitcnt vmcnt(0)" ::: "memory");
    __syncthreads();
    if (threadIdx.x == 0) {
        unsigned* bar = b.bar;
        __builtin_amdgcn_s_waitcnt(0);
        unsigned nloc = b.st[0], nx = b.st[1];
        if (nloc == 0u) { xcd_barrier_complete(bar, b.x, nloc, nx); b.st[0] = nloc; b.st[1] = nx; }
        const unsigned old = xb_add(&bar[XB_XSUB(b.x)], 1u);
        const unsigned gen = old / nloc;
        if (old + 1u == (gen + 1u) * nloc) {
            __builtin_amdgcn_fence(__ATOMIC_RELEASE, "agent");
            asm volatile("s_waitcnt vmcnt(0)" ::: "memory");
            const unsigned og = xb_add(&bar[XB_TOP], 1u);
            const unsigned tg = og / nx;
            if (og + 1u == (tg + 1u) * nx) xb_add(&bar[XB_TOPGEN], 1u);
            else XB_SPIN(xb_ld(&bar[XB_TOPGEN]) == tg, bar);
            __builtin_amdgcn_fence(__ATOMIC_ACQUIRE, "agent");
            xb_add(&bar[XB_XGEN(b.x)], 1u);
            asm volatile("s_waitcnt vmcnt(0)" ::: "memory");
        } else {
            XB_SPIN(xb_ld(&bar[XB_XGEN(b.x)]) == gen, bar);
            __builtin_amdgcn_fence(__ATOMIC_ACQUIRE, "agent");
            asm volatile("s_waitcnt vmcnt(0)" ::: "memory");
        }
    }
    __syncthreads();
}


DI void run_phase(const DP& p, int ph, int dry) {
  if (ph == 0) { phase0(p); wconv_phase(p, 0); return; }
  int q = ph - 1, layer, lp;
  if (q < 10) { layer = 0; lp = q; } else if (q < 18) { layer = 1; lp = q - 10; } else if (q < 28) { layer = 2; lp = q - 18; } else { layer = 3; lp = q - 28; }
  const int j = layer >> 1;
  const bool even = (layer & 1) == 0;
  int op, gsel = 0;
  if (even) {
    op = (int)((0x2272654321ull >> (4 * lp)) & 15ull); gsel = (int)((0x3201000000ull >> (4 * lp)) & 15ull);
  } else {
    op = (int)((0x22729821ull >> (4 * lp)) & 15ull); gsel = (int)((0x32010000ull >> (4 * lp)) & 15ull);
  }
  if (op == 1 && layer != 0) wconv_phase(p, layer);
  if (op == 1 || op == 7) {
    const bool first = op == 1;
    norm_phase(p, layer, (first ? p.norm_mix_g : p.norm_ff_g) + layer * 1024, first ? 0 : 3, first ? 1 : 4);
  } else if (op == 2) {
    int mode, lda, N, K, gch; size_t offA, offB;
    if (gsel == 0) { mode = even ? EPI_EVEN_IN : EPI_ODD_IN; offA = OFF_MIX; lda = 1024; offB = OFF_WIN; N = even ? 5168 : 2304; K = 1024; gch = 0; }
    else if (gsel == 1) { mode = EPI_RESID; offA = OFF_MIX; lda = even ? 2048 : 1024; offB = OFF_WOUT; N = 1024; K = even ? 2048 : 1024; gch = 2; }
    else if (gsel == 2) { mode = EPI_RELU2; offA = OFF_MIX; lda = 1024; offB = OFF_WFF1; N = 4096; K = 1024; gch = 0; }
    else { mode = EPI_RESID; offA = OFF_ACT; lda = 4096; offB = OFF_WFF2; N = 1024; K = 4096; gch = 5; }
    if (dry && mode == EPI_RESID) mode = 4;
    gemm_phase(p, mode, wsp<bfr>(p, offA), lda, wsp<bfr>(p, offB), N, K, layer, gch, (layer == 3 && gsel != 0) ? RL / 128 : R / 128);
  } else if (op == 3) conv_dt_phase(p, j);
  else if (op == 4) s1f1_phase(p);
  else if (op == 5) s2f2_phase(p, j);
  else if (op == 6) s3_phase(p, j);
  else if (op == 8) qkprep_phase(p, j);
  else if (op == 9) attn_phase(p, j);
}

DI int probe_reps(int ph) {
#ifdef PROBE_MASK
  if (ph == 0) return (PROBE_MASK & 1) ? 2 : 1;
  int q = ph - 1, layer, lp;
  if (q < 10) { layer = 0; lp = q; } else if (q < 18) { layer = 1; lp = q - 10; } else if (q < 28) { layer = 2; lp = q - 18; } else { layer = 3; lp = q - 28; }
  const bool even = (layer & 1) == 0;
  int op, gsel;
  if (even) { op = (int)((0x2272654321ull >> (4 * lp)) & 15ull); gsel = (int)((0x3201000000ull >> (4 * lp)) & 15ull); }
  else { op = (int)((0x22729821ull >> (4 * lp)) & 15ull); gsel = (int)((0x32010000ull >> (4 * lp)) & 15ull); }
  if (op == 5) return 1;
  if (op == 2 && (gsel == 1 || gsel == 3)) return ((PROBE_MASK >> 10) & 1) ? 2 : 1;
  return ((PROBE_MASK >> op) & 1) ? 2 : 1;
#else
  return 1;
#endif
}

__shared__ uint4 xb_words;

__global__ void __launch_bounds__(256, 2) mega(Params p, int ph0, int ph1) {
  cg::grid_group grid = cg::this_grid();
  if (threadIdx.x == 0) xb_words = make_uint4(0u, 0u, 0u, 0u);
  __syncthreads();
  XcdBarrier xb = xcd_barrier_post((unsigned*)(p.ws + OFF_BAR), (volatile LAS unsigned*)&xb_words);
#pragma unroll 1
  for (int ph = ph0; ph < ph1; ++ph) {
    const int nrep = probe_reps(ph);
#pragma unroll 1
    for (int rep = 0; rep < nrep; ++rep) {
      DP q;
      (Params&)q = p;
      int t = threadIdx.x, bb = blockIdx.x;
      asm volatile("" : "+v"(t));
      asm volatile("" : "+s"(bb));
      int z0;
      asm volatile("s_mov_b32 %0, 0" : "=s"(z0));
      q.ws = p.ws + z0;
      q.out = p.out + z0;
      q.tidl = t; q.bidl = bb;
      run_phase(q, ph, rep + 1 < nrep);
    }
    if (ph + 1 < ph1) {
      if (ph == ph0) grid.sync();
      else xcd_barrier(xb);
    }
  }
}

extern "C" void kernel_launch(void* const* d_in, const int* in_sizes, int n_in, void* d_out, int out_size, void* d_ws,
                              size_t ws_size, hipStream_t stream) {
  static int grid_blocks = 0;
  if (!grid_blocks) {
    int dev = 0, cus = 0, per_cu = 0;
    hipGetDevice(&dev);
    hipDeviceGetAttribute(&cus, hipDeviceAttributeMultiprocessorCount, dev);
    hipOccupancyMaxActiveBlocksPerMultiprocessor(&per_cu, mega, 256, 0);
    if (per_cu > 2) per_cu = 2;
    if (per_cu < 1) per_cu = 1;
    grid_blocks = cus * per_cu;
  }
  Params p{};
  const float** pp = (const float**)&p;
  for (int i = 0; i < 26; ++i) pp[i] = (const float*)d_in[i];
  p.out = (float*)d_out;
  p.ws = (unsigned char*)d_ws;
  if (ws_size < WS_TOTAL) fprintf(stderr, "workspace too small: %zu < %zu\n", ws_size, (size_t)WS_TOTAL);
  hipMemsetAsync((unsigned char*)d_ws + OFF_BAR, 0, XCD_BAR_WORDS * 4, stream);
#if MULTI_LAUNCH
  for (int ph = 0; ph < NPHASE; ++ph) {
    int a = ph, b = ph + 1;
    void* args[] = {&p, &a, &b};
    hipLaunchCooperativeKernel((void*)mega, dim3(grid_blocks), dim3(256), args, 0, stream);
  }
#else
  int a = 0, b = NPHASE;
  void* args[] = {&p, &a, &b};
  hipError_t e = hipLaunchCooperativeKernel((void*)mega, dim3(grid_blocks), dim3(256), args, 0, stream);
  if (e != hipSuccess) fprintf(stderr, "cooperative launch failed: %s (grid %d)\n", hipGetErrorString(e), grid_blocks);
#endif
}
```

```cpp
#include <hip/hip_runtime.h>
#include <hip/hip_cooperative_groups.h>
#include <cstdio>
namespace cg = cooperative_groups;

typedef unsigned short bfr;
typedef __attribute__((ext_vector_type(8))) short bf16x8;
typedef __attribute__((ext_vector_type(4))) short bf16x4;
typedef __attribute__((ext_vector_type(16))) float f32x16;
#define DI __device__ __forceinline__
#define MFMA(a, b, c) __builtin_amdgcn_mfma_f32_32x32x16_bf16((a), (b), (c), 0, 0, 0)

#ifndef MULTI_LAUNCH
#define MULTI_LAUNCH 0
#endif

constexpr int RL = 16384, R = 16896, SEQ = 8192, CTX = 256;
constexpr int NCH = 33, CL = 256;
constexpr int NPHASE = 35;

constexpr size_t al(size_t x) { return (x + 255) & ~size_t(255); }
constexpr size_t OFF_HC = 0;
constexpr size_t OFF_MOD = OFF_HC + al(512 * 1024 * 4);
constexpr size_t OFF_TW = OFF_MOD + al(4 * 3 * 6144 * 4);
constexpr size_t OFF_C128 = OFF_TW + al(8192 * 8);
constexpr size_t OFF_S128 = OFF_C128 + al(128 * 128 * 2);
constexpr size_t OFF_C64 = OFF_S128 + al(128 * 128 * 2);
constexpr size_t OFF_S64 = OFF_C64 + al(64 * 64 * 2);
constexpr size_t OFF_C256 = OFF_S64 + al(64 * 64 * 2);
constexpr size_t OFF_S256 = OFF_C256 + al(256 * 256 * 2);
constexpr size_t OFF_ROPE = OFF_S256 + al(256 * 256 * 2);
constexpr size_t OFF_DTV = OFF_ROPE + al(2 * 2 * 128 * 16 * 4);
constexpr size_t DT_BYTES = (size_t)2 * 2 * NCH * 24 * 256 * 4;
constexpr size_t OFF_ACUM = OFF_DTV + al(DT_BYTES);
constexpr size_t OFF_WIN = OFF_ACUM + al(DT_BYTES);
constexpr size_t OFF_WOUT = OFF_WIN + al((size_t)5248 * 1024 * 2);
constexpr size_t OFF_WFF1 = OFF_WOUT + al((size_t)1024 * 2048 * 2);
constexpr size_t OFF_WFF2 = OFF_WFF1 + al((size_t)4096 * 1024 * 2);
constexpr size_t OFF_MIX = OFF_WFF2 + al((size_t)4096 * 1024 * 2);
constexpr size_t OFF_BIG = OFF_MIX + al((size_t)R * 2048 * 2);
constexpr size_t OFF_Z = OFF_BIG;
constexpr size_t OFF_ZRT = OFF_Z + (size_t)R * 1536 * 2;
constexpr size_t OFF_ZIT = OFF_ZRT + (size_t)512 * R * 2;
constexpr size_t OFF_XBC = OFF_ZIT + (size_t)512 * R * 2;
constexpr size_t OFF_DTRAW = OFF_XBC + (size_t)R * 2560 * 2;
constexpr size_t BIG_END = OFF_DTRAW + (size_t)R * 48 * 4;
constexpr size_t OFF_HS = OFF_XBC;
constexpr size_t HS_BYTES = (size_t)2 * 2 * NCH * 24 * 8192 * 2;
constexpr size_t OFF_YR = OFF_HS + HS_BYTES;
constexpr size_t OFF_YI = OFF_YR + (size_t)2 * 512 * 128 * 64 * 2;
static_assert(OFF_YI + (size_t)2 * 512 * 128 * 64 * 2 <= OFF_DTRAW, "fft scratch overflows");
constexpr size_t OFF_ACT = OFF_BIG;
static_assert((size_t)R * 4096 * 2 <= BIG_END - OFF_BIG, "act overflows");
constexpr size_t OFF_P = OFF_BIG;
constexpr size_t OFF_VT = OFF_P + (size_t)R * 2304 * 2;
constexpr size_t OFF_QK = OFF_VT + (size_t)640 * R * 2;
static_assert(OFF_QK + (size_t)R * 1664 * 2 <= BIG_END, "odd overflows");
constexpr size_t OFF_XT = al(BIG_END);
constexpr size_t OFF_BN = OFF_XT + (size_t)1536 * R * 2;
constexpr size_t OFF_BT = OFF_BN + (size_t)R * 512 * 2;
constexpr size_t OFF_CN = OFF_BT + (size_t)512 * R * 2;
constexpr size_t OFF_BAR = al(OFF_CN + (size_t)R * 512 * 2);
constexpr size_t WS_TOTAL = OFF_BAR + 16384;
static_assert(WS_TOTAL <= 402653184ull, "workspace too large");

struct Params {
  const float *x, *c, *ctx, *c_ctx, *w_mod, *b_mod, *norm_mix_g, *norm_ff_g, *w_ff1, *w_ff2;
  const float *w_in_even, *conv_w, *conv_b, *dt_bias, *a_log, *d_skip, *ssd_norm_g, *w_out_even;
  const float *w_in_odd, *q_norm_win, *k_norm_win, *sink_win, *q_norm_na, *k_norm_na, *rpb_na, *w_out_odd;
  float* out;
  unsigned char* ws;
};

struct DP : Params { int tidl, bidl; };

__shared__ __attribute__((aligned(16))) unsigned char smem[73728];

typedef __attribute__((ext_vector_type(2))) __bf16 bf2_t;
typedef __attribute__((ext_vector_type(2))) float f2_t;
typedef __attribute__((ext_vector_type(4))) unsigned u32x4_t;
typedef __attribute__((ext_vector_type(2))) unsigned u32x2_t;
DI unsigned pk2(float a, float b) { f2_t v = {a, b}; return __builtin_bit_cast(unsigned, __builtin_convertvector(v, bf2_t)); }
DI bfr f2bf(float x) { return (bfr)(pk2(x, 0.f) & 0xffffu); }
DI float bf2f(bfr b) { return __uint_as_float(((unsigned)b) << 16); }
DI float bfs(short s) { return __uint_as_float(((unsigned)(unsigned short)s) << 16); }
DI int crow(int i, int h) { return (i & 3) + 8 * (i >> 2) + 4 * h; }
DI f32x16 zero16() { f32x16 z; for (int i = 0; i < 16; ++i) z[i] = 0.f; return z; }
DI bf16x8 pack8(float a0, float a1, float a2, float a3, float a4, float a5, float a6, float a7) {
  u32x4_t v = {pk2(a0, a1), pk2(a2, a3), pk2(a4, a5), pk2(a6, a7)};
  return __builtin_bit_cast(bf16x8, v);
}
DI bf16x4 pack4(float a0, float a1, float a2, float a3) {
  u32x2_t v = {pk2(a0, a1), pk2(a2, a3)};
  return __builtin_bit_cast(bf16x4, v);
}
#define PACK_HALF(s, s2) pack8(s[8 * (s2)], s[8 * (s2) + 1], s[8 * (s2) + 2], s[8 * (s2) + 3], s[8 * (s2) + 4], s[8 * (s2) + 5], s[8 * (s2) + 6], s[8 * (s2) + 7])
DI bf16x8 join44(bf16x4 lo, bf16x4 hi) { return __builtin_shufflevector(lo, hi, 0, 1, 2, 3, 4, 5, 6, 7); }
DI int chunk_row0(int b, int c) { return c == 0 ? RL + b * CTX : b * SEQ + (c - 1) * CL; }

DI void sincos_turn(double f, float& s, float& c) {
  f -= rint(f);
  double x = f * 6.283185307179586476925;
  double x2 = x * x, ss = 1.0, cc = 1.0;
#pragma unroll
  for (int k = 13; k >= 1; --k) {
    ss = 1.0 - x2 / (double)((2 * k) * (2 * k + 1)) * ss;
    cc = 1.0 - x2 / (double)((2 * k - 1) * (2 * k)) * cc;
  }
  s = (float)(x * ss); c = (float)cc;
}

template <class T> DI T* wsp(const DP& p, size_t off) { return (T*)(p.ws + off); }

DI void phase0(const DP& p) {
  const int tid = p.tidl, bid = p.bidl, G = gridDim.x;
  float* lds = (float*)smem;
  float* MOD = wsp<float>(p, OFF_MOD);
  for (int u = bid; u < 384; u += G) {
    int layer = u / 96, cb = u % 96;
    for (int i = tid; i < 3072; i += 256) {
      int v = i >> 10, k = i & 1023;
      float c = v < 2 ? p.c[v * 1024 + k] : p.c_ctx[k];
      lds[i] = c / (1.f + expf(-c));
    }
    __syncthreads();
    int kq = tid >> 6, cc = tid & 63, col = cb * 64 + cc;
    const float* w = p.w_mod + (size_t)layer * 1024 * 6144 + col;
    float a0 = 0, a1 = 0, a2 = 0;
    for (int k = kq * 256; k < kq * 256 + 256; ++k) {
      float wv = w[(size_t)k * 6144];
      a0 += lds[k] * wv; a1 += lds[1024 + k] * wv; a2 += lds[2048 + k] * wv;
    }
    float* red = lds + 3072;
    red[(kq * 3 + 0) * 64 + cc] = a0; red[(kq * 3 + 1) * 64 + cc] = a1; red[(kq * 3 + 2) * 64 + cc] = a2;
    __syncthreads();
    if (tid < 192) {
      int v = tid >> 6;
      float s = red[(0 * 3 + v) * 64 + cc] + red[(1 * 3 + v) * 64 + cc] + red[(2 * 3 + v) * 64 + cc] + red[(3 * 3 + v) * 64 + cc];
      MOD[(layer * 3 + v) * 6144 + col] = s + p.b_mod[layer * 6144 + col];
    }
    __syncthreads();
  }
  const int gt = bid * 256 + tid, nt = G * 256;
  {
    const float4* xs = (const float4*)p.x; float4* od = (float4*)p.out;
    for (int i = gt; i < RL * 256; i += 4 * nt) {
      float4 t4[4];
#pragma unroll
      for (int q = 0; q < 4; ++q) { const int ii = i + q * nt; t4[q] = ii < RL * 256 ? xs[ii] : make_float4(0.f, 0.f, 0.f, 0.f); }
#pragma unroll
      for (int q = 0; q < 4; ++q) { const int ii = i + q * nt; if (ii < RL * 256) od[ii] = t4[q]; }
    }
    const float4* cs = (const float4*)p.ctx; float4* hd = wsp<float4>(p, OFF_HC);
    for (int i = gt; i < 512 * 256; i += nt) hd[i] = cs[i];
  }
  float2* TW = wsp<float2>(p, OFF_TW);
  for (int i = gt; i < 8192; i += nt) { float s, c; sincos_turn((double)i / 8192.0, s, c); TW[i] = make_float2(c, s); }
  bfr* C128 = wsp<bfr>(p, OFF_C128); bfr* S128 = wsp<bfr>(p, OFF_S128);
  for (int i = gt; i < 128 * 128; i += nt) { int a = i >> 7, b = i & 127; float s, c; sincos_turn((double)((a * b) & 127) / 128.0, s, c); C128[i] = f2bf(c); S128[i] = f2bf(s); }
  bfr* C64 = wsp<bfr>(p, OFF_C64); bfr* S64 = wsp<bfr>(p, OFF_S64);
  for (int i = gt; i < 64 * 64; i += nt) { int a = i >> 6, b = i & 63; float s, c; sincos_turn((double)((a * b) & 63) / 64.0, s, c); C64[i] = f2bf(c); S64[i] = f2bf(s); }
  bfr* C256 = wsp<bfr>(p, OFF_C256); bfr* S256 = wsp<bfr>(p, OFF_S256);
  for (int i = gt; i < 256 * 256; i += nt) { int a = i >> 8, b = i & 255; float s, c; sincos_turn((double)((a * b) & 255) / 256.0, s, c); C256[i] = f2bf(c); S256[i] = f2bf(s); }
  float* ROPE = wsp<float>(p, OFF_ROPE);
  for (int i = gt; i < 2 * 128 * 16; i += nt) {
    int f = i & 15, idx = (i >> 4) & 127;
    float ang = (float)idx * (float)exp(-(double)f * 0.5756462732485115);
    float s, c; sincos_turn((double)ang / 6.283185307179586476925, s, c);
    ROPE[i] = c; ROPE[4096 + i] = s;
  }
}

DI void tcvt_unit(const float* __restrict__ src, int ld, int c0, int ncols, int K, bfr* __restrict__ dst, int dr0, int u, int tid) {
  const int ntk = K >> 6;
  const int tn = u / ntk, tk = u % ntk, k0 = tk * 64, nb = tn * 64;
  bfr* T = (bfr*)smem;
  float4 v[4];
  const int n4 = (tid & 15) * 4;
#pragma unroll
  for (int i = 0; i < 4; ++i) {
    const int kk = (tid >> 4) + 16 * i;
    v[i] = make_float4(0.f, 0.f, 0.f, 0.f);
    if (nb + n4 < ncols) v[i] = *(const float4*)(src + (size_t)(k0 + kk) * ld + c0 + nb + n4);
  }
#pragma unroll
  for (int i = 0; i < 4; ++i) {
    const int kk = (tid >> 4) + 16 * i;
    T[(n4 + 0) * 72 + kk] = f2bf(v[i].x); T[(n4 + 1) * 72 + kk] = f2bf(v[i].y);
    T[(n4 + 2) * 72 + kk] = f2bf(v[i].z); T[(n4 + 3) * 72 + kk] = f2bf(v[i].w);
  }
  __syncthreads();
  {
    int n = tid >> 2, kseg = (tid & 3) * 16;
    if (nb + n < ncols) {
      bfr* d = dst + (size_t)(dr0 + nb + n) * K + k0 + kseg;
      *(bf16x8*)d = *(const bf16x8*)(T + n * 72 + kseg);
      *(bf16x8*)(d + 8) = *(const bf16x8*)(T + n * 72 + kseg + 8);
    }
  }
  __syncthreads();
}

DI void wconv_phase(const DP& p, int layer) {
  const int tid = p.tidl;
  const int j = layer >> 1;
  bfr* WIN = wsp<bfr>(p, OFF_WIN); bfr* WOUT = wsp<bfr>(p, OFF_WOUT);
  bfr* WFF1 = wsp<bfr>(p, OFF_WFF1); bfr* WFF2 = wsp<bfr>(p, OFF_WFF2);
  const float* ff1 = p.w_ff1 + (size_t)layer * 1024 * 4096;
  const float* ff2 = p.w_ff2 + (size_t)layer * 4096 * 1024;
  float* cst = (float*)(smem + 20480);
  if (tid < 64) { float s, c; sincos_turn((double)tid / 64.0, s, c); cst[tid] = c; cst[64 + tid] = s; }
  __syncthreads();
  if ((layer & 1) == 0) {
    const float* win = p.w_in_even + (size_t)j * 1024 * 4656;
    const float* wout = p.w_out_even + (size_t)j * 2048 * 1024;
    const int n_in = 65 * 16, n_out = 16 * 32, n_f1 = 64 * 16, n_f2 = 16 * 64, n_fold = 128;
    const int total = n_in + n_out + n_f1 + n_f2 + n_fold;
    for (int u = p.bidl; u < total; u += gridDim.x) {
      int v = u;
      if (v < n_in) { tcvt_unit(win, 4656, 512, 4144, 1024, WIN, 1024, v, tid); continue; }
      v -= n_in;
      if (v < n_out) { tcvt_unit(wout, 1024, 0, 1024, 2048, WOUT, 0, v, tid); continue; }
      v -= n_out;
      if (v < n_f1) { tcvt_unit(ff1, 4096, 0, 4096, 1024, WFF1, 0, v, tid); continue; }
      v -= n_f1;
      if (v < n_f2) { tcvt_unit(ff2, 1024, 0, 1024, 4096, WFF2, 0, v, tid); continue; }
      v -= n_f2;
      {
        const int g = v >> 4, kb = v & 15;
        float* wt = (float*)smem;
#pragma unroll
        for (int i = 0; i < 4; ++i) {
          const int idx = tid + 256 * i, kk = idx >> 4, j4 = (idx & 15) * 4;
          const float4 wv = *(const float4*)(win + (size_t)(kb * 64 + kk) * 4656 + g * 64 + j4);
          wt[kk * 65 + j4] = wv.x; wt[kk * 65 + j4 + 1] = wv.y; wt[kk * 65 + j4 + 2] = wv.z; wt[kk * 65 + j4 + 3] = wv.w;
        }
        __syncthreads();
        const int kl = tid & 63, mg = tid >> 6;
#pragma unroll 1
        for (int mi = 0; mi < 16; ++mi) {
          const int m = mg * 16 + mi;
          float sc = 0.f, ss = 0.f;
#pragma unroll 8
          for (int jj = 0; jj < 64; ++jj) { const float w = wt[kl * 65 + jj]; const int idx = (m * jj) & 63; sc += w * cst[idx]; ss += w * cst[64 + idx]; }
          const int ch = g * 64 + m, k = kb * 64 + kl;
          WIN[(size_t)ch * 1024 + k] = f2bf(sc);
          WIN[(size_t)(512 + ch) * 1024 + k] = f2bf(-ss);
        }
        __syncthreads();
      }
    }
  } else {
    const float* win = p.w_in_odd + (size_t)j * 1024 * 2304;
    const float* wout = p.w_out_odd + (size_t)j * 1024 * 1024;
    const int n_in = 36 * 16, n_out = 16 * 16, n_f1 = 64 * 16, n_f2 = 16 * 64;
    const int total = n_in + n_out + n_f1 + n_f2;
    for (int u = p.bidl; u < total; u += gridDim.x) {
      int v = u;
      if (v < n_in) { tcvt_unit(win, 2304, 0, 2304, 1024, WIN, 0, v, tid); continue; }
      v -= n_in;
      if (v < n_out) { tcvt_unit(wout, 1024, 0, 1024, 1024, WOUT, 0, v, tid); continue; }
      v -= n_out;
      if (v < n_f1) { tcvt_unit(ff1, 4096, 0, 4096, 1024, WFF1, 0, v, tid); continue; }
      v -= n_f1;
      tcvt_unit(ff2, 1024, 0, 1024, 4096, WFF2, 0, v, tid);
    }
  }
}

DI void norm_phase(const DP& p, int layer, const float* __restrict__ gvec, int shc, int scc) {
  const int lane = p.tidl & 63;
  const int wg = p.bidl * 4 + (p.tidl >> 6), nw = gridDim.x * 4;
  const float* MOD = wsp<float>(p, OFF_MOD);
  const float* HC = wsp<float>(p, OFF_HC);
  bfr* U = wsp<bfr>(p, OFF_MIX);
#pragma unroll 1
  for (int row0 = wg; row0 < R; row0 += 2 * nw) {
    float4 v[2][4]; float ss[2] = {0.f, 0.f};
#pragma unroll
    for (int q = 0; q < 2; ++q) {
      const int row = row0 + q * nw < R ? row0 + q * nw : row0;
      const float* hp = row < RL ? p.out + (size_t)row * 1024 : HC + (size_t)(row - RL) * 1024;
#pragma unroll
      for (int i = 0; i < 4; ++i) v[q][i] = *(const float4*)(hp + i * 256 + lane * 4);
    }
#pragma unroll
    for (int q = 0; q < 2; ++q) {
#pragma unroll
      for (int i = 0; i < 4; ++i) ss[q] += v[q][i].x * v[q][i].x + v[q][i].y * v[q][i].y + v[q][i].z * v[q][i].z + v[q][i].w * v[q][i].w;
#pragma unroll
      for (int o = 32; o >= 1; o >>= 1) ss[q] += __shfl_xor(ss[q], o);
    }
#pragma unroll
    for (int q = 0; q < 2; ++q) {
      const int row = row0 + q * nw;
      if (row >= R) continue;
      const int ms = row < RL ? (row >> 13) : 2;
      const float* md = MOD + (layer * 3 + ms) * 6144;
      const float rs = rsqrtf(ss[q] * (1.f / 1024.f) + 1e-6f);
#pragma unroll
      for (int i = 0; i < 4; ++i) {
        int col = i * 256 + lane * 4;
        float4 g = *(const float4*)(gvec + col);
        float4 sc = *(const float4*)(md + scc * 1024 + col);
        float4 sh = *(const float4*)(md + shc * 1024 + col);
        bf16x4 o = pack4(v[q][i].x * rs * g.x * (1.f + sc.x) + sh.x, v[q][i].y * rs * g.y * (1.f + sc.y) + sh.y,
                         v[q][i].z * rs * g.z * (1.f + sc.z) + sh.z, v[q][i].w * rs * g.w * (1.f + sc.w) + sh.w);
        *(bf16x4*)(U + (size_t)row * 1024 + col) = o;
      }
    }
  }
}

enum { EPI_EVEN_IN = 0, EPI_ODD_IN = 1, EPI_RELU2 = 2, EPI_RESID = 3 };

DI void gemm_phase(const DP& p, int mode, const bfr* __restrict__ A, int lda, const bfr* __restrict__ Bt,
                   int N, int K, int layer, int gchunk, int nM) {
  const int tid = p.tidl, lane = tid & 63, wid = tid >> 6, r = lane & 31, h = lane >> 5;
  const int wm = wid >> 1, wn = wid & 1;
  const int nN = (N + 127) >> 7;
  const int tiles = nM * nN, G = (int)gridDim.x;
  int full = tiles, tail = 0, St = 1;
  if (mode == EPI_RESID) {
    full = (tiles / G) * G; tail = tiles - full;
    if (tail > 0) { int c = G / tail; int kmax = K >> 7; St = 1; while (St * 2 <= c && St * 2 <= 16 && St * 2 <= kmax) St *= 2; }
  }
  const int chunk = (full + 7) >> 3;
  const int units = chunk * 8 + tail * St;
  bfr* sm = (bfr*)smem;
  const int lrow = tid >> 3, lc = (tid & 7) * 8;
#pragma unroll 1
  for (int u = p.bidl; u < units; u += G) {
    int t, ks, Ks; bool atom;
    if (u < chunk * 8) {
      t = (u & 7) * chunk + (u >> 3);
      if (t >= full) continue;
      ks = 0; Ks = K; atom = false;
    } else { const int v = u - chunk * 8; t = full + v / St; ks = v % St; Ks = K / St; atom = St > 1; }
    const int nk = Ks >> 6;
    const int panel = t / (nM * 8); const int rem = t - panel * nM * 8;
    const int pw = (nN - panel * 8) < 8 ? (nN - panel * 8) : 8;
    const int tm = rem / pw, tn = panel * 8 + rem % pw;
    const int m0 = tm * 128, n0 = tn * 128, kbase = ks * Ks;
    f32x16 acc[2][2];
    acc[0][0] = zero16(); acc[0][1] = zero16(); acc[1][0] = zero16(); acc[1][1] = zero16();
    const bfr* Ag = A + (size_t)(m0 + lrow) * lda + kbase + lc;
    const bfr* Bg = Bt + (size_t)(n0 + lrow) * K + kbase + lc;
    bf16x8 ra[4], rb[4];
#pragma unroll
    for (int i = 0; i < 4; ++i) {
      ra[i] = *(const bf16x8*)(Ag + (size_t)(32 * i) * lda);
      rb[i] = *(const bf16x8*)(Bg + (size_t)(32 * i) * K);
    }
#pragma unroll
    for (int i = 0; i < 4; ++i) {
      *(bf16x8*)(sm + (lrow + 32 * i) * 72 + lc) = ra[i];
      *(bf16x8*)(sm + 9216 + (lrow + 32 * i) * 72 + lc) = rb[i];
    }
    if (nk > 1) {
#pragma unroll
      for (int i = 0; i < 4; ++i) {
        ra[i] = *(const bf16x8*)(Ag + (size_t)(32 * i) * lda + 64);
        rb[i] = *(const bf16x8*)(Bg + (size_t)(32 * i) * K + 64);
      }
    }
    __syncthreads();
#pragma unroll 1
    for (int kt = 0; kt < nk; ++kt) {
      if (kt + 1 < nk) {
        bfr* Ad = sm + ((kt + 1) & 1) * 18432;
#pragma unroll
        for (int i = 0; i < 4; ++i) {
          *(bf16x8*)(Ad + (lrow + 32 * i) * 72 + lc) = ra[i];
          *(bf16x8*)(Ad + 9216 + (lrow + 32 * i) * 72 + lc) = rb[i];
        }
      }
      if (kt + 2 < nk) {
#pragma unroll
        for (int i = 0; i < 4; ++i) {
          ra[i] = *(const bf16x8*)(Ag + (size_t)(32 * i) * lda + (kt + 2) * 64);
          rb[i] = *(const bf16x8*)(Bg + (size_t)(32 * i) * K + (kt + 2) * 64);
        }
      }
      const bfr* As = sm + (kt & 1) * 18432;
      const bfr* Bs = As + 9216;
      __builtin_amdgcn_s_setprio(1);
#pragma unroll
      for (int kk = 0; kk < 4; ++kk) {
        bf16x8 a0 = *(const bf16x8*)(As + (wm * 64 + r) * 72 + kk * 16 + h * 8);
        bf16x8 a1 = *(const bf16x8*)(As + (wm * 64 + 32 + r) * 72 + kk * 16 + h * 8);
        bf16x8 b0 = *(const bf16x8*)(Bs + (wn * 64 + r) * 72 + kk * 16 + h * 8);
        bf16x8 b1 = *(const bf16x8*)(Bs + (wn * 64 + 32 + r) * 72 + kk * 16 + h * 8);
        acc[0][0] = MFMA(a0, b0, acc[0][0]);
        acc[0][1] = MFMA(a0, b1, acc[0][1]);
        acc[1][0] = MFMA(a1, b0, acc[1][0]);
        acc[1][1] = MFMA(a1, b1, acc[1][1]);
      }
      __builtin_amdgcn_s_setprio(0);
      __syncthreads();
    }
    if (mode == EPI_RESID && !atom) {
      float hv[2][2][16], gt2[2][2];
#pragma unroll
      for (int mi = 0; mi < 2; ++mi)
#pragma unroll
        for (int ni = 0; ni < 2; ++ni) {
          const int col = n0 + wn * 64 + ni * 32 + r;
          const int rowb = m0 + wm * 64 + mi * 32 + 4 * h;
          const int ms = rowb < RL ? (rowb >> 13) : 2;
          gt2[mi][ni] = wsp<float>(p, OFF_MOD)[(layer * 3 + ms) * 6144 + gchunk * 1024 + col];
          const float* hp = rowb < RL ? p.out + (size_t)rowb * 1024 + col : wsp<float>(p, OFF_HC) + (size_t)(rowb - RL) * 1024 + col;
#pragma unroll
          for (int i = 0; i < 16; ++i) hv[mi][ni][i] = hp[(size_t)((i & 3) + 8 * (i >> 2)) * 1024];
        }
#pragma unroll
      for (int mi = 0; mi < 2; ++mi)
#pragma unroll
        for (int ni = 0; ni < 2; ++ni) {
          const int col = n0 + wn * 64 + ni * 32 + r;
          const int rowb = m0 + wm * 64 + mi * 32 + 4 * h;
          float* hp = rowb < RL ? p.out + (size_t)rowb * 1024 + col : wsp<float>(p, OFF_HC) + (size_t)(rowb - RL) * 1024 + col;
#pragma unroll
          for (int i = 0; i < 16; ++i) hp[(size_t)((i & 3) + 8 * (i >> 2)) * 1024] = hv[mi][ni][i] + gt2[mi][ni] * acc[mi][ni][i];
        }
      continue;
    }
    const int cbw = n0 + wn * 64;
    const bool qkfuse = mode == EPI_ODD_IN && !((cbw >= 640 && cbw < 768) || cbw >= 1792);
    if (qkfuse) {
      float* T = (float*)smem + wid * 4160;
#pragma unroll
      for (int mi = 0; mi < 2; ++mi)
#pragma unroll
        for (int ni = 0; ni < 2; ++ni)
#pragma unroll
          for (int i = 0; i < 16; ++i) T[(mi * 32 + crow(i, h)) * 65 + ni * 32 + r] = acc[mi][ni][i];
      asm volatile("s_waitcnt lgkmcnt(0)" ::: "memory");
      const int hs = cbw < 640 ? (cbw >> 6) : 10 + ((cbw - 768) >> 6);
      const int jj = layer >> 1;
      const float* gv = hs < 8 ? p.q_norm_win + jj * 64 : hs < 10 ? p.k_norm_win + jj * 64 : hs < 18 ? p.q_norm_na + jj * 64 : p.k_norm_na + jj * 64;
      const float qs = (hs < 8 || (hs >= 10 && hs < 18)) ? 0.125f : 1.f;
      const int row = m0 + wm * 64 + lane;
      float ss = 0.f;
#pragma unroll
      for (int d = 0; d < 64; ++d) { const float t = T[lane * 65 + d]; ss += t * t; }
      const float rs = rsqrtf(ss * (1.f / 64.f) + 1e-6f);
      const bool dorope = hs < 10 && row < RL;
      const float* ROPE = wsp<float>(p, OFF_ROPE);
      const int pos = row & 8191;
      bfr* dst = wsp<bfr>(p, OFF_QK) + (size_t)row * 1664 + hs * 64;
#pragma unroll
      for (int a = 0; a < 2; ++a) {
        float x[32];
#pragma unroll
        for (int d = 0; d < 32; ++d) x[d] = T[lane * 65 + a * 32 + d] * rs * gv[a * 32 + d];
        if (dorope) {
          const int idx = a == 0 ? (pos >> 6) : 128 + (pos & 63);
#pragma unroll
          for (int f4 = 0; f4 < 4; ++f4) {
            const float4 c4 = *(const float4*)(ROPE + idx * 16 + f4 * 4), s4 = *(const float4*)(ROPE + 4096 + idx * 16 + f4 * 4);
            const float cc[4] = {c4.x, c4.y, c4.z, c4.w}, sn[4] = {s4.x, s4.y, s4.z, s4.w};
#pragma unroll
            for (int q = 0; q < 4; ++q) {
              const int f = f4 * 4 + q;
              const float x1 = x[f], x2 = x[16 + f];
              x[f] = x1 * cc[q] - x2 * sn[q];
              x[16 + f] = x2 * cc[q] + x1 * sn[q];
            }
          }
        }
#pragma unroll
        for (int k8 = 0; k8 < 4; ++k8)
          *(bf16x8*)(dst + a * 32 + k8 * 8) = pack8(x[k8 * 8] * qs, x[k8 * 8 + 1] * qs, x[k8 * 8 + 2] * qs, x[k8 * 8 + 3] * qs,
                                                    x[k8 * 8 + 4] * qs, x[k8 * 8 + 5] * qs, x[k8 * 8 + 6] * qs, x[k8 * 8 + 7] * qs);
      }
    }
    if (!qkfuse)
#pragma unroll
    for (int mi = 0; mi < 2; ++mi)
#pragma unroll
      for (int ni = 0; ni < 2; ++ni)
#pragma unroll
        for (int g4 = 0; g4 < 4; ++g4) {
          const int row = m0 + wm * 64 + mi * 32 + 8 * g4 + 4 * h;
          const int col = n0 + wn * 64 + ni * 32 + r;
          const float v0 = acc[mi][ni][4 * g4], v1 = acc[mi][ni][4 * g4 + 1], v2 = acc[mi][ni][4 * g4 + 2], v3 = acc[mi][ni][4 * g4 + 3];
          if (mode == EPI_EVEN_IN) {
            if (col < 1024) {
              bfr* dst = wsp<bfr>(p, col < 512 ? OFF_ZRT : OFF_ZIT) + (size_t)(col & 511) * R + row;
              *(bf16x4*)dst = pack4(v0, v1, v2, v3);
            } else if (col < 2560) {
              bfr* dst = wsp<bfr>(p, OFF_Z) + (size_t)row * 1536 + (col - 1024);
              dst[0] = f2bf(v0); dst[1536] = f2bf(v1); dst[2 * 1536] = f2bf(v2); dst[3 * 1536] = f2bf(v3);
            } else if (col < 5120) {
              bfr* dst = wsp<bfr>(p, OFF_XBC) + (size_t)row * 2560 + (col - 2560);
              dst[0] = f2bf(v0); dst[2560] = f2bf(v1); dst[2 * 2560] = f2bf(v2); dst[3 * 2560] = f2bf(v3);
            } else if (col < 5168) {
              float* dst = wsp<float>(p, OFF_DTRAW) + (size_t)row * 48 + (col - 5120);
              dst[0] = v0; dst[48] = v1; dst[96] = v2; dst[144] = v3;
            }
          } else if (mode == EPI_ODD_IN) {
            if (col >= 640 && col < 768) {
              *(bf16x4*)(wsp<bfr>(p, OFF_VT) + (size_t)(col - 640) * R + row) = pack4(v0, v1, v2, v3);
            } else if (col >= 1792) {
              *(bf16x4*)(wsp<bfr>(p, OFF_VT) + (size_t)(128 + col - 1792) * R + row) = pack4(v0, v1, v2, v3);
            } else {
              bfr* dst = wsp<bfr>(p, OFF_P) + (size_t)row * 2304 + col;
              dst[0] = f2bf(v0); dst[2304] = f2bf(v1); dst[2 * 2304] = f2bf(v2); dst[3 * 2304] = f2bf(v3);
            }
          } else if (mode == EPI_RELU2) {
            bfr* dst = wsp<bfr>(p, OFF_ACT) + (size_t)row * 4096 + col;
            float t0 = fmaxf(v0, 0.f), t1 = fmaxf(v1, 0.f), t2 = fmaxf(v2, 0.f), t3 = fmaxf(v3, 0.f);
            dst[0] = f2bf(t0 * t0); dst[4096] = f2bf(t1 * t1); dst[2 * 4096] = f2bf(t2 * t2); dst[3 * 4096] = f2bf(t3 * t3);
          } else if (mode == EPI_RESID) {
            const int ms = row < RL ? (row >> 13) : 2;
            const float gate = wsp<float>(p, OFF_MOD)[(layer * 3 + ms) * 6144 + gchunk * 1024 + col];
            float* hp = row < RL ? p.out + (size_t)row * 1024 + col : wsp<float>(p, OFF_HC) + (size_t)(row - RL) * 1024 + col;
            if (atom) {
              unsafeAtomicAdd(hp, gate * v0); unsafeAtomicAdd(hp + 1024, gate * v1);
              unsafeAtomicAdd(hp + 2048, gate * v2); unsafeAtomicAdd(hp + 3072, gate * v3);
            } else {
              hp[0] += gate * v0; hp[1024] += gate * v1; hp[2048] += gate * v2; hp[3072] += gate * v3;
            }
          }
        }
    if (mode == EPI_ODD_IN) __syncthreads();
  }
}

DI float softplus_f(float x) { return x > 0.f ? x + log1pf(expf(-x)) : log1pf(expf(x)); }

DI void conv_dt_phase(const DP& p, int j) {
  const int tid = p.tidl, lane = tid & 63, wid = tid >> 6;
  const bfr* XBC = wsp<bfr>(p, OFF_XBC);
  bfr* XT = wsp<bfr>(p, OFF_XT); bfr* BN = wsp<bfr>(p, OFF_BN); bfr* BTt = wsp<bfr>(p, OFF_BT); bfr* CN = wsp<bfr>(p, OFF_CN);
  bfr* TT = (bfr*)smem;
  const float* cw = p.conv_w + (size_t)j * 5 * 2560;
  const float* cb = p.conv_b + (size_t)j * 2560;
  const int n_conv = 264 * 40, n_dt = 792;
  for (int u = p.bidl; u < n_conv + n_dt; u += gridDim.x) {
    if (u < n_conv) {
      const int tb = u / 40, cbk = u % 40, row0 = tb * 64, ch0 = cbk * 64;
      int pos0, len;
      if (row0 < RL) { pos0 = row0 & 8191; len = SEQ; } else { pos0 = (row0 - RL) & 255; len = CTX; }
      const int c8 = tid & 7, ch = ch0 + c8 * 8;
      float w[5][8], bias[8];
#pragma unroll
      for (int k = 0; k < 5; ++k) {
        float4 wa = *(const float4*)(cw + k * 2560 + ch), wb = *(const float4*)(cw + k * 2560 + ch + 4);
        w[k][0] = wa.x; w[k][1] = wa.y; w[k][2] = wa.z; w[k][3] = wa.w; w[k][4] = wb.x; w[k][5] = wb.y; w[k][6] = wb.z; w[k][7] = wb.w;
      }
      {
        float4 wa = *(const float4*)(cb + ch), wb = *(const float4*)(cb + ch + 4);
        bias[0] = wa.x; bias[1] = wa.y; bias[2] = wa.z; bias[3] = wa.w; bias[4] = wb.x; bias[5] = wb.y; bias[6] = wb.z; bias[7] = wb.w;
      }
#pragma unroll
      for (int ps = 0; ps < 2; ++ps) {
        const int tl = (tid >> 3) + 32 * ps, pos = pos0 + tl, row = row0 + tl;
        float a[8];
#pragma unroll
        for (int e = 0; e < 8; ++e) a[e] = bias[e];
        bf16x8 xr[5];
#pragma unroll
        for (int k = 0; k < 5; ++k) {
          const int pp = pos + k - 2;
          const bool ok = pp >= 0 && pp < len;
          const bfr* xp = XBC + (size_t)(ok ? row + k - 2 : row) * 2560 + ch;
          xr[k] = *(const bf16x8*)xp;
          if (!ok) { for (int e = 0; e < 8; ++e) xr[k][e] = 0; }
        }
#pragma unroll
        for (int k = 0; k < 5; ++k)
#pragma unroll
          for (int e = 0; e < 8; ++e) a[e] += w[k][e] * bfs(xr[k][e]);
        bf16x8 o;
#pragma unroll
        for (int e = 0; e < 8; ++e) { float s = a[e] / (1.f + __expf(-a[e])); o[e] = (short)f2bf(s); }
        if (ch0 >= 2048) *(bf16x8*)(CN + (size_t)row * 512 + (ch - 2048)) = o;
        else if (ch0 >= 1536) *(bf16x8*)(BN + (size_t)row * 512 + (ch - 1536)) = o;
        if (ch0 < 2048) {
#pragma unroll
          for (int e = 0; e < 8; ++e) TT[(c8 * 8 + e) * 72 + tl] = (bfr)o[e];
        }
      }
      if (ch0 < 2048) {
        __syncthreads();
        const int chl = tid >> 2, tseg = (tid & 3) * 16;
        bfr* dst = (ch0 < 1536 ? XT + (size_t)(ch0 + chl) * R : BTt + (size_t)(ch0 - 1536 + chl) * R) + row0 + tseg;
        *(bf16x8*)dst = *(const bf16x8*)(TT + chl * 72 + tseg);
        *(bf16x8*)(dst + 8) = *(const bf16x8*)(TT + chl * 72 + tseg + 8);
        __syncthreads();
      }
    } else {
      const int item = (u - n_conv) * 4 + wid;
      const int head = item % 24; int rest = item / 24; const int dir = rest & 1; rest >>= 1; const int c = rest % NCH, b = rest / NCH;
      const int row0 = chunk_row0(b, c), col = dir * 24 + head;
      const float bias = p.dt_bias[j * 48 + col];
      const float a = -expf(p.a_log[j * 48 + col]);
      const float* DTRAW = wsp<float>(p, OFF_DTRAW);
      float dt[4], cs[4];
      float run = 0.f;
#pragma unroll
      for (int q = 0; q < 4; ++q) {
        dt[q] = softplus_f(DTRAW[(size_t)(row0 + lane * 4 + q) * 48 + col] + bias);
        run += dt[q] * a; cs[q] = run;
      }
      float x = run;
#pragma unroll
      for (int o = 1; o < 64; o <<= 1) { float t2 = __shfl_up(x, o); if (lane >= o) x += t2; }
      const float excl = x - run;
      const float total = __shfl(x, 63);
      float ac[4];
#pragma unroll
      for (int q = 0; q < 4; ++q) {
        float inc = excl + cs[q];
        ac[q] = dir == 0 ? inc : total - inc + dt[q] * a;
      }
      const size_t base = ((size_t)(((dir * 2 + b) * NCH + c) * 24 + head)) * 256 + lane * 4;
      *(float4*)(wsp<float>(p, OFF_DTV) + base) = make_float4(dt[0], dt[1], dt[2], dt[3]);
      *(float4*)(wsp<float>(p, OFF_ACUM) + base) = make_float4(ac[0], ac[1], ac[2], ac[3]);
    }
  }
}

DI bf16x8 scale8(bf16x8 a, const float* w) {
  return pack8(bfs(a[0]) * w[0], bfs(a[1]) * w[1], bfs(a[2]) * w[2], bfs(a[3]) * w[3],
               bfs(a[4]) * w[4], bfs(a[5]) * w[5], bfs(a[6]) * w[6], bfs(a[7]) * w[7]);
}

DI void s1_item(const DP& p, int item, int lane) {
  const int r = lane & 31, h = lane >> 5;
  const int head = item % 24; int rest = item / 24; const int dir = rest & 1; rest >>= 1; const int c = rest % NCH, b = rest / NCH;
  const int g = head / 6;
  const int row0 = chunk_row0(b, c);
  const size_t dbase = ((size_t)(((dir * 2 + b) * NCH + c) * 24 + head)) * 256;
  const float* dtv = wsp<float>(p, OFF_DTV) + dbase;
  const float* acm = wsp<float>(p, OFF_ACUM) + dbase;
  const float acend = dir == 0 ? acm[255] : acm[0];
  const bfr* XT = wsp<bfr>(p, OFF_XT); const bfr* BTt = wsp<bfr>(p, OFF_BT);
  bfr* HS = wsp<bfr>(p, OFF_HS) + ((size_t)(((dir * 2 + b) * NCH + c) * 24 + head)) * 8192;
#pragma unroll 1
  for (int pt = 0; pt < 2; ++pt) {
    f32x16 acc[4];
#pragma unroll
    for (int n = 0; n < 4; ++n) acc[n] = zero16();
#pragma unroll 4
    for (int kk = 0; kk < 16; ++kk) {
      const int s0 = kk * 16 + 8 * h;
      float4 d0 = *(const float4*)(dtv + s0), d1 = *(const float4*)(dtv + s0 + 4);
      float4 a0 = *(const float4*)(acm + s0), a1 = *(const float4*)(acm + s0 + 4);
      float w[8];
      w[0] = d0.x * __expf(acend - a0.x); w[1] = d0.y * __expf(acend - a0.y); w[2] = d0.z * __expf(acend - a0.z); w[3] = d0.w * __expf(acend - a0.w);
      w[4] = d1.x * __expf(acend - a1.x); w[5] = d1.y * __expf(acend - a1.y); w[6] = d1.z * __expf(acend - a1.z); w[7] = d1.w * __expf(acend - a1.w);
      bf16x8 af = scale8(*(const bf16x8*)(XT + (size_t)(head * 64 + pt * 32 + r) * R + row0 + s0), w);
#pragma unroll
      for (int nt = 0; nt < 4; ++nt) {
        bf16x8 bfv = *(const bf16x8*)(BTt + (size_t)(g * 128 + nt * 32 + r) * R + row0 + s0);
        acc[nt] = MFMA(af, bfv, acc[nt]);
      }
    }
#pragma unroll
    for (int nt = 0; nt < 4; ++nt)
#pragma unroll
      for (int i = 0; i < 16; ++i) HS[(pt * 32 + crow(i, h)) * 128 + nt * 32 + r] = f2bf(acc[nt][i]);
  }
}

DI void s1_block(const DP& p, int item) {
  const int tid = p.tidl, lane = tid & 63, wid = tid >> 6, r = lane & 31, h = lane >> 5;
  const int g = item & 3; const int bc = item >> 2; const int c = bc % NCH, b = bc / NCH;
  const int row0 = chunk_row0(b, c);
  const bfr* XT = wsp<bfr>(p, OFF_XT); const bfr* BTt = wsp<bfr>(p, OFF_BT);
  bfr* BS = (bfr*)smem;
  __syncthreads();
#pragma unroll 4
  for (int i = 0; i < 32; ++i) {
    const int row = wid * 32 + i;
    if (lane < 32)
      __builtin_amdgcn_global_load_lds((const unsigned*)(BTt + (size_t)(g * 128 + row) * R + row0 + lane * 8),
                                       (unsigned*)(BS + row * 264 + lane * 8), 16, 0, 0);
  }
  asm volatile("s_waitcnt vmcnt(0)" ::: "memory");
  __syncthreads();
#pragma unroll 1
  for (int j3 = 0; j3 < 3; ++j3) {
    const int pi = wid * 3 + j3, dir = pi / 6, head = g * 6 + pi % 6;
    const size_t ci = (size_t)(((dir * 2 + b) * NCH + c) * 24 + head);
    const float* dtv = wsp<float>(p, OFF_DTV) + ci * 256;
    const float* acm = wsp<float>(p, OFF_ACUM) + ci * 256;
    const float acend = dir == 0 ? acm[255] : acm[0];
    bfr* HS = wsp<bfr>(p, OFF_HS) + ci * 8192;
#pragma unroll 1
    for (int pt = 0; pt < 2; ++pt) {
      f32x16 acc[4];
#pragma unroll
      for (int n = 0; n < 4; ++n) acc[n] = zero16();
#pragma unroll 4
      for (int kk = 0; kk < 16; ++kk) {
        const int s0 = kk * 16 + 8 * h;
        float4 d0 = *(const float4*)(dtv + s0), d1 = *(const float4*)(dtv + s0 + 4);
        float4 a0 = *(const float4*)(acm + s0), a1 = *(const float4*)(acm + s0 + 4);
        float w[8];
        w[0] = d0.x * __expf(acend - a0.x); w[1] = d0.y * __expf(acend - a0.y); w[2] = d0.z * __expf(acend - a0.z); w[3] = d0.w * __expf(acend - a0.w);
        w[4] = d1.x * __expf(acend - a1.x); w[5] = d1.y * __expf(acend - a1.y); w[6] = d1.z * __expf(acend - a1.z); w[7] = d1.w * __expf(acend - a1.w);
        bf16x8 af = scale8(*(const bf16x8*)(XT + (size_t)(head * 64 + pt * 32 + r) * R + row0 + s0), w);
#pragma unroll
        for (int nt = 0; nt < 4; ++nt) {
          bf16x8 bfv = *(const bf16x8*)(BS + (nt * 32 + r) * 264 + s0);
          acc[nt] = MFMA(af, bfv, acc[nt]);
        }
      }
#pragma unroll
      for (int nt = 0; nt < 4; ++nt)
#pragma unroll
        for (int i = 0; i < 16; ++i) HS[(pt * 32 + crow(i, h)) * 128 + nt * 32 + r] = f2bf(acc[nt][i]);
    }
  }
}

DI void f1_item(const DP& p, int item, int lane) {
  const int r = lane & 31, h = lane >> 5;
  const int l2t = item & 1, m = (item >> 1) & 511, b = item >> 10;
  const bfr* ZRT = wsp<bfr>(p, OFF_ZRT) + (size_t)m * R + b * SEQ + l2t * 32 + r;
  const bfr* ZIT = wsp<bfr>(p, OFF_ZIT) + (size_t)m * R + b * SEQ + l2t * 32 + r;
  const bfr* C128 = wsp<bfr>(p, OFF_C128); const bfr* S128 = wsp<bfr>(p, OFF_S128);
  const float2* TW = wsp<float2>(p, OFF_TW);
  bfr* YR = wsp<bfr>(p, OFF_YR); bfr* YI = wsp<bfr>(p, OFF_YI);
  const int l2 = l2t * 32 + r;
#pragma unroll 1
  for (int mh = 0; mh < 2; ++mh) {
    f32x16 yr[2], yi[2];
#pragma unroll
    for (int i = 0; i < 2; ++i) { yr[i] = zero16(); yi[i] = zero16(); }
#pragma unroll 2
    for (int kk = 0; kk < 8; ++kk) {
      bf16x8 zr, zi, nzr;
#pragma unroll
      for (int jj = 0; jj < 8; ++jj) {
        int l1 = kk * 16 + 8 * h + jj;
        zr[jj] = (short)ZRT[l1 * 64]; zi[jj] = (short)ZIT[l1 * 64];
        nzr[jj] = (short)(zr[jj] ^ (short)0x8000);
      }
#pragma unroll
      for (int m2 = 0; m2 < 2; ++m2) {
        const int mt = mh * 2 + m2;
        bf16x8 ca = *(const bf16x8*)(C128 + (mt * 32 + r) * 128 + kk * 16 + 8 * h);
        bf16x8 sa = *(const bf16x8*)(S128 + (mt * 32 + r) * 128 + kk * 16 + 8 * h);
        yr[m2] = MFMA(ca, zr, yr[m2]); yr[m2] = MFMA(sa, zi, yr[m2]);
        yi[m2] = MFMA(ca, zi, yi[m2]); yi[m2] = MFMA(sa, nzr, yi[m2]);
      }
    }
#pragma unroll
    for (int m2 = 0; m2 < 2; ++m2)
#pragma unroll
      for (int i = 0; i < 16; ++i) {
        int k1 = (mh * 2 + m2) * 32 + crow(i, h);
        float2 t = TW[k1 * l2];
        float a = yr[m2][i], bb = yi[m2][i];
        size_t o = ((size_t)(b * 512 + m) * 128 + k1) * 64 + l2;
        YR[o] = f2bf(a * t.x + bb * t.y);
        YI[o] = f2bf(bb * t.x - a * t.y);
      }
  }
}

DI void f1c_item(const DP& p, int item, int lane) {
  const int r = lane & 31, h = lane >> 5;
  const int mt = item & 15, kt = (item >> 4) & 7, b = item >> 7;
  const int m = mt * 32 + r;
  const bfr* ZRT = wsp<bfr>(p, OFF_ZRT) + (size_t)m * R + RL + b * CTX;
  const bfr* ZIT = wsp<bfr>(p, OFF_ZIT) + (size_t)m * R + RL + b * CTX;
  const bfr* C256 = wsp<bfr>(p, OFF_C256) + (kt * 32 + r) * 256;
  const bfr* S256 = wsp<bfr>(p, OFF_S256) + (kt * 32 + r) * 256;
  f32x16 acc = zero16();
#pragma unroll 4
  for (int kk = 0; kk < 16; ++kk) {
    int o = kk * 16 + 8 * h;
    acc = MFMA(*(const bf16x8*)(C256 + o), *(const bf16x8*)(ZRT + o), acc);
    acc = MFMA(*(const bf16x8*)(S256 + o), *(const bf16x8*)(ZIT + o), acc);
  }
  bfr* MIX = wsp<bfr>(p, OFF_MIX);
#pragma unroll
  for (int i = 0; i < 16; ++i)
    MIX[(size_t)(RL + b * CTX + kt * 32 + crow(i, h)) * 2048 + m] = f2bf(acc[i] * (1.f / 128.f));
}

DI void s1f1_phase(const DP& p) {
  const int nS1 = 2 * NCH * 4;
  const int G = (int)gridDim.x;
  if (G > nS1 + 64) {
    if (p.bidl < nS1) { s1_block(p, p.bidl); return; }
    const int lane = p.tidl & 63;
    const int wg = (p.bidl - nS1) * 4 + (p.tidl >> 6), nw = (G - nS1) * 4;
#pragma unroll 1
    for (int it = wg; it < 2048 + 256; it += nw) {
      if (it < 2048) f1_item(p, it, lane); else f1c_item(p, it - 2048, lane);
    }
  } else {
#pragma unroll 1
    for (int it = p.bidl; it < nS1; it += G) s1_block(p, it);
    const int lane = p.tidl & 63;
    const int wg = p.bidl * 4 + (p.tidl >> 6), nw = G * 4;
#pragma unroll 1
    for (int it = wg; it < 2048 + 256; it += nw) {
      if (it < 2048) f1_item(p, it, lane); else f1c_item(p, it - 2048, lane);
    }
  }
}

DI void f2_item(const DP& p, int item, int lane) {
  const int r = lane & 31, h = lane >> 5;
  const int mt16 = item & 15, k1 = (item >> 4) & 127, b = item >> 11;
  const int m = mt16 * 32 + r;
  const bfr* YR = wsp<bfr>(p, OFF_YR) + ((size_t)(b * 512 + m) * 128 + k1) * 64;
  const bfr* YI = wsp<bfr>(p, OFF_YI) + ((size_t)(b * 512 + m) * 128 + k1) * 64;
  const bfr* C64 = wsp<bfr>(p, OFF_C64); const bfr* S64 = wsp<bfr>(p, OFF_S64);
  f32x16 acc[2]; acc[0] = zero16(); acc[1] = zero16();
#pragma unroll
  for (int kk = 0; kk < 4; ++kk) {
    bf16x8 yr = *(const bf16x8*)(YR + kk * 16 + 8 * h), yi = *(const bf16x8*)(YI + kk * 16 + 8 * h);
#pragma unroll
    for (int t = 0; t < 2; ++t) {
      bf16x8 ca = *(const bf16x8*)(C64 + (t * 32 + r) * 64 + kk * 16 + 8 * h);
      bf16x8 sa = *(const bf16x8*)(S64 + (t * 32 + r) * 64 + kk * 16 + 8 * h);
      acc[t] = MFMA(ca, yr, acc[t]); acc[t] = MFMA(sa, yi, acc[t]);
    }
  }
  bfr* MIX = wsp<bfr>(p, OFF_MIX);
  const float scale = 0.001381067932f;
#pragma unroll
  for (int t = 0; t < 2; ++t)
#pragma unroll
    for (int i = 0; i < 16; ++i) {
      int k2 = t * 32 + crow(i, h);
      MIX[(size_t)(b * SEQ + k1 + 128 * k2) * 2048 + m] = f2bf(acc[t][i] * scale);
    }
}

DI void s3_block(const DP& p, int j, int b, int c, int g, int half);

DI void s2f2_phase(const DP& p, int j) {
  if (p.bidl < 16) {
    const int k = p.bidl;
    s3_block(p, j, k >> 3, 0, (k >> 1) & 3, k & 1);
    return;
  }
  const int gt = (p.bidl - 16) * 256 + p.tidl, nt = ((int)gridDim.x - 16) * 256;
  bfr* HSb = wsp<bfr>(p, OFF_HS);
  const float* ACUM = wsp<float>(p, OFF_ACUM);
#pragma unroll 1
  for (int it = gt; it < 2 * 2 * 24 * 2048; it += nt) {
    const int e4 = it & 2047; const int rest = it >> 11; const int head = rest % 24, db = rest / 24, dir = db >> 1;
    bf16x4 sv[NCH]; float cd[NCH];
#pragma unroll
    for (int step = 0; step < NCH; ++step) {
      const int c = dir == 0 ? step : (step == 0 ? 0 : NCH - step);
      const size_t ci = (size_t)((db * NCH + c) * 24 + head);
      sv[step] = *(const bf16x4*)(HSb + ci * 8192 + e4 * 4);
      cd[step] = ACUM[ci * 256 + (dir == 0 ? 255 : 0)];
    }
    float h0 = 0.f, h1 = 0.f, h2 = 0.f, h3 = 0.f;
#pragma unroll
    for (int step = 0; step < NCH; ++step) {
      const int c = dir == 0 ? step : (step == 0 ? 0 : NCH - step);
      const size_t ci = (size_t)((db * NCH + c) * 24 + head);
      *(bf16x4*)(HSb + ci * 8192 + e4 * 4) = pack4(h0, h1, h2, h3);
      const float e = __expf(cd[step]);
      h0 = h0 * e + bfs(sv[step][0]); h1 = h1 * e + bfs(sv[step][1]); h2 = h2 * e + bfs(sv[step][2]); h3 = h3 * e + bfs(sv[step][3]);
    }
  }
  const int lane = p.tidl & 63;
  const int wg = (p.bidl - 16) * 4 + (p.tidl >> 6), nw = ((int)gridDim.x - 16) * 4;
#pragma unroll 1
  for (int it = wg; it < 4096; it += nw) f2_item(p, it, lane);
}

DI void s3_block(const DP& p, int j, int b, int c, int g, int half) {
  const int tid = p.tidl, lane = tid & 63, wid = tid >> 6, r = lane & 31, h = lane >> 5;
  const bfr* CN = wsp<bfr>(p, OFF_CN); const bfr* BN = wsp<bfr>(p, OFF_BN); const bfr* XT = wsp<bfr>(p, OFF_XT);
  const bfr* Z = wsp<bfr>(p, OFF_Z); bfr* MIX = wsp<bfr>(p, OFF_MIX);
  bfr* XTs = (bfr*)smem;
  bfr* HSF = (bfr*)(smem + 33792);
  bfr* HSB = (bfr*)(smem + 51200);
  float* LWF = (float*)(smem + 68608);
  float* LWB = LWF + 256;
  {
    const int row0 = chunk_row0(b, c);
    const int lt = half * 4 + wid;
    const int rowl = row0 + lt * 32 + r;
    const bfr* cfp = CN + (size_t)rowl * 512 + g * 128 + 8 * h;
    bf16x8 gtp[8][2];
    {
      bf16x8 cf[8];
#pragma unroll
      for (int kk = 0; kk < 8; ++kk) cf[kk] = *(const bf16x8*)(cfp + kk * 16);
#pragma unroll
      for (int k = 0; k < 8; ++k) { gtp[k][0] = cf[0]; gtp[k][1] = cf[0]; }
      __syncthreads();
      {
        bfr* BS = (bfr*)smem;
#pragma unroll 4
        for (int i = 0; i < 64; ++i) {
          const int row = wid * 64 + i;
          if (lane < 16)
            __builtin_amdgcn_global_load_lds((const unsigned*)(BN + (size_t)(row0 + row) * 512 + g * 128 + lane * 8),
                                             (unsigned*)(BS + row * 136 + lane * 8), 16, 0, 0);
        }
      }
      asm volatile("s_waitcnt vmcnt(0)" ::: "memory");
      __syncthreads();
#pragma unroll 1
      for (int st = 0; st < 8; ++st) {
        f32x16 gt = zero16();
#pragma unroll
        for (int kk = 0; kk < 8; ++kk)
          gt = MFMA(*(const bf16x8*)((const bfr*)smem + (st * 32 + r) * 136 + kk * 16 + 8 * h), cf[kk], gt);
#pragma unroll
        for (int k = 0; k < 7; ++k) { gtp[k][0] = gtp[k + 1][0]; gtp[k][1] = gtp[k + 1][1]; }
        gtp[7][0] = PACK_HALF(gt, 0); gtp[7][1] = PACK_HALF(gt, 1);
      }
    }
    float sumsq = 0.f;
#pragma unroll 1
    for (int hh = 0; hh < 6; ++hh) {
      const int head = g * 6 + hh;
      const size_t cif = (size_t)(((0 * 2 + b) * NCH + c) * 24 + head), cib = (size_t)(((1 * 2 + b) * NCH + c) * 24 + head);
      const float* acf = wsp<float>(p, OFF_ACUM) + cif * 256; const float* acb = wsp<float>(p, OFF_ACUM) + cib * 256;
      const float* dtf = wsp<float>(p, OFF_DTV) + cif * 256; const float* dtb = wsp<float>(p, OFF_DTV) + cib * 256;
      const bfr* HSf = wsp<bfr>(p, OFF_HS) + cif * 8192; const bfr* HSbk = wsp<bfr>(p, OFF_HS) + cib * 8192;
      __syncthreads();
#pragma unroll 4
      for (int i = 0; i < 16; ++i) {
        const int row = wid * 16 + i;
        if (lane < 32)
          __builtin_amdgcn_global_load_lds((const unsigned*)(XT + (size_t)(head * 64 + row) * R + row0 + lane * 8),
                                           (unsigned*)(XTs + row * 264 + lane * 8), 16, 0, 0);
      }
      if (c != 0) {
#pragma unroll 4
        for (int i = 0; i < 16; ++i) {
          const int row = wid * 16 + i;
          if (lane < 16) {
            __builtin_amdgcn_global_load_lds((const unsigned*)(HSf + row * 128 + lane * 8), (unsigned*)(HSF + row * 136 + lane * 8), 16, 0, 0);
            __builtin_amdgcn_global_load_lds((const unsigned*)(HSbk + row * 128 + lane * 8), (unsigned*)(HSB + row * 136 + lane * 8), 16, 0, 0);
          }
        }
      }
      bf16x8 cfh[8];
#pragma unroll
      for (int kk = 0; kk < 8; ++kk) cfh[kk] = *(const bf16x8*)(cfp + kk * 16);
      LWF[tid] = __logf(dtf[tid]) - acf[tid];
      LWB[tid] = __logf(dtb[tid]) - acb[tid];
      const float al_f = acf[lt * 32 + r], al_b = acb[lt * 32 + r];
      asm volatile("s_waitcnt vmcnt(0)" ::: "memory");
      __syncthreads();
      f32x16 acc[2];
      acc[0] = zero16(); acc[1] = zero16();
      if (c != 0) {
        f32x16 t0 = zero16(), t1 = zero16();
#pragma unroll
        for (int kk = 0; kk < 8; ++kk) {
          t0 = MFMA(*(const bf16x8*)(HSF + (r) * 136 + kk * 16 + 8 * h), cfh[kk], t0);
          t1 = MFMA(*(const bf16x8*)(HSF + (32 + r) * 136 + kk * 16 + 8 * h), cfh[kk], t1);
        }
        const float ef = __expf(al_f);
#pragma unroll
        for (int i = 0; i < 16; ++i) { acc[0][i] = t0[i] * ef; acc[1][i] = t1[i] * ef; }
        t0 = zero16(); t1 = zero16();
#pragma unroll
        for (int kk = 0; kk < 8; ++kk) {
          t0 = MFMA(*(const bf16x8*)(HSB + (r) * 136 + kk * 16 + 8 * h), cfh[kk], t0);
          t1 = MFMA(*(const bf16x8*)(HSB + (32 + r) * 136 + kk * 16 + 8 * h), cfh[kk], t1);
        }
        const float eb = __expf(al_b);
#pragma unroll
        for (int i = 0; i < 16; ++i) { acc[0][i] += t0[i] * eb; acc[1][i] += t1[i] * eb; }
      }
      bf16x4 zpre[2][4];
#pragma unroll
      for (int pt = 0; pt < 2; ++pt)
#pragma unroll
        for (int g4 = 0; g4 < 4; ++g4) zpre[pt][g4] = *(const bf16x4*)(Z + (size_t)rowl * 1536 + head * 64 + pt * 32 + 8 * g4 + 4 * h);
#pragma unroll 1
      for (int st = 0; st < 8; ++st) {
        const bf16x8 g0 = gtp[0][0], g1 = gtp[0][1];
#pragma unroll
        for (int k = 0; k < 7; ++k) { gtp[k][0] = gtp[k + 1][0]; gtp[k][1] = gtp[k + 1][1]; }
        gtp[7][0] = g0; gtp[7][1] = g1;
#pragma unroll 1
        for (int dir = 0; dir < 2; ++dir) {
          if (dir == 0 ? (st > lt) : (st < lt)) continue;
          const float* lwd = dir == 0 ? LWF : LWB;
          const float al = dir == 0 ? al_f : al_b;
          f32x16 mm;
#pragma unroll
          for (int g4 = 0; g4 < 4; ++g4) {
            const int sb = st * 32 + 8 * g4 + 4 * h;
            const float4 l4 = *(const float4*)(lwd + sb);
            const float lv[4] = {l4.x, l4.y, l4.z, l4.w};
#pragma unroll
            for (int q = 0; q < 4; ++q) {
              const int i = 4 * g4 + q;
              const int sidx = sb + q, lidx = lt * 32 + r;
              const bool valid = dir == 0 ? (sidx <= lidx) : (sidx >= lidx);
              const float gv = bfs((i >> 3) ? g1[i & 7] : g0[i & 7]);
              const float e = __expf(fminf(al + lv[q], 30.f));
              mm[i] = valid ? gv * e : 0.f;
            }
          }
#pragma unroll
          for (int s2 = 0; s2 < 2; ++s2) {
            bf16x8 pf = PACK_HALF(mm, s2);
#pragma unroll
            for (int pt = 0; pt < 2; ++pt) {
              const bfr* xp = XTs + (pt * 32 + r) * 264 + st * 32 + 16 * s2 + 4 * h;
              bf16x8 xf = join44(*(const bf16x4*)xp, *(const bf16x4*)(xp + 8));
              acc[pt] = MFMA(xf, pf, acc[pt]);
            }
          }
        }
      }
      const float dsk = p.d_skip[j * 24 + head];
#pragma unroll
      for (int pt = 0; pt < 2; ++pt)
#pragma unroll
        for (int g4 = 0; g4 < 4; ++g4) {
          const int pb = pt * 32 + 8 * g4 + 4 * h;
          bf16x4 zv = zpre[pt][g4];
          float y[4];
#pragma unroll
          for (int q = 0; q < 4; ++q) {
            float xv = bf2f(XTs[(pb + q) * 264 + lt * 32 + r]);
            float zz = bfs(zv[q]);
            float v = (acc[pt][4 * g4 + q] + dsk * xv) * (zz / (1.f + __expf(-zz)));
            sumsq += v * v; y[q] = v;
          }
          *(bf16x4*)(MIX + (size_t)rowl * 2048 + 512 + head * 64 + pb) = pack4(y[0], y[1], y[2], y[3]);
        }
    }
    const float tot = sumsq + __shfl_xor(sumsq, 32);
    const float sc = rsqrtf(tot * (1.f / 384.f) + 1e-6f);
    const float* ng = p.ssd_norm_g + (size_t)j * 1536;
    bf16x4 yv[6][2][4];
#pragma unroll
    for (int hh = 0; hh < 6; ++hh)
#pragma unroll
      for (int pt = 0; pt < 2; ++pt)
#pragma unroll
        for (int g4 = 0; g4 < 4; ++g4)
          yv[hh][pt][g4] = *(const bf16x4*)(MIX + (size_t)rowl * 2048 + 512 + (g * 6 + hh) * 64 + pt * 32 + 8 * g4 + 4 * h);
#pragma unroll
    for (int hh = 0; hh < 6; ++hh)
#pragma unroll
      for (int pt = 0; pt < 2; ++pt)
#pragma unroll
        for (int g4 = 0; g4 < 4; ++g4) {
          const int pb = pt * 32 + 8 * g4 + 4 * h, head = g * 6 + hh;
          const float4 gg = *(const float4*)(ng + head * 64 + pb);
          const bf16x4 y4 = yv[hh][pt][g4];
          *(bf16x4*)(MIX + (size_t)rowl * 2048 + 512 + head * 64 + pb) =
              pack4(bfs(y4[0]) * sc * gg.x, bfs(y4[1]) * sc * gg.y, bfs(y4[2]) * sc * gg.z, bfs(y4[3]) * sc * gg.w);
        }
  }
}

DI void s3_phase(const DP& p, int j) {
#pragma unroll 1
  for (int idx = p.bidl; idx < 512; idx += (int)gridDim.x) {
    const int half = idx & 1, g = (idx >> 1) & 3, bcl = idx >> 3;
    s3_block(p, j, bcl >> 5, 1 + (bcl & 31), g, half);
  }
}

DI void qkprep_phase(const DP& p, int j) {
  const int lane = p.tidl & 63;
  const int wg = p.bidl * 4 + (p.tidl >> 6), nw = gridDim.x * 4;
  const bfr* P = wsp<bfr>(p, OFF_P); bfr* QK = wsp<bfr>(p, OFF_QK);
  const float* ROPE = wsp<float>(p, OFF_ROPE);
  const int sub = lane >> 3, d0 = (lane & 7) * 8;
  for (int row = wg; row < R; row += nw) {
    bf16x8 xin[4];
#pragma unroll
    for (int ps = 0; ps < 4; ++ps) {
      const int hs0 = ps * 8 + sub, hsc0 = hs0 < 26 ? hs0 : 25;
      xin[ps] = *(const bf16x8*)(P + (size_t)row * 2304 + (hsc0 < 10 ? hsc0 * 64 : 768 + (hsc0 - 10) * 64) + d0);
    }
#pragma unroll
    for (int ps = 0; ps < 4; ++ps) {
      const int hs = ps * 8 + sub;
      const bool act = hs < 26;
      const int hsc = act ? hs : 25;
      bf16x8 xv = xin[ps];
      float x[8]; float ss = 0.f;
#pragma unroll
      for (int e = 0; e < 8; ++e) { x[e] = bfs(xv[e]); ss += x[e] * x[e]; }
      ss += __shfl_xor(ss, 1); ss += __shfl_xor(ss, 2); ss += __shfl_xor(ss, 4);
      const float rs = rsqrtf(ss * (1.f / 64.f) + 1e-6f);
      const float* gv = hsc < 8 ? p.q_norm_win + j * 64 : hsc < 10 ? p.k_norm_win + j * 64 : hsc < 18 ? p.q_norm_na + j * 64 : p.k_norm_na + j * 64;
#pragma unroll
      for (int e = 0; e < 8; ++e) x[e] = x[e] * rs * gv[d0 + e];
      float pr[8];
#pragma unroll
      for (int e = 0; e < 8; ++e) pr[e] = __shfl_xor(x[e], 2);
      if (hsc < 10 && row < RL) {
        const int pos = row & 8191;
        const int axis = d0 >> 5;
        const int idx = axis == 0 ? (pos >> 6) : (pos & 63);
        const int f0 = d0 & 15;
        const bool second = (d0 & 16) != 0;
        const float* cp = ROPE + (axis * 128 + idx) * 16 + f0;
        const float* sp = cp + 4096;
#pragma unroll
        for (int e = 0; e < 8; ++e) {
          float cs = cp[e], sn = sp[e];
          x[e] = second ? (x[e] * cs + pr[e] * sn) : (x[e] * cs - pr[e] * sn);
        }
      }
      const bool isq = hsc < 8 || (hsc >= 10 && hsc < 18);
      const float qs = isq ? 0.125f : 1.f;
      if (act) *(bf16x8*)(QK + (size_t)row * 1664 + hsc * 64 + d0) = pack8(x[0] * qs, x[1] * qs, x[2] * qs, x[3] * qs, x[4] * qs, x[5] * qs, x[6] * qs, x[7] * qs);
    }
  }
}

struct KVF { bf16x8 k[4]; bf16x8 v[2][2]; };
struct KVS { bf16x8 k[4]; bf16x8 v[4]; };

DI void kv_gload(KVS& g, const bfr* __restrict__ Kt, const bfr* __restrict__ Vt, int lane) {
#pragma unroll
  for (int i = 0; i < 4; ++i) {
    const int idx = lane + 64 * i;
    g.k[i] = *(const bf16x8*)(Kt + (size_t)(idx >> 3) * 1664 + (idx & 7) * 8);
    g.v[i] = *(const bf16x8*)(Vt + (size_t)(idx >> 2) * R + (idx & 3) * 8);
  }
}
DI void kv_sstore(const KVS& g, unsigned char* base, int lane) {
#pragma unroll
  for (int i = 0; i < 4; ++i) {
    const int idx = lane + 64 * i;
    { const int row = idx >> 3, c = idx & 7; *(bf16x8*)(base + row * 128 + ((c ^ (row & 7)) << 4)) = g.k[i]; }
    {
      const int d = idx >> 2, c16 = idx & 3, sw = (d >> 2) & 7;
      bf16x4 lo = __builtin_shufflevector(g.v[i], g.v[i], 0, 1, 2, 3), hi = __builtin_shufflevector(g.v[i], g.v[i], 4, 5, 6, 7);
      *(bf16x4*)(base + 4096 + d * 64 + (((2 * c16) ^ sw) << 3)) = lo;
      *(bf16x4*)(base + 4096 + d * 64 + (((2 * c16 + 1) ^ sw) << 3)) = hi;
    }
  }
}
DI void kv_sload(KVF& f, const unsigned char* base, int r, int h) {
#pragma unroll
  for (int kk = 0; kk < 4; ++kk) f.k[kk] = *(const bf16x8*)(base + r * 128 + (((2 * kk + h) ^ (r & 7)) << 4));
#pragma unroll
  for (int s2 = 0; s2 < 2; ++s2)
#pragma unroll
    for (int dt = 0; dt < 2; ++dt) {
      const int d = dt * 32 + r, sw = (d >> 2) & 7, c8 = 4 * s2 + h;
      const unsigned char* vb = base + 4096 + d * 64;
      f.v[s2][dt] = join44(*(const bf16x4*)(vb + ((c8 ^ sw) << 3)), *(const bf16x4*)(vb + (((c8 + 2) ^ sw) << 3)));
    }
}

DI void attn_compute(f32x16 (&o)[2], float& m, float& l, const unsigned char* qb, const unsigned char* base, int r, int h,
                     int mode, int a0, int a1, const float* __restrict__ rp) {
  f32x16 s = zero16();
#pragma unroll
  for (int kk = 0; kk < 4; ++kk) {
    const int off = r * 128 + (((2 * kk + h) ^ (r & 7)) << 4);
    s = MFMA(*(const bf16x8*)(base + off), *(const bf16x8*)(qb + off), s);
  }
  float tmax = -3.0e38f;
  if (mode == 1) {
#pragma unroll
    for (int i = 0; i < 16; ++i) { int dd = a0 - crow(i, h); dd = dd < 0 ? -dd : dd; s[i] = dd <= 128 ? s[i] : -1.0e30f; }
  } else if (mode == 2) {
#pragma unroll
    for (int i = 0; i < 16; ++i) {
      const int key = crow(i, h);
      const int rel = a0 + key;
      int co = a1 + key; co = co < 0 ? 0 : (co > 30 ? 30 : co);
      s[i] = (rel >= 0 && rel < 16) ? s[i] + rp[co] : -1.0e30f;
    }
  }
#pragma unroll
  for (int i = 0; i < 16; ++i) tmax = fmaxf(tmax, s[i]);
  tmax = fmaxf(tmax, __shfl_xor(tmax, 32));
  const float mn = fmaxf(m, tmax);
  const float alpha = __expf(m - mn);
  float ps = 0.f;
#pragma unroll
  for (int i = 0; i < 16; ++i) { s[i] = __expf(s[i] - mn); ps += s[i]; }
  l = l * alpha + ps; m = mn;
#pragma unroll
  for (int i = 0; i < 16; ++i) { o[0][i] *= alpha; o[1][i] *= alpha; }
#pragma unroll
  for (int s2 = 0; s2 < 2; ++s2) {
    bf16x8 pf = PACK_HALF(s, s2);
#pragma unroll
    for (int dt = 0; dt < 2; ++dt) {
      const int d = dt * 32 + r, sw = (d >> 2) & 7, c8 = 4 * s2 + h;
      const unsigned char* vb = base + 4096 + d * 64;
      bf16x8 vf = join44(*(const bf16x4*)(vb + ((c8 ^ sw) << 3)), *(const bf16x4*)(vb + (((c8 + 2) ^ sw) << 3)));
      o[dt] = MFMA(vf, pf, o[dt]);
    }
  }
}

DI void attn_item(const DP& p, int j, int item, int lane) {
  const int r = lane & 31, h = lane >> 5;
  const bfr* QK = wsp<bfr>(p, OFF_QK); const bfr* VT = wsp<bfr>(p, OFF_VT); bfr* MIX = wsp<bfr>(p, OFF_MIX);
  int kind, b, hd, qt;
  if (item < 4096) { kind = 0; qt = item & 255; hd = (item >> 8) & 7; b = item >> 11; }
  else if (item < 8192) { int v = item - 4096; kind = 1; qt = v & 255; hd = (v >> 8) & 7; b = v >> 11; }
  else if (item < 8320) { int v = item - 8192; kind = 2; qt = v & 7; hd = (v >> 3) & 7; b = v >> 6; }
  else { int v = item - 8320; kind = 3; qt = v & 7; hd = (v >> 3) & 7; b = v >> 6; }
  const bool win = (kind == 0 || kind == 2);
  const bool lat = kind < 2;
  const int q_row0 = lat ? b * SEQ + qt * 32 : RL + b * CTX + qt * 32;
  const int qcol = win ? hd * 64 : (10 + hd) * 64;
  const int kcol = win ? (8 + (hd >> 2)) * 64 : (18 + hd) * 64;
  const bfr* Vb = win ? VT + (size_t)((hd >> 2) * 64) * R : VT + (size_t)(128 + hd * 64) * R;
  const bfr* Kb = QK + kcol;
  f32x16 o[2]; o[0] = zero16(); o[1] = zero16();
  float m = -1.0e30f, l = 0.f;
  if (win) { m = p.sink_win[j * 8 + hd]; l = h == 0 ? 1.f : 0.f; }
  int nloc = 0, lo = 0, gr = 0, kr0 = 0, w = 0, cs = 0;
  const int qpos = qt * 32 + r;
  if (kind == 0) { lo = qt - 4 < 0 ? 0 : qt - 4; const int hi = qt + 4 > 255 ? 255 : qt + 4; nloc = hi - lo + 1; }
  else if (kind == 1) {
    gr = qt >> 1; w = (qt & 1) * 32 + r;
    cs = w - 8; cs = cs < 0 ? 0 : (cs > 48 ? 48 : cs);
    kr0 = gr - 4; kr0 = kr0 < 0 ? 0 : (kr0 > 120 ? 120 : kr0);
    nloc = 16;
  }
  const int ntile = 8 + nloc;
  const float* rpb = p.rpb_na + (size_t)j * 8 * 15 * 31 + hd * 15 * 31;
  auto tile_row = [&](int i) -> int {
    if (i < 8) return RL + b * CTX + i * 32;
    const int li = i - 8;
    if (kind == 0) return b * SEQ + (lo + li) * 32;
    return b * SEQ + (kr0 + (li >> 1)) * 64 + (li & 1) * 32;
  };
  unsigned char* lbase = smem + (p.tidl >> 6) * 12288;
  asm volatile("" ::: "memory");
#pragma unroll
  for (int i = 0; i < 4; ++i) {
    const int idx = lane + 64 * i, row = idx >> 3, c = idx & 7;
    *(bf16x8*)(lbase + 8192 + row * 128 + ((c ^ (row & 7)) << 4)) = *(const bf16x8*)(QK + (size_t)(q_row0 + row) * 1664 + qcol + c * 8);
  }
  KVS g;
  { const int k0 = tile_row(0); kv_gload(g, Kb + (size_t)k0 * 1664, Vb + k0, lane); }
  kv_sstore(g, lbase, lane);
#pragma unroll 1
  for (int i = 0; i < ntile; ++i) {
    { const int in = i + 1 < ntile ? i + 1 : i; const int k0 = tile_row(in); kv_gload(g, Kb + (size_t)k0 * 1664, Vb + k0, lane); }
    int mode = 0, a0 = 0, a1 = 0; const float* rp = rpb;
    if (i >= 8) {
      const int li = i - 8;
      if (kind == 0) { mode = 1; a0 = qpos - (lo + li) * 32; }
      else { mode = 2; const int krow = kr0 + (li >> 1); const int ub = (li & 1) * 32; a0 = ub - cs; a1 = ub - w + 15; rp = rpb + (krow - gr + 7) * 31; }
    }
    asm volatile("" ::: "memory");
    attn_compute(o, m, l, lbase + 8192, lbase, r, h, mode, a0, a1, rp);
    asm volatile("" ::: "memory");
    kv_sstore(g, lbase, lane);
  }
  asm volatile("" ::: "memory");
  const float lt = l + __shfl_xor(l, 32);
  const float inv = 1.f / lt;
  const int ocol = win ? hd * 64 : 512 + hd * 64;
#pragma unroll
  for (int dt = 0; dt < 2; ++dt)
#pragma unroll
    for (int g4 = 0; g4 < 4; ++g4) {
      const int d = dt * 32 + 8 * g4 + 4 * h;
      *(bf16x4*)(MIX + (size_t)(q_row0 + r) * 1024 + ocol + d) =
          pack4(o[dt][4 * g4] * inv, o[dt][4 * g4 + 1] * inv, o[dt][4 * g4 + 2] * inv, o[dt][4 * g4 + 3] * inv);
    }
}

DI void attn_phase(const DP& p, int j) {
  const int lane = p.tidl & 63;
  const int wg = p.bidl * 4 + (p.tidl >> 6), nw = gridDim.x * 4;
#pragma unroll 1
  for (int it = wg; it < 8448; it += nw) attn_item(p, j, it, lane);
}

#define XB_TMO      128
#define XB_XCNT(j)  (256  + 64 * (j))
#define XB_XSUB(j)  (1280 + 64 * (j))
#define XB_XGEN(j)  (2304 + 64 * (j))
#define XB_TOP      3328
#define XB_TOPGEN   3392
#define XCD_BAR_WORDS 3456
#define XB_SPIN_CAP (1u << 18)
#define LAS __attribute__((address_space(3)))

__device__ __forceinline__ unsigned xb_ld(unsigned* p)              { return __hip_atomic_load(p, __ATOMIC_RELAXED, __HIP_MEMORY_SCOPE_AGENT); }
__device__ __forceinline__ unsigned xb_add(unsigned* p, unsigned v) { return __hip_atomic_fetch_add(p, v, __ATOMIC_RELAXED, __HIP_MEMORY_SCOPE_AGENT); }
__device__ __forceinline__ unsigned xb_xcc_id() { return (unsigned)__builtin_amdgcn_s_getreg((3 << 11) | 20) & 0xFu; }
#define XB_SPIN(cond, bar) do { unsigned _sp = 0; while (cond) { __builtin_amdgcn_s_sleep(1); \
    if ((++_sp & 255u) == 0u) { if (xb_ld(&(bar)[XB_TMO])) break; if (_sp > XB_SPIN_CAP) { atomicAdd(&(bar)[XB_TMO], 1u); break; } } } } while (0)

struct XcdBarrier {
    unsigned* bar; unsigned x;
    volatile LAS unsigned* st;
};

__device__ __forceinline__ XcdBarrier xcd_barrier_post(unsigned* bar, volatile LAS unsigned* st) {
    XcdBarrier b; b.bar = bar; b.x = xb_xcc_id(); b.st = st;
    if (threadIdx.x == 0) (void)xb_add(&bar[XB_XCNT(b.x)], 1u);
    return b;
}
__device__ __forceinline__ void xcd_barrier_complete(unsigned* bar, unsigned x, unsigned& nloc, unsigned& nx) {
    const unsigned G = gridDim.x * gridDim.y * gridDim.z;
    unsigned sum, cnt, mine, sp = 0u;
    for (;;) {
        sum = 0u; cnt = 0u; mine = 0u;
#pragma unroll
        for (unsigned j = 0; j < 16; ++j) { const unsigned c = xb_ld(&bar[XB_XCNT(j)]); sum += c; cnt += (c > 0u) ? 1u : 0u; mine = (j == x) ? c : mine; }
        if (sum == G) break;
        __builtin_amdgcn_s_sleep(1);
        if ((++sp & 255u) == 0u) { if (xb_ld(&bar[XB_TMO])) break; if (sp > XB_SPIN_CAP) { atomicAdd(&bar[XB_TMO], 1u); break; } }
    }
    nloc = mine > 0u ? mine : 1u; nx = cnt > 0u ? cnt : 1u;
}

__device__ __forceinline__ void xcd_barrier(const XcdBarrier& b) {
    asm volatile("s_waitcnt vmcnt(0)" ::: "memory");
    __syncthreads();
    if (threadIdx.x == 0) {
        unsigned* bar = b.bar;
        __builtin_amdgcn_s_waitcnt(0);
        unsigned nloc = b.st[0], nx = b.st[1];
        if (nloc == 0u) { xcd_barrier_complete(bar, b.x, nloc, nx); b.st[0] = nloc; b.st[1] = nx; }
        const unsigned old = xb_add(&bar[XB_XSUB(b.x)], 1u);
        const unsigned gen = old / nloc;
        if (old + 1u == (gen + 1u) * nloc) {
            __builtin_amdgcn_fence(__ATOMIC_RELEASE, "agent");
            asm volatile("s_waitcnt vmcnt(0)" ::: "memory");
            const unsigned og = xb_add(&bar[XB_TOP], 1u);
            const unsigned tg = og / nx;
            if (og + 1u == (tg + 1u) * nx) xb_add(&bar[XB_TOPGEN], 1u);
            else XB_SPIN(xb_ld(&bar[XB_TOPGEN]) == tg, bar);
            __builtin_amdgcn_fence(__ATOMIC_ACQUIRE, "agent");
            xb_add(&bar[XB_XGEN(b.x)], 1u);
            asm volatile("s_waitcnt vmcnt(0)" ::: "memory");
        } else {
            XB_SPIN(xb_ld(&bar[XB_XGEN(b.x)]) == gen, bar);
            __builtin_amdgcn_fence(__ATOMIC_ACQUIRE, "agent");
            asm volatile("s_waitcnt vmcnt(0)" ::: "memory");
        }
    }
    __syncthreads();
}


DI void run_phase(const DP& p, int ph, int dry) {
  if (ph == 0) { phase0(p); wconv_phase(p, 0); return; }
  int q = ph - 1, layer, lp;
  if (q < 10) { layer = 0; lp = q; } else if (q < 17) { layer = 1; lp = q - 10; } else if (q < 27) { layer = 2; lp = q - 17; } else { layer = 3; lp = q - 27; }
  const int j = layer >> 1;
  const bool even = (layer & 1) == 0;
  int op, gsel = 0;
  if (even) {
    op = (int)((0x2272654321ull >> (4 * lp)) & 15ull); gsel = (int)((0x3201000000ull >> (4 * lp)) & 15ull);
  } else {
    op = (int)((0x2272921ull >> (4 * lp)) & 15ull); gsel = (int)((0x3201000ull >> (4 * lp)) & 15ull);
  }
  if (op == 1 && layer != 0) wconv_phase(p, layer);
  if (op == 1 || op == 7) {
    const bool first = op == 1;
    norm_phase(p, layer, (first ? p.norm_mix_g : p.norm_ff_g) + layer * 1024, first ? 0 : 3, first ? 1 : 4);
  } else if (op == 2) {
    int mode, lda, N, K, gch; size_t offA, offB;
    if (gsel == 0) { mode = even ? EPI_EVEN_IN : EPI_ODD_IN; offA = OFF_MIX; lda = 1024; offB = OFF_WIN; N = even ? 5168 : 2304; K = 1024; gch = 0; }
    else if (gsel == 1) { mode = EPI_RESID; offA = OFF_MIX; lda = even ? 2048 : 1024; offB = OFF_WOUT; N = 1024; K = even ? 2048 : 1024; gch = 2; }
    else if (gsel == 2) { mode = EPI_RELU2; offA = OFF_MIX; lda = 1024; offB = OFF_WFF1; N = 4096; K = 1024; gch = 0; }
    else { mode = EPI_RESID; offA = OFF_ACT; lda = 4096; offB = OFF_WFF2; N = 1024; K = 4096; gch = 5; }
    if (dry && mode == EPI_RESID) mode = 4;
    gemm_phase(p, mode, wsp<bfr>(p, offA), lda, wsp<bfr>(p, offB), N, K, layer, gch, (layer == 3 && gsel != 0) ? RL / 128 : R / 128);
  } else if (op == 3) conv_dt_phase(p, j);
  else if (op == 4) s1f1_phase(p);
  else if (op == 5) s2f2_phase(p, j);
  else if (op == 6) s3_phase(p, j);
  else if (op == 8) qkprep_phase(p, j);
  else if (op == 9) attn_phase(p, j);
}

DI int probe_reps(int ph) {
#ifdef PROBE_MASK
  if (ph == 0) return (PROBE_MASK & 1) ? 2 : 1;
  int q = ph - 1, layer, lp;
  if (q < 10) { layer = 0; lp = q; } else if (q < 17) { layer = 1; lp = q - 10; } else if (q < 27) { layer = 2; lp = q - 17; } else { layer = 3; lp = q - 27; }
  const bool even = (layer & 1) == 0;
  int op, gsel;
  if (even) { op = (int)((0x2272654321ull >> (4 * lp)) & 15ull); gsel = (int)((0x3201000000ull >> (4 * lp)) & 15ull); }
  else { op = (int)((0x2272921ull >> (4 * lp)) & 15ull); gsel = (int)((0x3201000ull >> (4 * lp)) & 15ull); }
  if (op == 5) return 1;
  if (op == 2 && (gsel == 1 || gsel == 3)) return ((PROBE_MASK >> 10) & 1) ? 2 : 1;
  return ((PROBE_MASK >> op) & 1) ? 2 : 1;
#else
  return 1;
#endif
}

__shared__ uint4 xb_words;

__global__ void __launch_bounds__(256, 2) mega(Params p, int ph0, int ph1) {
  cg::grid_group grid = cg::this_grid();
  if (threadIdx.x == 0) xb_words = make_uint4(0u, 0u, 0u, 0u);
  __syncthreads();
  XcdBarrier xb = xcd_barrier_post((unsigned*)(p.ws + OFF_BAR), (volatile LAS unsigned*)&xb_words);
#pragma unroll 1
  for (int ph = ph0; ph < ph1; ++ph) {
    const int nrep = probe_reps(ph);
#pragma unroll 1
    for (int rep = 0; rep < nrep; ++rep) {
      DP q;
      (Params&)q = p;
      int t = threadIdx.x, bb = blockIdx.x;
      asm volatile("" : "+v"(t));
      asm volatile("" : "+s"(bb));
      int z0;
      asm volatile("s_mov_b32 %0, 0" : "=s"(z0));
      q.ws = p.ws + z0;
      q.out = p.out + z0;
      q.tidl = t; q.bidl = bb;
      run_phase(q, ph, rep + 1 < nrep);
    }
    if (ph + 1 < ph1) {
      if (ph == ph0) grid.sync();
      else xcd_barrier(xb);
    }
  }
}

extern "C" void kernel_launch(void* const* d_in, const int* in_sizes, int n_in, void* d_out, int out_size, void* d_ws,
                              size_t ws_size, hipStream_t stream) {
  static int grid_blocks = 0;
  if (!grid_blocks) {
    int dev = 0, cus = 0, per_cu = 0;
    hipGetDevice(&dev);
    hipDeviceGetAttribute(&cus, hipDeviceAttributeMultiprocessorCount, dev);
    hipOccupancyMaxActiveBlocksPerMultiprocessor(&per_cu, mega, 256, 0);
    if (per_cu > 2) per_cu = 2;
    if (per_cu < 1) per_cu = 1;
    grid_blocks = cus * per_cu;
  }
  Params p{};
  const float** pp = (const float**)&p;
  for (int i = 0; i < 26; ++i) pp[i] = (const float*)d_in[i];
  p.out = (float*)d_out;
  p.ws = (unsigned char*)d_ws;
  if (ws_size < WS_TOTAL) fprintf(stderr, "workspace too small: %zu < %zu\n", ws_size, (size_t)WS_TOTAL);
  hipMemsetAsync((unsigned char*)d_ws + OFF_BAR, 0, XCD_BAR_WORDS * 4, stream);
#if MULTI_LAUNCH
  for (int ph = 0; ph < NPHASE; ++ph) {
    int a = ph, b = ph + 1;
    void* args[] = {&p, &a, &b};
    hipLaunchCooperativeKernel((void*)mega, dim3(grid_blocks), dim3(256), args, 0, stream);
  }
#else
  int a = 0, b = NPHASE;
  void* args[] = {&p, &a, &b};
  hipError_t e = hipLaunchCooperativeKernel((void*)mega, dim3(grid_blocks), dim3(256), args, 0, stream);
  if (e != hipSuccess) fprintf(stderr, "cooperative launch failed: %s (grid %d)\n", hipGetErrorString(e), grid_blocks);
#endif
}
```

```cpp
#include <hip/hip_runtime.h>
#include <hip/hip_cooperative_groups.h>
#include <cstdio>
namespace cg = cooperative_groups;

typedef unsigned short bfr;
typedef __attribute__((ext_vector_type(8))) short bf16x8;
typedef __attribute__((ext_vector_type(4))) short bf16x4;
typedef __attribute__((ext_vector_type(16))) float f32x16;
#define DI __device__ __forceinline__
#define MFMA(a, b, c) __builtin_amdgcn_mfma_f32_32x32x16_bf16((a), (b), (c), 0, 0, 0)

#ifndef MULTI_LAUNCH
#define MULTI_LAUNCH 0
#endif

constexpr int RL = 16384, R = 16896, SEQ = 8192, CTX = 256;
constexpr int NCH = 33, CL = 256;
constexpr int NPHASE = 35;

constexpr size_t al(size_t x) { return (x + 255) & ~size_t(255); }
constexpr size_t OFF_HC = 0;
constexpr size_t OFF_MOD = OFF_HC + al(512 * 1024 * 4);
constexpr size_t OFF_TW = OFF_MOD + al(4 * 3 * 6144 * 4);
constexpr size_t OFF_C128 = OFF_TW + al(8192 * 8);
constexpr size_t OFF_S128 = OFF_C128 + al(128 * 128 * 2);
constexpr size_t OFF_C64 = OFF_S128 + al(128 * 128 * 2);
constexpr size_t OFF_S64 = OFF_C64 + al(64 * 64 * 2);
constexpr size_t OFF_C256 = OFF_S64 + al(64 * 64 * 2);
constexpr size_t OFF_S256 = OFF_C256 + al(256 * 256 * 2);
constexpr size_t OFF_ROPE = OFF_S256 + al(256 * 256 * 2);
constexpr size_t OFF_DTV = OFF_ROPE + al(2 * 2 * 128 * 16 * 4);
constexpr size_t DT_BYTES = (size_t)2 * 2 * NCH * 24 * 256 * 4;
constexpr size_t OFF_ACUM = OFF_DTV + al(DT_BYTES);
constexpr size_t OFF_WIN = OFF_ACUM + al(DT_BYTES);
constexpr size_t OFF_WOUT = OFF_WIN + al((size_t)5248 * 1024 * 2);
constexpr size_t OFF_WFF1 = OFF_WOUT + al((size_t)1024 * 2048 * 2);
constexpr size_t OFF_WFF2 = OFF_WFF1 + al((size_t)4096 * 1024 * 2);
constexpr size_t OFF_MIX = OFF_WFF2 + al((size_t)4096 * 1024 * 2);
constexpr size_t OFF_BIG = OFF_MIX + al((size_t)R * 2048 * 2);
constexpr size_t OFF_Z = OFF_BIG;
constexpr size_t OFF_ZRT = OFF_Z + (size_t)R * 1536 * 2;
constexpr size_t OFF_ZIT = OFF_ZRT + (size_t)512 * R * 2;
constexpr size_t OFF_XBC = OFF_ZIT + (size_t)512 * R * 2;
constexpr size_t OFF_DTRAW = OFF_XBC + (size_t)R * 2560 * 2;
constexpr size_t BIG_END = OFF_DTRAW + (size_t)R * 48 * 4;
constexpr size_t OFF_HS = OFF_XBC;
constexpr size_t HS_BYTES = (size_t)2 * 2 * NCH * 24 * 8192 * 2;
constexpr size_t OFF_YR = OFF_HS + HS_BYTES;
constexpr size_t OFF_YI = OFF_YR + (size_t)2 * 512 * 128 * 64 * 2;
static_assert(OFF_YI + (size_t)2 * 512 * 128 * 64 * 2 <= OFF_DTRAW, "fft scratch overflows");
constexpr size_t OFF_ACT = OFF_BIG;
static_assert((size_t)R * 4096 * 2 <= BIG_END - OFF_BIG, "act overflows");
constexpr size_t OFF_P = OFF_BIG;
constexpr size_t OFF_VT = OFF_P + (size_t)R * 2304 * 2;
constexpr size_t OFF_QK = OFF_VT + (size_t)640 * R * 2;
static_assert(OFF_QK + (size_t)R * 1664 * 2 <= BIG_END, "odd overflows");
constexpr size_t OFF_XT = al(BIG_END);
constexpr size_t OFF_BN = OFF_XT + (size_t)1536 * R * 2;
constexpr size_t OFF_BT = OFF_BN + (size_t)R * 512 * 2;
constexpr size_t OFF_CN = OFF_BT + (size_t)512 * R * 2;
constexpr size_t OFF_BAR = al(OFF_CN + (size_t)R * 512 * 2);
constexpr size_t WS_TOTAL = OFF_BAR + 16384;
static_assert(WS_TOTAL <= 402653184ull, "workspace too large");

struct Params {
  const float *x, *c, *ctx, *c_ctx, *w_mod, *b_mod, *norm_mix_g, *norm_ff_g, *w_ff1, *w_ff2;
  const float *w_in_even, *conv_w, *conv_b, *dt_bias, *a_log, *d_skip, *ssd_norm_g, *w_out_even;
  const float *w_in_odd, *q_norm_win, *k_norm_win, *sink_win, *q_norm_na, *k_norm_na, *rpb_na, *w_out_odd;
  float* out;
  unsigned char* ws;
};

struct DP : Params { int tidl, bidl; };

__shared__ __attribute__((aligned(16))) unsigned char smem[73728];

typedef __attribute__((ext_vector_type(2))) __bf16 bf2_t;
typedef __attribute__((ext_vector_type(2))) float f2_t;
typedef __attribute__((ext_vector_type(4))) unsigned u32x4_t;
typedef __attribute__((ext_vector_type(2))) unsigned u32x2_t;
DI unsigned pk2(float a, float b) { f2_t v = {a, b}; return __builtin_bit_cast(unsigned, __builtin_convertvector(v, bf2_t)); }
DI bfr f2bf(float x) { return (bfr)(pk2(x, 0.f) & 0xffffu); }
DI float bf2f(bfr b) { return __uint_as_float(((unsigned)b) << 16); }
DI float bfs(short s) { return __uint_as_float(((unsigned)(unsigned short)s) << 16); }
DI int crow(int i, int h) { return (i & 3) + 8 * (i >> 2) + 4 * h; }
DI f32x16 zero16() { f32x16 z; for (int i = 0; i < 16; ++i) z[i] = 0.f; return z; }
DI bf16x8 pack8(float a0, float a1, float a2, float a3, float a4, float a5, float a6, float a7) {
  u32x4_t v = {pk2(a0, a1), pk2(a2, a3), pk2(a4, a5), pk2(a6, a7)};
  return __builtin_bit_cast(bf16x8, v);
}
DI bf16x4 pack4(float a0, float a1, float a2, float a3) {
  u32x2_t v = {pk2(a0, a1), pk2(a2, a3)};
  return __builtin_bit_cast(bf16x4, v);
}
#define PACK_HALF(s, s2) pack8(s[8 * (s2)], s[8 * (s2) + 1], s[8 * (s2) + 2], s[8 * (s2) + 3], s[8 * (s2) + 4], s[8 * (s2) + 5], s[8 * (s2) + 6], s[8 * (s2) + 7])
DI bf16x8 join44(bf16x4 lo, bf16x4 hi) { return __builtin_shufflevector(lo, hi, 0, 1, 2, 3, 4, 5, 6, 7); }
DI int chunk_row0(int b, int c) { return c == 0 ? RL + b * CTX : b * SEQ + (c - 1) * CL; }

DI void sincos_turn(double f, float& s, float& c) {
  f -= rint(f);
  double x = f * 6.283185307179586476925;
  double x2 = x * x, ss = 1.0, cc = 1.0;
#pragma unroll
  for (int k = 13; k >= 1; --k) {
    ss = 1.0 - x2 / (double)((2 * k) * (2 * k + 1)) * ss;
    cc = 1.0 - x2 / (double)((2 * k - 1) * (2 * k)) * cc;
  }
  s = (float)(x * ss); c = (float)cc;
}

template <class T> DI T* wsp(const DP& p, size_t off) { return (T*)(p.ws + off); }

DI void phase0(const DP& p) {
  const int tid = p.tidl, bid = p.bidl, G = gridDim.x;
  float* lds = (float*)smem;
  float* MOD = wsp<float>(p, OFF_MOD);
  for (int u = bid; u < 384; u += G) {
    int layer = u / 96, cb = u % 96;
    for (int i = tid; i < 3072; i += 256) {
      int v = i >> 10, k = i & 1023;
      float c = v < 2 ? p.c[v * 1024 + k] : p.c_ctx[k];
      lds[i] = c / (1.f + expf(-c));
    }
    __syncthreads();
    int kq = tid >> 6, cc = tid & 63, col = cb * 64 + cc;
    const float* w = p.w_mod + (size_t)layer * 1024 * 6144 + col;
    float a0 = 0, a1 = 0, a2 = 0;
    for (int k = kq * 256; k < kq * 256 + 256; ++k) {
      float wv = w[(size_t)k * 6144];
      a0 += lds[k] * wv; a1 += lds[1024 + k] * wv; a2 += lds[2048 + k] * wv;
    }
    float* red = lds + 3072;
    red[(kq * 3 + 0) * 64 + cc] = a0; red[(kq * 3 + 1) * 64 + cc] = a1; red[(kq * 3 + 2) * 64 + cc] = a2;
    __syncthreads();
    if (tid < 192) {
      int v = tid >> 6;
      float s = red[(0 * 3 + v) * 64 + cc] + red[(1 * 3 + v) * 64 + cc] + red[(2 * 3 + v) * 64 + cc] + red[(3 * 3 + v) * 64 + cc];
      MOD[(layer * 3 + v) * 6144 + col] = s + p.b_mod[layer * 6144 + col];
    }
    __syncthreads();
  }
  const int gt = bid * 256 + tid, nt = G * 256;
  {
    const float4* xs = (const float4*)p.x; float4* od = (float4*)p.out;
    for (int i = gt; i < RL * 256; i += 4 * nt) {
      float4 t4[4];
#pragma unroll
      for (int q = 0; q < 4; ++q) { const int ii = i + q * nt; t4[q] = ii < RL * 256 ? xs[ii] : make_float4(0.f, 0.f, 0.f, 0.f); }
#pragma unroll
      for (int q = 0; q < 4; ++q) { const int ii = i + q * nt; if (ii < RL * 256) od[ii] = t4[q]; }
    }
    const float4* cs = (const float4*)p.ctx; float4* hd = wsp<float4>(p, OFF_HC);
    for (int i = gt; i < 512 * 256; i += nt) hd[i] = cs[i];
  }
  float2* TW = wsp<float2>(p, OFF_TW);
  for (int i = gt; i < 8192; i += nt) { float s, c; sincos_turn((double)i / 8192.0, s, c); TW[i] = make_float2(c, s); }
  bfr* C128 = wsp<bfr>(p, OFF_C128); bfr* S128 = wsp<bfr>(p, OFF_S128);
  for (int i = gt; i < 128 * 128; i += nt) { int a = i >> 7, b = i & 127; float s, c; sincos_turn((double)((a * b) & 127) / 128.0, s, c); C128[i] = f2bf(c); S128[i] = f2bf(s); }
  bfr* C64 = wsp<bfr>(p, OFF_C64); bfr* S64 = wsp<bfr>(p, OFF_S64);
  for (int i = gt; i < 64 * 64; i += nt) { int a = i >> 6, b = i & 63; float s, c; sincos_turn((double)((a * b) & 63) / 64.0, s, c); C64[i] = f2bf(c); S64[i] = f2bf(s); }
  bfr* C256 = wsp<bfr>(p, OFF_C256); bfr* S256 = wsp<bfr>(p, OFF_S256);
  for (int i = gt; i < 256 * 256; i += nt) { int a = i >> 8, b = i & 255; float s, c; sincos_turn((double)((a * b) & 255) / 256.0, s, c); C256[i] = f2bf(c); S256[i] = f2bf(s); }
  float* ROPE = wsp<float>(p, OFF_ROPE);
  for (int i = gt; i < 2 * 128 * 16; i += nt) {
    int f = i & 15, idx = (i >> 4) & 127;
    float ang = (float)idx * (float)exp(-(double)f * 0.5756462732485115);
    float s, c; sincos_turn((double)ang / 6.283185307179586476925, s, c);
    ROPE[i] = c; ROPE[4096 + i] = s;
  }
}

DI void tcvt_unit(const float* __restrict__ src, int ld, int c0, int ncols, int K, bfr* __restrict__ dst, int dr0, int u, int tid) {
  const int ntk = K >> 6;
  const int tn = u / ntk, tk = u % ntk, k0 = tk * 64, nb = tn * 64;
  bfr* T = (bfr*)smem;
  float4 v[4];
  const int n4 = (tid & 15) * 4;
#pragma unroll
  for (int i = 0; i < 4; ++i) {
    const int kk = (tid >> 4) + 16 * i;
    v[i] = make_float4(0.f, 0.f, 0.f, 0.f);
    if (nb + n4 < ncols) v[i] = *(const float4*)(src + (size_t)(k0 + kk) * ld + c0 + nb + n4);
  }
#pragma unroll
  for (int i = 0; i < 4; ++i) {
    const int kk = (tid >> 4) + 16 * i;
    T[(n4 + 0) * 72 + kk] = f2bf(v[i].x); T[(n4 + 1) * 72 + kk] = f2bf(v[i].y);
    T[(n4 + 2) * 72 + kk] = f2bf(v[i].z); T[(n4 + 3) * 72 + kk] = f2bf(v[i].w);
  }
  __syncthreads();
  {
    int n = tid >> 2, kseg = (tid & 3) * 16;
    if (nb + n < ncols) {
      bfr* d = dst + (size_t)(dr0 + nb + n) * K + k0 + kseg;
      *(bf16x8*)d = *(const bf16x8*)(T + n * 72 + kseg);
      *(bf16x8*)(d + 8) = *(const bf16x8*)(T + n * 72 + kseg + 8);
    }
  }
  __syncthreads();
}

DI void wconv_phase(const DP& p, int layer) {
  const int tid = p.tidl;
  const int j = layer >> 1;
  bfr* WIN = wsp<bfr>(p, OFF_WIN); bfr* WOUT = wsp<bfr>(p, OFF_WOUT);
  bfr* WFF1 = wsp<bfr>(p, OFF_WFF1); bfr* WFF2 = wsp<bfr>(p, OFF_WFF2);
  const float* ff1 = p.w_ff1 + (size_t)layer * 1024 * 4096;
  const float* ff2 = p.w_ff2 + (size_t)layer * 4096 * 1024;
  float* cst = (float*)(smem + 20480);
  if (tid < 64) { float s, c; sincos_turn((double)tid / 64.0, s, c); cst[tid] = c; cst[64 + tid] = s; }
  __syncthreads();
  if ((layer & 1) == 0) {
    const float* win = p.w_in_even + (size_t)j * 1024 * 4656;
    const float* wout = p.w_out_even + (size_t)j * 2048 * 1024;
    const int n_in = 65 * 16, n_out = 16 * 32, n_f1 = 64 * 16, n_f2 = 16 * 64, n_fold = 128;
    const int total = n_in + n_out + n_f1 + n_f2 + n_fold;
    for (int u = p.bidl; u < total; u += gridDim.x) {
      int v = u;
      if (v < n_in) { tcvt_unit(win, 4656, 512, 4144, 1024, WIN, 1024, v, tid); continue; }
      v -= n_in;
      if (v < n_out) { tcvt_unit(wout, 1024, 0, 1024, 2048, WOUT, 0, v, tid); continue; }
      v -= n_out;
      if (v < n_f1) { tcvt_unit(ff1, 4096, 0, 4096, 1024, WFF1, 0, v, tid); continue; }
      v -= n_f1;
      if (v < n_f2) { tcvt_unit(ff2, 1024, 0, 1024, 4096, WFF2, 0, v, tid); continue; }
      v -= n_f2;
      {
        const int g = v >> 4, kb = v & 15;
        float* wt = (float*)smem;
#pragma unroll
        for (int i = 0; i < 4; ++i) {
          const int idx = tid + 256 * i, kk = idx >> 4, j4 = (idx & 15) * 4;
          const float4 wv = *(const float4*)(win + (size_t)(kb * 64 + kk) * 4656 + g * 64 + j4);
          wt[kk * 65 + j4] = wv.x; wt[kk * 65 + j4 + 1] = wv.y; wt[kk * 65 + j4 + 2] = wv.z; wt[kk * 65 + j4 + 3] = wv.w;
        }
        __syncthreads();
        const int kl = tid & 63, mg = tid >> 6;
#pragma unroll 1
        for (int mi = 0; mi < 16; ++mi) {
          const int m = mg * 16 + mi;
          float sc = 0.f, ss = 0.f;
#pragma unroll 8
          for (int jj = 0; jj < 64; ++jj) { const float w = wt[kl * 65 + jj]; const int idx = (m * jj) & 63; sc += w * cst[idx]; ss += w * cst[64 + idx]; }
          const int ch = g * 64 + m, k = kb * 64 + kl;
          WIN[(size_t)ch * 1024 + k] = f2bf(sc);
          WIN[(size_t)(512 + ch) * 1024 + k] = f2bf(-ss);
        }
        __syncthreads();
      }
    }
  } else {
    const float* win = p.w_in_odd + (size_t)j * 1024 * 2304;
    const float* wout = p.w_out_odd + (size_t)j * 1024 * 1024;
    const int n_in = 36 * 16, n_out = 16 * 16, n_f1 = 64 * 16, n_f2 = 16 * 64;
    const int total = n_in + n_out + n_f1 + n_f2;
    for (int u = p.bidl; u < total; u += gridDim.x) {
      int v = u;
      if (v < n_in) { tcvt_unit(win, 2304, 0, 2304, 1024, WIN, 0, v, tid); continue; }
      v -= n_in;
      if (v < n_out) { tcvt_unit(wout, 1024, 0, 1024, 1024, WOUT, 0, v, tid); continue; }
      v -= n_out;
      if (v < n_f1) { tcvt_unit(ff1, 4096, 0, 4096, 1024, WFF1, 0, v, tid); continue; }
      v -= n_f1;
      tcvt_unit(ff2, 1024, 0, 1024, 4096, WFF2, 0, v, tid);
    }
  }
}

DI void norm_phase(const DP& p, int layer, const float* __restrict__ gvec, int shc, int scc) {
  const int lane = p.tidl & 63;
  const int wg = p.bidl * 4 + (p.tidl >> 6), nw = gridDim.x * 4;
  const float* MOD = wsp<float>(p, OFF_MOD);
  const float* HC = wsp<float>(p, OFF_HC);
  bfr* U = wsp<bfr>(p, OFF_MIX);
#pragma unroll 1
  for (int row0 = wg; row0 < R; row0 += 2 * nw) {
    float4 v[2][4]; float ss[2] = {0.f, 0.f};
#pragma unroll
    for (int q = 0; q < 2; ++q) {
      const int row = row0 + q * nw < R ? row0 + q * nw : row0;
      const float* hp = row < RL ? p.out + (size_t)row * 1024 : HC + (size_t)(row - RL) * 1024;
#pragma unroll
      for (int i = 0; i < 4; ++i) v[q][i] = *(const float4*)(hp + i * 256 + lane * 4);
    }
#pragma unroll
    for (int q = 0; q < 2; ++q) {
#pragma unroll
      for (int i = 0; i < 4; ++i) ss[q] += v[q][i].x * v[q][i].x + v[q][i].y * v[q][i].y + v[q][i].z * v[q][i].z + v[q][i].w * v[q][i].w;
#pragma unroll
      for (int o = 32; o >= 1; o >>= 1) ss[q] += __shfl_xor(ss[q], o);
    }
#pragma unroll
    for (int q = 0; q < 2; ++q) {
      const int row = row0 + q * nw;
      if (row >= R) continue;
      const int ms = row < RL ? (row >> 13) : 2;
      const float* md = MOD + (layer * 3 + ms) * 6144;
      const float rs = rsqrtf(ss[q] * (1.f / 1024.f) + 1e-6f);
#pragma unroll
      for (int i = 0; i < 4; ++i) {
        int col = i * 256 + lane * 4;
        float4 g = *(const float4*)(gvec + col);
        float4 sc = *(const float4*)(md + scc * 1024 + col);
        float4 sh = *(const float4*)(md + shc * 1024 + col);
        bf16x4 o = pack4(v[q][i].x * rs * g.x * (1.f + sc.x) + sh.x, v[q][i].y * rs * g.y * (1.f + sc.y) + sh.y,
                         v[q][i].z * rs * g.z * (1.f + sc.z) + sh.z, v[q][i].w * rs * g.w * (1.f + sc.w) + sh.w);
        *(bf16x4*)(U + (size_t)row * 1024 + col) = o;
      }
    }
  }
}

enum { EPI_EVEN_IN = 0, EPI_ODD_IN = 1, EPI_RELU2 = 2, EPI_RESID = 3 };

DI void gemm_phase(const DP& p, int mode, const bfr* __restrict__ A, int lda, const bfr* __restrict__ Bt,
                   int N, int K, int layer, int gchunk, int nM) {
  const int tid = p.tidl, lane = tid & 63, wid = tid >> 6, r = lane & 31, h = lane >> 5;
  const int wm = wid >> 1, wn = wid & 1;
  const int nN = (N + 127) >> 7;
  const int tiles = nM * nN, G = (int)gridDim.x;
  int full = tiles, tail = 0, St = 1;
  if (mode == EPI_RESID) {
    full = (tiles / G) * G; tail = tiles - full;
    if (tail > 0) { int c = G / tail; int kmax = K >> 7; St = 1; while (St * 2 <= c && St * 2 <= 16 && St * 2 <= kmax) St *= 2; }
  }
  const int chunk = (full + 7) >> 3;
  const int units = chunk * 8 + tail * St;
  bfr* sm = (bfr*)smem;
  const int lrow = tid >> 3, lc = (tid & 7) * 8;
#pragma unroll 1
  for (int u = p.bidl; u < units; u += G) {
    int t, ks, Ks; bool atom;
    if (u < chunk * 8) {
      t = (u & 7) * chunk + (u >> 3);
      if (t >= full) continue;
      ks = 0; Ks = K; atom = false;
    } else { const int v = u - chunk * 8; t = full + v / St; ks = v % St; Ks = K / St; atom = St > 1; }
    const int nk = Ks >> 6;
    const int panel = t / (nM * 8); const int rem = t - panel * nM * 8;
    const int pw = (nN - panel * 8) < 8 ? (nN - panel * 8) : 8;
    const int tm = rem / pw, tn = panel * 8 + rem % pw;
    const int m0 = tm * 128, n0 = tn * 128, kbase = ks * Ks;
    f32x16 acc[2][2];
    acc[0][0] = zero16(); acc[0][1] = zero16(); acc[1][0] = zero16(); acc[1][1] = zero16();
    const bfr* Ag = A + (size_t)(m0 + lrow) * lda + kbase + lc;
    const bfr* Bg = Bt + (size_t)(n0 + lrow) * K + kbase + lc;
    bf16x8 ra[4], rb[4];
#pragma unroll
    for (int i = 0; i < 4; ++i) {
      ra[i] = *(const bf16x8*)(Ag + (size_t)(32 * i) * lda);
      rb[i] = *(const bf16x8*)(Bg + (size_t)(32 * i) * K);
    }
#pragma unroll
    for (int i = 0; i < 4; ++i) {
      *(bf16x8*)(sm + (lrow + 32 * i) * 72 + lc) = ra[i];
      *(bf16x8*)(sm + 9216 + (lrow + 32 * i) * 72 + lc) = rb[i];
    }
    if (nk > 1) {
#pragma unroll
      for (int i = 0; i < 4; ++i) {
        ra[i] = *(const bf16x8*)(Ag + (size_t)(32 * i) * lda + 64);
        rb[i] = *(const bf16x8*)(Bg + (size_t)(32 * i) * K + 64);
      }
    }
    __syncthreads();
#pragma unroll 1
    for (int kt = 0; kt < nk; ++kt) {
      if (kt + 1 < nk) {
        bfr* Ad = sm + ((kt + 1) & 1) * 18432;
#pragma unroll
        for (int i = 0; i < 4; ++i) {
          *(bf16x8*)(Ad + (lrow + 32 * i) * 72 + lc) = ra[i];
          *(bf16x8*)(Ad + 9216 + (lrow + 32 * i) * 72 + lc) = rb[i];
        }
      }
      if (kt + 2 < nk) {
#pragma unroll
        for (int i = 0; i < 4; ++i) {
          ra[i] = *(const bf16x8*)(Ag + (size_t)(32 * i) * lda + (kt + 2) * 64);
          rb[i] = *(const bf16x8*)(Bg + (size_t)(32 * i) * K + (kt + 2) * 64);
        }
      }
      const bfr* As = sm + (kt & 1) * 18432;
      const bfr* Bs = As + 9216;
      __builtin_amdgcn_s_setprio(1);
#pragma unroll
      for (int kk = 0; kk < 4; ++kk) {
        bf16x8 a0 = *(const bf16x8*)(As + (wm * 64 + r) * 72 + kk * 16 + h * 8);
        bf16x8 a1 = *(const bf16x8*)(As + (wm * 64 + 32 + r) * 72 + kk * 16 + h * 8);
        bf16x8 b0 = *(const bf16x8*)(Bs + (wn * 64 + r) * 72 + kk * 16 + h * 8);
        bf16x8 b1 = *(const bf16x8*)(Bs + (wn * 64 + 32 + r) * 72 + kk * 16 + h * 8);
        acc[0][0] = MFMA(a0, b0, acc[0][0]);
        acc[0][1] = MFMA(a0, b1, acc[0][1]);
        acc[1][0] = MFMA(a1, b0, acc[1][0]);
        acc[1][1] = MFMA(a1, b1, acc[1][1]);
      }
      __builtin_amdgcn_s_setprio(0);
      __syncthreads();
    }
    if (mode == EPI_RESID && !atom) {
      float hv[2][2][16], gt2[2][2];
#pragma unroll
      for (int mi = 0; mi < 2; ++mi)
#pragma unroll
        for (int ni = 0; ni < 2; ++ni) {
          const int col = n0 + wn * 64 + ni * 32 + r;
          const int rowb = m0 + wm * 64 + mi * 32 + 4 * h;
          const int ms = rowb < RL ? (rowb >> 13) : 2;
          gt2[mi][ni] = wsp<float>(p, OFF_MOD)[(layer * 3 + ms) * 6144 + gchunk * 1024 + col];
          const float* hp = rowb < RL ? p.out + (size_t)rowb * 1024 + col : wsp<float>(p, OFF_HC) + (size_t)(rowb - RL) * 1024 + col;
#pragma unroll
          for (int i = 0; i < 16; ++i) hv[mi][ni][i] = hp[(size_t)((i & 3) + 8 * (i >> 2)) * 1024];
        }
#pragma unroll
      for (int mi = 0; mi < 2; ++mi)
#pragma unroll
        for (int ni = 0; ni < 2; ++ni) {
          const int col = n0 + wn * 64 + ni * 32 + r;
          const int rowb = m0 + wm * 64 + mi * 32 + 4 * h;
          float* hp = rowb < RL ? p.out + (size_t)rowb * 1024 + col : wsp<float>(p, OFF_HC) + (size_t)(rowb - RL) * 1024 + col;
#pragma unroll
          for (int i = 0; i < 16; ++i) hp[(size_t)((i & 3) + 8 * (i >> 2)) * 1024] = hv[mi][ni][i] + gt2[mi][ni] * acc[mi][ni][i];
        }
      continue;
    }
    const int cbw = n0 + wn * 64;
    const bool qkfuse = mode == EPI_ODD_IN && !((cbw >= 640 && cbw < 768) || cbw >= 1792);
    if (qkfuse) {
      float* T = (float*)smem + wid * 4160;
#pragma unroll
      for (int mi = 0; mi < 2; ++mi)
#pragma unroll
        for (int ni = 0; ni < 2; ++ni)
#pragma unroll
          for (int i = 0; i < 16; ++i) T[(mi * 32 + crow(i, h)) * 65 + ni * 32 + r] = acc[mi][ni][i];
      asm volatile("s_waitcnt lgkmcnt(0)" ::: "memory");
      const int hs = cbw < 640 ? (cbw >> 6) : 10 + ((cbw - 768) >> 6);
      const int jj = layer >> 1;
      const float* gv = hs < 8 ? p.q_norm_win + jj * 64 : hs < 10 ? p.k_norm_win + jj * 64 : hs < 18 ? p.q_norm_na + jj * 64 : p.k_norm_na + jj * 64;
      const float qs = (hs < 8 || (hs >= 10 && hs < 18)) ? 0.125f : 1.f;
      const int row = m0 + wm * 64 + lane;
      float ss = 0.f;
#pragma unroll
      for (int d = 0; d < 64; ++d) { const float t = T[lane * 65 + d]; ss += t * t; }
      const float rs = rsqrtf(ss * (1.f / 64.f) + 1e-6f);
      const bool dorope = hs < 10 && row < RL;
      const float* ROPE = wsp<float>(p, OFF_ROPE);
      const int pos = row & 8191;
      bfr* dst = wsp<bfr>(p, OFF_QK) + (size_t)row * 1664 + hs * 64;
#pragma unroll
      for (int a = 0; a < 2; ++a) {
        float x[32];
#pragma unroll
        for (int d = 0; d < 32; ++d) x[d] = T[lane * 65 + a * 32 + d] * rs * gv[a * 32 + d];
        if (dorope) {
          const int idx = a == 0 ? (pos >> 6) : 128 + (pos & 63);
#pragma unroll
          for (int f4 = 0; f4 < 4; ++f4) {
            const float4 c4 = *(const float4*)(ROPE + idx * 16 + f4 * 4), s4 = *(const float4*)(ROPE + 4096 + idx * 16 + f4 * 4);
            const float cc[4] = {c4.x, c4.y, c4.z, c4.w}, sn[4] = {s4.x, s4.y, s4.z, s4.w};
#pragma unroll
            for (int q = 0; q < 4; ++q) {
              const int f = f4 * 4 + q;
              const float x1 = x[f], x2 = x[16 + f];
              x[f] = x1 * cc[q] - x2 * sn[q];
              x[16 + f] = x2 * cc[q] + x1 * sn[q];
            }
          }
        }
#pragma unroll
        for (int k8 = 0; k8 < 4; ++k8)
          *(bf16x8*)(dst + a * 32 + k8 * 8) = pack8(x[k8 * 8] * qs, x[k8 * 8 + 1] * qs, x[k8 * 8 + 2] * qs, x[k8 * 8 + 3] * qs,
                                                    x[k8 * 8 + 4] * qs, x[k8 * 8 + 5] * qs, x[k8 * 8 + 6] * qs, x[k8 * 8 + 7] * qs);
      }
    }
    if (!qkfuse)
#pragma unroll
    for (int mi = 0; mi < 2; ++mi)
#pragma unroll
      for (int ni = 0; ni < 2; ++ni)
#pragma unroll
        for (int g4 = 0; g4 < 4; ++g4) {
          const int row = m0 + wm * 64 + mi * 32 + 8 * g4 + 4 * h;
          const int col = n0 + wn * 64 + ni * 32 + r;
          const float v0 = acc[mi][ni][4 * g4], v1 = acc[mi][ni][4 * g4 + 1], v2 = acc[mi][ni][4 * g4 + 2], v3 = acc[mi][ni][4 * g4 + 3];
          if (mode == EPI_EVEN_IN) {
            if (col < 1024) {
              bfr* dst = wsp<bfr>(p, col < 512 ? OFF_ZRT : OFF_ZIT) + (size_t)(col & 511) * R + row;
              *(bf16x4*)dst = pack4(v0, v1, v2, v3);
            } else if (col < 2560) {
              bfr* dst = wsp<bfr>(p, OFF_Z) + (size_t)row * 1536 + (col - 1024);
              dst[0] = f2bf(v0); dst[1536] = f2bf(v1); dst[2 * 1536] = f2bf(v2); dst[3 * 1536] = f2bf(v3);
            } else if (col < 5120) {
              bfr* dst = wsp<bfr>(p, OFF_XBC) + (size_t)row * 2560 + (col - 2560);
              dst[0] = f2bf(v0); dst[2560] = f2bf(v1); dst[2 * 2560] = f2bf(v2); dst[3 * 2560] = f2bf(v3);
            } else if (col < 5168) {
              float* dst = wsp<float>(p, OFF_DTRAW) + (size_t)row * 48 + (col - 5120);
              dst[0] = v0; dst[48] = v1; dst[96] = v2; dst[144] = v3;
            }
          } else if (mode == EPI_ODD_IN) {
            if (col >= 640 && col < 768) {
              *(bf16x4*)(wsp<bfr>(p, OFF_VT) + (size_t)(col - 640) * R + row) = pack4(v0, v1, v2, v3);
            } else if (col >= 1792) {
              *(bf16x4*)(wsp<bfr>(p, OFF_VT) + (size_t)(128 + col - 1792) * R + row) = pack4(v0, v1, v2, v3);
            } else {
              bfr* dst = wsp<bfr>(p, OFF_P) + (size_t)row * 2304 + col;
              dst[0] = f2bf(v0); dst[2304] = f2bf(v1); dst[2 * 2304] = f2bf(v2); dst[3 * 2304] = f2bf(v3);
            }
          } else if (mode == EPI_RELU2) {
            bfr* dst = wsp<bfr>(p, OFF_ACT) + (size_t)row * 4096 + col;
            float t0 = fmaxf(v0, 0.f), t1 = fmaxf(v1, 0.f), t2 = fmaxf(v2, 0.f), t3 = fmaxf(v3, 0.f);
            dst[0] = f2bf(t0 * t0); dst[4096] = f2bf(t1 * t1); dst[2 * 4096] = f2bf(t2 * t2); dst[3 * 4096] = f2bf(t3 * t3);
          } else if (mode == EPI_RESID) {
            const int ms = row < RL ? (row >> 13) : 2;
            const float gate = wsp<float>(p, OFF_MOD)[(layer * 3 + ms) * 6144 + gchunk * 1024 + col];
            float* hp = row < RL ? p.out + (size_t)row * 1024 + col : wsp<float>(p, OFF_HC) + (size_t)(row - RL) * 1024 + col;
            if (atom) {
              unsafeAtomicAdd(hp, gate * v0); unsafeAtomicAdd(hp + 1024, gate * v1);
              unsafeAtomicAdd(hp + 2048, gate * v2); unsafeAtomicAdd(hp + 3072, gate * v3);
            } else {
              hp[0] += gate * v0; hp[1024] += gate * v1; hp[2048] += gate * v2; hp[3072] += gate * v3;
            }
          }
        }
    if (mode == EPI_ODD_IN) __syncthreads();
  }
}

DI float softplus_f(float x) { return x > 0.f ? x + log1pf(expf(-x)) : log1pf(expf(x)); }

DI void conv_dt_phase(const DP& p, int j) {
  const int tid = p.tidl, lane = tid & 63, wid = tid >> 6;
  const bfr* XBC = wsp<bfr>(p, OFF_XBC);
  bfr* XT = wsp<bfr>(p, OFF_XT); bfr* BN = wsp<bfr>(p, OFF_BN); bfr* BTt = wsp<bfr>(p, OFF_BT); bfr* CN = wsp<bfr>(p, OFF_CN);
  bfr* TT = (bfr*)smem;
  const float* cw = p.conv_w + (size_t)j * 5 * 2560;
  const float* cb = p.conv_b + (size_t)j * 2560;
  const int n_conv = 264 * 40, n_dt = 792;
  for (int u = p.bidl; u < n_conv + n_dt; u += gridDim.x) {
    if (u < n_conv) {
      const int tb = u / 40, cbk = u % 40, row0 = tb * 64, ch0 = cbk * 64;
      int pos0, len;
      if (row0 < RL) { pos0 = row0 & 8191; len = SEQ; } else { pos0 = (row0 - RL) & 255; len = CTX; }
      const int c8 = tid & 7, ch = ch0 + c8 * 8;
      float w[5][8], bias[8];
#pragma unroll
      for (int k = 0; k < 5; ++k) {
        float4 wa = *(const float4*)(cw + k * 2560 + ch), wb = *(const float4*)(cw + k * 2560 + ch + 4);
        w[k][0] = wa.x; w[k][1] = wa.y; w[k][2] = wa.z; w[k][3] = wa.w; w[k][4] = wb.x; w[k][5] = wb.y; w[k][6] = wb.z; w[k][7] = wb.w;
      }
      {
        float4 wa = *(const float4*)(cb + ch), wb = *(const float4*)(cb + ch + 4);
        bias[0] = wa.x; bias[1] = wa.y; bias[2] = wa.z; bias[3] = wa.w; bias[4] = wb.x; bias[5] = wb.y; bias[6] = wb.z; bias[7] = wb.w;
      }
#pragma unroll
      for (int ps = 0; ps < 2; ++ps) {
        const int tl = (tid >> 3) + 32 * ps, pos = pos0 + tl, row = row0 + tl;
        float a[8];
#pragma unroll
        for (int e = 0; e < 8; ++e) a[e] = bias[e];
        bf16x8 xr[5];
#pragma unroll
        for (int k = 0; k < 5; ++k) {
          const int pp = pos + k - 2;
          const bool ok = pp >= 0 && pp < len;
          const bfr* xp = XBC + (size_t)(ok ? row + k - 2 : row) * 2560 + ch;
          xr[k] = *(const bf16x8*)xp;
          if (!ok) { for (int e = 0; e < 8; ++e) xr[k][e] = 0; }
        }
#pragma unroll
        for (int k = 0; k < 5; ++k)
#pragma unroll
          for (int e = 0; e < 8; ++e) a[e] += w[k][e] * bfs(xr[k][e]);
        bf16x8 o;
#pragma unroll
        for (int e = 0; e < 8; ++e) { float s = a[e] / (1.f + __expf(-a[e])); o[e] = (short)f2bf(s); }
        if (ch0 >= 2048) *(bf16x8*)(CN + (size_t)row * 512 + (ch - 2048)) = o;
        else if (ch0 >= 1536) *(bf16x8*)(BN + (size_t)row * 512 + (ch - 1536)) = o;
        if (ch0 < 2048) {
#pragma unroll
          for (int e = 0; e < 8; ++e) TT[(c8 * 8 + e) * 72 + tl] = (bfr)o[e];
        }
      }
      if (ch0 < 2048) {
        __syncthreads();
        const int chl = tid >> 2, tseg = (tid & 3) * 16;
        bfr* dst = (ch0 < 1536 ? XT + (size_t)(ch0 + chl) * R : BTt + (size_t)(ch0 - 1536 + chl) * R) + row0 + tseg;
        *(bf16x8*)dst = *(const bf16x8*)(TT + chl * 72 + tseg);
        *(bf16x8*)(dst + 8) = *(const bf16x8*)(TT + chl * 72 + tseg + 8);
        __syncthreads();
      }
    } else {
      const int item = (u - n_conv) * 4 + wid;
      const int head = item % 24; int rest = item / 24; const int dir = rest & 1; rest >>= 1; const int c = rest % NCH, b = rest / NCH;
      const int row0 = chunk_row0(b, c), col = dir * 24 + head;
      const float bias = p.dt_bias[j * 48 + col];
      const float a = -expf(p.a_log[j * 48 + col]);
      const float* DTRAW = wsp<float>(p, OFF_DTRAW);
      float dt[4], cs[4];
      float run = 0.f;
#pragma unroll
      for (int q = 0; q < 4; ++q) {
        dt[q] = softplus_f(DTRAW[(size_t)(row0 + lane * 4 + q) * 48 + col] + bias);
        run += dt[q] * a; cs[q] = run;
      }
      float x = run;
#pragma unroll
      for (int o = 1; o < 64; o <<= 1) { float t2 = __shfl_up(x, o); if (lane >= o) x += t2; }
      const float excl = x - run;
      const float total = __shfl(x, 63);
      float ac[4];
#pragma unroll
      for (int q = 0; q < 4; ++q) {
        float inc = excl + cs[q];
        ac[q] = dir == 0 ? inc : total - inc + dt[q] * a;
      }
      const size_t base = ((size_t)(((dir * 2 + b) * NCH + c) * 24 + head)) * 256 + lane * 4;
      *(float4*)(wsp<float>(p, OFF_DTV) + base) = make_float4(dt[0], dt[1], dt[2], dt[3]);
      *(float4*)(wsp<float>(p, OFF_ACUM) + base) = make_float4(ac[0], ac[1], ac[2], ac[3]);
    }
  }
}

DI bf16x8 scale8(bf16x8 a, const float* w) {
  return pack8(bfs(a[0]) * w[0], bfs(a[1]) * w[1], bfs(a[2]) * w[2], bfs(a[3]) * w[3],
               bfs(a[4]) * w[4], bfs(a[5]) * w[5], bfs(a[6]) * w[6], bfs(a[7]) * w[7]);
}

DI void s1_item(const DP& p, int item, int lane) {
  const int r = lane & 31, h = lane >> 5;
  const int head = item % 24; int rest = item / 24; const int dir = rest & 1; rest >>= 1; const int c = rest % NCH, b = rest / NCH;
  const int g = head / 6;
  const int row0 = chunk_row0(b, c);
  const size_t dbase = ((size_t)(((dir * 2 + b) * NCH + c) * 24 + head)) * 256;
  const float* dtv = wsp<float>(p, OFF_DTV) + dbase;
  const float* acm = wsp<float>(p, OFF_ACUM) + dbase;
  const float acend = dir == 0 ? acm[255] : acm[0];
  const bfr* XT = wsp<bfr>(p, OFF_XT); const bfr* BTt = wsp<bfr>(p, OFF_BT);
  bfr* HS = wsp<bfr>(p, OFF_HS) + ((size_t)(((dir * 2 + b) * NCH + c) * 24 + head)) * 8192;
#pragma unroll 1
  for (int pt = 0; pt < 2; ++pt) {
    f32x16 acc[4];
#pragma unroll
    for (int n = 0; n < 4; ++n) acc[n] = zero16();
#pragma unroll 4
    for (int kk = 0; kk < 16; ++kk) {
      const int s0 = kk * 16 + 8 * h;
      float4 d0 = *(const float4*)(dtv + s0), d1 = *(const float4*)(dtv + s0 + 4);
      float4 a0 = *(const float4*)(acm + s0), a1 = *(const float4*)(acm + s0 + 4);
      float w[8];
      w[0] = d0.x * __expf(acend - a0.x); w[1] = d0.y * __expf(acend - a0.y); w[2] = d0.z * __expf(acend - a0.z); w[3] = d0.w * __expf(acend - a0.w);
      w[4] = d1.x * __expf(acend - a1.x); w[5] = d1.y * __expf(acend - a1.y); w[6] = d1.z * __expf(acend - a1.z); w[7] = d1.w * __expf(acend - a1.w);
      bf16x8 af = scale8(*(const bf16x8*)(XT + (size_t)(head * 64 + pt * 32 + r) * R + row0 + s0), w);
#pragma unroll
      for (int nt = 0; nt < 4; ++nt) {
        bf16x8 bfv = *(const bf16x8*)(BTt + (size_t)(g * 128 + nt * 32 + r) * R + row0 + s0);
        acc[nt] = MFMA(af, bfv, acc[nt]);
      }
    }
#pragma unroll
    for (int nt = 0; nt < 4; ++nt)
#pragma unroll
      for (int i = 0; i < 16; ++i) HS[(pt * 32 + crow(i, h)) * 128 + nt * 32 + r] = f2bf(acc[nt][i]);
  }
}

DI void s1_block(const DP& p, int item) {
  const int tid = p.tidl, lane = tid & 63, wid = tid >> 6, r = lane & 31, h = lane >> 5;
  const int g = item & 3; const int bc = item >> 2; const int c = bc % NCH, b = bc / NCH;
  const int row0 = chunk_row0(b, c);
  const bfr* XT = wsp<bfr>(p, OFF_XT); const bfr* BTt = wsp<bfr>(p, OFF_BT);
  bfr* BS = (bfr*)smem;
  __syncthreads();
#pragma unroll 4
  for (int i = 0; i < 32; ++i) {
    const int row = wid * 32 + i;
    if (lane < 32)
      __builtin_amdgcn_global_load_lds((const unsigned*)(BTt + (size_t)(g * 128 + row) * R + row0 + lane * 8),
                                       (unsigned*)(BS + row * 264 + lane * 8), 16, 0, 0);
  }
  asm volatile("s_waitcnt vmcnt(0)" ::: "memory");
  __syncthreads();
#pragma unroll 1
  for (int j3 = 0; j3 < 3; ++j3) {
    const int pi = wid * 3 + j3, dir = pi / 6, head = g * 6 + pi % 6;
    const size_t ci = (size_t)(((dir * 2 + b) * NCH + c) * 24 + head);
    const float* dtv = wsp<float>(p, OFF_DTV) + ci * 256;
    const float* acm = wsp<float>(p, OFF_ACUM) + ci * 256;
    const float acend = dir == 0 ? acm[255] : acm[0];
    bfr* HS = wsp<bfr>(p, OFF_HS) + ci * 8192;
    float* WS = (float*)(smem + 67584) + wid * 256;
    {
      const float4 d4 = *(const float4*)(dtv + lane * 4), a4 = *(const float4*)(acm + lane * 4);
      asm volatile("" ::: "memory");
      *(float4*)(WS + lane * 4) = make_float4(d4.x * __expf(acend - a4.x), d4.y * __expf(acend - a4.y),
                                              d4.z * __expf(acend - a4.z), d4.w * __expf(acend - a4.w));
      asm volatile("s_waitcnt lgkmcnt(0)" ::: "memory");
    }
#pragma unroll 1
    for (int pt = 0; pt < 2; ++pt) {
      f32x16 acc[4];
#pragma unroll
      for (int n = 0; n < 4; ++n) acc[n] = zero16();
#pragma unroll 4
      for (int kk = 0; kk < 16; ++kk) {
        const int s0 = kk * 16 + 8 * h;
        const float4 w0 = *(const float4*)(WS + s0), w1 = *(const float4*)(WS + s0 + 4);
        const float w[8] = {w0.x, w0.y, w0.z, w0.w, w1.x, w1.y, w1.z, w1.w};
        bf16x8 af = scale8(*(const bf16x8*)(XT + (size_t)(head * 64 + pt * 32 + r) * R + row0 + s0), w);
#pragma unroll
        for (int nt = 0; nt < 4; ++nt) {
          bf16x8 bfv = *(const bf16x8*)(BS + (nt * 32 + r) * 264 + s0);
          acc[nt] = MFMA(af, bfv, acc[nt]);
        }
      }
#pragma unroll
      for (int nt = 0; nt < 4; ++nt)
#pragma unroll
        for (int i = 0; i < 16; ++i) HS[(pt * 32 + crow(i, h)) * 128 + nt * 32 + r] = f2bf(acc[nt][i]);
    }
  }
}

DI void f1_item(const DP& p, int item, int lane) {
  const int r = lane & 31, h = lane >> 5;
  const int l2t = item & 1, m = (item >> 1) & 511, b = item >> 10;
  const bfr* ZRT = wsp<bfr>(p, OFF_ZRT) + (size_t)m * R + b * SEQ + l2t * 32 + r;
  const bfr* ZIT = wsp<bfr>(p, OFF_ZIT) + (size_t)m * R + b * SEQ + l2t * 32 + r;
  const bfr* C128 = wsp<bfr>(p, OFF_C128); const bfr* S128 = wsp<bfr>(p, OFF_S128);
  const float2* TW = wsp<float2>(p, OFF_TW);
  bfr* YR = wsp<bfr>(p, OFF_YR); bfr* YI = wsp<bfr>(p, OFF_YI);
  const int l2 = l2t * 32 + r;
#pragma unroll 1
  for (int mh = 0; mh < 2; ++mh) {
    f32x16 yr[2], yi[2];
#pragma unroll
    for (int i = 0; i < 2; ++i) { yr[i] = zero16(); yi[i] = zero16(); }
#pragma unroll 2
    for (int kk = 0; kk < 8; ++kk) {
      bf16x8 zr, zi, nzr;
#pragma unroll
      for (int jj = 0; jj < 8; ++jj) {
        int l1 = kk * 16 + 8 * h + jj;
        zr[jj] = (short)ZRT[l1 * 64]; zi[jj] = (short)ZIT[l1 * 64];
        nzr[jj] = (short)(zr[jj] ^ (short)0x8000);
      }
#pragma unroll
      for (int m2 = 0; m2 < 2; ++m2) {
        const int mt = mh * 2 + m2;
        bf16x8 ca = *(const bf16x8*)(C128 + (mt * 32 + r) * 128 + kk * 16 + 8 * h);
        bf16x8 sa = *(const bf16x8*)(S128 + (mt * 32 + r) * 128 + kk * 16 + 8 * h);
        yr[m2] = MFMA(ca, zr, yr[m2]); yr[m2] = MFMA(sa, zi, yr[m2]);
        yi[m2] = MFMA(ca, zi, yi[m2]); yi[m2] = MFMA(sa, nzr, yi[m2]);
      }
    }
#pragma unroll
    for (int m2 = 0; m2 < 2; ++m2)
#pragma unroll
      for (int i = 0; i < 16; ++i) {
        int k1 = (mh * 2 + m2) * 32 + crow(i, h);
        float2 t = TW[k1 * l2];
        float a = yr[m2][i], bb = yi[m2][i];
        size_t o = ((size_t)(b * 512 + m) * 128 + k1) * 64 + l2;
        YR[o] = f2bf(a * t.x + bb * t.y);
        YI[o] = f2bf(bb * t.x - a * t.y);
      }
  }
}

DI void f1c_item(const DP& p, int item, int lane) {
  const int r = lane & 31, h = lane >> 5;
  const int mt = item & 15, kt = (item >> 4) & 7, b = item >> 7;
  const int m = mt * 32 + r;
  const bfr* ZRT = wsp<bfr>(p, OFF_ZRT) + (size_t)m * R + RL + b * CTX;
  const bfr* ZIT = wsp<bfr>(p, OFF_ZIT) + (size_t)m * R + RL + b * CTX;
  const bfr* C256 = wsp<bfr>(p, OFF_C256) + (kt * 32 + r) * 256;
  const bfr* S256 = wsp<bfr>(p, OFF_S256) + (kt * 32 + r) * 256;
  f32x16 acc = zero16();
#pragma unroll 4
  for (int kk = 0; kk < 16; ++kk) {
    int o = kk * 16 + 8 * h;
    acc = MFMA(*(const bf16x8*)(C256 + o), *(const bf16x8*)(ZRT + o), acc);
    acc = MFMA(*(const bf16x8*)(S256 + o), *(const bf16x8*)(ZIT + o), acc);
  }
  bfr* MIX = wsp<bfr>(p, OFF_MIX);
#pragma unroll
  for (int i = 0; i < 16; ++i)
    MIX[(size_t)(RL + b * CTX + kt * 32 + crow(i, h)) * 2048 + m] = f2bf(acc[i] * (1.f / 128.f));
}

DI void s1f1_phase(const DP& p) {
  const int nS1 = 2 * NCH * 4;
  const int G = (int)gridDim.x;
  if (G > nS1 + 64) {
    if (p.bidl < nS1) { s1_block(p, p.bidl); return; }
    const int lane = p.tidl & 63;
    const int wg = (p.bidl - nS1) * 4 + (p.tidl >> 6), nw = (G - nS1) * 4;
#pragma unroll 1
    for (int it = wg; it < 2048 + 256; it += nw) {
      if (it < 2048) f1_item(p, it, lane); else f1c_item(p, it - 2048, lane);
    }
  } else {
#pragma unroll 1
    for (int it = p.bidl; it < nS1; it += G) s1_block(p, it);
    const int lane = p.tidl & 63;
    const int wg = p.bidl * 4 + (p.tidl >> 6), nw = G * 4;
#pragma unroll 1
    for (int it = wg; it < 2048 + 256; it += nw) {
      if (it < 2048) f1_item(p, it, lane); else f1c_item(p, it - 2048, lane);
    }
  }
}

DI void f2_item(const DP& p, int item, int lane) {
  const int r = lane & 31, h = lane >> 5;
  const int mt16 = item & 15, k1 = (item >> 4) & 127, b = item >> 11;
  const int m = mt16 * 32 + r;
  const bfr* YR = wsp<bfr>(p, OFF_YR) + ((size_t)(b * 512 + m) * 128 + k1) * 64;
  const bfr* YI = wsp<bfr>(p, OFF_YI) + ((size_t)(b * 512 + m) * 128 + k1) * 64;
  const bfr* C64 = wsp<bfr>(p, OFF_C64); const bfr* S64 = wsp<bfr>(p, OFF_S64);
  f32x16 acc[2]; acc[0] = zero16(); acc[1] = zero16();
#pragma unroll
  for (int kk = 0; kk < 4; ++kk) {
    bf16x8 yr = *(const bf16x8*)(YR + kk * 16 + 8 * h), yi = *(const bf16x8*)(YI + kk * 16 + 8 * h);
#pragma unroll
    for (int t = 0; t < 2; ++t) {
      bf16x8 ca = *(const bf16x8*)(C64 + (t * 32 + r) * 64 + kk * 16 + 8 * h);
      bf16x8 sa = *(const bf16x8*)(S64 + (t * 32 + r) * 64 + kk * 16 + 8 * h);
      acc[t] = MFMA(ca, yr, acc[t]); acc[t] = MFMA(sa, yi, acc[t]);
    }
  }
  bfr* MIX = wsp<bfr>(p, OFF_MIX);
  const float scale = 0.001381067932f;
#pragma unroll
  for (int t = 0; t < 2; ++t)
#pragma unroll
    for (int i = 0; i < 16; ++i) {
      int k2 = t * 32 + crow(i, h);
      MIX[(size_t)(b * SEQ + k1 + 128 * k2) * 2048 + m] = f2bf(acc[t][i] * scale);
    }
}

DI void s3_block(const DP& p, int j, int b, int c, int g, int half);

DI void s2f2_phase(const DP& p, int j) {
  if (p.bidl < 16) {
    const int k = p.bidl;
    s3_block(p, j, k >> 3, 0, (k >> 1) & 3, k & 1);
    return;
  }
  const int gt = (p.bidl - 16) * 256 + p.tidl, nt = ((int)gridDim.x - 16) * 256;
  bfr* HSb = wsp<bfr>(p, OFF_HS);
  const float* ACUM = wsp<float>(p, OFF_ACUM);
#pragma unroll 1
  for (int it = gt; it < 2 * 2 * 24 * 2048; it += nt) {
    const int e4 = it & 2047; const int rest = it >> 11; const int head = rest % 24, db = rest / 24, dir = db >> 1;
    bf16x4 sv[NCH]; float cd[NCH];
#pragma unroll
    for (int step = 0; step < NCH; ++step) {
      const int c = dir == 0 ? step : (step == 0 ? 0 : NCH - step);
      const size_t ci = (size_t)((db * NCH + c) * 24 + head);
      sv[step] = *(const bf16x4*)(HSb + ci * 8192 + e4 * 4);
      cd[step] = ACUM[ci * 256 + (dir == 0 ? 255 : 0)];
    }
    float h0 = 0.f, h1 = 0.f, h2 = 0.f, h3 = 0.f;
#pragma unroll
    for (int step = 0; step < NCH; ++step) {
      const int c = dir == 0 ? step : (step == 0 ? 0 : NCH - step);
      const size_t ci = (size_t)((db * NCH + c) * 24 + head);
      *(bf16x4*)(HSb + ci * 8192 + e4 * 4) = pack4(h0, h1, h2, h3);
      const float e = __expf(cd[step]);
      h0 = h0 * e + bfs(sv[step][0]); h1 = h1 * e + bfs(sv[step][1]); h2 = h2 * e + bfs(sv[step][2]); h3 = h3 * e + bfs(sv[step][3]);
    }
  }
  const int lane = p.tidl & 63;
  const int wg = (p.bidl - 16) * 4 + (p.tidl >> 6), nw = ((int)gridDim.x - 16) * 4;
#pragma unroll 1
  for (int it = wg; it < 4096; it += nw) f2_item(p, it, lane);
}

DI void s3_block(const DP& p, int j, int b, int c, int g, int half) {
  const int tid = p.tidl, lane = tid & 63, wid = tid >> 6, r = lane & 31, h = lane >> 5;
  const bfr* CN = wsp<bfr>(p, OFF_CN); const bfr* BN = wsp<bfr>(p, OFF_BN); const bfr* XT = wsp<bfr>(p, OFF_XT);
  const bfr* Z = wsp<bfr>(p, OFF_Z); bfr* MIX = wsp<bfr>(p, OFF_MIX);
  bfr* XTs = (bfr*)smem;
  bfr* HSF = (bfr*)(smem + 33792);
  bfr* HSB = (bfr*)(smem + 51200);
  float* LWF = (float*)(smem + 68608);
  float* LWB = LWF + 256;
  {
    const int row0 = chunk_row0(b, c);
    const int lt = half * 4 + wid;
    const int rowl = row0 + lt * 32 + r;
    const bfr* cfp = CN + (size_t)rowl * 512 + g * 128 + 8 * h;
    bf16x8 gtp[8][2];
    {
      bf16x8 cf[8];
#pragma unroll
      for (int kk = 0; kk < 8; ++kk) cf[kk] = *(const bf16x8*)(cfp + kk * 16);
#pragma unroll
      for (int k = 0; k < 8; ++k) { gtp[k][0] = cf[0]; gtp[k][1] = cf[0]; }
      __syncthreads();
      {
        bfr* BS = (bfr*)smem;
#pragma unroll 4
        for (int i = 0; i < 64; ++i) {
          const int row = wid * 64 + i;
          if (lane < 16)
            __builtin_amdgcn_global_load_lds((const unsigned*)(BN + (size_t)(row0 + row) * 512 + g * 128 + lane * 8),
                                             (unsigned*)(BS + row * 136 + lane * 8), 16, 0, 0);
        }
      }
      asm volatile("s_waitcnt vmcnt(0)" ::: "memory");
      __syncthreads();
#pragma unroll 1
      for (int st = 0; st < 8; ++st) {
        f32x16 gt = zero16();
#pragma unroll
        for (int kk = 0; kk < 8; ++kk)
          gt = MFMA(*(const bf16x8*)((const bfr*)smem + (st * 32 + r) * 136 + kk * 16 + 8 * h), cf[kk], gt);
#pragma unroll
        for (int k = 0; k < 7; ++k) { gtp[k][0] = gtp[k + 1][0]; gtp[k][1] = gtp[k + 1][1]; }
        gtp[7][0] = PACK_HALF(gt, 0); gtp[7][1] = PACK_HALF(gt, 1);
      }
    }
    float sumsq = 0.f;
#pragma unroll 1
    for (int hh = 0; hh < 6; ++hh) {
      const int head = g * 6 + hh;
      const size_t cif = (size_t)(((0 * 2 + b) * NCH + c) * 24 + head), cib = (size_t)(((1 * 2 + b) * NCH + c) * 24 + head);
      const float* acf = wsp<float>(p, OFF_ACUM) + cif * 256; const float* acb = wsp<float>(p, OFF_ACUM) + cib * 256;
      const float* dtf = wsp<float>(p, OFF_DTV) + cif * 256; const float* dtb = wsp<float>(p, OFF_DTV) + cib * 256;
      const bfr* HSf = wsp<bfr>(p, OFF_HS) + cif * 8192; const bfr* HSbk = wsp<bfr>(p, OFF_HS) + cib * 8192;
      __syncthreads();
#pragma unroll 4
      for (int i = 0; i < 16; ++i) {
        const int row = wid * 16 + i;
        if (lane < 32)
          __builtin_amdgcn_global_load_lds((const unsigned*)(XT + (size_t)(head * 64 + row) * R + row0 + lane * 8),
                                           (unsigned*)(XTs + row * 264 + lane * 8), 16, 0, 0);
      }
      if (c != 0) {
#pragma unroll 4
        for (int i = 0; i < 16; ++i) {
          const int row = wid * 16 + i;
          if (lane < 16) {
            __builtin_amdgcn_global_load_lds((const unsigned*)(HSf + row * 128 + lane * 8), (unsigned*)(HSF + row * 136 + lane * 8), 16, 0, 0);
            __builtin_amdgcn_global_load_lds((const unsigned*)(HSbk + row * 128 + lane * 8), (unsigned*)(HSB + row * 136 + lane * 8), 16, 0, 0);
          }
        }
      }
      bf16x8 cfh[8];
#pragma unroll
      for (int kk = 0; kk < 8; ++kk) cfh[kk] = *(const bf16x8*)(cfp + kk * 16);
      LWF[tid] = __logf(dtf[tid]) - acf[tid];
      LWB[tid] = __logf(dtb[tid]) - acb[tid];
      const float al_f = acf[lt * 32 + r], al_b = acb[lt * 32 + r];
      asm volatile("s_waitcnt vmcnt(0)" ::: "memory");
      __syncthreads();
      f32x16 acc[2];
      acc[0] = zero16(); acc[1] = zero16();
      if (c != 0) {
        f32x16 t0 = zero16(), t1 = zero16();
#pragma unroll
        for (int kk = 0; kk < 8; ++kk) {
          t0 = MFMA(*(const bf16x8*)(HSF + (r) * 136 + kk * 16 + 8 * h), cfh[kk], t0);
          t1 = MFMA(*(const bf16x8*)(HSF + (32 + r) * 136 + kk * 16 + 8 * h), cfh[kk], t1);
        }
        const float ef = __expf(al_f);
#pragma unroll
        for (int i = 0; i < 16; ++i) { acc[0][i] = t0[i] * ef; acc[1][i] = t1[i] * ef; }
        t0 = zero16(); t1 = zero16();
#pragma unroll
        for (int kk = 0; kk < 8; ++kk) {
          t0 = MFMA(*(const bf16x8*)(HSB + (r) * 136 + kk * 16 + 8 * h), cfh[kk], t0);
          t1 = MFMA(*(const bf16x8*)(HSB + (32 + r) * 136 + kk * 16 + 8 * h), cfh[kk], t1);
        }
        const float eb = __expf(al_b);
#pragma unroll
        for (int i = 0; i < 16; ++i) { acc[0][i] += t0[i] * eb; acc[1][i] += t1[i] * eb; }
      }
      bf16x4 zpre[2][4];
#pragma unroll
      for (int pt = 0; pt < 2; ++pt)
#pragma unroll
        for (int g4 = 0; g4 < 4; ++g4) zpre[pt][g4] = *(const bf16x4*)(Z + (size_t)rowl * 1536 + head * 64 + pt * 32 + 8 * g4 + 4 * h);
#pragma unroll 1
      for (int st = 0; st < 8; ++st) {
        const bf16x8 g0 = gtp[0][0], g1 = gtp[0][1];
#pragma unroll
        for (int k = 0; k < 7; ++k) { gtp[k][0] = gtp[k + 1][0]; gtp[k][1] = gtp[k + 1][1]; }
        gtp[7][0] = g0; gtp[7][1] = g1;
#pragma unroll 1
        for (int dir = 0; dir < 2; ++dir) {
          if (dir == 0 ? (st > lt) : (st < lt)) continue;
          const float* lwd = dir == 0 ? LWF : LWB;
          const float al = dir == 0 ? al_f : al_b;
          f32x16 mm;
#pragma unroll
          for (int g4 = 0; g4 < 4; ++g4) {
            const int sb = st * 32 + 8 * g4 + 4 * h;
            const float4 l4 = *(const float4*)(lwd + sb);
            const float lv[4] = {l4.x, l4.y, l4.z, l4.w};
#pragma unroll
            for (int q = 0; q < 4; ++q) {
              const int i = 4 * g4 + q;
              const int sidx = sb + q, lidx = lt * 32 + r;
              const bool valid = dir == 0 ? (sidx <= lidx) : (sidx >= lidx);
              const float gv = bfs((i >> 3) ? g1[i & 7] : g0[i & 7]);
              const float e = __expf(fminf(al + lv[q], 30.f));
              mm[i] = valid ? gv * e : 0.f;
            }
          }
#pragma unroll
          for (int s2 = 0; s2 < 2; ++s2) {
            bf16x8 pf = PACK_HALF(mm, s2);
#pragma unroll
            for (int pt = 0; pt < 2; ++pt) {
              const bfr* xp = XTs + (pt * 32 + r) * 264 + st * 32 + 16 * s2 + 4 * h;
              bf16x8 xf = join44(*(const bf16x4*)xp, *(const bf16x4*)(xp + 8));
              acc[pt] = MFMA(xf, pf, acc[pt]);
            }
          }
        }
      }
      const float dsk = p.d_skip[j * 24 + head];
#pragma unroll
      for (int pt = 0; pt < 2; ++pt)
#pragma unroll
        for (int g4 = 0; g4 < 4; ++g4) {
          const int pb = pt * 32 + 8 * g4 + 4 * h;
          bf16x4 zv = zpre[pt][g4];
          float y[4];
#pragma unroll
          for (int q = 0; q < 4; ++q) {
            float xv = bf2f(XTs[(pb + q) * 264 + lt * 32 + r]);
            float zz = bfs(zv[q]);
            float v = (acc[pt][4 * g4 + q] + dsk * xv) * (zz / (1.f + __expf(-zz)));
            sumsq += v * v; y[q] = v;
          }
          *(bf16x4*)(MIX + (size_t)rowl * 2048 + 512 + head * 64 + pb) = pack4(y[0], y[1], y[2], y[3]);
        }
    }
    const float tot = sumsq + __shfl_xor(sumsq, 32);
    const float sc = rsqrtf(tot * (1.f / 384.f) + 1e-6f);
    const float* ng = p.ssd_norm_g + (size_t)j * 1536;
    bf16x4 yv[6][2][4];
#pragma unroll
    for (int hh = 0; hh < 6; ++hh)
#pragma unroll
      for (int pt = 0; pt < 2; ++pt)
#pragma unroll
        for (int g4 = 0; g4 < 4; ++g4)
          yv[hh][pt][g4] = *(const bf16x4*)(MIX + (size_t)rowl * 2048 + 512 + (g * 6 + hh) * 64 + pt * 32 + 8 * g4 + 4 * h);
#pragma unroll
    for (int hh = 0; hh < 6; ++hh)
#pragma unroll
      for (int pt = 0; pt < 2; ++pt)
#pragma unroll
        for (int g4 = 0; g4 < 4; ++g4) {
          const int pb = pt * 32 + 8 * g4 + 4 * h, head = g * 6 + hh;
          const float4 gg = *(const float4*)(ng + head * 64 + pb);
          const bf16x4 y4 = yv[hh][pt][g4];
          *(bf16x4*)(MIX + (size_t)rowl * 2048 + 512 + head * 64 + pb) =
              pack4(bfs(y4[0]) * sc * gg.x, bfs(y4[1]) * sc * gg.y, bfs(y4[2]) * sc * gg.z, bfs(y4[3]) * sc * gg.w);
        }
  }
}

DI void s3_phase(const DP& p, int j) {
#pragma unroll 1
  for (int idx = p.bidl; idx < 512; idx += (int)gridDim.x) {
    const int half = idx & 1, g = (idx >> 1) & 3, bcl = idx >> 3;
    s3_block(p, j, bcl >> 5, 1 + (bcl & 31), g, half);
  }
}

DI void qkprep_phase(const DP& p, int j) {
  const int lane = p.tidl & 63;
  const int wg = p.bidl * 4 + (p.tidl >> 6), nw = gridDim.x * 4;
  const bfr* P = wsp<bfr>(p, OFF_P); bfr* QK = wsp<bfr>(p, OFF_QK);
  const float* ROPE = wsp<float>(p, OFF_ROPE);
  const int sub = lane >> 3, d0 = (lane & 7) * 8;
  for (int row = wg; row < R; row += nw) {
    bf16x8 xin[4];
#pragma unroll
    for (int ps = 0; ps < 4; ++ps) {
      const int hs0 = ps * 8 + sub, hsc0 = hs0 < 26 ? hs0 : 25;
      xin[ps] = *(const bf16x8*)(P + (size_t)row * 2304 + (hsc0 < 10 ? hsc0 * 64 : 768 + (hsc0 - 10) * 64) + d0);
    }
#pragma unroll
    for (int ps = 0; ps < 4; ++ps) {
      const int hs = ps * 8 + sub;
      const bool act = hs < 26;
      const int hsc = act ? hs : 25;
      bf16x8 xv = xin[ps];
      float x[8]; float ss = 0.f;
#pragma unroll
      for (int e = 0; e < 8; ++e) { x[e] = bfs(xv[e]); ss += x[e] * x[e]; }
      ss += __shfl_xor(ss, 1); ss += __shfl_xor(ss, 2); ss += __shfl_xor(ss, 4);
      const float rs = rsqrtf(ss * (1.f / 64.f) + 1e-6f);
      const float* gv = hsc < 8 ? p.q_norm_win + j * 64 : hsc < 10 ? p.k_norm_win + j * 64 : hsc < 18 ? p.q_norm_na + j * 64 : p.k_norm_na + j * 64;
#pragma unroll
      for (int e = 0; e < 8; ++e) x[e] = x[e] * rs * gv[d0 + e];
      float pr[8];
#pragma unroll
      for (int e = 0; e < 8; ++e) pr[e] = __shfl_xor(x[e], 2);
      if (hsc < 10 && row < RL) {
        const int pos = row & 8191;
        const int axis = d0 >> 5;
        const int idx = axis == 0 ? (pos >> 6) : (pos & 63);
        const int f0 = d0 & 15;
        const bool second = (d0 & 16) != 0;
        const float* cp = ROPE + (axis * 128 + idx) * 16 + f0;
        const float* sp = cp + 4096;
#pragma unroll
        for (int e = 0; e < 8; ++e) {
          float cs = cp[e], sn = sp[e];
          x[e] = second ? (x[e] * cs + pr[e] * sn) : (x[e] * cs - pr[e] * sn);
        }
      }
      const bool isq = hsc < 8 || (hsc >= 10 && hsc < 18);
      const float qs = isq ? 0.125f : 1.f;
      if (act) *(bf16x8*)(QK + (size_t)row * 1664 + hsc * 64 + d0) = pack8(x[0] * qs, x[1] * qs, x[2] * qs, x[3] * qs, x[4] * qs, x[5] * qs, x[6] * qs, x[7] * qs);
    }
  }
}

struct KVF { bf16x8 k[4]; bf16x8 v[2][2]; };
struct KVS { bf16x8 k[4]; bf16x8 v[4]; };

DI void kv_gload(KVS& g, const bfr* __restrict__ Kt, const bfr* __restrict__ Vt, int lane) {
#pragma unroll
  for (int i = 0; i < 4; ++i) {
    const int idx = lane + 64 * i;
    g.k[i] = *(const bf16x8*)(Kt + (size_t)(idx >> 3) * 1664 + (idx & 7) * 8);
    g.v[i] = *(const bf16x8*)(Vt + (size_t)(idx >> 2) * R + (idx & 3) * 8);
  }
}
DI void kv_sstore(const KVS& g, unsigned char* base, int lane) {
#pragma unroll
  for (int i = 0; i < 4; ++i) {
    const int idx = lane + 64 * i;
    { const int row = idx >> 3, c = idx & 7; *(bf16x8*)(base + row * 128 + ((c ^ (row & 7)) << 4)) = g.k[i]; }
    {
      const int d = idx >> 2, c16 = idx & 3, sw = (d >> 2) & 7;
      bf16x4 lo = __builtin_shufflevector(g.v[i], g.v[i], 0, 1, 2, 3), hi = __builtin_shufflevector(g.v[i], g.v[i], 4, 5, 6, 7);
      *(bf16x4*)(base + 4096 + d * 64 + (((2 * c16) ^ sw) << 3)) = lo;
      *(bf16x4*)(base + 4096 + d * 64 + (((2 * c16 + 1) ^ sw) << 3)) = hi;
    }
  }
}
DI void kv_sload(KVF& f, const unsigned char* base, int r, int h) {
#pragma unroll
  for (int kk = 0; kk < 4; ++kk) f.k[kk] = *(const bf16x8*)(base + r * 128 + (((2 * kk + h) ^ (r & 7)) << 4));
#pragma unroll
  for (int s2 = 0; s2 < 2; ++s2)
#pragma unroll
    for (int dt = 0; dt < 2; ++dt) {
      const int d = dt * 32 + r, sw = (d >> 2) & 7, c8 = 4 * s2 + h;
      const unsigned char* vb = base + 4096 + d * 64;
      f.v[s2][dt] = join44(*(const bf16x4*)(vb + ((c8 ^ sw) << 3)), *(const bf16x4*)(vb + (((c8 + 2) ^ sw) << 3)));
    }
}

DI void attn_compute(f32x16 (&o)[2], float& m, float& l, const unsigned char* qb, const unsigned char* base, int r, int h,
                     int mode, int a0, int a1, const float* __restrict__ rp) {
  f32x16 s = zero16();
#pragma unroll
  for (int kk = 0; kk < 4; ++kk) {
    const int off = r * 128 + (((2 * kk + h) ^ (r & 7)) << 4);
    s = MFMA(*(const bf16x8*)(base + off), *(const bf16x8*)(qb + off), s);
  }
  float tmax = -3.0e38f;
  if (mode == 1) {
#pragma unroll
    for (int i = 0; i < 16; ++i) { int dd = a0 - crow(i, h); dd = dd < 0 ? -dd : dd; s[i] = dd <= 128 ? s[i] : -1.0e30f; }
  } else if (mode == 2) {
#pragma unroll
    for (int i = 0; i < 16; ++i) {
      const int key = crow(i, h);
      const int rel = a0 + key;
      int co = a1 + key; co = co < 0 ? 0 : (co > 30 ? 30 : co);
      s[i] = (rel >= 0 && rel < 16) ? s[i] + rp[co] : -1.0e30f;
    }
  }
#pragma unroll
  for (int i = 0; i < 16; ++i) tmax = fmaxf(tmax, s[i]);
  tmax = fmaxf(tmax, __shfl_xor(tmax, 32));
  const float mn = fmaxf(m, tmax);
  const float alpha = __expf(m - mn);
  float ps = 0.f;
#pragma unroll
  for (int i = 0; i < 16; ++i) { s[i] = __expf(s[i] - mn); ps += s[i]; }
  l = l * alpha + ps; m = mn;
#pragma unroll
  for (int i = 0; i < 16; ++i) { o[0][i] *= alpha; o[1][i] *= alpha; }
#pragma unroll
  for (int s2 = 0; s2 < 2; ++s2) {
    bf16x8 pf = PACK_HALF(s, s2);
#pragma unroll
    for (int dt = 0; dt < 2; ++dt) {
      const int d = dt * 32 + r, sw = (d >> 2) & 7, c8 = 4 * s2 + h;
      const unsigned char* vb = base + 4096 + d * 64;
      bf16x8 vf = join44(*(const bf16x4*)(vb + ((c8 ^ sw) << 3)), *(const bf16x4*)(vb + (((c8 + 2) ^ sw) << 3)));
      o[dt] = MFMA(vf, pf, o[dt]);
    }
  }
}

DI void attn_item(const DP& p, int j, int item, int lane) {
  const int r = lane & 31, h = lane >> 5;
  const bfr* QK = wsp<bfr>(p, OFF_QK); const bfr* VT = wsp<bfr>(p, OFF_VT); bfr* MIX = wsp<bfr>(p, OFF_MIX);
  int kind, b, hd, qt;
  if (item < 4096) { kind = 0; qt = item & 255; hd = (item >> 8) & 7; b = item >> 11; }
  else if (item < 8192) { int v = item - 4096; kind = 1; qt = v & 255; hd = (v >> 8) & 7; b = v >> 11; }
  else if (item < 8320) { int v = item - 8192; kind = 2; qt = v & 7; hd = (v >> 3) & 7; b = v >> 6; }
  else { int v = item - 8320; kind = 3; qt = v & 7; hd = (v >> 3) & 7; b = v >> 6; }
  const bool win = (kind == 0 || kind == 2);
  const bool lat = kind < 2;
  const int q_row0 = lat ? b * SEQ + qt * 32 : RL + b * CTX + qt * 32;
  const int qcol = win ? hd * 64 : (10 + hd) * 64;
  const int kcol = win ? (8 + (hd >> 2)) * 64 : (18 + hd) * 64;
  const bfr* Vb = win ? VT + (size_t)((hd >> 2) * 64) * R : VT + (size_t)(128 + hd * 64) * R;
  const bfr* Kb = QK + kcol;
  f32x16 o[2]; o[0] = zero16(); o[1] = zero16();
  float m = -1.0e30f, l = 0.f;
  if (win) { m = p.sink_win[j * 8 + hd]; l = h == 0 ? 1.f : 0.f; }
  int nloc = 0, lo = 0, gr = 0, kr0 = 0, w = 0, cs = 0;
  const int qpos = qt * 32 + r;
  if (kind == 0) { lo = qt - 4 < 0 ? 0 : qt - 4; const int hi = qt + 4 > 255 ? 255 : qt + 4; nloc = hi - lo + 1; }
  else if (kind == 1) {
    gr = qt >> 1; w = (qt & 1) * 32 + r;
    cs = w - 8; cs = cs < 0 ? 0 : (cs > 48 ? 48 : cs);
    kr0 = gr - 4; kr0 = kr0 < 0 ? 0 : (kr0 > 120 ? 120 : kr0);
    nloc = 16;
  }
  const int ntile = 8 + nloc;
  const float* rpb = p.rpb_na + (size_t)j * 8 * 15 * 31 + hd * 15 * 31;
  auto tile_row = [&](int i) -> int {
    if (i < 8) return RL + b * CTX + i * 32;
    const int li = i - 8;
    if (kind == 0) return b * SEQ + (lo + li) * 32;
    return b * SEQ + (kr0 + (li >> 1)) * 64 + (li & 1) * 32;
  };
  unsigned char* lbase = smem + (p.tidl >> 6) * 12288;
  asm volatile("" ::: "memory");
#pragma unroll
  for (int i = 0; i < 4; ++i) {
    const int idx = lane + 64 * i, row = idx >> 3, c = idx & 7;
    *(bf16x8*)(lbase + 8192 + row * 128 + ((c ^ (row & 7)) << 4)) = *(const bf16x8*)(QK + (size_t)(q_row0 + row) * 1664 + qcol + c * 8);
  }
  KVS g;
  { const int k0 = tile_row(0); kv_gload(g, Kb + (size_t)k0 * 1664, Vb + k0, lane); }
  kv_sstore(g, lbase, lane);
#pragma unroll 1
  for (int i = 0; i < ntile; ++i) {
    { const int in = i + 1 < ntile ? i + 1 : i; const int k0 = tile_row(in); kv_gload(g, Kb + (size_t)k0 * 1664, Vb + k0, lane); }
    int mode = 0, a0 = 0, a1 = 0; const float* rp = rpb;
    if (i >= 8) {
      const int li = i - 8;
      if (kind == 0) { mode = 1; a0 = qpos - (lo + li) * 32; }
      else { mode = 2; const int krow = kr0 + (li >> 1); const int ub = (li & 1) * 32; a0 = ub - cs; a1 = ub - w + 15; rp = rpb + (krow - gr + 7) * 31; }
    }
    asm volatile("" ::: "memory");
    attn_compute(o, m, l, lbase + 8192, lbase, r, h, mode, a0, a1, rp);
    asm volatile("" ::: "memory");
    kv_sstore(g, lbase, lane);
  }
  asm volatile("" ::: "memory");
  const float lt = l + __shfl_xor(l, 32);
  const float inv = 1.f / lt;
  const int ocol = win ? hd * 64 : 512 + hd * 64;
#pragma unroll
  for (int dt = 0; dt < 2; ++dt)
#pragma unroll
    for (int g4 = 0; g4 < 4; ++g4) {
      const int d = dt * 32 + 8 * g4 + 4 * h;
      *(bf16x4*)(MIX + (size_t)(q_row0 + r) * 1024 + ocol + d) =
          pack4(o[dt][4 * g4] * inv, o[dt][4 * g4 + 1] * inv, o[dt][4 * g4 + 2] * inv, o[dt][4 * g4 + 3] * inv);
    }
}

DI void attn_phase(const DP& p, int j) {
  const int lane = p.tidl & 63;
  const int wg = p.bidl * 4 + (p.tidl >> 6), nw = gridDim.x * 4;
#pragma unroll 1
  for (int it = wg; it < 8448; it += nw) attn_item(p, j, it, lane);
}

#define XB_TMO      128
#define XB_XCNT(j)  (256  + 64 * (j))
#define XB_XSUB(j)  (1280 + 64 * (j))
#define XB_XGEN(j)  (2304 + 64 * (j))
#define XB_TOP      3328
#define XB_TOPGEN   3392
#define XCD_BAR_WORDS 3456
#define XB_SPIN_CAP (1u << 18)
#define LAS __attribute__((address_space(3)))

__device__ __forceinline__ unsigned xb_ld(unsigned* p)              { return __hip_atomic_load(p, __ATOMIC_RELAXED, __HIP_MEMORY_SCOPE_AGENT); }
__device__ __forceinline__ unsigned xb_add(unsigned* p, unsigned v) { return __hip_atomic_fetch_add(p, v, __ATOMIC_RELAXED, __HIP_MEMORY_SCOPE_AGENT); }
__device__ __forceinline__ unsigned xb_xcc_id() { return (unsigned)__builtin_amdgcn_s_getreg((3 << 11) | 20) & 0xFu; }
#define XB_SPIN(cond, bar) do { unsigned _sp = 0; while (cond) { __builtin_amdgcn_s_sleep(1); \
    if ((++_sp & 255u) == 0u) { if (xb_ld(&(bar)[XB_TMO])) break; if (_sp > XB_SPIN_CAP) { atomicAdd(&(bar)[XB_TMO], 1u); break; } } } } while (0)

struct XcdBarrier {
    unsigned* bar; unsigned x;
    volatile LAS unsigned* st;
};

__device__ __forceinline__ XcdBarrier xcd_barrier_post(unsigned* bar, volatile LAS unsigned* st) {
    XcdBarrier b; b.bar = bar; b.x = xb_xcc_id(); b.st = st;
    if (threadIdx.x == 0) (void)xb_add(&bar[XB_XCNT(b.x)], 1u);
    return b;
}
__device__ __forceinline__ void xcd_barrier_complete(unsigned* bar, unsigned x, unsigned& nloc, unsigned& nx) {
    const unsigned G = gridDim.x * gridDim.y * gridDim.z;
    unsigned sum, cnt, mine, sp = 0u;
    for (;;) {
        sum = 0u; cnt = 0u; mine = 0u;
#pragma unroll
        for (unsigned j = 0; j < 16; ++j) { const unsigned c = xb_ld(&bar[XB_XCNT(j)]); sum += c; cnt += (c > 0u) ? 1u : 0u; mine = (j == x) ? c : mine; }
        if (sum == G) break;
        __builtin_amdgcn_s_sleep(1);
        if ((++sp & 255u) == 0u) { if (xb_ld(&bar[XB_TMO])) break; if (sp > XB_SPIN_CAP) { atomicAdd(&bar[XB_TMO], 1u); break; } }
    }
    nloc = mine > 0u ? mine : 1u; nx = cnt > 0u ? cnt : 1u;
}

__device__ __forceinline__ void xcd_barrier(const XcdBarrier& b) {
    asm volatile("s_waitcnt vmcnt(0)" ::: "memory");
    __syncthreads();
    if (threadIdx.x == 0) {
        unsigned* bar = b.bar;
        __builtin_amdgcn_s_waitcnt(0);
        unsigned nloc = b.st[0], nx = b.st[1];
        if (nloc == 0u) { xcd_barrier_complete(bar, b.x, nloc, nx); b.st[0] = nloc; b.st[1] = nx; }
        const unsigned old = xb_add(&bar[XB_XSUB(b.x)], 1u);
        const unsigned gen = old / nloc;
        if (old + 1u == (gen + 1u) * nloc) {
            __builtin_amdgcn_fence(__ATOMIC_RELEASE, "agent");
            asm volatile("s_waitcnt vmcnt(0)" ::: "memory");
            const unsigned og = xb_add(&bar[XB_TOP], 1u);
            const unsigned tg = og / nx;
            if (og + 1u == (tg + 1u) * nx) xb_add(&bar[XB_TOPGEN], 1u);
            else XB_SPIN(xb_ld(&bar[XB_TOPGEN]) == tg, bar);
            __builtin_amdgcn_fence(__ATOMIC_ACQUIRE, "agent");
            xb_add(&bar[XB_XGEN(b.x)], 1u);
            asm volatile("s_waitcnt vmcnt(0)" ::: "memory");
        } else {
            XB_SPIN(xb_ld(&bar[XB_XGEN(b.x)]) == gen, bar);
            __builtin_amdgcn_fence(__ATOMIC_ACQUIRE, "agent");
            asm volatile("s_waitcnt vmcnt(0)" ::: "memory");
        }
    }
    __syncthreads();
}


DI void run_phase(const DP& p, int ph, int dry) {
  if (ph == 0) { phase0(p); wconv_phase(p, 0); return; }
  int q = ph - 1, layer, lp;
  if (q < 10) { layer = 0; lp = q; } else if (q < 17) { layer = 1; lp = q - 10; } else if (q < 27) { layer = 2; lp = q - 17; } else { layer = 3; lp = q - 27; }
  const int j = layer >> 1;
  const bool even = (layer & 1) == 0;
  int op, gsel = 0;
  if (even) {
    op = (int)((0x2272654321ull >> (4 * lp)) & 15ull); gsel = (int)((0x3201000000ull >> (4 * lp)) & 15ull);
  } else {
    op = (int)((0x2272921ull >> (4 * lp)) & 15ull); gsel = (int)((0x3201000ull >> (4 * lp)) & 15ull);
  }
  if (op == 1 && layer != 0) wconv_phase(p, layer);
  if (op == 1 || op == 7) {
    const bool first = op == 1;
    norm_phase(p, layer, (first ? p.norm_mix_g : p.norm_ff_g) + layer * 1024, first ? 0 : 3, first ? 1 : 4);
  } else if (op == 2) {
    int mode, lda, N, K, gch; size_t offA, offB;
    if (gsel == 0) { mode = even ? EPI_EVEN_IN : EPI_ODD_IN; offA = OFF_MIX; lda = 1024; offB = OFF_WIN; N = even ? 5168 : 2304; K = 1024; gch = 0; }
    else if (gsel == 1) { mode = EPI_RESID; offA = OFF_MIX; lda = even ? 2048 : 1024; offB = OFF_WOUT; N = 1024; K = even ? 2048 : 1024; gch = 2; }
    else if (gsel == 2) { mode = EPI_RELU2; offA = OFF_MIX; lda = 1024; offB = OFF_WFF1; N = 4096; K = 1024; gch = 0; }
    else { mode = EPI_RESID; offA = OFF_ACT; lda = 4096; offB = OFF_WFF2; N = 1024; K = 4096; gch = 5; }
    if (dry && mode == EPI_RESID) mode = 4;
    gemm_phase(p, mode, wsp<bfr>(p, offA), lda, wsp<bfr>(p, offB), N, K, layer, gch, (layer == 3 && gsel != 0) ? RL / 128 : R / 128);
  } else if (op == 3) conv_dt_phase(p, j);
  else if (op == 4) s1f1_phase(p);
  else if (op == 5) s2f2_phase(p, j);
  else if (op == 6) s3_phase(p, j);
  else if (op == 8) qkprep_phase(p, j);
  else if (op == 9) attn_phase(p, j);
}

DI int probe_reps(int ph) {
#ifdef PROBE_MASK
  if (ph == 0) return (PROBE_MASK & 1) ? 2 : 1;
  int q = ph - 1, layer, lp;
  if (q < 10) { layer = 0; lp = q; } else if (q < 17) { layer = 1; lp = q - 10; } else if (q < 27) { layer = 2; lp = q - 17; } else { layer = 3; lp = q - 27; }
  const bool even = (layer & 1) == 0;
  int op, gsel;
  if (even) { op = (int)((0x2272654321ull >> (4 * lp)) & 15ull); gsel = (int)((0x3201000000ull >> (4 * lp)) & 15ull); }
  else { op = (int)((0x2272921ull >> (4 * lp)) & 15ull); gsel = (int)((0x3201000ull >> (4 * lp)) & 15ull); }
  if (op == 5) return 1;
  if (op == 2 && (gsel == 1 || gsel == 3)) return ((PROBE_MASK >> 10) & 1) ? 2 : 1;
  return ((PROBE_MASK >> op) & 1) ? 2 : 1;
#else
  return 1;
#endif
}

__shared__ uint4 xb_words;

__global__ void __launch_bounds__(256, 2) mega(Params p, int ph0, int ph1) {
  cg::grid_group grid = cg::this_grid();
  if (threadIdx.x == 0) xb_words = make_uint4(0u, 0u, 0u, 0u);
  __syncthreads();
  XcdBarrier xb = xcd_barrier_post((unsigned*)(p.ws + OFF_BAR), (volatile LAS unsigned*)&xb_words);
#pragma unroll 1
  for (int ph = ph0; ph < ph1; ++ph) {
    const int nrep = probe_reps(ph);
#pragma unroll 1
    for (int rep = 0; rep < nrep; ++rep) {
      DP q;
      (Params&)q = p;
      int t = threadIdx.x, bb = blockIdx.x;
      asm volatile("" : "+v"(t));
      asm volatile("" : "+s"(bb));
      int z0;
      asm volatile("s_mov_b32 %0, 0" : "=s"(z0));
      q.ws = p.ws + z0;
      q.out = p.out + z0;
      q.tidl = t; q.bidl = bb;
      run_phase(q, ph, rep + 1 < nrep);
    }
    if (ph + 1 < ph1) {
      if (ph == ph0) grid.sync();
      else xcd_barrier(xb);
    }
  }
}

extern "C" void kernel_launch(void* const* d_in, const int* in_sizes, int n_in, void* d_out, int out_size, void* d_ws,
                              size_t ws_size, hipStream_t stream) {
  static int grid_blocks = 0;
  if (!grid_blocks) {
    int dev = 0, cus = 0, per_cu = 0;
    hipGetDevice(&dev);
    hipDeviceGetAttribute(&cus, hipDeviceAttributeMultiprocessorCount, dev);
    hipOccupancyMaxActiveBlocksPerMultiprocessor(&per_cu, mega, 256, 0);
    if (per_cu > 2) per_cu = 2;
    if (per_cu < 1) per_cu = 1;
    grid_blocks = cus * per_cu;
  }
  Params p{};
  const float** pp = (const float**)&p;
  for (int i = 0; i < 26; ++i) pp[i] = (const float*)d_in[i];
  p.out = (float*)d_out;
  p.ws = (unsigned char*)d_ws;
  if (ws_size < WS_TOTAL) fprintf(stderr, "workspace too small: %zu < %zu\n", ws_size, (size_t)WS_TOTAL);
  hipMemsetAsync((unsigned char*)d_ws + OFF_BAR, 0, XCD_BAR_WORDS * 4, stream);
#if MULTI_LAUNCH
  for (int ph = 0; ph < NPHASE; ++ph) {
    int a = ph, b = ph + 1;
    void* args[] = {&p, &a, &b};
    hipLaunchCooperativeKernel((void*)mega, dim3(grid_blocks), dim3(256), args, 0, stream);
  }
#else
  int a = 0, b = NPHASE;
  void* args[] = {&p, &a, &b};
  hipError_t e = hipLaunchCooperativeKernel((void*)mega, dim3(grid_blocks), dim3(256), args, 0, stream);
  if (e != hipSuccess) fprintf(stderr, "cooperative launch failed: %s (grid %d)\n", hipGetErrorString(e), grid_blocks);
#endif
}
```

```cpp
#include <hip/hip_runtime.h>
#include <hip/hip_cooperative_groups.h>
#include <cstdio>
namespace cg = cooperative_groups;

typedef unsigned short bfr;
typedef __attribute__((ext_vector_type(8))) short bf16x8;
typedef __attribute__((ext_vector_type(4))) short bf16x4;
typedef __attribute__((ext_vector_type(16))) float f32x16;
#define DI __device__ __forceinline__
#define MFMA(a, b, c) __builtin_amdgcn_mfma_f32_32x32x16_bf16((a), (b), (c), 0, 0, 0)

#ifndef MULTI_LAUNCH
#define MULTI_LAUNCH 0
#endif

constexpr int RL = 16384, R = 16896, SEQ = 8192, CTX = 256;
constexpr int NCH = 33, CL = 256;
constexpr int NPHASE = 35;

constexpr size_t al(size_t x) { return (x + 255) & ~size_t(255); }
constexpr size_t OFF_HC = 0;
constexpr size_t OFF_MOD = OFF_HC + al(512 * 1024 * 4);
constexpr size_t OFF_TW = OFF_MOD + al(4 * 3 * 6144 * 4);
constexpr size_t OFF_C128 = OFF_TW + al(8192 * 8);
constexpr size_t OFF_S128 = OFF_C128 + al(128 * 128 * 2);
constexpr size_t OFF_C64 = OFF_S128 + al(128 * 128 * 2);
constexpr size_t OFF_S64 = OFF_C64 + al(64 * 64 * 2);
constexpr size_t OFF_C256 = OFF_S64 + al(64 * 64 * 2);
constexpr size_t OFF_S256 = OFF_C256 + al(256 * 256 * 2);
constexpr size_t OFF_ROPE = OFF_S256 + al(256 * 256 * 2);
constexpr size_t OFF_DTV = OFF_ROPE + al(2 * 2 * 128 * 16 * 4);
constexpr size_t DT_BYTES = (size_t)2 * 2 * NCH * 24 * 256 * 4;
constexpr size_t OFF_ACUM = OFF_DTV + al(DT_BYTES);
constexpr size_t OFF_WIN = OFF_ACUM + al(DT_BYTES);
constexpr size_t OFF_WOUT = OFF_WIN + al((size_t)5248 * 1024 * 2);
constexpr size_t OFF_WFF1 = OFF_WOUT + al((size_t)1024 * 2048 * 2);
constexpr size_t OFF_WFF2 = OFF_WFF1 + al((size_t)4096 * 1024 * 2);
constexpr size_t OFF_MIX = OFF_WFF2 + al((size_t)4096 * 1024 * 2);
constexpr size_t OFF_BIG = OFF_MIX + al((size_t)R * 2048 * 2);
constexpr size_t OFF_Z = OFF_BIG;
constexpr size_t OFF_ZRT = OFF_Z + (size_t)R * 1536 * 2;
constexpr size_t OFF_ZIT = OFF_ZRT + (size_t)512 * R * 2;
constexpr size_t OFF_XBC = OFF_ZIT + (size_t)512 * R * 2;
constexpr size_t OFF_DTRAW = OFF_XBC + (size_t)R * 2560 * 2;
constexpr size_t BIG_END = OFF_DTRAW + (size_t)R * 48 * 4;
constexpr size_t OFF_HS = OFF_XBC;
constexpr size_t HS_BYTES = (size_t)2 * 2 * NCH * 24 * 8192 * 2;
constexpr size_t OFF_YR = OFF_HS + HS_BYTES;
constexpr size_t OFF_YI = OFF_YR + (size_t)2 * 512 * 128 * 64 * 2;
static_assert(OFF_YI + (size_t)2 * 512 * 128 * 64 * 2 <= OFF_DTRAW, "fft scratch overflows");
constexpr size_t OFF_ACT = OFF_BIG;
static_assert((size_t)R * 4096 * 2 <= BIG_END - OFF_BIG, "act overflows");
constexpr size_t OFF_P = OFF_BIG;
constexpr size_t OFF_VT = OFF_P + (size_t)R * 2304 * 2;
constexpr size_t OFF_QK = OFF_VT + (size_t)640 * R * 2;
static_assert(OFF_QK + (size_t)R * 1664 * 2 <= BIG_END, "odd overflows");
constexpr size_t OFF_XT = al(BIG_END);
constexpr size_t OFF_BN = OFF_XT + (size_t)1536 * R * 2;
constexpr size_t OFF_BT = OFF_BN + (size_t)R * 512 * 2;
constexpr size_t OFF_CN = OFF_BT + (size_t)512 * R * 2;
constexpr size_t OFF_BAR = al(OFF_CN + (size_t)R * 512 * 2);
constexpr size_t WS_TOTAL = OFF_BAR + 16384;
static_assert(WS_TOTAL <= 402653184ull, "workspace too large");

struct Params {
  const float *x, *c, *ctx, *c_ctx, *w_mod, *b_mod, *norm_mix_g, *norm_ff_g, *w_ff1, *w_ff2;
  const float *w_in_even, *conv_w, *conv_b, *dt_bias, *a_log, *d_skip, *ssd_norm_g, *w_out_even;
  const float *w_in_odd, *q_norm_win, *k_norm_win, *sink_win, *q_norm_na, *k_norm_na, *rpb_na, *w_out_odd;
  float* out;
  unsigned char* ws;
};

struct DP : Params { int tidl, bidl; };

__shared__ __attribute__((aligned(16))) unsigned char smem[73728];

typedef __attribute__((ext_vector_type(2))) __bf16 bf2_t;
typedef __attribute__((ext_vector_type(2))) float f2_t;
typedef __attribute__((ext_vector_type(4))) unsigned u32x4_t;
typedef __attribute__((ext_vector_type(2))) unsigned u32x2_t;
DI unsigned pk2(float a, float b) { f2_t v = {a, b}; return __builtin_bit_cast(unsigned, __builtin_convertvector(v, bf2_t)); }
DI bfr f2bf(float x) { return (bfr)(pk2(x, 0.f) & 0xffffu); }
DI float bf2f(bfr b) { return __uint_as_float(((unsigned)b) << 16); }
DI float bfs(short s) { return __uint_as_float(((unsigned)(unsigned short)s) << 16); }
DI int crow(int i, int h) { return (i & 3) + 8 * (i >> 2) + 4 * h; }
DI f32x16 zero16() { f32x16 z; for (int i = 0; i < 16; ++i) z[i] = 0.f; return z; }
DI bf16x8 pack8(float a0, float a1, float a2, float a3, float a4, float a5, float a6, float a7) {
  u32x4_t v = {pk2(a0, a1), pk2(a2, a3), pk2(a4, a5), pk2(a6, a7)};
  return __builtin_bit_cast(bf16x8, v);
}
DI bf16x4 pack4(float a0, float a1, float a2, float a3) {
  u32x2_t v = {pk2(a0, a1), pk2(a2, a3)};
  return __builtin_bit_cast(bf16x4, v);
}
#define PACK_HALF(s, s2) pack8(s[8 * (s2)], s[8 * (s2) + 1], s[8 * (s2) + 2], s[8 * (s2) + 3], s[8 * (s2) + 4], s[8 * (s2) + 5], s[8 * (s2) + 6], s[8 * (s2) + 7])
DI bf16x8 join44(bf16x4 lo, bf16x4 hi) { return __builtin_shufflevector(lo, hi, 0, 1, 2, 3, 4, 5, 6, 7); }
DI int chunk_row0(int b, int c) { return c == 0 ? RL + b * CTX : b * SEQ + (c - 1) * CL; }

DI void sincos_turn(double f, float& s, float& c) {
  f -= rint(f);
  double x = f * 6.283185307179586476925;
  double x2 = x * x, ss = 1.0, cc = 1.0;
#pragma unroll
  for (int k = 13; k >= 1; --k) {
    ss = 1.0 - x2 / (double)((2 * k) * (2 * k + 1)) * ss;
    cc = 1.0 - x2 / (double)((2 * k - 1) * (2 * k)) * cc;
  }
  s = (float)(x * ss); c = (float)cc;
}

template <class T> DI T* wsp(const DP& p, size_t off) { return (T*)(p.ws + off); }

DI void phase0(const DP& p) {
  const int tid = p.tidl, bid = p.bidl, G = gridDim.x;
  float* lds = (float*)smem;
  float* MOD = wsp<float>(p, OFF_MOD);
  for (int u = bid; u < 384; u += G) {
    int layer = u / 96, cb = u % 96;
    for (int i = tid; i < 3072; i += 256) {
      int v = i >> 10, k = i & 1023;
      float c = v < 2 ? p.c[v * 1024 + k] : p.c_ctx[k];
      lds[i] = c / (1.f + expf(-c));
    }
    __syncthreads();
    const int kq = tid >> 4, c4 = (tid & 15) * 4;
    const float* w = p.w_mod + (size_t)layer * 1024 * 6144 + cb * 64 + c4;
    float a0[4] = {0.f, 0.f, 0.f, 0.f}, a1[4] = {0.f, 0.f, 0.f, 0.f}, a2[4] = {0.f, 0.f, 0.f, 0.f};
#pragma unroll 8
    for (int k = kq * 64; k < kq * 64 + 64; ++k) {
      const float4 wv = *(const float4*)(w + (size_t)k * 6144);
      const float s0 = lds[k], s1 = lds[1024 + k], s2 = lds[2048 + k];
      a0[0] += s0 * wv.x; a0[1] += s0 * wv.y; a0[2] += s0 * wv.z; a0[3] += s0 * wv.w;
      a1[0] += s1 * wv.x; a1[1] += s1 * wv.y; a1[2] += s1 * wv.z; a1[3] += s1 * wv.w;
      a2[0] += s2 * wv.x; a2[1] += s2 * wv.y; a2[2] += s2 * wv.z; a2[3] += s2 * wv.w;
    }
    float* red = lds + 3072;
#pragma unroll
    for (int e = 0; e < 4; ++e) {
      red[(kq * 3 + 0) * 64 + c4 + e] = a0[e]; red[(kq * 3 + 1) * 64 + c4 + e] = a1[e]; red[(kq * 3 + 2) * 64 + c4 + e] = a2[e];
    }
    __syncthreads();
    if (tid < 192) {
      const int v = tid >> 6, cc = tid & 63, col = cb * 64 + cc;
      float sacc = 0.f;
#pragma unroll
      for (int q = 0; q < 16; ++q) sacc += red[(q * 3 + v) * 64 + cc];
      MOD[(layer * 3 + v) * 6144 + col] = sacc + p.b_mod[layer * 6144 + col];
    }
    __syncthreads();
  }
  const int gt = bid * 256 + tid, nt = G * 256;
  {
    const float4* xs = (const float4*)p.x; float4* od = (float4*)p.out;
    for (int i = gt; i < RL * 256; i += 4 * nt) {
      float4 t4[4];
#pragma unroll
      for (int q = 0; q < 4; ++q) { const int ii = i + q * nt; t4[q] = ii < RL * 256 ? xs[ii] : make_float4(0.f, 0.f, 0.f, 0.f); }
#pragma unroll
      for (int q = 0; q < 4; ++q) { const int ii = i + q * nt; if (ii < RL * 256) od[ii] = t4[q]; }
    }
    const float4* cs = (const float4*)p.ctx; float4* hd = wsp<float4>(p, OFF_HC);
    for (int i = gt; i < 512 * 256; i += nt) hd[i] = cs[i];
  }
  float2* TW = wsp<float2>(p, OFF_TW);
  for (int i = gt; i < 8192; i += nt) { float s, c; sincos_turn((double)i / 8192.0, s, c); TW[i] = make_float2(c, s); }
  bfr* C128 = wsp<bfr>(p, OFF_C128); bfr* S128 = wsp<bfr>(p, OFF_S128);
  for (int i = gt; i < 128 * 128; i += nt) { int a = i >> 7, b = i & 127; float s, c; sincos_turn((double)((a * b) & 127) / 128.0, s, c); C128[i] = f2bf(c); S128[i] = f2bf(s); }
  bfr* C64 = wsp<bfr>(p, OFF_C64); bfr* S64 = wsp<bfr>(p, OFF_S64);
  for (int i = gt; i < 64 * 64; i += nt) { int a = i >> 6, b = i & 63; float s, c; sincos_turn((double)((a * b) & 63) / 64.0, s, c); C64[i] = f2bf(c); S64[i] = f2bf(s); }
  bfr* C256 = wsp<bfr>(p, OFF_C256); bfr* S256 = wsp<bfr>(p, OFF_S256);
  for (int i = gt; i < 256 * 256; i += nt) { int a = i >> 8, b = i & 255; float s, c; sincos_turn((double)((a * b) & 255) / 256.0, s, c); C256[i] = f2bf(c); S256[i] = f2bf(s); }
  float* ROPE = wsp<float>(p, OFF_ROPE);
  for (int i = gt; i < 2 * 128 * 16; i += nt) {
    int f = i & 15, idx = (i >> 4) & 127;
    float ang = (float)idx * (float)exp(-(double)f * 0.5756462732485115);
    float s, c; sincos_turn((double)ang / 6.283185307179586476925, s, c);
    ROPE[i] = c; ROPE[4096 + i] = s;
  }
}

DI void tcvt_unit(const float* __restrict__ src, int ld, int c0, int ncols, int K, bfr* __restrict__ dst, int dr0, int u, int tid) {
  const int ntk = K >> 6;
  const int tn = u / ntk, tk = u % ntk, k0 = tk * 64, nb = tn * 64;
  bfr* T = (bfr*)smem;
  float4 v[4];
  const int n4 = (tid & 15) * 4;
#pragma unroll
  for (int i = 0; i < 4; ++i) {
    const int kk = (tid >> 4) + 16 * i;
    v[i] = make_float4(0.f, 0.f, 0.f, 0.f);
    if (nb + n4 < ncols) v[i] = *(const float4*)(src + (size_t)(k0 + kk) * ld + c0 + nb + n4);
  }
#pragma unroll
  for (int i = 0; i < 4; ++i) {
    const int kk = (tid >> 4) + 16 * i;
    T[(n4 + 0) * 72 + kk] = f2bf(v[i].x); T[(n4 + 1) * 72 + kk] = f2bf(v[i].y);
    T[(n4 + 2) * 72 + kk] = f2bf(v[i].z); T[(n4 + 3) * 72 + kk] = f2bf(v[i].w);
  }
  __syncthreads();
  {
    int n = tid >> 2, kseg = (tid & 3) * 16;
    if (nb + n < ncols) {
      bfr* d = dst + (size_t)(dr0 + nb + n) * K + k0 + kseg;
      *(bf16x8*)d = *(const bf16x8*)(T + n * 72 + kseg);
      *(bf16x8*)(d + 8) = *(const bf16x8*)(T + n * 72 + kseg + 8);
    }
  }
  __syncthreads();
}

DI void wconv_phase(const DP& p, int layer) {
  const int tid = p.tidl;
  const int j = layer >> 1;
  bfr* WIN = wsp<bfr>(p, OFF_WIN); bfr* WOUT = wsp<bfr>(p, OFF_WOUT);
  bfr* WFF1 = wsp<bfr>(p, OFF_WFF1); bfr* WFF2 = wsp<bfr>(p, OFF_WFF2);
  const float* ff1 = p.w_ff1 + (size_t)layer * 1024 * 4096;
  const float* ff2 = p.w_ff2 + (size_t)layer * 4096 * 1024;
  float* cst = (float*)(smem + 20480);
  if (tid < 64) { float s, c; sincos_turn((double)tid / 64.0, s, c); cst[tid] = c; cst[64 + tid] = s; }
  __syncthreads();
  if ((layer & 1) == 0) {
    const float* win = p.w_in_even + (size_t)j * 1024 * 4656;
    const float* wout = p.w_out_even + (size_t)j * 2048 * 1024;
    const int n_in = 65 * 16, n_out = 16 * 32, n_f1 = 64 * 16, n_f2 = 16 * 64, n_fold = 128;
    const int total = n_in + n_out + n_f1 + n_f2 + n_fold;
    for (int u = p.bidl; u < total; u += gridDim.x) {
      int v = u;
      if (v < n_in) { tcvt_unit(win, 4656, 512, 4144, 1024, WIN, 1024, v, tid); continue; }
      v -= n_in;
      if (v < n_out) { tcvt_unit(wout, 1024, 0, 1024, 2048, WOUT, 0, v, tid); continue; }
      v -= n_out;
      if (v < n_f1) { tcvt_unit(ff1, 4096, 0, 4096, 1024, WFF1, 0, v, tid); continue; }
      v -= n_f1;
      if (v < n_f2) { tcvt_unit(ff2, 1024, 0, 1024, 4096, WFF2, 0, v, tid); continue; }
      v -= n_f2;
      {
        const int g = v >> 4, kb = v & 15;
        float* wt = (float*)smem;
#pragma unroll
        for (int i = 0; i < 4; ++i) {
          const int idx = tid + 256 * i, kk = idx >> 4, j4 = (idx & 15) * 4;
          const float4 wv = *(const float4*)(win + (size_t)(kb * 64 + kk) * 4656 + g * 64 + j4);
          wt[kk * 65 + j4] = wv.x; wt[kk * 65 + j4 + 1] = wv.y; wt[kk * 65 + j4 + 2] = wv.z; wt[kk * 65 + j4 + 3] = wv.w;
        }
        __syncthreads();
        const int kl = tid & 63, mg = tid >> 6;
#pragma unroll 1
        for (int mi = 0; mi < 16; ++mi) {
          const int m = mg * 16 + mi;
          float sc = 0.f, ss = 0.f;
#pragma unroll 8
          for (int jj = 0; jj < 64; ++jj) { const float w = wt[kl * 65 + jj]; const int idx = (m * jj) & 63; sc += w * cst[idx]; ss += w * cst[64 + idx]; }
          const int ch = g * 64 + m, k = kb * 64 + kl;
          WIN[(size_t)ch * 1024 + k] = f2bf(sc);
          WIN[(size_t)(512 + ch) * 1024 + k] = f2bf(-ss);
        }
        __syncthreads();
      }
    }
  } else {
    const float* win = p.w_in_odd + (size_t)j * 1024 * 2304;
    const float* wout = p.w_out_odd + (size_t)j * 1024 * 1024;
    const int n_in = 36 * 16, n_out = 16 * 16, n_f1 = 64 * 16, n_f2 = 16 * 64;
    const int total = n_in + n_out + n_f1 + n_f2;
    for (int u = p.bidl; u < total; u += gridDim.x) {
      int v = u;
      if (v < n_in) { tcvt_unit(win, 2304, 0, 2304, 1024, WIN, 0, v, tid); continue; }
      v -= n_in;
      if (v < n_out) { tcvt_unit(wout, 1024, 0, 1024, 1024, WOUT, 0, v, tid); continue; }
      v -= n_out;
      if (v < n_f1) { tcvt_unit(ff1, 4096, 0, 4096, 1024, WFF1, 0, v, tid); continue; }
      v -= n_f1;
      tcvt_unit(ff2, 1024, 0, 1024, 4096, WFF2, 0, v, tid);
    }
  }
}

DI void norm_phase(const DP& p, int layer, const float* __restrict__ gvec, int shc, int scc) {
  const int lane = p.tidl & 63;
  const int wg = p.bidl * 4 + (p.tidl >> 6), nw = gridDim.x * 4;
  const float* MOD = wsp<float>(p, OFF_MOD);
  const float* HC = wsp<float>(p, OFF_HC);
  bfr* U = wsp<bfr>(p, OFF_MIX);
#pragma unroll 1
  for (int row0 = wg; row0 < R; row0 += 2 * nw) {
    float4 v[2][4]; float ss[2] = {0.f, 0.f};
#pragma unroll
    for (int q = 0; q < 2; ++q) {
      const int row = row0 + q * nw < R ? row0 + q * nw : row0;
      const float* hp = row < RL ? p.out + (size_t)row * 1024 : HC + (size_t)(row - RL) * 1024;
#pragma unroll
      for (int i = 0; i < 4; ++i) v[q][i] = *(const float4*)(hp + i * 256 + lane * 4);
    }
#pragma unroll
    for (int q = 0; q < 2; ++q) {
#pragma unroll
      for (int i = 0; i < 4; ++i) ss[q] += v[q][i].x * v[q][i].x + v[q][i].y * v[q][i].y + v[q][i].z * v[q][i].z + v[q][i].w * v[q][i].w;
#pragma unroll
      for (int o = 32; o >= 1; o >>= 1) ss[q] += __shfl_xor(ss[q], o);
    }
#pragma unroll
    for (int q = 0; q < 2; ++q) {
      const int row = row0 + q * nw;
      if (row >= R) continue;
      const int ms = row < RL ? (row >> 13) : 2;
      const float* md = MOD + (layer * 3 + ms) * 6144;
      const float rs = rsqrtf(ss[q] * (1.f / 1024.f) + 1e-6f);
#pragma unroll
      for (int i = 0; i < 4; ++i) {
        int col = i * 256 + lane * 4;
        float4 g = *(const float4*)(gvec + col);
        float4 sc = *(const float4*)(md + scc * 1024 + col);
        float4 sh = *(const float4*)(md + shc * 1024 + col);
        bf16x4 o = pack4(v[q][i].x * rs * g.x * (1.f + sc.x) + sh.x, v[q][i].y * rs * g.y * (1.f + sc.y) + sh.y,
                         v[q][i].z * rs * g.z * (1.f + sc.z) + sh.z, v[q][i].w * rs * g.w * (1.f + sc.w) + sh.w);
        *(bf16x4*)(U + (size_t)row * 1024 + col) = o;
      }
    }
  }
}

enum { EPI_EVEN_IN = 0, EPI_ODD_IN = 1, EPI_RELU2 = 2, EPI_RESID = 3 };

DI void gemm_phase(const DP& p, int mode, const bfr* __restrict__ A, int lda, const bfr* __restrict__ Bt,
                   int N, int K, int layer, int gchunk, int nM) {
  const int tid = p.tidl, lane = tid & 63, wid = tid >> 6, r = lane & 31, h = lane >> 5;
  const int wm = wid >> 1, wn = wid & 1;
  const int nN = (N + 127) >> 7;
  const int tiles = nM * nN, G = (int)gridDim.x;
  int full = tiles, tail = 0, St = 1;
  if (mode == EPI_RESID) {
    full = (tiles / G) * G; tail = tiles - full;
    if (tail > 0) { int c = G / tail; int kmax = K >> 7; St = 1; while (St * 2 <= c && St * 2 <= 16 && St * 2 <= kmax) St *= 2; }
  }
  const int chunk = (full + 7) >> 3;
  const int units = chunk * 8 + tail * St;
  bfr* sm = (bfr*)smem;
  const int lrow = tid >> 3, lc = (tid & 7) * 8;
#pragma unroll 1
  for (int u = p.bidl; u < units; u += G) {
    int t, ks, Ks; bool atom;
    if (u < chunk * 8) {
      t = (u & 7) * chunk + (u >> 3);
      if (t >= full) continue;
      ks = 0; Ks = K; atom = false;
    } else { const int v = u - chunk * 8; t = full + v / St; ks = v % St; Ks = K / St; atom = St > 1; }
    const int nk = Ks >> 6;
    const int panel = t / (nM * 8); const int rem = t - panel * nM * 8;
    const int pw = (nN - panel * 8) < 8 ? (nN - panel * 8) : 8;
    const int tm = rem / pw, tn = panel * 8 + rem % pw;
    const int m0 = tm * 128, n0 = tn * 128, kbase = ks * Ks;
    f32x16 acc[2][2];
    acc[0][0] = zero16(); acc[0][1] = zero16(); acc[1][0] = zero16(); acc[1][1] = zero16();
    const bfr* Ag = A + (size_t)(m0 + lrow) * lda + kbase + lc;
    const bfr* Bg = Bt + (size_t)(n0 + lrow) * K + kbase + lc;
    bf16x8 ra[4], rb[4];
#pragma unroll
    for (int i = 0; i < 4; ++i) {
      ra[i] = *(const bf16x8*)(Ag + (size_t)(32 * i) * lda);
      rb[i] = *(const bf16x8*)(Bg + (size_t)(32 * i) * K);
    }
#pragma unroll
    for (int i = 0; i < 4; ++i) {
      *(bf16x8*)(sm + (lrow + 32 * i) * 72 + lc) = ra[i];
      *(bf16x8*)(sm + 9216 + (lrow + 32 * i) * 72 + lc) = rb[i];
    }
    if (nk > 1) {
#pragma unroll
      for (int i = 0; i < 4; ++i) {
        ra[i] = *(const bf16x8*)(Ag + (size_t)(32 * i) * lda + 64);
        rb[i] = *(const bf16x8*)(Bg + (size_t)(32 * i) * K + 64);
      }
    }
    __syncthreads();
#pragma unroll 1
    for (int kt = 0; kt < nk; ++kt) {
      if (kt + 1 < nk) {
        bfr* Ad = sm + ((kt + 1) & 1) * 18432;
#pragma unroll
        for (int i = 0; i < 4; ++i) {
          *(bf16x8*)(Ad + (lrow + 32 * i) * 72 + lc) = ra[i];
          *(bf16x8*)(Ad + 9216 + (lrow + 32 * i) * 72 + lc) = rb[i];
        }
      }
      if (kt + 2 < nk) {
#pragma unroll
        for (int i = 0; i < 4; ++i) {
          ra[i] = *(const bf16x8*)(Ag + (size_t)(32 * i) * lda + (kt + 2) * 64);
          rb[i] = *(const bf16x8*)(Bg + (size_t)(32 * i) * K + (kt + 2) * 64);
        }
      }
      const bfr* As = sm + (kt & 1) * 18432;
      const bfr* Bs = As + 9216;
      __builtin_amdgcn_s_setprio(1);
#pragma unroll
      for (int kk = 0; kk < 4; ++kk) {
        bf16x8 a0 = *(const bf16x8*)(As + (wm * 64 + r) * 72 + kk * 16 + h * 8);
        bf16x8 a1 = *(const bf16x8*)(As + (wm * 64 + 32 + r) * 72 + kk * 16 + h * 8);
        bf16x8 b0 = *(const bf16x8*)(Bs + (wn * 64 + r) * 72 + kk * 16 + h * 8);
        bf16x8 b1 = *(const bf16x8*)(Bs + (wn * 64 + 32 + r) * 72 + kk * 16 + h * 8);
        acc[0][0] = MFMA(a0, b0, acc[0][0]);
        acc[0][1] = MFMA(a0, b1, acc[0][1]);
        acc[1][0] = MFMA(a1, b0, acc[1][0]);
        acc[1][1] = MFMA(a1, b1, acc[1][1]);
      }
      __builtin_amdgcn_s_setprio(0);
      __syncthreads();
    }
    if (mode == EPI_RESID && !atom) {
      float hv[2][2][16], gt2[2][2];
#pragma unroll
      for (int mi = 0; mi < 2; ++mi)
#pragma unroll
        for (int ni = 0; ni < 2; ++ni) {
          const int col = n0 + wn * 64 + ni * 32 + r;
          const int rowb = m0 + wm * 64 + mi * 32 + 4 * h;
          const int ms = rowb < RL ? (rowb >> 13) : 2;
          gt2[mi][ni] = wsp<float>(p, OFF_MOD)[(layer * 3 + ms) * 6144 + gchunk * 1024 + col];
          const float* hp = rowb < RL ? p.out + (size_t)rowb * 1024 + col : wsp<float>(p, OFF_HC) + (size_t)(rowb - RL) * 1024 + col;
#pragma unroll
          for (int i = 0; i < 16; ++i) hv[mi][ni][i] = hp[(size_t)((i & 3) + 8 * (i >> 2)) * 1024];
        }
#pragma unroll
      for (int mi = 0; mi < 2; ++mi)
#pragma unroll
        for (int ni = 0; ni < 2; ++ni) {
          const int col = n0 + wn * 64 + ni * 32 + r;
          const int rowb = m0 + wm * 64 + mi * 32 + 4 * h;
          float* hp = rowb < RL ? p.out + (size_t)rowb * 1024 + col : wsp<float>(p, OFF_HC) + (size_t)(rowb - RL) * 1024 + col;
#pragma unroll
          for (int i = 0; i < 16; ++i) hp[(size_t)((i & 3) + 8 * (i >> 2)) * 1024] = hv[mi][ni][i] + gt2[mi][ni] * acc[mi][ni][i];
        }
      continue;
    }
    const int cbw = n0 + wn * 64;
    const bool qkfuse = mode == EPI_ODD_IN && !((cbw >= 640 && cbw < 768) || cbw >= 1792);
    if (qkfuse) {
      float* T = (float*)smem + wid * 4160;
#pragma unroll
      for (int mi = 0; mi < 2; ++mi)
#pragma unroll
        for (int ni = 0; ni < 2; ++ni)
#pragma unroll
          for (int i = 0; i < 16; ++i) T[(mi * 32 + crow(i, h)) * 65 + ni * 32 + r] = acc[mi][ni][i];
      asm volatile("s_waitcnt lgkmcnt(0)" ::: "memory");
      const int hs = cbw < 640 ? (cbw >> 6) : 10 + ((cbw - 768) >> 6);
      const int jj = layer >> 1;
      const float* gv = hs < 8 ? p.q_norm_win + jj * 64 : hs < 10 ? p.k_norm_win + jj * 64 : hs < 18 ? p.q_norm_na + jj * 64 : p.k_norm_na + jj * 64;
      const float qs = (hs < 8 || (hs >= 10 && hs < 18)) ? 0.125f : 1.f;
      const int row = m0 + wm * 64 + lane;
      float ss = 0.f;
#pragma unroll
      for (int d = 0; d < 64; ++d) { const float t = T[lane * 65 + d]; ss += t * t; }
      const float rs = rsqrtf(ss * (1.f / 64.f) + 1e-6f);
      const bool dorope = hs < 10 && row < RL;
      const float* ROPE = wsp<float>(p, OFF_ROPE);
      const int pos = row & 8191;
      bfr* dst = wsp<bfr>(p, OFF_QK) + (size_t)row * 1664 + hs * 64;
#pragma unroll
      for (int a = 0; a < 2; ++a) {
        float x[32];
#pragma unroll
        for (int d = 0; d < 32; ++d) x[d] = T[lane * 65 + a * 32 + d] * rs * gv[a * 32 + d];
        if (dorope) {
          const int idx = a == 0 ? (pos >> 6) : 128 + (pos & 63);
#pragma unroll
          for (int f4 = 0; f4 < 4; ++f4) {
            const float4 c4 = *(const float4*)(ROPE + idx * 16 + f4 * 4), s4 = *(const float4*)(ROPE + 4096 + idx * 16 + f4 * 4);
            const float cc[4] = {c4.x, c4.y, c4.z, c4.w}, sn[4] = {s4.x, s4.y, s4.z, s4.w};
#pragma unroll
            for (int q = 0; q < 4; ++q) {
              const int f = f4 * 4 + q;
              const float x1 = x[f], x2 = x[16 + f];
              x[f] = x1 * cc[q] - x2 * sn[q];
              x[16 + f] = x2 * cc[q] + x1 * sn[q];
            }
          }
        }
#pragma unroll
        for (int k8 = 0; k8 < 4; ++k8)
          *(bf16x8*)(dst + a * 32 + k8 * 8) = pack8(x[k8 * 8] * qs, x[k8 * 8 + 1] * qs, x[k8 * 8 + 2] * qs, x[k8 * 8 + 3] * qs,
                                                    x[k8 * 8 + 4] * qs, x[k8 * 8 + 5] * qs, x[k8 * 8 + 6] * qs, x[k8 * 8 + 7] * qs);
      }
    }
    if (!qkfuse)
#pragma unroll
    for (int mi = 0; mi < 2; ++mi)
#pragma unroll
      for (int ni = 0; ni < 2; ++ni)
#pragma unroll
        for (int g4 = 0; g4 < 4; ++g4) {
          const int row = m0 + wm * 64 + mi * 32 + 8 * g4 + 4 * h;
          const int col = n0 + wn * 64 + ni * 32 + r;
          const float v0 = acc[mi][ni][4 * g4], v1 = acc[mi][ni][4 * g4 + 1], v2 = acc[mi][ni][4 * g4 + 2], v3 = acc[mi][ni][4 * g4 + 3];
          if (mode == EPI_EVEN_IN) {
            if (col < 1024) {
              bfr* dst = wsp<bfr>(p, col < 512 ? OFF_ZRT : OFF_ZIT) + (size_t)(col & 511) * R + row;
              *(bf16x4*)dst = pack4(v0, v1, v2, v3);
            } else if (col < 2560) {
              bfr* dst = wsp<bfr>(p, OFF_Z) + (size_t)row * 1536 + (col - 1024);
              dst[0] = f2bf(v0); dst[1536] = f2bf(v1); dst[2 * 1536] = f2bf(v2); dst[3 * 1536] = f2bf(v3);
            } else if (col < 5120) {
              bfr* dst = wsp<bfr>(p, OFF_XBC) + (size_t)row * 2560 + (col - 2560);
              dst[0] = f2bf(v0); dst[2560] = f2bf(v1); dst[2 * 2560] = f2bf(v2); dst[3 * 2560] = f2bf(v3);
            } else if (col < 5168) {
              float* dst = wsp<float>(p, OFF_DTRAW) + (size_t)row * 48 + (col - 5120);
              dst[0] = v0; dst[48] = v1; dst[96] = v2; dst[144] = v3;
            }
          } else if (mode == EPI_ODD_IN) {
            if (col >= 640 && col < 768) {
              *(bf16x4*)(wsp<bfr>(p, OFF_VT) + (size_t)(col - 640) * R + row) = pack4(v0, v1, v2, v3);
            } else if (col >= 1792) {
              *(bf16x4*)(wsp<bfr>(p, OFF_VT) + (size_t)(128 + col - 1792) * R + row) = pack4(v0, v1, v2, v3);
            } else {
              bfr* dst = wsp<bfr>(p, OFF_P) + (size_t)row * 2304 + col;
              dst[0] = f2bf(v0); dst[2304] = f2bf(v1); dst[2 * 2304] = f2bf(v2); dst[3 * 2304] = f2bf(v3);
            }
          } else if (mode == EPI_RELU2) {
            bfr* dst = wsp<bfr>(p, OFF_ACT) + (size_t)row * 4096 + col;
            float t0 = fmaxf(v0, 0.f), t1 = fmaxf(v1, 0.f), t2 = fmaxf(v2, 0.f), t3 = fmaxf(v3, 0.f);
            dst[0] = f2bf(t0 * t0); dst[4096] = f2bf(t1 * t1); dst[2 * 4096] = f2bf(t2 * t2); dst[3 * 4096] = f2bf(t3 * t3);
          } else if (mode == EPI_RESID) {
            const int ms = row < RL ? (row >> 13) : 2;
            const float gate = wsp<float>(p, OFF_MOD)[(layer * 3 + ms) * 6144 + gchunk * 1024 + col];
            float* hp = row < RL ? p.out + (size_t)row * 1024 + col : wsp<float>(p, OFF_HC) + (size_t)(row - RL) * 1024 + col;
            if (atom) {
              unsafeAtomicAdd(hp, gate * v0); unsafeAtomicAdd(hp + 1024, gate * v1);
              unsafeAtomicAdd(hp + 2048, gate * v2); unsafeAtomicAdd(hp + 3072, gate * v3);
            } else {
              hp[0] += gate * v0; hp[1024] += gate * v1; hp[2048] += gate * v2; hp[3072] += gate * v3;
            }
          }
        }
    if (mode == EPI_ODD_IN) __syncthreads();
  }
}

DI float softplus_f(float x) { return x > 0.f ? x + log1pf(expf(-x)) : log1pf(expf(x)); }

DI void conv_dt_phase(const DP& p, int j) {
  const int tid = p.tidl, lane = tid & 63, wid = tid >> 6;
  const bfr* XBC = wsp<bfr>(p, OFF_XBC);
  bfr* XT = wsp<bfr>(p, OFF_XT); bfr* BN = wsp<bfr>(p, OFF_BN); bfr* BTt = wsp<bfr>(p, OFF_BT); bfr* CN = wsp<bfr>(p, OFF_CN);
  bfr* TT = (bfr*)smem;
  const float* cw = p.conv_w + (size_t)j * 5 * 2560;
  const float* cb = p.conv_b + (size_t)j * 2560;
  const int n_conv = 264 * 40, n_dt = 792;
  for (int u = p.bidl; u < n_conv + n_dt; u += gridDim.x) {
    if (u < n_conv) {
      const int tb = u / 40, cbk = u % 40, row0 = tb * 64, ch0 = cbk * 64;
      int pos0, len;
      if (row0 < RL) { pos0 = row0 & 8191; len = SEQ; } else { pos0 = (row0 - RL) & 255; len = CTX; }
      const int c8 = tid & 7, ch = ch0 + c8 * 8;
      float w[5][8], bias[8];
#pragma unroll
      for (int k = 0; k < 5; ++k) {
        float4 wa = *(const float4*)(cw + k * 2560 + ch), wb = *(const float4*)(cw + k * 2560 + ch + 4);
        w[k][0] = wa.x; w[k][1] = wa.y; w[k][2] = wa.z; w[k][3] = wa.w; w[k][4] = wb.x; w[k][5] = wb.y; w[k][6] = wb.z; w[k][7] = wb.w;
      }
      {
        float4 wa = *(const float4*)(cb + ch), wb = *(const float4*)(cb + ch + 4);
        bias[0] = wa.x; bias[1] = wa.y; bias[2] = wa.z; bias[3] = wa.w; bias[4] = wb.x; bias[5] = wb.y; bias[6] = wb.z; bias[7] = wb.w;
      }
#pragma unroll
      for (int ps = 0; ps < 2; ++ps) {
        const int tl = (tid >> 3) + 32 * ps, pos = pos0 + tl, row = row0 + tl;
        float a[8];
#pragma unroll
        for (int e = 0; e < 8; ++e) a[e] = bias[e];
        bf16x8 xr[5];
#pragma unroll
        for (int k = 0; k < 5; ++k) {
          const int pp = pos + k - 2;
          const bool ok = pp >= 0 && pp < len;
          const bfr* xp = XBC + (size_t)(ok ? row + k - 2 : row) * 2560 + ch;
          xr[k] = *(const bf16x8*)xp;
          if (!ok) { for (int e = 0; e < 8; ++e) xr[k][e] = 0; }
        }
#pragma unroll
        for (int k = 0; k < 5; ++k)
#pragma unroll
          for (int e = 0; e < 8; ++e) a[e] += w[k][e] * bfs(xr[k][e]);
        bf16x8 o;
#pragma unroll
        for (int e = 0; e < 8; ++e) { float s = a[e] / (1.f + __expf(-a[e])); o[e] = (short)f2bf(s); }
        if (ch0 >= 2048) *(bf16x8*)(CN + (size_t)row * 512 + (ch - 2048)) = o;
        else if (ch0 >= 1536) *(bf16x8*)(BN + (size_t)row * 512 + (ch - 1536)) = o;
        if (ch0 < 2048) {
#pragma unroll
          for (int e = 0; e < 8; ++e) TT[(c8 * 8 + e) * 72 + tl] = (bfr)o[e];
        }
      }
      if (ch0 < 2048) {
        __syncthreads();
        const int chl = tid >> 2, tseg = (tid & 3) * 16;
        bfr* dst = (ch0 < 1536 ? XT + (size_t)(ch0 + chl) * R : BTt + (size_t)(ch0 - 1536 + chl) * R) + row0 + tseg;
        *(bf16x8*)dst = *(const bf16x8*)(TT + chl * 72 + tseg);
        *(bf16x8*)(dst + 8) = *(const bf16x8*)(TT + chl * 72 + tseg + 8);
        __syncthreads();
      }
    } else {
      const int item = (u - n_conv) * 4 + wid;
      const int head = item % 24; int rest = item / 24; const int dir = rest & 1; rest >>= 1; const int c = rest % NCH, b = rest / NCH;
      const int row0 = chunk_row0(b, c), col = dir * 24 + head;
      const float bias = p.dt_bias[j * 48 + col];
      const float a = -expf(p.a_log[j * 48 + col]);
      const float* DTRAW = wsp<float>(p, OFF_DTRAW);
      float dt[4], cs[4];
      float run = 0.f;
#pragma unroll
      for (int q = 0; q < 4; ++q) {
        dt[q] = softplus_f(DTRAW[(size_t)(row0 + lane * 4 + q) * 48 + col] + bias);
        run += dt[q] * a; cs[q] = run;
      }
      float x = run;
#pragma unroll
      for (int o = 1; o < 64; o <<= 1) { float t2 = __shfl_up(x, o); if (lane >= o) x += t2; }
      const float excl = x - run;
      const float total = __shfl(x, 63);
      float ac[4];
#pragma unroll
      for (int q = 0; q < 4; ++q) {
        float inc = excl + cs[q];
        ac[q] = dir == 0 ? inc : total - inc + dt[q] * a;
      }
      const size_t base = ((size_t)(((dir * 2 + b) * NCH + c) * 24 + head)) * 256 + lane * 4;
      *(float4*)(wsp<float>(p, OFF_DTV) + base) = make_float4(dt[0], dt[1], dt[2], dt[3]);
      *(float4*)(wsp<float>(p, OFF_ACUM) + base) = make_float4(ac[0], ac[1], ac[2], ac[3]);
    }
  }
}

DI bf16x8 scale8(bf16x8 a, const float* w) {
  return pack8(bfs(a[0]) * w[0], bfs(a[1]) * w[1], bfs(a[2]) * w[2], bfs(a[3]) * w[3],
               bfs(a[4]) * w[4], bfs(a[5]) * w[5], bfs(a[6]) * w[6], bfs(a[7]) * w[7]);
}

DI void s1_item(const DP& p, int item, int lane) {
  const int r = lane & 31, h = lane >> 5;
  const int head = item % 24; int rest = item / 24; const int dir = rest & 1; rest >>= 1; const int c = rest % NCH, b = rest / NCH;
  const int g = head / 6;
  const int row0 = chunk_row0(b, c);
  const size_t dbase = ((size_t)(((dir * 2 + b) * NCH + c) * 24 + head)) * 256;
  const float* dtv = wsp<float>(p, OFF_DTV) + dbase;
  const float* acm = wsp<float>(p, OFF_ACUM) + dbase;
  const float acend = dir == 0 ? acm[255] : acm[0];
  const bfr* XT = wsp<bfr>(p, OFF_XT); const bfr* BTt = wsp<bfr>(p, OFF_BT);
  bfr* HS = wsp<bfr>(p, OFF_HS) + ((size_t)(((dir * 2 + b) * NCH + c) * 24 + head)) * 8192;
#pragma unroll 1
  for (int pt = 0; pt < 2; ++pt) {
    f32x16 acc[4];
#pragma unroll
    for (int n = 0; n < 4; ++n) acc[n] = zero16();
#pragma unroll 4
    for (int kk = 0; kk < 16; ++kk) {
      const int s0 = kk * 16 + 8 * h;
      float4 d0 = *(const float4*)(dtv + s0), d1 = *(const float4*)(dtv + s0 + 4);
      float4 a0 = *(const float4*)(acm + s0), a1 = *(const float4*)(acm + s0 + 4);
      float w[8];
      w[0] = d0.x * __expf(acend - a0.x); w[1] = d0.y * __expf(acend - a0.y); w[2] = d0.z * __expf(acend - a0.z); w[3] = d0.w * __expf(acend - a0.w);
      w[4] = d1.x * __expf(acend - a1.x); w[5] = d1.y * __expf(acend - a1.y); w[6] = d1.z * __expf(acend - a1.z); w[7] = d1.w * __expf(acend - a1.w);
      bf16x8 af = scale8(*(const bf16x8*)(XT + (size_t)(head * 64 + pt * 32 + r) * R + row0 + s0), w);
#pragma unroll
      for (int nt = 0; nt < 4; ++nt) {
        bf16x8 bfv = *(const bf16x8*)(BTt + (size_t)(g * 128 + nt * 32 + r) * R + row0 + s0);
        acc[nt] = MFMA(af, bfv, acc[nt]);
      }
    }
#pragma unroll
    for (int nt = 0; nt < 4; ++nt)
#pragma unroll
      for (int i = 0; i < 16; ++i) HS[(pt * 32 + crow(i, h)) * 128 + nt * 32 + r] = f2bf(acc[nt][i]);
  }
}

DI void s1_block(const DP& p, int item) {
  const int tid = p.tidl, lane = tid & 63, wid = tid >> 6, r = lane & 31, h = lane >> 5;
  const int g = item & 3; const int bc = item >> 2; const int c = bc % NCH, b = bc / NCH;
  const int row0 = chunk_row0(b, c);
  const bfr* XT = wsp<bfr>(p, OFF_XT); const bfr* BTt = wsp<bfr>(p, OFF_BT);
  bfr* BS = (bfr*)smem;
  __syncthreads();
#pragma unroll 4
  for (int i = 0; i < 32; ++i) {
    const int row = wid * 32 + i;
    if (lane < 32)
      __builtin_amdgcn_global_load_lds((const unsigned*)(BTt + (size_t)(g * 128 + row) * R + row0 + lane * 8),
                                       (unsigned*)(BS + row * 264 + lane * 8), 16, 0, 0);
  }
  asm volatile("s_waitcnt vmcnt(0)" ::: "memory");
  __syncthreads();
#pragma unroll 1
  for (int j3 = 0; j3 < 3; ++j3) {
    const int pi = wid * 3 + j3, dir = pi / 6, head = g * 6 + pi % 6;
    const size_t ci = (size_t)(((dir * 2 + b) * NCH + c) * 24 + head);
    const float* dtv = wsp<float>(p, OFF_DTV) + ci * 256;
    const float* acm = wsp<float>(p, OFF_ACUM) + ci * 256;
    const float acend = dir == 0 ? acm[255] : acm[0];
    bfr* HS = wsp<bfr>(p, OFF_HS) + ci * 8192;
    float* WS = (float*)(smem + 67584) + wid * 256;
    {
      const float4 d4 = *(const float4*)(dtv + lane * 4), a4 = *(const float4*)(acm + lane * 4);
      asm volatile("" ::: "memory");
      *(float4*)(WS + lane * 4) = make_float4(d4.x * __expf(acend - a4.x), d4.y * __expf(acend - a4.y),
                                              d4.z * __expf(acend - a4.z), d4.w * __expf(acend - a4.w));
      asm volatile("s_waitcnt lgkmcnt(0)" ::: "memory");
    }
#pragma unroll 1
    for (int pt = 0; pt < 2; ++pt) {
      f32x16 acc[4];
#pragma unroll
      for (int n = 0; n < 4; ++n) acc[n] = zero16();
#pragma unroll 4
      for (int kk = 0; kk < 16; ++kk) {
        const int s0 = kk * 16 + 8 * h;
        const float4 w0 = *(const float4*)(WS + s0), w1 = *(const float4*)(WS + s0 + 4);
        const float w[8] = {w0.x, w0.y, w0.z, w0.w, w1.x, w1.y, w1.z, w1.w};
        bf16x8 af = scale8(*(const bf16x8*)(XT + (size_t)(head * 64 + pt * 32 + r) * R + row0 + s0), w);
#pragma unroll
        for (int nt = 0; nt < 4; ++nt) {
          bf16x8 bfv = *(const bf16x8*)(BS + (nt * 32 + r) * 264 + s0);
          acc[nt] = MFMA(af, bfv, acc[nt]);
        }
      }
#pragma unroll
      for (int nt = 0; nt < 4; ++nt)
#pragma unroll
        for (int i = 0; i < 16; ++i) HS[(pt * 32 + crow(i, h)) * 128 + nt * 32 + r] = f2bf(acc[nt][i]);
    }
  }
}

DI void f1_item(const DP& p, int item, int lane) {
  const int r = lane & 31, h = lane >> 5;
  const int l2t = item & 1, m = (item >> 1) & 511, b = item >> 10;
  const bfr* ZRT = wsp<bfr>(p, OFF_ZRT) + (size_t)m * R + b * SEQ + l2t * 32 + r;
  const bfr* ZIT = wsp<bfr>(p, OFF_ZIT) + (size_t)m * R + b * SEQ + l2t * 32 + r;
  const bfr* C128 = wsp<bfr>(p, OFF_C128); const bfr* S128 = wsp<bfr>(p, OFF_S128);
  const float2* TW = wsp<float2>(p, OFF_TW);
  bfr* YR = wsp<bfr>(p, OFF_YR); bfr* YI = wsp<bfr>(p, OFF_YI);
  const int l2 = l2t * 32 + r;
#pragma unroll 1
  for (int mh = 0; mh < 2; ++mh) {
    f32x16 yr[2], yi[2];
#pragma unroll
    for (int i = 0; i < 2; ++i) { yr[i] = zero16(); yi[i] = zero16(); }
#pragma unroll 2
    for (int kk = 0; kk < 8; ++kk) {
      bf16x8 zr, zi, nzr;
#pragma unroll
      for (int jj = 0; jj < 8; ++jj) {
        int l1 = kk * 16 + 8 * h + jj;
        zr[jj] = (short)ZRT[l1 * 64]; zi[jj] = (short)ZIT[l1 * 64];
        nzr[jj] = (short)(zr[jj] ^ (short)0x8000);
      }
#pragma unroll
      for (int m2 = 0; m2 < 2; ++m2) {
        const int mt = mh * 2 + m2;
        bf16x8 ca = *(const bf16x8*)(C128 + (mt * 32 + r) * 128 + kk * 16 + 8 * h);
        bf16x8 sa = *(const bf16x8*)(S128 + (mt * 32 + r) * 128 + kk * 16 + 8 * h);
        yr[m2] = MFMA(ca, zr, yr[m2]); yr[m2] = MFMA(sa, zi, yr[m2]);
        yi[m2] = MFMA(ca, zi, yi[m2]); yi[m2] = MFMA(sa, nzr, yi[m2]);
      }
    }
#pragma unroll
    for (int m2 = 0; m2 < 2; ++m2)
#pragma unroll
      for (int i = 0; i < 16; ++i) {
        int k1 = (mh * 2 + m2) * 32 + crow(i, h);
        float2 t = TW[k1 * l2];
        float a = yr[m2][i], bb = yi[m2][i];
        size_t o = ((size_t)(b * 512 + m) * 128 + k1) * 64 + l2;
        YR[o] = f2bf(a * t.x + bb * t.y);
        YI[o] = f2bf(bb * t.x - a * t.y);
      }
  }
}

DI void f1c_item(const DP& p, int item, int lane) {
  const int r = lane & 31, h = lane >> 5;
  const int mt = item & 15, kt = (item >> 4) & 7, b = item >> 7;
  const int m = mt * 32 + r;
  const bfr* ZRT = wsp<bfr>(p, OFF_ZRT) + (size_t)m * R + RL + b * CTX;
  const bfr* ZIT = wsp<bfr>(p, OFF_ZIT) + (size_t)m * R + RL + b * CTX;
  const bfr* C256 = wsp<bfr>(p, OFF_C256) + (kt * 32 + r) * 256;
  const bfr* S256 = wsp<bfr>(p, OFF_S256) + (kt * 32 + r) * 256;
  f32x16 acc = zero16();
#pragma unroll 4
  for (int kk = 0; kk < 16; ++kk) {
    int o = kk * 16 + 8 * h;
    acc = MFMA(*(const bf16x8*)(C256 + o), *(const bf16x8*)(ZRT + o), acc);
    acc = MFMA(*(const bf16x8*)(S256 + o), *(const bf16x8*)(ZIT + o), acc);
  }
  bfr* MIX = wsp<bfr>(p, OFF_MIX);
#pragma unroll
  for (int i = 0; i < 16; ++i)
    MIX[(size_t)(RL + b * CTX + kt * 32 + crow(i, h)) * 2048 + m] = f2bf(acc[i] * (1.f / 128.f));
}

DI void s1f1_phase(const DP& p) {
  const int nS1 = 2 * NCH * 4;
  const int G = (int)gridDim.x;
  if (G > nS1 + 64) {
    if (p.bidl < nS1) { s1_block(p, p.bidl); return; }
    const int lane = p.tidl & 63;
    const int wg = (p.bidl - nS1) * 4 + (p.tidl >> 6), nw = (G - nS1) * 4;
#pragma unroll 1
    for (int it = wg; it < 2048 + 256; it += nw) {
      if (it < 2048) f1_item(p, it, lane); else f1c_item(p, it - 2048, lane);
    }
  } else {
#pragma unroll 1
    for (int it = p.bidl; it < nS1; it += G) s1_block(p, it);
    const int lane = p.tidl & 63;
    const int wg = p.bidl * 4 + (p.tidl >> 6), nw = G * 4;
#pragma unroll 1
    for (int it = wg; it < 2048 + 256; it += nw) {
      if (it < 2048) f1_item(p, it, lane); else f1c_item(p, it - 2048, lane);
    }
  }
}

DI void f2_item(const DP& p, int item, int lane) {
  const int r = lane & 31, h = lane >> 5;
  const int mt16 = item & 15, k1 = (item >> 4) & 127, b = item >> 11;
  const int m = mt16 * 32 + r;
  const bfr* YR = wsp<bfr>(p, OFF_YR) + ((size_t)(b * 512 + m) * 128 + k1) * 64;
  const bfr* YI = wsp<bfr>(p, OFF_YI) + ((size_t)(b * 512 + m) * 128 + k1) * 64;
  const bfr* C64 = wsp<bfr>(p, OFF_C64); const bfr* S64 = wsp<bfr>(p, OFF_S64);
  f32x16 acc[2]; acc[0] = zero16(); acc[1] = zero16();
#pragma unroll
  for (int kk = 0; kk < 4; ++kk) {
    bf16x8 yr = *(const bf16x8*)(YR + kk * 16 + 8 * h), yi = *(const bf16x8*)(YI + kk * 16 + 8 * h);
#pragma unroll
    for (int t = 0; t < 2; ++t) {
      bf16x8 ca = *(const bf16x8*)(C64 + (t * 32 + r) * 64 + kk * 16 + 8 * h);
      bf16x8 sa = *(const bf16x8*)(S64 + (t * 32 + r) * 64 + kk * 16 + 8 * h);
      acc[t] = MFMA(ca, yr, acc[t]); acc[t] = MFMA(sa, yi, acc[t]);
    }
  }
  bfr* MIX = wsp<bfr>(p, OFF_MIX);
  const float scale = 0.001381067932f;
#pragma unroll
  for (int t = 0; t < 2; ++t)
#pragma unroll
    for (int i = 0; i < 16; ++i) {
      int k2 = t * 32 + crow(i, h);
      MIX[(size_t)(b * SEQ + k1 + 128 * k2) * 2048 + m] = f2bf(acc[t][i] * scale);
    }
}

DI void s3_block(const DP& p, int j, int b, int c, int g, int half);

DI void s2f2_phase(const DP& p, int j) {
  if (p.bidl < 16) {
    const int k = p.bidl;
    s3_block(p, j, k >> 3, 0, (k >> 1) & 3, k & 1);
    return;
  }
  const int gt = (p.bidl - 16) * 256 + p.tidl, nt = ((int)gridDim.x - 16) * 256;
  bfr* HSb = wsp<bfr>(p, OFF_HS);
  const float* ACUM = wsp<float>(p, OFF_ACUM);
#pragma unroll 1
  for (int it = gt; it < 2 * 2 * 24 * 2048; it += nt) {
    const int e4 = it & 2047; const int rest = it >> 11; const int head = rest % 24, db = rest / 24, dir = db >> 1;
    bf16x4 sv[NCH]; float cd[NCH];
#pragma unroll
    for (int step = 0; step < NCH; ++step) {
      const int c = dir == 0 ? step : (step == 0 ? 0 : NCH - step);
      const size_t ci = (size_t)((db * NCH + c) * 24 + head);
      sv[step] = *(const bf16x4*)(HSb + ci * 8192 + e4 * 4);
      cd[step] = ACUM[ci * 256 + (dir == 0 ? 255 : 0)];
    }
    float h0 = 0.f, h1 = 0.f, h2 = 0.f, h3 = 0.f;
#pragma unroll
    for (int step = 0; step < NCH; ++step) {
      const int c = dir == 0 ? step : (step == 0 ? 0 : NCH - step);
      const size_t ci = (size_t)((db * NCH + c) * 24 + head);
      *(bf16x4*)(HSb + ci * 8192 + e4 * 4) = pack4(h0, h1, h2, h3);
      const float e = __expf(cd[step]);
      h0 = h0 * e + bfs(sv[step][0]); h1 = h1 * e + bfs(sv[step][1]); h2 = h2 * e + bfs(sv[step][2]); h3 = h3 * e + bfs(sv[step][3]);
    }
  }
  const int lane = p.tidl & 63;
  const int wg = (p.bidl - 16) * 4 + (p.tidl >> 6), nw = ((int)gridDim.x - 16) * 4;
#pragma unroll 1
  for (int it = wg; it < 4096; it += nw) f2_item(p, it, lane);
}

DI void s3_block(const DP& p, int j, int b, int c, int g, int half) {
  const int tid = p.tidl, lane = tid & 63, wid = tid >> 6, r = lane & 31, h = lane >> 5;
  const bfr* CN = wsp<bfr>(p, OFF_CN); const bfr* BN = wsp<bfr>(p, OFF_BN); const bfr* XT = wsp<bfr>(p, OFF_XT);
  const bfr* Z = wsp<bfr>(p, OFF_Z); bfr* MIX = wsp<bfr>(p, OFF_MIX);
  bfr* XTs = (bfr*)smem;
  bfr* HSF = (bfr*)(smem + 33792);
  bfr* HSB = (bfr*)(smem + 51200);
  float* LWF = (float*)(smem + 68608);
  float* LWB = LWF + 256;
  {
    const int row0 = chunk_row0(b, c);
    const int lt = half * 4 + wid;
    const int rowl = row0 + lt * 32 + r;
    const bfr* cfp = CN + (size_t)rowl * 512 + g * 128 + 8 * h;
    bf16x8 gtp[8][2];
    {
      bf16x8 cf[8];
#pragma unroll
      for (int kk = 0; kk < 8; ++kk) cf[kk] = *(const bf16x8*)(cfp + kk * 16);
#pragma unroll
      for (int k = 0; k < 8; ++k) { gtp[k][0] = cf[0]; gtp[k][1] = cf[0]; }
      __syncthreads();
      {
        bfr* BS = (bfr*)smem;
#pragma unroll 4
        for (int i = 0; i < 64; ++i) {
          const int row = wid * 64 + i;
          if (lane < 16)
            __builtin_amdgcn_global_load_lds((const unsigned*)(BN + (size_t)(row0 + row) * 512 + g * 128 + lane * 8),
                                             (unsigned*)(BS + row * 136 + lane * 8), 16, 0, 0);
        }
      }
      asm volatile("s_waitcnt vmcnt(0)" ::: "memory");
      __syncthreads();
#pragma unroll 1
      for (int st = 0; st < 8; ++st) {
        f32x16 gt = zero16();
#pragma unroll
        for (int kk = 0; kk < 8; ++kk)
          gt = MFMA(*(const bf16x8*)((const bfr*)smem + (st * 32 + r) * 136 + kk * 16 + 8 * h), cf[kk], gt);
#pragma unroll
        for (int k = 0; k < 7; ++k) { gtp[k][0] = gtp[k + 1][0]; gtp[k][1] = gtp[k + 1][1]; }
        gtp[7][0] = PACK_HALF(gt, 0); gtp[7][1] = PACK_HALF(gt, 1);
      }
    }
    float sumsq = 0.f;
#pragma unroll 1
    for (int hh = 0; hh < 6; ++hh) {
      const int head = g * 6 + hh;
      const size_t cif = (size_t)(((0 * 2 + b) * NCH + c) * 24 + head), cib = (size_t)(((1 * 2 + b) * NCH + c) * 24 + head);
      const float* acf = wsp<float>(p, OFF_ACUM) + cif * 256; const float* acb = wsp<float>(p, OFF_ACUM) + cib * 256;
      const float* dtf = wsp<float>(p, OFF_DTV) + cif * 256; const float* dtb = wsp<float>(p, OFF_DTV) + cib * 256;
      const bfr* HSf = wsp<bfr>(p, OFF_HS) + cif * 8192; const bfr* HSbk = wsp<bfr>(p, OFF_HS) + cib * 8192;
      __syncthreads();
#pragma unroll 4
      for (int i = 0; i < 16; ++i) {
        const int row = wid * 16 + i;
        if (lane < 32)
          __builtin_amdgcn_global_load_lds((const unsigned*)(XT + (size_t)(head * 64 + row) * R + row0 + lane * 8),
                                           (unsigned*)(XTs + row * 264 + lane * 8), 16, 0, 0);
      }
      if (c != 0) {
#pragma unroll 4
        for (int i = 0; i < 16; ++i) {
          const int row = wid * 16 + i;
          if (lane < 16) {
            __builtin_amdgcn_global_load_lds((const unsigned*)(HSf + row * 128 + lane * 8), (unsigned*)(HSF + row * 136 + lane * 8), 16, 0, 0);
            __builtin_amdgcn_global_load_lds((const unsigned*)(HSbk + row * 128 + lane * 8), (unsigned*)(HSB + row * 136 + lane * 8), 16, 0, 0);
          }
        }
      }
      bf16x8 cfh[8];
#pragma unroll
      for (int kk = 0; kk < 8; ++kk) cfh[kk] = *(const bf16x8*)(cfp + kk * 16);
      LWF[tid] = __logf(dtf[tid]) - acf[tid];
      LWB[tid] = __logf(dtb[tid]) - acb[tid];
      const float al_f = acf[lt * 32 + r], al_b = acb[lt * 32 + r];
      asm volatile("s_waitcnt vmcnt(0)" ::: "memory");
      __syncthreads();
      f32x16 acc[2];
      acc[0] = zero16(); acc[1] = zero16();
      if (c != 0) {
        f32x16 t0 = zero16(), t1 = zero16();
#pragma unroll
        for (int kk = 0; kk < 8; ++kk) {
          t0 = MFMA(*(const bf16x8*)(HSF + (r) * 136 + kk * 16 + 8 * h), cfh[kk], t0);
          t1 = MFMA(*(const bf16x8*)(HSF + (32 + r) * 136 + kk * 16 + 8 * h), cfh[kk], t1);
        }
        const float ef = __expf(al_f);
#pragma unroll
        for (int i = 0; i < 16; ++i) { acc[0][i] = t0[i] * ef; acc[1][i] = t1[i] * ef; }
        t0 = zero16(); t1 = zero16();
#pragma unroll
        for (int kk = 0; kk < 8; ++kk) {
          t0 = MFMA(*(const bf16x8*)(HSB + (r) * 136 + kk * 16 + 8 * h), cfh[kk], t0);
          t1 = MFMA(*(const bf16x8*)(HSB + (32 + r) * 136 + kk * 16 + 8 * h), cfh[kk], t1);
        }
        const float eb = __expf(al_b);
#pragma unroll
        for (int i = 0; i < 16; ++i) { acc[0][i] += t0[i] * eb; acc[1][i] += t1[i] * eb; }
      }
      bf16x4 zpre[2][4];
#pragma unroll
      for (int pt = 0; pt < 2; ++pt)
#pragma unroll
        for (int g4 = 0; g4 < 4; ++g4) zpre[pt][g4] = *(const bf16x4*)(Z + (size_t)rowl * 1536 + head * 64 + pt * 32 + 8 * g4 + 4 * h);
#pragma unroll 1
      for (int st = 0; st < 8; ++st) {
        const bf16x8 g0 = gtp[0][0], g1 = gtp[0][1];
#pragma unroll
        for (int k = 0; k < 7; ++k) { gtp[k][0] = gtp[k + 1][0]; gtp[k][1] = gtp[k + 1][1]; }
        gtp[7][0] = g0; gtp[7][1] = g1;
#pragma unroll 1
        for (int dir = 0; dir < 2; ++dir) {
          if (dir == 0 ? (st > lt) : (st < lt)) continue;
          const float* lwd = dir == 0 ? LWF : LWB;
          const float al = dir == 0 ? al_f : al_b;
          f32x16 mm;
#pragma unroll
          for (int g4 = 0; g4 < 4; ++g4) {
            const int sb = st * 32 + 8 * g4 + 4 * h;
            const float4 l4 = *(const float4*)(lwd + sb);
            const float lv[4] = {l4.x, l4.y, l4.z, l4.w};
#pragma unroll
            for (int q = 0; q < 4; ++q) {
              const int i = 4 * g4 + q;
              const int sidx = sb + q, lidx = lt * 32 + r;
              const bool valid = dir == 0 ? (sidx <= lidx) : (sidx >= lidx);
              const float gv = bfs((i >> 3) ? g1[i & 7] : g0[i & 7]);
              const float e = __expf(fminf(al + lv[q], 30.f));
              mm[i] = valid ? gv * e : 0.f;
            }
          }
#pragma unroll
          for (int s2 = 0; s2 < 2; ++s2) {
            bf16x8 pf = PACK_HALF(mm, s2);
#pragma unroll
            for (int pt = 0; pt < 2; ++pt) {
              const bfr* xp = XTs + (pt * 32 + r) * 264 + st * 32 + 16 * s2 + 4 * h;
              bf16x8 xf = join44(*(const bf16x4*)xp, *(const bf16x4*)(xp + 8));
              acc[pt] = MFMA(xf, pf, acc[pt]);
            }
          }
        }
      }
      const float dsk = p.d_skip[j * 24 + head];
#pragma unroll
      for (int pt = 0; pt < 2; ++pt)
#pragma unroll
        for (int g4 = 0; g4 < 4; ++g4) {
          const int pb = pt * 32 + 8 * g4 + 4 * h;
          bf16x4 zv = zpre[pt][g4];
          float y[4];
#pragma unroll
          for (int q = 0; q < 4; ++q) {
            float xv = bf2f(XTs[(pb + q) * 264 + lt * 32 + r]);
            float zz = bfs(zv[q]);
            float v = (acc[pt][4 * g4 + q] + dsk * xv) * (zz / (1.f + __expf(-zz)));
            sumsq += v * v; y[q] = v;
          }
          *(bf16x4*)(MIX + (size_t)rowl * 2048 + 512 + head * 64 + pb) = pack4(y[0], y[1], y[2], y[3]);
        }
    }
    const float tot = sumsq + __shfl_xor(sumsq, 32);
    const float sc = rsqrtf(tot * (1.f / 384.f) + 1e-6f);
    const float* ng = p.ssd_norm_g + (size_t)j * 1536;
    bf16x4 yv[6][2][4];
#pragma unroll
    for (int hh = 0; hh < 6; ++hh)
#pragma unroll
      for (int pt = 0; pt < 2; ++pt)
#pragma unroll
        for (int g4 = 0; g4 < 4; ++g4)
          yv[hh][pt][g4] = *(const bf16x4*)(MIX + (size_t)rowl * 2048 + 512 + (g * 6 + hh) * 64 + pt * 32 + 8 * g4 + 4 * h);
#pragma unroll
    for (int hh = 0; hh < 6; ++hh)
#pragma unroll
      for (int pt = 0; pt < 2; ++pt)
#pragma unroll
        for (int g4 = 0; g4 < 4; ++g4) {
          const int pb = pt * 32 + 8 * g4 + 4 * h, head = g * 6 + hh;
          const float4 gg = *(const float4*)(ng + head * 64 + pb);
          const bf16x4 y4 = yv[hh][pt][g4];
          *(bf16x4*)(MIX + (size_t)rowl * 2048 + 512 + head * 64 + pb) =
              pack4(bfs(y4[0]) * sc * gg.x, bfs(y4[1]) * sc * gg.y, bfs(y4[2]) * sc * gg.z, bfs(y4[3]) * sc * gg.w);
        }
  }
}

DI void s3_phase(const DP& p, int j) {
#pragma unroll 1
  for (int idx = p.bidl; idx < 512; idx += (int)gridDim.x) {
    const int half = idx & 1, g = (idx >> 1) & 3, bcl = idx >> 3;
    s3_block(p, j, bcl >> 5, 1 + (bcl & 31), g, half);
  }
}

DI void qkprep_phase(const DP& p, int j) {
  const int lane = p.tidl & 63;
  const int wg = p.bidl * 4 + (p.tidl >> 6), nw = gridDim.x * 4;
  const bfr* P = wsp<bfr>(p, OFF_P); bfr* QK = wsp<bfr>(p, OFF_QK);
  const float* ROPE = wsp<float>(p, OFF_ROPE);
  const int sub = lane >> 3, d0 = (lane & 7) * 8;
  for (int row = wg; row < R; row += nw) {
    bf16x8 xin[4];
#pragma unroll
    for (int ps = 0; ps < 4; ++ps) {
      const int hs0 = ps * 8 + sub, hsc0 = hs0 < 26 ? hs0 : 25;
      xin[ps] = *(const bf16x8*)(P + (size_t)row * 2304 + (hsc0 < 10 ? hsc0 * 64 : 768 + (hsc0 - 10) * 64) + d0);
    }
#pragma unroll
    for (int ps = 0; ps < 4; ++ps) {
      const int hs = ps * 8 + sub;
      const bool act = hs < 26;
      const int hsc = act ? hs : 25;
      bf16x8 xv = xin[ps];
      float x[8]; float ss = 0.f;
#pragma unroll
      for (int e = 0; e < 8; ++e) { x[e] = bfs(xv[e]); ss += x[e] * x[e]; }
      ss += __shfl_xor(ss, 1); ss += __shfl_xor(ss, 2); ss += __shfl_xor(ss, 4);
      const float rs = rsqrtf(ss * (1.f / 64.f) + 1e-6f);
      const float* gv = hsc < 8 ? p.q_norm_win + j * 64 : hsc < 10 ? p.k_norm_win + j * 64 : hsc < 18 ? p.q_norm_na + j * 64 : p.k_norm_na + j * 64;
#pragma unroll
      for (int e = 0; e < 8; ++e) x[e] = x[e] * rs * gv[d0 + e];
      float pr[8];
#pragma unroll
      for (int e = 0; e < 8; ++e) pr[e] = __shfl_xor(x[e], 2);
      if (hsc < 10 && row < RL) {
        const int pos = row & 8191;
        const int axis = d0 >> 5;
        const int idx = axis == 0 ? (pos >> 6) : (pos & 63);
        const int f0 = d0 & 15;
        const bool second = (d0 & 16) != 0;
        const float* cp = ROPE + (axis * 128 + idx) * 16 + f0;
        const float* sp = cp + 4096;
#pragma unroll
        for (int e = 0; e < 8; ++e) {
          float cs = cp[e], sn = sp[e];
          x[e] = second ? (x[e] * cs + pr[e] * sn) : (x[e] * cs - pr[e] * sn);
        }
      }
      const bool isq = hsc < 8 || (hsc >= 10 && hsc < 18);
      const float qs = isq ? 0.125f : 1.f;
      if (act) *(bf16x8*)(QK + (size_t)row * 1664 + hsc * 64 + d0) = pack8(x[0] * qs, x[1] * qs, x[2] * qs, x[3] * qs, x[4] * qs, x[5] * qs, x[6] * qs, x[7] * qs);
    }
  }
}

struct KVF { bf16x8 k[4]; bf16x8 v[2][2]; };
struct KVS { bf16x8 k[4]; bf16x8 v[4]; };

DI void kv_gload(KVS& g, const bfr* __restrict__ Kt, const bfr* __restrict__ Vt, int lane) {
#pragma unroll
  for (int i = 0; i < 4; ++i) {
    const int idx = lane + 64 * i;
    g.k[i] = *(const bf16x8*)(Kt + (size_t)(idx >> 3) * 1664 + (idx & 7) * 8);
    g.v[i] = *(const bf16x8*)(Vt + (size_t)(idx >> 2) * R + (idx & 3) * 8);
  }
}
DI void kv_sstore(const KVS& g, unsigned char* base, int lane) {
#pragma unroll
  for (int i = 0; i < 4; ++i) {
    const int idx = lane + 64 * i;
    { const int row = idx >> 3, c = idx & 7; *(bf16x8*)(base + row * 128 + ((c ^ (row & 7)) << 4)) = g.k[i]; }
    {
      const int d = idx >> 2, c16 = idx & 3, sw = (d >> 2) & 7;
      bf16x4 lo = __builtin_shufflevector(g.v[i], g.v[i], 0, 1, 2, 3), hi = __builtin_shufflevector(g.v[i], g.v[i], 4, 5, 6, 7);
      *(bf16x4*)(base + 4096 + d * 64 + (((2 * c16) ^ sw) << 3)) = lo;
      *(bf16x4*)(base + 4096 + d * 64 + (((2 * c16 + 1) ^ sw) << 3)) = hi;
    }
  }
}
DI void kv_sload(KVF& f, const unsigned char* base, int r, int h) {
#pragma unroll
  for (int kk = 0; kk < 4; ++kk) f.k[kk] = *(const bf16x8*)(base + r * 128 + (((2 * kk + h) ^ (r & 7)) << 4));
#pragma unroll
  for (int s2 = 0; s2 < 2; ++s2)
#pragma unroll
    for (int dt = 0; dt < 2; ++dt) {
      const int d = dt * 32 + r, sw = (d >> 2) & 7, c8 = 4 * s2 + h;
      const unsigned char* vb = base + 4096 + d * 64;
      f.v[s2][dt] = join44(*(const bf16x4*)(vb + ((c8 ^ sw) << 3)), *(const bf16x4*)(vb + (((c8 + 2) ^ sw) << 3)));
    }
}

DI void attn_compute(f32x16 (&o)[2], float& m, float& l, const unsigned char* qb, const unsigned char* base, int r, int h,
                     int mode, int a0, int a1, const float* __restrict__ rp) {
  f32x16 s = zero16();
#pragma unroll
  for (int kk = 0; kk < 4; ++kk) {
    const int off = r * 128 + (((2 * kk + h) ^ (r & 7)) << 4);
    s = MFMA(*(const bf16x8*)(base + off), *(const bf16x8*)(qb + off), s);
  }
  float tmax = -3.0e38f;
  if (mode == 1) {
#pragma unroll
    for (int i = 0; i < 16; ++i) { int dd = a0 - crow(i, h); dd = dd < 0 ? -dd : dd; s[i] = dd <= 128 ? s[i] : -1.0e30f; }
  } else if (mode == 2) {
#pragma unroll
    for (int i = 0; i < 16; ++i) {
      const int key = crow(i, h);
      const int rel = a0 + key;
      int co = a1 + key; co = co < 0 ? 0 : (co > 30 ? 30 : co);
      s[i] = (rel >= 0 && rel < 16) ? s[i] + rp[co] : -1.0e30f;
    }
  }
#pragma unroll
  for (int i = 0; i < 16; ++i) tmax = fmaxf(tmax, s[i]);
  tmax = fmaxf(tmax, __shfl_xor(tmax, 32));
  const float mn = fmaxf(m, tmax);
  const float alpha = __expf(m - mn);
  float ps = 0.f;
#pragma unroll
  for (int i = 0; i < 16; ++i) { s[i] = __expf(s[i] - mn); ps += s[i]; }
  l = l * alpha + ps; m = mn;
#pragma unroll
  for (int i = 0; i < 16; ++i) { o[0][i] *= alpha; o[1][i] *= alpha; }
#pragma unroll
  for (int s2 = 0; s2 < 2; ++s2) {
    bf16x8 pf = PACK_HALF(s, s2);
#pragma unroll
    for (int dt = 0; dt < 2; ++dt) {
      const int d = dt * 32 + r, sw = (d >> 2) & 7, c8 = 4 * s2 + h;
      const unsigned char* vb = base + 4096 + d * 64;
      bf16x8 vf = join44(*(const bf16x4*)(vb + ((c8 ^ sw) << 3)), *(const bf16x4*)(vb + (((c8 + 2) ^ sw) << 3)));
      o[dt] = MFMA(vf, pf, o[dt]);
    }
  }
}

DI void attn_item(const DP& p, int j, int item, int lane) {
  const int r = lane & 31, h = lane >> 5;
  const bfr* QK = wsp<bfr>(p, OFF_QK); const bfr* VT = wsp<bfr>(p, OFF_VT); bfr* MIX = wsp<bfr>(p, OFF_MIX);
  int kind, b, hd, qt;
  if (item < 4096) { kind = 0; qt = item & 255; hd = (item >> 8) & 7; b = item >> 11; }
  else if (item < 8192) { int v = item - 4096; kind = 1; qt = v & 255; hd = (v >> 8) & 7; b = v >> 11; }
  else if (item < 8320) { int v = item - 8192; kind = 2; qt = v & 7; hd = (v >> 3) & 7; b = v >> 6; }
  else { int v = item - 8320; kind = 3; qt = v & 7; hd = (v >> 3) & 7; b = v >> 6; }
  const bool win = (kind == 0 || kind == 2);
  const bool lat = kind < 2;
  const int q_row0 = lat ? b * SEQ + qt * 32 : RL + b * CTX + qt * 32;
  const int qcol = win ? hd * 64 : (10 + hd) * 64;
  const int kcol = win ? (8 + (hd >> 2)) * 64 : (18 + hd) * 64;
  const bfr* Vb = win ? VT + (size_t)((hd >> 2) * 64) * R : VT + (size_t)(128 + hd * 64) * R;
  const bfr* Kb = QK + kcol;
  f32x16 o[2]; o[0] = zero16(); o[1] = zero16();
  float m = -1.0e30f, l = 0.f;
  if (win) { m = p.sink_win[j * 8 + hd]; l = h == 0 ? 1.f : 0.f; }
  int nloc = 0, lo = 0, gr = 0, kr0 = 0, w = 0, cs = 0;
  const int qpos = qt * 32 + r;
  if (kind == 0) { lo = qt - 4 < 0 ? 0 : qt - 4; const int hi = qt + 4 > 255 ? 255 : qt + 4; nloc = hi - lo + 1; }
  else if (kind == 1) {
    gr = qt >> 1; w = (qt & 1) * 32 + r;
    cs = w - 8; cs = cs < 0 ? 0 : (cs > 48 ? 48 : cs);
    kr0 = gr - 4; kr0 = kr0 < 0 ? 0 : (kr0 > 120 ? 120 : kr0);
    nloc = 16;
  }
  const int ntile = 8 + nloc;
  const float* rpb = p.rpb_na + (size_t)j * 8 * 15 * 31 + hd * 15 * 31;
  auto tile_row = [&](int i) -> int {
    if (i < 8) return RL + b * CTX + i * 32;
    const int li = i - 8;
    if (kind == 0) return b * SEQ + (lo + li) * 32;
    return b * SEQ + (kr0 + (li >> 1)) * 64 + (li & 1) * 32;
  };
  unsigned char* lbase = smem + (p.tidl >> 6) * 12288;
  asm volatile("" ::: "memory");
#pragma unroll
  for (int i = 0; i < 4; ++i) {
    const int idx = lane + 64 * i, row = idx >> 3, c = idx & 7;
    *(bf16x8*)(lbase + 8192 + row * 128 + ((c ^ (row & 7)) << 4)) = *(const bf16x8*)(QK + (size_t)(q_row0 + row) * 1664 + qcol + c * 8);
  }
  KVS g;
  { const int k0 = tile_row(0); kv_gload(g, Kb + (size_t)k0 * 1664, Vb + k0, lane); }
  kv_sstore(g, lbase, lane);
#pragma unroll 1
  for (int i = 0; i < ntile; ++i) {
    { const int in = i + 1 < ntile ? i + 1 : i; const int k0 = tile_row(in); kv_gload(g, Kb + (size_t)k0 * 1664, Vb + k0, lane); }
    int mode = 0, a0 = 0, a1 = 0; const float* rp = rpb;
    if (i >= 8) {
      const int li = i - 8;
      if (kind == 0) { mode = 1; a0 = qpos - (lo + li) * 32; }
      else { mode = 2; const int krow = kr0 + (li >> 1); const int ub = (li & 1) * 32; a0 = ub - cs; a1 = ub - w + 15; rp = rpb + (krow - gr + 7) * 31; }
    }
    asm volatile("" ::: "memory");
    attn_compute(o, m, l, lbase + 8192, lbase, r, h, mode, a0, a1, rp);
    asm volatile("" ::: "memory");
    kv_sstore(g, lbase, lane);
  }
  asm volatile("" ::: "memory");
  const float lt = l + __shfl_xor(l, 32);
  const float inv = 1.f / lt;
  const int ocol = win ? hd * 64 : 512 + hd * 64;
#pragma unroll
  for (int dt = 0; dt < 2; ++dt)
#pragma unroll
    for (int g4 = 0; g4 < 4; ++g4) {
      const int d = dt * 32 + 8 * g4 + 4 * h;
      *(bf16x4*)(MIX + (size_t)(q_row0 + r) * 1024 + ocol + d) =
          pack4(o[dt][4 * g4] * inv, o[dt][4 * g4 + 1] * inv, o[dt][4 * g4 + 2] * inv, o[dt][4 * g4 + 3] * inv);
    }
}

DI void attn_phase(const DP& p, int j) {
  const int lane = p.tidl & 63;
  const int wg = p.bidl * 4 + (p.tidl >> 6), nw = gridDim.x * 4;
#pragma unroll 1
  for (int it = wg; it < 8448; it += nw) attn_item(p, j, it, lane);
}

#define XB_TMO      128
#define XB_XCNT(j)  (256  + 64 * (j))
#define XB_XSUB(j)  (1280 + 64 * (j))
#define XB_XGEN(j)  (2304 + 64 * (j))
#define XB_TOP      3328
#define XB_TOPGEN   3392
#define XCD_BAR_WORDS 3456
#define XB_SPIN_CAP (1u << 18)
#define LAS __attribute__((address_space(3)))

__device__ __forceinline__ unsigned xb_ld(unsigned* p)              { return __hip_atomic_load(p, __ATOMIC_RELAXED, __HIP_MEMORY_SCOPE_AGENT); }
__device__ __forceinline__ unsigned xb_add(unsigned* p, unsigned v) { return __hip_atomic_fetch_add(p, v, __ATOMIC_RELAXED, __HIP_MEMORY_SCOPE_AGENT); }
__device__ __forceinline__ unsigned xb_xcc_id() { return (unsigned)__builtin_amdgcn_s_getreg((3 << 11) | 20) & 0xFu; }
#define XB_SPIN(cond, bar) do { unsigned _sp = 0; while (cond) { __builtin_amdgcn_s_sleep(1); \
    if ((++_sp & 255u) == 0u) { if (xb_ld(&(bar)[XB_TMO])) break; if (_sp > XB_SPIN_CAP) { atomicAdd(&(bar)[XB_TMO], 1u); break; } } } } while (0)

struct XcdBarrier {
    unsigned* bar; unsigned x;
    volatile LAS unsigned* st;
};

__device__ __forceinline__ XcdBarrier xcd_barrier_post(unsigned* bar, volatile LAS unsigned* st) {
    XcdBarrier b; b.bar = bar; b.x = xb_xcc_id(); b.st = st;
    if (threadIdx.x == 0) (void)xb_add(&bar[XB_XCNT(b.x)], 1u);
    return b;
}
__device__ __forceinline__ void xcd_barrier_complete(unsigned* bar, unsigned x, unsigned& nloc, unsigned& nx) {
    const unsigned G = gridDim.x * gridDim.y * gridDim.z;
    unsigned sum, cnt, mine, sp = 0u;
    for (;;) {
        sum = 0u; cnt = 0u; mine = 0u;
#pragma unroll
        for (unsigned j = 0; j < 16; ++j) { const unsigned c = xb_ld(&bar[XB_XCNT(j)]); sum += c; cnt += (c > 0u) ? 1u : 0u; mine = (j == x) ? c : mine; }
        if (sum == G) break;
        __builtin_amdgcn_s_sleep(1);
        if ((++sp & 255u) == 0u) { if (xb_ld(&bar[XB_TMO])) break; if (sp > XB_SPIN_CAP) { atomicAdd(&bar[XB_TMO], 1u); break; } }
    }
    nloc = mine > 0u ? mine : 1u; nx = cnt > 0u ? cnt : 1u;
}

__device__ __forceinline__ void xcd_barrier(const XcdBarrier& b) {
    asm volatile("s_waitcnt vmcnt(0)" ::: "memory");
    __syncthreads();
    if (threadIdx.x == 0) {
        unsigned* bar = b.bar;
        __builtin_amdgcn_s_waitcnt(0);
        unsigned nloc = b.st[0], nx = b.st[1];
        if (nloc == 0u) { xcd_barrier_complete(bar, b.x, nloc, nx); b.st[0] = nloc; b.st[1] = nx; }
        const unsigned old = xb_add(&bar[XB_XSUB(b.x)], 1u);
        const unsigned gen = old / nloc;
        if (old + 1u == (gen + 1u) * nloc) {
            __builtin_amdgcn_fence(__ATOMIC_RELEASE, "agent");
            asm volatile("s_waitcnt vmcnt(0)" ::: "memory");
            const unsigned og = xb_add(&bar[XB_TOP], 1u);
            const unsigned tg = og / nx;
            if (og + 1u == (tg + 1u) * nx) xb_add(&bar[XB_TOPGEN], 1u);
            else XB_SPIN(xb_ld(&bar[XB_TOPGEN]) == tg, bar);
            __builtin_amdgcn_fence(__ATOMIC_ACQUIRE, "agent");
            xb_add(&bar[XB_XGEN(b.x)], 1u);
            asm volatile("s_waitcnt vmcnt(0)" ::: "memory");
        } else {
            XB_SPIN(xb_ld(&bar[XB_XGEN(b.x)]) == gen, bar);
            __builtin_amdgcn_fence(__ATOMIC_ACQUIRE, "agent");
            asm volatile("s_waitcnt vmcnt(0)" ::: "memory");
        }
    }
    __syncthreads();
}


DI void run_phase(const DP& p, int ph, int dry) {
  if (ph == 0) { phase0(p); wconv_phase(p, 0); return; }
  int q = ph - 1, layer, lp;
  if (q < 10) { layer = 0; lp = q; } else if (q < 17) { layer = 1; lp = q - 10; } else if (q < 27) { layer = 2; lp = q - 17; } else { layer = 3; lp = q - 27; }
  const int j = layer >> 1;
  const bool even = (layer & 1) == 0;
  int op, gsel = 0;
  if (even) {
    op = (int)((0x2272654321ull >> (4 * lp)) & 15ull); gsel = (int)((0x3201000000ull >> (4 * lp)) & 15ull);
  } else {
    op = (int)((0x2272921ull >> (4 * lp)) & 15ull); gsel = (int)((0x3201000ull >> (4 * lp)) & 15ull);
  }
  if (op == 1 && layer != 0) wconv_phase(p, layer);
  if (op == 1 || op == 7) {
    const bool first = op == 1;
    norm_phase(p, layer, (first ? p.norm_mix_g : p.norm_ff_g) + layer * 1024, first ? 0 : 3, first ? 1 : 4);
  } else if (op == 2) {
    int mode, lda, N, K, gch; size_t offA, offB;
    if (gsel == 0) { mode = even ? EPI_EVEN_IN : EPI_ODD_IN; offA = OFF_MIX; lda = 1024; offB = OFF_WIN; N = even ? 5168 : 2304; K = 1024; gch = 0; }
    else if (gsel == 1) { mode = EPI_RESID; offA = OFF_MIX; lda = even ? 2048 : 1024; offB = OFF_WOUT; N = 1024; K = even ? 2048 : 1024; gch = 2; }
    else if (gsel == 2) { mode = EPI_RELU2; offA = OFF_MIX; lda = 1024; offB = OFF_WFF1; N = 4096; K = 1024; gch = 0; }
    else { mode = EPI_RESID; offA = OFF_ACT; lda = 4096; offB = OFF_WFF2; N = 1024; K = 4096; gch = 5; }
    if (dry && mode == EPI_RESID) mode = 4;
    gemm_phase(p, mode, wsp<bfr>(p, offA), lda, wsp<bfr>(p, offB), N, K, layer, gch, (layer == 3 && gsel != 0) ? RL / 128 : R / 128);
  } else if (op == 3) conv_dt_phase(p, j);
  else if (op == 4) s1f1_phase(p);
  else if (op == 5) s2f2_phase(p, j);
  else if (op == 6) s3_phase(p, j);
  else if (op == 8) qkprep_phase(p, j);
  else if (op == 9) attn_phase(p, j);
}

DI int probe_reps(int ph) {
#ifdef PROBE_MASK
  if (ph == 0) return (PROBE_MASK & 1) ? 2 : 1;
  int q = ph - 1, layer, lp;
  if (q < 10) { layer = 0; lp = q; } else if (q < 17) { layer = 1; lp = q - 10; } else if (q < 27) { layer = 2; lp = q - 17; } else { layer = 3; lp = q - 27; }
  const bool even = (layer & 1) == 0;
  int op, gsel;
  if (even) { op = (int)((0x2272654321ull >> (4 * lp)) & 15ull); gsel = (int)((0x3201000000ull >> (4 * lp)) & 15ull); }
  else { op = (int)((0x2272921ull >> (4 * lp)) & 15ull); gsel = (int)((0x3201000ull >> (4 * lp)) & 15ull); }
  if (op == 5) return 1;
  if (op == 2 && (gsel == 1 || gsel == 3)) return ((PROBE_MASK >> 10) & 1) ? 2 : 1;
  return ((PROBE_MASK >> op) & 1) ? 2 : 1;
#else
  return 1;
#endif
}

__shared__ uint4 xb_words;

__global__ void __launch_bounds__(256, 2) mega(Params p, int ph0, int ph1) {
  cg::grid_group grid = cg::this_grid();
  if (threadIdx.x == 0) xb_words = make_uint4(0u, 0u, 0u, 0u);
  __syncthreads();
  XcdBarrier xb = xcd_barrier_post((unsigned*)(p.ws + OFF_BAR), (volatile LAS unsigned*)&xb_words);
#pragma unroll 1
  for (int ph = ph0; ph < ph1; ++ph) {
    const int nrep = probe_reps(ph);
#pragma unroll 1
    for (int rep = 0; rep < nrep; ++rep) {
      DP q;
      (Params&)q = p;
      int t = threadIdx.x, bb = blockIdx.x;
      asm volatile("" : "+v"(t));
      asm volatile("" : "+s"(bb));
      int z0;
      asm volatile("s_mov_b32 %0, 0" : "=s"(z0));
      q.ws = p.ws + z0;
      q.out = p.out + z0;
      q.tidl = t; q.bidl = bb;
      run_phase(q, ph, rep + 1 < nrep);
    }
    if (ph + 1 < ph1) {
      if (ph == ph0) grid.sync();
      else xcd_barrier(xb);
    }
  }
}

extern "C" void kernel_launch(void* const* d_in, const int* in_sizes, int n_in, void* d_out, int out_size, void* d_ws,
                              size_t ws_size, hipStream_t stream) {
  static int grid_blocks = 0;
  if (!grid_blocks) {
    int dev = 0, cus = 0, per_cu = 0;
    hipGetDevice(&dev);
    hipDeviceGetAttribute(&cus, hipDeviceAttributeMultiprocessorCount, dev);
    hipOccupancyMaxActiveBlocksPerMultiprocessor(&per_cu, mega, 256, 0);
    if (per_cu > 2) per_cu = 2;
    if (per_cu < 1) per_cu = 1;
    grid_blocks = cus * per_cu;
  }
  Params p{};
  const float** pp = (const float**)&p;
  for (int i = 0; i < 26; ++i) pp[i] = (const float*)d_in[i];
  p.out = (float*)d_out;
  p.ws = (unsigned char*)d_ws;
  if (ws_size < WS_TOTAL) fprintf(stderr, "workspace too small: %zu < %zu\n", ws_size, (size_t)WS_TOTAL);
  hipMemsetAsync((unsigned char*)d_ws + OFF_BAR, 0, XCD_BAR_WORDS * 4, stream);
#if MULTI_LAUNCH
  for (int ph = 0; ph < NPHASE; ++ph) {
    int a = ph, b = ph + 1;
    void* args[] = {&p, &a, &b};
    hipLaunchCooperativeKernel((void*)mega, dim3(grid_blocks), dim3(256), args, 0, stream);
  }
#else
  int a = 0, b = NPHASE;
  void* args[] = {&p, &a, &b};
  hipError_t e = hipLaunchCooperativeKernel((void*)mega, dim3(grid_blocks), dim3(256), args, 0, stream);
  if (e != hipSuccess) fprintf(stderr, "cooperative launch failed: %s (grid %d)\n", hipGetErrorString(e), grid_blocks);
#endif
}
```

```cpp
#include <hip/hip_runtime.h>
#include <hip/hip_cooperative_groups.h>
#include <cstdio>
namespace cg = cooperative_groups;

typedef unsigned short bfr;
typedef __attribute__((ext_vector_type(8))) short bf16x8;
typedef __attribute__((ext_vector_type(4))) short bf16x4;
typedef __attribute__((ext_vector_type(16))) float f32x16;
#define DI __device__ __forceinline__
#define MFMA(a, b, c) __builtin_amdgcn_mfma_f32_32x32x16_bf16((a), (b), (c), 0, 0, 0)

#ifndef MULTI_LAUNCH
#define MULTI_LAUNCH 0
#endif

constexpr int RL = 16384, R = 16896, SEQ = 8192, CTX = 256;
constexpr int NCH = 33, CL = 256;
constexpr int NPHASE = 35;

constexpr size_t al(size_t x) { return (x + 255) & ~size_t(255); }
constexpr size_t OFF_HC = 0;
constexpr size_t OFF_MOD = OFF_HC + al(512 * 1024 * 4);
constexpr size_t OFF_TW = OFF_MOD + al(4 * 3 * 6144 * 4);
constexpr size_t OFF_C128 = OFF_TW + al(8192 * 8);
constexpr size_t OFF_S128 = OFF_C128 + al(128 * 128 * 2);
constexpr size_t OFF_C64 = OFF_S128 + al(128 * 128 * 2);
constexpr size_t OFF_S64 = OFF_C64 + al(64 * 64 * 2);
constexpr size_t OFF_C256 = OFF_S64 + al(64 * 64 * 2);
constexpr size_t OFF_S256 = OFF_C256 + al(256 * 256 * 2);
constexpr size_t OFF_ROPE = OFF_S256 + al(256 * 256 * 2);
constexpr size_t OFF_DTV = OFF_ROPE + al(2 * 2 * 128 * 16 * 4);
constexpr size_t DT_BYTES = (size_t)2 * 2 * NCH * 24 * 256 * 4;
constexpr size_t OFF_ACUM = OFF_DTV + al(DT_BYTES);
constexpr size_t OFF_WIN = OFF_ACUM + al(DT_BYTES);
constexpr size_t OFF_WOUT = OFF_WIN + al((size_t)5248 * 1024 * 2);
constexpr size_t OFF_WFF1 = OFF_WOUT + al((size_t)1024 * 2048 * 2);
constexpr size_t OFF_WFF2 = OFF_WFF1 + al((size_t)4096 * 1024 * 2);
constexpr size_t OFF_MIX = OFF_WFF2 + al((size_t)4096 * 1024 * 2);
constexpr size_t OFF_BIG = OFF_MIX + al((size_t)R * 2048 * 2);
constexpr size_t OFF_Z = OFF_BIG;
constexpr size_t OFF_ZRT = OFF_Z + (size_t)R * 1536 * 2;
constexpr size_t OFF_ZIT = OFF_ZRT + (size_t)512 * R * 2;
constexpr size_t OFF_XBC = OFF_ZIT + (size_t)512 * R * 2;
constexpr size_t OFF_DTRAW = OFF_XBC + (size_t)R * 2560 * 2;
constexpr size_t BIG_END = OFF_DTRAW + (size_t)R * 48 * 4;
constexpr size_t OFF_HS = OFF_XBC;
constexpr size_t HS_BYTES = (size_t)2 * 2 * NCH * 24 * 8192 * 2;
constexpr size_t OFF_YR = OFF_HS + HS_BYTES;
constexpr size_t OFF_YI = OFF_YR + (size_t)2 * 512 * 128 * 64 * 2;
static_assert(OFF_YI + (size_t)2 * 512 * 128 * 64 * 2 <= OFF_DTRAW, "fft scratch overflows");
constexpr size_t OFF_ACT = OFF_BIG;
static_assert((size_t)R * 4096 * 2 <= BIG_END - OFF_BIG, "act overflows");
constexpr size_t OFF_P = OFF_BIG;
constexpr size_t OFF_VT = OFF_P + (size_t)R * 2304 * 2;
constexpr size_t OFF_QK = OFF_VT + (size_t)640 * R * 2;
static_assert(OFF_QK + (size_t)R * 1664 * 2 <= BIG_END, "odd overflows");
constexpr size_t OFF_XT = al(BIG_END);
constexpr size_t OFF_BN = OFF_XT + (size_t)1536 * R * 2;
constexpr size_t OFF_BT = OFF_BN + (size_t)R * 512 * 2;
constexpr size_t OFF_CN = OFF_BT + (size_t)512 * R * 2;
constexpr size_t OFF_BAR = al(OFF_CN + (size_t)R * 512 * 2);
constexpr size_t WS_TOTAL = OFF_BAR + 16384;
static_assert(WS_TOTAL <= 402653184ull, "workspace too large");

struct Params {
  const float *x, *c, *ctx, *c_ctx, *w_mod, *b_mod, *norm_mix_g, *norm_ff_g, *w_ff1, *w_ff2;
  const float *w_in_even, *conv_w, *conv_b, *dt_bias, *a_log, *d_skip, *ssd_norm_g, *w_out_even;
  const float *w_in_odd, *q_norm_win, *k_norm_win, *sink_win, *q_norm_na, *k_norm_na, *rpb_na, *w_out_odd;
  float* out;
  unsigned char* ws;
};

struct DP : Params { int tidl, bidl; };

__shared__ __attribute__((aligned(16))) unsigned char smem[73728];

typedef __attribute__((ext_vector_type(2))) __bf16 bf2_t;
typedef __attribute__((ext_vector_type(2))) float f2_t;
typedef __attribute__((ext_vector_type(4))) unsigned u32x4_t;
typedef __attribute__((ext_vector_type(2))) unsigned u32x2_t;
DI unsigned pk2(float a, float b) { f2_t v = {a, b}; return __builtin_bit_cast(unsigned, __builtin_convertvector(v, bf2_t)); }
DI bfr f2bf(float x) { return (bfr)(pk2(x, 0.f) & 0xffffu); }
DI float bf2f(bfr b) { return __uint_as_float(((unsigned)b) << 16); }
DI float bfs(short s) { return __uint_as_float(((unsigned)(unsigned short)s) << 16); }
DI int crow(int i, int h) { return (i & 3) + 8 * (i >> 2) + 4 * h; }
DI f32x16 zero16() { f32x16 z; for (int i = 0; i < 16; ++i) z[i] = 0.f; return z; }
DI bf16x8 pack8(float a0, float a1, float a2, float a3, float a4, float a5, float a6, float a7) {
  u32x4_t v = {pk2(a0, a1), pk2(a2, a3), pk2(a4, a5), pk2(a6, a7)};
  return __builtin_bit_cast(bf16x8, v);
}
DI bf16x4 pack4(float a0, float a1, float a2, float a3) {
  u32x2_t v = {pk2(a0, a1), pk2(a2, a3)};
  return __builtin_bit_cast(bf16x4, v);
}
#define PACK_HALF(s, s2) pack8(s[8 * (s2)], s[8 * (s2) + 1], s[8 * (s2) + 2], s[8 * (s2) + 3], s[8 * (s2) + 4], s[8 * (s2) + 5], s[8 * (s2) + 6], s[8 * (s2) + 7])
DI bf16x8 join44(bf16x4 lo, bf16x4 hi) { return __builtin_shufflevector(lo, hi, 0, 1, 2, 3, 4, 5, 6, 7); }
DI int chunk_row0(int b, int c) { return c == 0 ? RL + b * CTX : b * SEQ + (c - 1) * CL; }

DI void sincos_turn(double f, float& s, float& c) {
  f -= rint(f);
  double x = f * 6.283185307179586476925;
  double x2 = x * x, ss = 1.0, cc = 1.0;
#pragma unroll
  for (int k = 13; k >= 1; --k) {
    ss = 1.0 - x2 / (double)((2 * k) * (2 * k + 1)) * ss;
    cc = 1.0 - x2 / (double)((2 * k - 1) * (2 * k)) * cc;
  }
  s = (float)(x * ss); c = (float)cc;
}

template <class T> DI T* wsp(const DP& p, size_t off) { return (T*)(p.ws + off); }

DI void phase0(const DP& p) {
  const int tid = p.tidl, bid = p.bidl, G = gridDim.x;
  float* lds = (float*)smem;
  float* MOD = wsp<float>(p, OFF_MOD);
  for (int u = bid; u < 384; u += G) {
    int layer = u / 96, cb = u % 96;
    for (int i = tid; i < 3072; i += 256) {
      int v = i >> 10, k = i & 1023;
      float c = v < 2 ? p.c[v * 1024 + k] : p.c_ctx[k];
      lds[i] = c / (1.f + expf(-c));
    }
    __syncthreads();
    const int kq = tid >> 4, c4 = (tid & 15) * 4;
    const float* w = p.w_mod + (size_t)layer * 1024 * 6144 + cb * 64 + c4;
    float a0[4] = {0.f, 0.f, 0.f, 0.f}, a1[4] = {0.f, 0.f, 0.f, 0.f}, a2[4] = {0.f, 0.f, 0.f, 0.f};
#pragma unroll 8
    for (int k = kq * 64; k < kq * 64 + 64; ++k) {
      const float4 wv = *(const float4*)(w + (size_t)k * 6144);
      const float s0 = lds[k], s1 = lds[1024 + k], s2 = lds[2048 + k];
      a0[0] += s0 * wv.x; a0[1] += s0 * wv.y; a0[2] += s0 * wv.z; a0[3] += s0 * wv.w;
      a1[0] += s1 * wv.x; a1[1] += s1 * wv.y; a1[2] += s1 * wv.z; a1[3] += s1 * wv.w;
      a2[0] += s2 * wv.x; a2[1] += s2 * wv.y; a2[2] += s2 * wv.z; a2[3] += s2 * wv.w;
    }
    float* red = lds + 3072;
#pragma unroll
    for (int e = 0; e < 4; ++e) {
      red[(kq * 3 + 0) * 64 + c4 + e] = a0[e]; red[(kq * 3 + 1) * 64 + c4 + e] = a1[e]; red[(kq * 3 + 2) * 64 + c4 + e] = a2[e];
    }
    __syncthreads();
    if (tid < 192) {
      const int v = tid >> 6, cc = tid & 63, col = cb * 64 + cc;
      float sacc = 0.f;
#pragma unroll
      for (int q = 0; q < 16; ++q) sacc += red[(q * 3 + v) * 64 + cc];
      MOD[(layer * 3 + v) * 6144 + col] = sacc + p.b_mod[layer * 6144 + col];
    }
    __syncthreads();
  }
  const int gt = bid * 256 + tid, nt = G * 256;
  {
    const float4* xs = (const float4*)p.x; float4* od = (float4*)p.out;
    for (int i = gt; i < RL * 256; i += 4 * nt) {
      float4 t4[4];
#pragma unroll
      for (int q = 0; q < 4; ++q) { const int ii = i + q * nt; t4[q] = ii < RL * 256 ? xs[ii] : make_float4(0.f, 0.f, 0.f, 0.f); }
#pragma unroll
      for (int q = 0; q < 4; ++q) { const int ii = i + q * nt; if (ii < RL * 256) od[ii] = t4[q]; }
    }
    const float4* cs = (const float4*)p.ctx; float4* hd = wsp<float4>(p, OFF_HC);
    for (int i = gt; i < 512 * 256; i += nt) hd[i] = cs[i];
  }
  float2* TW = wsp<float2>(p, OFF_TW);
  for (int i = gt; i < 8192; i += nt) { float s, c; sincos_turn((double)i / 8192.0, s, c); TW[i] = make_float2(c, s); }
  bfr* C128 = wsp<bfr>(p, OFF_C128); bfr* S128 = wsp<bfr>(p, OFF_S128);
  for (int i = gt; i < 128 * 128; i += nt) { int a = i >> 7, b = i & 127; float s, c; sincos_turn((double)((a * b) & 127) / 128.0, s, c); C128[i] = f2bf(c); S128[i] = f2bf(s); }
  bfr* C64 = wsp<bfr>(p, OFF_C64); bfr* S64 = wsp<bfr>(p, OFF_S64);
  for (int i = gt; i < 64 * 64; i += nt) { int a = i >> 6, b = i & 63; float s, c; sincos_turn((double)((a * b) & 63) / 64.0, s, c); C64[i] = f2bf(c); S64[i] = f2bf(s); }
  bfr* C256 = wsp<bfr>(p, OFF_C256); bfr* S256 = wsp<bfr>(p, OFF_S256);
  for (int i = gt; i < 256 * 256; i += nt) { int a = i >> 8, b = i & 255; float s, c; sincos_turn((double)((a * b) & 255) / 256.0, s, c); C256[i] = f2bf(c); S256[i] = f2bf(s); }
  float* ROPE = wsp<float>(p, OFF_ROPE);
  for (int i = gt; i < 2 * 128 * 16; i += nt) {
    int f = i & 15, idx = (i >> 4) & 127;
    float ang = (float)idx * (float)exp(-(double)f * 0.5756462732485115);
    float s, c; sincos_turn((double)ang / 6.283185307179586476925, s, c);
    ROPE[i] = c; ROPE[4096 + i] = s;
  }
}

DI void tcvt_unit(const float* __restrict__ src, int ld, int c0, int ncols, int K, bfr* __restrict__ dst, int dr0, int u, int tid) {
  const int ntk = K >> 6;
  const int tn = u / ntk, tk = u % ntk, k0 = tk * 64, nb = tn * 64;
  bfr* T = (bfr*)smem;
  float4 v[4];
  const int n4 = (tid & 15) * 4;
#pragma unroll
  for (int i = 0; i < 4; ++i) {
    const int kk = (tid >> 4) + 16 * i;
    v[i] = make_float4(0.f, 0.f, 0.f, 0.f);
    if (nb + n4 < ncols) v[i] = *(const float4*)(src + (size_t)(k0 + kk) * ld + c0 + nb + n4);
  }
#pragma unroll
  for (int i = 0; i < 4; ++i) {
    const int kk = (tid >> 4) + 16 * i;
    T[(n4 + 0) * 72 + kk] = f2bf(v[i].x); T[(n4 + 1) * 72 + kk] = f2bf(v[i].y);
    T[(n4 + 2) * 72 + kk] = f2bf(v[i].z); T[(n4 + 3) * 72 + kk] = f2bf(v[i].w);
  }
  __syncthreads();
  {
    int n = tid >> 2, kseg = (tid & 3) * 16;
    if (nb + n < ncols) {
      bfr* d = dst + (size_t)(dr0 + nb + n) * K + k0 + kseg;
      *(bf16x8*)d = *(const bf16x8*)(T + n * 72 + kseg);
      *(bf16x8*)(d + 8) = *(const bf16x8*)(T + n * 72 + kseg + 8);
    }
  }
  __syncthreads();
}

DI void wconv_phase(const DP& p, int layer) {
  const int tid = p.tidl;
  const int j = layer >> 1;
  bfr* WIN = wsp<bfr>(p, OFF_WIN); bfr* WOUT = wsp<bfr>(p, OFF_WOUT);
  bfr* WFF1 = wsp<bfr>(p, OFF_WFF1); bfr* WFF2 = wsp<bfr>(p, OFF_WFF2);
  const float* ff1 = p.w_ff1 + (size_t)layer * 1024 * 4096;
  const float* ff2 = p.w_ff2 + (size_t)layer * 4096 * 1024;
  float* cst = (float*)(smem + 20480);
  if (tid < 64) { float s, c; sincos_turn((double)tid / 64.0, s, c); cst[tid] = c; cst[64 + tid] = s; }
  __syncthreads();
  if ((layer & 1) == 0) {
    const float* win = p.w_in_even + (size_t)j * 1024 * 4656;
    const float* wout = p.w_out_even + (size_t)j * 2048 * 1024;
    const int n_in = 65 * 16, n_out = 16 * 32, n_f1 = 64 * 16, n_f2 = 16 * 64, n_fold = 128;
    const int total = n_in + n_out + n_f1 + n_f2 + n_fold;
    for (int u = p.bidl; u < total; u += gridDim.x) {
      int v = u;
      if (v < n_in) { tcvt_unit(win, 4656, 512, 4144, 1024, WIN, 1024, v, tid); continue; }
      v -= n_in;
      if (v < n_out) { tcvt_unit(wout, 1024, 0, 1024, 2048, WOUT, 0, v, tid); continue; }
      v -= n_out;
      if (v < n_f1) { tcvt_unit(ff1, 4096, 0, 4096, 1024, WFF1, 0, v, tid); continue; }
      v -= n_f1;
      if (v < n_f2) { tcvt_unit(ff2, 1024, 0, 1024, 4096, WFF2, 0, v, tid); continue; }
      v -= n_f2;
      {
        const int g = v >> 4, kb = v & 15;
        float* wt = (float*)smem;
#pragma unroll
        for (int i = 0; i < 4; ++i) {
          const int idx = tid + 256 * i, kk = idx >> 4, j4 = (idx & 15) * 4;
          const float4 wv = *(const float4*)(win + (size_t)(kb * 64 + kk) * 4656 + g * 64 + j4);
          wt[kk * 65 + j4] = wv.x; wt[kk * 65 + j4 + 1] = wv.y; wt[kk * 65 + j4 + 2] = wv.z; wt[kk * 65 + j4 + 3] = wv.w;
        }
        __syncthreads();
        const int kl = tid & 63, mg = tid >> 6;
#pragma unroll 1
        for (int mi = 0; mi < 16; ++mi) {
          const int m = mg * 16 + mi;
          float sc = 0.f, ss = 0.f;
#pragma unroll 8
          for (int jj = 0; jj < 64; ++jj) { const float w = wt[kl * 65 + jj]; const int idx = (m * jj) & 63; sc += w * cst[idx]; ss += w * cst[64 + idx]; }
          const int ch = g * 64 + m, k = kb * 64 + kl;
          WIN[(size_t)ch * 1024 + k] = f2bf(sc);
          WIN[(size_t)(512 + ch) * 1024 + k] = f2bf(-ss);
        }
        __syncthreads();
      }
    }
  } else {
    const float* win = p.w_in_odd + (size_t)j * 1024 * 2304;
    const float* wout = p.w_out_odd + (size_t)j * 1024 * 1024;
    const int n_in = 36 * 16, n_out = 16 * 16, n_f1 = 64 * 16, n_f2 = 16 * 64;
    const int total = n_in + n_out + n_f1 + n_f2;
    for (int u = p.bidl; u < total; u += gridDim.x) {
      int v = u;
      if (v < n_in) { tcvt_unit(win, 2304, 0, 2304, 1024, WIN, 0, v, tid); continue; }
      v -= n_in;
      if (v < n_out) { tcvt_unit(wout, 1024, 0, 1024, 1024, WOUT, 0, v, tid); continue; }
      v -= n_out;
      if (v < n_f1) { tcvt_unit(ff1, 4096, 0, 4096, 1024, WFF1, 0, v, tid); continue; }
      v -= n_f1;
      tcvt_unit(ff2, 1024, 0, 1024, 4096, WFF2, 0, v, tid);
    }
  }
}

DI void norm_phase(const DP& p, int layer, const float* __restrict__ gvec, int shc, int scc) {
  const int lane = p.tidl & 63;
  const int wg = p.bidl * 4 + (p.tidl >> 6), nw = gridDim.x * 4;
  const float* MOD = wsp<float>(p, OFF_MOD);
  const float* HC = wsp<float>(p, OFF_HC);
  bfr* U = wsp<bfr>(p, OFF_MIX);
#pragma unroll 1
  for (int row0 = wg; row0 < R; row0 += 2 * nw) {
    float4 v[2][4]; float ss[2] = {0.f, 0.f};
#pragma unroll
    for (int q = 0; q < 2; ++q) {
      const int row = row0 + q * nw < R ? row0 + q * nw : row0;
      const float* hp = row < RL ? p.out + (size_t)row * 1024 : HC + (size_t)(row - RL) * 1024;
#pragma unroll
      for (int i = 0; i < 4; ++i) v[q][i] = *(const float4*)(hp + i * 256 + lane * 4);
    }
#pragma unroll
    for (int q = 0; q < 2; ++q) {
#pragma unroll
      for (int i = 0; i < 4; ++i) ss[q] += v[q][i].x * v[q][i].x + v[q][i].y * v[q][i].y + v[q][i].z * v[q][i].z + v[q][i].w * v[q][i].w;
#pragma unroll
      for (int o = 32; o >= 1; o >>= 1) ss[q] += __shfl_xor(ss[q], o);
    }
#pragma unroll
    for (int q = 0; q < 2; ++q) {
      const int row = row0 + q * nw;
      if (row >= R) continue;
      const int ms = row < RL ? (row >> 13) : 2;
      const float* md = MOD + (layer * 3 + ms) * 6144;
      const float rs = rsqrtf(ss[q] * (1.f / 1024.f) + 1e-6f);
#pragma unroll
      for (int i = 0; i < 4; ++i) {
        int col = i * 256 + lane * 4;
        float4 g = *(const float4*)(gvec + col);
        float4 sc = *(const float4*)(md + scc * 1024 + col);
        float4 sh = *(const float4*)(md + shc * 1024 + col);
        bf16x4 o = pack4(v[q][i].x * rs * g.x * (1.f + sc.x) + sh.x, v[q][i].y * rs * g.y * (1.f + sc.y) + sh.y,
                         v[q][i].z * rs * g.z * (1.f + sc.z) + sh.z, v[q][i].w * rs * g.w * (1.f + sc.w) + sh.w);
        *(bf16x4*)(U + (size_t)row * 1024 + col) = o;
      }
    }
  }
}

enum { EPI_EVEN_IN = 0, EPI_ODD_IN = 1, EPI_RELU2 = 2, EPI_RESID = 3 };

DI void gemm_phase(const DP& p, int mode, const bfr* __restrict__ A, int lda, const bfr* __restrict__ Bt,
                   int N, int K, int layer, int gchunk, int nM) {
  const int tid = p.tidl, lane = tid & 63, wid = tid >> 6, r = lane & 31, h = lane >> 5;
  const int wm = wid >> 1, wn = wid & 1;
  const int nN = (N + 127) >> 7;
  const int tiles = nM * nN, G = (int)gridDim.x;
  int full = tiles, tail = 0, St = 1;
  if (mode == EPI_RESID) {
    full = (tiles / G) * G; tail = tiles - full;
    if (tail > 0) { int c = G / tail; int kmax = K >> 7; St = 1; while (St * 2 <= c && St * 2 <= 16 && St * 2 <= kmax) St *= 2; }
  }
  const int chunk = (full + 7) >> 3;
  const int units = chunk * 8 + tail * St;
  bfr* sm = (bfr*)smem;
  const int lrow = tid >> 3, lc = (tid & 7) * 8;
#pragma unroll 1
  for (int u = p.bidl; u < units; u += G) {
    int t, ks, Ks; bool atom;
    if (u < chunk * 8) {
      t = (u & 7) * chunk + (u >> 3);
      if (t >= full) continue;
      ks = 0; Ks = K; atom = false;
    } else { const int v = u - chunk * 8; t = full + v / St; ks = v % St; Ks = K / St; atom = St > 1; }
    const int nk = Ks >> 6;
    const int panel = t / (nM * 8); const int rem = t - panel * nM * 8;
    const int pw = (nN - panel * 8) < 8 ? (nN - panel * 8) : 8;
    const int tm = rem / pw, tn = panel * 8 + rem % pw;
    const int m0 = tm * 128, n0 = tn * 128, kbase = ks * Ks;
    f32x16 acc[2][2];
    acc[0][0] = zero16(); acc[0][1] = zero16(); acc[1][0] = zero16(); acc[1][1] = zero16();
    const bfr* Ag = A + (size_t)(m0 + lrow) * lda + kbase + lc;
    const bfr* Bg = Bt + (size_t)(n0 + lrow) * K + kbase + lc;
    bf16x8 ra[4], rb[4];
#pragma unroll
    for (int i = 0; i < 4; ++i) {
      ra[i] = *(const bf16x8*)(Ag + (size_t)(32 * i) * lda);
      rb[i] = *(const bf16x8*)(Bg + (size_t)(32 * i) * K);
    }
#pragma unroll
    for (int i = 0; i < 4; ++i) {
      *(bf16x8*)(sm + (lrow + 32 * i) * 72 + lc) = ra[i];
      *(bf16x8*)(sm + 9216 + (lrow + 32 * i) * 72 + lc) = rb[i];
    }
    if (nk > 1) {
#pragma unroll
      for (int i = 0; i < 4; ++i) {
        ra[i] = *(const bf16x8*)(Ag + (size_t)(32 * i) * lda + 64);
        rb[i] = *(const bf16x8*)(Bg + (size_t)(32 * i) * K + 64);
      }
    }
    __syncthreads();
#pragma unroll 1
    for (int kt = 0; kt < nk; ++kt) {
      if (kt + 1 < nk) {
        bfr* Ad = sm + ((kt + 1) & 1) * 18432;
#pragma unroll
        for (int i = 0; i < 4; ++i) {
          *(bf16x8*)(Ad + (lrow + 32 * i) * 72 + lc) = ra[i];
          *(bf16x8*)(Ad + 9216 + (lrow + 32 * i) * 72 + lc) = rb[i];
        }
      }
      if (kt + 2 < nk) {
#pragma unroll
        for (int i = 0; i < 4; ++i) {
          ra[i] = *(const bf16x8*)(Ag + (size_t)(32 * i) * lda + (kt + 2) * 64);
          rb[i] = *(const bf16x8*)(Bg + (size_t)(32 * i) * K + (kt + 2) * 64);
        }
      }
      const bfr* As = sm + (kt & 1) * 18432;
      const bfr* Bs = As + 9216;
      __builtin_amdgcn_s_setprio(1);
#pragma unroll
      for (int kk = 0; kk < 4; ++kk) {
        bf16x8 a0 = *(const bf16x8*)(As + (wm * 64 + r) * 72 + kk * 16 + h * 8);
        bf16x8 a1 = *(const bf16x8*)(As + (wm * 64 + 32 + r) * 72 + kk * 16 + h * 8);
        bf16x8 b0 = *(const bf16x8*)(Bs + (wn * 64 + r) * 72 + kk * 16 + h * 8);
        bf16x8 b1 = *(const bf16x8*)(Bs + (wn * 64 + 32 + r) * 72 + kk * 16 + h * 8);
        acc[0][0] = MFMA(a0, b0, acc[0][0]);
        acc[0][1] = MFMA(a0, b1, acc[0][1]);
        acc[1][0] = MFMA(a1, b0, acc[1][0]);
        acc[1][1] = MFMA(a1, b1, acc[1][1]);
      }
      __builtin_amdgcn_s_setprio(0);
      __syncthreads();
    }
    if (mode == EPI_RESID && !atom) {
      float hv[2][2][16], gt2[2][2];
#pragma unroll
      for (int mi = 0; mi < 2; ++mi)
#pragma unroll
        for (int ni = 0; ni < 2; ++ni) {
          const int col = n0 + wn * 64 + ni * 32 + r;
          const int rowb = m0 + wm * 64 + mi * 32 + 4 * h;
          const int ms = rowb < RL ? (rowb >> 13) : 2;
          gt2[mi][ni] = wsp<float>(p, OFF_MOD)[(layer * 3 + ms) * 6144 + gchunk * 1024 + col];
          const float* hp = rowb < RL ? p.out + (size_t)rowb * 1024 + col : wsp<float>(p, OFF_HC) + (size_t)(rowb - RL) * 1024 + col;
#pragma unroll
          for (int i = 0; i < 16; ++i) hv[mi][ni][i] = hp[(size_t)((i & 3) + 8 * (i >> 2)) * 1024];
        }
#pragma unroll
      for (int mi = 0; mi < 2; ++mi)
#pragma unroll
        for (int ni = 0; ni < 2; ++ni) {
          const int col = n0 + wn * 64 + ni * 32 + r;
          const int rowb = m0 + wm * 64 + mi * 32 + 4 * h;
          float* hp = rowb < RL ? p.out + (size_t)rowb * 1024 + col : wsp<float>(p, OFF_HC) + (size_t)(rowb - RL) * 1024 + col;
#pragma unroll
          for (int i = 0; i < 16; ++i) hp[(size_t)((i & 3) + 8 * (i >> 2)) * 1024] = hv[mi][ni][i] + gt2[mi][ni] * acc[mi][ni][i];
        }
      continue;
    }
    const int cbw = n0 + wn * 64;
    const bool qkfuse = mode == EPI_ODD_IN && !((cbw >= 640 && cbw < 768) || cbw >= 1792);
    if (qkfuse) {
      float* T = (float*)smem + wid * 4160;
#pragma unroll
      for (int mi = 0; mi < 2; ++mi)
#pragma unroll
        for (int ni = 0; ni < 2; ++ni)
#pragma unroll
          for (int i = 0; i < 16; ++i) T[(mi * 32 + crow(i, h)) * 65 + ni * 32 + r] = acc[mi][ni][i];
      asm volatile("s_waitcnt lgkmcnt(0)" ::: "memory");
      const int hs = cbw < 640 ? (cbw >> 6) : 10 + ((cbw - 768) >> 6);
      const int jj = layer >> 1;
      const float* gv = hs < 8 ? p.q_norm_win + jj * 64 : hs < 10 ? p.k_norm_win + jj * 64 : hs < 18 ? p.q_norm_na + jj * 64 : p.k_norm_na + jj * 64;
      const float qs = (hs < 8 || (hs >= 10 && hs < 18)) ? 0.125f : 1.f;
      const int row = m0 + wm * 64 + lane;
      float ss = 0.f;
#pragma unroll
      for (int d = 0; d < 64; ++d) { const float t = T[lane * 65 + d]; ss += t * t; }
      const float rs = rsqrtf(ss * (1.f / 64.f) + 1e-6f);
      const bool dorope = hs < 10 && row < RL;
      const float* ROPE = wsp<float>(p, OFF_ROPE);
      const int pos = row & 8191;
      bfr* dst = wsp<bfr>(p, OFF_QK) + (size_t)row * 1664 + hs * 64;
#pragma unroll
      for (int a = 0; a < 2; ++a) {
        float x[32];
#pragma unroll
        for (int d = 0; d < 32; ++d) x[d] = T[lane * 65 + a * 32 + d] * rs * gv[a * 32 + d];
        if (dorope) {
          const int idx = a == 0 ? (pos >> 6) : 128 + (pos & 63);
#pragma unroll
          for (int f4 = 0; f4 < 4; ++f4) {
            const float4 c4 = *(const float4*)(ROPE + idx * 16 + f4 * 4), s4 = *(const float4*)(ROPE + 4096 + idx * 16 + f4 * 4);
            const float cc[4] = {c4.x, c4.y, c4.z, c4.w}, sn[4] = {s4.x, s4.y, s4.z, s4.w};
#pragma unroll
            for (int q = 0; q < 4; ++q) {
              const int f = f4 * 4 + q;
              const float x1 = x[f], x2 = x[16 + f];
              x[f] = x1 * cc[q] - x2 * sn[q];
              x[16 + f] = x2 * cc[q] + x1 * sn[q];
            }
          }
        }
#pragma unroll
        for (int k8 = 0; k8 < 4; ++k8)
          *(bf16x8*)(dst + a * 32 + k8 * 8) = pack8(x[k8 * 8] * qs, x[k8 * 8 + 1] * qs, x[k8 * 8 + 2] * qs, x[k8 * 8 + 3] * qs,
                                                    x[k8 * 8 + 4] * qs, x[k8 * 8 + 5] * qs, x[k8 * 8 + 6] * qs, x[k8 * 8 + 7] * qs);
      }
    }
    if (!qkfuse)
#pragma unroll
    for (int mi = 0; mi < 2; ++mi)
#pragma unroll
      for (int ni = 0; ni < 2; ++ni)
#pragma unroll
        for (int g4 = 0; g4 < 4; ++g4) {
          const int row = m0 + wm * 64 + mi * 32 + 8 * g4 + 4 * h;
          const int col = n0 + wn * 64 + ni * 32 + r;
          const float v0 = acc[mi][ni][4 * g4], v1 = acc[mi][ni][4 * g4 + 1], v2 = acc[mi][ni][4 * g4 + 2], v3 = acc[mi][ni][4 * g4 + 3];
          if (mode == EPI_EVEN_IN) {
            if (col < 1024) {
              bfr* dst = wsp<bfr>(p, col < 512 ? OFF_ZRT : OFF_ZIT) + (size_t)(col & 511) * R + row;
              *(bf16x4*)dst = pack4(v0, v1, v2, v3);
            } else if (col < 2560) {
              bfr* dst = wsp<bfr>(p, OFF_Z) + (size_t)row * 1536 + (col - 1024);
              dst[0] = f2bf(v0); dst[1536] = f2bf(v1); dst[2 * 1536] = f2bf(v2); dst[3 * 1536] = f2bf(v3);
            } else if (col < 5120) {
              bfr* dst = wsp<bfr>(p, OFF_XBC) + (size_t)row * 2560 + (col - 2560);
              dst[0] = f2bf(v0); dst[2560] = f2bf(v1); dst[2 * 2560] = f2bf(v2); dst[3 * 2560] = f2bf(v3);
            } else if (col < 5168) {
              float* dst = wsp<float>(p, OFF_DTRAW) + (size_t)row * 48 + (col - 5120);
              dst[0] = v0; dst[48] = v1; dst[96] = v2; dst[144] = v3;
            }
          } else if (mode == EPI_ODD_IN) {
            if (col >= 640 && col < 768) {
              *(bf16x4*)(wsp<bfr>(p, OFF_VT) + (size_t)(col - 640) * R + row) = pack4(v0, v1, v2, v3);
            } else if (col >= 1792) {
              *(bf16x4*)(wsp<bfr>(p, OFF_VT) + (size_t)(128 + col - 1792) * R + row) = pack4(v0, v1, v2, v3);
            } else {
              bfr* dst = wsp<bfr>(p, OFF_P) + (size_t)row * 2304 + col;
              dst[0] = f2bf(v0); dst[2304] = f2bf(v1); dst[2 * 2304] = f2bf(v2); dst[3 * 2304] = f2bf(v3);
            }
          } else if (mode == EPI_RELU2) {
            bfr* dst = wsp<bfr>(p, OFF_ACT) + (size_t)row * 4096 + col;
            float t0 = fmaxf(v0, 0.f), t1 = fmaxf(v1, 0.f), t2 = fmaxf(v2, 0.f), t3 = fmaxf(v3, 0.f);
            dst[0] = f2bf(t0 * t0); dst[4096] = f2bf(t1 * t1); dst[2 * 4096] = f2bf(t2 * t2); dst[3 * 4096] = f2bf(t3 * t3);
          } else if (mode == EPI_RESID) {
            const int ms = row < RL ? (row >> 13) : 2;
            const float gate = wsp<float>(p, OFF_MOD)[(layer * 3 + ms) * 6144 + gchunk * 1024 + col];
            float* hp = row < RL ? p.out + (size_t)row * 1024 + col : wsp<float>(p, OFF_HC) + (size_t)(row - RL) * 1024 + col;
            if (atom) {
              unsafeAtomicAdd(hp, gate * v0); unsafeAtomicAdd(hp + 1024, gate * v1);
              unsafeAtomicAdd(hp + 2048, gate * v2); unsafeAtomicAdd(hp + 3072, gate * v3);
            } else {
              hp[0] += gate * v0; hp[1024] += gate * v1; hp[2048] += gate * v2; hp[3072] += gate * v3;
            }
          }
        }
    if (mode == EPI_ODD_IN) __syncthreads();
  }
}

DI float softplus_f(float x) { return x > 0.f ? x + log1pf(expf(-x)) : log1pf(expf(x)); }

DI void conv_dt_phase(const DP& p, int j) {
  const int tid = p.tidl, lane = tid & 63, wid = tid >> 6;
  const bfr* XBC = wsp<bfr>(p, OFF_XBC);
  bfr* XT = wsp<bfr>(p, OFF_XT); bfr* BN = wsp<bfr>(p, OFF_BN); bfr* BTt = wsp<bfr>(p, OFF_BT); bfr* CN = wsp<bfr>(p, OFF_CN);
  bfr* TT = (bfr*)smem;
  const float* cw = p.conv_w + (size_t)j * 5 * 2560;
  const float* cb = p.conv_b + (size_t)j * 2560;
  const int n_conv = 264 * 40, n_dt = 792;
  for (int u = p.bidl; u < n_conv + n_dt; u += gridDim.x) {
    if (u < n_conv) {
      const int tb = u / 40, cbk = u % 40, row0 = tb * 64, ch0 = cbk * 64;
      int pos0, len;
      if (row0 < RL) { pos0 = row0 & 8191; len = SEQ; } else { pos0 = (row0 - RL) & 255; len = CTX; }
      const int c8 = tid & 7, ch = ch0 + c8 * 8;
      float w[5][8], bias[8];
#pragma unroll
      for (int k = 0; k < 5; ++k) {
        float4 wa = *(const float4*)(cw + k * 2560 + ch), wb = *(const float4*)(cw + k * 2560 + ch + 4);
        w[k][0] = wa.x; w[k][1] = wa.y; w[k][2] = wa.z; w[k][3] = wa.w; w[k][4] = wb.x; w[k][5] = wb.y; w[k][6] = wb.z; w[k][7] = wb.w;
      }
      {
        float4 wa = *(const float4*)(cb + ch), wb = *(const float4*)(cb + ch + 4);
        bias[0] = wa.x; bias[1] = wa.y; bias[2] = wa.z; bias[3] = wa.w; bias[4] = wb.x; bias[5] = wb.y; bias[6] = wb.z; bias[7] = wb.w;
      }
#pragma unroll
      for (int ps = 0; ps < 2; ++ps) {
        const int tl = (tid >> 3) + 32 * ps, pos = pos0 + tl, row = row0 + tl;
        float a[8];
#pragma unroll
        for (int e = 0; e < 8; ++e) a[e] = bias[e];
        bf16x8 xr[5];
#pragma unroll
        for (int k = 0; k < 5; ++k) {
          const int pp = pos + k - 2;
          const bool ok = pp >= 0 && pp < len;
          const bfr* xp = XBC + (size_t)(ok ? row + k - 2 : row) * 2560 + ch;
          xr[k] = *(const bf16x8*)xp;
          if (!ok) { for (int e = 0; e < 8; ++e) xr[k][e] = 0; }
        }
#pragma unroll
        for (int k = 0; k < 5; ++k)
#pragma unroll
          for (int e = 0; e < 8; ++e) a[e] += w[k][e] * bfs(xr[k][e]);
        bf16x8 o;
#pragma unroll
        for (int e = 0; e < 8; ++e) { float s = a[e] / (1.f + __expf(-a[e])); o[e] = (short)f2bf(s); }
        if (ch0 >= 2048) *(bf16x8*)(CN + (size_t)row * 512 + (ch - 2048)) = o;
        else if (ch0 >= 1536) *(bf16x8*)(BN + (size_t)row * 512 + (ch - 1536)) = o;
        if (ch0 < 2048) {
#pragma unroll
          for (int e = 0; e < 8; ++e) TT[(c8 * 8 + e) * 72 + tl] = (bfr)o[e];
        }
      }
      if (ch0 < 2048) {
        __syncthreads();
        const int chl = tid >> 2, tseg = (tid & 3) * 16;
        bfr* dst = (ch0 < 1536 ? XT + (size_t)(ch0 + chl) * R : BTt + (size_t)(ch0 - 1536 + chl) * R) + row0 + tseg;
        *(bf16x8*)dst = *(const bf16x8*)(TT + chl * 72 + tseg);
        *(bf16x8*)(dst + 8) = *(const bf16x8*)(TT + chl * 72 + tseg + 8);
        __syncthreads();
      }
    } else {
      const int item = (u - n_conv) * 4 + wid;
      const int head = item % 24; int rest = item / 24; const int dir = rest & 1; rest >>= 1; const int c = rest % NCH, b = rest / NCH;
      const int row0 = chunk_row0(b, c), col = dir * 24 + head;
      const float bias = p.dt_bias[j * 48 + col];
      const float a = -expf(p.a_log[j * 48 + col]);
      const float* DTRAW = wsp<float>(p, OFF_DTRAW);
      float dt[4], cs[4];
      float run = 0.f;
#pragma unroll
      for (int q = 0; q < 4; ++q) {
        dt[q] = softplus_f(DTRAW[(size_t)(row0 + lane * 4 + q) * 48 + col] + bias);
        run += dt[q] * a; cs[q] = run;
      }
      float x = run;
#pragma unroll
      for (int o = 1; o < 64; o <<= 1) { float t2 = __shfl_up(x, o); if (lane >= o) x += t2; }
      const float excl = x - run;
      const float total = __shfl(x, 63);
      float ac[4];
#pragma unroll
      for (int q = 0; q < 4; ++q) {
        float inc = excl + cs[q];
        ac[q] = dir == 0 ? inc : total - inc + dt[q] * a;
      }
      const size_t base = ((size_t)(((dir * 2 + b) * NCH + c) * 24 + head)) * 256 + lane * 4;
      *(float4*)(wsp<float>(p, OFF_DTV) + base) = make_float4(dt[0], dt[1], dt[2], dt[3]);
      *(float4*)(wsp<float>(p, OFF_ACUM) + base) = make_float4(ac[0], ac[1], ac[2], ac[3]);
    }
  }
}

DI bf16x8 scale8(bf16x8 a, const float* w) {
  return pack8(bfs(a[0]) * w[0], bfs(a[1]) * w[1], bfs(a[2]) * w[2], bfs(a[3]) * w[3],
               bfs(a[4]) * w[4], bfs(a[5]) * w[5], bfs(a[6]) * w[6], bfs(a[7]) * w[7]);
}

DI void s1_item(const DP& p, int item, int lane) {
  const int r = lane & 31, h = lane >> 5;
  const int head = item % 24; int rest = item / 24; const int dir = rest & 1; rest >>= 1; const int c = rest % NCH, b = rest / NCH;
  const int g = head / 6;
  const int row0 = chunk_row0(b, c);
  const size_t dbase = ((size_t)(((dir * 2 + b) * NCH + c) * 24 + head)) * 256;
  const float* dtv = wsp<float>(p, OFF_DTV) + dbase;
  const float* acm = wsp<float>(p, OFF_ACUM) + dbase;
  const float acend = dir == 0 ? acm[255] : acm[0];
  const bfr* XT = wsp<bfr>(p, OFF_XT); const bfr* BTt = wsp<bfr>(p, OFF_BT);
  bfr* HS = wsp<bfr>(p, OFF_HS) + ((size_t)(((dir * 2 + b) * NCH + c) * 24 + head)) * 8192;
#pragma unroll 1
  for (int pt = 0; pt < 2; ++pt) {
    f32x16 acc[4];
#pragma unroll
    for (int n = 0; n < 4; ++n) acc[n] = zero16();
#pragma unroll 4
    for (int kk = 0; kk < 16; ++kk) {
      const int s0 = kk * 16 + 8 * h;
      float4 d0 = *(const float4*)(dtv + s0), d1 = *(const float4*)(dtv + s0 + 4);
      float4 a0 = *(const float4*)(acm + s0), a1 = *(const float4*)(acm + s0 + 4);
      float w[8];
      w[0] = d0.x * __expf(acend - a0.x); w[1] = d0.y * __expf(acend - a0.y); w[2] = d0.z * __expf(acend - a0.z); w[3] = d0.w * __expf(acend - a0.w);
      w[4] = d1.x * __expf(acend - a1.x); w[5] = d1.y * __expf(acend - a1.y); w[6] = d1.z * __expf(acend - a1.z); w[7] = d1.w * __expf(acend - a1.w);
      bf16x8 af = scale8(*(const bf16x8*)(XT + (size_t)(head * 64 + pt * 32 + r) * R + row0 + s0), w);
#pragma unroll
      for (int nt = 0; nt < 4; ++nt) {
        bf16x8 bfv = *(const bf16x8*)(BTt + (size_t)(g * 128 + nt * 32 + r) * R + row0 + s0);
        acc[nt] = MFMA(af, bfv, acc[nt]);
      }
    }
#pragma unroll
    for (int nt = 0; nt < 4; ++nt)
#pragma unroll
      for (int i = 0; i < 16; ++i) HS[(pt * 32 + crow(i, h)) * 128 + nt * 32 + r] = f2bf(acc[nt][i]);
  }
}

DI void s1_block(const DP& p, int item) {
  const int tid = p.tidl, lane = tid & 63, wid = tid >> 6, r = lane & 31, h = lane >> 5;
  const int g = item & 3; const int bc = item >> 2; const int c = bc % NCH, b = bc / NCH;
  const int row0 = chunk_row0(b, c);
  const bfr* XT = wsp<bfr>(p, OFF_XT); const bfr* BTt = wsp<bfr>(p, OFF_BT);
  bfr* BS = (bfr*)smem;
  __syncthreads();
#pragma unroll 4
  for (int i = 0; i < 32; ++i) {
    const int row = wid * 32 + i;
    if (lane < 32)
      __builtin_amdgcn_global_load_lds((const unsigned*)(BTt + (size_t)(g * 128 + row) * R + row0 + lane * 8),
                                       (unsigned*)(BS + row * 264 + lane * 8), 16, 0, 0);
  }
  asm volatile("s_waitcnt vmcnt(0)" ::: "memory");
  __syncthreads();
#pragma unroll 1
  for (int j3 = 0; j3 < 3; ++j3) {
    const int pi = wid * 3 + j3, dir = pi / 6, head = g * 6 + pi % 6;
    const size_t ci = (size_t)(((dir * 2 + b) * NCH + c) * 24 + head);
    const float* dtv = wsp<float>(p, OFF_DTV) + ci * 256;
    const float* acm = wsp<float>(p, OFF_ACUM) + ci * 256;
    const float acend = dir == 0 ? acm[255] : acm[0];
    bfr* HS = wsp<bfr>(p, OFF_HS) + ci * 8192;
    float* WS = (float*)(smem + 67584) + wid * 256;
    {
      const float4 d4 = *(const float4*)(dtv + lane * 4), a4 = *(const float4*)(acm + lane * 4);
      asm volatile("" ::: "memory");
      *(float4*)(WS + lane * 4) = make_float4(d4.x * __expf(acend - a4.x), d4.y * __expf(acend - a4.y),
                                              d4.z * __expf(acend - a4.z), d4.w * __expf(acend - a4.w));
      asm volatile("s_waitcnt lgkmcnt(0)" ::: "memory");
    }
#pragma unroll 1
    for (int pt = 0; pt < 2; ++pt) {
      f32x16 acc[4];
#pragma unroll
      for (int n = 0; n < 4; ++n) acc[n] = zero16();
#pragma unroll 4
      for (int kk = 0; kk < 16; ++kk) {
        const int s0 = kk * 16 + 8 * h;
        const float4 w0 = *(const float4*)(WS + s0), w1 = *(const float4*)(WS + s0 + 4);
        const float w[8] = {w0.x, w0.y, w0.z, w0.w, w1.x, w1.y, w1.z, w1.w};
        bf16x8 af = scale8(*(const bf16x8*)(XT + (size_t)(head * 64 + pt * 32 + r) * R + row0 + s0), w);
#pragma unroll
        for (int nt = 0; nt < 4; ++nt) {
          bf16x8 bfv = *(const bf16x8*)(BS + (nt * 32 + r) * 264 + s0);
          acc[nt] = MFMA(af, bfv, acc[nt]);
        }
      }
#pragma unroll
      for (int nt = 0; nt < 4; ++nt)
#pragma unroll
        for (int i = 0; i < 16; ++i) HS[(pt * 32 + crow(i, h)) * 128 + nt * 32 + r] = f2bf(acc[nt][i]);
    }
  }
}

DI void f1_item(const DP& p, int item, int lane) {
  const int r = lane & 31, h = lane >> 5;
  const int l2t = item & 1, m = (item >> 1) & 511, b = item >> 10;
  const bfr* ZRT = wsp<bfr>(p, OFF_ZRT) + (size_t)m * R + b * SEQ + l2t * 32 + r;
  const bfr* ZIT = wsp<bfr>(p, OFF_ZIT) + (size_t)m * R + b * SEQ + l2t * 32 + r;
  const bfr* C128 = wsp<bfr>(p, OFF_C128); const bfr* S128 = wsp<bfr>(p, OFF_S128);
  const float2* TW = wsp<float2>(p, OFF_TW);
  bfr* YR = wsp<bfr>(p, OFF_YR); bfr* YI = wsp<bfr>(p, OFF_YI);
  const int l2 = l2t * 32 + r;
#pragma unroll 1
  for (int mh = 0; mh < 2; ++mh) {
    f32x16 yr[2], yi[2];
#pragma unroll
    for (int i = 0; i < 2; ++i) { yr[i] = zero16(); yi[i] = zero16(); }
#pragma unroll 2
    for (int kk = 0; kk < 8; ++kk) {
      bf16x8 zr, zi, nzr;
#pragma unroll
      for (int jj = 0; jj < 8; ++jj) {
        int l1 = kk * 16 + 8 * h + jj;
        zr[jj] = (short)ZRT[l1 * 64]; zi[jj] = (short)ZIT[l1 * 64];
        nzr[jj] = (short)(zr[jj] ^ (short)0x8000);
      }
#pragma unroll
      for (int m2 = 0; m2 < 2; ++m2) {
        const int mt = mh * 2 + m2;
        bf16x8 ca = *(const bf16x8*)(C128 + (mt * 32 + r) * 128 + kk * 16 + 8 * h);
        bf16x8 sa = *(const bf16x8*)(S128 + (mt * 32 + r) * 128 + kk * 16 + 8 * h);
        yr[m2] = MFMA(ca, zr, yr[m2]); yr[m2] = MFMA(sa, zi, yr[m2]);
        yi[m2] = MFMA(ca, zi, yi[m2]); yi[m2] = MFMA(sa, nzr, yi[m2]);
      }
    }
#pragma unroll
    for (int m2 = 0; m2 < 2; ++m2)
#pragma unroll
      for (int i = 0; i < 16; ++i) {
        int k1 = (mh * 2 + m2) * 32 + crow(i, h);
        float2 t = TW[k1 * l2];
        float a = yr[m2][i], bb = yi[m2][i];
        size_t o = ((size_t)(b * 512 + m) * 128 + k1) * 64 + l2;
        YR[o] = f2bf(a * t.x + bb * t.y);
        YI[o] = f2bf(bb * t.x - a * t.y);
      }
  }
}

DI void f1c_item(const DP& p, int item, int lane) {
  const int r = lane & 31, h = lane >> 5;
  const int mt = item & 15, kt = (item >> 4) & 7, b = item >> 7;
  const int m = mt * 32 + r;
  const bfr* ZRT = wsp<bfr>(p, OFF_ZRT) + (size_t)m * R + RL + b * CTX;
  const bfr* ZIT = wsp<bfr>(p, OFF_ZIT) + (size_t)m * R + RL + b * CTX;
  const bfr* C256 = wsp<bfr>(p, OFF_C256) + (kt * 32 + r) * 256;
  const bfr* S256 = wsp<bfr>(p, OFF_S256) + (kt * 32 + r) * 256;
  f32x16 acc = zero16();
#pragma unroll 4
  for (int kk = 0; kk < 16; ++kk) {
    int o = kk * 16 + 8 * h;
    acc = MFMA(*(const bf16x8*)(C256 + o), *(const bf16x8*)(ZRT + o), acc);
    acc = MFMA(*(const bf16x8*)(S256 + o), *(const bf16x8*)(ZIT + o), acc);
  }
  bfr* MIX = wsp<bfr>(p, OFF_MIX);
#pragma unroll
  for (int i = 0; i < 16; ++i)
    MIX[(size_t)(RL + b * CTX + kt * 32 + crow(i, h)) * 2048 + m] = f2bf(acc[i] * (1.f / 128.f));
}

DI void s1f1_phase(const DP& p) {
  const int nS1 = 2 * NCH * 4;
  const int G = (int)gridDim.x;
  if (G > nS1 + 64) {
    if (p.bidl < nS1) { s1_block(p, p.bidl); return; }
    const int lane = p.tidl & 63;
    const int wg = (p.bidl - nS1) * 4 + (p.tidl >> 6), nw = (G - nS1) * 4;
#pragma unroll 1
    for (int it = wg; it < 2048 + 256; it += nw) {
      if (it < 2048) f1_item(p, it, lane); else f1c_item(p, it - 2048, lane);
    }
  } else {
#pragma unroll 1
    for (int it = p.bidl; it < nS1; it += G) s1_block(p, it);
    const int lane = p.tidl & 63;
    const int wg = p.bidl * 4 + (p.tidl >> 6), nw = G * 4;
#pragma unroll 1
    for (int it = wg; it < 2048 + 256; it += nw) {
      if (it < 2048) f1_item(p, it, lane); else f1c_item(p, it - 2048, lane);
    }
  }
}

DI void f2_item(const DP& p, int item, int lane) {
  const int r = lane & 31, h = lane >> 5;
  const int mt16 = item & 15, k1 = (item >> 4) & 127, b = item >> 11;
  const int m = mt16 * 32 + r;
  const bfr* YR = wsp<bfr>(p, OFF_YR) + ((size_t)(b * 512 + m) * 128 + k1) * 64;
  const bfr* YI = wsp<bfr>(p, OFF_YI) + ((size_t)(b * 512 + m) * 128 + k1) * 64;
  const bfr* C64 = wsp<bfr>(p, OFF_C64); const bfr* S64 = wsp<bfr>(p, OFF_S64);
  f32x16 acc[2]; acc[0] = zero16(); acc[1] = zero16();
#pragma unroll
  for (int kk = 0; kk < 4; ++kk) {
    bf16x8 yr = *(const bf16x8*)(YR + kk * 16 + 8 * h), yi = *(const bf16x8*)(YI + kk * 16 + 8 * h);
#pragma unroll
    for (int t = 0; t < 2; ++t) {
      bf16x8 ca = *(const bf16x8*)(C64 + (t * 32 + r) * 64 + kk * 16 + 8 * h);
      bf16x8 sa = *(const bf16x8*)(S64 + (t * 32 + r) * 64 + kk * 16 + 8 * h);
      acc[t] = MFMA(ca, yr, acc[t]); acc[t] = MFMA(sa, yi, acc[t]);
    }
  }
  bfr* MIX = wsp<bfr>(p, OFF_MIX);
  const float scale = 0.001381067932f;
#pragma unroll
  for (int t = 0; t < 2; ++t)
#pragma unroll
    for (int i = 0; i < 16; ++i) {
      int k2 = t * 32 + crow(i, h);
      MIX[(size_t)(b * SEQ + k1 + 128 * k2) * 2048 + m] = f2bf(acc[t][i] * scale);
    }
}

DI void s3_block(const DP& p, int j, int b, int c, int g, int half);

DI void s2f2_phase(const DP& p, int j) {
  if (p.bidl < 16) {
    const int k = p.bidl;
    s3_block(p, j, k >> 3, 0, (k >> 1) & 3, k & 1);
    return;
  }
  const int gt = (p.bidl - 16) * 256 + p.tidl, nt = ((int)gridDim.x - 16) * 256;
  bfr* HSb = wsp<bfr>(p, OFF_HS);
  const float* ACUM = wsp<float>(p, OFF_ACUM);
#pragma unroll 1
  for (int it = gt; it < 2 * 2 * 24 * 2048; it += nt) {
    const int e4 = it & 2047; const int rest = it >> 11; const int head = rest % 24, db = rest / 24, dir = db >> 1;
    bf16x4 sv[NCH]; float cd[NCH];
#pragma unroll
    for (int step = 0; step < NCH; ++step) {
      const int c = dir == 0 ? step : (step == 0 ? 0 : NCH - step);
      const size_t ci = (size_t)((db * NCH + c) * 24 + head);
      sv[step] = *(const bf16x4*)(HSb + ci * 8192 + e4 * 4);
      cd[step] = ACUM[ci * 256 + (dir == 0 ? 255 : 0)];
    }
    float h0 = 0.f, h1 = 0.f, h2 = 0.f, h3 = 0.f;
#pragma unroll
    for (int step = 0; step < NCH; ++step) {
      const int c = dir == 0 ? step : (step == 0 ? 0 : NCH - step);
      const size_t ci = (size_t)((db * NCH + c) * 24 + head);
      *(bf16x4*)(HSb + ci * 8192 + e4 * 4) = pack4(h0, h1, h2, h3);
      const float e = __expf(cd[step]);
      h0 = h0 * e + bfs(sv[step][0]); h1 = h1 * e + bfs(sv[step][1]); h2 = h2 * e + bfs(sv[step][2]); h3 = h3 * e + bfs(sv[step][3]);
    }
  }
  const int lane = p.tidl & 63;
  const int wg = (p.bidl - 16) * 4 + (p.tidl >> 6), nw = ((int)gridDim.x - 16) * 4;
#pragma unroll 1
  for (int it = wg; it < 4096; it += nw) f2_item(p, it, lane);
}

DI void s3_block(const DP& p, int j, int b, int c, int g, int half) {
  const int tid = p.tidl, lane = tid & 63, wid = tid >> 6, r = lane & 31, h = lane >> 5;
  const bfr* CN = wsp<bfr>(p, OFF_CN); const bfr* BN = wsp<bfr>(p, OFF_BN); const bfr* XT = wsp<bfr>(p, OFF_XT);
  const bfr* Z = wsp<bfr>(p, OFF_Z); bfr* MIX = wsp<bfr>(p, OFF_MIX);
  bfr* XTs = (bfr*)smem;
  bfr* HSF = (bfr*)(smem + 33792);
  bfr* HSB = (bfr*)(smem + 51200);
  float* LWF = (float*)(smem + 68608);
  float* LWB = LWF + 256;
  {
    const int row0 = chunk_row0(b, c);
    const int lt = half * 4 + wid;
    const int rowl = row0 + lt * 32 + r;
    const bfr* cfp = CN + (size_t)rowl * 512 + g * 128 + 8 * h;
    bf16x8 gtp[8][2];
    {
      bf16x8 cf[8];
#pragma unroll
      for (int kk = 0; kk < 8; ++kk) cf[kk] = *(const bf16x8*)(cfp + kk * 16);
#pragma unroll
      for (int k = 0; k < 8; ++k) { gtp[k][0] = cf[0]; gtp[k][1] = cf[0]; }
      __syncthreads();
      {
        bfr* BS = (bfr*)smem;
#pragma unroll 4
        for (int i = 0; i < 64; ++i) {
          const int row = wid * 64 + i;
          if (lane < 16)
            __builtin_amdgcn_global_load_lds((const unsigned*)(BN + (size_t)(row0 + row) * 512 + g * 128 + lane * 8),
                                             (unsigned*)(BS + row * 136 + lane * 8), 16, 0, 0);
        }
      }
      asm volatile("s_waitcnt vmcnt(0)" ::: "memory");
      __syncthreads();
#pragma unroll 1
      for (int st = 0; st < 8; ++st) {
        f32x16 gt = zero16();
#pragma unroll
        for (int kk = 0; kk < 8; ++kk)
          gt = MFMA(*(const bf16x8*)((const bfr*)smem + (st * 32 + r) * 136 + kk * 16 + 8 * h), cf[kk], gt);
#pragma unroll
        for (int k = 0; k < 7; ++k) { gtp[k][0] = gtp[k + 1][0]; gtp[k][1] = gtp[k + 1][1]; }
        gtp[7][0] = PACK_HALF(gt, 0); gtp[7][1] = PACK_HALF(gt, 1);
      }
    }
    float sumsq = 0.f;
#pragma unroll 1
    for (int hh = 0; hh < 6; ++hh) {
      const int head = g * 6 + hh;
      const size_t cif = (size_t)(((0 * 2 + b) * NCH + c) * 24 + head), cib = (size_t)(((1 * 2 + b) * NCH + c) * 24 + head);
      const float* acf = wsp<float>(p, OFF_ACUM) + cif * 256; const float* acb = wsp<float>(p, OFF_ACUM) + cib * 256;
      const float* dtf = wsp<float>(p, OFF_DTV) + cif * 256; const float* dtb = wsp<float>(p, OFF_DTV) + cib * 256;
      const bfr* HSf = wsp<bfr>(p, OFF_HS) + cif * 8192; const bfr* HSbk = wsp<bfr>(p, OFF_HS) + cib * 8192;
      __syncthreads();
#pragma unroll 4
      for (int i = 0; i < 16; ++i) {
        const int row = wid * 16 + i;
        if (lane < 32)
          __builtin_amdgcn_global_load_lds((const unsigned*)(XT + (size_t)(head * 64 + row) * R + row0 + lane * 8),
                                           (unsigned*)(XTs + row * 264 + lane * 8), 16, 0, 0);
      }
      if (c != 0) {
#pragma unroll 4
        for (int i = 0; i < 16; ++i) {
          const int row = wid * 16 + i;
          if (lane < 16) {
            __builtin_amdgcn_global_load_lds((const unsigned*)(HSf + row * 128 + lane * 8), (unsigned*)(HSF + row * 136 + lane * 8), 16, 0, 0);
            __builtin_amdgcn_global_load_lds((const unsigned*)(HSbk + row * 128 + lane * 8), (unsigned*)(HSB + row * 136 + lane * 8), 16, 0, 0);
          }
        }
      }
      bf16x8 cfh[8];
#pragma unroll
      for (int kk = 0; kk < 8; ++kk) cfh[kk] = *(const bf16x8*)(cfp + kk * 16);
      LWF[tid] = (__logf(dtf[tid]) - acf[tid]) * 1.44269504f;
      LWB[tid] = (__logf(dtb[tid]) - acb[tid]) * 1.44269504f;
      const float al_f = acf[lt * 32 + r], al_b = acb[lt * 32 + r];
      asm volatile("s_waitcnt vmcnt(0)" ::: "memory");
      __syncthreads();
      f32x16 acc[2];
      acc[0] = zero16(); acc[1] = zero16();
      if (c != 0) {
        f32x16 t0 = zero16(), t1 = zero16();
#pragma unroll
        for (int kk = 0; kk < 8; ++kk) {
          t0 = MFMA(*(const bf16x8*)(HSF + (r) * 136 + kk * 16 + 8 * h), cfh[kk], t0);
          t1 = MFMA(*(const bf16x8*)(HSF + (32 + r) * 136 + kk * 16 + 8 * h), cfh[kk], t1);
        }
        const float ef = __expf(al_f);
#pragma unroll
        for (int i = 0; i < 16; ++i) { acc[0][i] = t0[i] * ef; acc[1][i] = t1[i] * ef; }
        t0 = zero16(); t1 = zero16();
#pragma unroll
        for (int kk = 0; kk < 8; ++kk) {
          t0 = MFMA(*(const bf16x8*)(HSB + (r) * 136 + kk * 16 + 8 * h), cfh[kk], t0);
          t1 = MFMA(*(const bf16x8*)(HSB + (32 + r) * 136 + kk * 16 + 8 * h), cfh[kk], t1);
        }
        const float eb = __expf(al_b);
#pragma unroll
        for (int i = 0; i < 16; ++i) { acc[0][i] += t0[i] * eb; acc[1][i] += t1[i] * eb; }
      }
      bf16x4 zpre[2][4];
#pragma unroll
      for (int pt = 0; pt < 2; ++pt)
#pragma unroll
        for (int g4 = 0; g4 < 4; ++g4) zpre[pt][g4] = *(const bf16x4*)(Z + (size_t)rowl * 1536 + head * 64 + pt * 32 + 8 * g4 + 4 * h);
#pragma unroll 1
      for (int st = 0; st < 8; ++st) {
        const bf16x8 g0 = gtp[0][0], g1 = gtp[0][1];
#pragma unroll
        for (int k = 0; k < 7; ++k) { gtp[k][0] = gtp[k + 1][0]; gtp[k][1] = gtp[k + 1][1]; }
        gtp[7][0] = g0; gtp[7][1] = g1;
#pragma unroll 1
        for (int dir = 0; dir < 2; ++dir) {
          if (dir == 0 ? (st > lt) : (st < lt)) continue;
          const float* lwd = dir == 0 ? LWF : LWB;
          const float al = (dir == 0 ? al_f : al_b) * 1.44269504f;
          f32x16 mm;
          if (st != lt) {
#pragma unroll
            for (int g4 = 0; g4 < 4; ++g4) {
              const float4 l4 = *(const float4*)(lwd + st * 32 + 8 * g4 + 4 * h);
              const float lv[4] = {l4.x, l4.y, l4.z, l4.w};
#pragma unroll
              for (int q = 0; q < 4; ++q) {
                const int i = 4 * g4 + q;
                mm[i] = bfs((i >> 3) ? g1[i & 7] : g0[i & 7]) * __builtin_amdgcn_exp2f(al + lv[q]);
              }
            }
          } else {
#pragma unroll
            for (int g4 = 0; g4 < 4; ++g4) {
              const int sb = st * 32 + 8 * g4 + 4 * h;
              const float4 l4 = *(const float4*)(lwd + sb);
              const float lv[4] = {l4.x, l4.y, l4.z, l4.w};
#pragma unroll
              for (int q = 0; q < 4; ++q) {
                const int i = 4 * g4 + q;
                const int sidx = sb + q, lidx = lt * 32 + r;
                const bool valid = dir == 0 ? (sidx <= lidx) : (sidx >= lidx);
                const float gv = bfs((i >> 3) ? g1[i & 7] : g0[i & 7]);
                const float e = __builtin_amdgcn_exp2f(fminf(al + lv[q], 40.f));
                mm[i] = valid ? gv * e : 0.f;
              }
            }
          }
#pragma unroll
          for (int s2 = 0; s2 < 2; ++s2) {
            bf16x8 pf = PACK_HALF(mm, s2);
#pragma unroll
            for (int pt = 0; pt < 2; ++pt) {
              const bfr* xp = XTs + (pt * 32 + r) * 264 + st * 32 + 16 * s2 + 4 * h;
              bf16x8 xf = join44(*(const bf16x4*)xp, *(const bf16x4*)(xp + 8));
              acc[pt] = MFMA(xf, pf, acc[pt]);
            }
          }
        }
      }
      const float dsk = p.d_skip[j * 24 + head];
#pragma unroll
      for (int pt = 0; pt < 2; ++pt)
#pragma unroll
        for (int g4 = 0; g4 < 4; ++g4) {
          const int pb = pt * 32 + 8 * g4 + 4 * h;
          bf16x4 zv = zpre[pt][g4];
          float y[4];
#pragma unroll
          for (int q = 0; q < 4; ++q) {
            float xv = bf2f(XTs[(pb + q) * 264 + lt * 32 + r]);
            float zz = bfs(zv[q]);
            float v = (acc[pt][4 * g4 + q] + dsk * xv) * (zz / (1.f + __expf(-zz)));
            sumsq += v * v; y[q] = v;
          }
          *(bf16x4*)(MIX + (size_t)rowl * 2048 + 512 + head * 64 + pb) = pack4(y[0], y[1], y[2], y[3]);
        }
    }
    const float tot = sumsq + __shfl_xor(sumsq, 32);
    const float sc = rsqrtf(tot * (1.f / 384.f) + 1e-6f);
    const float* ng = p.ssd_norm_g + (size_t)j * 1536;
    bf16x4 yv[6][2][4];
#pragma unroll
    for (int hh = 0; hh < 6; ++hh)
#pragma unroll
      for (int pt = 0; pt < 2; ++pt)
#pragma unroll
        for (int g4 = 0; g4 < 4; ++g4)
          yv[hh][pt][g4] = *(const bf16x4*)(MIX + (size_t)rowl * 2048 + 512 + (g * 6 + hh) * 64 + pt * 32 + 8 * g4 + 4 * h);
#pragma unroll
    for (int hh = 0; hh < 6; ++hh)
#pragma unroll
      for (int pt = 0; pt < 2; ++pt)
#pragma unroll
        for (int g4 = 0; g4 < 4; ++g4) {
          const int pb = pt * 32 + 8 * g4 + 4 * h, head = g * 6 + hh;
          const float4 gg = *(const float4*)(ng + head * 64 + pb);
          const bf16x4 y4 = yv[hh][pt][g4];
          *(bf16x4*)(MIX + (size_t)rowl * 2048 + 512 + head * 64 + pb) =
              pack4(bfs(y4[0]) * sc * gg.x, bfs(y4[1]) * sc * gg.y, bfs(y4[2]) * sc * gg.z, bfs(y4[3]) * sc * gg.w);
        }
  }
}

DI void s3_phase(const DP& p, int j) {
#pragma unroll 1
  for (int idx = p.bidl; idx < 512; idx += (int)gridDim.x) {
    const int half = idx & 1, g = (idx >> 1) & 3, bcl = idx >> 3;
    s3_block(p, j, bcl >> 5, 1 + (bcl & 31), g, half);
  }
}

DI void qkprep_phase(const DP& p, int j) {
  const int lane = p.tidl & 63;
  const int wg = p.bidl * 4 + (p.tidl >> 6), nw = gridDim.x * 4;
  const bfr* P = wsp<bfr>(p, OFF_P); bfr* QK = wsp<bfr>(p, OFF_QK);
  const float* ROPE = wsp<float>(p, OFF_ROPE);
  const int sub = lane >> 3, d0 = (lane & 7) * 8;
  for (int row = wg; row < R; row += nw) {
    bf16x8 xin[4];
#pragma unroll
    for (int ps = 0; ps < 4; ++ps) {
      const int hs0 = ps * 8 + sub, hsc0 = hs0 < 26 ? hs0 : 25;
      xin[ps] = *(const bf16x8*)(P + (size_t)row * 2304 + (hsc0 < 10 ? hsc0 * 64 : 768 + (hsc0 - 10) * 64) + d0);
    }
#pragma unroll
    for (int ps = 0; ps < 4; ++ps) {
      const int hs = ps * 8 + sub;
      const bool act = hs < 26;
      const int hsc = act ? hs : 25;
      bf16x8 xv = xin[ps];
      float x[8]; float ss = 0.f;
#pragma unroll
      for (int e = 0; e < 8; ++e) { x[e] = bfs(xv[e]); ss += x[e] * x[e]; }
      ss += __shfl_xor(ss, 1); ss += __shfl_xor(ss, 2); ss += __shfl_xor(ss, 4);
      const float rs = rsqrtf(ss * (1.f / 64.f) + 1e-6f);
      const float* gv = hsc < 8 ? p.q_norm_win + j * 64 : hsc < 10 ? p.k_norm_win + j * 64 : hsc < 18 ? p.q_norm_na + j * 64 : p.k_norm_na + j * 64;
#pragma unroll
      for (int e = 0; e < 8; ++e) x[e] = x[e] * rs * gv[d0 + e];
      float pr[8];
#pragma unroll
      for (int e = 0; e < 8; ++e) pr[e] = __shfl_xor(x[e], 2);
      if (hsc < 10 && row < RL) {
        const int pos = row & 8191;
        const int axis = d0 >> 5;
        const int idx = axis == 0 ? (pos >> 6) : (pos & 63);
        const int f0 = d0 & 15;
        const bool second = (d0 & 16) != 0;
        const float* cp = ROPE + (axis * 128 + idx) * 16 + f0;
        const float* sp = cp + 4096;
#pragma unroll
        for (int e = 0; e < 8; ++e) {
          float cs = cp[e], sn = sp[e];
          x[e] = second ? (x[e] * cs + pr[e] * sn) : (x[e] * cs - pr[e] * sn);
        }
      }
      const bool isq = hsc < 8 || (hsc >= 10 && hsc < 18);
      const float qs = isq ? 0.125f : 1.f;
      if (act) *(bf16x8*)(QK + (size_t)row * 1664 + hsc * 64 + d0) = pack8(x[0] * qs, x[1] * qs, x[2] * qs, x[3] * qs, x[4] * qs, x[5] * qs, x[6] * qs, x[7] * qs);
    }
  }
}

struct KVF { bf16x8 k[4]; bf16x8 v[2][2]; };
struct KVS { bf16x8 k[4]; bf16x8 v[4]; };

DI void kv_gload(KVS& g, const bfr* __restrict__ Kt, const bfr* __restrict__ Vt, int lane) {
#pragma unroll
  for (int i = 0; i < 4; ++i) {
    const int idx = lane + 64 * i;
    g.k[i] = *(const bf16x8*)(Kt + (size_t)(idx >> 3) * 1664 + (idx & 7) * 8);
    g.v[i] = *(const bf16x8*)(Vt + (size_t)(idx >> 2) * R + (idx & 3) * 8);
  }
}
DI void kv_sstore(const KVS& g, unsigned char* base, int lane) {
#pragma unroll
  for (int i = 0; i < 4; ++i) {
    const int idx = lane + 64 * i;
    { const int row = idx >> 3, c = idx & 7; *(bf16x8*)(base + row * 128 + ((c ^ (row & 7)) << 4)) = g.k[i]; }
    {
      const int d = idx >> 2, c16 = idx & 3, sw = (d >> 2) & 7;
      bf16x4 lo = __builtin_shufflevector(g.v[i], g.v[i], 0, 1, 2, 3), hi = __builtin_shufflevector(g.v[i], g.v[i], 4, 5, 6, 7);
      *(bf16x4*)(base + 4096 + d * 64 + (((2 * c16) ^ sw) << 3)) = lo;
      *(bf16x4*)(base + 4096 + d * 64 + (((2 * c16 + 1) ^ sw) << 3)) = hi;
    }
  }
}
DI void kv_sload(KVF& f, const unsigned char* base, int r, int h) {
#pragma unroll
  for (int kk = 0; kk < 4; ++kk) f.k[kk] = *(const bf16x8*)(base + r * 128 + (((2 * kk + h) ^ (r & 7)) << 4));
#pragma unroll
  for (int s2 = 0; s2 < 2; ++s2)
#pragma unroll
    for (int dt = 0; dt < 2; ++dt) {
      const int d = dt * 32 + r, sw = (d >> 2) & 7, c8 = 4 * s2 + h;
      const unsigned char* vb = base + 4096 + d * 64;
      f.v[s2][dt] = join44(*(const bf16x4*)(vb + ((c8 ^ sw) << 3)), *(const bf16x4*)(vb + (((c8 + 2) ^ sw) << 3)));
    }
}

DI void attn_compute(f32x16 (&o)[2], float& m, float& l, const unsigned char* qb, const unsigned char* base, int r, int h,
                     int mode, int a0, int a1, const float* __restrict__ rp) {
  f32x16 s = zero16();
#pragma unroll
  for (int kk = 0; kk < 4; ++kk) {
    const int off = r * 128 + (((2 * kk + h) ^ (r & 7)) << 4);
    s = MFMA(*(const bf16x8*)(base + off), *(const bf16x8*)(qb + off), s);
  }
  float tmax = -3.0e38f;
  if (mode == 1) {
#pragma unroll
    for (int i = 0; i < 16; ++i) { int dd = a0 - crow(i, h); dd = dd < 0 ? -dd : dd; s[i] = dd <= 128 ? s[i] : -1.0e30f; }
  } else if (mode == 2) {
#pragma unroll
    for (int i = 0; i < 16; ++i) {
      const int key = crow(i, h);
      const int rel = a0 + key;
      int co = a1 + key; co = co < 0 ? 0 : (co > 30 ? 30 : co);
      s[i] = (rel >= 0 && rel < 16) ? s[i] + rp[co] : -1.0e30f;
    }
  }
#pragma unroll
  for (int i = 0; i < 16; ++i) tmax = fmaxf(tmax, s[i]);
  tmax = fmaxf(tmax, __shfl_xor(tmax, 32));
  const float mn = fmaxf(m, tmax);
  const float alpha = __expf(m - mn);
  float ps = 0.f;
#pragma unroll
  for (int i = 0; i < 16; ++i) { s[i] = __expf(s[i] - mn); ps += s[i]; }
  l = l * alpha + ps; m = mn;
#pragma unroll
  for (int i = 0; i < 16; ++i) { o[0][i] *= alpha; o[1][i] *= alpha; }
#pragma unroll
  for (int s2 = 0; s2 < 2; ++s2) {
    bf16x8 pf = PACK_HALF(s, s2);
#pragma unroll
    for (int dt = 0; dt < 2; ++dt) {
      const int d = dt * 32 + r, sw = (d >> 2) & 7, c8 = 4 * s2 + h;
      const unsigned char* vb = base + 4096 + d * 64;
      bf16x8 vf = join44(*(const bf16x4*)(vb + ((c8 ^ sw) << 3)), *(const bf16x4*)(vb + (((c8 + 2) ^ sw) << 3)));
      o[dt] = MFMA(vf, pf, o[dt]);
    }
  }
}

DI void attn_item(const DP& p, int j, int item, int lane) {
  const int r = lane & 31, h = lane >> 5;
  const bfr* QK = wsp<bfr>(p, OFF_QK); const bfr* VT = wsp<bfr>(p, OFF_VT); bfr* MIX = wsp<bfr>(p, OFF_MIX);
  int kind, b, hd, qt;
  if (item < 4096) { kind = 0; qt = item & 255; hd = (item >> 8) & 7; b = item >> 11; }
  else if (item < 8192) { int v = item - 4096; kind = 1; qt = v & 255; hd = (v >> 8) & 7; b = v >> 11; }
  else if (item < 8320) { int v = item - 8192; kind = 2; qt = v & 7; hd = (v >> 3) & 7; b = v >> 6; }
  else { int v = item - 8320; kind = 3; qt = v & 7; hd = (v >> 3) & 7; b = v >> 6; }
  const bool win = (kind == 0 || kind == 2);
  const bool lat = kind < 2;
  const int q_row0 = lat ? b * SEQ + qt * 32 : RL + b * CTX + qt * 32;
  const int qcol = win ? hd * 64 : (10 + hd) * 64;
  const int kcol = win ? (8 + (hd >> 2)) * 64 : (18 + hd) * 64;
  const bfr* Vb = win ? VT + (size_t)((hd >> 2) * 64) * R : VT + (size_t)(128 + hd * 64) * R;
  const bfr* Kb = QK + kcol;
  f32x16 o[2]; o[0] = zero16(); o[1] = zero16();
  float m = -1.0e30f, l = 0.f;
  if (win) { m = p.sink_win[j * 8 + hd]; l = h == 0 ? 1.f : 0.f; }
  int nloc = 0, lo = 0, gr = 0, kr0 = 0, w = 0, cs = 0;
  const int qpos = qt * 32 + r;
  if (kind == 0) { lo = qt - 4 < 0 ? 0 : qt - 4; const int hi = qt + 4 > 255 ? 255 : qt + 4; nloc = hi - lo + 1; }
  else if (kind == 1) {
    gr = qt >> 1; w = (qt & 1) * 32 + r;
    cs = w - 8; cs = cs < 0 ? 0 : (cs > 48 ? 48 : cs);
    kr0 = gr - 4; kr0 = kr0 < 0 ? 0 : (kr0 > 120 ? 120 : kr0);
    nloc = 16;
  }
  const int ntile = 8 + nloc;
  const float* rpb = p.rpb_na + (size_t)j * 8 * 15 * 31 + hd * 15 * 31;
  auto tile_row = [&](int i) -> int {
    if (i < 8) return RL + b * CTX + i * 32;
    const int li = i - 8;
    if (kind == 0) return b * SEQ + (lo + li) * 32;
    return b * SEQ + (kr0 + (li >> 1)) * 64 + (li & 1) * 32;
  };
  unsigned char* lbase = smem + (p.tidl >> 6) * 12288;
  asm volatile("" ::: "memory");
#pragma unroll
  for (int i = 0; i < 4; ++i) {
    const int idx = lane + 64 * i, row = idx >> 3, c = idx & 7;
    *(bf16x8*)(lbase + 8192 + row * 128 + ((c ^ (row & 7)) << 4)) = *(const bf16x8*)(QK + (size_t)(q_row0 + row) * 1664 + qcol + c * 8);
  }
  KVS g;
  { const int k0 = tile_row(0); kv_gload(g, Kb + (size_t)k0 * 1664, Vb + k0, lane); }
  kv_sstore(g, lbase, lane);
#pragma unroll 1
  for (int i = 0; i < ntile; ++i) {
    { const int in = i + 1 < ntile ? i + 1 : i; const int k0 = tile_row(in); kv_gload(g, Kb + (size_t)k0 * 1664, Vb + k0, lane); }
    int mode = 0, a0 = 0, a1 = 0; const float* rp = rpb;
    if (i >= 8) {
      const int li = i - 8;
      if (kind == 0) { mode = 1; a0 = qpos - (lo + li) * 32; }
      else { mode = 2; const int krow = kr0 + (li >> 1); const int ub = (li & 1) * 32; a0 = ub - cs; a1 = ub - w + 15; rp = rpb + (krow - gr + 7) * 31; }
    }
    asm volatile("" ::: "memory");
    attn_compute(o, m, l, lbase + 8192, lbase, r, h, mode, a0, a1, rp);
    asm volatile("" ::: "memory");
    kv_sstore(g, lbase, lane);
  }
  asm volatile("" ::: "memory");
  const float lt = l + __shfl_xor(l, 32);
  const float inv = 1.f / lt;
  const int ocol = win ? hd * 64 : 512 + hd * 64;
#pragma unroll
  for (int dt = 0; dt < 2; ++dt)
#pragma unroll
    for (int g4 = 0; g4 < 4; ++g4) {
      const int d = dt * 32 + 8 * g4 + 4 * h;
      *(bf16x4*)(MIX + (size_t)(q_row0 + r) * 1024 + ocol + d) =
          pack4(o[dt][4 * g4] * inv, o[dt][4 * g4 + 1] * inv, o[dt][4 * g4 + 2] * inv, o[dt][4 * g4 + 3] * inv);
    }
}

DI void attn_phase(const DP& p, int j) {
  const int lane = p.tidl & 63;
  const int wg = p.bidl * 4 + (p.tidl >> 6), nw = gridDim.x * 4;
#pragma unroll 1
  for (int it = wg; it < 8448; it += nw) attn_item(p, j, it, lane);
}

#define XB_TMO      128
#define XB_XCNT(j)  (256  + 64 * (j))
#define XB_XSUB(j)  (1280 + 64 * (j))
#define XB_XGEN(j)  (2304 + 64 * (j))
#define XB_TOP      3328
#define XB_TOPGEN   3392
#define XCD_BAR_WORDS 3456
#define XB_SPIN_CAP (1u << 18)
#define LAS __attribute__((address_space(3)))

__device__ __forceinline__ unsigned xb_ld(unsigned* p)              { return __hip_atomic_load(p, __ATOMIC_RELAXED, __HIP_MEMORY_SCOPE_AGENT); }
__device__ __forceinline__ unsigned xb_add(unsigned* p, unsigned v) { return __hip_atomic_fetch_add(p, v, __ATOMIC_RELAXED, __HIP_MEMORY_SCOPE_AGENT); }
__device__ __forceinline__ unsigned xb_xcc_id() { return (unsigned)__builtin_amdgcn_s_getreg((3 << 11) | 20) & 0xFu; }
#define XB_SPIN(cond, bar) do { unsigned _sp = 0; while (cond) { __builtin_amdgcn_s_sleep(1); \
    if ((++_sp & 255u) == 0u) { if (xb_ld(&(bar)[XB_TMO])) break; if (_sp > XB_SPIN_CAP) { atomicAdd(&(bar)[XB_TMO], 1u); break; } } } } while (0)

struct XcdBarrier {
    unsigned* bar; unsigned x;
    volatile LAS unsigned* st;
};

__device__ __forceinline__ XcdBarrier xcd_barrier_post(unsigned* bar, volatile LAS unsigned* st) {
    XcdBarrier b; b.bar = bar; b.x = xb_xcc_id(); b.st = st;
    if (threadIdx.x == 0) (void)xb_add(&bar[XB_XCNT(b.x)], 1u);
    return b;
}
__device__ __forceinline__ void xcd_barrier_complete(unsigned* bar, unsigned x, unsigned& nloc, unsigned& nx) {
    const unsigned G = gridDim.x * gridDim.y * gridDim.z;
    unsigned sum, cnt, mine, sp = 0u;
    for (;;) {
        sum = 0u; cnt = 0u; mine = 0u;
#pragma unroll
        for (unsigned j = 0; j < 16; ++j) { const unsigned c = xb_ld(&bar[XB_XCNT(j)]); sum += c; cnt += (c > 0u) ? 1u : 0u; mine = (j == x) ? c : mine; }
        if (sum == G) break;
        __builtin_amdgcn_s_sleep(1);
        if ((++sp & 255u) == 0u) { if (xb_ld(&bar[XB_TMO])) break; if (sp > XB_SPIN_CAP) { atomicAdd(&bar[XB_TMO], 1u); break; } }
    }
    nloc = mine > 0u ? mine : 1u; nx = cnt > 0u ? cnt : 1u;
}

__device__ __forceinline__ void xcd_barrier(const XcdBarrier& b) {
    asm volatile("s_waitcnt vmcnt(0)" ::: "memory");
    __syncthreads();
    if (threadIdx.x == 0) {
        unsigned* bar = b.bar;
        __builtin_amdgcn_s_waitcnt(0);
        unsigned nloc = b.st[0], nx = b.st[1];
        if (nloc == 0u) { xcd_barrier_complete(bar, b.x, nloc, nx); b.st[0] = nloc; b.st[1] = nx; }
        const unsigned old = xb_add(&bar[XB_XSUB(b.x)], 1u);
        const unsigned gen = old / nloc;
        if (old + 1u == (gen + 1u) * nloc) {
            __builtin_amdgcn_fence(__ATOMIC_RELEASE, "agent");
            asm volatile("s_waitcnt vmcnt(0)" ::: "memory");
            const unsigned og = xb_add(&bar[XB_TOP], 1u);
            const unsigned tg = og / nx;
            if (og + 1u == (tg + 1u) * nx) xb_add(&bar[XB_TOPGEN], 1u);
            else XB_SPIN(xb_ld(&bar[XB_TOPGEN]) == tg, bar);
            __builtin_amdgcn_fence(__ATOMIC_ACQUIRE, "agent");
            xb_add(&bar[XB_XGEN(b.x)], 1u);
            asm volatile("s_waitcnt vmcnt(0)" ::: "memory");
        } else {
            XB_SPIN(xb_ld(&bar[XB_XGEN(b.x)]) == gen, bar);
            __builtin_amdgcn_fence(__ATOMIC_ACQUIRE, "agent");
            asm volatile("s_waitcnt vmcnt(0)" ::: "memory");
        }
    }
    __syncthreads();
}


DI void run_phase(const DP& p, int ph, int dry) {
  if (ph == 0) { phase0(p); wconv_phase(p, 0); return; }
  int q = ph - 1, layer, lp;
  if (q < 10) { layer = 0; lp = q; } else if (q < 17) { layer = 1; lp = q - 10; } else if (q < 27) { layer = 2; lp = q - 17; } else { layer = 3; lp = q - 27; }
  const int j = layer >> 1;
  const bool even = (layer & 1) == 0;
  int op, gsel = 0;
  if (even) {
    op = (int)((0x2272654321ull >> (4 * lp)) & 15ull); gsel = (int)((0x3201000000ull >> (4 * lp)) & 15ull);
  } else {
    op = (int)((0x2272921ull >> (4 * lp)) & 15ull); gsel = (int)((0x3201000ull >> (4 * lp)) & 15ull);
  }
  if (op == 1 && layer != 0) wconv_phase(p, layer);
  if (op == 1 || op == 7) {
    const bool first = op == 1;
    norm_phase(p, layer, (first ? p.norm_mix_g : p.norm_ff_g) + layer * 1024, first ? 0 : 3, first ? 1 : 4);
  } else if (op == 2) {
    int mode, lda, N, K, gch; size_t offA, offB;
    if (gsel == 0) { mode = even ? EPI_EVEN_IN : EPI_ODD_IN; offA = OFF_MIX; lda = 1024; offB = OFF_WIN; N = even ? 5168 : 2304; K = 1024; gch = 0; }
    else if (gsel == 1) { mode = EPI_RESID; offA = OFF_MIX; lda = even ? 2048 : 1024; offB = OFF_WOUT; N = 1024; K = even ? 2048 : 1024; gch = 2; }
    else if (gsel == 2) { mode = EPI_RELU2; offA = OFF_MIX; lda = 1024; offB = OFF_WFF1; N = 4096; K = 1024; gch = 0; }
    else { mode = EPI_RESID; offA = OFF_ACT; lda = 4096; offB = OFF_WFF2; N = 1024; K = 4096; gch = 5; }
    if (dry && mode == EPI_RESID) mode = 4;
    gemm_phase(p, mode, wsp<bfr>(p, offA), lda, wsp<bfr>(p, offB), N, K, layer, gch, (layer == 3 && gsel != 0) ? RL / 128 : R / 128);
  } else if (op == 3) conv_dt_phase(p, j);
  else if (op == 4) s1f1_phase(p);
  else if (op == 5) s2f2_phase(p, j);
  else if (op == 6) s3_phase(p, j);
  else if (op == 8) qkprep_phase(p, j);
  else if (op == 9) attn_phase(p, j);
}

DI int probe_reps(int ph) {
#ifdef PROBE_MASK
  if (ph == 0) return (PROBE_MASK & 1) ? 2 : 1;
  int q = ph - 1, layer, lp;
  if (q < 10) { layer = 0; lp = q; } else if (q < 17) { layer = 1; lp = q - 10; } else if (q < 27) { layer = 2; lp = q - 17; } else { layer = 3; lp = q - 27; }
  const bool even = (layer & 1) == 0;
  int op, gsel;
  if (even) { op = (int)((0x2272654321ull >> (4 * lp)) & 15ull); gsel = (int)((0x3201000000ull >> (4 * lp)) & 15ull); }
  else { op = (int)((0x2272921ull >> (4 * lp)) & 15ull); gsel = (int)((0x3201000ull >> (4 * lp)) & 15ull); }
  if (op == 5) return 1;
  if (op == 2 && (gsel == 1 || gsel == 3)) return ((PROBE_MASK >> 10) & 1) ? 2 : 1;
  return ((PROBE_MASK >> op) & 1) ? 2 : 1;
#else
  return 1;
#endif
}

__shared__ uint4 xb_words;

__global__ void __launch_bounds__(256, 2) mega(Params p, int ph0, int ph1) {
  cg::grid_group grid = cg::this_grid();
  if (threadIdx.x == 0) xb_words = make_uint4(0u, 0u, 0u, 0u);
  __syncthreads();
  XcdBarrier xb = xcd_barrier_post((unsigned*)(p.ws + OFF_BAR), (volatile LAS unsigned*)&xb_words);
#pragma unroll 1
  for (int ph = ph0; ph < ph1; ++ph) {
    const int nrep = probe_reps(ph);
#pragma unroll 1
    for (int rep = 0; rep < nrep; ++rep) {
      DP q;
      (Params&)q = p;
      int t = threadIdx.x, bb = blockIdx.x;
      asm volatile("" : "+v"(t));
      asm volatile("" : "+s"(bb));
      int z0;
      asm volatile("s_mov_b32 %0, 0" : "=s"(z0));
      q.ws = p.ws + z0;
      q.out = p.out + z0;
      q.tidl = t; q.bidl = bb;
      run_phase(q, ph, rep + 1 < nrep);
    }
    if (ph + 1 < ph1) {
      if (ph == ph0) grid.sync();
      else xcd_barrier(xb);
    }
  }
}

extern "C" void kernel_launch(void* const* d_in, const int* in_sizes, int n_in, void* d_out, int out_size, void* d_ws,
                              size_t ws_size, hipStream_t stream) {
  static int grid_blocks = 0;
  if (!grid_blocks) {
    int dev = 0, cus = 0, per_cu = 0;
    hipGetDevice(&dev);
    hipDeviceGetAttribute(&cus, hipDeviceAttributeMultiprocessorCount, dev);
    hipOccupancyMaxActiveBlocksPerMultiprocessor(&per_cu, mega, 256, 0);
    if (per_cu > 2) per_cu = 2;
    if (per_cu < 1) per_cu = 1;
    grid_blocks = cus * per_cu;
  }
  Params p{};
  const float** pp = (const float**)&p;
  for (int i = 0; i < 26; ++i) pp[i] = (const float*)d_in[i];
  p.out = (float*)d_out;
  p.ws = (unsigned char*)d_ws;
  if (ws_size < WS_TOTAL) fprintf(stderr, "workspace too small: %zu < %zu\n", ws_size, (size_t)WS_TOTAL);
  hipMemsetAsync((unsigned char*)d_ws + OFF_BAR, 0, XCD_BAR_WORDS * 4, stream);
#if MULTI_LAUNCH
  for (int ph = 0; ph < NPHASE; ++ph) {
    int a = ph, b = ph + 1;
    void* args[] = {&p, &a, &b};
    hipLaunchCooperativeKernel((void*)mega, dim3(grid_blocks), dim3(256), args, 0, stream);
  }
#else
  int a = 0, b = NPHASE;
  void* args[] = {&p, &a, &b};
  hipError_t e = hipLaunchCooperativeKernel((void*)mega, dim3(grid_blocks), dim3(256), args, 0, stream);
  if (e != hipSuccess) fprintf(stderr, "cooperative launch failed: %s (grid %d)\n", hipGetErrorString(e), grid_blocks);
#endif
}
```

```cpp
#include <hip/hip_runtime.h>
#include <hip/hip_cooperative_groups.h>
#include <cstdio>
namespace cg = cooperative_groups;

typedef unsigned short bfr;
typedef __attribute__((ext_vector_type(8))) short bf16x8;
typedef __attribute__((ext_vector_type(4))) short bf16x4;
typedef __attribute__((ext_vector_type(16))) float f32x16;
#define DI __device__ __forceinline__
#define MFMA(a, b, c) __builtin_amdgcn_mfma_f32_32x32x16_bf16((a), (b), (c), 0, 0, 0)

#ifndef MULTI_LAUNCH
#define MULTI_LAUNCH 0
#endif

constexpr int RL = 16384, R = 16896, SEQ = 8192, CTX = 256;
constexpr int NCH = 33, CL = 256;
constexpr int NPHASE = 35;

constexpr size_t al(size_t x) { return (x + 255) & ~size_t(255); }
constexpr size_t OFF_HC = 0;
constexpr size_t OFF_MOD = OFF_HC + al(512 * 1024 * 4);
constexpr size_t OFF_TW = OFF_MOD + al(4 * 3 * 6144 * 4);
constexpr size_t OFF_C128 = OFF_TW + al(8192 * 8);
constexpr size_t OFF_S128 = OFF_C128 + al(128 * 128 * 2);
constexpr size_t OFF_C64 = OFF_S128 + al(128 * 128 * 2);
constexpr size_t OFF_S64 = OFF_C64 + al(64 * 64 * 2);
constexpr size_t OFF_C256 = OFF_S64 + al(64 * 64 * 2);
constexpr size_t OFF_S256 = OFF_C256 + al(256 * 256 * 2);
constexpr size_t OFF_ROPE = OFF_S256 + al(256 * 256 * 2);
constexpr size_t OFF_DTV = OFF_ROPE + al(2 * 2 * 128 * 16 * 4);
constexpr size_t DT_BYTES = (size_t)2 * 2 * NCH * 24 * 256 * 4;
constexpr size_t OFF_ACUM = OFF_DTV + al(DT_BYTES);
constexpr size_t OFF_WIN = OFF_ACUM + al(DT_BYTES);
constexpr size_t OFF_WOUT = OFF_WIN + al((size_t)5248 * 1024 * 2);
constexpr size_t OFF_WFF1 = OFF_WOUT + al((size_t)1024 * 2048 * 2);
constexpr size_t OFF_WFF2 = OFF_WFF1 + al((size_t)4096 * 1024 * 2);
constexpr size_t OFF_MIX = OFF_WFF2 + al((size_t)4096 * 1024 * 2);
constexpr size_t OFF_BIG = OFF_MIX + al((size_t)R * 2048 * 2);
constexpr size_t OFF_Z = OFF_BIG;
constexpr size_t OFF_ZRT = OFF_Z + (size_t)R * 1536 * 2;
constexpr size_t OFF_ZIT = OFF_ZRT + (size_t)512 * R * 2;
constexpr size_t OFF_XBC = OFF_ZIT + (size_t)512 * R * 2;
constexpr size_t OFF_DTRAW = OFF_XBC + (size_t)R * 2560 * 2;
constexpr size_t BIG_END = OFF_DTRAW + (size_t)R * 48 * 4;
constexpr size_t OFF_HS = OFF_XBC;
constexpr size_t HS_BYTES = (size_t)2 * 2 * NCH * 24 * 8192 * 2;
constexpr size_t OFF_YR = OFF_HS + HS_BYTES;
constexpr size_t OFF_YI = OFF_YR + (size_t)2 * 512 * 128 * 64 * 2;
static_assert(OFF_YI + (size_t)2 * 512 * 128 * 64 * 2 <= OFF_DTRAW, "fft scratch overflows");
constexpr size_t OFF_ACT = OFF_BIG;
static_assert((size_t)R * 4096 * 2 <= BIG_END - OFF_BIG, "act overflows");
constexpr size_t OFF_P = OFF_BIG;
constexpr size_t OFF_VT = OFF_P + (size_t)R * 2304 * 2;
constexpr size_t OFF_QK = OFF_VT + (size_t)640 * R * 2;
static_assert(OFF_QK + (size_t)R * 1664 * 2 <= BIG_END, "odd overflows");
constexpr size_t OFF_XT = al(BIG_END);
constexpr size_t OFF_BN = OFF_XT + (size_t)1536 * R * 2;
constexpr size_t OFF_BT = OFF_BN + (size_t)R * 512 * 2;
constexpr size_t OFF_CN = OFF_BT + (size_t)512 * R * 2;
constexpr size_t OFF_BAR = al(OFF_CN + (size_t)R * 512 * 2);
constexpr size_t WS_TOTAL = OFF_BAR + 16384;
static_assert(WS_TOTAL <= 402653184ull, "workspace too large");

struct Params {
  const float *x, *c, *ctx, *c_ctx, *w_mod, *b_mod, *norm_mix_g, *norm_ff_g, *w_ff1, *w_ff2;
  const float *w_in_even, *conv_w, *conv_b, *dt_bias, *a_log, *d_skip, *ssd_norm_g, *w_out_even;
  const float *w_in_odd, *q_norm_win, *k_norm_win, *sink_win, *q_norm_na, *k_norm_na, *rpb_na, *w_out_odd;
  float* out;
  unsigned char* ws;
};

struct DP : Params { int tidl, bidl; };

__shared__ __attribute__((aligned(16))) unsigned char smem[73728];

typedef __attribute__((ext_vector_type(2))) __bf16 bf2_t;
typedef __attribute__((ext_vector_type(2))) float f2_t;
typedef __attribute__((ext_vector_type(4))) unsigned u32x4_t;
typedef __attribute__((ext_vector_type(2))) unsigned u32x2_t;
DI unsigned pk2(float a, float b) { f2_t v = {a, b}; return __builtin_bit_cast(unsigned, __builtin_convertvector(v, bf2_t)); }
DI bfr f2bf(float x) { return (bfr)(pk2(x, 0.f) & 0xffffu); }
DI float bf2f(bfr b) { return __uint_as_float(((unsigned)b) << 16); }
DI float bfs(short s) { return __uint_as_float(((unsigned)(unsigned short)s) << 16); }
DI int crow(int i, int h) { return (i & 3) + 8 * (i >> 2) + 4 * h; }
DI f32x16 zero16() { f32x16 z; for (int i = 0; i < 16; ++i) z[i] = 0.f; return z; }
DI bf16x8 pack8(float a0, float a1, float a2, float a3, float a4, float a5, float a6, float a7) {
  u32x4_t v = {pk2(a0, a1), pk2(a2, a3), pk2(a4, a5), pk2(a6, a7)};
  return __builtin_bit_cast(bf16x8, v);
}
DI bf16x4 pack4(float a0, float a1, float a2, float a3) {
  u32x2_t v = {pk2(a0, a1), pk2(a2, a3)};
  return __builtin_bit_cast(bf16x4, v);
}
#define PACK_HALF(s, s2) pack8(s[8 * (s2)], s[8 * (s2) + 1], s[8 * (s2) + 2], s[8 * (s2) + 3], s[8 * (s2) + 4], s[8 * (s2) + 5], s[8 * (s2) + 6], s[8 * (s2) + 7])
DI bf16x8 join44(bf16x4 lo, bf16x4 hi) { return __builtin_shufflevector(lo, hi, 0, 1, 2, 3, 4, 5, 6, 7); }
DI int chunk_row0(int b, int c) { return c == 0 ? RL + b * CTX : b * SEQ + (c - 1) * CL; }

DI void sincos_turn(double f, float& s, float& c) {
  f -= rint(f);
  double x = f * 6.283185307179586476925;
  double x2 = x * x, ss = 1.0, cc = 1.0;
#pragma unroll
  for (int k = 13; k >= 1; --k) {
    ss = 1.0 - x2 / (double)((2 * k) * (2 * k + 1)) * ss;
    cc = 1.0 - x2 / (double)((2 * k - 1) * (2 * k)) * cc;
  }
  s = (float)(x * ss); c = (float)cc;
}

template <class T> DI T* wsp(const DP& p, size_t off) { return (T*)(p.ws + off); }

DI void phase0(const DP& p) {
  const int tid = p.tidl, bid = p.bidl, G = gridDim.x;
  float* lds = (float*)smem;
  float* MOD = wsp<float>(p, OFF_MOD);
  for (int u = bid; u < 384; u += G) {
    int layer = u / 96, cb = u % 96;
    for (int i = tid; i < 3072; i += 256) {
      int v = i >> 10, k = i & 1023;
      float c = v < 2 ? p.c[v * 1024 + k] : p.c_ctx[k];
      lds[i] = c / (1.f + expf(-c));
    }
    __syncthreads();
    const int kq = tid >> 4, c4 = (tid & 15) * 4;
    const float* w = p.w_mod + (size_t)layer * 1024 * 6144 + cb * 64 + c4;
    float a0[4] = {0.f, 0.f, 0.f, 0.f}, a1[4] = {0.f, 0.f, 0.f, 0.f}, a2[4] = {0.f, 0.f, 0.f, 0.f};
#pragma unroll 16
    for (int k = kq * 64; k < kq * 64 + 64; ++k) {
      const float4 wv = *(const float4*)(w + (size_t)k * 6144);
      const float s0 = lds[k], s1 = lds[1024 + k], s2 = lds[2048 + k];
      a0[0] += s0 * wv.x; a0[1] += s0 * wv.y; a0[2] += s0 * wv.z; a0[3] += s0 * wv.w;
      a1[0] += s1 * wv.x; a1[1] += s1 * wv.y; a1[2] += s1 * wv.z; a1[3] += s1 * wv.w;
      a2[0] += s2 * wv.x; a2[1] += s2 * wv.y; a2[2] += s2 * wv.z; a2[3] += s2 * wv.w;
    }
    float* red = lds + 3072;
#pragma unroll
    for (int e = 0; e < 4; ++e) {
      red[(kq * 3 + 0) * 64 + c4 + e] = a0[e]; red[(kq * 3 + 1) * 64 + c4 + e] = a1[e]; red[(kq * 3 + 2) * 64 + c4 + e] = a2[e];
    }
    __syncthreads();
    if (tid < 192) {
      const int v = tid >> 6, cc = tid & 63, col = cb * 64 + cc;
      float sacc = 0.f;
#pragma unroll
      for (int q = 0; q < 16; ++q) sacc += red[(q * 3 + v) * 64 + cc];
      MOD[(layer * 3 + v) * 6144 + col] = sacc + p.b_mod[layer * 6144 + col];
    }
    __syncthreads();
  }
  const int gt = bid * 256 + tid, nt = G * 256;
  {
    const float4* xs = (const float4*)p.x; float4* od = (float4*)p.out;
    for (int i = gt; i < RL * 256; i += 8 * nt) {
      float4 t4[8];
#pragma unroll
      for (int q = 0; q < 8; ++q) { const int ii = i + q * nt; t4[q] = ii < RL * 256 ? xs[ii] : make_float4(0.f, 0.f, 0.f, 0.f); }
#pragma unroll
      for (int q = 0; q < 8; ++q) { const int ii = i + q * nt; if (ii < RL * 256) od[ii] = t4[q]; }
    }
    const float4* cs = (const float4*)p.ctx; float4* hd = wsp<float4>(p, OFF_HC);
    for (int i = gt; i < 512 * 256; i += nt) hd[i] = cs[i];
  }
  float2* TW = wsp<float2>(p, OFF_TW);
  for (int i = gt; i < 8192; i += nt) { float s, c; sincos_turn((double)i / 8192.0, s, c); TW[i] = make_float2(c, s); }
  bfr* C128 = wsp<bfr>(p, OFF_C128); bfr* S128 = wsp<bfr>(p, OFF_S128);
  for (int i = gt; i < 128 * 128; i += nt) { int a = i >> 7, b = i & 127; float s, c; sincos_turn((double)((a * b) & 127) / 128.0, s, c); C128[i] = f2bf(c); S128[i] = f2bf(s); }
  bfr* C64 = wsp<bfr>(p, OFF_C64); bfr* S64 = wsp<bfr>(p, OFF_S64);
  for (int i = gt; i < 64 * 64; i += nt) { int a = i >> 6, b = i & 63; float s, c; sincos_turn((double)((a * b) & 63) / 64.0, s, c); C64[i] = f2bf(c); S64[i] = f2bf(s); }
  bfr* C256 = wsp<bfr>(p, OFF_C256); bfr* S256 = wsp<bfr>(p, OFF_S256);
  for (int i = gt; i < 256 * 256; i += nt) { int a = i >> 8, b = i & 255; float s, c; sincos_turn((double)((a * b) & 255) / 256.0, s, c); C256[i] = f2bf(c); S256[i] = f2bf(s); }
  float* ROPE = wsp<float>(p, OFF_ROPE);
  for (int i = gt; i < 2 * 128 * 16; i += nt) {
    int f = i & 15, idx = (i >> 4) & 127;
    float ang = (float)idx * (float)exp(-(double)f * 0.5756462732485115);
    float s, c; sincos_turn((double)ang / 6.283185307179586476925, s, c);
    ROPE[i] = c; ROPE[4096 + i] = s;
  }
}

DI void tcvt_unit(const float* __restrict__ src, int ld, int c0, int ncols, int K, bfr* __restrict__ dst, int dr0, int u, int tid) {
  const int ntk = K >> 6;
  const int tn = u / ntk, tk = u % ntk, k0 = tk * 64, nb = tn * 64;
  bfr* T = (bfr*)smem;
  float4 v[4];
  const int n4 = (tid & 15) * 4;
#pragma unroll
  for (int i = 0; i < 4; ++i) {
    const int kk = (tid >> 4) + 16 * i;
    v[i] = make_float4(0.f, 0.f, 0.f, 0.f);
    if (nb + n4 < ncols) v[i] = *(const float4*)(src + (size_t)(k0 + kk) * ld + c0 + nb + n4);
  }
#pragma unroll
  for (int i = 0; i < 4; ++i) {
    const int kk = (tid >> 4) + 16 * i;
    T[(n4 + 0) * 72 + kk] = f2bf(v[i].x); T[(n4 + 1) * 72 + kk] = f2bf(v[i].y);
    T[(n4 + 2) * 72 + kk] = f2bf(v[i].z); T[(n4 + 3) * 72 + kk] = f2bf(v[i].w);
  }
  __syncthreads();
  {
    int n = tid >> 2, kseg = (tid & 3) * 16;
    if (nb + n < ncols) {
      bfr* d = dst + (size_t)(dr0 + nb + n) * K + k0 + kseg;
      *(bf16x8*)d = *(const bf16x8*)(T + n * 72 + kseg);
      *(bf16x8*)(d + 8) = *(const bf16x8*)(T + n * 72 + kseg + 8);
    }
  }
  __syncthreads();
}

DI void wconv_phase(const DP& p, int layer) {
  const int tid = p.tidl;
  const int j = layer >> 1;
  bfr* WIN = wsp<bfr>(p, OFF_WIN); bfr* WOUT = wsp<bfr>(p, OFF_WOUT);
  bfr* WFF1 = wsp<bfr>(p, OFF_WFF1); bfr* WFF2 = wsp<bfr>(p, OFF_WFF2);
  const float* ff1 = p.w_ff1 + (size_t)layer * 1024 * 4096;
  const float* ff2 = p.w_ff2 + (size_t)layer * 4096 * 1024;
  float* cst = (float*)(smem + 20480);
  if (tid < 64) { float s, c; sincos_turn((double)tid / 64.0, s, c); cst[tid] = c; cst[64 + tid] = s; }
  __syncthreads();
  if ((layer & 1) == 0) {
    const float* win = p.w_in_even + (size_t)j * 1024 * 4656;
    const float* wout = p.w_out_even + (size_t)j * 2048 * 1024;
    const int n_in = 65 * 16, n_out = 16 * 32, n_f1 = 64 * 16, n_f2 = 16 * 64, n_fold = 512;
    const int total = n_in + n_out + n_f1 + n_f2 + n_fold;
    for (int u = p.bidl; u < total; u += gridDim.x) {
      int v = u;
      if (v < n_in) { tcvt_unit(win, 4656, 512, 4144, 1024, WIN, 1024, v, tid); continue; }
      v -= n_in;
      if (v < n_out) { tcvt_unit(wout, 1024, 0, 1024, 2048, WOUT, 0, v, tid); continue; }
      v -= n_out;
      if (v < n_f1) { tcvt_unit(ff1, 4096, 0, 4096, 1024, WFF1, 0, v, tid); continue; }
      v -= n_f1;
      if (v < n_f2) { tcvt_unit(ff2, 1024, 0, 1024, 4096, WFF2, 0, v, tid); continue; }
      v -= n_f2;
      {
        const int g = v >> 6, kb = (v >> 2) & 15, mq = v & 3;
        float* wt = (float*)smem;
#pragma unroll
        for (int i = 0; i < 4; ++i) {
          const int idx = tid + 256 * i, kk = idx >> 4, j4 = (idx & 15) * 4;
          const float4 wv = *(const float4*)(win + (size_t)(kb * 64 + kk) * 4656 + g * 64 + j4);
          wt[kk * 65 + j4] = wv.x; wt[kk * 65 + j4 + 1] = wv.y; wt[kk * 65 + j4 + 2] = wv.z; wt[kk * 65 + j4 + 3] = wv.w;
        }
        __syncthreads();
        const int kl = tid & 63, mg = tid >> 6;
#pragma unroll 1
        for (int mi = 0; mi < 4; ++mi) {
          const int m = mg * 16 + mq * 4 + mi;
          float sc = 0.f, ss = 0.f;
#pragma unroll 8
          for (int jj = 0; jj < 64; ++jj) { const float w = wt[kl * 65 + jj]; const int idx = (m * jj) & 63; sc += w * cst[idx]; ss += w * cst[64 + idx]; }
          const int ch = g * 64 + m, k = kb * 64 + kl;
          WIN[(size_t)ch * 1024 + k] = f2bf(sc);
          WIN[(size_t)(512 + ch) * 1024 + k] = f2bf(-ss);
        }
        __syncthreads();
      }
    }
  } else {
    const float* win = p.w_in_odd + (size_t)j * 1024 * 2304;
    const float* wout = p.w_out_odd + (size_t)j * 1024 * 1024;
    const int n_in = 36 * 16, n_out = 16 * 16, n_f1 = 64 * 16, n_f2 = 16 * 64;
    const int total = n_in + n_out + n_f1 + n_f2;
    for (int u = p.bidl; u < total; u += gridDim.x) {
      int v = u;
      if (v < n_in) { tcvt_unit(win, 2304, 0, 2304, 1024, WIN, 0, v, tid); continue; }
      v -= n_in;
      if (v < n_out) { tcvt_unit(wout, 1024, 0, 1024, 1024, WOUT, 0, v, tid); continue; }
      v -= n_out;
      if (v < n_f1) { tcvt_unit(ff1, 4096, 0, 4096, 1024, WFF1, 0, v, tid); continue; }
      v -= n_f1;
      tcvt_unit(ff2, 1024, 0, 1024, 4096, WFF2, 0, v, tid);
    }
  }
}

DI void norm_phase(const DP& p, int layer, const float* __restrict__ gvec, int shc, int scc) {
  const int lane = p.tidl & 63;
  const int wg = p.bidl * 4 + (p.tidl >> 6), nw = gridDim.x * 4;
  const float* MOD = wsp<float>(p, OFF_MOD);
  const float* HC = wsp<float>(p, OFF_HC);
  bfr* U = wsp<bfr>(p, OFF_MIX);
#pragma unroll 1
  for (int row0 = wg; row0 < R; row0 += 2 * nw) {
    float4 v[2][4]; float ss[2] = {0.f, 0.f};
#pragma unroll
    for (int q = 0; q < 2; ++q) {
      const int row = row0 + q * nw < R ? row0 + q * nw : row0;
      const float* hp = row < RL ? p.out + (size_t)row * 1024 : HC + (size_t)(row - RL) * 1024;
#pragma unroll
      for (int i = 0; i < 4; ++i) v[q][i] = *(const float4*)(hp + i * 256 + lane * 4);
    }
#pragma unroll
    for (int q = 0; q < 2; ++q) {
#pragma unroll
      for (int i = 0; i < 4; ++i) ss[q] += v[q][i].x * v[q][i].x + v[q][i].y * v[q][i].y + v[q][i].z * v[q][i].z + v[q][i].w * v[q][i].w;
#pragma unroll
      for (int o = 32; o >= 1; o >>= 1) ss[q] += __shfl_xor(ss[q], o);
    }
#pragma unroll
    for (int q = 0; q < 2; ++q) {
      const int row = row0 + q * nw;
      if (row >= R) continue;
      const int ms = row < RL ? (row >> 13) : 2;
      const float* md = MOD + (layer * 3 + ms) * 6144;
      const float rs = rsqrtf(ss[q] * (1.f / 1024.f) + 1e-6f);
#pragma unroll
      for (int i = 0; i < 4; ++i) {
        int col = i * 256 + lane * 4;
        float4 g = *(const float4*)(gvec + col);
        float4 sc = *(const float4*)(md + scc * 1024 + col);
        float4 sh = *(const float4*)(md + shc * 1024 + col);
        bf16x4 o = pack4(v[q][i].x * rs * g.x * (1.f + sc.x) + sh.x, v[q][i].y * rs * g.y * (1.f + sc.y) + sh.y,
                         v[q][i].z * rs * g.z * (1.f + sc.z) + sh.z, v[q][i].w * rs * g.w * (1.f + sc.w) + sh.w);
        *(bf16x4*)(U + (size_t)row * 1024 + col) = o;
      }
    }
  }
}

enum { EPI_EVEN_IN = 0, EPI_ODD_IN = 1, EPI_RELU2 = 2, EPI_RESID = 3 };

DI void gemm_phase(const DP& p, int mode, const bfr* __restrict__ A, int lda, const bfr* __restrict__ Bt,
                   int N, int K, int layer, int gchunk, int nM) {
  const int tid = p.tidl, lane = tid & 63, wid = tid >> 6, r = lane & 31, h = lane >> 5;
  const int wm = wid >> 1, wn = wid & 1;
  const int nN = (N + 127) >> 7;
  const int tiles = nM * nN, G = (int)gridDim.x;
  int full = tiles, tail = 0, St = 1;
  if (mode == EPI_RESID) {
    full = (tiles / G) * G; tail = tiles - full;
    if (tail > 0) { int c = G / tail; int kmax = K >> 7; St = 1; while (St * 2 <= c && St * 2 <= 16 && St * 2 <= kmax) St *= 2; }
  }
  const int chunk = (full + 7) >> 3;
  const int units = chunk * 8 + tail * St;
  bfr* sm = (bfr*)smem;
  const int lrow = tid >> 3, lc = (tid & 7) * 8;
#pragma unroll 1
  for (int u = p.bidl; u < units; u += G) {
    int t, ks, Ks; bool atom;
    if (u < chunk * 8) {
      t = (u & 7) * chunk + (u >> 3);
      if (t >= full) continue;
      ks = 0; Ks = K; atom = false;
    } else { const int v = u - chunk * 8; t = full + v / St; ks = v % St; Ks = K / St; atom = St > 1; }
    const int nk = Ks >> 6;
    const int panel = t / (nM * 8); const int rem = t - panel * nM * 8;
    const int pw = (nN - panel * 8) < 8 ? (nN - panel * 8) : 8;
    const int tm = rem / pw, tn = panel * 8 + rem % pw;
    const int m0 = tm * 128, n0 = tn * 128, kbase = ks * Ks;
    f32x16 acc[2][2];
    acc[0][0] = zero16(); acc[0][1] = zero16(); acc[1][0] = zero16(); acc[1][1] = zero16();
    const bfr* Ag = A + (size_t)(m0 + lrow) * lda + kbase + lc;
    const bfr* Bg = Bt + (size_t)(n0 + lrow) * K + kbase + lc;
    bf16x8 ra[4], rb[4];
#pragma unroll
    for (int i = 0; i < 4; ++i) {
      ra[i] = *(const bf16x8*)(Ag + (size_t)(32 * i) * lda);
      rb[i] = *(const bf16x8*)(Bg + (size_t)(32 * i) * K);
    }
#pragma unroll
    for (int i = 0; i < 4; ++i) {
      *(bf16x8*)(sm + (lrow + 32 * i) * 72 + lc) = ra[i];
      *(bf16x8*)(sm + 9216 + (lrow + 32 * i) * 72 + lc) = rb[i];
    }
    if (nk > 1) {
#pragma unroll
      for (int i = 0; i < 4; ++i) {
        ra[i] = *(const bf16x8*)(Ag + (size_t)(32 * i) * lda + 64);
        rb[i] = *(const bf16x8*)(Bg + (size_t)(32 * i) * K + 64);
      }
    }
    __syncthreads();
#pragma unroll 1
    for (int kt = 0; kt < nk; ++kt) {
      if (kt + 1 < nk) {
        bfr* Ad = sm + ((kt + 1) & 1) * 18432;
#pragma unroll
        for (int i = 0; i < 4; ++i) {
          *(bf16x8*)(Ad + (lrow + 32 * i) * 72 + lc) = ra[i];
          *(bf16x8*)(Ad + 9216 + (lrow + 32 * i) * 72 + lc) = rb[i];
        }
      }
      if (kt + 2 < nk) {
#pragma unroll
        for (int i = 0; i < 4; ++i) {
          ra[i] = *(const bf16x8*)(Ag + (size_t)(32 * i) * lda + (kt + 2) * 64);
          rb[i] = *(const bf16x8*)(Bg + (size_t)(32 * i) * K + (kt + 2) * 64);
        }
      }
      const bfr* As = sm + (kt & 1) * 18432;
      const bfr* Bs = As + 9216;
      __builtin_amdgcn_s_setprio(1);
#pragma unroll
      for (int kk = 0; kk < 4; ++kk) {
        bf16x8 a0 = *(const bf16x8*)(As + (wm * 64 + r) * 72 + kk * 16 + h * 8);
        bf16x8 a1 = *(const bf16x8*)(As + (wm * 64 + 32 + r) * 72 + kk * 16 + h * 8);
        bf16x8 b0 = *(const bf16x8*)(Bs + (wn * 64 + r) * 72 + kk * 16 + h * 8);
        bf16x8 b1 = *(const bf16x8*)(Bs + (wn * 64 + 32 + r) * 72 + kk * 16 + h * 8);
        acc[0][0] = MFMA(a0, b0, acc[0][0]);
        acc[0][1] = MFMA(a0, b1, acc[0][1]);
        acc[1][0] = MFMA(a1, b0, acc[1][0]);
        acc[1][1] = MFMA(a1, b1, acc[1][1]);
      }
      __builtin_amdgcn_s_setprio(0);
      __syncthreads();
    }
    if (mode == EPI_RESID && !atom) {
      float hv[2][2][16], gt2[2][2];
#pragma unroll
      for (int mi = 0; mi < 2; ++mi)
#pragma unroll
        for (int ni = 0; ni < 2; ++ni) {
          const int col = n0 + wn * 64 + ni * 32 + r;
          const int rowb = m0 + wm * 64 + mi * 32 + 4 * h;
          const int ms = rowb < RL ? (rowb >> 13) : 2;
          gt2[mi][ni] = wsp<float>(p, OFF_MOD)[(layer * 3 + ms) * 6144 + gchunk * 1024 + col];
          const float* hp = rowb < RL ? p.out + (size_t)rowb * 1024 + col : wsp<float>(p, OFF_HC) + (size_t)(rowb - RL) * 1024 + col;
#pragma unroll
          for (int i = 0; i < 16; ++i) hv[mi][ni][i] = hp[(size_t)((i & 3) + 8 * (i >> 2)) * 1024];
        }
#pragma unroll
      for (int mi = 0; mi < 2; ++mi)
#pragma unroll
        for (int ni = 0; ni < 2; ++ni) {
          const int col = n0 + wn * 64 + ni * 32 + r;
          const int rowb = m0 + wm * 64 + mi * 32 + 4 * h;
          float* hp = rowb < RL ? p.out + (size_t)rowb * 1024 + col : wsp<float>(p, OFF_HC) + (size_t)(rowb - RL) * 1024 + col;
#pragma unroll
          for (int i = 0; i < 16; ++i) hp[(size_t)((i & 3) + 8 * (i >> 2)) * 1024] = hv[mi][ni][i] + gt2[mi][ni] * acc[mi][ni][i];
        }
      continue;
    }
    const int cbw = n0 + wn * 64;
    const bool qkfuse = mode == EPI_ODD_IN && !((cbw >= 640 && cbw < 768) || cbw >= 1792);
    if (qkfuse) {
      float* T = (float*)smem + wid * 4160;
#pragma unroll
      for (int mi = 0; mi < 2; ++mi)
#pragma unroll
        for (int ni = 0; ni < 2; ++ni)
#pragma unroll
          for (int i = 0; i < 16; ++i) T[(mi * 32 + crow(i, h)) * 65 + ni * 32 + r] = acc[mi][ni][i];
      asm volatile("s_waitcnt lgkmcnt(0)" ::: "memory");
      const int hs = cbw < 640 ? (cbw >> 6) : 10 + ((cbw - 768) >> 6);
      const int jj = layer >> 1;
      const float* gv = hs < 8 ? p.q_norm_win + jj * 64 : hs < 10 ? p.k_norm_win + jj * 64 : hs < 18 ? p.q_norm_na + jj * 64 : p.k_norm_na + jj * 64;
      const float qs = (hs < 8 || (hs >= 10 && hs < 18)) ? 0.125f : 1.f;
      const int row = m0 + wm * 64 + lane;
      float ss = 0.f;
#pragma unroll
      for (int d = 0; d < 64; ++d) { const float t = T[lane * 65 + d]; ss += t * t; }
      const float rs = rsqrtf(ss * (1.f / 64.f) + 1e-6f);
      const bool dorope = hs < 10 && row < RL;
      const float* ROPE = wsp<float>(p, OFF_ROPE);
      const int pos = row & 8191;
      bfr* dst = wsp<bfr>(p, OFF_QK) + (size_t)row * 1664 + hs * 64;
#pragma unroll
      for (int a = 0; a < 2; ++a) {
        float x[32];
#pragma unroll
        for (int d = 0; d < 32; ++d) x[d] = T[lane * 65 + a * 32 + d] * rs * gv[a * 32 + d];
        if (dorope) {
          const int idx = a == 0 ? (pos >> 6) : 128 + (pos & 63);
#pragma unroll
          for (int f4 = 0; f4 < 4; ++f4) {
            const float4 c4 = *(const float4*)(ROPE + idx * 16 + f4 * 4), s4 = *(const float4*)(ROPE + 4096 + idx * 16 + f4 * 4);
            const float cc[4] = {c4.x, c4.y, c4.z, c4.w}, sn[4] = {s4.x, s4.y, s4.z, s4.w};
#pragma unroll
            for (int q = 0; q < 4; ++q) {
              const int f = f4 * 4 + q;
              const float x1 = x[f], x2 = x[16 + f];
              x[f] = x1 * cc[q] - x2 * sn[q];
              x[16 + f] = x2 * cc[q] + x1 * sn[q];
            }
          }
        }
#pragma unroll
        for (int k8 = 0; k8 < 4; ++k8)
          *(bf16x8*)(dst + a * 32 + k8 * 8) = pack8(x[k8 * 8] * qs, x[k8 * 8 + 1] * qs, x[k8 * 8 + 2] * qs, x[k8 * 8 + 3] * qs,
                                                    x[k8 * 8 + 4] * qs, x[k8 * 8 + 5] * qs, x[k8 * 8 + 6] * qs, x[k8 * 8 + 7] * qs);
      }
    }
    if (!qkfuse)
#pragma unroll
    for (int mi = 0; mi < 2; ++mi)
#pragma unroll
      for (int ni = 0; ni < 2; ++ni)
#pragma unroll
        for (int g4 = 0; g4 < 4; ++g4) {
          const int row = m0 + wm * 64 + mi * 32 + 8 * g4 + 4 * h;
          const int col = n0 + wn * 64 + ni * 32 + r;
          const float v0 = acc[mi][ni][4 * g4], v1 = acc[mi][ni][4 * g4 + 1], v2 = acc[mi][ni][4 * g4 + 2], v3 = acc[mi][ni][4 * g4 + 3];
          if (mode == EPI_EVEN_IN) {
            if (col < 1024) {
              bfr* dst = wsp<bfr>(p, col < 512 ? OFF_ZRT : OFF_ZIT) + (size_t)(col & 511) * R + row;
              *(bf16x4*)dst = pack4(v0, v1, v2, v3);
            } else if (col < 2560) {
              bfr* dst = wsp<bfr>(p, OFF_Z) + (size_t)row * 1536 + (col - 1024);
              dst[0] = f2bf(v0); dst[1536] = f2bf(v1); dst[2 * 1536] = f2bf(v2); dst[3 * 1536] = f2bf(v3);
            } else if (col < 5120) {
              bfr* dst = wsp<bfr>(p, OFF_XBC) + (size_t)row * 2560 + (col - 2560);
              dst[0] = f2bf(v0); dst[2560] = f2bf(v1); dst[2 * 2560] = f2bf(v2); dst[3 * 2560] = f2bf(v3);
            } else if (col < 5168) {
              float* dst = wsp<float>(p, OFF_DTRAW) + (size_t)row * 48 + (col - 5120);
              dst[0] = v0; dst[48] = v1; dst[96] = v2; dst[144] = v3;
            }
          } else if (mode == EPI_ODD_IN) {
            if (col >= 640 && col < 768) {
              *(bf16x4*)(wsp<bfr>(p, OFF_VT) + (size_t)(col - 640) * R + row) = pack4(v0, v1, v2, v3);
            } else if (col >= 1792) {
              *(bf16x4*)(wsp<bfr>(p, OFF_VT) + (size_t)(128 + col - 1792) * R + row) = pack4(v0, v1, v2, v3);
            } else {
              bfr* dst = wsp<bfr>(p, OFF_P) + (size_t)row * 2304 + col;
              dst[0] = f2bf(v0); dst[2304] = f2bf(v1); dst[2 * 2304] = f2bf(v2); dst[3 * 2304] = f2bf(v3);
            }
          } else if (mode == EPI_RELU2) {
            bfr* dst = wsp<bfr>(p, OFF_ACT) + (size_t)row * 4096 + col;
            float t0 = fmaxf(v0, 0.f), t1 = fmaxf(v1, 0.f), t2 = fmaxf(v2, 0.f), t3 = fmaxf(v3, 0.f);
            dst[0] = f2bf(t0 * t0); dst[4096] = f2bf(t1 * t1); dst[2 * 4096] = f2bf(t2 * t2); dst[3 * 4096] = f2bf(t3 * t3);
          } else if (mode == EPI_RESID) {
            const int ms = row < RL ? (row >> 13) : 2;
            const float gate = wsp<float>(p, OFF_MOD)[(layer * 3 + ms) * 6144 + gchunk * 1024 + col];
            float* hp = row < RL ? p.out + (size_t)row * 1024 + col : wsp<float>(p, OFF_HC) + (size_t)(row - RL) * 1024 + col;
            if (atom) {
              unsafeAtomicAdd(hp, gate * v0); unsafeAtomicAdd(hp + 1024, gate * v1);
              unsafeAtomicAdd(hp + 2048, gate * v2); unsafeAtomicAdd(hp + 3072, gate * v3);
            } else {
              hp[0] += gate * v0; hp[1024] += gate * v1; hp[2048] += gate * v2; hp[3072] += gate * v3;
            }
          }
        }
    if (mode == EPI_ODD_IN) __syncthreads();
  }
}

DI float softplus_f(float x) { return x > 0.f ? x + log1pf(expf(-x)) : log1pf(expf(x)); }

DI void conv_dt_phase(const DP& p, int j) {
  const int tid = p.tidl, lane = tid & 63, wid = tid >> 6;
  const bfr* XBC = wsp<bfr>(p, OFF_XBC);
  bfr* XT = wsp<bfr>(p, OFF_XT); bfr* BN = wsp<bfr>(p, OFF_BN); bfr* BTt = wsp<bfr>(p, OFF_BT); bfr* CN = wsp<bfr>(p, OFF_CN);
  bfr* TT = (bfr*)smem;
  const float* cw = p.conv_w + (size_t)j * 5 * 2560;
  const float* cb = p.conv_b + (size_t)j * 2560;
  const int n_conv = 264 * 40, n_dt = 792;
  for (int u = p.bidl; u < n_conv + n_dt; u += gridDim.x) {
    if (u < n_conv) {
      const int tb = u / 40, cbk = u % 40, row0 = tb * 64, ch0 = cbk * 64;
      int pos0, len;
      if (row0 < RL) { pos0 = row0 & 8191; len = SEQ; } else { pos0 = (row0 - RL) & 255; len = CTX; }
      const int c8 = tid & 7, ch = ch0 + c8 * 8;
      float w[5][8], bias[8];
#pragma unroll
      for (int k = 0; k < 5; ++k) {
        float4 wa = *(const float4*)(cw + k * 2560 + ch), wb = *(const float4*)(cw + k * 2560 + ch + 4);
        w[k][0] = wa.x; w[k][1] = wa.y; w[k][2] = wa.z; w[k][3] = wa.w; w[k][4] = wb.x; w[k][5] = wb.y; w[k][6] = wb.z; w[k][7] = wb.w;
      }
      {
        float4 wa = *(const float4*)(cb + ch), wb = *(const float4*)(cb + ch + 4);
        bias[0] = wa.x; bias[1] = wa.y; bias[2] = wa.z; bias[3] = wa.w; bias[4] = wb.x; bias[5] = wb.y; bias[6] = wb.z; bias[7] = wb.w;
      }
#pragma unroll
      for (int ps = 0; ps < 2; ++ps) {
        const int tl = (tid >> 3) + 32 * ps, pos = pos0 + tl, row = row0 + tl;
        float a[8];
#pragma unroll
        for (int e = 0; e < 8; ++e) a[e] = bias[e];
        bf16x8 xr[5];
#pragma unroll
        for (int k = 0; k < 5; ++k) {
          const int pp = pos + k - 2;
          const bool ok = pp >= 0 && pp < len;
          const bfr* xp = XBC + (size_t)(ok ? row + k - 2 : row) * 2560 + ch;
          xr[k] = *(const bf16x8*)xp;
          if (!ok) { for (int e = 0; e < 8; ++e) xr[k][e] = 0; }
        }
#pragma unroll
        for (int k = 0; k < 5; ++k)
#pragma unroll
          for (int e = 0; e < 8; ++e) a[e] += w[k][e] * bfs(xr[k][e]);
        bf16x8 o;
#pragma unroll
        for (int e = 0; e < 8; ++e) { float s = a[e] / (1.f + __expf(-a[e])); o[e] = (short)f2bf(s); }
        if (ch0 >= 2048) *(bf16x8*)(CN + (size_t)row * 512 + (ch - 2048)) = o;
        else if (ch0 >= 1536) *(bf16x8*)(BN + (size_t)row * 512 + (ch - 1536)) = o;
        if (ch0 < 2048) {
#pragma unroll
          for (int e = 0; e < 8; ++e) TT[(c8 * 8 + e) * 72 + tl] = (bfr)o[e];
        }
      }
      if (ch0 < 2048) {
        __syncthreads();
        const int chl = tid >> 2, tseg = (tid & 3) * 16;
        bfr* dst = (ch0 < 1536 ? XT + (size_t)(ch0 + chl) * R : BTt + (size_t)(ch0 - 1536 + chl) * R) + row0 + tseg;
        *(bf16x8*)dst = *(const bf16x8*)(TT + chl * 72 + tseg);
        *(bf16x8*)(dst + 8) = *(const bf16x8*)(TT + chl * 72 + tseg + 8);
        __syncthreads();
      }
    } else {
      const int item = (u - n_conv) * 4 + wid;
      const int head = item % 24; int rest = item / 24; const int dir = rest & 1; rest >>= 1; const int c = rest % NCH, b = rest / NCH;
      const int row0 = chunk_row0(b, c), col = dir * 24 + head;
      const float bias = p.dt_bias[j * 48 + col];
      const float a = -expf(p.a_log[j * 48 + col]);
      const float* DTRAW = wsp<float>(p, OFF_DTRAW);
      float dt[4], cs[4];
      float run = 0.f;
#pragma unroll
      for (int q = 0; q < 4; ++q) {
        dt[q] = softplus_f(DTRAW[(size_t)(row0 + lane * 4 + q) * 48 + col] + bias);
        run += dt[q] * a; cs[q] = run;
      }
      float x = run;
#pragma unroll
      for (int o = 1; o < 64; o <<= 1) { float t2 = __shfl_up(x, o); if (lane >= o) x += t2; }
      const float excl = x - run;
      const float total = __shfl(x, 63);
      float ac[4];
#pragma unroll
      for (int q = 0; q < 4; ++q) {
        float inc = excl + cs[q];
        ac[q] = dir == 0 ? inc : total - inc + dt[q] * a;
      }
      const size_t base = ((size_t)(((dir * 2 + b) * NCH + c) * 24 + head)) * 256 + lane * 4;
      *(float4*)(wsp<float>(p, OFF_DTV) + base) = make_float4(dt[0], dt[1], dt[2], dt[3]);
      *(float4*)(wsp<float>(p, OFF_ACUM) + base) = make_float4(ac[0], ac[1], ac[2], ac[3]);
    }
  }
}

DI bf16x8 scale8(bf16x8 a, const float* w) {
  return pack8(bfs(a[0]) * w[0], bfs(a[1]) * w[1], bfs(a[2]) * w[2], bfs(a[3]) * w[3],
               bfs(a[4]) * w[4], bfs(a[5]) * w[5], bfs(a[6]) * w[6], bfs(a[7]) * w[7]);
}

DI void s1_item(const DP& p, int item, int lane) {
  const int r = lane & 31, h = lane >> 5;
  const int head = item % 24; int rest = item / 24; const int dir = rest & 1; rest >>= 1; const int c = rest % NCH, b = rest / NCH;
  const int g = head / 6;
  const int row0 = chunk_row0(b, c);
  const size_t dbase = ((size_t)(((dir * 2 + b) * NCH + c) * 24 + head)) * 256;
  const float* dtv = wsp<float>(p, OFF_DTV) + dbase;
  const float* acm = wsp<float>(p, OFF_ACUM) + dbase;
  const float acend = dir == 0 ? acm[255] : acm[0];
  const bfr* XT = wsp<bfr>(p, OFF_XT); const bfr* BTt = wsp<bfr>(p, OFF_BT);
  bfr* HS = wsp<bfr>(p, OFF_HS) + ((size_t)(((dir * 2 + b) * NCH + c) * 24 + head)) * 8192;
#pragma unroll 1
  for (int pt = 0; pt < 2; ++pt) {
    f32x16 acc[4];
#pragma unroll
    for (int n = 0; n < 4; ++n) acc[n] = zero16();
#pragma unroll 4
    for (int kk = 0; kk < 16; ++kk) {
      const int s0 = kk * 16 + 8 * h;
      float4 d0 = *(const float4*)(dtv + s0), d1 = *(const float4*)(dtv + s0 + 4);
      float4 a0 = *(const float4*)(acm + s0), a1 = *(const float4*)(acm + s0 + 4);
      float w[8];
      w[0] = d0.x * __expf(acend - a0.x); w[1] = d0.y * __expf(acend - a0.y); w[2] = d0.z * __expf(acend - a0.z); w[3] = d0.w * __expf(acend - a0.w);
      w[4] = d1.x * __expf(acend - a1.x); w[5] = d1.y * __expf(acend - a1.y); w[6] = d1.z * __expf(acend - a1.z); w[7] = d1.w * __expf(acend - a1.w);
      bf16x8 af = scale8(*(const bf16x8*)(XT + (size_t)(head * 64 + pt * 32 + r) * R + row0 + s0), w);
#pragma unroll
      for (int nt = 0; nt < 4; ++nt) {
        bf16x8 bfv = *(const bf16x8*)(BTt + (size_t)(g * 128 + nt * 32 + r) * R + row0 + s0);
        acc[nt] = MFMA(af, bfv, acc[nt]);
      }
    }
#pragma unroll
    for (int nt = 0; nt < 4; ++nt)
#pragma unroll
      for (int i = 0; i < 16; ++i) HS[(pt * 32 + crow(i, h)) * 128 + nt * 32 + r] = f2bf(acc[nt][i]);
  }
}

DI void s1_block(const DP& p, int item) {
  const int tid = p.tidl, lane = tid & 63, wid = tid >> 6, r = lane & 31, h = lane >> 5;
  const int g = item & 3; const int bc = item >> 2; const int c = bc % NCH, b = bc / NCH;
  const int row0 = chunk_row0(b, c);
  const bfr* XT = wsp<bfr>(p, OFF_XT); const bfr* BTt = wsp<bfr>(p, OFF_BT);
  bfr* BS = (bfr*)smem;
  __syncthreads();
#pragma unroll 4
  for (int i = 0; i < 32; ++i) {
    const int row = wid * 32 + i;
    if (lane < 32)
      __builtin_amdgcn_global_load_lds((const unsigned*)(BTt + (size_t)(g * 128 + row) * R + row0 + lane * 8),
                                       (unsigned*)(BS + row * 264 + lane * 8), 16, 0, 0);
  }
  asm volatile("s_waitcnt vmcnt(0)" ::: "memory");
  __syncthreads();
#pragma unroll 1
  for (int j3 = 0; j3 < 3; ++j3) {
    const int pi = wid * 3 + j3, dir = pi / 6, head = g * 6 + pi % 6;
    const size_t ci = (size_t)(((dir * 2 + b) * NCH + c) * 24 + head);
    const float* dtv = wsp<float>(p, OFF_DTV) + ci * 256;
    const float* acm = wsp<float>(p, OFF_ACUM) + ci * 256;
    const float acend = dir == 0 ? acm[255] : acm[0];
    bfr* HS = wsp<bfr>(p, OFF_HS) + ci * 8192;
    float* WS = (float*)(smem + 67584) + wid * 256;
    {
      const float4 d4 = *(const float4*)(dtv + lane * 4), a4 = *(const float4*)(acm + lane * 4);
      asm volatile("" ::: "memory");
      *(float4*)(WS + lane * 4) = make_float4(d4.x * __expf(acend - a4.x), d4.y * __expf(acend - a4.y),
                                              d4.z * __expf(acend - a4.z), d4.w * __expf(acend - a4.w));
      asm volatile("s_waitcnt lgkmcnt(0)" ::: "memory");
    }
#pragma unroll 1
    for (int pt = 0; pt < 2; ++pt) {
      f32x16 acc[4];
#pragma unroll
      for (int n = 0; n < 4; ++n) acc[n] = zero16();
#pragma unroll 4
      for (int kk = 0; kk < 16; ++kk) {
        const int s0 = kk * 16 + 8 * h;
        const float4 w0 = *(const float4*)(WS + s0), w1 = *(const float4*)(WS + s0 + 4);
        const float w[8] = {w0.x, w0.y, w0.z, w0.w, w1.x, w1.y, w1.z, w1.w};
        bf16x8 af = scale8(*(const bf16x8*)(XT + (size_t)(head * 64 + pt * 32 + r) * R + row0 + s0), w);
#pragma unroll
        for (int nt = 0; nt < 4; ++nt) {
          bf16x8 bfv = *(const bf16x8*)(BS + (nt * 32 + r) * 264 + s0);
          acc[nt] = MFMA(af, bfv, acc[nt]);
        }
      }
#pragma unroll
      for (int nt = 0; nt < 4; ++nt)
#pragma unroll
        for (int i = 0; i < 16; ++i) HS[(pt * 32 + crow(i, h)) * 128 + nt * 32 + r] = f2bf(acc[nt][i]);
    }
  }
}

DI void f1_item(const DP& p, int item, int lane) {
  const int r = lane & 31, h = lane >> 5;
  const int l2t = item & 1, m = (item >> 1) & 511, b = item >> 10;
  const bfr* ZRT = wsp<bfr>(p, OFF_ZRT) + (size_t)m * R + b * SEQ + l2t * 32 + r;
  const bfr* ZIT = wsp<bfr>(p, OFF_ZIT) + (size_t)m * R + b * SEQ + l2t * 32 + r;
  const bfr* C128 = wsp<bfr>(p, OFF_C128); const bfr* S128 = wsp<bfr>(p, OFF_S128);
  const float2* TW = wsp<float2>(p, OFF_TW);
  bfr* YR = wsp<bfr>(p, OFF_YR); bfr* YI = wsp<bfr>(p, OFF_YI);
  const int l2 = l2t * 32 + r;
#pragma unroll 1
  for (int mh = 0; mh < 2; ++mh) {
    f32x16 yr[2], yi[2];
#pragma unroll
    for (int i = 0; i < 2; ++i) { yr[i] = zero16(); yi[i] = zero16(); }
#pragma unroll 2
    for (int kk = 0; kk < 8; ++kk) {
      bf16x8 zr, zi, nzr;
#pragma unroll
      for (int jj = 0; jj < 8; ++jj) {
        int l1 = kk * 16 + 8 * h + jj;
        zr[jj] = (short)ZRT[l1 * 64]; zi[jj] = (short)ZIT[l1 * 64];
        nzr[jj] = (short)(zr[jj] ^ (short)0x8000);
      }
#pragma unroll
      for (int m2 = 0; m2 < 2; ++m2) {
        const int mt = mh * 2 + m2;
        bf16x8 ca = *(const bf16x8*)(C128 + (mt * 32 + r) * 128 + kk * 16 + 8 * h);
        bf16x8 sa = *(const bf16x8*)(S128 + (mt * 32 + r) * 128 + kk * 16 + 8 * h);
        yr[m2] = MFMA(ca, zr, yr[m2]); yr[m2] = MFMA(sa, zi, yr[m2]);
        yi[m2] = MFMA(ca, zi, yi[m2]); yi[m2] = MFMA(sa, nzr, yi[m2]);
      }
    }
#pragma unroll
    for (int m2 = 0; m2 < 2; ++m2)
#pragma unroll
      for (int i = 0; i < 16; ++i) {
        int k1 = (mh * 2 + m2) * 32 + crow(i, h);
        float2 t = TW[k1 * l2];
        float a = yr[m2][i], bb = yi[m2][i];
        size_t o = ((size_t)(b * 512 + m) * 128 + k1) * 64 + l2;
        YR[o] = f2bf(a * t.x + bb * t.y);
        YI[o] = f2bf(bb * t.x - a * t.y);
      }
  }
}

DI void f1c_item(const DP& p, int item, int lane) {
  const int r = lane & 31, h = lane >> 5;
  const int mt = item & 15, kt = (item >> 4) & 7, b = item >> 7;
  const int m = mt * 32 + r;
  const bfr* ZRT = wsp<bfr>(p, OFF_ZRT) + (size_t)m * R + RL + b * CTX;
  const bfr* ZIT = wsp<bfr>(p, OFF_ZIT) + (size_t)m * R + RL + b * CTX;
  const bfr* C256 = wsp<bfr>(p, OFF_C256) + (kt * 32 + r) * 256;
  const bfr* S256 = wsp<bfr>(p, OFF_S256) + (kt * 32 + r) * 256;
  f32x16 acc = zero16();
#pragma unroll 4
  for (int kk = 0; kk < 16; ++kk) {
    int o = kk * 16 + 8 * h;
    acc = MFMA(*(const bf16x8*)(C256 + o), *(const bf16x8*)(ZRT + o), acc);
    acc = MFMA(*(const bf16x8*)(S256 + o), *(const bf16x8*)(ZIT + o), acc);
  }
  bfr* MIX = wsp<bfr>(p, OFF_MIX);
#pragma unroll
  for (int i = 0; i < 16; ++i)
    MIX[(size_t)(RL + b * CTX + kt * 32 + crow(i, h)) * 2048 + m] = f2bf(acc[i] * (1.f / 128.f));
}

DI void s1f1_phase(const DP& p) {
  const int nS1 = 2 * NCH * 4;
  const int G = (int)gridDim.x;
  if (G > nS1 + 64) {
    if (p.bidl < nS1) { s1_block(p, p.bidl); return; }
    const int lane = p.tidl & 63;
    const int wg = (p.bidl - nS1) * 4 + (p.tidl >> 6), nw = (G - nS1) * 4;
#pragma unroll 1
    for (int it = wg; it < 2048 + 256; it += nw) {
      if (it < 2048) f1_item(p, it, lane); else f1c_item(p, it - 2048, lane);
    }
  } else {
#pragma unroll 1
    for (int it = p.bidl; it < nS1; it += G) s1_block(p, it);
    const int lane = p.tidl & 63;
    const int wg = p.bidl * 4 + (p.tidl >> 6), nw = G * 4;
#pragma unroll 1
    for (int it = wg; it < 2048 + 256; it += nw) {
      if (it < 2048) f1_item(p, it, lane); else f1c_item(p, it - 2048, lane);
    }
  }
}

DI void f2_item(const DP& p, int item, int lane) {
  const int r = lane & 31, h = lane >> 5;
  const int mt16 = item & 15, k1 = (item >> 4) & 127, b = item >> 11;
  const int m = mt16 * 32 + r;
  const bfr* YR = wsp<bfr>(p, OFF_YR) + ((size_t)(b * 512 + m) * 128 + k1) * 64;
  const bfr* YI = wsp<bfr>(p, OFF_YI) + ((size_t)(b * 512 + m) * 128 + k1) * 64;
  const bfr* C64 = wsp<bfr>(p, OFF_C64); const bfr* S64 = wsp<bfr>(p, OFF_S64);
  f32x16 acc[2]; acc[0] = zero16(); acc[1] = zero16();
#pragma unroll
  for (int kk = 0; kk < 4; ++kk) {
    bf16x8 yr = *(const bf16x8*)(YR + kk * 16 + 8 * h), yi = *(const bf16x8*)(YI + kk * 16 + 8 * h);
#pragma unroll
    for (int t = 0; t < 2; ++t) {
      bf16x8 ca = *(const bf16x8*)(C64 + (t * 32 + r) * 64 + kk * 16 + 8 * h);
      bf16x8 sa = *(const bf16x8*)(S64 + (t * 32 + r) * 64 + kk * 16 + 8 * h);
      acc[t] = MFMA(ca, yr, acc[t]); acc[t] = MFMA(sa, yi, acc[t]);
    }
  }
  bfr* MIX = wsp<bfr>(p, OFF_MIX);
  const float scale = 0.001381067932f;
#pragma unroll
  for (int t = 0; t < 2; ++t)
#pragma unroll
    for (int i = 0; i < 16; ++i) {
      int k2 = t * 32 + crow(i, h);
      MIX[(size_t)(b * SEQ + k1 + 128 * k2) * 2048 + m] = f2bf(acc[t][i] * scale);
    }
}

DI void s3_block(const DP& p, int j, int b, int c, int g, int half);

DI void s2f2_phase(const DP& p, int j) {
  if (p.bidl < 16) {
    const int k = p.bidl;
    s3_block(p, j, k >> 3, 0, (k >> 1) & 3, k & 1);
    return;
  }
  const int gt = (p.bidl - 16) * 256 + p.tidl, nt = ((int)gridDim.x - 16) * 256;
  bfr* HSb = wsp<bfr>(p, OFF_HS);
  const float* ACUM = wsp<float>(p, OFF_ACUM);
#pragma unroll 1
  for (int it = gt; it < 2 * 2 * 24 * 2048; it += nt) {
    const int e4 = it & 2047; const int rest = it >> 11; const int head = rest % 24, db = rest / 24, dir = db >> 1;
    bf16x4 sv[NCH]; float cd[NCH];
#pragma unroll
    for (int step = 0; step < NCH; ++step) {
      const int c = dir == 0 ? step : (step == 0 ? 0 : NCH - step);
      const size_t ci = (size_t)((db * NCH + c) * 24 + head);
      sv[step] = *(const bf16x4*)(HSb + ci * 8192 + e4 * 4);
      cd[step] = ACUM[ci * 256 + (dir == 0 ? 255 : 0)];
    }
    float h0 = 0.f, h1 = 0.f, h2 = 0.f, h3 = 0.f;
#pragma unroll
    for (int step = 0; step < NCH; ++step) {
      const int c = dir == 0 ? step : (step == 0 ? 0 : NCH - step);
      const size_t ci = (size_t)((db * NCH + c) * 24 + head);
      *(bf16x4*)(HSb + ci * 8192 + e4 * 4) = pack4(h0, h1, h2, h3);
      const float e = __expf(cd[step]);
      h0 = h0 * e + bfs(sv[step][0]); h1 = h1 * e + bfs(sv[step][1]); h2 = h2 * e + bfs(sv[step][2]); h3 = h3 * e + bfs(sv[step][3]);
    }
  }
  const int lane = p.tidl & 63;
  const int wg = (p.bidl - 16) * 4 + (p.tidl >> 6), nw = ((int)gridDim.x - 16) * 4;
#pragma unroll 1
  for (int it = wg; it < 4096; it += nw) f2_item(p, it, lane);
}

DI void s3_block(const DP& p, int j, int b, int c, int g, int half) {
  const int tid = p.tidl, lane = tid & 63, wid = tid >> 6, r = lane & 31, h = lane >> 5;
  const bfr* CN = wsp<bfr>(p, OFF_CN); const bfr* BN = wsp<bfr>(p, OFF_BN); const bfr* XT = wsp<bfr>(p, OFF_XT);
  const bfr* Z = wsp<bfr>(p, OFF_Z); bfr* MIX = wsp<bfr>(p, OFF_MIX);
  bfr* XTs = (bfr*)smem;
  bfr* HSF = (bfr*)(smem + 33792);
  bfr* HSB = (bfr*)(smem + 51200);
  float* LWF = (float*)(smem + 68608);
  float* LWB = LWF + 256;
  {
    const int row0 = chunk_row0(b, c);
    const int lt = half * 4 + wid;
    const int rowl = row0 + lt * 32 + r;
    const bfr* cfp = CN + (size_t)rowl * 512 + g * 128 + 8 * h;
    bf16x8 gtp[8][2];
    {
      bf16x8 cf[8];
#pragma unroll
      for (int kk = 0; kk < 8; ++kk) cf[kk] = *(const bf16x8*)(cfp + kk * 16);
#pragma unroll
      for (int k = 0; k < 8; ++k) { gtp[k][0] = cf[0]; gtp[k][1] = cf[0]; }
      __syncthreads();
      {
        bfr* BS = (bfr*)smem;
#pragma unroll 4
        for (int i = 0; i < 64; ++i) {
          const int row = wid * 64 + i;
          if (lane < 16)
            __builtin_amdgcn_global_load_lds((const unsigned*)(BN + (size_t)(row0 + row) * 512 + g * 128 + lane * 8),
                                             (unsigned*)(BS + row * 136 + lane * 8), 16, 0, 0);
        }
      }
      asm volatile("s_waitcnt vmcnt(0)" ::: "memory");
      __syncthreads();
#pragma unroll 1
      for (int st = 0; st < 8; ++st) {
        f32x16 gt = zero16();
#pragma unroll
        for (int kk = 0; kk < 8; ++kk)
          gt = MFMA(*(const bf16x8*)((const bfr*)smem + (st * 32 + r) * 136 + kk * 16 + 8 * h), cf[kk], gt);
#pragma unroll
        for (int k = 0; k < 7; ++k) { gtp[k][0] = gtp[k + 1][0]; gtp[k][1] = gtp[k + 1][1]; }
        gtp[7][0] = PACK_HALF(gt, 0); gtp[7][1] = PACK_HALF(gt, 1);
      }
    }
    float sumsq = 0.f;
#pragma unroll 1
    for (int hh = 0; hh < 6; ++hh) {
      const int head = g * 6 + hh;
      const size_t cif = (size_t)(((0 * 2 + b) * NCH + c) * 24 + head), cib = (size_t)(((1 * 2 + b) * NCH + c) * 24 + head);
      const float* acf = wsp<float>(p, OFF_ACUM) + cif * 256; const float* acb = wsp<float>(p, OFF_ACUM) + cib * 256;
      const float* dtf = wsp<float>(p, OFF_DTV) + cif * 256; const float* dtb = wsp<float>(p, OFF_DTV) + cib * 256;
      const bfr* HSf = wsp<bfr>(p, OFF_HS) + cif * 8192; const bfr* HSbk = wsp<bfr>(p, OFF_HS) + cib * 8192;
      __syncthreads();
#pragma unroll 4
      for (int i = 0; i < 16; ++i) {
        const int row = wid * 16 + i;
        if (lane < 32)
          __builtin_amdgcn_global_load_lds((const unsigned*)(XT + (size_t)(head * 64 + row) * R + row0 + lane * 8),
                                           (unsigned*)(XTs + row * 264 + lane * 8), 16, 0, 0);
      }
      if (c != 0) {
#pragma unroll 4
        for (int i = 0; i < 16; ++i) {
          const int row = wid * 16 + i;
          if (lane < 16) {
            __builtin_amdgcn_global_load_lds((const unsigned*)(HSf + row * 128 + lane * 8), (unsigned*)(HSF + row * 136 + lane * 8), 16, 0, 0);
            __builtin_amdgcn_global_load_lds((const unsigned*)(HSbk + row * 128 + lane * 8), (unsigned*)(HSB + row * 136 + lane * 8), 16, 0, 0);
          }
        }
      }
      bf16x8 cfh[8];
#pragma unroll
      for (int kk = 0; kk < 8; ++kk) cfh[kk] = *(const bf16x8*)(cfp + kk * 16);
      LWF[tid] = (__logf(dtf[tid]) - acf[tid]) * 1.44269504f;
      LWB[tid] = (__logf(dtb[tid]) - acb[tid]) * 1.44269504f;
      const float al_f = acf[lt * 32 + r], al_b = acb[lt * 32 + r];
      asm volatile("s_waitcnt vmcnt(0)" ::: "memory");
      __syncthreads();
      f32x16 acc[2];
      acc[0] = zero16(); acc[1] = zero16();
      if (c != 0) {
        f32x16 t0 = zero16(), t1 = zero16();
#pragma unroll
        for (int kk = 0; kk < 8; ++kk) {
          t0 = MFMA(*(const bf16x8*)(HSF + (r) * 136 + kk * 16 + 8 * h), cfh[kk], t0);
          t1 = MFMA(*(const bf16x8*)(HSF + (32 + r) * 136 + kk * 16 + 8 * h), cfh[kk], t1);
        }
        const float ef = __expf(al_f);
#pragma unroll
        for (int i = 0; i < 16; ++i) { acc[0][i] = t0[i] * ef; acc[1][i] = t1[i] * ef; }
        t0 = zero16(); t1 = zero16();
#pragma unroll
        for (int kk = 0; kk < 8; ++kk) {
          t0 = MFMA(*(const bf16x8*)(HSB + (r) * 136 + kk * 16 + 8 * h), cfh[kk], t0);
          t1 = MFMA(*(const bf16x8*)(HSB + (32 + r) * 136 + kk * 16 + 8 * h), cfh[kk], t1);
        }
        const float eb = __expf(al_b);
#pragma unroll
        for (int i = 0; i < 16; ++i) { acc[0][i] += t0[i] * eb; acc[1][i] += t1[i] * eb; }
      }
      bf16x4 zpre[2][4];
#pragma unroll
      for (int pt = 0; pt < 2; ++pt)
#pragma unroll
        for (int g4 = 0; g4 < 4; ++g4) zpre[pt][g4] = *(const bf16x4*)(Z + (size_t)rowl * 1536 + head * 64 + pt * 32 + 8 * g4 + 4 * h);
#pragma unroll 1
      for (int st = 0; st < 8; ++st) {
        const bf16x8 g0 = gtp[0][0], g1 = gtp[0][1];
#pragma unroll
        for (int k = 0; k < 7; ++k) { gtp[k][0] = gtp[k + 1][0]; gtp[k][1] = gtp[k + 1][1]; }
        gtp[7][0] = g0; gtp[7][1] = g1;
#pragma unroll 1
        for (int dir = 0; dir < 2; ++dir) {
          if (dir == 0 ? (st > lt) : (st < lt)) continue;
          const float* lwd = dir == 0 ? LWF : LWB;
          const float al = (dir == 0 ? al_f : al_b) * 1.44269504f;
          f32x16 mm;
          if (st != lt) {
#pragma unroll
            for (int g4 = 0; g4 < 4; ++g4) {
              const float4 l4 = *(const float4*)(lwd + st * 32 + 8 * g4 + 4 * h);
              const float lv[4] = {l4.x, l4.y, l4.z, l4.w};
#pragma unroll
              for (int q = 0; q < 4; ++q) {
                const int i = 4 * g4 + q;
                mm[i] = bfs((i >> 3) ? g1[i & 7] : g0[i & 7]) * __builtin_amdgcn_exp2f(al + lv[q]);
              }
            }
          } else {
#pragma unroll
            for (int g4 = 0; g4 < 4; ++g4) {
              const int sb = st * 32 + 8 * g4 + 4 * h;
              const float4 l4 = *(const float4*)(lwd + sb);
              const float lv[4] = {l4.x, l4.y, l4.z, l4.w};
#pragma unroll
              for (int q = 0; q < 4; ++q) {
                const int i = 4 * g4 + q;
                const int sidx = sb + q, lidx = lt * 32 + r;
                const bool valid = dir == 0 ? (sidx <= lidx) : (sidx >= lidx);
                const float gv = bfs((i >> 3) ? g1[i & 7] : g0[i & 7]);
                const float e = __builtin_amdgcn_exp2f(fminf(al + lv[q], 40.f));
                mm[i] = valid ? gv * e : 0.f;
              }
            }
          }
#pragma unroll
          for (int s2 = 0; s2 < 2; ++s2) {
            bf16x8 pf = PACK_HALF(mm, s2);
#pragma unroll
            for (int pt = 0; pt < 2; ++pt) {
              const bfr* xp = XTs + (pt * 32 + r) * 264 + st * 32 + 16 * s2 + 4 * h;
              bf16x8 xf = join44(*(const bf16x4*)xp, *(const bf16x4*)(xp + 8));
              acc[pt] = MFMA(xf, pf, acc[pt]);
            }
          }
        }
      }
      const float dsk = p.d_skip[j * 24 + head];
#pragma unroll
      for (int pt = 0; pt < 2; ++pt)
#pragma unroll
        for (int g4 = 0; g4 < 4; ++g4) {
          const int pb = pt * 32 + 8 * g4 + 4 * h;
          bf16x4 zv = zpre[pt][g4];
          float y[4];
#pragma unroll
          for (int q = 0; q < 4; ++q) {
            float xv = bf2f(XTs[(pb + q) * 264 + lt * 32 + r]);
            float zz = bfs(zv[q]);
            float v = (acc[pt][4 * g4 + q] + dsk * xv) * (zz / (1.f + __expf(-zz)));
            sumsq += v * v; y[q] = v;
          }
          *(bf16x4*)(MIX + (size_t)rowl * 2048 + 512 + head * 64 + pb) = pack4(y[0], y[1], y[2], y[3]);
        }
    }
    const float tot = sumsq + __shfl_xor(sumsq, 32);
    const float sc = rsqrtf(tot * (1.f / 384.f) + 1e-6f);
    const float* ng = p.ssd_norm_g + (size_t)j * 1536;
    bf16x4 yv[6][2][4];
#pragma unroll
    for (int hh = 0; hh < 6; ++hh)
#pragma unroll
      for (int pt = 0; pt < 2; ++pt)
#pragma unroll
        for (int g4 = 0; g4 < 4; ++g4)
          yv[hh][pt][g4] = *(const bf16x4*)(MIX + (size_t)rowl * 2048 + 512 + (g * 6 + hh) * 64 + pt * 32 + 8 * g4 + 4 * h);
#pragma unroll
    for (int hh = 0; hh < 6; ++hh)
#pragma unroll
      for (int pt = 0; pt < 2; ++pt)
#pragma unroll
        for (int g4 = 0; g4 < 4; ++g4) {
          const int pb = pt * 32 + 8 * g4 + 4 * h, head = g * 6 + hh;
          const float4 gg = *(const float4*)(ng + head * 64 + pb);
          const bf16x4 y4 = yv[hh][pt][g4];
          *(bf16x4*)(MIX + (size_t)rowl * 2048 + 512 + head * 64 + pb) =
              pack4(bfs(y4[0]) * sc * gg.x, bfs(y4[1]) * sc * gg.y, bfs(y4[2]) * sc * gg.z, bfs(y4[3]) * sc * gg.w);
        }
  }
}

DI void s3_phase(const DP& p, int j) {
#pragma unroll 1
  for (int idx = p.bidl; idx < 512; idx += (int)gridDim.x) {
    const int half = idx & 1, g = (idx >> 1) & 3, bcl = idx >> 3;
    s3_block(p, j, bcl >> 5, 1 + (bcl & 31), g, half);
  }
}

DI void qkprep_phase(const DP& p, int j) {
  const int lane = p.tidl & 63;
  const int wg = p.bidl * 4 + (p.tidl >> 6), nw = gridDim.x * 4;
  const bfr* P = wsp<bfr>(p, OFF_P); bfr* QK = wsp<bfr>(p, OFF_QK);
  const float* ROPE = wsp<float>(p, OFF_ROPE);
  const int sub = lane >> 3, d0 = (lane & 7) * 8;
  for (int row = wg; row < R; row += nw) {
    bf16x8 xin[4];
#pragma unroll
    for (int ps = 0; ps < 4; ++ps) {
      const int hs0 = ps * 8 + sub, hsc0 = hs0 < 26 ? hs0 : 25;
      xin[ps] = *(const bf16x8*)(P + (size_t)row * 2304 + (hsc0 < 10 ? hsc0 * 64 : 768 + (hsc0 - 10) * 64) + d0);
    }
#pragma unroll
    for (int ps = 0; ps < 4; ++ps) {
      const int hs = ps * 8 + sub;
      const bool act = hs < 26;
      const int hsc = act ? hs : 25;
      bf16x8 xv = xin[ps];
      float x[8]; float ss = 0.f;
#pragma unroll
      for (int e = 0; e < 8; ++e) { x[e] = bfs(xv[e]); ss += x[e] * x[e]; }
      ss += __shfl_xor(ss, 1); ss += __shfl_xor(ss, 2); ss += __shfl_xor(ss, 4);
      const float rs = rsqrtf(ss * (1.f / 64.f) + 1e-6f);
      const float* gv = hsc < 8 ? p.q_norm_win + j * 64 : hsc < 10 ? p.k_norm_win + j * 64 : hsc < 18 ? p.q_norm_na + j * 64 : p.k_norm_na + j * 64;
#pragma unroll
      for (int e = 0; e < 8; ++e) x[e] = x[e] * rs * gv[d0 + e];
      float pr[8];
#pragma unroll
      for (int e = 0; e < 8; ++e) pr[e] = __shfl_xor(x[e], 2);
      if (hsc < 10 && row < RL) {
        const int pos = row & 8191;
        const int axis = d0 >> 5;
        const int idx = axis == 0 ? (pos >> 6) : (pos & 63);
        const int f0 = d0 & 15;
        const bool second = (d0 & 16) != 0;
        const float* cp = ROPE + (axis * 128 + idx) * 16 + f0;
        const float* sp = cp + 4096;
#pragma unroll
        for (int e = 0; e < 8; ++e) {
          float cs = cp[e], sn = sp[e];
          x[e] = second ? (x[e] * cs + pr[e] * sn) : (x[e] * cs - pr[e] * sn);
        }
      }
      const bool isq = hsc < 8 || (hsc >= 10 && hsc < 18);
      const float qs = isq ? 0.125f : 1.f;
      if (act) *(bf16x8*)(QK + (size_t)row * 1664 + hsc * 64 + d0) = pack8(x[0] * qs, x[1] * qs, x[2] * qs, x[3] * qs, x[4] * qs, x[5] * qs, x[6] * qs, x[7] * qs);
    }
  }
}

struct KVF { bf16x8 k[4]; bf16x8 v[2][2]; };
struct KVS { bf16x8 k[4]; bf16x8 v[4]; };

DI void kv_gload(KVS& g, const bfr* __restrict__ Kt, const bfr* __restrict__ Vt, int lane) {
#pragma unroll
  for (int i = 0; i < 4; ++i) {
    const int idx = lane + 64 * i;
    g.k[i] = *(const bf16x8*)(Kt + (size_t)(idx >> 3) * 1664 + (idx & 7) * 8);
    g.v[i] = *(const bf16x8*)(Vt + (size_t)(idx >> 2) * R + (idx & 3) * 8);
  }
}
DI void kv_sstore(const KVS& g, unsigned char* base, int lane) {
#pragma unroll
  for (int i = 0; i < 4; ++i) {
    const int idx = lane + 64 * i;
    { const int row = idx >> 3, c = idx & 7; *(bf16x8*)(base + row * 128 + ((c ^ (row & 7)) << 4)) = g.k[i]; }
    {
      const int d = idx >> 2, c16 = idx & 3, sw = (d >> 2) & 7;
      bf16x4 lo = __builtin_shufflevector(g.v[i], g.v[i], 0, 1, 2, 3), hi = __builtin_shufflevector(g.v[i], g.v[i], 4, 5, 6, 7);
      *(bf16x4*)(base + 4096 + d * 64 + (((2 * c16) ^ sw) << 3)) = lo;
      *(bf16x4*)(base + 4096 + d * 64 + (((2 * c16 + 1) ^ sw) << 3)) = hi;
    }
  }
}
DI void kv_sload(KVF& f, const unsigned char* base, int r, int h) {
#pragma unroll
  for (int kk = 0; kk < 4; ++kk) f.k[kk] = *(const bf16x8*)(base + r * 128 + (((2 * kk + h) ^ (r & 7)) << 4));
#pragma unroll
  for (int s2 = 0; s2 < 2; ++s2)
#pragma unroll
    for (int dt = 0; dt < 2; ++dt) {
      const int d = dt * 32 + r, sw = (d >> 2) & 7, c8 = 4 * s2 + h;
      const unsigned char* vb = base + 4096 + d * 64;
      f.v[s2][dt] = join44(*(const bf16x4*)(vb + ((c8 ^ sw) << 3)), *(const bf16x4*)(vb + (((c8 + 2) ^ sw) << 3)));
    }
}

DI void attn_compute(f32x16 (&o)[2], float& m, float& l, const unsigned char* qb, const unsigned char* base, int r, int h,
                     int mode, int a0, int a1, const float* __restrict__ rp) {
  f32x16 s = zero16();
#pragma unroll
  for (int kk = 0; kk < 4; ++kk) {
    const int off = r * 128 + (((2 * kk + h) ^ (r & 7)) << 4);
    s = MFMA(*(const bf16x8*)(base + off), *(const bf16x8*)(qb + off), s);
  }
  float tmax = -3.0e38f;
  if (mode == 1) {
#pragma unroll
    for (int i = 0; i < 16; ++i) { int dd = a0 - crow(i, h); dd = dd < 0 ? -dd : dd; s[i] = dd <= 128 ? s[i] : -1.0e30f; }
  } else if (mode == 2) {
#pragma unroll
    for (int i = 0; i < 16; ++i) {
      const int key = crow(i, h);
      const int rel = a0 + key;
      int co = a1 + key; co = co < 0 ? 0 : (co > 30 ? 30 : co);
      s[i] = (rel >= 0 && rel < 16) ? s[i] + rp[co] : -1.0e30f;
    }
  }
#pragma unroll
  for (int i = 0; i < 16; ++i) tmax = fmaxf(tmax, s[i]);
  tmax = fmaxf(tmax, __shfl_xor(tmax, 32));
  const float mn = fmaxf(m, tmax);
  const float alpha = __expf(m - mn);
  float ps = 0.f;
#pragma unroll
  for (int i = 0; i < 16; ++i) { s[i] = __expf(s[i] - mn); ps += s[i]; }
  l = l * alpha + ps; m = mn;
#pragma unroll
  for (int i = 0; i < 16; ++i) { o[0][i] *= alpha; o[1][i] *= alpha; }
#pragma unroll
  for (int s2 = 0; s2 < 2; ++s2) {
    bf16x8 pf = PACK_HALF(s, s2);
#pragma unroll
    for (int dt = 0; dt < 2; ++dt) {
      const int d = dt * 32 + r, sw = (d >> 2) & 7, c8 = 4 * s2 + h;
      const unsigned char* vb = base + 4096 + d * 64;
      bf16x8 vf = join44(*(const bf16x4*)(vb + ((c8 ^ sw) << 3)), *(const bf16x4*)(vb + (((c8 + 2) ^ sw) << 3)));
      o[dt] = MFMA(vf, pf, o[dt]);
    }
  }
}

DI void attn_item(const DP& p, int j, int item, int lane) {
  const int r = lane & 31, h = lane >> 5;
  const bfr* QK = wsp<bfr>(p, OFF_QK); const bfr* VT = wsp<bfr>(p, OFF_VT); bfr* MIX = wsp<bfr>(p, OFF_MIX);
  int kind, b, hd, qt;
  if (item < 4096) { kind = 0; qt = item & 255; hd = (item >> 8) & 7; b = item >> 11; }
  else if (item < 8192) { int v = item - 4096; kind = 1; qt = v & 255; hd = (v >> 8) & 7; b = v >> 11; }
  else if (item < 8320) { int v = item - 8192; kind = 2; qt = v & 7; hd = (v >> 3) & 7; b = v >> 6; }
  else { int v = item - 8320; kind = 3; qt = v & 7; hd = (v >> 3) & 7; b = v >> 6; }
  const bool win = (kind == 0 || kind == 2);
  const bool lat = kind < 2;
  const int q_row0 = lat ? b * SEQ + qt * 32 : RL + b * CTX + qt * 32;
  const int qcol = win ? hd * 64 : (10 + hd) * 64;
  const int kcol = win ? (8 + (hd >> 2)) * 64 : (18 + hd) * 64;
  const bfr* Vb = win ? VT + (size_t)((hd >> 2) * 64) * R : VT + (size_t)(128 + hd * 64) * R;
  const bfr* Kb = QK + kcol;
  f32x16 o[2]; o[0] = zero16(); o[1] = zero16();
  float m = -1.0e30f, l = 0.f;
  if (win) { m = p.sink_win[j * 8 + hd]; l = h == 0 ? 1.f : 0.f; }
  int nloc = 0, lo = 0, gr = 0, kr0 = 0, w = 0, cs = 0;
  const int qpos = qt * 32 + r;
  if (kind == 0) { lo = qt - 4 < 0 ? 0 : qt - 4; const int hi = qt + 4 > 255 ? 255 : qt + 4; nloc = hi - lo + 1; }
  else if (kind == 1) {
    gr = qt >> 1; w = (qt & 1) * 32 + r;
    cs = w - 8; cs = cs < 0 ? 0 : (cs > 48 ? 48 : cs);
    kr0 = gr - 4; kr0 = kr0 < 0 ? 0 : (kr0 > 120 ? 120 : kr0);
    nloc = 16;
  }
  const int ntile = 8 + nloc;
  const float* rpb = p.rpb_na + (size_t)j * 8 * 15 * 31 + hd * 15 * 31;
  auto tile_row = [&](int i) -> int {
    if (i < 8) return RL + b * CTX + i * 32;
    const int li = i - 8;
    if (kind == 0) return b * SEQ + (lo + li) * 32;
    return b * SEQ + (kr0 + (li >> 1)) * 64 + (li & 1) * 32;
  };
  unsigned char* lbase = smem + (p.tidl >> 6) * 12288;
  asm volatile("" ::: "memory");
#pragma unroll
  for (int i = 0; i < 4; ++i) {
    const int idx = lane + 64 * i, row = idx >> 3, c = idx & 7;
    *(bf16x8*)(lbase + 8192 + row * 128 + ((c ^ (row & 7)) << 4)) = *(const bf16x8*)(QK + (size_t)(q_row0 + row) * 1664 + qcol + c * 8);
  }
  KVS g;
  { const int k0 = tile_row(0); kv_gload(g, Kb + (size_t)k0 * 1664, Vb + k0, lane); }
  kv_sstore(g, lbase, lane);
#pragma unroll 1
  for (int i = 0; i < ntile; ++i) {
    { const int in = i + 1 < ntile ? i + 1 : i; const int k0 = tile_row(in); kv_gload(g, Kb + (size_t)k0 * 1664, Vb + k0, lane); }
    int mode = 0, a0 = 0, a1 = 0; const float* rp = rpb;
    if (i >= 8) {
      const int li = i - 8;
      if (kind == 0) { mode = 1; a0 = qpos - (lo + li) * 32; }
      else { mode = 2; const int krow = kr0 + (li >> 1); const int ub = (li & 1) * 32; a0 = ub - cs; a1 = ub - w + 15; rp = rpb + (krow - gr + 7) * 31; }
    }
    asm volatile("" ::: "memory");
    attn_compute(o, m, l, lbase + 8192, lbase, r, h, mode, a0, a1, rp);
    asm volatile("" ::: "memory");
    kv_sstore(g, lbase, lane);
  }
  asm volatile("" ::: "memory");
  const float lt = l + __shfl_xor(l, 32);
  const float inv = 1.f / lt;
  const int ocol = win ? hd * 64 : 512 + hd * 64;
#pragma unroll
  for (int dt = 0; dt < 2; ++dt)
#pragma unroll
    for (int g4 = 0; g4 < 4; ++g4) {
      const int d = dt * 32 + 8 * g4 + 4 * h;
      *(bf16x4*)(MIX + (size_t)(q_row0 + r) * 1024 + ocol + d) =
          pack4(o[dt][4 * g4] * inv, o[dt][4 * g4 + 1] * inv, o[dt][4 * g4 + 2] * inv, o[dt][4 * g4 + 3] * inv);
    }
}

DI void attn_phase(const DP& p, int j) {
  const int lane = p.tidl & 63;
  const int wg = p.bidl * 4 + (p.tidl >> 6), nw = gridDim.x * 4;
#pragma unroll 1
  for (int it = wg; it < 8448; it += nw) attn_item(p, j, it, lane);
}

#define XB_TMO      128
#define XB_XCNT(j)  (256  + 64 * (j))
#define XB_XSUB(j)  (1280 + 64 * (j))
#define XB_XGEN(j)  (2304 + 64 * (j))
#define XB_TOP      3328
#define XB_TOPGEN   3392
#define XCD_BAR_WORDS 3456
#define XB_SPIN_CAP (1u << 18)
#define LAS __attribute__((address_space(3)))

__device__ __forceinline__ unsigned xb_ld(unsigned* p)              { return __hip_atomic_load(p, __ATOMIC_RELAXED, __HIP_MEMORY_SCOPE_AGENT); }
__device__ __forceinline__ unsigned xb_add(unsigned* p, unsigned v) { return __hip_atomic_fetch_add(p, v, __ATOMIC_RELAXED, __HIP_MEMORY_SCOPE_AGENT); }
__device__ __forceinline__ unsigned xb_xcc_id() { return (unsigned)__builtin_amdgcn_s_getreg((3 << 11) | 20) & 0xFu; }
#define XB_SPIN(cond, bar) do { unsigned _sp = 0; while (cond) { __builtin_amdgcn_s_sleep(1); \
    if ((++_sp & 255u) == 0u) { if (xb_ld(&(bar)[XB_TMO])) break; if (_sp > XB_SPIN_CAP) { atomicAdd(&(bar)[XB_TMO], 1u); break; } } } } while (0)

struct XcdBarrier {
    unsigned* bar; unsigned x;
    volatile LAS unsigned* st;
};

__device__ __forceinline__ XcdBarrier xcd_barrier_post(unsigned* bar, volatile LAS unsigned* st) {
    XcdBarrier b; b.bar = bar; b.x = xb_xcc_id(); b.st = st;
    if (threadIdx.x == 0) (void)xb_add(&bar[XB_XCNT(b.x)], 1u);
    return b;
}
__device__ __forceinline__ void xcd_barrier_complete(unsigned* bar, unsigned x, unsigned& nloc, unsigned& nx) {
    const unsigned G = gridDim.x * gridDim.y * gridDim.z;
    unsigned sum, cnt, mine, sp = 0u;
    for (;;) {
        sum = 0u; cnt = 0u; mine = 0u;
#pragma unroll
        for (unsigned j = 0; j < 16; ++j) { const unsigned c = xb_ld(&bar[XB_XCNT(j)]); sum += c; cnt += (c > 0u) ? 1u : 0u; mine = (j == x) ? c : mine; }
        if (sum == G) break;
        __builtin_amdgcn_s_sleep(1);
        if ((++sp & 255u) == 0u) { if (xb_ld(&bar[XB_TMO])) break; if (sp > XB_SPIN_CAP) { atomicAdd(&bar[XB_TMO], 1u); break; } }
    }
    nloc = mine > 0u ? mine : 1u; nx = cnt > 0u ? cnt : 1u;
}

__device__ __forceinline__ void xcd_barrier(const XcdBarrier& b) {
    asm volatile("s_waitcnt vmcnt(0)" ::: "memory");
    __syncthreads();
    if (threadIdx.x == 0) {
        unsigned* bar = b.bar;
        __builtin_amdgcn_s_waitcnt(0);
        unsigned nloc = b.st[0], nx = b.st[1];
        if (nloc == 0u) { xcd_barrier_complete(bar, b.x, nloc, nx); b.st[0] = nloc; b.st[1] = nx; }
        const unsigned old = xb_add(&bar[XB_XSUB(b.x)], 1u);
        const unsigned gen = old / nloc;
        if (old + 1u == (gen + 1u) * nloc) {
            __builtin_amdgcn_fence(__ATOMIC_RELEASE, "agent");
            asm volatile("s_waitcnt vmcnt(0)" ::: "memory");
            const unsigned og = xb_add(&bar[XB_TOP], 1u);
            const unsigned tg = og / nx;
            if (og + 1u == (tg + 1u) * nx) xb_add(&bar[XB_TOPGEN], 1u);
            else XB_SPIN(xb_ld(&bar[XB_TOPGEN]) == tg, bar);
            __builtin_amdgcn_fence(__ATOMIC_ACQUIRE, "agent");
            xb_add(&bar[XB_XGEN(b.x)], 1u);
            asm volatile("s_waitcnt vmcnt(0)" ::: "memory");
        } else {
            XB_SPIN(xb_ld(&bar[XB_XGEN(b.x)]) == gen, bar);
            __builtin_amdgcn_fence(__ATOMIC_ACQUIRE, "agent");
            asm volatile("s_waitcnt vmcnt(0)" ::: "memory");
        }
    }
    __syncthreads();
}


DI void run_phase(const DP& p, int ph, int dry) {
  if (ph == 0) { phase0(p); wconv_phase(p, 0); return; }
  int q = ph - 1, layer, lp;
  if (q < 10) { layer = 0; lp = q; } else if (q < 17) { layer = 1; lp = q - 10; } else if (q < 27) { layer = 2; lp = q - 17; } else { layer = 3; lp = q - 27; }
  const int j = layer >> 1;
  const bool even = (layer & 1) == 0;
  int op, gsel = 0;
  if (even) {
    op = (int)((0x2272654321ull >> (4 * lp)) & 15ull); gsel = (int)((0x3201000000ull >> (4 * lp)) & 15ull);
  } else {
    op = (int)((0x2272921ull >> (4 * lp)) & 15ull); gsel = (int)((0x3201000ull >> (4 * lp)) & 15ull);
  }
  if (op == 1 && layer != 0) wconv_phase(p, layer);
  if (op == 1 || op == 7) {
    const bool first = op == 1;
    norm_phase(p, layer, (first ? p.norm_mix_g : p.norm_ff_g) + layer * 1024, first ? 0 : 3, first ? 1 : 4);
  } else if (op == 2) {
    int mode, lda, N, K, gch; size_t offA, offB;
    if (gsel == 0) { mode = even ? EPI_EVEN_IN : EPI_ODD_IN; offA = OFF_MIX; lda = 1024; offB = OFF_WIN; N = even ? 5168 : 2304; K = 1024; gch = 0; }
    else if (gsel == 1) { mode = EPI_RESID; offA = OFF_MIX; lda = even ? 2048 : 1024; offB = OFF_WOUT; N = 1024; K = even ? 2048 : 1024; gch = 2; }
    else if (gsel == 2) { mode = EPI_RELU2; offA = OFF_MIX; lda = 1024; offB = OFF_WFF1; N = 4096; K = 1024; gch = 0; }
    else { mode = EPI_RESID; offA = OFF_ACT; lda = 4096; offB = OFF_WFF2; N = 1024; K = 4096; gch = 5; }
    if (dry && mode == EPI_RESID) mode = 4;
    gemm_phase(p, mode, wsp<bfr>(p, offA), lda, wsp<bfr>(p, offB), N, K, layer, gch, (layer == 3 && gsel != 0) ? RL / 128 : R / 128);
  } else if (op == 3) conv_dt_phase(p, j);
  else if (op == 4) s1f1_phase(p);
  else if (op == 5) s2f2_phase(p, j);
  else if (op == 6) s3_phase(p, j);
  else if (op == 8) qkprep_phase(p, j);
  else if (op == 9) attn_phase(p, j);
}

DI int probe_reps(int ph) {
#ifdef PROBE_MASK
  if (ph == 0) return (PROBE_MASK & 1) ? 2 : 1;
  int q = ph - 1, layer, lp;
  if (q < 10) { layer = 0; lp = q; } else if (q < 17) { layer = 1; lp = q - 10; } else if (q < 27) { layer = 2; lp = q - 17; } else { layer = 3; lp = q - 27; }
  const bool even = (layer & 1) == 0;
  int op, gsel;
  if (even) { op = (int)((0x2272654321ull >> (4 * lp)) & 15ull); gsel = (int)((0x3201000000ull >> (4 * lp)) & 15ull); }
  else { op = (int)((0x2272921ull >> (4 * lp)) & 15ull); gsel = (int)((0x3201000ull >> (4 * lp)) & 15ull); }
  if (op == 5) return 1;
  if (op == 2 && (gsel == 1 || gsel == 3)) return ((PROBE_MASK >> 10) & 1) ? 2 : 1;
  return ((PROBE_MASK >> op) & 1) ? 2 : 1;
#else
  return 1;
#endif
}

__shared__ uint4 xb_words;

__global__ void __launch_bounds__(256, 2) mega(Params p, int ph0, int ph1) {
  cg::grid_group grid = cg::this_grid();
  if (threadIdx.x == 0) xb_words = make_uint4(0u, 0u, 0u, 0u);
  __syncthreads();
  XcdBarrier xb = xcd_barrier_post((unsigned*)(p.ws + OFF_BAR), (volatile LAS unsigned*)&xb_words);
#pragma unroll 1
  for (int ph = ph0; ph < ph1; ++ph) {
    const int nrep = probe_reps(ph);
#pragma unroll 1
    for (int rep = 0; rep < nrep; ++rep) {
      DP q;
      (Params&)q = p;
      int t = threadIdx.x, bb = blockIdx.x;
      asm volatile("" : "+v"(t));
      asm volatile("" : "+s"(bb));
      int z0;
      asm volatile("s_mov_b32 %0, 0" : "=s"(z0));
      q.ws = p.ws + z0;
      q.out = p.out + z0;
      q.tidl = t; q.bidl = bb;
      run_phase(q, ph, rep + 1 < nrep);
    }
    if (ph + 1 < ph1) {
      if (ph == ph0) grid.sync();
      else xcd_barrier(xb);
    }
  }
}

extern "C" void kernel_launch(void* const* d_in, const int* in_sizes, int n_in, void* d_out, int out_size, void* d_ws,
                              size_t ws_size, hipStream_t stream) {
  static int grid_blocks = 0;
  if (!grid_blocks) {
    int dev = 0, cus = 0, per_cu = 0;
    hipGetDevice(&dev);
    hipDeviceGetAttribute(&cus, hipDeviceAttributeMultiprocessorCount, dev);
    hipOccupancyMaxActiveBlocksPerMultiprocessor(&per_cu, mega, 256, 0);
    if (per_cu > 2) per_cu = 2;
    if (per_cu < 1) per_cu = 1;
    grid_blocks = cus * per_cu;
  }
  Params p{};
  const float** pp = (const float**)&p;
  for (int i = 0; i < 26; ++i) pp[i] = (const float*)d_in[i];
  p.out = (float*)d_out;
  p.ws = (unsigned char*)d_ws;
  if (ws_size < WS_TOTAL) fprintf(stderr, "workspace too small: %zu < %zu\n", ws_size, (size_t)WS_TOTAL);
  hipMemsetAsync((unsigned char*)d_ws + OFF_BAR, 0, XCD_BAR_WORDS * 4, stream);
#if MULTI_LAUNCH
  for (int ph = 0; ph < NPHASE; ++ph) {
    int a = ph, b = ph + 1;
    void* args[] = {&p, &a, &b};
    hipLaunchCooperativeKernel((void*)mega, dim3(grid_blocks), dim3(256), args, 0, stream);
  }
#else
  int a = 0, b = NPHASE;
  void* args[] = {&p, &a, &b};
  hipError_t e = hipLaunchCooperativeKernel((void*)mega, dim3(grid_blocks), dim3(256), args, 0, stream);
  if (e != hipSuccess) fprintf(stderr, "cooperative launch failed: %s (grid %d)\n", hipGetErrorString(e), grid_blocks);
#endif
}
```

```cpp
#include <hip/hip_runtime.h>
#include <hip/hip_cooperative_groups.h>
#include <cstdio>
namespace cg = cooperative_groups;

typedef unsigned short bfr;
typedef __attribute__((ext_vector_type(8))) short bf16x8;
typedef __attribute__((ext_vector_type(4))) short bf16x4;
typedef __attribute__((ext_vector_type(16))) float f32x16;
#define DI __device__ __forceinline__
#define MFMA(a, b, c) __builtin_amdgcn_mfma_f32_32x32x16_bf16((a), (b), (c), 0, 0, 0)

#ifndef MULTI_LAUNCH
#define MULTI_LAUNCH 0
#endif

constexpr int RL = 16384, R = 16896, SEQ = 8192, CTX = 256;
constexpr int NCH = 33, CL = 256;
constexpr int NPHASE = 35;

constexpr size_t al(size_t x) { return (x + 255) & ~size_t(255); }
constexpr size_t OFF_HC = 0;
constexpr size_t OFF_MOD = OFF_HC + al(512 * 1024 * 4);
constexpr size_t OFF_TW = OFF_MOD + al(4 * 3 * 6144 * 4);
constexpr size_t OFF_C128 = OFF_TW + al(8192 * 8);
constexpr size_t OFF_S128 = OFF_C128 + al(128 * 128 * 2);
constexpr size_t OFF_C64 = OFF_S128 + al(128 * 128 * 2);
constexpr size_t OFF_S64 = OFF_C64 + al(64 * 64 * 2);
constexpr size_t OFF_C256 = OFF_S64 + al(64 * 64 * 2);
constexpr size_t OFF_S256 = OFF_C256 + al(256 * 256 * 2);
constexpr size_t OFF_ROPE = OFF_S256 + al(256 * 256 * 2);
constexpr size_t OFF_DTV = OFF_ROPE + al(2 * 2 * 128 * 16 * 4);
constexpr size_t DT_BYTES = (size_t)2 * 2 * NCH * 24 * 256 * 4;
constexpr size_t OFF_ACUM = OFF_DTV + al(DT_BYTES);
constexpr size_t OFF_WIN = OFF_ACUM + al(DT_BYTES);
constexpr size_t OFF_WOUT = OFF_WIN + al((size_t)5248 * 1024 * 2);
constexpr size_t OFF_WFF1 = OFF_WOUT + al((size_t)1024 * 2048 * 2);
constexpr size_t OFF_WFF2 = OFF_WFF1 + al((size_t)4096 * 1024 * 2);
constexpr size_t OFF_MIX = OFF_WFF2 + al((size_t)4096 * 1024 * 2);
constexpr size_t OFF_BIG = OFF_MIX + al((size_t)R * 2048 * 2);
constexpr size_t OFF_Z = OFF_BIG;
constexpr size_t OFF_ZRT = OFF_Z + (size_t)R * 1536 * 2;
constexpr size_t OFF_ZIT = OFF_ZRT + (size_t)512 * R * 2;
constexpr size_t OFF_XBC = OFF_ZIT + (size_t)512 * R * 2;
constexpr size_t OFF_DTRAW = OFF_XBC + (size_t)R * 2560 * 2;
constexpr size_t BIG_END = OFF_DTRAW + (size_t)R * 48 * 4;
constexpr size_t OFF_HS = OFF_XBC;
constexpr size_t HS_BYTES = (size_t)2 * 2 * NCH * 24 * 8192 * 2;
constexpr size_t OFF_YR = OFF_HS + HS_BYTES;
constexpr size_t OFF_YI = OFF_YR + (size_t)2 * 512 * 128 * 64 * 2;
static_assert(OFF_YI + (size_t)2 * 512 * 128 * 64 * 2 <= OFF_DTRAW, "fft scratch overflows");
constexpr size_t OFF_ACT = OFF_BIG;
static_assert((size_t)R * 4096 * 2 <= BIG_END - OFF_BIG, "act overflows");
constexpr size_t OFF_P = OFF_BIG;
constexpr size_t OFF_VT = OFF_P + (size_t)R * 2304 * 2;
constexpr size_t OFF_QK = OFF_VT + (size_t)640 * R * 2;
static_assert(OFF_QK + (size_t)R * 1664 * 2 <= BIG_END, "odd overflows");
constexpr size_t OFF_XT = al(BIG_END);
constexpr size_t OFF_BN = OFF_XT + (size_t)1536 * R * 2;
constexpr size_t OFF_BT = OFF_BN + (size_t)R * 512 * 2;
constexpr size_t OFF_CN = OFF_BT + (size_t)512 * R * 2;
constexpr size_t OFF_BAR = al(OFF_CN + (size_t)R * 512 * 2);
constexpr size_t WS_TOTAL = OFF_BAR + 16384;
static_assert(WS_TOTAL <= 402653184ull, "workspace too large");

struct Params {
  const float *x, *c, *ctx, *c_ctx, *w_mod, *b_mod, *norm_mix_g, *norm_ff_g, *w_ff1, *w_ff2;
  const float *w_in_even, *conv_w, *conv_b, *dt_bias, *a_log, *d_skip, *ssd_norm_g, *w_out_even;
  const float *w_in_odd, *q_norm_win, *k_norm_win, *sink_win, *q_norm_na, *k_norm_na, *rpb_na, *w_out_odd;
  float* out;
  unsigned char* ws;
};

struct DP : Params { int tidl, bidl; };

__shared__ __attribute__((aligned(16))) unsigned char smem[73728];

typedef __attribute__((ext_vector_type(2))) __bf16 bf2_t;
typedef __attribute__((ext_vector_type(2))) float f2_t;
typedef __attribute__((ext_vector_type(4))) unsigned u32x4_t;
typedef __attribute__((ext_vector_type(2))) unsigned u32x2_t;
DI unsigned pk2(float a, float b) { f2_t v = {a, b}; return __builtin_bit_cast(unsigned, __builtin_convertvector(v, bf2_t)); }
DI bfr f2bf(float x) { return (bfr)(pk2(x, 0.f) & 0xffffu); }
DI float bf2f(bfr b) { return __uint_as_float(((unsigned)b) << 16); }
DI float bfs(short s) { return __uint_as_float(((unsigned)(unsigned short)s) << 16); }
DI int crow(int i, int h) { return (i & 3) + 8 * (i >> 2) + 4 * h; }
DI f32x16 zero16() { f32x16 z; for (int i = 0; i < 16; ++i) z[i] = 0.f; return z; }
DI bf16x8 pack8(float a0, float a1, float a2, float a3, float a4, float a5, float a6, float a7) {
  u32x4_t v = {pk2(a0, a1), pk2(a2, a3), pk2(a4, a5), pk2(a6, a7)};
  return __builtin_bit_cast(bf16x8, v);
}
DI bf16x4 pack4(float a0, float a1, float a2, float a3) {
  u32x2_t v = {pk2(a0, a1), pk2(a2, a3)};
  return __builtin_bit_cast(bf16x4, v);
}
#define PACK_HALF(s, s2) pack8(s[8 * (s2)], s[8 * (s2) + 1], s[8 * (s2) + 2], s[8 * (s2) + 3], s[8 * (s2) + 4], s[8 * (s2) + 5], s[8 * (s2) + 6], s[8 * (s2) + 7])
DI bf16x8 join44(bf16x4 lo, bf16x4 hi) { return __builtin_shufflevector(lo, hi, 0, 1, 2, 3, 4, 5, 6, 7); }
DI int chunk_row0(int b, int c) { return c == 0 ? RL + b * CTX : b * SEQ + (c - 1) * CL; }

DI void sincos_turn(double f, float& s, float& c) {
  f -= rint(f);
  double x = f * 6.283185307179586476925;
  double x2 = x * x, ss = 1.0, cc = 1.0;
#pragma unroll
  for (int k = 13; k >= 1; --k) {
    ss = 1.0 - x2 * (1.0 / (double)((2 * k) * (2 * k + 1))) * ss;
    cc = 1.0 - x2 * (1.0 / (double)((2 * k - 1) * (2 * k))) * cc;
  }
  s = (float)(x * ss); c = (float)cc;
}

template <class T> DI T* wsp(const DP& p, size_t off) { return (T*)(p.ws + off); }

DI void phase0(const DP& p) {
  const int tid = p.tidl, bid = p.bidl, G = gridDim.x;
  float* lds = (float*)smem;
  float* MOD = wsp<float>(p, OFF_MOD);
  for (int u = bid; u < 384; u += G) {
    int layer = u / 96, cb = u % 96;
    for (int i = tid; i < 3072; i += 256) {
      int v = i >> 10, k = i & 1023;
      float c = v < 2 ? p.c[v * 1024 + k] : p.c_ctx[k];
      lds[i] = c / (1.f + expf(-c));
    }
    __syncthreads();
    const int kq = tid >> 4, c4 = (tid & 15) * 4;
    const float* w = p.w_mod + (size_t)layer * 1024 * 6144 + cb * 64 + c4;
    float a0[4] = {0.f, 0.f, 0.f, 0.f}, a1[4] = {0.f, 0.f, 0.f, 0.f}, a2[4] = {0.f, 0.f, 0.f, 0.f};
#pragma unroll 16
    for (int k = kq * 64; k < kq * 64 + 64; ++k) {
      const float4 wv = *(const float4*)(w + (size_t)k * 6144);
      const float s0 = lds[k], s1 = lds[1024 + k], s2 = lds[2048 + k];
      a0[0] += s0 * wv.x; a0[1] += s0 * wv.y; a0[2] += s0 * wv.z; a0[3] += s0 * wv.w;
      a1[0] += s1 * wv.x; a1[1] += s1 * wv.y; a1[2] += s1 * wv.z; a1[3] += s1 * wv.w;
      a2[0] += s2 * wv.x; a2[1] += s2 * wv.y; a2[2] += s2 * wv.z; a2[3] += s2 * wv.w;
    }
    float* red = lds + 3072;
#pragma unroll
    for (int e = 0; e < 4; ++e) {
      red[(kq * 3 + 0) * 64 + c4 + e] = a0[e]; red[(kq * 3 + 1) * 64 + c4 + e] = a1[e]; red[(kq * 3 + 2) * 64 + c4 + e] = a2[e];
    }
    __syncthreads();
    if (tid < 192) {
      const int v = tid >> 6, cc = tid & 63, col = cb * 64 + cc;
      float sacc = 0.f;
#pragma unroll
      for (int q = 0; q < 16; ++q) sacc += red[(q * 3 + v) * 64 + cc];
      MOD[(layer * 3 + v) * 6144 + col] = sacc + p.b_mod[layer * 6144 + col];
    }
    __syncthreads();
  }
  const int gt = bid * 256 + tid, nt = G * 256;
  {
    const float4* xs = (const float4*)p.x; float4* od = (float4*)p.out;
    for (int i = gt; i < RL * 256; i += 8 * nt) {
      float4 t4[8];
#pragma unroll
      for (int q = 0; q < 8; ++q) { const int ii = i + q * nt; t4[q] = ii < RL * 256 ? xs[ii] : make_float4(0.f, 0.f, 0.f, 0.f); }
#pragma unroll
      for (int q = 0; q < 8; ++q) { const int ii = i + q * nt; if (ii < RL * 256) od[ii] = t4[q]; }
    }
    const float4* cs = (const float4*)p.ctx; float4* hd = wsp<float4>(p, OFF_HC);
    for (int i = gt; i < 512 * 256; i += nt) hd[i] = cs[i];
  }
  float2* TW = wsp<float2>(p, OFF_TW);
  for (int i = gt; i < 8192; i += nt) { float s, c; sincos_turn((double)i / 8192.0, s, c); TW[i] = make_float2(c, s); }
  bfr* C128 = wsp<bfr>(p, OFF_C128); bfr* S128 = wsp<bfr>(p, OFF_S128);
  for (int i = (gt + nt - 8192) % nt; i < 128 * 128; i += nt) { int a = i >> 7, b = i & 127; float s, c; sincos_turn((double)((a * b) & 127) / 128.0, s, c); C128[i] = f2bf(c); S128[i] = f2bf(s); }
  bfr* C64 = wsp<bfr>(p, OFF_C64); bfr* S64 = wsp<bfr>(p, OFF_S64);
  for (int i = (gt + nt - 24576) % nt; i < 64 * 64; i += nt) { int a = i >> 6, b = i & 63; float s, c; sincos_turn((double)((a * b) & 63) / 64.0, s, c); C64[i] = f2bf(c); S64[i] = f2bf(s); }
  bfr* C256 = wsp<bfr>(p, OFF_C256); bfr* S256 = wsp<bfr>(p, OFF_S256);
  for (int i = (gt + nt - 32768) % nt; i < 256 * 256; i += nt) { int a = i >> 8, b = i & 255; float s, c; sincos_turn((double)((a * b) & 255) / 256.0, s, c); C256[i] = f2bf(c); S256[i] = f2bf(s); }
  float* ROPE = wsp<float>(p, OFF_ROPE);
  for (int i = (gt + nt - 28672) % nt; i < 2 * 128 * 16; i += nt) {
    int f = i & 15, idx = (i >> 4) & 127;
    float ang = (float)idx * (float)exp(-(double)f * 0.5756462732485115);
    float s, c; sincos_turn((double)ang / 6.283185307179586476925, s, c);
    ROPE[i] = c; ROPE[4096 + i] = s;
  }
}

DI void tcvt_unit(const float* __restrict__ src, int ld, int c0, int ncols, int K, bfr* __restrict__ dst, int dr0, int u, int tid) {
  const int ntk = K >> 6;
  const int tn = u / ntk, tk = u % ntk, k0 = tk * 64, nb = tn * 64;
  bfr* T = (bfr*)smem;
  float4 v[4];
  const int n4 = (tid & 15) * 4;
#pragma unroll
  for (int i = 0; i < 4; ++i) {
    const int kk = (tid >> 4) + 16 * i;
    v[i] = make_float4(0.f, 0.f, 0.f, 0.f);
    if (nb + n4 < ncols) v[i] = *(const float4*)(src + (size_t)(k0 + kk) * ld + c0 + nb + n4);
  }
#pragma unroll
  for (int i = 0; i < 4; ++i) {
    const int kk = (tid >> 4) + 16 * i;
    T[(n4 + 0) * 72 + kk] = f2bf(v[i].x); T[(n4 + 1) * 72 + kk] = f2bf(v[i].y);
    T[(n4 + 2) * 72 + kk] = f2bf(v[i].z); T[(n4 + 3) * 72 + kk] = f2bf(v[i].w);
  }
  __syncthreads();
  {
    int n = tid >> 2, kseg = (tid & 3) * 16;
    if (nb + n < ncols) {
      bfr* d = dst + (size_t)(dr0 + nb + n) * K + k0 + kseg;
      *(bf16x8*)d = *(const bf16x8*)(T + n * 72 + kseg);
      *(bf16x8*)(d + 8) = *(const bf16x8*)(T + n * 72 + kseg + 8);
    }
  }
  __syncthreads();
}

DI void wconv_phase(const DP& p, int layer) {
  const int tid = p.tidl;
  const int j = layer >> 1;
  bfr* WIN = wsp<bfr>(p, OFF_WIN); bfr* WOUT = wsp<bfr>(p, OFF_WOUT);
  bfr* WFF1 = wsp<bfr>(p, OFF_WFF1); bfr* WFF2 = wsp<bfr>(p, OFF_WFF2);
  const float* ff1 = p.w_ff1 + (size_t)layer * 1024 * 4096;
  const float* ff2 = p.w_ff2 + (size_t)layer * 4096 * 1024;
  float* cst = (float*)(smem + 20480);
  if (tid < 64) { float s, c; sincos_turn((double)tid / 64.0, s, c); cst[tid] = c; cst[64 + tid] = s; }
  __syncthreads();
  if ((layer & 1) == 0) {
    const float* win = p.w_in_even + (size_t)j * 1024 * 4656;
    const float* wout = p.w_out_even + (size_t)j * 2048 * 1024;
    const int n_in = 65 * 16, n_out = 16 * 32, n_f1 = 64 * 16, n_f2 = 16 * 64, n_fold = 512;
    const int total = n_in + n_out + n_f1 + n_f2 + n_fold;
    for (int u = p.bidl; u < total; u += gridDim.x) {
      int v = u;
      if (v < n_in) { tcvt_unit(win, 4656, 512, 4144, 1024, WIN, 1024, v, tid); continue; }
      v -= n_in;
      if (v < n_out) { tcvt_unit(wout, 1024, 0, 1024, 2048, WOUT, 0, v, tid); continue; }
      v -= n_out;
      if (v < n_f1) { tcvt_unit(ff1, 4096, 0, 4096, 1024, WFF1, 0, v, tid); continue; }
      v -= n_f1;
      if (v < n_f2) { tcvt_unit(ff2, 1024, 0, 1024, 4096, WFF2, 0, v, tid); continue; }
      v -= n_f2;
      {
        const int g = v >> 6, kb = (v >> 2) & 15, mq = v & 3;
        float* wt = (float*)smem;
#pragma unroll
        for (int i = 0; i < 4; ++i) {
          const int idx = tid + 256 * i, kk = idx >> 4, j4 = (idx & 15) * 4;
          const float4 wv = *(const float4*)(win + (size_t)(kb * 64 + kk) * 4656 + g * 64 + j4);
          wt[kk * 65 + j4] = wv.x; wt[kk * 65 + j4 + 1] = wv.y; wt[kk * 65 + j4 + 2] = wv.z; wt[kk * 65 + j4 + 3] = wv.w;
        }
        __syncthreads();
        const int kl = tid & 63, mg = tid >> 6;
#pragma unroll 1
        for (int mi = 0; mi < 4; ++mi) {
          const int m = mg * 16 + mq * 4 + mi;
          float sc = 0.f, ss = 0.f;
#pragma unroll 8
          for (int jj = 0; jj < 64; ++jj) { const float w = wt[kl * 65 + jj]; const int idx = (m * jj) & 63; sc += w * cst[idx]; ss += w * cst[64 + idx]; }
          const int ch = g * 64 + m, k = kb * 64 + kl;
          WIN[(size_t)ch * 1024 + k] = f2bf(sc);
          WIN[(size_t)(512 + ch) * 1024 + k] = f2bf(-ss);
        }
        __syncthreads();
      }
    }
  } else {
    const float* win = p.w_in_odd + (size_t)j * 1024 * 2304;
    const float* wout = p.w_out_odd + (size_t)j * 1024 * 1024;
    const int n_in = 36 * 16, n_out = 16 * 16, n_f1 = 64 * 16, n_f2 = 16 * 64;
    const int total = n_in + n_out + n_f1 + n_f2;
    for (int u = p.bidl; u < total; u += gridDim.x) {
      int v = u;
      if (v < n_in) { tcvt_unit(win, 2304, 0, 2304, 1024, WIN, 0, v, tid); continue; }
      v -= n_in;
      if (v < n_out) { tcvt_unit(wout, 1024, 0, 1024, 1024, WOUT, 0, v, tid); continue; }
      v -= n_out;
      if (v < n_f1) { tcvt_unit(ff1, 4096, 0, 4096, 1024, WFF1, 0, v, tid); continue; }
      v -= n_f1;
      tcvt_unit(ff2, 1024, 0, 1024, 4096, WFF2, 0, v, tid);
    }
  }
}

DI void norm_phase(const DP& p, int layer, const float* __restrict__ gvec, int shc, int scc) {
  const int lane = p.tidl & 63;
  const int wg = p.bidl * 4 + (p.tidl >> 6), nw = gridDim.x * 4;
  const float* MOD = wsp<float>(p, OFF_MOD);
  const float* HC = wsp<float>(p, OFF_HC);
  bfr* U = wsp<bfr>(p, OFF_MIX);
#pragma unroll 1
  for (int row0 = wg; row0 < R; row0 += 2 * nw) {
    float4 v[2][4]; float ss[2] = {0.f, 0.f};
#pragma unroll
    for (int q = 0; q < 2; ++q) {
      const int row = row0 + q * nw < R ? row0 + q * nw : row0;
      const float* hp = row < RL ? p.out + (size_t)row * 1024 : HC + (size_t)(row - RL) * 1024;
#pragma unroll
      for (int i = 0; i < 4; ++i) v[q][i] = *(const float4*)(hp + i * 256 + lane * 4);
    }
#pragma unroll
    for (int q = 0; q < 2; ++q) {
#pragma unroll
      for (int i = 0; i < 4; ++i) ss[q] += v[q][i].x * v[q][i].x + v[q][i].y * v[q][i].y + v[q][i].z * v[q][i].z + v[q][i].w * v[q][i].w;
#pragma unroll
      for (int o = 32; o >= 1; o >>= 1) ss[q] += __shfl_xor(ss[q], o);
    }
#pragma unroll
    for (int q = 0; q < 2; ++q) {
      const int row = row0 + q * nw;
      if (row >= R) continue;
      const int ms = row < RL ? (row >> 13) : 2;
      const float* md = MOD + (layer * 3 + ms) * 6144;
      const float rs = rsqrtf(ss[q] * (1.f / 1024.f) + 1e-6f);
#pragma unroll
      for (int i = 0; i < 4; ++i) {
        int col = i * 256 + lane * 4;
        float4 g = *(const float4*)(gvec + col);
        float4 sc = *(const float4*)(md + scc * 1024 + col);
        float4 sh = *(const float4*)(md + shc * 1024 + col);
        bf16x4 o = pack4(v[q][i].x * rs * g.x * (1.f + sc.x) + sh.x, v[q][i].y * rs * g.y * (1.f + sc.y) + sh.y,
                         v[q][i].z * rs * g.z * (1.f + sc.z) + sh.z, v[q][i].w * rs * g.w * (1.f + sc.w) + sh.w);
        *(bf16x4*)(U + (size_t)row * 1024 + col) = o;
      }
    }
  }
}

enum { EPI_EVEN_IN = 0, EPI_ODD_IN = 1, EPI_RELU2 = 2, EPI_RESID = 3 };

DI void gemm_phase(const DP& p, int mode, const bfr* __restrict__ A, int lda, const bfr* __restrict__ Bt,
                   int N, int K, int layer, int gchunk, int nM) {
  const int tid = p.tidl, lane = tid & 63, wid = tid >> 6, r = lane & 31, h = lane >> 5;
  const int wm = wid >> 1, wn = wid & 1;
  const int nN = (N + 127) >> 7;
  const int tiles = nM * nN, G = (int)gridDim.x;
  int full = tiles, tail = 0, St = 1;
  if (mode == EPI_RESID) {
    full = (tiles / G) * G; tail = tiles - full;
    if (tail > 0) { int c = G / tail; int kmax = K >> 7; St = 1; while (St * 2 <= c && St * 2 <= 16 && St * 2 <= kmax) St *= 2; }
  }
  const int chunk = (full + 7) >> 3;
  const int units = chunk * 8 + tail * St;
  bfr* sm = (bfr*)smem;
  const int lrow = tid >> 3, lc = (tid & 7) * 8;
#pragma unroll 1
  for (int u = p.bidl; u < units; u += G) {
    int t, ks, Ks; bool atom;
    if (u < chunk * 8) {
      t = (u & 7) * chunk + (u >> 3);
      if (t >= full) continue;
      ks = 0; Ks = K; atom = false;
    } else { const int v = u - chunk * 8; t = full + v / St; ks = v % St; Ks = K / St; atom = St > 1; }
    const int nk = Ks >> 6;
    const int panel = t / (nM * 8); const int rem = t - panel * nM * 8;
    const int pw = (nN - panel * 8) < 8 ? (nN - panel * 8) : 8;
    const int tm = rem / pw, tn = panel * 8 + rem % pw;
    const int m0 = tm * 128, n0 = tn * 128, kbase = ks * Ks;
    f32x16 acc[2][2];
    acc[0][0] = zero16(); acc[0][1] = zero16(); acc[1][0] = zero16(); acc[1][1] = zero16();
    const bfr* Ag = A + (size_t)(m0 + lrow) * lda + kbase + lc;
    const bfr* Bg = Bt + (size_t)(n0 + lrow) * K + kbase + lc;
    bf16x8 ra[4], rb[4];
#pragma unroll
    for (int i = 0; i < 4; ++i) {
      ra[i] = *(const bf16x8*)(Ag + (size_t)(32 * i) * lda);
      rb[i] = *(const bf16x8*)(Bg + (size_t)(32 * i) * K);
    }
#pragma unroll
    for (int i = 0; i < 4; ++i) {
      *(bf16x8*)(sm + (lrow + 32 * i) * 72 + lc) = ra[i];
      *(bf16x8*)(sm + 9216 + (lrow + 32 * i) * 72 + lc) = rb[i];
    }
    if (nk > 1) {
#pragma unroll
      for (int i = 0; i < 4; ++i) {
        ra[i] = *(const bf16x8*)(Ag + (size_t)(32 * i) * lda + 64);
        rb[i] = *(const bf16x8*)(Bg + (size_t)(32 * i) * K + 64);
      }
    }
    __syncthreads();
#pragma unroll 1
    for (int kt = 0; kt < nk; ++kt) {
      if (kt + 1 < nk) {
        bfr* Ad = sm + ((kt + 1) & 1) * 18432;
#pragma unroll
        for (int i = 0; i < 4; ++i) {
          *(bf16x8*)(Ad + (lrow + 32 * i) * 72 + lc) = ra[i];
          *(bf16x8*)(Ad + 9216 + (lrow + 32 * i) * 72 + lc) = rb[i];
        }
      }
      if (kt + 2 < nk) {
#pragma unroll
        for (int i = 0; i < 4; ++i) {
          ra[i] = *(const bf16x8*)(Ag + (size_t)(32 * i) * lda + (kt + 2) * 64);
          rb[i] = *(const bf16x8*)(Bg + (size_t)(32 * i) * K + (kt + 2) * 64);
        }
      }
      const bfr* As = sm + (kt & 1) * 18432;
      const bfr* Bs = As + 9216;
      __builtin_amdgcn_s_setprio(1);
#pragma unroll
      for (int kk = 0; kk < 4; ++kk) {
        bf16x8 a0 = *(const bf16x8*)(As + (wm * 64 + r) * 72 + kk * 16 + h * 8);
        bf16x8 a1 = *(const bf16x8*)(As + (wm * 64 + 32 + r) * 72 + kk * 16 + h * 8);
        bf16x8 b0 = *(const bf16x8*)(Bs + (wn * 64 + r) * 72 + kk * 16 + h * 8);
        bf16x8 b1 = *(const bf16x8*)(Bs + (wn * 64 + 32 + r) * 72 + kk * 16 + h * 8);
        acc[0][0] = MFMA(a0, b0, acc[0][0]);
        acc[0][1] = MFMA(a0, b1, acc[0][1]);
        acc[1][0] = MFMA(a1, b0, acc[1][0]);
        acc[1][1] = MFMA(a1, b1, acc[1][1]);
      }
      __builtin_amdgcn_s_setprio(0);
      __syncthreads();
    }
    if (mode == EPI_RESID && !atom) {
      float hv[2][2][16], gt2[2][2];
#pragma unroll
      for (int mi = 0; mi < 2; ++mi)
#pragma unroll
        for (int ni = 0; ni < 2; ++ni) {
          const int col = n0 + wn * 64 + ni * 32 + r;
          const int rowb = m0 + wm * 64 + mi * 32 + 4 * h;
          const int ms = rowb < RL ? (rowb >> 13) : 2;
          gt2[mi][ni] = wsp<float>(p, OFF_MOD)[(layer * 3 + ms) * 6144 + gchunk * 1024 + col];
          const float* hp = rowb < RL ? p.out + (size_t)rowb * 1024 + col : wsp<float>(p, OFF_HC) + (size_t)(rowb - RL) * 1024 + col;
#pragma unroll
          for (int i = 0; i < 16; ++i) hv[mi][ni][i] = hp[(size_t)((i & 3) + 8 * (i >> 2)) * 1024];
        }
#pragma unroll
      for (int mi = 0; mi < 2; ++mi)
#pragma unroll
        for (int ni = 0; ni < 2; ++ni) {
          const int col = n0 + wn * 64 + ni * 32 + r;
          const int rowb = m0 + wm * 64 + mi * 32 + 4 * h;
          float* hp = rowb < RL ? p.out + (size_t)rowb * 1024 + col : wsp<float>(p, OFF_HC) + (size_t)(rowb - RL) * 1024 + col;
#pragma unroll
          for (int i = 0; i < 16; ++i) hp[(size_t)((i & 3) + 8 * (i >> 2)) * 1024] = hv[mi][ni][i] + gt2[mi][ni] * acc[mi][ni][i];
        }
      continue;
    }
    const int cbw = n0 + wn * 64;
    const bool qkfuse = mode == EPI_ODD_IN && !((cbw >= 640 && cbw < 768) || cbw >= 1792);
    if (qkfuse) {
      float* T = (float*)smem + wid * 4160;
#pragma unroll
      for (int mi = 0; mi < 2; ++mi)
#pragma unroll
        for (int ni = 0; ni < 2; ++ni)
#pragma unroll
          for (int i = 0; i < 16; ++i) T[(mi * 32 + crow(i, h)) * 65 + ni * 32 + r] = acc[mi][ni][i];
      asm volatile("s_waitcnt lgkmcnt(0)" ::: "memory");
      const int hs = cbw < 640 ? (cbw >> 6) : 10 + ((cbw - 768) >> 6);
      const int jj = layer >> 1;
      const float* gv = hs < 8 ? p.q_norm_win + jj * 64 : hs < 10 ? p.k_norm_win + jj * 64 : hs < 18 ? p.q_norm_na + jj * 64 : p.k_norm_na + jj * 64;
      const float qs = (hs < 8 || (hs >= 10 && hs < 18)) ? 0.125f : 1.f;
      const int row = m0 + wm * 64 + lane;
      float ss = 0.f;
#pragma unroll
      for (int d = 0; d < 64; ++d) { const float t = T[lane * 65 + d]; ss += t * t; }
      const float rs = rsqrtf(ss * (1.f / 64.f) + 1e-6f);
      const bool dorope = hs < 10 && row < RL;
      const float* ROPE = wsp<float>(p, OFF_ROPE);
      const int pos = row & 8191;
      bfr* dst = wsp<bfr>(p, OFF_QK) + (size_t)row * 1664 + hs * 64;
#pragma unroll
      for (int a = 0; a < 2; ++a) {
        float x[32];
#pragma unroll
        for (int d = 0; d < 32; ++d) x[d] = T[lane * 65 + a * 32 + d] * rs * gv[a * 32 + d];
        if (dorope) {
          const int idx = a == 0 ? (pos >> 6) : 128 + (pos & 63);
#pragma unroll
          for (int f4 = 0; f4 < 4; ++f4) {
            const float4 c4 = *(const float4*)(ROPE + idx * 16 + f4 * 4), s4 = *(const float4*)(ROPE + 4096 + idx * 16 + f4 * 4);
            const float cc[4] = {c4.x, c4.y, c4.z, c4.w}, sn[4] = {s4.x, s4.y, s4.z, s4.w};
#pragma unroll
            for (int q = 0; q < 4; ++q) {
              const int f = f4 * 4 + q;
              const float x1 = x[f], x2 = x[16 + f];
              x[f] = x1 * cc[q] - x2 * sn[q];
              x[16 + f] = x2 * cc[q] + x1 * sn[q];
            }
          }
        }
#pragma unroll
        for (int k8 = 0; k8 < 4; ++k8)
          *(bf16x8*)(dst + a * 32 + k8 * 8) = pack8(x[k8 * 8] * qs, x[k8 * 8 + 1] * qs, x[k8 * 8 + 2] * qs, x[k8 * 8 + 3] * qs,
                                                    x[k8 * 8 + 4] * qs, x[k8 * 8 + 5] * qs, x[k8 * 8 + 6] * qs, x[k8 * 8 + 7] * qs);
      }
    }
    if (!qkfuse)
#pragma unroll
    for (int mi = 0; mi < 2; ++mi)
#pragma unroll
      for (int ni = 0; ni < 2; ++ni)
#pragma unroll
        for (int g4 = 0; g4 < 4; ++g4) {
          const int row = m0 + wm * 64 + mi * 32 + 8 * g4 + 4 * h;
          const int col = n0 + wn * 64 + ni * 32 + r;
          const float v0 = acc[mi][ni][4 * g4], v1 = acc[mi][ni][4 * g4 + 1], v2 = acc[mi][ni][4 * g4 + 2], v3 = acc[mi][ni][4 * g4 + 3];
          if (mode == EPI_EVEN_IN) {
            if (col < 1024) {
              bfr* dst = wsp<bfr>(p, col < 512 ? OFF_ZRT : OFF_ZIT) + (size_t)(col & 511) * R + row;
              *(bf16x4*)dst = pack4(v0, v1, v2, v3);
            } else if (col < 2560) {
              bfr* dst = wsp<bfr>(p, OFF_Z) + (size_t)row * 1536 + (col - 1024);
              dst[0] = f2bf(v0); dst[1536] = f2bf(v1); dst[2 * 1536] = f2bf(v2); dst[3 * 1536] = f2bf(v3);
            } else if (col < 5120) {
              bfr* dst = wsp<bfr>(p, OFF_XBC) + (size_t)row * 2560 + (col - 2560);
              dst[0] = f2bf(v0); dst[2560] = f2bf(v1); dst[2 * 2560] = f2bf(v2); dst[3 * 2560] = f2bf(v3);
            } else if (col < 5168) {
              float* dst = wsp<float>(p, OFF_DTRAW) + (size_t)row * 48 + (col - 5120);
              dst[0] = v0; dst[48] = v1; dst[96] = v2; dst[144] = v3;
            }
          } else if (mode == EPI_ODD_IN) {
            if (col >= 640 && col < 768) {
              *(bf16x4*)(wsp<bfr>(p, OFF_VT) + (size_t)(col - 640) * R + row) = pack4(v0, v1, v2, v3);
            } else if (col >= 1792) {
              *(bf16x4*)(wsp<bfr>(p, OFF_VT) + (size_t)(128 + col - 1792) * R + row) = pack4(v0, v1, v2, v3);
            } else {
              bfr* dst = wsp<bfr>(p, OFF_P) + (size_t)row * 2304 + col;
              dst[0] = f2bf(v0); dst[2304] = f2bf(v1); dst[2 * 2304] = f2bf(v2); dst[3 * 2304] = f2bf(v3);
            }
          } else if (mode == EPI_RELU2) {
            bfr* dst = wsp<bfr>(p, OFF_ACT) + (size_t)row * 4096 + col;
            float t0 = fmaxf(v0, 0.f), t1 = fmaxf(v1, 0.f), t2 = fmaxf(v2, 0.f), t3 = fmaxf(v3, 0.f);
            dst[0] = f2bf(t0 * t0); dst[4096] = f2bf(t1 * t1); dst[2 * 4096] = f2bf(t2 * t2); dst[3 * 4096] = f2bf(t3 * t3);
          } else if (mode == EPI_RESID) {
            const int ms = row < RL ? (row >> 13) : 2;
            const float gate = wsp<float>(p, OFF_MOD)[(layer * 3 + ms) * 6144 + gchunk * 1024 + col];
            float* hp = row < RL ? p.out + (size_t)row * 1024 + col : wsp<float>(p, OFF_HC) + (size_t)(row - RL) * 1024 + col;
            if (atom) {
              unsafeAtomicAdd(hp, gate * v0); unsafeAtomicAdd(hp + 1024, gate * v1);
              unsafeAtomicAdd(hp + 2048, gate * v2); unsafeAtomicAdd(hp + 3072, gate * v3);
            } else {
              hp[0] += gate * v0; hp[1024] += gate * v1; hp[2048] += gate * v2; hp[3072] += gate * v3;
            }
          }
        }
    if (mode == EPI_ODD_IN) __syncthreads();
  }
}

DI float softplus_f(float x) { return x > 0.f ? x + log1pf(expf(-x)) : log1pf(expf(x)); }

DI void conv_dt_phase(const DP& p, int j) {
  const int tid = p.tidl, lane = tid & 63, wid = tid >> 6;
  const bfr* XBC = wsp<bfr>(p, OFF_XBC);
  bfr* XT = wsp<bfr>(p, OFF_XT); bfr* BN = wsp<bfr>(p, OFF_BN); bfr* BTt = wsp<bfr>(p, OFF_BT); bfr* CN = wsp<bfr>(p, OFF_CN);
  bfr* TT = (bfr*)smem;
  const float* cw = p.conv_w + (size_t)j * 5 * 2560;
  const float* cb = p.conv_b + (size_t)j * 2560;
  const int n_conv = 264 * 40, n_dt = 792;
  for (int u = p.bidl; u < n_conv + n_dt; u += gridDim.x) {
    if (u < n_conv) {
      const int tb = u / 40, cbk = u % 40, row0 = tb * 64, ch0 = cbk * 64;
      int pos0, len;
      if (row0 < RL) { pos0 = row0 & 8191; len = SEQ; } else { pos0 = (row0 - RL) & 255; len = CTX; }
      const int c8 = tid & 7, ch = ch0 + c8 * 8;
      float w[5][8], bias[8];
#pragma unroll
      for (int k = 0; k < 5; ++k) {
        float4 wa = *(const float4*)(cw + k * 2560 + ch), wb = *(const float4*)(cw + k * 2560 + ch + 4);
        w[k][0] = wa.x; w[k][1] = wa.y; w[k][2] = wa.z; w[k][3] = wa.w; w[k][4] = wb.x; w[k][5] = wb.y; w[k][6] = wb.z; w[k][7] = wb.w;
      }
      {
        float4 wa = *(const float4*)(cb + ch), wb = *(const float4*)(cb + ch + 4);
        bias[0] = wa.x; bias[1] = wa.y; bias[2] = wa.z; bias[3] = wa.w; bias[4] = wb.x; bias[5] = wb.y; bias[6] = wb.z; bias[7] = wb.w;
      }
#pragma unroll
      for (int ps = 0; ps < 2; ++ps) {
        const int tl = (tid >> 3) + 32 * ps, pos = pos0 + tl, row = row0 + tl;
        float a[8];
#pragma unroll
        for (int e = 0; e < 8; ++e) a[e] = bias[e];
        bf16x8 xr[5];
#pragma unroll
        for (int k = 0; k < 5; ++k) {
          const int pp = pos + k - 2;
          const bool ok = pp >= 0 && pp < len;
          const bfr* xp = XBC + (size_t)(ok ? row + k - 2 : row) * 2560 + ch;
          xr[k] = *(const bf16x8*)xp;
          if (!ok) { for (int e = 0; e < 8; ++e) xr[k][e] = 0; }
        }
#pragma unroll
        for (int k = 0; k < 5; ++k)
#pragma unroll
          for (int e = 0; e < 8; ++e) a[e] += w[k][e] * bfs(xr[k][e]);
        bf16x8 o;
#pragma unroll
        for (int e = 0; e < 8; ++e) { float s = a[e] / (1.f + __expf(-a[e])); o[e] = (short)f2bf(s); }
        if (ch0 >= 2048) *(bf16x8*)(CN + (size_t)row * 512 + (ch - 2048)) = o;
        else if (ch0 >= 1536) *(bf16x8*)(BN + (size_t)row * 512 + (ch - 1536)) = o;
        if (ch0 < 2048) {
#pragma unroll
          for (int e = 0; e < 8; ++e) TT[(c8 * 8 + e) * 72 + tl] = (bfr)o[e];
        }
      }
      if (ch0 < 2048) {
        __syncthreads();
        const int chl = tid >> 2, tseg = (tid & 3) * 16;
        bfr* dst = (ch0 < 1536 ? XT + (size_t)(ch0 + chl) * R : BTt + (size_t)(ch0 - 1536 + chl) * R) + row0 + tseg;
        *(bf16x8*)dst = *(const bf16x8*)(TT + chl * 72 + tseg);
        *(bf16x8*)(dst + 8) = *(const bf16x8*)(TT + chl * 72 + tseg + 8);
        __syncthreads();
      }
    } else {
      const int item = (u - n_conv) * 4 + wid;
      const int head = item % 24; int rest = item / 24; const int dir = rest & 1; rest >>= 1; const int c = rest % NCH, b = rest / NCH;
      const int row0 = chunk_row0(b, c), col = dir * 24 + head;
      const float bias = p.dt_bias[j * 48 + col];
      const float a = -expf(p.a_log[j * 48 + col]);
      const float* DTRAW = wsp<float>(p, OFF_DTRAW);
      float dt[4], cs[4];
      float run = 0.f;
#pragma unroll
      for (int q = 0; q < 4; ++q) {
        dt[q] = softplus_f(DTRAW[(size_t)(row0 + lane * 4 + q) * 48 + col] + bias);
        run += dt[q] * a; cs[q] = run;
      }
      float x = run;
#pragma unroll
      for (int o = 1; o < 64; o <<= 1) { float t2 = __shfl_up(x, o); if (lane >= o) x += t2; }
      const float excl = x - run;
      const float total = __shfl(x, 63);
      float ac[4];
#pragma unroll
      for (int q = 0; q < 4; ++q) {
        float inc = excl + cs[q];
        ac[q] = dir == 0 ? inc : total - inc + dt[q] * a;
      }
      const size_t base = ((size_t)(((dir * 2 + b) * NCH + c) * 24 + head)) * 256 + lane * 4;
      *(float4*)(wsp<float>(p, OFF_DTV) + base) = make_float4(dt[0], dt[1], dt[2], dt[3]);
      *(float4*)(wsp<float>(p, OFF_ACUM) + base) = make_float4(ac[0], ac[1], ac[2], ac[3]);
    }
  }
}

DI bf16x8 scale8(bf16x8 a, const float* w) {
  return pack8(bfs(a[0]) * w[0], bfs(a[1]) * w[1], bfs(a[2]) * w[2], bfs(a[3]) * w[3],
               bfs(a[4]) * w[4], bfs(a[5]) * w[5], bfs(a[6]) * w[6], bfs(a[7]) * w[7]);
}

DI void s1_item(const DP& p, int item, int lane) {
  const int r = lane & 31, h = lane >> 5;
  const int head = item % 24; int rest = item / 24; const int dir = rest & 1; rest >>= 1; const int c = rest % NCH, b = rest / NCH;
  const int g = head / 6;
  const int row0 = chunk_row0(b, c);
  const size_t dbase = ((size_t)(((dir * 2 + b) * NCH + c) * 24 + head)) * 256;
  const float* dtv = wsp<float>(p, OFF_DTV) + dbase;
  const float* acm = wsp<float>(p, OFF_ACUM) + dbase;
  const float acend = dir == 0 ? acm[255] : acm[0];
  const bfr* XT = wsp<bfr>(p, OFF_XT); const bfr* BTt = wsp<bfr>(p, OFF_BT);
  bfr* HS = wsp<bfr>(p, OFF_HS) + ((size_t)(((dir * 2 + b) * NCH + c) * 24 + head)) * 8192;
#pragma unroll 1
  for (int pt = 0; pt < 2; ++pt) {
    f32x16 acc[4];
#pragma unroll
    for (int n = 0; n < 4; ++n) acc[n] = zero16();
#pragma unroll 4
    for (int kk = 0; kk < 16; ++kk) {
      const int s0 = kk * 16 + 8 * h;
      float4 d0 = *(const float4*)(dtv + s0), d1 = *(const float4*)(dtv + s0 + 4);
      float4 a0 = *(const float4*)(acm + s0), a1 = *(const float4*)(acm + s0 + 4);
      float w[8];
      w[0] = d0.x * __expf(acend - a0.x); w[1] = d0.y * __expf(acend - a0.y); w[2] = d0.z * __expf(acend - a0.z); w[3] = d0.w * __expf(acend - a0.w);
      w[4] = d1.x * __expf(acend - a1.x); w[5] = d1.y * __expf(acend - a1.y); w[6] = d1.z * __expf(acend - a1.z); w[7] = d1.w * __expf(acend - a1.w);
      bf16x8 af = scale8(*(const bf16x8*)(XT + (size_t)(head * 64 + pt * 32 + r) * R + row0 + s0), w);
#pragma unroll
      for (int nt = 0; nt < 4; ++nt) {
        bf16x8 bfv = *(const bf16x8*)(BTt + (size_t)(g * 128 + nt * 32 + r) * R + row0 + s0);
        acc[nt] = MFMA(af, bfv, acc[nt]);
      }
    }
#pragma unroll
    for (int nt = 0; nt < 4; ++nt)
#pragma unroll
      for (int i = 0; i < 16; ++i) HS[(pt * 32 + crow(i, h)) * 128 + nt * 32 + r] = f2bf(acc[nt][i]);
  }
}

DI void s1_block(const DP& p, int item) {
  const int tid = p.tidl, lane = tid & 63, wid = tid >> 6, r = lane & 31, h = lane >> 5;
  const int g = item & 3; const int bc = item >> 2; const int c = bc % NCH, b = bc / NCH;
  const int row0 = chunk_row0(b, c);
  const bfr* XT = wsp<bfr>(p, OFF_XT); const bfr* BTt = wsp<bfr>(p, OFF_BT);
  bfr* BS = (bfr*)smem;
  __syncthreads();
#pragma unroll 4
  for (int i = 0; i < 32; ++i) {
    const int row = wid * 32 + i;
    if (lane < 32)
      __builtin_amdgcn_global_load_lds((const unsigned*)(BTt + (size_t)(g * 128 + row) * R + row0 + lane * 8),
                                       (unsigned*)(BS + row * 264 + lane * 8), 16, 0, 0);
  }
  asm volatile("s_waitcnt vmcnt(0)" ::: "memory");
  __syncthreads();
#pragma unroll 1
  for (int j3 = 0; j3 < 3; ++j3) {
    const int pi = wid * 3 + j3, dir = pi / 6, head = g * 6 + pi % 6;
    const size_t ci = (size_t)(((dir * 2 + b) * NCH + c) * 24 + head);
    const float* dtv = wsp<float>(p, OFF_DTV) + ci * 256;
    const float* acm = wsp<float>(p, OFF_ACUM) + ci * 256;
    const float acend = dir == 0 ? acm[255] : acm[0];
    bfr* HS = wsp<bfr>(p, OFF_HS) + ci * 8192;
    float* WS = (float*)(smem + 67584) + wid * 256;
    {
      const float4 d4 = *(const float4*)(dtv + lane * 4), a4 = *(const float4*)(acm + lane * 4);
      asm volatile("" ::: "memory");
      *(float4*)(WS + lane * 4) = make_float4(d4.x * __expf(acend - a4.x), d4.y * __expf(acend - a4.y),
                                              d4.z * __expf(acend - a4.z), d4.w * __expf(acend - a4.w));
      asm volatile("s_waitcnt lgkmcnt(0)" ::: "memory");
    }
#pragma unroll 1
    for (int pt = 0; pt < 2; ++pt) {
      f32x16 acc[4];
#pragma unroll
      for (int n = 0; n < 4; ++n) acc[n] = zero16();
#pragma unroll 4
      for (int kk = 0; kk < 16; ++kk) {
        const int s0 = kk * 16 + 8 * h;
        const float4 w0 = *(const float4*)(WS + s0), w1 = *(const float4*)(WS + s0 + 4);
        const float w[8] = {w0.x, w0.y, w0.z, w0.w, w1.x, w1.y, w1.z, w1.w};
        bf16x8 af = scale8(*(const bf16x8*)(XT + (size_t)(head * 64 + pt * 32 + r) * R + row0 + s0), w);
#pragma unroll
        for (int nt = 0; nt < 4; ++nt) {
          bf16x8 bfv = *(const bf16x8*)(BS + (nt * 32 + r) * 264 + s0);
          acc[nt] = MFMA(af, bfv, acc[nt]);
        }
      }
#pragma unroll
      for (int nt = 0; nt < 4; ++nt)
#pragma unroll
        for (int i = 0; i < 16; ++i) HS[(pt * 32 + crow(i, h)) * 128 + nt * 32 + r] = f2bf(acc[nt][i]);
    }
  }
}

DI void f1_item(const DP& p, int item, int lane) {
  const int r = lane & 31, h = lane >> 5;
  const int l2t = item & 1, m = (item >> 1) & 511, b = item >> 10;
  const bfr* ZRT = wsp<bfr>(p, OFF_ZRT) + (size_t)m * R + b * SEQ + l2t * 32 + r;
  const bfr* ZIT = wsp<bfr>(p, OFF_ZIT) + (size_t)m * R + b * SEQ + l2t * 32 + r;
  const bfr* C128 = wsp<bfr>(p, OFF_C128); const bfr* S128 = wsp<bfr>(p, OFF_S128);
  const float2* TW = wsp<float2>(p, OFF_TW);
  bfr* YR = wsp<bfr>(p, OFF_YR); bfr* YI = wsp<bfr>(p, OFF_YI);
  const int l2 = l2t * 32 + r;
#pragma unroll 1
  for (int mh = 0; mh < 2; ++mh) {
    f32x16 yr[2], yi[2];
#pragma unroll
    for (int i = 0; i < 2; ++i) { yr[i] = zero16(); yi[i] = zero16(); }
#pragma unroll 2
    for (int kk = 0; kk < 8; ++kk) {
      bf16x8 zr, zi, nzr;
#pragma unroll
      for (int jj = 0; jj < 8; ++jj) {
        int l1 = kk * 16 + 8 * h + jj;
        zr[jj] = (short)ZRT[l1 * 64]; zi[jj] = (short)ZIT[l1 * 64];
        nzr[jj] = (short)(zr[jj] ^ (short)0x8000);
      }
#pragma unroll
      for (int m2 = 0; m2 < 2; ++m2) {
        const int mt = mh * 2 + m2;
        bf16x8 ca = *(const bf16x8*)(C128 + (mt * 32 + r) * 128 + kk * 16 + 8 * h);
        bf16x8 sa = *(const bf16x8*)(S128 + (mt * 32 + r) * 128 + kk * 16 + 8 * h);
        yr[m2] = MFMA(ca, zr, yr[m2]); yr[m2] = MFMA(sa, zi, yr[m2]);
        yi[m2] = MFMA(ca, zi, yi[m2]); yi[m2] = MFMA(sa, nzr, yi[m2]);
      }
    }
#pragma unroll
    for (int m2 = 0; m2 < 2; ++m2)
#pragma unroll
      for (int i = 0; i < 16; ++i) {
        int k1 = (mh * 2 + m2) * 32 + crow(i, h);
        float2 t = TW[k1 * l2];
        float a = yr[m2][i], bb = yi[m2][i];
        size_t o = ((size_t)(b * 512 + m) * 128 + k1) * 64 + l2;
        YR[o] = f2bf(a * t.x + bb * t.y);
        YI[o] = f2bf(bb * t.x - a * t.y);
      }
  }
}

DI void f1c_item(const DP& p, int item, int lane) {
  const int r = lane & 31, h = lane >> 5;
  const int mt = item & 15, kt = (item >> 4) & 7, b = item >> 7;
  const int m = mt * 32 + r;
  const bfr* ZRT = wsp<bfr>(p, OFF_ZRT) + (size_t)m * R + RL + b * CTX;
  const bfr* ZIT = wsp<bfr>(p, OFF_ZIT) + (size_t)m * R + RL + b * CTX;
  const bfr* C256 = wsp<bfr>(p, OFF_C256) + (kt * 32 + r) * 256;
  const bfr* S256 = wsp<bfr>(p, OFF_S256) + (kt * 32 + r) * 256;
  f32x16 acc = zero16();
#pragma unroll 4
  for (int kk = 0; kk < 16; ++kk) {
    int o = kk * 16 + 8 * h;
    acc = MFMA(*(const bf16x8*)(C256 + o), *(const bf16x8*)(ZRT + o), acc);
    acc = MFMA(*(const bf16x8*)(S256 + o), *(const bf16x8*)(ZIT + o), acc);
  }
  bfr* MIX = wsp<bfr>(p, OFF_MIX);
#pragma unroll
  for (int i = 0; i < 16; ++i)
    MIX[(size_t)(RL + b * CTX + kt * 32 + crow(i, h)) * 2048 + m] = f2bf(acc[i] * (1.f / 128.f));
}

DI void s1f1_phase(const DP& p) {
  const int nS1 = 2 * NCH * 4;
  const int G = (int)gridDim.x;
  if (G > nS1 + 64) {
    if (p.bidl < nS1) { s1_block(p, p.bidl); return; }
    const int lane = p.tidl & 63;
    const int wg = (p.bidl - nS1) * 4 + (p.tidl >> 6), nw = (G - nS1) * 4;
#pragma unroll 1
    for (int it = wg; it < 2048 + 256; it += nw) {
      if (it < 2048) f1_item(p, it, lane); else f1c_item(p, it - 2048, lane);
    }
  } else {
#pragma unroll 1
    for (int it = p.bidl; it < nS1; it += G) s1_block(p, it);
    const int lane = p.tidl & 63;
    const int wg = p.bidl * 4 + (p.tidl >> 6), nw = G * 4;
#pragma unroll 1
    for (int it = wg; it < 2048 + 256; it += nw) {
      if (it < 2048) f1_item(p, it, lane); else f1c_item(p, it - 2048, lane);
    }
  }
}

DI void f2_item(const DP& p, int item, int lane) {
  const int r = lane & 31, h = lane >> 5;
  const int mt16 = item & 15, k1 = (item >> 4) & 127, b = item >> 11;
  const int m = mt16 * 32 + r;
  const bfr* YR = wsp<bfr>(p, OFF_YR) + ((size_t)(b * 512 + m) * 128 + k1) * 64;
  const bfr* YI = wsp<bfr>(p, OFF_YI) + ((size_t)(b * 512 + m) * 128 + k1) * 64;
  const bfr* C64 = wsp<bfr>(p, OFF_C64); const bfr* S64 = wsp<bfr>(p, OFF_S64);
  f32x16 acc[2]; acc[0] = zero16(); acc[1] = zero16();
#pragma unroll
  for (int kk = 0; kk < 4; ++kk) {
    bf16x8 yr = *(const bf16x8*)(YR + kk * 16 + 8 * h), yi = *(const bf16x8*)(YI + kk * 16 + 8 * h);
#pragma unroll
    for (int t = 0; t < 2; ++t) {
      bf16x8 ca = *(const bf16x8*)(C64 + (t * 32 + r) * 64 + kk * 16 + 8 * h);
      bf16x8 sa = *(const bf16x8*)(S64 + (t * 32 + r) * 64 + kk * 16 + 8 * h);
      acc[t] = MFMA(ca, yr, acc[t]); acc[t] = MFMA(sa, yi, acc[t]);
    }
  }
  bfr* MIX = wsp<bfr>(p, OFF_MIX);
  const float scale = 0.001381067932f;
#pragma unroll
  for (int t = 0; t < 2; ++t)
#pragma unroll
    for (int i = 0; i < 16; ++i) {
      int k2 = t * 32 + crow(i, h);
      MIX[(size_t)(b * SEQ + k1 + 128 * k2) * 2048 + m] = f2bf(acc[t][i] * scale);
    }
}

DI void s3_block(const DP& p, int j, int b, int c, int g, int half);

DI void s2f2_phase(const DP& p, int j) {
  if (p.bidl < 16) {
    const int k = p.bidl;
    s3_block(p, j, k >> 3, 0, (k >> 1) & 3, k & 1);
    return;
  }
  const int gt = (p.bidl - 16) * 256 + p.tidl, nt = ((int)gridDim.x - 16) * 256;
  bfr* HSb = wsp<bfr>(p, OFF_HS);
  const float* ACUM = wsp<float>(p, OFF_ACUM);
#pragma unroll 1
  for (int it = gt; it < 2 * 2 * 24 * 2048; it += nt) {
    const int e4 = it & 2047; const int rest = it >> 11; const int head = rest % 24, db = rest / 24, dir = db >> 1;
    bf16x4 sv[NCH]; float cd[NCH];
#pragma unroll
    for (int step = 0; step < NCH; ++step) {
      const int c = dir == 0 ? step : (step == 0 ? 0 : NCH - step);
      const size_t ci = (size_t)((db * NCH + c) * 24 + head);
      sv[step] = *(const bf16x4*)(HSb + ci * 8192 + e4 * 4);
      cd[step] = ACUM[ci * 256 + (dir == 0 ? 255 : 0)];
    }
    float h0 = 0.f, h1 = 0.f, h2 = 0.f, h3 = 0.f;
#pragma unroll
    for (int step = 0; step < NCH; ++step) {
      const int c = dir == 0 ? step : (step == 0 ? 0 : NCH - step);
      const size_t ci = (size_t)((db * NCH + c) * 24 + head);
      *(bf16x4*)(HSb + ci * 8192 + e4 * 4) = pack4(h0, h1, h2, h3);
      const float e = __expf(cd[step]);
      h0 = h0 * e + bfs(sv[step][0]); h1 = h1 * e + bfs(sv[step][1]); h2 = h2 * e + bfs(sv[step][2]); h3 = h3 * e + bfs(sv[step][3]);
    }
  }
  const int lane = p.tidl & 63;
  const int wg = (p.bidl - 16) * 4 + (p.tidl >> 6), nw = ((int)gridDim.x - 16) * 4;
#pragma unroll 1
  for (int it = wg; it < 4096; it += nw) f2_item(p, it, lane);
}

DI void s3_block(const DP& p, int j, int b, int c, int g, int half) {
  const int tid = p.tidl, lane = tid & 63, wid = tid >> 6, r = lane & 31, h = lane >> 5;
  const bfr* CN = wsp<bfr>(p, OFF_CN); const bfr* BN = wsp<bfr>(p, OFF_BN); const bfr* XT = wsp<bfr>(p, OFF_XT);
  const bfr* Z = wsp<bfr>(p, OFF_Z); bfr* MIX = wsp<bfr>(p, OFF_MIX);
  bfr* XTs = (bfr*)smem;
  bfr* HSF = (bfr*)(smem + 33792);
  bfr* HSB = (bfr*)(smem + 51200);
  float* LWF = (float*)(smem + 68608);
  float* LWB = LWF + 256;
  {
    const int row0 = chunk_row0(b, c);
    const int lt = half * 4 + wid;
    const int rowl = row0 + lt * 32 + r;
    const bfr* cfp = CN + (size_t)rowl * 512 + g * 128 + 8 * h;
    bf16x8 gtp[8][2];
    {
      bf16x8 cf[8];
#pragma unroll
      for (int kk = 0; kk < 8; ++kk) cf[kk] = *(const bf16x8*)(cfp + kk * 16);
#pragma unroll
      for (int k = 0; k < 8; ++k) { gtp[k][0] = cf[0]; gtp[k][1] = cf[0]; }
      __syncthreads();
      {
        bfr* BS = (bfr*)smem;
#pragma unroll 4
        for (int i = 0; i < 64; ++i) {
          const int row = wid * 64 + i;
          if (lane < 16)
            __builtin_amdgcn_global_load_lds((const unsigned*)(BN + (size_t)(row0 + row) * 512 + g * 128 + lane * 8),
                                             (unsigned*)(BS + row * 136 + lane * 8), 16, 0, 0);
        }
      }
      asm volatile("s_waitcnt vmcnt(0)" ::: "memory");
      __syncthreads();
#pragma unroll 1
      for (int st = 0; st < 8; ++st) {
        f32x16 gt = zero16();
#pragma unroll
        for (int kk = 0; kk < 8; ++kk)
          gt = MFMA(*(const bf16x8*)((const bfr*)smem + (st * 32 + r) * 136 + kk * 16 + 8 * h), cf[kk], gt);
#pragma unroll
        for (int k = 0; k < 7; ++k) { gtp[k][0] = gtp[k + 1][0]; gtp[k][1] = gtp[k + 1][1]; }
        gtp[7][0] = PACK_HALF(gt, 0); gtp[7][1] = PACK_HALF(gt, 1);
      }
    }
    float sumsq = 0.f;
#pragma unroll 1
    for (int hh = 0; hh < 6; ++hh) {
      const int head = g * 6 + hh;
      const size_t cif = (size_t)(((0 * 2 + b) * NCH + c) * 24 + head), cib = (size_t)(((1 * 2 + b) * NCH + c) * 24 + head);
      const float* acf = wsp<float>(p, OFF_ACUM) + cif * 256; const float* acb = wsp<float>(p, OFF_ACUM) + cib * 256;
      const float* dtf = wsp<float>(p, OFF_DTV) + cif * 256; const float* dtb = wsp<float>(p, OFF_DTV) + cib * 256;
      const bfr* HSf = wsp<bfr>(p, OFF_HS) + cif * 8192; const bfr* HSbk = wsp<bfr>(p, OFF_HS) + cib * 8192;
      __syncthreads();
#pragma unroll 4
      for (int i = 0; i < 16; ++i) {
        const int row = wid * 16 + i;
        if (lane < 32)
          __builtin_amdgcn_global_load_lds((const unsigned*)(XT + (size_t)(head * 64 + row) * R + row0 + lane * 8),
                                           (unsigned*)(XTs + row * 264 + lane * 8), 16, 0, 0);
      }
      if (c != 0) {
#pragma unroll 4
        for (int i = 0; i < 16; ++i) {
          const int row = wid * 16 + i;
          if (lane < 16) {
            __builtin_amdgcn_global_load_lds((const unsigned*)(HSf + row * 128 + lane * 8), (unsigned*)(HSF + row * 136 + lane * 8), 16, 0, 0);
            __builtin_amdgcn_global_load_lds((const unsigned*)(HSbk + row * 128 + lane * 8), (unsigned*)(HSB + row * 136 + lane * 8), 16, 0, 0);
          }
        }
      }
      bf16x8 cfh[8];
#pragma unroll
      for (int kk = 0; kk < 8; ++kk) cfh[kk] = *(const bf16x8*)(cfp + kk * 16);
      LWF[tid] = (__logf(dtf[tid]) - acf[tid]) * 1.44269504f;
      LWB[tid] = (__logf(dtb[tid]) - acb[tid]) * 1.44269504f;
      const float al_f = acf[lt * 32 + r], al_b = acb[lt * 32 + r];
      asm volatile("s_waitcnt vmcnt(0)" ::: "memory");
      __syncthreads();
      f32x16 acc[2];
      acc[0] = zero16(); acc[1] = zero16();
      if (c != 0) {
        f32x16 t0 = zero16(), t1 = zero16();
#pragma unroll
        for (int kk = 0; kk < 8; ++kk) {
          t0 = MFMA(*(const bf16x8*)(HSF + (r) * 136 + kk * 16 + 8 * h), cfh[kk], t0);
          t1 = MFMA(*(const bf16x8*)(HSF + (32 + r) * 136 + kk * 16 + 8 * h), cfh[kk], t1);
        }
        const float ef = __expf(al_f);
#pragma unroll
        for (int i = 0; i < 16; ++i) { acc[0][i] = t0[i] * ef; acc[1][i] = t1[i] * ef; }
        t0 = zero16(); t1 = zero16();
#pragma unroll
        for (int kk = 0; kk < 8; ++kk) {
          t0 = MFMA(*(const bf16x8*)(HSB + (r) * 136 + kk * 16 + 8 * h), cfh[kk], t0);
          t1 = MFMA(*(const bf16x8*)(HSB + (32 + r) * 136 + kk * 16 + 8 * h), cfh[kk], t1);
        }
        const float eb = __expf(al_b);
#pragma unroll
        for (int i = 0; i < 16; ++i) { acc[0][i] += t0[i] * eb; acc[1][i] += t1[i] * eb; }
      }
      bf16x4 zpre[2][4];
#pragma unroll
      for (int pt = 0; pt < 2; ++pt)
#pragma unroll
        for (int g4 = 0; g4 < 4; ++g4) zpre[pt][g4] = *(const bf16x4*)(Z + (size_t)rowl * 1536 + head * 64 + pt * 32 + 8 * g4 + 4 * h);
#pragma unroll 1
      for (int st = 0; st < 8; ++st) {
        const bf16x8 g0 = gtp[0][0], g1 = gtp[0][1];
#pragma unroll
        for (int k = 0; k < 7; ++k) { gtp[k][0] = gtp[k + 1][0]; gtp[k][1] = gtp[k + 1][1]; }
        gtp[7][0] = g0; gtp[7][1] = g1;
#pragma unroll 1
        for (int dir = 0; dir < 2; ++dir) {
          if (dir == 0 ? (st > lt) : (st < lt)) continue;
          const float* lwd = dir == 0 ? LWF : LWB;
          const float al = (dir == 0 ? al_f : al_b) * 1.44269504f;
          f32x16 mm;
          if (st != lt) {
#pragma unroll
            for (int g4 = 0; g4 < 4; ++g4) {
              const float4 l4 = *(const float4*)(lwd + st * 32 + 8 * g4 + 4 * h);
              const float lv[4] = {l4.x, l4.y, l4.z, l4.w};
#pragma unroll
              for (int q = 0; q < 4; ++q) {
                const int i = 4 * g4 + q;
                mm[i] = bfs((i >> 3) ? g1[i & 7] : g0[i & 7]) * __builtin_amdgcn_exp2f(al + lv[q]);
              }
            }
          } else {
#pragma unroll
            for (int g4 = 0; g4 < 4; ++g4) {
              const int sb = st * 32 + 8 * g4 + 4 * h;
              const float4 l4 = *(const float4*)(lwd + sb);
              const float lv[4] = {l4.x, l4.y, l4.z, l4.w};
#pragma unroll
              for (int q = 0; q < 4; ++q) {
                const int i = 4 * g4 + q;
                const int sidx = sb + q, lidx = lt * 32 + r;
                const bool valid = dir == 0 ? (sidx <= lidx) : (sidx >= lidx);
                const float gv = bfs((i >> 3) ? g1[i & 7] : g0[i & 7]);
                const float e = __builtin_amdgcn_exp2f(fminf(al + lv[q], 40.f));
                mm[i] = valid ? gv * e : 0.f;
              }
            }
          }
#pragma unroll
          for (int s2 = 0; s2 < 2; ++s2) {
            bf16x8 pf = PACK_HALF(mm, s2);
#pragma unroll
            for (int pt = 0; pt < 2; ++pt) {
              const bfr* xp = XTs + (pt * 32 + r) * 264 + st * 32 + 16 * s2 + 4 * h;
              bf16x8 xf = join44(*(const bf16x4*)xp, *(const bf16x4*)(xp + 8));
              acc[pt] = MFMA(xf, pf, acc[pt]);
            }
          }
        }
      }
      const float dsk = p.d_skip[j * 24 + head];
#pragma unroll
      for (int pt = 0; pt < 2; ++pt)
#pragma unroll
        for (int g4 = 0; g4 < 4; ++g4) {
          const int pb = pt * 32 + 8 * g4 + 4 * h;
          bf16x4 zv = zpre[pt][g4];
          float y[4];
#pragma unroll
          for (int q = 0; q < 4; ++q) {
            float xv = bf2f(XTs[(pb + q) * 264 + lt * 32 + r]);
            float zz = bfs(zv[q]);
            float v = (acc[pt][4 * g4 + q] + dsk * xv) * (zz / (1.f + __expf(-zz)));
            sumsq += v * v; y[q] = v;
          }
          *(bf16x4*)(MIX + (size_t)rowl * 2048 + 512 + head * 64 + pb) = pack4(y[0], y[1], y[2], y[3]);
        }
    }
    const float tot = sumsq + __shfl_xor(sumsq, 32);
    const float sc = rsqrtf(tot * (1.f / 384.f) + 1e-6f);
    const float* ng = p.ssd_norm_g + (size_t)j * 1536;
    bf16x4 yv[6][2][4];
#pragma unroll
    for (int hh = 0; hh < 6; ++hh)
#pragma unroll
      for (int pt = 0; pt < 2; ++pt)
#pragma unroll
        for (int g4 = 0; g4 < 4; ++g4)
          yv[hh][pt][g4] = *(const bf16x4*)(MIX + (size_t)rowl * 2048 + 512 + (g * 6 + hh) * 64 + pt * 32 + 8 * g4 + 4 * h);
#pragma unroll
    for (int hh = 0; hh < 6; ++hh)
#pragma unroll
      for (int pt = 0; pt < 2; ++pt)
#pragma unroll
        for (int g4 = 0; g4 < 4; ++g4) {
          const int pb = pt * 32 + 8 * g4 + 4 * h, head = g * 6 + hh;
          const float4 gg = *(const float4*)(ng + head * 64 + pb);
          const bf16x4 y4 = yv[hh][pt][g4];
          *(bf16x4*)(MIX + (size_t)rowl * 2048 + 512 + head * 64 + pb) =
              pack4(bfs(y4[0]) * sc * gg.x, bfs(y4[1]) * sc * gg.y, bfs(y4[2]) * sc * gg.z, bfs(y4[3]) * sc * gg.w);
        }
  }
}

DI void s3_phase(const DP& p, int j) {
#pragma unroll 1
  for (int idx = p.bidl; idx < 512; idx += (int)gridDim.x) {
    const int half = idx & 1, g = (idx >> 1) & 3, bcl = idx >> 3;
    s3_block(p, j, bcl >> 5, 1 + (bcl & 31), g, half);
  }
}

DI void qkprep_phase(const DP& p, int j) {
  const int lane = p.tidl & 63;
  const int wg = p.bidl * 4 + (p.tidl >> 6), nw = gridDim.x * 4;
  const bfr* P = wsp<bfr>(p, OFF_P); bfr* QK = wsp<bfr>(p, OFF_QK);
  const float* ROPE = wsp<float>(p, OFF_ROPE);
  const int sub = lane >> 3, d0 = (lane & 7) * 8;
  for (int row = wg; row < R; row += nw) {
    bf16x8 xin[4];
#pragma unroll
    for (int ps = 0; ps < 4; ++ps) {
      const int hs0 = ps * 8 + sub, hsc0 = hs0 < 26 ? hs0 : 25;
      xin[ps] = *(const bf16x8*)(P + (size_t)row * 2304 + (hsc0 < 10 ? hsc0 * 64 : 768 + (hsc0 - 10) * 64) + d0);
    }
#pragma unroll
    for (int ps = 0; ps < 4; ++ps) {
      const int hs = ps * 8 + sub;
      const bool act = hs < 26;
      const int hsc = act ? hs : 25;
      bf16x8 xv = xin[ps];
      float x[8]; float ss = 0.f;
#pragma unroll
      for (int e = 0; e < 8; ++e) { x[e] = bfs(xv[e]); ss += x[e] * x[e]; }
      ss += __shfl_xor(ss, 1); ss += __shfl_xor(ss, 2); ss += __shfl_xor(ss, 4);
      const float rs = rsqrtf(ss * (1.f / 64.f) + 1e-6f);
      const float* gv = hsc < 8 ? p.q_norm_win + j * 64 : hsc < 10 ? p.k_norm_win + j * 64 : hsc < 18 ? p.q_norm_na + j * 64 : p.k_norm_na + j * 64;
#pragma unroll
      for (int e = 0; e < 8; ++e) x[e] = x[e] * rs * gv[d0 + e];
      float pr[8];
#pragma unroll
      for (int e = 0; e < 8; ++e) pr[e] = __shfl_xor(x[e], 2);
      if (hsc < 10 && row < RL) {
        const int pos = row & 8191;
        const int axis = d0 >> 5;
        const int idx = axis == 0 ? (pos >> 6) : (pos & 63);
        const int f0 = d0 & 15;
        const bool second = (d0 & 16) != 0;
        const float* cp = ROPE + (axis * 128 + idx) * 16 + f0;
        const float* sp = cp + 4096;
#pragma unroll
        for (int e = 0; e < 8; ++e) {
          float cs = cp[e], sn = sp[e];
          x[e] = second ? (x[e] * cs + pr[e] * sn) : (x[e] * cs - pr[e] * sn);
        }
      }
      const bool isq = hsc < 8 || (hsc >= 10 && hsc < 18);
      const float qs = isq ? 0.125f : 1.f;
      if (act) *(bf16x8*)(QK + (size_t)row * 1664 + hsc * 64 + d0) = pack8(x[0] * qs, x[1] * qs, x[2] * qs, x[3] * qs, x[4] * qs, x[5] * qs, x[6] * qs, x[7] * qs);
    }
  }
}

struct KVF { bf16x8 k[4]; bf16x8 v[2][2]; };
struct KVS { bf16x8 k[4]; bf16x8 v[4]; };

DI void kv_gload(KVS& g, const bfr* __restrict__ Kt, const bfr* __restrict__ Vt, int lane) {
#pragma unroll
  for (int i = 0; i < 4; ++i) {
    const int idx = lane + 64 * i;
    g.k[i] = *(const bf16x8*)(Kt + (size_t)(idx >> 3) * 1664 + (idx & 7) * 8);
    g.v[i] = *(const bf16x8*)(Vt + (size_t)(idx >> 2) * R + (idx & 3) * 8);
  }
}
DI void kv_sstore(const KVS& g, unsigned char* base, int lane) {
#pragma unroll
  for (int i = 0; i < 4; ++i) {
    const int idx = lane + 64 * i;
    { const int row = idx >> 3, c = idx & 7; *(bf16x8*)(base + row * 128 + ((c ^ (row & 7)) << 4)) = g.k[i]; }
    {
      const int d = idx >> 2, c16 = idx & 3, sw = (d >> 2) & 7;
      bf16x4 lo = __builtin_shufflevector(g.v[i], g.v[i], 0, 1, 2, 3), hi = __builtin_shufflevector(g.v[i], g.v[i], 4, 5, 6, 7);
      *(bf16x4*)(base + 4096 + d * 64 + (((2 * c16) ^ sw) << 3)) = lo;
      *(bf16x4*)(base + 4096 + d * 64 + (((2 * c16 + 1) ^ sw) << 3)) = hi;
    }
  }
}
DI void kv_sload(KVF& f, const unsigned char* base, int r, int h) {
#pragma unroll
  for (int kk = 0; kk < 4; ++kk) f.k[kk] = *(const bf16x8*)(base + r * 128 + (((2 * kk + h) ^ (r & 7)) << 4));
#pragma unroll
  for (int s2 = 0; s2 < 2; ++s2)
#pragma unroll
    for (int dt = 0; dt < 2; ++dt) {
      const int d = dt * 32 + r, sw = (d >> 2) & 7, c8 = 4 * s2 + h;
      const unsigned char* vb = base + 4096 + d * 64;
      f.v[s2][dt] = join44(*(const bf16x4*)(vb + ((c8 ^ sw) << 3)), *(const bf16x4*)(vb + (((c8 + 2) ^ sw) << 3)));
    }
}

DI void attn_compute(f32x16 (&o)[2], float& m, float& l, const unsigned char* qb, const unsigned char* base, int r, int h,
                     int mode, int a0, int a1, const float* __restrict__ rp) {
  f32x16 s = zero16();
#pragma unroll
  for (int kk = 0; kk < 4; ++kk) {
    const int off = r * 128 + (((2 * kk + h) ^ (r & 7)) << 4);
    s = MFMA(*(const bf16x8*)(base + off), *(const bf16x8*)(qb + off), s);
  }
  float tmax = -3.0e38f;
  if (mode == 1) {
#pragma unroll
    for (int i = 0; i < 16; ++i) { int dd = a0 - crow(i, h); dd = dd < 0 ? -dd : dd; s[i] = dd <= 128 ? s[i] : -1.0e30f; }
  } else if (mode == 2) {
#pragma unroll
    for (int i = 0; i < 16; ++i) {
      const int key = crow(i, h);
      const int rel = a0 + key;
      int co = a1 + key; co = co < 0 ? 0 : (co > 30 ? 30 : co);
      s[i] = (rel >= 0 && rel < 16) ? s[i] + rp[co] : -1.0e30f;
    }
  }
#pragma unroll
  for (int i = 0; i < 16; ++i) tmax = fmaxf(tmax, s[i]);
  tmax = fmaxf(tmax, __shfl_xor(tmax, 32));
  const float mn = fmaxf(m, tmax);
  const float alpha = __expf(m - mn);
  float ps = 0.f;
#pragma unroll
  for (int i = 0; i < 16; ++i) { s[i] = __expf(s[i] - mn); ps += s[i]; }
  l = l * alpha + ps; m = mn;
#pragma unroll
  for (int i = 0; i < 16; ++i) { o[0][i] *= alpha; o[1][i] *= alpha; }
#pragma unroll
  for (int s2 = 0; s2 < 2; ++s2) {
    bf16x8 pf = PACK_HALF(s, s2);
#pragma unroll
    for (int dt = 0; dt < 2; ++dt) {
      const int d = dt * 32 + r, sw = (d >> 2) & 7, c8 = 4 * s2 + h;
      const unsigned char* vb = base + 4096 + d * 64;
      bf16x8 vf = join44(*(const bf16x4*)(vb + ((c8 ^ sw) << 3)), *(const bf16x4*)(vb + (((c8 + 2) ^ sw) << 3)));
      o[dt] = MFMA(vf, pf, o[dt]);
    }
  }
}

DI void attn_item(const DP& p, int j, int item, int lane) {
  const int r = lane & 31, h = lane >> 5;
  const bfr* QK = wsp<bfr>(p, OFF_QK); const bfr* VT = wsp<bfr>(p, OFF_VT); bfr* MIX = wsp<bfr>(p, OFF_MIX);
  int kind, b, hd, qt;
  if (item < 4096) { kind = 0; qt = item & 255; hd = (item >> 8) & 7; b = item >> 11; }
  else if (item < 8192) { int v = item - 4096; kind = 1; qt = v & 255; hd = (v >> 8) & 7; b = v >> 11; }
  else if (item < 8320) { int v = item - 8192; kind = 2; qt = v & 7; hd = (v >> 3) & 7; b = v >> 6; }
  else { int v = item - 8320; kind = 3; qt = v & 7; hd = (v >> 3) & 7; b = v >> 6; }
  const bool win = (kind == 0 || kind == 2);
  const bool lat = kind < 2;
  const int q_row0 = lat ? b * SEQ + qt * 32 : RL + b * CTX + qt * 32;
  const int qcol = win ? hd * 64 : (10 + hd) * 64;
  const int kcol = win ? (8 + (hd >> 2)) * 64 : (18 + hd) * 64;
  const bfr* Vb = win ? VT + (size_t)((hd >> 2) * 64) * R : VT + (size_t)(128 + hd * 64) * R;
  const bfr* Kb = QK + kcol;
  f32x16 o[2]; o[0] = zero16(); o[1] = zero16();
  float m = -1.0e30f, l = 0.f;
  if (win) { m = p.sink_win[j * 8 + hd]; l = h == 0 ? 1.f : 0.f; }
  int nloc = 0, lo = 0, gr = 0, kr0 = 0, w = 0, cs = 0;
  const int qpos = qt * 32 + r;
  if (kind == 0) { lo = qt - 4 < 0 ? 0 : qt - 4; const int hi = qt + 4 > 255 ? 255 : qt + 4; nloc = hi - lo + 1; }
  else if (kind == 1) {
    gr = qt >> 1; w = (qt & 1) * 32 + r;
    cs = w - 8; cs = cs < 0 ? 0 : (cs > 48 ? 48 : cs);
    kr0 = gr - 4; kr0 = kr0 < 0 ? 0 : (kr0 > 120 ? 120 : kr0);
    nloc = 16;
  }
  const int ntile = 8 + nloc;
  const float* rpb = p.rpb_na + (size_t)j * 8 * 15 * 31 + hd * 15 * 31;
  auto tile_row = [&](int i) -> int {
    if (i < 8) return RL + b * CTX + i * 32;
    const int li = i - 8;
    if (kind == 0) return b * SEQ + (lo + li) * 32;
    return b * SEQ + (kr0 + (li >> 1)) * 64 + (li & 1) * 32;
  };
  unsigned char* lbase = smem + (p.tidl >> 6) * 12288;
  asm volatile("" ::: "memory");
#pragma unroll
  for (int i = 0; i < 4; ++i) {
    const int idx = lane + 64 * i, row = idx >> 3, c = idx & 7;
    *(bf16x8*)(lbase + 8192 + row * 128 + ((c ^ (row & 7)) << 4)) = *(const bf16x8*)(QK + (size_t)(q_row0 + row) * 1664 + qcol + c * 8);
  }
  KVS g;
  { const int k0 = tile_row(0); kv_gload(g, Kb + (size_t)k0 * 1664, Vb + k0, lane); }
  kv_sstore(g, lbase, lane);
#pragma unroll 1
  for (int i = 0; i < ntile; ++i) {
    { const int in = i + 1 < ntile ? i + 1 : i; const int k0 = tile_row(in); kv_gload(g, Kb + (size_t)k0 * 1664, Vb + k0, lane); }
    int mode = 0, a0 = 0, a1 = 0; const float* rp = rpb;
    if (i >= 8) {
      const int li = i - 8;
      if (kind == 0) { mode = 1; a0 = qpos - (lo + li) * 32; }
      else { mode = 2; const int krow = kr0 + (li >> 1); const int ub = (li & 1) * 32; a0 = ub - cs; a1 = ub - w + 15; rp = rpb + (krow - gr + 7) * 31; }
    }
    asm volatile("" ::: "memory");
    attn_compute(o, m, l, lbase + 8192, lbase, r, h, mode, a0, a1, rp);
    asm volatile("" ::: "memory");
    kv_sstore(g, lbase, lane);
  }
  asm volatile("" ::: "memory");
  const float lt = l + __shfl_xor(l, 32);
  const float inv = 1.f / lt;
  const int ocol = win ? hd * 64 : 512 + hd * 64;
#pragma unroll
  for (int dt = 0; dt < 2; ++dt)
#pragma unroll
    for (int g4 = 0; g4 < 4; ++g4) {
      const int d = dt * 32 + 8 * g4 + 4 * h;
      *(bf16x4*)(MIX + (size_t)(q_row0 + r) * 1024 + ocol + d) =
          pack4(o[dt][4 * g4] * inv, o[dt][4 * g4 + 1] * inv, o[dt][4 * g4 + 2] * inv, o[dt][4 * g4 + 3] * inv);
    }
}

DI void attn_phase(const DP& p, int j) {
  const int lane = p.tidl & 63;
  const int wg = p.bidl * 4 + (p.tidl >> 6), nw = gridDim.x * 4;
#pragma unroll 1
  for (int it = wg; it < 8448; it += nw) attn_item(p, j, it, lane);
}

#define XB_TMO      128
#define XB_XCNT(j)  (256  + 64 * (j))
#define XB_XSUB(j)  (1280 + 64 * (j))
#define XB_XGEN(j)  (2304 + 64 * (j))
#define XB_TOP      3328
#define XB_TOPGEN   3392
#define XCD_BAR_WORDS 3456
#define XB_SPIN_CAP (1u << 18)
#define LAS __attribute__((address_space(3)))

__device__ __forceinline__ unsigned xb_ld(unsigned* p)              { return __hip_atomic_load(p, __ATOMIC_RELAXED, __HIP_MEMORY_SCOPE_AGENT); }
__device__ __forceinline__ unsigned xb_add(unsigned* p, unsigned v) { return __hip_atomic_fetch_add(p, v, __ATOMIC_RELAXED, __HIP_MEMORY_SCOPE_AGENT); }
__device__ __forceinline__ unsigned xb_xcc_id() { return (unsigned)__builtin_amdgcn_s_getreg((3 << 11) | 20) & 0xFu; }
#define XB_SPIN(cond, bar) do { unsigned _sp = 0; while (cond) { __builtin_amdgcn_s_sleep(1); \
    if ((++_sp & 255u) == 0u) { if (xb_ld(&(bar)[XB_TMO])) break; if (_sp > XB_SPIN_CAP) { atomicAdd(&(bar)[XB_TMO], 1u); break; } } } } while (0)

struct XcdBarrier {
    unsigned* bar; unsigned x;
    volatile LAS unsigned* st;
};

__device__ __forceinline__ XcdBarrier xcd_barrier_post(unsigned* bar, volatile LAS unsigned* st) {
    XcdBarrier b; b.bar = bar; b.x = xb_xcc_id(); b.st = st;
    if (threadIdx.x == 0) (void)xb_add(&bar[XB_XCNT(b.x)], 1u);
    return b;
}
__device__ __forceinline__ void xcd_barrier_complete(unsigned* bar, unsigned x, unsigned& nloc, unsigned& nx) {
    const unsigned G = gridDim.x * gridDim.y * gridDim.z;
    unsigned sum, cnt, mine, sp = 0u;
    for (;;) {
        sum = 0u; cnt = 0u; mine = 0u;
#pragma unroll
        for (unsigned j = 0; j < 16; ++j) { const unsigned c = xb_ld(&bar[XB_XCNT(j)]); sum += c; cnt += (c > 0u) ? 1u : 0u; mine = (j == x) ? c : mine; }
        if (sum == G) break;
        __builtin_amdgcn_s_sleep(1);
        if ((++sp & 255u) == 0u) { if (xb_ld(&bar[XB_TMO])) break; if (sp > XB_SPIN_CAP) { atomicAdd(&bar[XB_TMO], 1u); break; } }
    }
    nloc = mine > 0u ? mine : 1u; nx = cnt > 0u ? cnt : 1u;
}

__device__ __forceinline__ void xcd_barrier(const XcdBarrier& b) {
    asm volatile("s_waitcnt vmcnt(0)" ::: "memory");
    __syncthreads();
    if (threadIdx.x == 0) {
        unsigned* bar = b.bar;
        __builtin_amdgcn_s_waitcnt(0);
        unsigned nloc = b.st[0], nx = b.st[1];
        if (nloc == 0u) { xcd_barrier_complete(bar, b.x, nloc, nx); b.st[0] = nloc; b.st[1] = nx; }
        const unsigned old = xb_add(&bar[XB_XSUB(b.x)], 1u);
        const unsigned gen = old / nloc;
        if (old + 1u == (gen + 1u) * nloc) {
            __builtin_amdgcn_fence(__ATOMIC_RELEASE, "agent");
            asm volatile("s_waitcnt vmcnt(0)" ::: "memory");
            const unsigned og = xb_add(&bar[XB_TOP], 1u);
            const unsigned tg = og / nx;
            if (og + 1u == (tg + 1u) * nx) xb_add(&bar[XB_TOPGEN], 1u);
            else XB_SPIN(xb_ld(&bar[XB_TOPGEN]) == tg, bar);
            __builtin_amdgcn_fence(__ATOMIC_ACQUIRE, "agent");
            xb_add(&bar[XB_XGEN(b.x)], 1u);
            asm volatile("s_waitcnt vmcnt(0)" ::: "memory");
        } else {
            XB_SPIN(xb_ld(&bar[XB_XGEN(b.x)]) == gen, bar);
            __builtin_amdgcn_fence(__ATOMIC_ACQUIRE, "agent");
            asm volatile("s_waitcnt vmcnt(0)" ::: "memory");
        }
    }
    __syncthreads();
}


DI void run_phase(const DP& p, int ph, int dry) {
  if (ph == 0) { phase0(p); wconv_phase(p, 0); return; }
  int q = ph - 1, layer, lp;
  if (q < 10) { layer = 0; lp = q; } else if (q < 17) { layer = 1; lp = q - 10; } else if (q < 27) { layer = 2; lp = q - 17; } else { layer = 3; lp = q - 27; }
  const int j = layer >> 1;
  const bool even = (layer & 1) == 0;
  int op, gsel = 0;
  if (even) {
    op = (int)((0x2272654321ull >> (4 * lp)) & 15ull); gsel = (int)((0x3201000000ull >> (4 * lp)) & 15ull);
  } else {
    op = (int)((0x2272921ull >> (4 * lp)) & 15ull); gsel = (int)((0x3201000ull >> (4 * lp)) & 15ull);
  }
  if (op == 1 && layer != 0) wconv_phase(p, layer);
  if (op == 1 || op == 7) {
    const bool first = op == 1;
    norm_phase(p, layer, (first ? p.norm_mix_g : p.norm_ff_g) + layer * 1024, first ? 0 : 3, first ? 1 : 4);
  } else if (op == 2) {
    int mode, lda, N, K, gch; size_t offA, offB;
    if (gsel == 0) { mode = even ? EPI_EVEN_IN : EPI_ODD_IN; offA = OFF_MIX; lda = 1024; offB = OFF_WIN; N = even ? 5168 : 2304; K = 1024; gch = 0; }
    else if (gsel == 1) { mode = EPI_RESID; offA = OFF_MIX; lda = even ? 2048 : 1024; offB = OFF_WOUT; N = 1024; K = even ? 2048 : 1024; gch = 2; }
    else if (gsel == 2) { mode = EPI_RELU2; offA = OFF_MIX; lda = 1024; offB = OFF_WFF1; N = 4096; K = 1024; gch = 0; }
    else { mode = EPI_RESID; offA = OFF_ACT; lda = 4096; offB = OFF_WFF2; N = 1024; K = 4096; gch = 5; }
    if (dry && mode == EPI_RESID) mode = 4;
    gemm_phase(p, mode, wsp<bfr>(p, offA), lda, wsp<bfr>(p, offB), N, K, layer, gch, (layer == 3 && gsel != 0) ? RL / 128 : R / 128);
  } else if (op == 3) conv_dt_phase(p, j);
  else if (op == 4) s1f1_phase(p);
  else if (op == 5) s2f2_phase(p, j);
  else if (op == 6) s3_phase(p, j);
  else if (op == 8) qkprep_phase(p, j);
  else if (op == 9) attn_phase(p, j);
}

DI int probe_reps(int ph) {
#ifdef PROBE_MASK
  if (ph == 0) return (PROBE_MASK & 1) ? 2 : 1;
  int q = ph - 1, layer, lp;
  if (q < 10) { layer = 0; lp = q; } else if (q < 17) { layer = 1; lp = q - 10; } else if (q < 27) { layer = 2; lp = q - 17; } else { layer = 3; lp = q - 27; }
  const bool even = (layer & 1) == 0;
  int op, gsel;
  if (even) { op = (int)((0x2272654321ull >> (4 * lp)) & 15ull); gsel = (int)((0x3201000000ull >> (4 * lp)) & 15ull); }
  else { op = (int)((0x2272921ull >> (4 * lp)) & 15ull); gsel = (int)((0x3201000ull >> (4 * lp)) & 15ull); }
  if (op == 5) return 1;
  if (op == 2 && (gsel == 1 || gsel == 3)) return ((PROBE_MASK >> 10) & 1) ? 2 : 1;
  return ((PROBE_MASK >> op) & 1) ? 2 : 1;
#else
  return 1;
#endif
}

__shared__ uint4 xb_words;

__global__ void __launch_bounds__(256, 2) mega(Params p, int ph0, int ph1) {
  cg::grid_group grid = cg::this_grid();
  if (threadIdx.x == 0) xb_words = make_uint4(0u, 0u, 0u, 0u);
  __syncthreads();
  XcdBarrier xb = xcd_barrier_post((unsigned*)(p.ws + OFF_BAR), (volatile LAS unsigned*)&xb_words);
#pragma unroll 1
  for (int ph = ph0; ph < ph1; ++ph) {
    const int nrep = probe_reps(ph);
#pragma unroll 1
    for (int rep = 0; rep < nrep; ++rep) {
      DP q;
      (Params&)q = p;
      int t = threadIdx.x, bb = blockIdx.x;
      asm volatile("" : "+v"(t));
      asm volatile("" : "+s"(bb));
      int z0;
      asm volatile("s_mov_b32 %0, 0" : "=s"(z0));
      q.ws = p.ws + z0;
      q.out = p.out + z0;
      q.tidl = t; q.bidl = bb;
      run_phase(q, ph, rep + 1 < nrep);
    }
    if (ph + 1 < ph1) {
      if (ph == ph0) grid.sync();
      else xcd_barrier(xb);
    }
  }
}

extern "C" void kernel_launch(void* const* d_in, const int* in_sizes, int n_in, void* d_out, int out_size, void* d_ws,
                              size_t ws_size, hipStream_t stream) {
  static int grid_blocks = 0;
  if (!grid_blocks) {
    int dev = 0, cus = 0, per_cu = 0;
    hipGetDevice(&dev);
    hipDeviceGetAttribute(&cus, hipDeviceAttributeMultiprocessorCount, dev);
    hipOccupancyMaxActiveBlocksPerMultiprocessor(&per_cu, mega, 256, 0);
    if (per_cu > 2) per_cu = 2;
    if (per_cu < 1) per_cu = 1;
    grid_blocks = cus * per_cu;
  }
  Params p{};
  const float** pp = (const float**)&p;
  for (int i = 0; i < 26; ++i) pp[i] = (const float*)d_in[i];
  p.out = (float*)d_out;
  p.ws = (unsigned char*)d_ws;
  if (ws_size < WS_TOTAL) fprintf(stderr, "workspace too small: %zu < %zu\n", ws_size, (size_t)WS_TOTAL);
  hipMemsetAsync((unsigned char*)d_ws + OFF_BAR, 0, XCD_BAR_WORDS * 4, stream);
#if MULTI_LAUNCH
  for (int ph = 0; ph < NPHASE; ++ph) {
    int a = ph, b = ph + 1;
    void* args[] = {&p, &a, &b};
    hipLaunchCooperativeKernel((void*)mega, dim3(grid_blocks), dim3(256), args, 0, stream);
  }
#else
  int a = 0, b = NPHASE;
  void* args[] = {&p, &a, &b};
  hipError_t e = hipLaunchCooperativeKernel((void*)mega, dim3(grid_blocks), dim3(256), args, 0, stream);
  if (e != hipSuccess) fprintf(stderr, "cooperative launch failed: %s (grid %d)\n", hipGetErrorString(e), grid_blocks);
#endif
}
```
